# Optimizing an MI355X kernel written in HIP

```python
import jax, jax.numpy as jnp
from jax import lax
import numpy as np

D_MODEL = 1024
BATCH = 2
SEQ = 8192
DEPTH = 4

POOL_WINDOWS = (2, 4, 8, 16)
POOL_GROUPS = 4
POOL_W = D_MODEL // 2
POOL_GC = POOL_W // POOL_GROUPS
HEAD_DIM = 64
B_HEADS = 8
B_W = B_HEADS * HEAD_DIM
IDX_HEADS = 8
IDX_DIM = 32
DSA_TOPK = 256
C_HEADS = 8
C_KV_GROUPS = 2
C_W = C_HEADS * HEAD_DIM
KVW = C_KV_GROUPS * HEAD_DIM
CMP_LEN = 32
CMP_STRIDE = 16
SLC_LEN = 64
SLC_N = 16
WIN = 512
FORCE_BONUS = 1e4
N_BRANCH = 3
QBLK = 128
LN_EPS = 1e-5
NEG = -1e30
ALPHA = (2 * DEPTH) ** 0.25
BETA = (8 * DEPTH) ** -0.25

IN_WIDTHS = (POOL_W, POOL_W,
             B_W, HEAD_DIM, HEAD_DIM, B_W,
             IDX_HEADS * IDX_DIM, IDX_DIM, IDX_HEADS,
             C_W, KVW, KVW, KVW, KVW, KVW, KVW,
             C_HEADS * 3, C_W,
             N_BRANCH * D_MODEL)
N_IN = sum(IN_WIDTHS)

kernel_name = "hybrid_pool_dsa_nsa_deepnorm"


def _layernorm(x, g, b):
    xf = x.astype(jnp.float32)
    mu = jnp.mean(xf, axis=-1, keepdims=True)
    var = jnp.mean(jnp.square(xf - mu), axis=-1, keepdims=True)
    return ((xf - mu) * lax.rsqrt(var + LN_EPS) * g + b).astype(x.dtype)


def _masked_softmax(s, mask):
    p = jax.nn.softmax(jnp.where(mask, s.astype(jnp.float32), NEG), axis=-1)
    return p * mask


def _pool_mixer(xa, w, b, scale):
    B_, S, _ = xa.shape
    xg = xa.reshape(B_, S, POOL_GROUPS, POOL_GC)
    c = jnp.pad(jnp.cumsum(xg.astype(jnp.float32), axis=1), ((0, 0), (1, 0), (0, 0), (0, 0)))
    pos = jnp.arange(1, S + 1, dtype=jnp.float32)
    outs = []
    for g, wnd in enumerate(POOL_WINDOWS):
        cg = c[:, :, g]
        lo = jnp.pad(cg[:, :S + 1 - wnd], ((0, 0), (wnd - 1, 0), (0, 0)))
        mean = (cg[:, 1:] - lo) / jnp.minimum(pos, float(wnd))[None, :, None]
        outs.append(mean - xg[:, :, g].astype(jnp.float32))
    pooled = jnp.stack(outs, axis=2).astype(xa.dtype)
    y = jnp.einsum('bsgc,gcd->bsgd', pooled, w) + b
    return y.reshape(B_, S, POOL_W) * scale


def _dsa_mixer(q, k, v, iq, ik, iw):
    B_, S = q.shape[:2]
    topk = min(DSA_TOPK, S // 4)
    nb = S // QBLK
    key_pos = jnp.arange(S)
    gather = jax.vmap(lambda kk, ii: kk[ii])

    def block(i):
        q0 = i * QBLK
        t = q0 + jnp.arange(QBLK)
        qb = lax.dynamic_slice_in_dim(q, q0, QBLK, axis=1)
        iqb = lax.dynamic_slice_in_dim(iq, q0, QBLK, axis=1)
        iwb = lax.dynamic_slice_in_dim(iw, q0, QBLK, axis=1)
        rel = jax.nn.relu(jnp.einsum('bthd,bsd->bths', iqb, ik))
        score = jnp.einsum('bths,bth->bts', rel, iwb).astype(jnp.float32)
        causal = key_pos[None, :] <= t[:, None]
        score = jnp.where(causal[None], score, NEG)
        _, idx = lax.top_k(score, topk)
        kg = gather(k, idx)
        vg = gather(v, idx)
        s = jnp.einsum('bthd,btkd->bthk', qb, kg) * (HEAD_DIM ** -0.5)
        valid = (idx <= t[None, :, None])[:, :, None, :]
        p = _masked_softmax(s, valid).astype(v.dtype)
        return jnp.einsum('bthk,btkd->bthd', p, vg)

    o = lax.map(block, jnp.arange(nb))
    return o.transpose(1, 0, 2, 3, 4).reshape(B_, S, B_W)


def _nsa_mixer(q, kc_tok, vc_tok, ks, vs, kw, vw, gates, pos_k, pos_v, w1k, w2k, w1v, w2v):
    B_, S = q.shape[:2]
    G, R, dh = C_KV_GROUPS, C_HEADS // C_KV_GROUPS, HEAD_DIM
    nb = S // QBLK
    n_c = (S - CMP_LEN) // CMP_STRIDE + 1
    n_s = S // SLC_LEN
    n_sel = min(SLC_N, n_s)
    nk_sel = n_sel * SLC_LEN
    c_start = jnp.arange(n_c) * CMP_STRIDE
    blk_idx = c_start[:, None] + jnp.arange(CMP_LEN)[None, :]

    def compress(tok, pos, w1, w2):
        blk = tok[:, blk_idx] + pos[:, None, :]
        blk = blk.transpose(0, 1, 3, 2, 4).reshape(B_, n_c, G, CMP_LEN * dh)
        h = jax.nn.silu(jnp.einsum('bngf,fe->bnge', blk, w1))
        return jnp.einsum('bnge,ef->bngf', h, w2)

    kcmp = compress(kc_tok, pos_k, w1k, w2k)
    vcmp = compress(vc_tok, pos_v, w1v, w2v)
    cmp_end = c_start + CMP_LEN - 1
    s_start = jnp.arange(n_s) * SLC_LEN
    overlap = ((c_start[:, None] <= s_start[None, :] + SLC_LEN - 1)
               & (cmp_end[:, None] >= s_start[None, :])).astype(jnp.float32)
    ksT = ks.transpose(0, 2, 1, 3)
    vsT = vs.transpose(0, 2, 1, 3)
    kw_pad = jnp.pad(kw, ((0, 0), (WIN, 0), (0, 0), (0, 0)))
    vw_pad = jnp.pad(vw, ((0, 0), (WIN, 0), (0, 0), (0, 0)))
    gather2 = jax.vmap(jax.vmap(lambda kk, ii: kk[ii]))
    sel_j = jnp.arange(n_s)
    scale = HEAD_DIM ** -0.5

    def block(i):
        q0 = i * QBLK
        t = q0 + jnp.arange(QBLK)
        qb = lax.dynamic_slice_in_dim(q, q0, QBLK, axis=1).reshape(B_, QBLK, G, R, dh) * scale
        s_c = jnp.einsum('btgrd,bngd->btgrn', qb, kcmp)
        m_c = (cmp_end[None, :] <= t[:, None])[None, :, None, None, :]
        p_c = _masked_softmax(s_c, m_c)
        o_c = jnp.einsum('btgrn,bngd->btgrd', p_c.astype(vcmp.dtype), vcmp)
        imp = jnp.einsum('btgrn,ns->btgs', p_c, overlap)
        blk_t = t // SLC_LEN
        forced = (sel_j[None, :] == 0) | (sel_j[None, :] == blk_t[:, None]) | (sel_j[None, :] == blk_t[:, None] - 1)
        admissible = s_start[None, :] <= t[:, None]
        imp = imp + jnp.where(forced, FORCE_BONUS, 0.0)[None, :, None, :]
        imp = jnp.where(admissible[None, :, None, :], imp, NEG)
        _, sel = lax.top_k(imp, n_sel)
        tok = (sel[..., None] * SLC_LEN + jnp.arange(SLC_LEN)).reshape(B_, QBLK, G, nk_sel)
        tokT = tok.transpose(0, 2, 1, 3).reshape(B_, G, QBLK * nk_sel)
        kg = gather2(ksT, tokT).reshape(B_, G, QBLK, nk_sel, dh)
        vg = gather2(vsT, tokT).reshape(B_, G, QBLK, nk_sel, dh)
        s_s = jnp.einsum('btgrd,bgtkd->btgrk', qb, kg)
        m_s = (tok <= t[None, :, None, None])[:, :, :, None, :]
        p_s = _masked_softmax(s_s, m_s).astype(vg.dtype)
        o_s = jnp.einsum('btgrk,bgtkd->btgrd', p_s, vg)
        kwb = lax.dynamic_slice_in_dim(kw_pad, q0, QBLK + WIN, axis=1)
        vwb = lax.dynamic_slice_in_dim(vw_pad, q0, QBLK + WIN, axis=1)
        kpos = q0 - WIN + jnp.arange(QBLK + WIN)
        m_w = (kpos[None, :] >= 0) & (kpos[None, :] <= t[:, None]) & (kpos[None, :] > t[:, None] - WIN)
        s_w = jnp.einsum('btgrd,bkgd->btgrk', qb, kwb)
        p_w = _masked_softmax(s_w, m_w[None, :, None, None, :]).astype(vwb.dtype)
        o_w = jnp.einsum('btgrk,bkgd->btgrd', p_w, vwb)
        gb = jax.nn.sigmoid(lax.dynamic_slice_in_dim(gates, q0, QBLK, axis=1)).reshape(B_, QBLK, G, R, 3)
        o = gb[..., 0:1] * o_c + gb[..., 1:2] * o_s + gb[..., 2:3] * o_w
        return o.reshape(B_, QBLK, C_W)

    o = lax.map(block, jnp.arange(nb))
    return o.transpose(1, 0, 2, 3).reshape(B_, S, C_W)


def _layer(x, w_in, b_in, pool_w, pool_b, pool_scale, pos_k, pos_v, w1k, w2k, w1v, w2v,
           w_pa, w_pb, w_pc, w_o, ln_g, ln_b):
    B_, S, _ = x.shape
    u = jnp.einsum('bsd,de->bse', x, w_in) + b_in
    points = [int(p) for p in np.cumsum(IN_WIDTHS)[:-1]]
    (a_x, a_z, b_q, b_k, b_v, b_z, i_q, i_k, i_w, c_q, c_kc, c_vc, c_ks, c_vs,
     c_kw, c_vw, c_g, c_z, g_merge) = jnp.split(u, points, axis=-1)
    y_a = _pool_mixer(a_x, pool_w, pool_b, pool_scale) * jax.nn.silu(a_z)
    y_b = _dsa_mixer(b_q.reshape(B_, S, B_HEADS, HEAD_DIM), b_k, b_v,
                     i_q.reshape(B_, S, IDX_HEADS, IDX_DIM), i_k,
                     i_w * (IDX_HEADS ** -0.5 * IDX_DIM ** -0.5)) * jax.nn.silu(b_z)
    kv = lambda t_: t_.reshape(B_, S, C_KV_GROUPS, HEAD_DIM)
    y_c = _nsa_mixer(c_q.reshape(B_, S, C_HEADS, HEAD_DIM), kv(c_kc), kv(c_vc), kv(c_ks), kv(c_vs),
                     kv(c_kw), kv(c_vw), c_g.reshape(B_, S, C_HEADS, 3),
                     pos_k, pos_v, w1k, w2k, w1v, w2v) * jax.nn.silu(c_z)
    g = jax.nn.sigmoid(g_merge).reshape(B_, S, N_BRANCH, D_MODEL)
    m = (g[:, :, 0] * jnp.einsum('bse,ed->bsd', y_a, w_pa)
         + g[:, :, 1] * jnp.einsum('bse,ed->bsd', y_b, w_pb)
         + g[:, :, 2] * jnp.einsum('bse,ed->bsd', y_c, w_pc))
    out = jnp.einsum('bsd,de->bse', m, w_o)
    return _layernorm(ALPHA * x + out, ln_g, ln_b)


def setup_inputs(seed: int = 0) -> dict:
    key = jax.random.key(seed)
    ks = jax.random.split(key, 19)
    nrm = lambda k, shape, s: jax.random.normal(k, shape, jnp.float32) * s
    L, D = DEPTH, D_MODEL
    return {
        "x": nrm(ks[0], (BATCH, SEQ, D), 1.0),
        "w_in": nrm(ks[1], (L, D, N_IN), D ** -0.5),
        "b_in": nrm(ks[2], (L, N_IN), 0.02),
        "pool_w": nrm(ks[3], (L, POOL_GROUPS, POOL_GC, POOL_GC), POOL_GC ** -0.5),
        "pool_b": nrm(ks[4], (L, POOL_GROUPS, POOL_GC), 0.02),
        "pool_scale": 1.0 + nrm(ks[5], (L, POOL_W), 0.02),
        "cmp_pos_k": nrm(ks[6], (L, CMP_LEN, HEAD_DIM), 0.1),
        "cmp_pos_v": nrm(ks[7], (L, CMP_LEN, HEAD_DIM), 0.1),
        "cmp_w1_k": nrm(ks[8], (L, CMP_LEN * HEAD_DIM, HEAD_DIM), (CMP_LEN * HEAD_DIM) ** -0.5),
        "cmp_w2_k": nrm(ks[9], (L, HEAD_DIM, HEAD_DIM), HEAD_DIM ** -0.5),
        "cmp_w1_v": nrm(ks[10], (L, CMP_LEN * HEAD_DIM, HEAD_DIM), (CMP_LEN * HEAD_DIM) ** -0.5),
        "cmp_w2_v": nrm(ks[11], (L, HEAD_DIM, HEAD_DIM), HEAD_DIM ** -0.5),
        "w_proj_a": nrm(ks[12], (L, POOL_W, D), POOL_W ** -0.5 * BETA),
        "w_proj_b": nrm(ks[13], (L, B_W, D), B_W ** -0.5 * BETA),
        "w_proj_c": nrm(ks[14], (L, C_W, D), C_W ** -0.5 * BETA),
        "w_o": nrm(ks[15], (L, D, D), D ** -0.5 * BETA),
        "ln_g": 1.0 + nrm(ks[16], (L, D), 0.02),
        "ln_b": nrm(ks[17], (L, D), 0.02),
    }


def reference(x, w_in, b_in, pool_w, pool_b, pool_scale, cmp_pos_k, cmp_pos_v, cmp_w1_k, cmp_w2_k,
              cmp_w1_v, cmp_w2_v, w_proj_a, w_proj_b, w_proj_c, w_o, ln_g, ln_b):
    h = x
    for l in range(DEPTH):
        h = _layer(h, w_in[l], b_in[l], pool_w[l], pool_b[l], pool_scale[l],
                   cmp_pos_k[l], cmp_pos_v[l], cmp_w1_k[l], cmp_w2_k[l], cmp_w1_v[l], cmp_w2_v[l],
                   w_proj_a[l], w_proj_b[l], w_proj_c[l], w_o[l], ln_g[l], ln_b[l])
    return h
```

```cpp
#include <hip/hip_runtime.h>
#include <hip/hip_cooperative_groups.h>
#include <cstdio>
#include <cstdint>
namespace cg = cooperative_groups;

typedef _Float16 half_t;
typedef _Float16 h8 __attribute__((ext_vector_type(8)));
typedef _Float16 h4 __attribute__((ext_vector_type(4)));
typedef float f32x4 __attribute__((ext_vector_type(4)));
typedef float f32x16 __attribute__((ext_vector_type(16)));

#define SEQ 8192
#define DM 1024
#define NTOK 16384
#define DEPTH 4
#define NIN 7360
#define NU 7424
#define ALPHA_F 1.681792830507429f
#define NEGF (-1e30f)

#define C_AX 0
#define C_AZ 512
#define C_BQ 1024
#define C_BZ 1536
#define C_CQ 2048
#define C_CZ 2560
#define C_GM 3072
#define C_IQ 6144
#define C_CKC 6400
#define C_CVC 6528
#define C_CKS 6656
#define C_CVS 6784
#define C_CKW 6912
#define C_CVW 7040
#define C_BK 7168
#define C_BV 7232
#define C_IK 7296
#define C_IW 7328
#define C_CG 7336

#define SMEM_BYTES 69632

constexpr size_t OFF_xr = 0;
constexpr size_t OFF_xh = OFF_xr + (((size_t)NTOK*DM*4 + 255) & ~(size_t)255);
constexpr size_t OFF_u = OFF_xh + (((size_t)NTOK*DM*2 + 255) & ~(size_t)255);
constexpr size_t OFF_winT = OFF_u + (((size_t)NTOK*NU*2 + 255) & ~(size_t)255);
constexpr size_t OFF_wpT = OFF_winT + (((size_t)NU*DM*2 + 255) & ~(size_t)255);
constexpr size_t OFF_woT = OFF_wpT + (((size_t)3*DM*512*2 + 255) & ~(size_t)255);
constexpr size_t OFF_poolT = OFF_woT + (((size_t)DM*DM*2 + 255) & ~(size_t)255);
constexpr size_t OFF_w1T = OFF_poolT + (((size_t)4*128*128*2 + 255) & ~(size_t)255);
constexpr size_t OFF_posb = OFF_w1T + (((size_t)2*64*2048*2 + 255) & ~(size_t)255);
constexpr size_t OFF_vsT = OFF_posb + (((size_t)512 + 255) & ~(size_t)255);
constexpr size_t OFF_vwT = OFF_vsT + (((size_t)4*64*SEQ*2 + 255) & ~(size_t)255);
constexpr size_t OFF_kcmp = OFF_vwT + (((size_t)4*64*SEQ*2 + 255) & ~(size_t)255);
constexpr size_t OFF_vcmpT = OFF_kcmp + (((size_t)4*512*64*2 + 255) & ~(size_t)255);
constexpr size_t OFF_ya = OFF_vcmpT + (((size_t)4*64*512*2 + 255) & ~(size_t)255);
constexpr size_t OFF_yb = OFF_ya + (((size_t)NTOK*512*2 + 255) & ~(size_t)255);
constexpr size_t OFF_yc = OFF_yb + (((size_t)NTOK*512*2 + 255) & ~(size_t)255);
constexpr size_t OFF_mm = OFF_yc + (((size_t)NTOK*512*2 + 255) & ~(size_t)255);
constexpr size_t OFF_counters = OFF_mm + (((size_t)NTOK*DM*2 + 255) & ~(size_t)255);
constexpr size_t WS_TOTAL = OFF_counters + (((size_t)256 + 255) & ~(size_t)255);
struct Params {
  const float* x; const float* w_in; const float* b_in; const float* pool_w; const float* pool_b;
  const float* pool_scale; const float* pos_k; const float* pos_v; const float* w1k; const float* w2k;
  const float* w1v; const float* w2v; const float* wpa; const float* wpb; const float* wpc;
  const float* wo; const float* ln_g; const float* ln_b;
  float* out;
  char* ws;
  __device__ __forceinline__ float* xr() const { return (float*)(ws + OFF_xr); }
  __device__ __forceinline__ half_t* xh() const { return (half_t*)(ws + OFF_xh); }
  __device__ __forceinline__ half_t* u() const { return (half_t*)(ws + OFF_u); }
  __device__ __forceinline__ half_t* winT() const { return (half_t*)(ws + OFF_winT); }
  __device__ __forceinline__ half_t* wpT() const { return (half_t*)(ws + OFF_wpT); }
  __device__ __forceinline__ half_t* woT() const { return (half_t*)(ws + OFF_woT); }
  __device__ __forceinline__ half_t* poolT() const { return (half_t*)(ws + OFF_poolT); }
  __device__ __forceinline__ half_t* w1T() const { return (half_t*)(ws + OFF_w1T); }
  __device__ __forceinline__ float* posb() const { return (float*)(ws + OFF_posb); }
  __device__ __forceinline__ half_t* vsT() const { return (half_t*)(ws + OFF_vsT); }
  __device__ __forceinline__ half_t* vwT() const { return (half_t*)(ws + OFF_vwT); }
  __device__ __forceinline__ half_t* kcmp() const { return (half_t*)(ws + OFF_kcmp); }
  __device__ __forceinline__ half_t* vcmpT() const { return (half_t*)(ws + OFF_vcmpT); }
  __device__ __forceinline__ half_t* ya() const { return (half_t*)(ws + OFF_ya); }
  __device__ __forceinline__ half_t* yb() const { return (half_t*)(ws + OFF_yb); }
  __device__ __forceinline__ half_t* yc() const { return (half_t*)(ws + OFF_yc); }
  __device__ __forceinline__ half_t* mm() const { return (half_t*)(ws + OFF_mm); }
  __device__ __forceinline__ int* counters() const { return (int*)(ws + OFF_counters); }
};

__device__ __forceinline__ int orig_col(int n) {
  if (n < 1536) return n;
  if (n < 2048) return 1664 + (n - 1536);
  if (n < 2560) return 2472 + (n - 2048);
  if (n < 3072) return 3776 + (n - 2560);
  if (n < 6144) return 4288 + (n - 3072);
  if (n < 6400) return 2176 + (n - 6144);
  if (n < 7168) return 2984 + (n - 6400);
  if (n < 7296) return 1536 + (n - 7168);
  if (n < 7328) return 2432 + (n - 7296);
  if (n < 7336) return 2464 + (n - 7328);
  if (n < 7360) return 3752 + (n - 7336);
  return -1;
}

__device__ __forceinline__ float wave_sum(float v) {
#pragma unroll
  for (int o = 32; o > 0; o >>= 1) v += __shfl_xor(v, o);
  return v;
}
__device__ __forceinline__ float sigmoidf_(float x) { return 1.f / (1.f + __expf(-x)); }
__device__ __forceinline__ float siluf_(float x) { return x / (1.f + __expf(-x)); }

template <int NI, class LA, class LB, class EP>
__device__ __forceinline__ void gemm_tile(int K, LA loadA, LB loadB, EP epi, char* smem) {
  constexpr int BN = NI * 64;
  constexpr int NB = BN / 32;
  half_t* sA = (half_t*)smem;
  half_t* sB = sA + 128 * 72;
  int tid = threadIdx.x;
  asm volatile("" : "+v"(tid));
  const int lane = tid & 63, wid = tid >> 6;
  const int wm = wid >> 1, wn = wid & 1;
  f32x16 acc[2][NI];
#pragma unroll
  for (int i = 0; i < 2; ++i)
#pragma unroll
    for (int j = 0; j < NI; ++j)
#pragma unroll
      for (int r = 0; r < 16; ++r) acc[i][j][r] = 0.f;
  const int lr = tid >> 3, lc = (tid & 7) * 8;
  uint4 ra[4], rb[NB];
#pragma unroll
  for (int i = 0; i < 4; ++i) ra[i] = loadA(lr + 32 * i, lc);
#pragma unroll
  for (int i = 0; i < NB; ++i) rb[i] = loadB(lr + 32 * i, lc);
  const int nk = K >> 6;
  for (int kt = 0; kt < nk; ++kt) {
    __syncthreads();
#pragma unroll
    for (int i = 0; i < 4; ++i) *(uint4*)&sA[(lr + 32 * i) * 72 + lc] = ra[i];
#pragma unroll
    for (int i = 0; i < NB; ++i) *(uint4*)&sB[(lr + 32 * i) * 72 + lc] = rb[i];
    __syncthreads();
    if (kt + 1 < nk) {
      const int kk = (kt + 1) * 64 + lc;
#pragma unroll
      for (int i = 0; i < 4; ++i) ra[i] = loadA(lr + 32 * i, kk);
#pragma unroll
      for (int i = 0; i < NB; ++i) rb[i] = loadB(lr + 32 * i, kk);
    }
#pragma unroll
    for (int s = 0; s < 4; ++s) {
      h8 af[2], bf[NI];
#pragma unroll
      for (int mi = 0; mi < 2; ++mi)
        af[mi] = *(const h8*)&sA[(wm * 64 + mi * 32 + (lane & 31)) * 72 + s * 16 + (lane >> 5) * 8];
#pragma unroll
      for (int ni = 0; ni < NI; ++ni)
        bf[ni] = *(const h8*)&sB[(wn * (NI * 32) + ni * 32 + (lane & 31)) * 72 + s * 16 + (lane >> 5) * 8];
#pragma unroll
      for (int mi = 0; mi < 2; ++mi)
#pragma unroll
        for (int ni = 0; ni < NI; ++ni)
          acc[mi][ni] = __builtin_amdgcn_mfma_f32_32x32x16_f16(af[mi], bf[ni], acc[mi][ni], 0, 0, 0);
    }
  }
#pragma unroll
  for (int mi = 0; mi < 2; ++mi)
#pragma unroll
    for (int ni = 0; ni < NI; ++ni)
#pragma unroll
      for (int r = 0; r < 16; ++r) {
        const int row = wm * 64 + mi * 32 + (r & 3) + 8 * (r >> 2) + 4 * (lane >> 5);
        const int col = wn * (NI * 32) + ni * 32 + (lane & 31);
        epi(mi, ni, r, row, col, acc[mi][ni][r]);
      }
}

template <class CM>
__device__ __forceinline__ void tconv_tile(const float* __restrict__ src, int lds_, half_t* __restrict__ dst, int ldd,
                                           int n0, int k0, CM cmap, char* smem) {
  float* t = (float*)smem;
  int tid = threadIdx.x;
  asm volatile("" : "+v"(tid));
  {
    const int n = tid & 63;
    const int c = cmap(n0 + n);
#pragma unroll 4
    for (int i = 0; i < 16; ++i) {
      const int k = (tid >> 6) + 4 * i;
      t[k * 65 + n] = (c >= 0) ? src[(size_t)(k0 + k) * lds_ + c] : 0.f;
    }
  }
  __syncthreads();
#pragma unroll
  for (int i = 0; i < 2; ++i) {
    const int idx = tid + 256 * i;
    const int n = idx >> 3, kc = (idx & 7) * 8;
    h8 v;
#pragma unroll
    for (int j = 0; j < 8; ++j) v[j] = (half_t)t[(kc + j) * 65 + n];
    *(h8*)&dst[(size_t)(n0 + n) * ldd + k0 + kc] = v;
  }
  __syncthreads();
}

__device__ void ln_rows(const Params& p, int lprev, bool final_) {
  int tid = threadIdx.x;
  asm volatile("" : "+v"(tid));
  const int lane = tid & 63, wid = tid >> 6;
  const int gw = blockIdx.x * 4 + wid, nw = gridDim.x * 4;
  for (int row = gw; row < NTOK; row += nw) {
    const float4* rp = (const float4*)((lprev < 0 ? p.x : p.xr()) + (size_t)row * DM);
    float4 v[4];
    float s = 0.f;
#pragma unroll
    for (int i = 0; i < 4; ++i) {
      v[i] = rp[lane + 64 * i];
      s += v[i].x + v[i].y + v[i].z + v[i].w;
    }
    if (lprev >= 0) {
      float mu = wave_sum(s) * (1.f / DM);
      float q = 0.f;
#pragma unroll
      for (int i = 0; i < 4; ++i) {
        float a = v[i].x - mu, b = v[i].y - mu, c = v[i].z - mu, d = v[i].w - mu;
        q += a * a + b * b + c * c + d * d;
      }
      float rstd = rsqrtf(wave_sum(q) * (1.f / DM) + 1e-5f);
      const float4* g4 = (const float4*)(p.ln_g + lprev * DM);
      const float4* b4 = (const float4*)(p.ln_b + lprev * DM);
#pragma unroll
      for (int i = 0; i < 4; ++i) {
        float4 g = g4[lane + 64 * i], bb = b4[lane + 64 * i];
        v[i].x = (v[i].x - mu) * rstd * g.x + bb.x;
        v[i].y = (v[i].y - mu) * rstd * g.y + bb.y;
        v[i].z = (v[i].z - mu) * rstd * g.z + bb.z;
        v[i].w = (v[i].w - mu) * rstd * g.w + bb.w;
      }
    }
    if (final_) {
      float4* op = (float4*)(p.out + (size_t)row * DM);
#pragma unroll
      for (int i = 0; i < 4; ++i) op[lane + 64 * i] = v[i];
    } else {
      float4* op = (float4*)(p.xr() + (size_t)row * DM);
      h4* hp = (h4*)(p.xh() + (size_t)row * DM);
#pragma unroll
      for (int i = 0; i < 4; ++i) {
        op[lane + 64 * i] = v[i];
        h4 hv;
        hv[0] = (half_t)v[i].x; hv[1] = (half_t)v[i].y; hv[2] = (half_t)v[i].z; hv[3] = (half_t)v[i].w;
        hp[lane + 64 * i] = hv;
      }
    }
  }
}

__device__ void prep_weights(const Params& p, int l, char* smem) {
  int tid = threadIdx.x;
  asm volatile("" : "+v"(tid));
  const int total = 1856 + 384 + 256 + 16 + 64 + 2;
  for (int it = blockIdx.x; it < total; it += gridDim.x) {
    if (it < 1856) {
      const int nt = it >> 4, kt = it & 15;
      tconv_tile(p.w_in + (size_t)l * DM * NIN, NIN, p.winT(), DM, nt * 64, kt * 64,
                 [](int n) { return orig_col(n); }, smem);
    } else if (it < 1856 + 384) {
      const int j = it - 1856;
      const int w = j >> 7, r = j & 127, nt = r >> 3, kt = r & 7;
      const float* src = (w == 0 ? p.wpa : (w == 1 ? p.wpb : p.wpc)) + (size_t)l * 512 * DM;
      tconv_tile(src, DM, p.wpT() + (size_t)w * DM * 512, 512, nt * 64, kt * 64, [](int n) { return n; }, smem);
    } else if (it < 1856 + 384 + 256) {
      const int j = it - 1856 - 384;
      const int nt = j >> 4, kt = j & 15;
      tconv_tile(p.wo + (size_t)l * DM * DM, DM, p.woT(), DM, nt * 64, kt * 64, [](int n) { return n; }, smem);
    } else if (it < 1856 + 384 + 256 + 16) {
      const int j = it - 1856 - 384 - 256;
      const int g = j >> 2, nt = (j >> 1) & 1, kt = j & 1;
      tconv_tile(p.pool_w + ((size_t)l * 4 + g) * 128 * 128, 128, p.poolT() + (size_t)g * 128 * 128, 128, nt * 64,
                 kt * 64, [](int n) { return n; }, smem);
    } else if (it < 1856 + 384 + 256 + 16 + 64) {
      const int j = it - 1856 - 384 - 256 - 16;
      const int kv = j >> 5, kt = j & 31;
      const float* src = (kv ? p.w1v : p.w1k) + (size_t)l * 2048 * 64;
      tconv_tile(src, 64, p.w1T() + (size_t)kv * 64 * 2048, 2048, 0, kt * 64, [](int n) { return n; }, smem);
    } else {
      const int kv = it - (1856 + 384 + 256 + 16 + 64);
      const float* w1 = (kv ? p.w1v : p.w1k) + (size_t)l * 2048 * 64;
      const float* pos = (kv ? p.pos_v : p.pos_k) + (size_t)l * 2048;
      float* red = (float*)smem;
      const int e = tid & 63, part = tid >> 6;
      float s = 0.f;
      for (int f = part * 512; f < part * 512 + 512; ++f) s += pos[f] * w1[(size_t)f * 64 + e];
      red[tid] = s;
      __syncthreads();
      if (tid < 64) p.posb()[kv * 64 + tid] = red[tid] + red[tid + 64] + red[tid + 128] + red[tid + 192];
      __syncthreads();
    }
  }
}

__device__ void phase_inproj(const Params& p, int l, char* smem) {
  const float* bias = p.b_in + (size_t)l * NIN;
  for (int tile = blockIdx.x; tile < 58 * 128; tile += gridDim.x) {
    const int nt = tile >> 7, mt = tile & 127;
    const int m0 = mt * 128, n0 = nt * 128;
    const half_t* A = p.xh() + (size_t)m0 * DM;
    const half_t* B = p.winT() + (size_t)n0 * DM;
    int tidx = threadIdx.x;
    asm volatile("" : "+v"(tidx));
    const int lane = tidx & 63, wn = (tidx >> 6) & 1;
    float bv[2];
#pragma unroll
    for (int ni = 0; ni < 2; ++ni) {
      const int oc = orig_col(n0 + wn * 64 + ni * 32 + (lane & 31));
      bv[ni] = oc >= 0 ? bias[oc] : 0.f;
    }
    half_t* vT = (nt == 53) ? p.vsT() : ((nt == 55) ? p.vwT() : nullptr);
    gemm_tile<2>(
        DM, [&](int r, int k) { return *(const uint4*)(A + (size_t)r * DM + k); },
        [&](int r, int k) { return *(const uint4*)(B + (size_t)r * DM + k); },
        [&](int mi, int ni, int r, int row, int col, float v) {
          const half_t hv = (half_t)(v + bv[ni]);
          const int tok = m0 + row;
          p.u()[(size_t)tok * NU + n0 + col] = hv;
          if (vT) {
            const int b = tok >> 13, t = tok & 8191;
            vT[((size_t)(b * 2 + (col >> 6)) * 64 + (col & 63)) * SEQ + t] = hv;
          }
        },
        smem);
  }
}

__device__ void pool_item(const Params& p, int l, int item, char* smem) {
  const int g = item & 3, mt = item >> 2;
  const int m0 = mt * 128;
  const int wnd = 2 << g;
  const half_t* B = p.poolT() + (size_t)g * 128 * 128;
  int tidx = threadIdx.x;
  asm volatile("" : "+v"(tidx));
  const int lane = tidx & 63, wn = (tidx >> 6) & 1;
  float pb[2], ps[2];
#pragma unroll
  for (int ni = 0; ni < 2; ++ni) {
    const int d = wn * 64 + ni * 32 + (lane & 31);
    pb[ni] = p.pool_b[(size_t)l * 512 + g * 128 + d];
    ps[ni] = p.pool_scale[(size_t)l * 512 + g * 128 + d];
  }
  gemm_tile<2>(
      128,
      [&](int r, int k) {
        const int tok = m0 + r, t = tok & 8191;
        const int cnt = min(t + 1, wnd);
        const half_t* base = p.u() + (size_t)tok * NU + C_AX + g * 128 + k;
        float s[8];
#pragma unroll
        for (int j = 0; j < 8; ++j) s[j] = 0.f;
        h8 cur = *(const h8*)base;
        for (int q = 0; q < cnt; ++q) {
          h8 v = *(const h8*)(base - (size_t)q * NU);
#pragma unroll
          for (int j = 0; j < 8; ++j) s[j] += (float)v[j];
        }
        const float inv = 1.f / (float)cnt;
        h8 o;
#pragma unroll
        for (int j = 0; j < 8; ++j) o[j] = (half_t)(s[j] * inv - (float)cur[j]);
        return *(uint4*)&o;
      },
      [&](int r, int k) { return *(const uint4*)(B + (size_t)r * 128 + k); },
      [&](int mi, int ni, int r, int row, int col, float v) {
        const int tok = m0 + row;
        const float z = (float)p.u()[(size_t)tok * NU + C_AZ + g * 128 + col];
        p.ya()[(size_t)tok * 512 + g * 128 + col] = (half_t)((v + pb[ni]) * ps[ni] * siluf_(z));
      },
      smem);
}

__device__ void compress_item(const Params& p, int l, int item, char* smem) {
  const int mt = item & 3, kv = (item >> 2) & 1, g = (item >> 3) & 1, b = item >> 4;
  int tid = threadIdx.x;
  asm volatile("" : "+v"(tid));
  const int ccol = (kv ? C_CVC : C_CKC) + g * 64;
  const half_t* ub = p.u() + (size_t)b * SEQ * NU + ccol;
  const half_t* B = p.w1T() + (size_t)kv * 64 * 2048;
  float* hid = (float*)(smem + 28672);
  const float* posb = p.posb() + kv * 64;
  gemm_tile<1>(
      2048,
      [&](int r, int k) {
        const int n = mt * 128 + r;
        if (n >= 511) return make_uint4(0, 0, 0, 0);
        const int tok = 16 * n + (k >> 6);
        return *(const uint4*)(ub + (size_t)tok * NU + (k & 63));
      },
      [&](int r, int k) { return *(const uint4*)(B + (size_t)r * 2048 + k); },
      [&](int mi, int ni, int r, int row, int col, float v) { hid[row * 65 + col] = siluf_(v + posb[col]); }, smem);
  __syncthreads();
  float* w2s = (float*)smem;
  const float* w2 = (kv ? p.w2v : p.w2k) + (size_t)l * 4096;
  for (int i = tid; i < 4096; i += 256) w2s[i] = w2[i];
  __syncthreads();
  {
    const int n = tid >> 1, fh = (tid & 1) * 32;
    float acc[32];
#pragma unroll
    for (int f = 0; f < 32; ++f) acc[f] = 0.f;
    for (int e = 0; e < 64; ++e) {
      const float hv = hid[n * 65 + e];
#pragma unroll
      for (int f = 0; f < 32; ++f) acc[f] += hv * w2s[e * 64 + fh + f];
    }
    const int ng = mt * 128 + n;
    const bool valid = ng < 511;
    if (kv == 0) {
      half_t* dst = p.kcmp() + ((size_t)(b * 2 + g) * 512 + ng) * 64 + fh;
#pragma unroll
      for (int f = 0; f < 32; ++f) dst[f] = valid ? (half_t)acc[f] : (half_t)0.f;
    } else {
      half_t* dst = p.vcmpT() + ((size_t)(b * 2 + g) * 64 + fh) * 512 + ng;
#pragma unroll
      for (int f = 0; f < 32; ++f) dst[(size_t)f * 512] = valid ? (half_t)acc[f] : (half_t)0.f;
    }
  }
  __syncthreads();
}

__device__ void dsa_item(const Params& p, int item, char* smem) {
  const int b = item & 1, tile = 255 - (item >> 1);
  const int t0 = tile * 32;
  int tid = threadIdx.x;
  asm volatile("" : "+v"(tid));
  const int lane = tid & 63, wid = tid >> 6;
  uint32_t* hist = (uint32_t*)smem;
  half_t* iqs = (half_t*)(smem + 32768);
  unsigned short* sel = (unsigned short*)(smem + 49664);
  unsigned long long* pfx = (unsigned long long*)(smem + 66048);
  unsigned long long* tkey = pfx + 32;
  int* need = (int*)(tkey + 32);
  int* done = need + 32;
  int* cnt = done + 32;
  int* nrem = cnt + 32;
  float* pbuf = (float*)smem + wid * 2048;

  const half_t* ub = p.u() + (size_t)b * SEQ * NU;
  for (int i = tid; i < 32 * 32; i += 256) {
    const int tk = i >> 5, c = (i & 31) * 8;
    *(uint4*)&iqs[tk * 264 + c] = *(const uint4*)(ub + (size_t)(t0 + tk) * NU + C_IQ + c);
  }
  if (tid < 32) {
    const int t = t0 + tid;
    pfx[tid] = 0ull; tkey[tid] = 0ull; need[tid] = 256; done[tid] = (t < 256) ? 1 : 0; cnt[tid] = 0;
  }
  if (tid < 8) nrem[tid] = 0;
  float iw[8];
  {
    const half_t* wp = ub + (size_t)(t0 + (lane & 31)) * NU + C_IW;
    h8 w8 = *(const h8*)wp;
#pragma unroll
    for (int h = 0; h < 8; ++h) iw[h] = (float)w8[h] * 0.0625f;
  }
  __syncthreads();
  const int nkt = tile + 1;
  const int mytok = lane & 31;
  const int myt = t0 + mytok;

  auto scores = [&](int kt, float* sc) {
    const half_t* kp = ub + (size_t)(kt * 32 + (lane & 31)) * NU + C_IK + (lane >> 5) * 8;
    const h8 a0 = *(const h8*)kp, a1 = *(const h8*)(kp + 16);
#pragma unroll
    for (int r = 0; r < 16; ++r) sc[r] = 0.f;
    int qoff = mytok * 264 + (lane >> 5) * 8;
    asm volatile("" : "+v"(qoff));
#pragma unroll
    for (int h = 0; h < 8; ++h) {
      const h8 b0 = *(const h8*)&iqs[qoff + h * 32];
      const h8 b1 = *(const h8*)&iqs[qoff + h * 32 + 16];
      f32x16 d;
#pragma unroll
      for (int r = 0; r < 16; ++r) d[r] = 0.f;
      d = __builtin_amdgcn_mfma_f32_32x32x16_f16(a0, b0, d, 0, 0, 0);
      d = __builtin_amdgcn_mfma_f32_32x32x16_f16(a1, b1, d, 0, 0, 0);
#pragma unroll
      for (int r = 0; r < 16; ++r) sc[r] += fmaxf(d[r], 0.f) * iw[h];
    }
  };
  auto mkkey = [&](float s, int key) -> unsigned long long {
    s = s + 0.f;
    uint32_t ub_ = __float_as_uint(s);
    ub_ = (ub_ & 0x80000000u) ? ~ub_ : (ub_ | 0x80000000u);
    return ((unsigned long long)ub_ << 16) | ((unsigned long long)(8191 - key) << 3);
  };

  for (int level = 0; level < 6; ++level) {
    const int shift = 40 - 8 * level;
    for (int i = tid; i < 8192; i += 256) hist[i] = 0u;
    __syncthreads();
    {
      const unsigned long long mypfx = pfx[mytok];
      const bool mydone = done[mytok] != 0;
      for (int kt = wid; kt < nkt; kt += 4) {
        float sc[16];
        scores(kt, sc);
        if (!mydone) {
#pragma unroll
          for (int r = 0; r < 16; ++r) {
            const int key = kt * 32 + (r & 3) + 8 * (r >> 2) + 4 * (lane >> 5);
            if (key <= myt) {
              const unsigned long long k48 = mkkey(sc[r], key);
              if (level == 0 || (k48 >> (shift + 8)) == mypfx)
                atomicAdd(&hist[mytok * 256 + (int)((k48 >> shift) & 255ull)], 1u);
            }
          }
        }
      }
    }
    __syncthreads();
    {
      int rem = 0;
      for (int j = 0; j < 8; ++j) {
        const int tk = wid * 8 + j;
        if (done[tk]) continue;
        const uint32_t* hrow = hist + tk * 256;
        const uint4 hv = *(const uint4*)&hrow[252 - 4 * lane];
        const int c = (int)(hv.x + hv.y + hv.z + hv.w);
        int cum = c;
#pragma unroll
        for (int o = 1; o < 64; o <<= 1) {
          int v = __shfl_up(cum, o);
          if (lane >= o) cum += v;
        }
        const int nd = need[tk];
        const unsigned long long mask = __ballot(cum >= nd);
        const int L = (int)__builtin_ctzll(mask);
        int running = cum - c, bstar, cb;
        if (running + (int)hv.w >= nd) { bstar = 255 - 4 * lane; cb = hv.w; }
        else {
          running += hv.w;
          if (running + (int)hv.z >= nd) { bstar = 254 - 4 * lane; cb = hv.z; }
          else {
            running += hv.z;
            if (running + (int)hv.y >= nd) { bstar = 253 - 4 * lane; cb = hv.y; }
            else { running += hv.y; bstar = 252 - 4 * lane; cb = hv.x; }
          }
        }
        running = __shfl(running, L); bstar = __shfl(bstar, L); cb = __shfl(cb, L);
        const int nd2 = nd - running;
        if (lane == 0) {
          const unsigned long long np = (pfx[tk] << 8) | (unsigned long long)bstar;
          if (cb == nd2 || level == 5) { done[tk] = 1; tkey[tk] = np << shift; }
          else { need[tk] = nd2; pfx[tk] = np; }
        }
        if (!(cb == nd2 || level == 5)) rem++;
      }
      if (lane == 0 && rem) atomicAdd(&nrem[level], rem);
    }
    __syncthreads();
    if (nrem[level] == 0) break;
  }
  {
    const unsigned long long mytk = tkey[mytok];
    for (int kt = wid; kt < nkt; kt += 4) {
      float sc[16];
      scores(kt, sc);
#pragma unroll
      for (int r = 0; r < 16; ++r) {
        const int key = kt * 32 + (r & 3) + 8 * (r >> 2) + 4 * (lane >> 5);
        if (key <= myt) {
          const unsigned long long k48 = mkkey(sc[r], key);
          if (k48 >= mytk) {
            const int pos = atomicAdd(&cnt[mytok], 1);
            if (pos < 256) sel[mytok * 256 + pos] = (unsigned short)key;
          }
        }
      }
    }
  }
  __syncthreads();
  for (int j = 0; j < 8; ++j) {
    const int tk = wid * 8 + j;
    const int t = t0 + tk;
    const int nsel = min(cnt[tk], 256);
    const half_t* urow = ub + (size_t)t * NU;
    const int col = lane & 15, hq = lane >> 4;
    h8 q0, q1;
#pragma unroll
    for (int e = 0; e < 8; ++e) { q0[e] = (half_t)0.f; q1[e] = (half_t)0.f; }
    if (col < 8) {
      q0 = *(const h8*)(urow + C_BQ + col * 64 + hq * 8);
      q1 = *(const h8*)(urow + C_BQ + col * 64 + 32 + hq * 8);
    }
    float mx = NEGF;
#pragma unroll 1
    for (int mg = 0; mg < 4; ++mg) {
#pragma unroll
      for (int mm = 0; mm < 4; ++mm) {
        const int m = mg * 4 + mm;
        const int pos = m * 16 + col;
        const int s = (pos < nsel) ? (int)sel[tk * 256 + pos] : 0;
        const half_t* kp = ub + (size_t)s * NU + C_BK + hq * 8;
        const h8 a0 = *(const h8*)kp, a1 = *(const h8*)(kp + 32);
        f32x4 d = {0.f, 0.f, 0.f, 0.f};
        d = __builtin_amdgcn_mfma_f32_16x16x32_f16(a0, q0, d, 0, 0, 0);
        d = __builtin_amdgcn_mfma_f32_16x16x32_f16(a1, q1, d, 0, 0, 0);
#pragma unroll
        for (int r = 0; r < 4; ++r) {
          const int pp = m * 16 + hq * 4 + r;
          const float v = (pp < nsel) ? d[r] * 0.125f : NEGF;
          mx = fmaxf(mx, v);
          if (col < 8) pbuf[pp * 8 + col] = v;
        }
      }
    }
    mx = fmaxf(mx, __shfl_xor(mx, 16));
    mx = fmaxf(mx, __shfl_xor(mx, 32));
    const float mxh = __shfl(mx, lane & 7);
    __builtin_amdgcn_wave_barrier();
    float sum = 0.f;
#pragma unroll 4
    for (int k = 0; k < 32; ++k) {
      const int i = lane + 64 * k;
      const float v = pbuf[i];
      const float e = (v > -1e29f) ? __expf(v - mxh) : 0.f;
      pbuf[i] = e;
      sum += e;
    }
    sum += __shfl_xor(sum, 8);
    sum += __shfl_xor(sum, 16);
    sum += __shfl_xor(sum, 32);
    const float inv = 1.f / sum;
    __builtin_amdgcn_wave_barrier();
    float o[8];
#pragma unroll
    for (int h = 0; h < 8; ++h) o[h] = 0.f;
#pragma unroll 4
    for (int pos = 0; pos < nsel; ++pos) {
      const int s = (int)sel[tk * 256 + pos];
      const float v = (float)ub[(size_t)s * NU + C_BV + lane];
      const f32x4 pa = *(const f32x4*)&pbuf[pos * 8];
      const f32x4 pb = *(const f32x4*)&pbuf[pos * 8 + 4];
      o[0] += pa[0] * v; o[1] += pa[1] * v; o[2] += pa[2] * v; o[3] += pa[3] * v;
      o[4] += pb[0] * v; o[5] += pb[1] * v; o[6] += pb[2] * v; o[7] += pb[3] * v;
    }
#pragma unroll
    for (int h = 0; h < 8; ++h) o[h] *= __shfl(inv, h);
    half_t* yrow = p.yb() + (size_t)(b * SEQ + t) * 512;
#pragma unroll
    for (int h = 0; h < 8; ++h) {
      const float z = (float)urow[C_BZ + h * 64 + lane];
      yrow[h * 64 + lane] = (half_t)(o[h] * siluf_(z));
    }
    __builtin_amdgcn_wave_barrier();
  }
  __syncthreads();
}

__device__ void phase2(const Params& p, int l, char* smem) {
  int* s_item = (int*)(smem + SMEM_BYTES - 16);
  const int total = 512 + 32 + 512;
  for (;;) {
    if (threadIdx.x == 0) *s_item = atomicAdd(&p.counters()[l], 1);
    __syncthreads();
    const int it = *s_item;
    __syncthreads();
    if (it >= total) break;
    if (it < 512) dsa_item(p, it, smem);
    else if (it < 544) compress_item(p, l, it - 512, smem);
    else pool_item(p, l, it - 544, smem);
  }
}

struct AttnState {
  float m, l;
  f32x4 o[4];
};

template <bool ONLINE, class VF>
__device__ __forceinline__ void attn_chunk(AttnState& st, const half_t* __restrict__ Kb, int ldk,
                                           const half_t* __restrict__ VT, int ldv, int key0, h8 q0, h8 q1,
                                           VF valid, float fixed_m, float fixed_invl, f32x4* pout) {
  int lane = threadIdx.x & 63;
  asm volatile("" : "+v"(lane));
  const int hq = lane >> 4;
  f32x4 s[2];
#pragma unroll
  for (int i = 0; i < 2; ++i) {
    const half_t* kp = Kb + (size_t)(key0 + 16 * i + (lane & 15)) * ldk + hq * 8;
    const h8 a0 = *(const h8*)kp, a1 = *(const h8*)(kp + 32);
    f32x4 d = {0.f, 0.f, 0.f, 0.f};
    d = __builtin_amdgcn_mfma_f32_16x16x32_f16(a0, q0, d, 0, 0, 0);
    d = __builtin_amdgcn_mfma_f32_16x16x32_f16(a1, q1, d, 0, 0, 0);
    s[i] = d;
  }
  bool vl[2][4];
#pragma unroll
  for (int i = 0; i < 2; ++i)
#pragma unroll
    for (int r = 0; r < 4; ++r) vl[i][r] = valid(key0 + 16 * i + 4 * hq + r);
  float mnew;
  if (ONLINE) {
    float cm = NEGF;
#pragma unroll
    for (int i = 0; i < 2; ++i)
#pragma unroll
      for (int r = 0; r < 4; ++r) cm = fmaxf(cm, vl[i][r] ? s[i][r] : NEGF);
    cm = fmaxf(cm, __shfl_xor(cm, 16));
    cm = fmaxf(cm, __shfl_xor(cm, 32));
    mnew = fmaxf(st.m, cm);
    const float alpha = __expf(st.m - mnew);
    st.m = mnew;
    st.l *= alpha;
#pragma unroll
    for (int dt = 0; dt < 4; ++dt)
#pragma unroll
      for (int r = 0; r < 4; ++r) st.o[dt][r] *= alpha;
  } else {
    mnew = fixed_m;
  }
  float ps = 0.f;
#pragma unroll
  for (int i = 0; i < 2; ++i)
#pragma unroll
    for (int r = 0; r < 4; ++r) {
      float e = vl[i][r] ? __expf(s[i][r] - mnew) : 0.f;
      if (!ONLINE) e *= fixed_invl;
      s[i][r] = e;
      ps += e;
    }
  st.l += ps;
  if (pout) { pout[0] = s[0]; pout[1] = s[1]; }
  if (VT) {
    h8 pf;
#pragma unroll
    for (int r = 0; r < 4; ++r) { pf[r] = (half_t)s[0][r]; pf[4 + r] = (half_t)s[1][r]; }
#pragma unroll
    for (int dt = 0; dt < 4; ++dt) {
      const half_t* vp = VT + (size_t)(16 * dt + (lane & 15)) * ldv + key0 + 4 * hq;
      const h4 lo = *(const h4*)vp, hi = *(const h4*)(vp + 16);
      h8 vf;
#pragma unroll
      for (int r = 0; r < 4; ++r) { vf[r] = lo[r]; vf[4 + r] = hi[r]; }
      st.o[dt] = __builtin_amdgcn_mfma_f32_16x16x32_f16(vf, pf, st.o[dt], 0, 0, 0);
    }
  }
}

__device__ __forceinline__ void st_reset(AttnState& st) {
  st.m = NEGF; st.l = 0.f;
#pragma unroll
  for (int dt = 0; dt < 4; ++dt)
#pragma unroll
    for (int r = 0; r < 4; ++r) st.o[dt][r] = 0.f;
}

__device__ void nsa_unit(const Params& p, int b, int g, int t0, float* wsm) {
  int lane = threadIdx.x & 63;
  asm volatile("" : "+v"(lane));
  const int col = lane & 15, hq = lane >> 4;
  const int j = col >> 2, r4 = col & 3;
  const int tj = t0 + j;
  const int head = g * 4 + r4;
  const half_t* ub = p.u() + (size_t)b * SEQ * NU;
  const half_t* urow = ub + (size_t)tj * NU;
  h8 q0 = *(const h8*)(urow + C_CQ + head * 64 + hq * 8);
  h8 q1 = *(const h8*)(urow + C_CQ + head * 64 + 32 + hq * 8);
#pragma unroll
  for (int e = 0; e < 8; ++e) { q0[e] = q0[e] * (half_t)0.125f; q1[e] = q1[e] * (half_t)0.125f; }
  float gate[3];
#pragma unroll
  for (int i = 0; i < 3; ++i) gate[i] = sigmoidf_((float)urow[C_CG + head * 3 + i]);
  f32x4 res[4];
#pragma unroll
  for (int dt = 0; dt < 4; ++dt)
#pragma unroll
    for (int r = 0; r < 4; ++r) res[dt][r] = 0.f;
  AttnState st;
  float* impA = wsm;
  float* impB = wsm + 512;
  for (int i = lane; i < 512 + 528; i += 64) wsm[i] = 0.f;
  __builtin_amdgcn_wave_barrier();

  const int nmax_u = (t0 + 3 - 31) >> 4;
  const int nmax_j = (tj >= 31) ? ((tj - 31) >> 4) : -1;
  if (nmax_u >= 0) {
    const half_t* Kc = p.kcmp() + (size_t)(b * 2 + g) * 512 * 64;
    const half_t* Vc = p.vcmpT() + (size_t)(b * 2 + g) * 64 * 512;
    st_reset(st);
    auto vfn = [&](int n) { return n <= nmax_j; };
    for (int k0 = 0; k0 <= nmax_u; k0 += 32)
      attn_chunk<true>(st, Kc, 64, (const half_t*)nullptr, 0, k0, q0, q1, vfn, 0.f, 0.f, (f32x4*)nullptr);
    float lt = st.l;
    lt += __shfl_xor(lt, 16);
    lt += __shfl_xor(lt, 32);
    const float mfix = st.m;
    const float invl = lt > 0.f ? 1.f / lt : 0.f;
    st_reset(st);
    for (int k0 = 0; k0 <= nmax_u; k0 += 32) {
      f32x4 pp[2];
      attn_chunk<false>(st, Kc, 64, Vc, 512, k0, q0, q1, vfn, mfix, invl, pp);
#pragma unroll
      for (int i = 0; i < 2; ++i) {
        float a = pp[i][0] + pp[i][1] + pp[i][2] + pp[i][3];
        float bb = pp[i][3];
        a += __shfl_xor(a, 1); a += __shfl_xor(a, 2);
        bb += __shfl_xor(bb, 1); bb += __shfl_xor(bb, 2);
        if (r4 == 0) {
          const int sblk = ((k0 + 16 * i) >> 2) + hq;
          impA[j * 128 + sblk] = a;
          impB[j * 132 + sblk + 1] = bb;
        }
      }
    }
#pragma unroll
    for (int dt = 0; dt < 4; ++dt)
#pragma unroll
      for (int r = 0; r < 4; ++r) res[dt][r] += gate[0] * st.o[dt][r];
  }
  __builtin_amdgcn_wave_barrier();

  unsigned long long mlo[4], mhi[4];
#pragma unroll
  for (int jj = 0; jj < 4; ++jj) {
    const int t = t0 + jj;
    const int blk = t >> 6;
    uint32_t k0, k1;
    {
      const int s0 = lane, s1 = lane + 64;
      const float i0 = impA[jj * 128 + s0] + impB[jj * 132 + s0];
      const float i1 = impA[jj * 128 + s1] + impB[jj * 132 + s1];
      auto mk = [&](float im, int s) -> uint32_t {
        if (s > blk) return 0u;
        uint32_t kk = ((__float_as_uint(im) >> 1) & ~127u) | (uint32_t)(127 - s) | 0x40000000u;
        if (s == 0 || s == blk || s == blk - 1) kk |= 0x80000000u;
        return kk;
      };
      k0 = mk(i0, s0); k1 = mk(i1, s1);
    }
    unsigned long long lo = 0ull, hi = 0ull;
    for (int it = 0; it < 16; ++it) {
      uint32_t mxk = k0 > k1 ? k0 : k1;
#pragma unroll
      for (int o = 32; o > 0; o >>= 1) {
        const uint32_t ov = (uint32_t)__shfl_xor((int)mxk, o);
        mxk = ov > mxk ? ov : mxk;
      }
      mxk = (uint32_t)__builtin_amdgcn_readfirstlane((int)mxk);
      if (mxk == 0u) break;
      const int s = 127 - (int)(mxk & 127u);
      if (s < 64) lo |= 1ull << s; else hi |= 1ull << (s - 64);
      if (s == lane) k0 = 0u;
      if (s == lane + 64) k1 = 0u;
    }
    mlo[jj] = lo; mhi[jj] = hi;
  }
  {
    const unsigned long long mylo = j == 0 ? mlo[0] : (j == 1 ? mlo[1] : (j == 2 ? mlo[2] : mlo[3]));
    const unsigned long long myhi = j == 0 ? mhi[0] : (j == 1 ? mhi[1] : (j == 2 ? mhi[2] : mhi[3]));
    const half_t* Ks = ub + C_CKS + g * 64;
    const half_t* Vs = p.vsT() + (size_t)(b * 2 + g) * 64 * SEQ;
    st_reset(st);
    for (int half = 0; half < 2; ++half) {
      unsigned long long un = half ? (mhi[0] | mhi[1] | mhi[2] | mhi[3]) : (mlo[0] | mlo[1] | mlo[2] | mlo[3]);
      const unsigned long long mym = half ? myhi : mylo;
      while (un) {
        const int bit = (int)__builtin_ctzll(un);
        un &= un - 1ull;
        const bool mine = (mym >> bit) & 1ull;
        const int sblk = half * 64 + bit;
        auto vfn = [&](int key) { return mine && key <= tj; };
        attn_chunk<true>(st, Ks, NU, Vs, SEQ, sblk * 64, q0, q1, vfn, 0.f, 0.f, (f32x4*)nullptr);
        attn_chunk<true>(st, Ks, NU, Vs, SEQ, sblk * 64 + 32, q0, q1, vfn, 0.f, 0.f, (f32x4*)nullptr);
      }
    }
    float lt = st.l;
    lt += __shfl_xor(lt, 16);
    lt += __shfl_xor(lt, 32);
    const float sc = lt > 0.f ? gate[1] / lt : 0.f;
#pragma unroll
    for (int dt = 0; dt < 4; ++dt)
#pragma unroll
      for (int r = 0; r < 4; ++r) res[dt][r] += sc * st.o[dt][r];
  }
  {
    const half_t* Kw = ub + C_CKW + g * 64;
    const half_t* Vw = p.vwT() + (size_t)(b * 2 + g) * 64 * SEQ;
    st_reset(st);
    const int kmin = max(0, t0 - 511) & ~31;
    auto vfn = [&](int key) { return key <= tj && key > tj - 512; };
    for (int k0 = kmin; k0 <= t0 + 3; k0 += 32)
      attn_chunk<true>(st, Kw, NU, Vw, SEQ, k0, q0, q1, vfn, 0.f, 0.f, (f32x4*)nullptr);
    float lt = st.l;
    lt += __shfl_xor(lt, 16);
    lt += __shfl_xor(lt, 32);
    const float sc = lt > 0.f ? gate[2] / lt : 0.f;
#pragma unroll
    for (int dt = 0; dt < 4; ++dt)
#pragma unroll
      for (int r = 0; r < 4; ++r) res[dt][r] += sc * st.o[dt][r];
  }
  half_t* yrow = p.yc() + (size_t)(b * SEQ + tj) * 512 + head * 64;
#pragma unroll
  for (int dt = 0; dt < 4; ++dt) {
    const int d = 16 * dt + 4 * hq;
    const h4 z = *(const h4*)(urow + C_CZ + head * 64 + d);
    h4 ov;
#pragma unroll
    for (int r = 0; r < 4; ++r) ov[r] = (half_t)(res[dt][r] * siluf_((float)z[r]));
    *(h4*)(yrow + d) = ov;
  }
  __builtin_amdgcn_wave_barrier();
}

__device__ void phase_nsa(const Params& p, char* smem) {
  const int wid = threadIdx.x >> 6;
  float* wsm = (float*)smem + wid * 1040;
  for (int it = blockIdx.x; it < 2048; it += gridDim.x) {
    const int b = it & 1, g = (it >> 1) & 1, tile = it >> 2;
    nsa_unit(p, b, g, tile * 16 + wid * 4, wsm);
  }
}

__device__ void phase_merge(const Params& p, char* smem) {
  for (int tile = blockIdx.x; tile < 16 * 128; tile += gridDim.x) {
    const int nt = tile >> 7, mt = tile & 127;
    const int m0 = mt * 128, n0 = nt * 64;
    f32x16 tot[2];
#pragma unroll
    for (int i = 0; i < 2; ++i)
#pragma unroll
      for (int r = 0; r < 16; ++r) tot[i][r] = 0.f;
#pragma unroll
    for (int br = 0; br < 3; ++br) {
      const half_t* A = (br == 0 ? p.ya() : (br == 1 ? p.yb() : p.yc())) + (size_t)m0 * 512;
      const half_t* B = p.wpT() + (size_t)br * DM * 512 + (size_t)n0 * 512;
      gemm_tile<1>(
          512, [&](int r, int k) { return *(const uint4*)(A + (size_t)r * 512 + k); },
          [&](int r, int k) { return *(const uint4*)(B + (size_t)r * 512 + k); },
          [&](int mi, int ni, int r, int row, int col, float v) {
            const float gz = (float)p.u()[(size_t)(m0 + row) * NU + C_GM + br * 1024 + n0 + col];
            tot[mi][r] += sigmoidf_(gz) * v;
          },
          smem);
    }
    int tidx = threadIdx.x;
    asm volatile("" : "+v"(tidx));
    const int lane = tidx & 63, wid = tidx >> 6, wm = wid >> 1, wn = wid & 1;
#pragma unroll
    for (int mi = 0; mi < 2; ++mi)
#pragma unroll
      for (int r = 0; r < 16; ++r) {
        const int row = wm * 64 + mi * 32 + (r & 3) + 8 * (r >> 2) + 4 * (lane >> 5);
        const int col = wn * 32 + (lane & 31);
        p.mm()[(size_t)(m0 + row) * DM + n0 + col] = (half_t)tot[mi][r];
      }
  }
}

__device__ void phase_outproj(const Params& p, char* smem) {
  for (int tile = blockIdx.x; tile < 8 * 128; tile += gridDim.x) {
    const int nt = tile >> 7, mt = tile & 127;
    const int m0 = mt * 128, n0 = nt * 128;
    const half_t* A = p.mm() + (size_t)m0 * DM;
    const half_t* B = p.woT() + (size_t)n0 * DM;
    gemm_tile<2>(
        DM, [&](int r, int k) { return *(const uint4*)(A + (size_t)r * DM + k); },
        [&](int r, int k) { return *(const uint4*)(B + (size_t)r * DM + k); },
        [&](int mi, int ni, int r, int row, int col, float v) {
          float* xp = p.xr() + (size_t)(m0 + row) * DM + n0 + col;
          *xp = ALPHA_F * (*xp) + v;
        },
        smem);
  }
}

__global__ void __launch_bounds__(256, 2) fwd_megakernel(Params p) {
  cg::grid_group grid = cg::this_grid();
  __shared__ __attribute__((aligned(16))) char smem[SMEM_BYTES];
  if (blockIdx.x == 0 && threadIdx.x < DEPTH) p.counters()[threadIdx.x] = 0;
  ln_rows(p, -1, false);
  prep_weights(p, 0, smem);
  grid.sync();
  for (int l = 0; l < DEPTH; ++l) {
    phase_inproj(p, l, smem);
    grid.sync();
    phase2(p, l, smem);
    grid.sync();
    phase_nsa(p, smem);
    grid.sync();
    phase_merge(p, smem);
    grid.sync();
    phase_outproj(p, smem);
    grid.sync();
    if (l + 1 < DEPTH) {
      ln_rows(p, l, false);
      prep_weights(p, l + 1, smem);
      grid.sync();
    } else {
      ln_rows(p, l, true);
    }
  }
}

extern "C" void kernel_launch(void* const* d_in, const int* in_sizes, int n_in, void* d_out, int out_size,
                              void* d_ws, size_t ws_size, hipStream_t stream) {
  static int grid_blocks = 0;
  if (!grid_blocks) {
    int dev = 0, cus = 0, per_cu = 0;
    (void)hipGetDevice(&dev);
    (void)hipDeviceGetAttribute(&cus, hipDeviceAttributeMultiprocessorCount, dev);
    (void)hipOccupancyMaxActiveBlocksPerMultiprocessor(&per_cu, fwd_megakernel, 256, 0);
    if (per_cu > 2) per_cu = 2;
    if (per_cu < 1) per_cu = 1;
    grid_blocks = cus * per_cu;
  }
  Params p{};
  p.x = (const float*)d_in[0]; p.w_in = (const float*)d_in[1]; p.b_in = (const float*)d_in[2];
  p.pool_w = (const float*)d_in[3]; p.pool_b = (const float*)d_in[4]; p.pool_scale = (const float*)d_in[5];
  p.pos_k = (const float*)d_in[6]; p.pos_v = (const float*)d_in[7]; p.w1k = (const float*)d_in[8];
  p.w2k = (const float*)d_in[9]; p.w1v = (const float*)d_in[10]; p.w2v = (const float*)d_in[11];
  p.wpa = (const float*)d_in[12]; p.wpb = (const float*)d_in[13]; p.wpc = (const float*)d_in[14];
  p.wo = (const float*)d_in[15]; p.ln_g = (const float*)d_in[16]; p.ln_b = (const float*)d_in[17];
  p.out = (float*)d_out;
  p.ws = (char*)d_ws;
  if (WS_TOTAL > ws_size) { fprintf(stderr, "workspace too small: need %zu have %zu\n", (size_t)WS_TOTAL, ws_size); return; }
  void* args[] = {&p};
  hipError_t e = hipLaunchCooperativeKernel((void*)fwd_megakernel, dim3(grid_blocks), dim3(256), args, 0, stream);
  if (e != hipSuccess) fprintf(stderr, "cooperative launch failed: %s (grid %d)\n", hipGetErrorString(e), grid_blocks);
}
```

```cpp
#include <hip/hip_runtime.h>
#include <hip/hip_cooperative_groups.h>
#include <cstdio>
#include <cstdint>
namespace cg = cooperative_groups;

typedef _Float16 half_t;
typedef _Float16 h8 __attribute__((ext_vector_type(8)));
typedef _Float16 h4 __attribute__((ext_vector_type(4)));
typedef float f32x4 __attribute__((ext_vector_type(4)));
typedef float f32x16 __attribute__((ext_vector_type(16)));

#define SEQ 8192
#define DM 1024
#define NTOK 16384
#define DEPTH 4
#define NIN 7360
#define NU 7424
#define ALPHA_F 1.681792830507429f
#define NEGF (-1e30f)

#define C_AX 0
#define C_AZ 512
#define C_BQ 1024
#define C_BZ 1536
#define C_CQ 2048
#define C_CZ 2560
#define C_GM 3072
#define C_IQ 6144
#define C_CKC 6400
#define C_CVC 6528
#define C_CKS 6656
#define C_CVS 6784
#define C_CKW 6912
#define C_CVW 7040
#define C_BK 7168
#define C_BV 7232
#define C_IK 7296
#define C_IW 7328
#define C_CG 7336

#define SMEM_BYTES 69632

constexpr size_t OFF_xr = 0;
constexpr size_t OFF_xh = OFF_xr + (((size_t)NTOK*DM*4 + 255) & ~(size_t)255);
constexpr size_t OFF_u = OFF_xh + (((size_t)NTOK*DM*2 + 255) & ~(size_t)255);
constexpr size_t OFF_winT = OFF_u + (((size_t)NTOK*NU*2 + 255) & ~(size_t)255);
constexpr size_t OFF_wpT = OFF_winT + (((size_t)NU*DM*2 + 255) & ~(size_t)255);
constexpr size_t OFF_woT = OFF_wpT + (((size_t)3*DM*512*2 + 255) & ~(size_t)255);
constexpr size_t OFF_poolT = OFF_woT + (((size_t)DM*DM*2 + 255) & ~(size_t)255);
constexpr size_t OFF_w1T = OFF_poolT + (((size_t)4*128*128*2 + 255) & ~(size_t)255);
constexpr size_t OFF_posb = OFF_w1T + (((size_t)2*64*2048*2 + 255) & ~(size_t)255);
constexpr size_t OFF_vsT = OFF_posb + (((size_t)512 + 255) & ~(size_t)255);
constexpr size_t OFF_vwT = OFF_vsT + (((size_t)4*64*SEQ*2 + 255) & ~(size_t)255);
constexpr size_t OFF_kcmp = OFF_vwT + (((size_t)4*64*SEQ*2 + 255) & ~(size_t)255);
constexpr size_t OFF_vcmpT = OFF_kcmp + (((size_t)4*512*64*2 + 255) & ~(size_t)255);
constexpr size_t OFF_ya = OFF_vcmpT + (((size_t)4*64*512*2 + 255) & ~(size_t)255);
constexpr size_t OFF_yb = OFF_ya + (((size_t)NTOK*512*2 + 255) & ~(size_t)255);
constexpr size_t OFF_yc = OFF_yb + (((size_t)NTOK*512*2 + 255) & ~(size_t)255);
constexpr size_t OFF_mm = OFF_yc + (((size_t)NTOK*512*2 + 255) & ~(size_t)255);
constexpr size_t OFF_counters = OFF_mm + (((size_t)NTOK*DM*2 + 255) & ~(size_t)255);
constexpr size_t WS_TOTAL = OFF_counters + (((size_t)32768 + 255) & ~(size_t)255);
struct Params {
  const float* x; const float* w_in; const float* b_in; const float* pool_w; const float* pool_b;
  const float* pool_scale; const float* pos_k; const float* pos_v; const float* w1k; const float* w2k;
  const float* w1v; const float* w2v; const float* wpa; const float* wpb; const float* wpc;
  const float* wo; const float* ln_g; const float* ln_b;
  float* out;
  char* ws;
};
typedef const __attribute__((address_space(4))) unsigned long long* kargp_t;
struct KP {
  kargp_t kp;
  __device__ __forceinline__ const float* x() const { return (const float*)kp[0]; }
  __device__ __forceinline__ const float* w_in() const { return (const float*)kp[1]; }
  __device__ __forceinline__ const float* b_in() const { return (const float*)kp[2]; }
  __device__ __forceinline__ const float* pool_w() const { return (const float*)kp[3]; }
  __device__ __forceinline__ const float* pool_b() const { return (const float*)kp[4]; }
  __device__ __forceinline__ const float* pool_scale() const { return (const float*)kp[5]; }
  __device__ __forceinline__ const float* pos_k() const { return (const float*)kp[6]; }
  __device__ __forceinline__ const float* pos_v() const { return (const float*)kp[7]; }
  __device__ __forceinline__ const float* w1k() const { return (const float*)kp[8]; }
  __device__ __forceinline__ const float* w2k() const { return (const float*)kp[9]; }
  __device__ __forceinline__ const float* w1v() const { return (const float*)kp[10]; }
  __device__ __forceinline__ const float* w2v() const { return (const float*)kp[11]; }
  __device__ __forceinline__ const float* wpa() const { return (const float*)kp[12]; }
  __device__ __forceinline__ const float* wpb() const { return (const float*)kp[13]; }
  __device__ __forceinline__ const float* wpc() const { return (const float*)kp[14]; }
  __device__ __forceinline__ const float* wo() const { return (const float*)kp[15]; }
  __device__ __forceinline__ const float* ln_g() const { return (const float*)kp[16]; }
  __device__ __forceinline__ const float* ln_b() const { return (const float*)kp[17]; }
  __device__ __forceinline__ float* out() const { return (float*)kp[18]; }
  __device__ __forceinline__ char* ws() const { return (char*)kp[19]; }
  __device__ __forceinline__ float* xr() const { return (float*)(ws() + OFF_xr); }
  __device__ __forceinline__ half_t* xh() const { return (half_t*)(ws() + OFF_xh); }
  __device__ __forceinline__ half_t* u() const { return (half_t*)(ws() + OFF_u); }
  __device__ __forceinline__ half_t* winT() const { return (half_t*)(ws() + OFF_winT); }
  __device__ __forceinline__ half_t* wpT() const { return (half_t*)(ws() + OFF_wpT); }
  __device__ __forceinline__ half_t* woT() const { return (half_t*)(ws() + OFF_woT); }
  __device__ __forceinline__ half_t* poolT() const { return (half_t*)(ws() + OFF_poolT); }
  __device__ __forceinline__ half_t* w1T() const { return (half_t*)(ws() + OFF_w1T); }
  __device__ __forceinline__ float* posb() const { return (float*)(ws() + OFF_posb); }
  __device__ __forceinline__ half_t* vsT() const { return (half_t*)(ws() + OFF_vsT); }
  __device__ __forceinline__ half_t* vwT() const { return (half_t*)(ws() + OFF_vwT); }
  __device__ __forceinline__ half_t* kcmp() const { return (half_t*)(ws() + OFF_kcmp); }
  __device__ __forceinline__ half_t* vcmpT() const { return (half_t*)(ws() + OFF_vcmpT); }
  __device__ __forceinline__ half_t* ya() const { return (half_t*)(ws() + OFF_ya); }
  __device__ __forceinline__ half_t* yb() const { return (half_t*)(ws() + OFF_yb); }
  __device__ __forceinline__ half_t* yc() const { return (half_t*)(ws() + OFF_yc); }
  __device__ __forceinline__ half_t* mm() const { return (half_t*)(ws() + OFF_mm); }
  __device__ __forceinline__ int* counters() const { return (int*)(ws() + OFF_counters); }
};
__device__ __forceinline__ KP get_params() {
  KP q;
  q.kp = (kargp_t)__builtin_amdgcn_kernarg_segment_ptr();
  asm volatile("" : "+s"(q.kp));
  return q;
}


__device__ __forceinline__ int orig_col(int n) {
  if (n < 1536) return n;
  if (n < 2048) return 1664 + (n - 1536);
  if (n < 2560) return 2472 + (n - 2048);
  if (n < 3072) return 3776 + (n - 2560);
  if (n < 6144) return 4288 + (n - 3072);
  if (n < 6400) return 2176 + (n - 6144);
  if (n < 7168) return 2984 + (n - 6400);
  if (n < 7296) return 1536 + (n - 7168);
  if (n < 7328) return 2432 + (n - 7296);
  if (n < 7336) return 2464 + (n - 7328);
  if (n < 7360) return 3752 + (n - 7336);
  return -1;
}

__device__ __forceinline__ float wave_sum(float v) {
#pragma unroll
  for (int o = 32; o > 0; o >>= 1) v += __shfl_xor(v, o);
  return v;
}
__device__ __forceinline__ float sigmoidf_(float x) { return 1.f / (1.f + __expf(-x)); }
__device__ __forceinline__ float siluf_(float x) { return x / (1.f + __expf(-x)); }

template <int NI, class LA, class LB, class EP>
__device__ __forceinline__ void gemm_tile(int K, LA loadA, LB loadB, EP epi, char* smem) {
  constexpr int BN = NI * 64;
  constexpr int NB = BN / 32;
  half_t* sA = (half_t*)smem;
  half_t* sB = sA + 128 * 72;
  int tid = threadIdx.x;
  asm volatile("" : "+v"(tid));
  const int lane = tid & 63, wid = tid >> 6;
  const int wm = wid >> 1, wn = wid & 1;
  f32x16 acc[2][NI];
#pragma unroll
  for (int i = 0; i < 2; ++i)
#pragma unroll
    for (int j = 0; j < NI; ++j)
#pragma unroll
      for (int r = 0; r < 16; ++r) acc[i][j][r] = 0.f;
  const int lr = tid >> 3, lc = (tid & 7) * 8;
  uint4 ra[4], rb[NB];
#pragma unroll
  for (int i = 0; i < 4; ++i) ra[i] = loadA(lr + 32 * i, lc);
#pragma unroll
  for (int i = 0; i < NB; ++i) rb[i] = loadB(lr + 32 * i, lc);
  const int nk = K >> 6;
  for (int kt = 0; kt < nk; ++kt) {
    __syncthreads();
#pragma unroll
    for (int i = 0; i < 4; ++i) *(uint4*)&sA[(lr + 32 * i) * 72 + lc] = ra[i];
#pragma unroll
    for (int i = 0; i < NB; ++i) *(uint4*)&sB[(lr + 32 * i) * 72 + lc] = rb[i];
    __syncthreads();
    if (kt + 1 < nk) {
      const int kk = (kt + 1) * 64 + lc;
#pragma unroll
      for (int i = 0; i < 4; ++i) ra[i] = loadA(lr + 32 * i, kk);
#pragma unroll
      for (int i = 0; i < NB; ++i) rb[i] = loadB(lr + 32 * i, kk);
    }
#pragma unroll
    for (int s = 0; s < 4; ++s) {
      h8 af[2], bf[NI];
#pragma unroll
      for (int mi = 0; mi < 2; ++mi)
        af[mi] = *(const h8*)&sA[(wm * 64 + mi * 32 + (lane & 31)) * 72 + s * 16 + (lane >> 5) * 8];
#pragma unroll
      for (int ni = 0; ni < NI; ++ni)
        bf[ni] = *(const h8*)&sB[(wn * (NI * 32) + ni * 32 + (lane & 31)) * 72 + s * 16 + (lane >> 5) * 8];
#pragma unroll
      for (int mi = 0; mi < 2; ++mi)
#pragma unroll
        for (int ni = 0; ni < NI; ++ni)
          acc[mi][ni] = __builtin_amdgcn_mfma_f32_32x32x16_f16(af[mi], bf[ni], acc[mi][ni], 0, 0, 0);
    }
  }
#pragma unroll
  for (int mi = 0; mi < 2; ++mi)
#pragma unroll
    for (int ni = 0; ni < NI; ++ni)
#pragma unroll
      for (int r = 0; r < 16; ++r) {
        const int row = wm * 64 + mi * 32 + (r & 3) + 8 * (r >> 2) + 4 * (lane >> 5);
        const int col = wn * (NI * 32) + ni * 32 + (lane & 31);
        epi(mi, ni, r, row, col, acc[mi][ni][r]);
      }
}

template <class CM>
__device__ __forceinline__ void tconv_tile(const float* __restrict__ src, int lds_, half_t* __restrict__ dst, int ldd,
                                           int n0, int k0, CM cmap, char* smem) {
  float* t = (float*)smem;
  int tid = threadIdx.x;
  asm volatile("" : "+v"(tid));
  {
    const int n = tid & 63;
    const int c = cmap(n0 + n);
#pragma unroll 4
    for (int i = 0; i < 16; ++i) {
      const int k = (tid >> 6) + 4 * i;
      t[k * 65 + n] = (c >= 0) ? src[(size_t)(k0 + k) * lds_ + c] : 0.f;
    }
  }
  __syncthreads();
#pragma unroll
  for (int i = 0; i < 2; ++i) {
    const int idx = tid + 256 * i;
    const int n = idx >> 3, kc = (idx & 7) * 8;
    h8 v;
#pragma unroll
    for (int j = 0; j < 8; ++j) v[j] = (half_t)t[(kc + j) * 65 + n];
    *(h8*)&dst[(size_t)(n0 + n) * ldd + k0 + kc] = v;
  }
  __syncthreads();
}

__device__ void ln_rows(const KP& p, int lprev, bool final_) {
  int tid = threadIdx.x;
  asm volatile("" : "+v"(tid));
  const int lane = tid & 63, wid = tid >> 6;
  const int gw = blockIdx.x * 4 + wid, nw = gridDim.x * 4;
  for (int row = gw; row < NTOK; row += nw) {
    const float4* rp = (const float4*)((lprev < 0 ? p.x() : (const float*)p.u()) + (size_t)row * DM);
    float4 v[4];
    float s = 0.f;
#pragma unroll
    for (int i = 0; i < 4; ++i) {
      v[i] = rp[lane + 64 * i];
      s += v[i].x + v[i].y + v[i].z + v[i].w;
    }
    if (lprev >= 0) {
      float mu = wave_sum(s) * (1.f / DM);
      float q = 0.f;
#pragma unroll
      for (int i = 0; i < 4; ++i) {
        float a = v[i].x - mu, b = v[i].y - mu, c = v[i].z - mu, d = v[i].w - mu;
        q += a * a + b * b + c * c + d * d;
      }
      float rstd = rsqrtf(wave_sum(q) * (1.f / DM) + 1e-5f);
      const float4* g4 = (const float4*)(p.ln_g() + lprev * DM);
      const float4* b4 = (const float4*)(p.ln_b() + lprev * DM);
#pragma unroll
      for (int i = 0; i < 4; ++i) {
        float4 g = g4[lane + 64 * i], bb = b4[lane + 64 * i];
        v[i].x = (v[i].x - mu) * rstd * g.x + bb.x;
        v[i].y = (v[i].y - mu) * rstd * g.y + bb.y;
        v[i].z = (v[i].z - mu) * rstd * g.z + bb.z;
        v[i].w = (v[i].w - mu) * rstd * g.w + bb.w;
      }
    }
    if (final_) {
      float4* op = (float4*)(p.out() + (size_t)row * DM);
#pragma unroll
      for (int i = 0; i < 4; ++i) op[lane + 64 * i] = v[i];
    } else {
      float4* op = (float4*)(p.xr() + (size_t)row * DM);
      h4* hp = (h4*)(p.xh() + (size_t)row * DM);
#pragma unroll
      for (int i = 0; i < 4; ++i) {
        op[lane + 64 * i] = v[i];
        h4 hv;
        hv[0] = (half_t)v[i].x; hv[1] = (half_t)v[i].y; hv[2] = (half_t)v[i].z; hv[3] = (half_t)v[i].w;
        hp[lane + 64 * i] = hv;
      }
    }
  }
}

__device__ void prep_weights(const KP& p, int l, char* smem) {
  int tid = threadIdx.x;
  asm volatile("" : "+v"(tid));
  const int total = 1856 + 384 + 256 + 16 + 64 + 2;
  for (int it = blockIdx.x; it < total; it += gridDim.x) {
    if (it < 1856) {
      const int nt = it >> 4, kt = it & 15;
      tconv_tile(p.w_in() + (size_t)l * DM * NIN, NIN, p.winT(), DM, nt * 64, kt * 64,
                 [](int n) { return orig_col(n); }, smem);
    } else if (it < 1856 + 384) {
      const int j = it - 1856;
      const int w = j >> 7, r = j & 127, nt = r >> 3, kt = r & 7;
      const float* src = (w == 0 ? p.wpa() : (w == 1 ? p.wpb() : p.wpc())) + (size_t)l * 512 * DM;
      tconv_tile(src, DM, p.wpT() + (size_t)w * DM * 512, 512, nt * 64, kt * 64, [](int n) { return n; }, smem);
    } else if (it < 1856 + 384 + 256) {
      const int j = it - 1856 - 384;
      const int nt = j >> 4, kt = j & 15;
      tconv_tile(p.wo() + (size_t)l * DM * DM, DM, p.woT(), DM, nt * 64, kt * 64, [](int n) { return n; }, smem);
    } else if (it < 1856 + 384 + 256 + 16) {
      const int j = it - 1856 - 384 - 256;
      const int g = j >> 2, nt = (j >> 1) & 1, kt = j & 1;
      tconv_tile(p.pool_w() + ((size_t)l * 4 + g) * 128 * 128, 128, p.poolT() + (size_t)g * 128 * 128, 128, nt * 64,
                 kt * 64, [](int n) { return n; }, smem);
    } else if (it < 1856 + 384 + 256 + 16 + 64) {
      const int j = it - 1856 - 384 - 256 - 16;
      const int kv = j >> 5, kt = j & 31;
      const float* src = (kv ? p.w1v() : p.w1k()) + (size_t)l * 2048 * 64;
      tconv_tile(src, 64, p.w1T() + (size_t)kv * 64 * 2048, 2048, 0, kt * 64, [](int n) { return n; }, smem);
    } else {
      const int kv = it - (1856 + 384 + 256 + 16 + 64);
      const float* w1 = (kv ? p.w1v() : p.w1k()) + (size_t)l * 2048 * 64;
      const float* pos = (kv ? p.pos_v() : p.pos_k()) + (size_t)l * 2048;
      float* red = (float*)smem;
      const int e = tid & 63, part = tid >> 6;
      float sa = 0.f, sb = 0.f, sc_ = 0.f, sd = 0.f;
      const float* wq = w1 + (size_t)part * 512 * 64 + e;
      const float* pq = pos + part * 512;
#pragma unroll 4
      for (int f = 0; f < 512; f += 4) {
        sa += pq[f] * wq[(size_t)f * 64];
        sb += pq[f + 1] * wq[(size_t)(f + 1) * 64];
        sc_ += pq[f + 2] * wq[(size_t)(f + 2) * 64];
        sd += pq[f + 3] * wq[(size_t)(f + 3) * 64];
      }
      const float s = (sa + sb) + (sc_ + sd);
      red[tid] = s;
      __syncthreads();
      if (tid < 64) p.posb()[kv * 64 + tid] = red[tid] + red[tid + 64] + red[tid + 128] + red[tid + 192];
      __syncthreads();
    }
  }
}

__device__ void phase_inproj(const KP& p, int l, char* smem) {
  const float* bias = p.b_in() + (size_t)l * NIN;
  for (int tile = blockIdx.x; tile < 58 * 128; tile += gridDim.x) {
    const int nt = tile >> 7, mt = tile & 127;
    const int m0 = mt * 128, n0 = nt * 128;
    const half_t* A = p.xh() + (size_t)m0 * DM;
    const half_t* B = p.winT() + (size_t)n0 * DM;
    int tidx = threadIdx.x;
    asm volatile("" : "+v"(tidx));
    const int lane = tidx & 63, wn = (tidx >> 6) & 1;
    float bv[2];
#pragma unroll
    for (int ni = 0; ni < 2; ++ni) {
      const int oc = orig_col(n0 + wn * 64 + ni * 32 + (lane & 31));
      bv[ni] = oc >= 0 ? bias[oc] : 0.f;
    }
    half_t* vT = (nt == 53) ? p.vsT() : ((nt == 55) ? p.vwT() : nullptr);
    gemm_tile<2>(
        DM, [&](int r, int k) { return *(const uint4*)(A + (size_t)r * DM + k); },
        [&](int r, int k) { return *(const uint4*)(B + (size_t)r * DM + k); },
        [&](int mi, int ni, int r, int row, int col, float v) {
          const half_t hv = (half_t)(v + bv[ni]);
          const int tok = m0 + row;
          p.u()[(size_t)tok * NU + n0 + col] = hv;
          if (vT) {
            const int b = tok >> 13, t = tok & 8191;
            vT[((size_t)(b * 2 + (col >> 6)) * 64 + (col & 63)) * SEQ + t] = hv;
          }
        },
        smem);
  }
}

__device__ void pool_item(const KP& p, int l, int item, char* smem) {
  const int g = item & 3, mt = item >> 2;
  const int m0 = mt * 128;
  const int wnd = 2 << g;
  const half_t* B = p.poolT() + (size_t)g * 128 * 128;
  int tidx = threadIdx.x;
  asm volatile("" : "+v"(tidx));
  const int lane = tidx & 63, wn = (tidx >> 6) & 1;
  float pb[2], ps[2];
#pragma unroll
  for (int ni = 0; ni < 2; ++ni) {
    const int d = wn * 64 + ni * 32 + (lane & 31);
    pb[ni] = p.pool_b()[(size_t)l * 512 + g * 128 + d];
    ps[ni] = p.pool_scale()[(size_t)l * 512 + g * 128 + d];
  }
  gemm_tile<2>(
      128,
      [&](int r, int k) {
        const int tok = m0 + r, t = tok & 8191;
        const int cnt = min(t + 1, wnd);
        const half_t* base = p.u() + (size_t)tok * NU + C_AX + g * 128 + k;
        float s[8];
#pragma unroll
        for (int j = 0; j < 8; ++j) s[j] = 0.f;
        h8 cur = *(const h8*)base;
        for (int q = 0; q < cnt; ++q) {
          h8 v = *(const h8*)(base - (size_t)q * NU);
#pragma unroll
          for (int j = 0; j < 8; ++j) s[j] += (float)v[j];
        }
        const float inv = 1.f / (float)cnt;
        h8 o;
#pragma unroll
        for (int j = 0; j < 8; ++j) o[j] = (half_t)(s[j] * inv - (float)cur[j]);
        return *(uint4*)&o;
      },
      [&](int r, int k) { return *(const uint4*)(B + (size_t)r * 128 + k); },
      [&](int mi, int ni, int r, int row, int col, float v) {
        const int tok = m0 + row;
        const float z = (float)p.u()[(size_t)tok * NU + C_AZ + g * 128 + col];
        p.ya()[(size_t)tok * 512 + g * 128 + col] = (half_t)((v + pb[ni]) * ps[ni] * siluf_(z));
      },
      smem);
}

__device__ void compress_item(const KP& p, int l, int item, char* smem) {
  const int mt = item & 3, kv = (item >> 2) & 1, g = (item >> 3) & 1, b = item >> 4;
  int tid = threadIdx.x;
  asm volatile("" : "+v"(tid));
  const int ccol = (kv ? C_CVC : C_CKC) + g * 64;
  const half_t* ub = p.u() + (size_t)b * SEQ * NU + ccol;
  const half_t* B = p.w1T() + (size_t)kv * 64 * 2048;
  float* hid = (float*)(smem + 28672);
  const float* posb = p.posb() + kv * 64;
  gemm_tile<1>(
      2048,
      [&](int r, int k) {
        const int n = mt * 128 + r;
        if (n >= 511) return make_uint4(0, 0, 0, 0);
        const int tok = 16 * n + (k >> 6);
        return *(const uint4*)(ub + (size_t)tok * NU + (k & 63));
      },
      [&](int r, int k) { return *(const uint4*)(B + (size_t)r * 2048 + k); },
      [&](int mi, int ni, int r, int row, int col, float v) { hid[row * 65 + col] = siluf_(v + posb[col]); }, smem);
  __syncthreads();
  float* w2s = (float*)smem;
  const float* w2 = (kv ? p.w2v() : p.w2k()) + (size_t)l * 4096;
  for (int i = tid; i < 4096; i += 256) w2s[i] = w2[i];
  __syncthreads();
  {
    const int n = tid >> 1, fh = (tid & 1) * 32;
    float acc[32];
#pragma unroll
    for (int f = 0; f < 32; ++f) acc[f] = 0.f;
    for (int e = 0; e < 64; ++e) {
      const float hv = hid[n * 65 + e];
#pragma unroll
      for (int f = 0; f < 32; ++f) acc[f] += hv * w2s[e * 64 + fh + f];
    }
    const int ng = mt * 128 + n;
    const bool valid = ng < 511;
    if (kv == 0) {
      half_t* dst = p.kcmp() + ((size_t)(b * 2 + g) * 512 + ng) * 64 + fh;
#pragma unroll
      for (int f = 0; f < 32; ++f) dst[f] = valid ? (half_t)acc[f] : (half_t)0.f;
    } else {
      half_t* dst = p.vcmpT() + ((size_t)(b * 2 + g) * 64 + fh) * 512 + ng;
#pragma unroll
      for (int f = 0; f < 32; ++f) dst[(size_t)f * 512] = valid ? (half_t)acc[f] : (half_t)0.f;
    }
  }
  __syncthreads();
}

__device__ void dsa_item(const KP& p, int item, char* smem) {
  const int b = item & 1, tile = 255 - (item >> 1);
  const int t0 = tile * 32;
  int tid = threadIdx.x;
  asm volatile("" : "+v"(tid));
  const int lane = tid & 63, wid = tid >> 6;
  uint32_t* hist = (uint32_t*)smem;
  half_t* iqs = (half_t*)(smem + 32768);
  unsigned short* sel = (unsigned short*)(smem + 49664);
  unsigned long long* pfx = (unsigned long long*)(smem + 66048);
  unsigned long long* tkey = pfx + 32;
  int* need = (int*)(tkey + 32);
  int* done = need + 32;
  int* cnt = done + 32;
  int* nrem = cnt + 32;
  float* pbuf = (float*)smem + wid * 2048;

  const half_t* ub = p.u() + (size_t)b * SEQ * NU;
  for (int i = tid; i < 32 * 32; i += 256) {
    const int tk = i >> 5, c = (i & 31) * 8;
    *(uint4*)&iqs[tk * 264 + c] = *(const uint4*)(ub + (size_t)(t0 + tk) * NU + C_IQ + c);
  }
  if (tid < 32) {
    const int t = t0 + tid;
    pfx[tid] = 0ull; tkey[tid] = 0ull; need[tid] = 256; done[tid] = (t < 256) ? 1 : 0; cnt[tid] = 0;
  }
  if (tid < 8) nrem[tid] = 0;
  float iw[8];
  {
    const half_t* wp = ub + (size_t)(t0 + (lane & 31)) * NU + C_IW;
    h8 w8 = *(const h8*)wp;
#pragma unroll
    for (int h = 0; h < 8; ++h) iw[h] = (float)w8[h] * 0.0625f;
  }
  __syncthreads();
  const int nkt = tile + 1;
  const int mytok = lane & 31;
  const int myt = t0 + mytok;

  auto loadk = [&](int kt, h8& a0, h8& a1) {
    const half_t* kp = ub + (size_t)(kt * 32 + (lane & 31)) * NU + C_IK + (lane >> 5) * 8;
    a0 = *(const h8*)kp; a1 = *(const h8*)(kp + 16);
  };
  auto scores = [&](const h8 a0, const h8 a1, float* sc) {
#pragma unroll
    for (int r = 0; r < 16; ++r) sc[r] = 0.f;
    int qoff = mytok * 264 + (lane >> 5) * 8;
    asm volatile("" : "+v"(qoff));
#pragma unroll
    for (int h = 0; h < 8; ++h) {
      const h8 b0 = *(const h8*)&iqs[qoff + h * 32];
      const h8 b1 = *(const h8*)&iqs[qoff + h * 32 + 16];
      f32x16 d;
#pragma unroll
      for (int r = 0; r < 16; ++r) d[r] = 0.f;
      d = __builtin_amdgcn_mfma_f32_32x32x16_f16(a0, b0, d, 0, 0, 0);
      d = __builtin_amdgcn_mfma_f32_32x32x16_f16(a1, b1, d, 0, 0, 0);
#pragma unroll
      for (int r = 0; r < 16; ++r) sc[r] += fmaxf(d[r], 0.f) * iw[h];
    }
  };
  auto mkkey = [&](float s, int key) -> unsigned long long {
    s = s + 0.f;
    uint32_t ub_ = __float_as_uint(s);
    ub_ = (ub_ & 0x80000000u) ? ~ub_ : (ub_ | 0x80000000u);
    return ((unsigned long long)ub_ << 16) | ((unsigned long long)(8191 - key) << 3);
  };

  for (int level = 0; level < 6; ++level) {
    const int shift = 40 - 8 * level;
    for (int i = tid; i < 8192; i += 256) hist[i] = 0u;
    __syncthreads();
    {
      const unsigned long long mypfx = pfx[mytok];
      const bool mydone = done[mytok] != 0;
      h8 na0, na1;
      if (wid < nkt) loadk(wid, na0, na1);
      for (int kt = wid; kt < nkt; kt += 4) {
        float sc[16];
        const h8 ca0 = na0, ca1 = na1;
        if (kt + 4 < nkt) loadk(kt + 4, na0, na1);
        scores(ca0, ca1, sc);
        if (!mydone) {
#pragma unroll
          for (int r = 0; r < 16; ++r) {
            const int key = kt * 32 + (r & 3) + 8 * (r >> 2) + 4 * (lane >> 5);
            if (key <= myt) {
              const unsigned long long k48 = mkkey(sc[r], key);
              if (level == 0 || (k48 >> (shift + 8)) == mypfx)
                atomicAdd(&hist[mytok * 256 + (int)((k48 >> shift) & 255ull)], 1u);
            }
          }
        }
      }
    }
    __syncthreads();
    {
      int rem = 0;
      for (int j = 0; j < 8; ++j) {
        const int tk = wid * 8 + j;
        if (done[tk]) continue;
        const uint32_t* hrow = hist + tk * 256;
        const uint4 hv = *(const uint4*)&hrow[252 - 4 * lane];
        const int c = (int)(hv.x + hv.y + hv.z + hv.w);
        int cum = c;
#pragma unroll
        for (int o = 1; o < 64; o <<= 1) {
          int v = __shfl_up(cum, o);
          if (lane >= o) cum += v;
        }
        const int nd = need[tk];
        const unsigned long long mask = __ballot(cum >= nd);
        const int L = (int)__builtin_ctzll(mask);
        int running = cum - c, bstar, cb;
        if (running + (int)hv.w >= nd) { bstar = 255 - 4 * lane; cb = hv.w; }
        else {
          running += hv.w;
          if (running + (int)hv.z >= nd) { bstar = 254 - 4 * lane; cb = hv.z; }
          else {
            running += hv.z;
            if (running + (int)hv.y >= nd) { bstar = 253 - 4 * lane; cb = hv.y; }
            else { running += hv.y; bstar = 252 - 4 * lane; cb = hv.x; }
          }
        }
        running = __shfl(running, L); bstar = __shfl(bstar, L); cb = __shfl(cb, L);
        const int nd2 = nd - running;
        if (lane == 0) {
          const unsigned long long np = (pfx[tk] << 8) | (unsigned long long)bstar;
          if (cb == nd2 || level == 5) { done[tk] = 1; tkey[tk] = np << shift; }
          else { need[tk] = nd2; pfx[tk] = np; }
        }
        if (!(cb == nd2 || level == 5)) rem++;
      }
      if (lane == 0 && rem) atomicAdd(&nrem[level], rem);
    }
    __syncthreads();
    if (nrem[level] == 0) break;
  }
  {
    const unsigned long long mytk = tkey[mytok];
    h8 na0, na1;
    if (wid < nkt) loadk(wid, na0, na1);
    for (int kt = wid; kt < nkt; kt += 4) {
      float sc[16];
      const h8 ca0 = na0, ca1 = na1;
      if (kt + 4 < nkt) loadk(kt + 4, na0, na1);
      scores(ca0, ca1, sc);
#pragma unroll
      for (int r = 0; r < 16; ++r) {
        const int key = kt * 32 + (r & 3) + 8 * (r >> 2) + 4 * (lane >> 5);
        if (key <= myt) {
          const unsigned long long k48 = mkkey(sc[r], key);
          if (k48 >= mytk) {
            const int pos = atomicAdd(&cnt[mytok], 1);
            if (pos < 256) sel[mytok * 256 + pos] = (unsigned short)key;
          }
        }
      }
    }
  }
  __syncthreads();
  for (int j = 0; j < 8; ++j) {
    const int tk = wid * 8 + j;
    const int t = t0 + tk;
    const int nsel = min(cnt[tk], 256);
    const half_t* urow = ub + (size_t)t * NU;
    const int col = lane & 15, hq = lane >> 4;
    h8 q0, q1;
#pragma unroll
    for (int e = 0; e < 8; ++e) { q0[e] = (half_t)0.f; q1[e] = (half_t)0.f; }
    if (col < 8) {
      q0 = *(const h8*)(urow + C_BQ + col * 64 + hq * 8);
      q1 = *(const h8*)(urow + C_BQ + col * 64 + 32 + hq * 8);
    }
    float mx = NEGF;
#pragma unroll 1
    for (int mg = 0; mg < 4; ++mg) {
#pragma unroll
      for (int mm = 0; mm < 4; ++mm) {
        const int m = mg * 4 + mm;
        const int pos = m * 16 + col;
        const int s = (pos < nsel) ? (int)sel[tk * 256 + pos] : 0;
        const half_t* kp = ub + (size_t)s * NU + C_BK + hq * 8;
        const h8 a0 = *(const h8*)kp, a1 = *(const h8*)(kp + 32);
        f32x4 d = {0.f, 0.f, 0.f, 0.f};
        d = __builtin_amdgcn_mfma_f32_16x16x32_f16(a0, q0, d, 0, 0, 0);
        d = __builtin_amdgcn_mfma_f32_16x16x32_f16(a1, q1, d, 0, 0, 0);
#pragma unroll
        for (int r = 0; r < 4; ++r) {
          const int pp = m * 16 + hq * 4 + r;
          const float v = (pp < nsel) ? d[r] * 0.125f : NEGF;
          mx = fmaxf(mx, v);
          if (col < 8) pbuf[pp * 8 + col] = v;
        }
      }
    }
    mx = fmaxf(mx, __shfl_xor(mx, 16));
    mx = fmaxf(mx, __shfl_xor(mx, 32));
    const float mxh = __shfl(mx, lane & 7);
    __builtin_amdgcn_wave_barrier();
    float sum = 0.f;
#pragma unroll 4
    for (int k = 0; k < 32; ++k) {
      const int i = lane + 64 * k;
      const float v = pbuf[i];
      const float e = (v > -1e29f) ? __expf(v - mxh) : 0.f;
      pbuf[i] = e;
      sum += e;
    }
    sum += __shfl_xor(sum, 8);
    sum += __shfl_xor(sum, 16);
    sum += __shfl_xor(sum, 32);
    const float inv = 1.f / sum;
    __builtin_amdgcn_wave_barrier();
    {
      const int rs = lane >> 3, dc = lane & 7;
      float acc[8][8];
#pragma unroll
      for (int h = 0; h < 8; ++h)
#pragma unroll
        for (int e = 0; e < 8; ++e) acc[h][e] = 0.f;
#pragma unroll 2
      for (int it = 0; it < 32; ++it) {
        const int pos = it * 8 + rs;
        const int s = (pos < nsel) ? (int)sel[tk * 256 + pos] : 0;
        const h8 v8 = *(const h8*)(ub + (size_t)s * NU + C_BV + dc * 8);
        const f32x4 pa = *(const f32x4*)&pbuf[pos * 8];
        const f32x4 pb = *(const f32x4*)&pbuf[pos * 8 + 4];
        float vf[8];
#pragma unroll
        for (int e = 0; e < 8; ++e) vf[e] = (float)v8[e];
#pragma unroll
        for (int e = 0; e < 8; ++e) {
          acc[0][e] += pa[0] * vf[e]; acc[1][e] += pa[1] * vf[e]; acc[2][e] += pa[2] * vf[e]; acc[3][e] += pa[3] * vf[e];
          acc[4][e] += pb[0] * vf[e]; acc[5][e] += pb[1] * vf[e]; acc[6][e] += pb[2] * vf[e]; acc[7][e] += pb[3] * vf[e];
        }
      }
      half_t* yrow = p.yb() + (size_t)(b * SEQ + t) * 512;
#pragma unroll
      for (int h = 0; h < 8; ++h) {
        const float invh = __shfl(inv, h);
        h8 ov;
        const h8 z8 = *(const h8*)(urow + C_BZ + h * 64 + dc * 8);
#pragma unroll
        for (int e = 0; e < 8; ++e) {
          float a = acc[h][e];
          a += __shfl_xor(a, 8);
          a += __shfl_xor(a, 16);
          a += __shfl_xor(a, 32);
          ov[e] = (half_t)(a * invh * siluf_((float)z8[e]));
        }
        if (rs == h) *(h8*)(yrow + h * 64 + dc * 8) = ov;
      }
    }
    __builtin_amdgcn_wave_barrier();
  }
  __syncthreads();
}

__device__ void phase2(const KP& p, int cidx, int l, char* smem) {
  int* s_item = (int*)(smem + SMEM_BYTES - 16);
  const int total = 512 + 32 + 512;
  for (;;) {
    if (threadIdx.x == 0) *s_item = atomicAdd(&p.counters()[cidx], 1);
    __syncthreads();
    const int it = *s_item;
    __syncthreads();
    if (it >= total) break;
    if (it < 512) dsa_item(p, it, smem);
    else if (it < 544) compress_item(p, l, it - 512, smem);
    else pool_item(p, l, it - 544, smem);
  }
}

struct AttnState {
  float m, l;
  f32x4 o[4];
};

template <bool ONLINE, class VF>
__device__ __forceinline__ void attn_chunk(AttnState& st, const half_t* __restrict__ Kb, int ldk,
                                           const half_t* __restrict__ VT, int ldv, int key0, h8 q0, h8 q1,
                                           VF valid, float fixed_m, float fixed_invl, f32x4* pout) {
  int lane = threadIdx.x & 63;
  asm volatile("" : "+v"(lane));
  const int hq = lane >> 4;
  f32x4 s[2];
#pragma unroll
  for (int i = 0; i < 2; ++i) {
    const half_t* kp = Kb + (size_t)(key0 + 16 * i + (lane & 15)) * ldk + hq * 8;
    const h8 a0 = *(const h8*)kp, a1 = *(const h8*)(kp + 32);
    f32x4 d = {0.f, 0.f, 0.f, 0.f};
    d = __builtin_amdgcn_mfma_f32_16x16x32_f16(a0, q0, d, 0, 0, 0);
    d = __builtin_amdgcn_mfma_f32_16x16x32_f16(a1, q1, d, 0, 0, 0);
    s[i] = d;
  }
  bool vl[2][4];
#pragma unroll
  for (int i = 0; i < 2; ++i)
#pragma unroll
    for (int r = 0; r < 4; ++r) vl[i][r] = valid(key0 + 16 * i + 4 * hq + r);
  float mnew;
  if (ONLINE) {
    float cm = NEGF;
#pragma unroll
    for (int i = 0; i < 2; ++i)
#pragma unroll
      for (int r = 0; r < 4; ++r) cm = fmaxf(cm, vl[i][r] ? s[i][r] : NEGF);
    cm = fmaxf(cm, __shfl_xor(cm, 16));
    cm = fmaxf(cm, __shfl_xor(cm, 32));
    mnew = fmaxf(st.m, cm);
    const float alpha = __expf(st.m - mnew);
    st.m = mnew;
    st.l *= alpha;
#pragma unroll
    for (int dt = 0; dt < 4; ++dt)
#pragma unroll
      for (int r = 0; r < 4; ++r) st.o[dt][r] *= alpha;
  } else {
    mnew = fixed_m;
  }
  float ps = 0.f;
#pragma unroll
  for (int i = 0; i < 2; ++i)
#pragma unroll
    for (int r = 0; r < 4; ++r) {
      float e = vl[i][r] ? __expf(s[i][r] - mnew) : 0.f;
      if (!ONLINE) e *= fixed_invl;
      s[i][r] = e;
      ps += e;
    }
  st.l += ps;
  if (pout) { pout[0] = s[0]; pout[1] = s[1]; }
  if (VT) {
    h8 pf;
#pragma unroll
    for (int r = 0; r < 4; ++r) { pf[r] = (half_t)s[0][r]; pf[4 + r] = (half_t)s[1][r]; }
#pragma unroll
    for (int dt = 0; dt < 4; ++dt) {
      const half_t* vp = VT + (size_t)(16 * dt + (lane & 15)) * ldv + key0 + 4 * hq;
      const h4 lo = *(const h4*)vp, hi = *(const h4*)(vp + 16);
      h8 vf;
#pragma unroll
      for (int r = 0; r < 4; ++r) { vf[r] = lo[r]; vf[4 + r] = hi[r]; }
      st.o[dt] = __builtin_amdgcn_mfma_f32_16x16x32_f16(vf, pf, st.o[dt], 0, 0, 0);
    }
  }
}

__device__ __forceinline__ void st_reset(AttnState& st) {
  st.m = NEGF; st.l = 0.f;
#pragma unroll
  for (int dt = 0; dt < 4; ++dt)
#pragma unroll
    for (int r = 0; r < 4; ++r) st.o[dt][r] = 0.f;
}

__device__ void nsa_unit(const KP& p, int b, int g, int t0, float* wsm) {
  int lane = threadIdx.x & 63;
  asm volatile("" : "+v"(lane));
  const int col = lane & 15, hq = lane >> 4;
  const int j = col >> 2, r4 = col & 3;
  const int tj = t0 + j;
  const int head = g * 4 + r4;
  const half_t* ub = p.u() + (size_t)b * SEQ * NU;
  const half_t* urow = ub + (size_t)tj * NU;
  h8 q0 = *(const h8*)(urow + C_CQ + head * 64 + hq * 8);
  h8 q1 = *(const h8*)(urow + C_CQ + head * 64 + 32 + hq * 8);
#pragma unroll
  for (int e = 0; e < 8; ++e) { q0[e] = q0[e] * (half_t)0.125f; q1[e] = q1[e] * (half_t)0.125f; }
  float gate[3];
#pragma unroll
  for (int i = 0; i < 3; ++i) gate[i] = sigmoidf_((float)urow[C_CG + head * 3 + i]);
  f32x4 res[4];
#pragma unroll
  for (int dt = 0; dt < 4; ++dt)
#pragma unroll
    for (int r = 0; r < 4; ++r) res[dt][r] = 0.f;
  AttnState st;
  float* impA = wsm;
  float* impB = wsm + 512;
  for (int i = lane; i < 512 + 528; i += 64) wsm[i] = 0.f;
  __builtin_amdgcn_wave_barrier();

  const int nmax_u = (t0 + 3 - 31) >> 4;
  const int nmax_j = (tj >= 31) ? ((tj - 31) >> 4) : -1;
  if (nmax_u >= 0) {
    const half_t* Kc = p.kcmp() + (size_t)(b * 2 + g) * 512 * 64;
    const half_t* Vc = p.vcmpT() + (size_t)(b * 2 + g) * 64 * 512;
    st_reset(st);
    auto vfn = [&](int n) { return n <= nmax_j; };
    for (int k0 = 0; k0 <= nmax_u; k0 += 32)
      attn_chunk<true>(st, Kc, 64, (const half_t*)nullptr, 0, k0, q0, q1, vfn, 0.f, 0.f, (f32x4*)nullptr);
    float lt = st.l;
    lt += __shfl_xor(lt, 16);
    lt += __shfl_xor(lt, 32);
    const float mfix = st.m;
    const float invl = lt > 0.f ? 1.f / lt : 0.f;
    st_reset(st);
    for (int k0 = 0; k0 <= nmax_u; k0 += 32) {
      f32x4 pp[2];
      attn_chunk<false>(st, Kc, 64, Vc, 512, k0, q0, q1, vfn, mfix, invl, pp);
#pragma unroll
      for (int i = 0; i < 2; ++i) {
        float a = pp[i][0] + pp[i][1] + pp[i][2] + pp[i][3];
        float bb = pp[i][3];
        a += __shfl_xor(a, 1); a += __shfl_xor(a, 2);
        bb += __shfl_xor(bb, 1); bb += __shfl_xor(bb, 2);
        if (r4 == 0) {
          const int sblk = ((k0 + 16 * i) >> 2) + hq;
          impA[j * 128 + sblk] = a;
          impB[j * 132 + sblk + 1] = bb;
        }
      }
    }
#pragma unroll
    for (int dt = 0; dt < 4; ++dt)
#pragma unroll
      for (int r = 0; r < 4; ++r) res[dt][r] += gate[0] * st.o[dt][r];
  }
  __builtin_amdgcn_wave_barrier();

  unsigned long long mlo[4], mhi[4];
#pragma unroll
  for (int jj = 0; jj < 4; ++jj) {
    const int t = t0 + jj;
    const int blk = t >> 6;
    uint32_t k0, k1;
    {
      const int s0 = lane, s1 = lane + 64;
      const float i0 = impA[jj * 128 + s0] + impB[jj * 132 + s0];
      const float i1 = impA[jj * 128 + s1] + impB[jj * 132 + s1];
      auto mk = [&](float im, int s) -> uint32_t {
        if (s > blk) return 0u;
        uint32_t kk = ((__float_as_uint(im) >> 1) & ~127u) | (uint32_t)(127 - s) | 0x40000000u;
        if (s == 0 || s == blk || s == blk - 1) kk |= 0x80000000u;
        return kk;
      };
      k0 = mk(i0, s0); k1 = mk(i1, s1);
    }
    unsigned long long lo = 0ull, hi = 0ull;
    for (int it = 0; it < 16; ++it) {
      uint32_t mxk = k0 > k1 ? k0 : k1;
#pragma unroll
      for (int o = 32; o > 0; o >>= 1) {
        const uint32_t ov = (uint32_t)__shfl_xor((int)mxk, o);
        mxk = ov > mxk ? ov : mxk;
      }
      mxk = (uint32_t)__builtin_amdgcn_readfirstlane((int)mxk);
      if (mxk == 0u) break;
      const int s = 127 - (int)(mxk & 127u);
      if (s < 64) lo |= 1ull << s; else hi |= 1ull << (s - 64);
      if (s == lane) k0 = 0u;
      if (s == lane + 64) k1 = 0u;
    }
    mlo[jj] = lo; mhi[jj] = hi;
  }
  {
    const unsigned long long mylo = j == 0 ? mlo[0] : (j == 1 ? mlo[1] : (j == 2 ? mlo[2] : mlo[3]));
    const unsigned long long myhi = j == 0 ? mhi[0] : (j == 1 ? mhi[1] : (j == 2 ? mhi[2] : mhi[3]));
    const half_t* Ks = ub + C_CKS + g * 64;
    const half_t* Vs = p.vsT() + (size_t)(b * 2 + g) * 64 * SEQ;
    st_reset(st);
    for (int half = 0; half < 2; ++half) {
      unsigned long long un = half ? (mhi[0] | mhi[1] | mhi[2] | mhi[3]) : (mlo[0] | mlo[1] | mlo[2] | mlo[3]);
      const unsigned long long mym = half ? myhi : mylo;
      while (un) {
        const int bit = (int)__builtin_ctzll(un);
        un &= un - 1ull;
        const bool mine = (mym >> bit) & 1ull;
        const int sblk = half * 64 + bit;
        auto vfn = [&](int key) { return mine && key <= tj; };
        attn_chunk<true>(st, Ks, NU, Vs, SEQ, sblk * 64, q0, q1, vfn, 0.f, 0.f, (f32x4*)nullptr);
        attn_chunk<true>(st, Ks, NU, Vs, SEQ, sblk * 64 + 32, q0, q1, vfn, 0.f, 0.f, (f32x4*)nullptr);
      }
    }
    float lt = st.l;
    lt += __shfl_xor(lt, 16);
    lt += __shfl_xor(lt, 32);
    const float sc = lt > 0.f ? gate[1] / lt : 0.f;
#pragma unroll
    for (int dt = 0; dt < 4; ++dt)
#pragma unroll
      for (int r = 0; r < 4; ++r) res[dt][r] += sc * st.o[dt][r];
  }
  {
    const half_t* Kw = ub + C_CKW + g * 64;
    const half_t* Vw = p.vwT() + (size_t)(b * 2 + g) * 64 * SEQ;
    st_reset(st);
    const int kmin = max(0, t0 - 511) & ~31;
    auto vfn = [&](int key) { return key <= tj && key > tj - 512; };
    for (int k0 = kmin; k0 <= t0 + 3; k0 += 32)
      attn_chunk<true>(st, Kw, NU, Vw, SEQ, k0, q0, q1, vfn, 0.f, 0.f, (f32x4*)nullptr);
    float lt = st.l;
    lt += __shfl_xor(lt, 16);
    lt += __shfl_xor(lt, 32);
    const float sc = lt > 0.f ? gate[2] / lt : 0.f;
#pragma unroll
    for (int dt = 0; dt < 4; ++dt)
#pragma unroll
      for (int r = 0; r < 4; ++r) res[dt][r] += sc * st.o[dt][r];
  }
  half_t* yrow = p.yc() + (size_t)(b * SEQ + tj) * 512 + head * 64;
#pragma unroll
  for (int dt = 0; dt < 4; ++dt) {
    const int d = 16 * dt + 4 * hq;
    const h4 z = *(const h4*)(urow + C_CZ + head * 64 + d);
    h4 ov;
#pragma unroll
    for (int r = 0; r < 4; ++r) ov[r] = (half_t)(res[dt][r] * siluf_((float)z[r]));
    *(h4*)(yrow + d) = ov;
  }
  __builtin_amdgcn_wave_barrier();
}

__device__ void phase_nsa(const KP& p, char* smem) {
  const int wid = threadIdx.x >> 6;
  float* wsm = (float*)smem + wid * 1040;
  for (int it = blockIdx.x; it < 2048; it += gridDim.x) {
    const int b = it & 1, g = (it >> 1) & 1, tile = it >> 2;
    nsa_unit(p, b, g, tile * 16 + wid * 4, wsm);
  }
}

__device__ void phase_merge(const KP& p, char* smem) {
  for (int tile = blockIdx.x; tile < 16 * 128; tile += gridDim.x) {
    const int nt = tile >> 7, mt = tile & 127;
    const int m0 = mt * 128, n0 = nt * 64;
    f32x16 tot[2];
#pragma unroll
    for (int i = 0; i < 2; ++i)
#pragma unroll
      for (int r = 0; r < 16; ++r) tot[i][r] = 0.f;
#pragma unroll
    for (int br = 0; br < 3; ++br) {
      const half_t* A = (br == 0 ? p.ya() : (br == 1 ? p.yb() : p.yc())) + (size_t)m0 * 512;
      const half_t* B = p.wpT() + (size_t)br * DM * 512 + (size_t)n0 * 512;
      gemm_tile<1>(
          512, [&](int r, int k) { return *(const uint4*)(A + (size_t)r * 512 + k); },
          [&](int r, int k) { return *(const uint4*)(B + (size_t)r * 512 + k); },
          [&](int mi, int ni, int r, int row, int col, float v) {
            const float gz = (float)p.u()[(size_t)(m0 + row) * NU + C_GM + br * 1024 + n0 + col];
            tot[mi][r] += sigmoidf_(gz) * v;
          },
          smem);
    }
    int tidx = threadIdx.x;
    asm volatile("" : "+v"(tidx));
    const int lane = tidx & 63, wid = tidx >> 6, wm = wid >> 1, wn = wid & 1;
#pragma unroll
    for (int mi = 0; mi < 2; ++mi)
#pragma unroll
      for (int r = 0; r < 16; ++r) {
        const int row = wm * 64 + mi * 32 + (r & 3) + 8 * (r >> 2) + 4 * (lane >> 5);
        const int col = wn * 32 + (lane & 31);
        p.mm()[(size_t)(m0 + row) * DM + n0 + col] = (half_t)tot[mi][r];
      }
  }
}

__device__ void phase_outproj(const KP& p, char* smem) {
  for (int tile = blockIdx.x; tile < 8 * 128; tile += gridDim.x) {
    const int nt = tile >> 7, mt = tile & 127;
    const int m0 = mt * 128, n0 = nt * 128;
    const half_t* A = p.mm() + (size_t)m0 * DM;
    const half_t* B = p.woT() + (size_t)n0 * DM;
    gemm_tile<2>(
        DM, [&](int r, int k) { return *(const uint4*)(A + (size_t)r * DM + k); },
        [&](int r, int k) { return *(const uint4*)(B + (size_t)r * DM + k); },
        [&](int mi, int ni, int r, int row, int col, float v) {
          const size_t xi = (size_t)(m0 + row) * DM + n0 + col;
          ((float*)p.u())[xi] = ALPHA_F * p.xr()[xi] + v;
        },
        smem);
  }
}


#define XB_TMO      128
#define XB_XCNT(j)  (256  + 64 * (j))
#define XB_XSUB(j)  (1280 + 64 * (j))
#define XB_XGEN(j)  (2304 + 64 * (j))
#define XB_TOP      3328
#define XB_TOPGEN   3392
#define XCD_BAR_WORDS 3456
#define XB_SPIN_CAP (1u << 20)
#define LAS __attribute__((address_space(3)))
__device__ __forceinline__ unsigned xb_ld(unsigned* p)              { return __hip_atomic_load(p, __ATOMIC_RELAXED, __HIP_MEMORY_SCOPE_AGENT); }
__device__ __forceinline__ unsigned xb_add(unsigned* p, unsigned v) { return __hip_atomic_fetch_add(p, v, __ATOMIC_RELAXED, __HIP_MEMORY_SCOPE_AGENT); }
__device__ __forceinline__ unsigned xb_xcc_id() { return (unsigned)__builtin_amdgcn_s_getreg((3 << 11) | 20) & 0xFu; }
#define XB_SPIN(cond, bar) do { unsigned _sp = 0; while (cond) { __builtin_amdgcn_s_sleep(1); \
    if ((++_sp & 255u) == 0u) { if (xb_ld(&(bar)[XB_TMO])) break; if (_sp > XB_SPIN_CAP) { atomicAdd(&(bar)[XB_TMO], 1u); break; } } } } while (0)
struct XcdBarrier { unsigned* bar; unsigned x; volatile LAS unsigned* st; };
__device__ __forceinline__ XcdBarrier xcd_barrier_post(unsigned* bar, volatile LAS unsigned* st) {
  XcdBarrier b; b.bar = bar; b.x = xb_xcc_id(); b.st = st;
  if (threadIdx.x == 0) (void)xb_add(&bar[XB_XCNT(b.x)], 1u);
  return b;
}
__device__ __forceinline__ void xcd_barrier_complete(unsigned* bar, unsigned x, unsigned& nloc, unsigned& nx) {
  const unsigned G = gridDim.x * gridDim.y * gridDim.z;
  unsigned sum, cnt, mine, sp = 0u;
  for (;;) {
    sum = 0u; cnt = 0u; mine = 0u;
#pragma unroll
    for (unsigned j = 0; j < 16; ++j) { const unsigned c = xb_ld(&bar[XB_XCNT(j)]); sum += c; cnt += (c > 0u) ? 1u : 0u; mine = (j == x) ? c : mine; }
    if (sum == G) break;
    __builtin_amdgcn_s_sleep(1);
    if ((++sp & 255u) == 0u) { if (xb_ld(&bar[XB_TMO])) break; if (sp > XB_SPIN_CAP) { atomicAdd(&bar[XB_TMO], 1u); break; } }
  }
  nloc = mine > 0u ? mine : 1u; nx = cnt > 0u ? cnt : 1u;
}
__device__ __forceinline__ void xcd_barrier(const XcdBarrier& b) {
  asm volatile("s_waitcnt vmcnt(0)" ::: "memory");
  __syncthreads();
  if (threadIdx.x == 0) {
    unsigned* bar = b.bar;
    __builtin_amdgcn_s_waitcnt(0);
    unsigned nloc = b.st[0], nx = b.st[1];
    if (nloc == 0u) { xcd_barrier_complete(bar, b.x, nloc, nx); b.st[0] = nloc; b.st[1] = nx; }
    const unsigned old = xb_add(&bar[XB_XSUB(b.x)], 1u);
    const unsigned gen = old / nloc;
    if (old + 1u == (gen + 1u) * nloc) {
      __builtin_amdgcn_fence(__ATOMIC_RELEASE, "agent");
      asm volatile("s_waitcnt vmcnt(0)" ::: "memory");
      const unsigned og = xb_add(&bar[XB_TOP], 1u);
      const unsigned tg = og / nx;
      if (og + 1u == (tg + 1u) * nx) xb_add(&bar[XB_TOPGEN], 1u);
      else XB_SPIN(xb_ld(&bar[XB_TOPGEN]) == tg, bar);
      __builtin_amdgcn_fence(__ATOMIC_ACQUIRE, "agent");
      xb_add(&bar[XB_XGEN(b.x)], 1u);
      asm volatile("s_waitcnt vmcnt(0)" ::: "memory");
    } else {
      XB_SPIN(xb_ld(&bar[XB_XGEN(b.x)]) == gen, bar);
      __builtin_amdgcn_fence(__ATOMIC_ACQUIRE, "agent");
      asm volatile("s_waitcnt vmcnt(0)" ::: "memory");
    }
  }
  __syncthreads();
}

__global__ void __launch_bounds__(256, 2) fwd_megakernel(Params p_unused) {
  cg::grid_group grid = cg::this_grid();
  __shared__ __attribute__((aligned(16))) char smem[SMEM_BYTES];
  volatile LAS unsigned* st = (volatile LAS unsigned*)(smem + SMEM_BYTES - 32);
  if (threadIdx.x == 0) { st[0] = 0u; st[1] = 0u; }
  {
    const KP p = get_params();
    if (blockIdx.x == 0)
      for (int i = threadIdx.x; i < 64 + XCD_BAR_WORDS; i += 256) p.counters()[i] = 0;
    ln_rows(p, -1, false);
    prep_weights(p, 0, smem);
  }
  grid.sync();
  XcdBarrier xb;
  {
    const KP p = get_params();
    xb = xcd_barrier_post((unsigned*)p.counters() + 64, st);
  }
#ifndef REP1
#define REP1 1
#define REP2 1
#define REP3 1
#define REP4 1
#endif
#ifndef REP5
#define REP5 1
#define REP6 1
#define REP7 0
#endif
#pragma unroll 1
  for (int l = 0; l < DEPTH; ++l) {
    for (int rep = 0; rep < REP1; ++rep) { const KP p = get_params(); phase_inproj(p, l, smem); }
    xcd_barrier(xb);
    for (int rep = 0; rep < REP2; ++rep) { const KP p = get_params(); phase2(p, l + 4 * rep, l, smem); }
    xcd_barrier(xb);
    for (int rep = 0; rep < REP3; ++rep) { const KP p = get_params(); phase_nsa(p, smem); }
    xcd_barrier(xb);
    for (int rep = 0; rep < REP4; ++rep) { const KP p = get_params(); phase_merge(p, smem); }
    xcd_barrier(xb);
    for (int rep = 0; rep < REP5; ++rep) { const KP p = get_params(); phase_outproj(p, smem); }
    xcd_barrier(xb);
    for (int rep = 0; rep < REP6; ++rep) {
      const KP p = get_params();
      if (l + 1 < DEPTH) {
        ln_rows(p, l, false);
        prep_weights(p, l + 1, smem);
      } else {
        ln_rows(p, l, true);
      }
    }
    if (l + 1 < DEPTH) xcd_barrier(xb);
    for (int rep = 0; rep < REP7; ++rep) xcd_barrier(xb);
  }
}

extern "C" void kernel_launch(void* const* d_in, const int* in_sizes, int n_in, void* d_out, int out_size,
                              void* d_ws, size_t ws_size, hipStream_t stream) {
  static int grid_blocks = 0;
  if (!grid_blocks) {
    int dev = 0, cus = 0, per_cu = 0;
    (void)hipGetDevice(&dev);
    (void)hipDeviceGetAttribute(&cus, hipDeviceAttributeMultiprocessorCount, dev);
    (void)hipOccupancyMaxActiveBlocksPerMultiprocessor(&per_cu, fwd_megakernel, 256, 0);
    if (per_cu > 2) per_cu = 2;
    if (per_cu < 1) per_cu = 1;
    grid_blocks = cus * per_cu;
  }
  Params p{};
  p.x = (const float*)d_in[0]; p.w_in = (const float*)d_in[1]; p.b_in = (const float*)d_in[2];
  p.pool_w = (const float*)d_in[3]; p.pool_b = (const float*)d_in[4]; p.pool_scale = (const float*)d_in[5];
  p.pos_k = (const float*)d_in[6]; p.pos_v = (const float*)d_in[7]; p.w1k = (const float*)d_in[8];
  p.w2k = (const float*)d_in[9]; p.w1v = (const float*)d_in[10]; p.w2v = (const float*)d_in[11];
  p.wpa = (const float*)d_in[12]; p.wpb = (const float*)d_in[13]; p.wpc = (const float*)d_in[14];
  p.wo = (const float*)d_in[15]; p.ln_g = (const float*)d_in[16]; p.ln_b = (const float*)d_in[17];
  p.out = (float*)d_out;
  p.ws = (char*)d_ws;
  if (WS_TOTAL > ws_size) { fprintf(stderr, "workspace too small: need %zu have %zu\n", (size_t)WS_TOTAL, ws_size); return; }
  void* args[] = {&p};
  hipError_t e = hipLaunchCooperativeKernel((void*)fwd_megakernel, dim3(grid_blocks), dim3(256), args, 0, stream);
  if (e != hipSuccess) fprintf(stderr, "cooperative launch failed: %s (grid %d)\n", hipGetErrorString(e), grid_blocks);
}
```

```cpp
#include <hip/hip_runtime.h>
#include <hip/hip_cooperative_groups.h>
#include <cstdio>
#include <cstdint>
namespace cg = cooperative_groups;

typedef _Float16 half_t;
typedef _Float16 h8 __attribute__((ext_vector_type(8)));
typedef _Float16 h4 __attribute__((ext_vector_type(4)));
typedef float f32x4 __attribute__((ext_vector_type(4)));
typedef float f32x16 __attribute__((ext_vector_type(16)));

#define SEQ 8192
#define DM 1024
#define NTOK 16384
#define DEPTH 4
#define NIN 7360
#define NU 7424
#define ALPHA_F 1.681792830507429f
#define NEGF (-1e30f)

#define C_AX 0
#define C_AZ 512
#define C_BQ 1024
#define C_BZ 1536
#define C_CQ 2048
#define C_CZ 2560
#define C_GM 3072
#define C_IQ 6144
#define C_CKC 6400
#define C_CVC 6528
#define C_CKS 6656
#define C_CVS 6784
#define C_CKW 6912
#define C_CVW 7040
#define C_BK 7168
#define C_BV 7232
#define C_IK 7296
#define C_IW 7328
#define C_CG 7336

#define SMEM_BYTES 69632

constexpr size_t OFF_xr = 0;
constexpr size_t OFF_xh = OFF_xr + (((size_t)NTOK*DM*4 + 255) & ~(size_t)255);
constexpr size_t OFF_u = OFF_xh + (((size_t)NTOK*DM*2 + 255) & ~(size_t)255);
constexpr size_t OFF_winT = OFF_u + (((size_t)NTOK*NU*2 + 255) & ~(size_t)255);
constexpr size_t OFF_wpT = OFF_winT + (((size_t)NU*DM*2 + 255) & ~(size_t)255);
constexpr size_t OFF_woT = OFF_wpT + (((size_t)3*DM*512*2 + 255) & ~(size_t)255);
constexpr size_t OFF_poolT = OFF_woT + (((size_t)DM*DM*2 + 255) & ~(size_t)255);
constexpr size_t OFF_w1T = OFF_poolT + (((size_t)4*128*128*2 + 255) & ~(size_t)255);
constexpr size_t OFF_posb = OFF_w1T + (((size_t)2*64*2048*2 + 255) & ~(size_t)255);
constexpr size_t OFF_vsT = OFF_posb + (((size_t)512 + 255) & ~(size_t)255);
constexpr size_t OFF_vwT = OFF_vsT + (((size_t)4*64*SEQ*2 + 255) & ~(size_t)255);
constexpr size_t OFF_kcmp = OFF_vwT + (((size_t)4*64*SEQ*2 + 255) & ~(size_t)255);
constexpr size_t OFF_vcmpT = OFF_kcmp + (((size_t)4*512*64*2 + 255) & ~(size_t)255);
constexpr size_t OFF_ya = OFF_vcmpT + (((size_t)4*64*512*2 + 255) & ~(size_t)255);
constexpr size_t OFF_yb = OFF_ya + (((size_t)NTOK*512*2 + 255) & ~(size_t)255);
constexpr size_t OFF_yc = OFF_yb + (((size_t)NTOK*512*2 + 255) & ~(size_t)255);
constexpr size_t OFF_mm = OFF_yc + (((size_t)NTOK*512*2 + 255) & ~(size_t)255);
constexpr size_t OFF_counters = OFF_mm + (((size_t)NTOK*DM*2 + 255) & ~(size_t)255);
constexpr size_t WS_TOTAL = OFF_counters + (((size_t)32768 + 255) & ~(size_t)255);
struct Params {
  const float* x; const float* w_in; const float* b_in; const float* pool_w; const float* pool_b;
  const float* pool_scale; const float* pos_k; const float* pos_v; const float* w1k; const float* w2k;
  const float* w1v; const float* w2v; const float* wpa; const float* wpb; const float* wpc;
  const float* wo; const float* ln_g; const float* ln_b;
  float* out;
  char* ws;
};
typedef const __attribute__((address_space(4))) unsigned long long* kargp_t;
struct KP {
  kargp_t kp;
  __device__ __forceinline__ const float* x() const { return (const float*)(const __attribute__((address_space(1))) float*)kp[0]; }
  __device__ __forceinline__ const float* w_in() const { return (const float*)(const __attribute__((address_space(1))) float*)kp[1]; }
  __device__ __forceinline__ const float* b_in() const { return (const float*)(const __attribute__((address_space(1))) float*)kp[2]; }
  __device__ __forceinline__ const float* pool_w() const { return (const float*)(const __attribute__((address_space(1))) float*)kp[3]; }
  __device__ __forceinline__ const float* pool_b() const { return (const float*)(const __attribute__((address_space(1))) float*)kp[4]; }
  __device__ __forceinline__ const float* pool_scale() const { return (const float*)(const __attribute__((address_space(1))) float*)kp[5]; }
  __device__ __forceinline__ const float* pos_k() const { return (const float*)(const __attribute__((address_space(1))) float*)kp[6]; }
  __device__ __forceinline__ const float* pos_v() const { return (const float*)(const __attribute__((address_space(1))) float*)kp[7]; }
  __device__ __forceinline__ const float* w1k() const { return (const float*)(const __attribute__((address_space(1))) float*)kp[8]; }
  __device__ __forceinline__ const float* w2k() const { return (const float*)(const __attribute__((address_space(1))) float*)kp[9]; }
  __device__ __forceinline__ const float* w1v() const { return (const float*)(const __attribute__((address_space(1))) float*)kp[10]; }
  __device__ __forceinline__ const float* w2v() const { return (const float*)(const __attribute__((address_space(1))) float*)kp[11]; }
  __device__ __forceinline__ const float* wpa() const { return (const float*)(const __attribute__((address_space(1))) float*)kp[12]; }
  __device__ __forceinline__ const float* wpb() const { return (const float*)(const __attribute__((address_space(1))) float*)kp[13]; }
  __device__ __forceinline__ const float* wpc() const { return (const float*)(const __attribute__((address_space(1))) float*)kp[14]; }
  __device__ __forceinline__ const float* wo() const { return (const float*)(const __attribute__((address_space(1))) float*)kp[15]; }
  __device__ __forceinline__ const float* ln_g() const { return (const float*)(const __attribute__((address_space(1))) float*)kp[16]; }
  __device__ __forceinline__ const float* ln_b() const { return (const float*)(const __attribute__((address_space(1))) float*)kp[17]; }
  __device__ __forceinline__ float* out() const { return (float*)(__attribute__((address_space(1))) float*)kp[18]; }
  __device__ __forceinline__ char* ws() const { return (char*)(__attribute__((address_space(1))) char*)kp[19]; }
  __device__ __forceinline__ float* xr() const { return (float*)(ws() + OFF_xr); }
  __device__ __forceinline__ half_t* xh() const { return (half_t*)(ws() + OFF_xh); }
  __device__ __forceinline__ half_t* u() const { return (half_t*)(ws() + OFF_u); }
  __device__ __forceinline__ half_t* winT() const { return (half_t*)(ws() + OFF_winT); }
  __device__ __forceinline__ half_t* wpT() const { return (half_t*)(ws() + OFF_wpT); }
  __device__ __forceinline__ half_t* woT() const { return (half_t*)(ws() + OFF_woT); }
  __device__ __forceinline__ half_t* poolT() const { return (half_t*)(ws() + OFF_poolT); }
  __device__ __forceinline__ half_t* w1T() const { return (half_t*)(ws() + OFF_w1T); }
  __device__ __forceinline__ float* posb() const { return (float*)(ws() + OFF_posb); }
  __device__ __forceinline__ half_t* vsT() const { return (half_t*)(ws() + OFF_vsT); }
  __device__ __forceinline__ half_t* vwT() const { return (half_t*)(ws() + OFF_vwT); }
  __device__ __forceinline__ half_t* kcmp() const { return (half_t*)(ws() + OFF_kcmp); }
  __device__ __forceinline__ half_t* vcmpT() const { return (half_t*)(ws() + OFF_vcmpT); }
  __device__ __forceinline__ half_t* ya() const { return (half_t*)(ws() + OFF_ya); }
  __device__ __forceinline__ half_t* yb() const { return (half_t*)(ws() + OFF_yb); }
  __device__ __forceinline__ half_t* yc() const { return (half_t*)(ws() + OFF_yc); }
  __device__ __forceinline__ half_t* mm() const { return (half_t*)(ws() + OFF_mm); }
  __device__ __forceinline__ int* counters() const { return (int*)(ws() + OFF_counters); }
};
__device__ __forceinline__ KP get_params() {
  KP q;
  q.kp = (kargp_t)__builtin_amdgcn_kernarg_segment_ptr();
  asm volatile("" : "+s"(q.kp));
  return q;
}


__device__ __forceinline__ int orig_col(int n) {
  if (n < 1536) return n;
  if (n < 2048) return 1664 + (n - 1536);
  if (n < 2560) return 2472 + (n - 2048);
  if (n < 3072) return 3776 + (n - 2560);
  if (n < 6144) return 4288 + (n - 3072);
  if (n < 6400) return 2176 + (n - 6144);
  if (n < 7168) return 2984 + (n - 6400);
  if (n < 7296) return 1536 + (n - 7168);
  if (n < 7328) return 2432 + (n - 7296);
  if (n < 7336) return 2464 + (n - 7328);
  if (n < 7360) return 3752 + (n - 7336);
  return -1;
}

__device__ __forceinline__ float wave_sum(float v) {
#pragma unroll
  for (int o = 32; o > 0; o >>= 1) v += __shfl_xor(v, o);
  return v;
}
__device__ __forceinline__ float sigmoidf_(float x) { return 1.f / (1.f + __expf(-x)); }
__device__ __forceinline__ float siluf_(float x) { return x / (1.f + __expf(-x)); }

template <int NI, class LA, class LB, class EP>
__device__ __forceinline__ void gemm_tile(int K, LA loadA, LB loadB, EP epi, char* smem) {
  constexpr int BN = NI * 64;
  constexpr int NB = BN / 32;
  half_t* sA = (half_t*)smem;
  half_t* sB = sA + 128 * 72;
  int tid = threadIdx.x;
  asm volatile("" : "+v"(tid));
  const int lane = tid & 63, wid = tid >> 6;
  const int wm = wid >> 1, wn = wid & 1;
  f32x16 acc[2][NI];
#pragma unroll
  for (int i = 0; i < 2; ++i)
#pragma unroll
    for (int j = 0; j < NI; ++j)
#pragma unroll
      for (int r = 0; r < 16; ++r) acc[i][j][r] = 0.f;
  const int lr = tid >> 3, lc = (tid & 7) * 8;
  uint4 ra[4], rb[NB];
#pragma unroll
  for (int i = 0; i < 4; ++i) ra[i] = loadA(lr + 32 * i, lc);
#pragma unroll
  for (int i = 0; i < NB; ++i) rb[i] = loadB(lr + 32 * i, lc);
  const int nk = K >> 6;
  for (int kt = 0; kt < nk; ++kt) {
    __syncthreads();
#pragma unroll
    for (int i = 0; i < 4; ++i) *(uint4*)&sA[(lr + 32 * i) * 72 + lc] = ra[i];
#pragma unroll
    for (int i = 0; i < NB; ++i) *(uint4*)&sB[(lr + 32 * i) * 72 + lc] = rb[i];
    __syncthreads();
    if (kt + 1 < nk) {
      const int kk = (kt + 1) * 64 + lc;
#pragma unroll
      for (int i = 0; i < 4; ++i) ra[i] = loadA(lr + 32 * i, kk);
#pragma unroll
      for (int i = 0; i < NB; ++i) rb[i] = loadB(lr + 32 * i, kk);
    }
#pragma unroll
    for (int s = 0; s < 4; ++s) {
      h8 af[2], bf[NI];
#pragma unroll
      for (int mi = 0; mi < 2; ++mi)
        af[mi] = *(const h8*)&sA[(wm * 64 + mi * 32 + (lane & 31)) * 72 + s * 16 + (lane >> 5) * 8];
#pragma unroll
      for (int ni = 0; ni < NI; ++ni)
        bf[ni] = *(const h8*)&sB[(wn * (NI * 32) + ni * 32 + (lane & 31)) * 72 + s * 16 + (lane >> 5) * 8];
#pragma unroll
      for (int mi = 0; mi < 2; ++mi)
#pragma unroll
        for (int ni = 0; ni < NI; ++ni)
          acc[mi][ni] = __builtin_amdgcn_mfma_f32_32x32x16_f16(af[mi], bf[ni], acc[mi][ni], 0, 0, 0);
    }
  }
#pragma unroll
  for (int mi = 0; mi < 2; ++mi)
#pragma unroll
    for (int ni = 0; ni < NI; ++ni)
#pragma unroll
      for (int r = 0; r < 16; ++r) {
        const int row = wm * 64 + mi * 32 + (r & 3) + 8 * (r >> 2) + 4 * (lane >> 5);
        const int col = wn * (NI * 32) + ni * 32 + (lane & 31);
        epi(mi, ni, r, row, col, acc[mi][ni][r]);
      }
}

template <class CM>
__device__ __forceinline__ void tconv_tile(const float* __restrict__ src, int lds_, half_t* __restrict__ dst, int ldd,
                                           int n0, int k0, CM cmap, char* smem) {
  float* t = (float*)smem;
  int tid = threadIdx.x;
  asm volatile("" : "+v"(tid));
  {
    const int n = tid & 63;
    const int c = cmap(n0 + n);
#pragma unroll 4
    for (int i = 0; i < 16; ++i) {
      const int k = (tid >> 6) + 4 * i;
      t[k * 65 + n] = (c >= 0) ? src[(size_t)(k0 + k) * lds_ + c] : 0.f;
    }
  }
  __syncthreads();
#pragma unroll
  for (int i = 0; i < 2; ++i) {
    const int idx = tid + 256 * i;
    const int n = idx >> 3, kc = (idx & 7) * 8;
    h8 v;
#pragma unroll
    for (int j = 0; j < 8; ++j) v[j] = (half_t)t[(kc + j) * 65 + n];
    *(h8*)&dst[(size_t)(n0 + n) * ldd + k0 + kc] = v;
  }
  __syncthreads();
}

__device__ __forceinline__ void ln_rows(const KP& p, int lprev, bool final_) {
  int tid = threadIdx.x;
  asm volatile("" : "+v"(tid));
  const int lane = tid & 63, wid = tid >> 6;
  const int gw = blockIdx.x * 4 + wid, nw = gridDim.x * 4;
  for (int row = gw; row < NTOK; row += nw) {
    const float4* rp = (const float4*)((lprev < 0 ? p.x() : (const float*)p.u()) + (size_t)row * DM);
    float4 v[4];
    float s = 0.f;
#pragma unroll
    for (int i = 0; i < 4; ++i) {
      v[i] = rp[lane + 64 * i];
      s += v[i].x + v[i].y + v[i].z + v[i].w;
    }
    if (lprev >= 0) {
      float mu = wave_sum(s) * (1.f / DM);
      float q = 0.f;
#pragma unroll
      for (int i = 0; i < 4; ++i) {
        float a = v[i].x - mu, b = v[i].y - mu, c = v[i].z - mu, d = v[i].w - mu;
        q += a * a + b * b + c * c + d * d;
      }
      float rstd = rsqrtf(wave_sum(q) * (1.f / DM) + 1e-5f);
      const float4* g4 = (const float4*)(p.ln_g() + lprev * DM);
      const float4* b4 = (const float4*)(p.ln_b() + lprev * DM);
#pragma unroll
      for (int i = 0; i < 4; ++i) {
        float4 g = g4[lane + 64 * i], bb = b4[lane + 64 * i];
        v[i].x = (v[i].x - mu) * rstd * g.x + bb.x;
        v[i].y = (v[i].y - mu) * rstd * g.y + bb.y;
        v[i].z = (v[i].z - mu) * rstd * g.z + bb.z;
        v[i].w = (v[i].w - mu) * rstd * g.w + bb.w;
      }
    }
    if (final_) {
      float4* op = (float4*)(p.out() + (size_t)row * DM);
#pragma unroll
      for (int i = 0; i < 4; ++i) op[lane + 64 * i] = v[i];
    } else {
      float4* op = (float4*)(p.xr() + (size_t)row * DM);
      h4* hp = (h4*)(p.xh() + (size_t)row * DM);
#pragma unroll
      for (int i = 0; i < 4; ++i) {
        op[lane + 64 * i] = v[i];
        h4 hv;
        hv[0] = (half_t)v[i].x; hv[1] = (half_t)v[i].y; hv[2] = (half_t)v[i].z; hv[3] = (half_t)v[i].w;
        hp[lane + 64 * i] = hv;
      }
    }
  }
}

__device__ __forceinline__ void prep_weights(const KP& p, int l, char* smem) {
  int tid = threadIdx.x;
  asm volatile("" : "+v"(tid));
  const int total = 1856 + 384 + 256 + 16 + 64 + 2;
  for (int it = blockIdx.x; it < total; it += gridDim.x) {
    if (it < 1856) {
      const int nt = it >> 4, kt = it & 15;
      tconv_tile(p.w_in() + (size_t)l * DM * NIN, NIN, p.winT(), DM, nt * 64, kt * 64,
                 [](int n) { return orig_col(n); }, smem);
    } else if (it < 1856 + 384) {
      const int j = it - 1856;
      const int w = j >> 7, r = j & 127, nt = r >> 3, kt = r & 7;
      const float* src = (w == 0 ? p.wpa() : (w == 1 ? p.wpb() : p.wpc())) + (size_t)l * 512 * DM;
      tconv_tile(src, DM, p.wpT() + (size_t)w * DM * 512, 512, nt * 64, kt * 64, [](int n) { return n; }, smem);
    } else if (it < 1856 + 384 + 256) {
      const int j = it - 1856 - 384;
      const int nt = j >> 4, kt = j & 15;
      tconv_tile(p.wo() + (size_t)l * DM * DM, DM, p.woT(), DM, nt * 64, kt * 64, [](int n) { return n; }, smem);
    } else if (it < 1856 + 384 + 256 + 16) {
      const int j = it - 1856 - 384 - 256;
      const int g = j >> 2, nt = (j >> 1) & 1, kt = j & 1;
      tconv_tile(p.pool_w() + ((size_t)l * 4 + g) * 128 * 128, 128, p.poolT() + (size_t)g * 128 * 128, 128, nt * 64,
                 kt * 64, [](int n) { return n; }, smem);
    } else if (it < 1856 + 384 + 256 + 16 + 64) {
      const int j = it - 1856 - 384 - 256 - 16;
      const int kv = j >> 5, kt = j & 31;
      const float* src = (kv ? p.w1v() : p.w1k()) + (size_t)l * 2048 * 64;
      tconv_tile(src, 64, p.w1T() + (size_t)kv * 64 * 2048, 2048, 0, kt * 64, [](int n) { return n; }, smem);
    } else {
      const int kv = it - (1856 + 384 + 256 + 16 + 64);
      const float* w1 = (kv ? p.w1v() : p.w1k()) + (size_t)l * 2048 * 64;
      const float* pos = (kv ? p.pos_v() : p.pos_k()) + (size_t)l * 2048;
      float* red = (float*)smem;
      const int e = tid & 63, part = tid >> 6;
      float sa = 0.f, sb = 0.f, sc_ = 0.f, sd = 0.f;
      const float* wq = w1 + (size_t)part * 512 * 64 + e;
      const float* pq = pos + part * 512;
#pragma unroll 4
      for (int f = 0; f < 512; f += 4) {
        sa += pq[f] * wq[(size_t)f * 64];
        sb += pq[f + 1] * wq[(size_t)(f + 1) * 64];
        sc_ += pq[f + 2] * wq[(size_t)(f + 2) * 64];
        sd += pq[f + 3] * wq[(size_t)(f + 3) * 64];
      }
      const float s = (sa + sb) + (sc_ + sd);
      red[tid] = s;
      __syncthreads();
      if (tid < 64) p.posb()[kv * 64 + tid] = red[tid] + red[tid + 64] + red[tid + 128] + red[tid + 192];
      __syncthreads();
    }
  }
}

template <class F>
__device__ __forceinline__ void xcd_schedule(int* q, int xcc, int ngroups, int gsize, char* smem, F f) {
  int* s_item = (int*)(smem + SMEM_BYTES - 16);
#pragma unroll 1
  for (int dy = 0; dy < 8; ++dy) {
    const int y = (xcc + dy) & 7;
    for (;;) {
      if (threadIdx.x == 0) *s_item = atomicAdd(&q[y], 1);
      __syncthreads();
      const int i = *s_item;
      __syncthreads();
      const int grp = (i / gsize) * 8 + y;
      if (grp >= ngroups) break;
      f(grp, i % gsize);
    }
  }
}

__device__ __forceinline__ void phase_inproj(const KP& p, int l, char* smem, int* q, int xcc) {
  const float* bias = p.b_in() + (size_t)l * NIN;
  xcd_schedule(q, xcc, 128, 64, smem, [&](int grp, int within) __attribute__((always_inline)) {
    const int mt = (grp & 15) * 8 + (within & 7), nt = (grp >> 4) * 8 + (within >> 3);
    if (nt >= 58) return;
    const int m0 = mt * 128, n0 = nt * 128;
    const half_t* A = p.xh() + (size_t)m0 * DM;
    const half_t* B = p.winT() + (size_t)n0 * DM;
    int tidx = threadIdx.x;
    asm volatile("" : "+v"(tidx));
    const int lane = tidx & 63, wn = (tidx >> 6) & 1;
    float bv[2];
#pragma unroll
    for (int ni = 0; ni < 2; ++ni) {
      const int oc = orig_col(n0 + wn * 64 + ni * 32 + (lane & 31));
      bv[ni] = oc >= 0 ? bias[oc] : 0.f;
    }
    half_t* vT = (nt == 53) ? p.vsT() : ((nt == 55) ? p.vwT() : nullptr);
    gemm_tile<2>(
        DM, [&](int r, int k) { return *(const uint4*)(A + (size_t)r * DM + k); },
        [&](int r, int k) { return *(const uint4*)(B + (size_t)r * DM + k); },
        [&](int mi, int ni, int r, int row, int col, float v) {
          const half_t hv = (half_t)(v + bv[ni]);
          const int tok = m0 + row;
          p.u()[(size_t)tok * NU + n0 + col] = hv;
          if (vT) {
            const int b = tok >> 13, t = tok & 8191;
            vT[((size_t)(b * 2 + (col >> 6)) * 64 + (col & 63)) * SEQ + t] = hv;
          }
        },
        smem);
  });
}

__device__ __forceinline__ void pool_item(const KP& p, int l, int item, char* smem) {
  const int g = item & 3, mt = item >> 2;
  const int m0 = mt * 128;
  const int wnd = 2 << g;
  const half_t* B = p.poolT() + (size_t)g * 128 * 128;
  int tidx = threadIdx.x;
  asm volatile("" : "+v"(tidx));
  const int lane = tidx & 63, wn = (tidx >> 6) & 1;
  float pb[2], ps[2];
#pragma unroll
  for (int ni = 0; ni < 2; ++ni) {
    const int d = wn * 64 + ni * 32 + (lane & 31);
    pb[ni] = p.pool_b()[(size_t)l * 512 + g * 128 + d];
    ps[ni] = p.pool_scale()[(size_t)l * 512 + g * 128 + d];
  }
  gemm_tile<2>(
      128,
      [&](int r, int k) {
        const int tok = m0 + r, t = tok & 8191;
        const int cnt = min(t + 1, wnd);
        const half_t* base = p.u() + (size_t)tok * NU + C_AX + g * 128 + k;
        float s[8];
#pragma unroll
        for (int j = 0; j < 8; ++j) s[j] = 0.f;
        h8 cur = *(const h8*)base;
        for (int q = 0; q < cnt; ++q) {
          h8 v = *(const h8*)(base - (size_t)q * NU);
#pragma unroll
          for (int j = 0; j < 8; ++j) s[j] += (float)v[j];
        }
        const float inv = 1.f / (float)cnt;
        h8 o;
#pragma unroll
        for (int j = 0; j < 8; ++j) o[j] = (half_t)(s[j] * inv - (float)cur[j]);
        return *(uint4*)&o;
      },
      [&](int r, int k) { return *(const uint4*)(B + (size_t)r * 128 + k); },
      [&](int mi, int ni, int r, int row, int col, float v) {
        const int tok = m0 + row;
        const float z = (float)p.u()[(size_t)tok * NU + C_AZ + g * 128 + col];
        p.ya()[(size_t)tok * 512 + g * 128 + col] = (half_t)((v + pb[ni]) * ps[ni] * siluf_(z));
      },
      smem);
}

__device__ __forceinline__ void compress_item(const KP& p, int l, int item, char* smem) {
  const int mt = item & 3, kv = (item >> 2) & 1, g = (item >> 3) & 1, b = item >> 4;
  int tid = threadIdx.x;
  asm volatile("" : "+v"(tid));
  const int ccol = (kv ? C_CVC : C_CKC) + g * 64;
  const half_t* ub = p.u() + (size_t)b * SEQ * NU + ccol;
  const half_t* B = p.w1T() + (size_t)kv * 64 * 2048;
  float* hid = (float*)(smem + 28672);
  const float* posb = p.posb() + kv * 64;
  gemm_tile<1>(
      2048,
      [&](int r, int k) {
        const int n = mt * 128 + r;
        if (n >= 511) return make_uint4(0, 0, 0, 0);
        const int tok = 16 * n + (k >> 6);
        return *(const uint4*)(ub + (size_t)tok * NU + (k & 63));
      },
      [&](int r, int k) { return *(const uint4*)(B + (size_t)r * 2048 + k); },
      [&](int mi, int ni, int r, int row, int col, float v) { hid[row * 65 + col] = siluf_(v + posb[col]); }, smem);
  __syncthreads();
  float* w2s = (float*)smem;
  const float* w2 = (kv ? p.w2v() : p.w2k()) + (size_t)l * 4096;
  for (int i = tid; i < 4096; i += 256) w2s[i] = w2[i];
  __syncthreads();
  {
    const int n = tid >> 1, fh = (tid & 1) * 32;
    float acc[32];
#pragma unroll
    for (int f = 0; f < 32; ++f) acc[f] = 0.f;
    for (int e = 0; e < 64; ++e) {
      const float hv = hid[n * 65 + e];
#pragma unroll
      for (int f = 0; f < 32; ++f) acc[f] += hv * w2s[e * 64 + fh + f];
    }
    const int ng = mt * 128 + n;
    const bool valid = ng < 511;
    if (kv == 0) {
      half_t* dst = p.kcmp() + ((size_t)(b * 2 + g) * 512 + ng) * 64 + fh;
#pragma unroll
      for (int f = 0; f < 32; ++f) dst[f] = valid ? (half_t)acc[f] : (half_t)0.f;
    } else {
      half_t* dst = p.vcmpT() + ((size_t)(b * 2 + g) * 64 + fh) * 512 + ng;
#pragma unroll
      for (int f = 0; f < 32; ++f) dst[(size_t)f * 512] = valid ? (half_t)acc[f] : (half_t)0.f;
    }
  }
  __syncthreads();
}

#ifndef DSA_CAP
#define DSA_CAP 128
#endif
__device__ __forceinline__ void dsa_item(const KP& p, int b, int tile, char* smem) {
  const int t0 = tile * 16;
  int tid = threadIdx.x;
  asm volatile("" : "+v"(tid));
  const int lane = tid & 63, wid = tid >> 6;
  uint32_t* hist = (uint32_t*)smem;
  unsigned long long* cand = (unsigned long long*)(smem + 16384);
  unsigned short* sel = (unsigned short*)(smem + 32768);
  unsigned long long* pfx = (unsigned long long*)(smem + 40960);
  unsigned long long* tkey = pfx + 16;
  int* need = (int*)(tkey + 16);
  int* state = need + 16;
  int* cnt = state + 16;
  int* ccnt = cnt + 16;
  int* pf16 = ccnt + 16;
  int* ovf = pf16 + 16;
  int* nrem = ovf + 16;
  float* pbuf = (float*)smem + wid * 2048;

  const half_t* ub = p.u() + (size_t)b * SEQ * NU;
  const int mytok = lane & 15, hq = lane >> 4;
  const int myt = t0 + mytok;
  if (tid < 16) {
    const int t = t0 + tid;
    pfx[tid] = 0ull; tkey[tid] = 0ull; need[tid] = 256; state[tid] = (t < 256) ? 0 : 1; cnt[tid] = 0; ccnt[tid] = 0;
    pf16[tid] = 0; ovf[tid] = 0;
  }
  if (tid < 8) nrem[tid] = 0;
  h8 qf[8];
  float iw[8];
  {
    const half_t* qrow = ub + (size_t)myt * NU;
#pragma unroll
    for (int h = 0; h < 8; ++h) qf[h] = *(const h8*)(qrow + C_IQ + h * 32 + hq * 8);
    const h8 w8 = *(const h8*)(qrow + C_IW);
#pragma unroll
    for (int h = 0; h < 8; ++h) iw[h] = (float)w8[h] * 0.0625f;
  }
  __syncthreads();
  const int nkt = (t0 + 16 + 63) >> 6;

  auto loadk = [&](int kt, h8* a) __attribute__((always_inline)) {
#pragma unroll
    for (int i = 0; i < 4; ++i)
      a[i] = *(const h8*)(ub + (size_t)(kt * 64 + i * 16 + (lane & 15)) * NU + C_IK + hq * 8);
  };
  auto scores = [&](const h8* a, float* sc) __attribute__((always_inline)) {
#pragma unroll
    for (int i = 0; i < 4; ++i) {
      f32x4 acc = {0.f, 0.f, 0.f, 0.f};
#pragma unroll
      for (int h = 0; h < 8; ++h) {
        f32x4 d = {0.f, 0.f, 0.f, 0.f};
        d = __builtin_amdgcn_mfma_f32_16x16x32_f16(a[i], qf[h], d, 0, 0, 0);
#pragma unroll
        for (int r = 0; r < 4; ++r) acc[r] += fmaxf(d[r], 0.f) * iw[h];
      }
#pragma unroll
      for (int r = 0; r < 4; ++r) sc[i * 4 + r] = acc[r];
    }
  };
  auto mkkey = [&](float s, int key) __attribute__((always_inline)) -> unsigned long long {
    s = s + 0.f;
    uint32_t u_ = __float_as_uint(s);
    u_ = (u_ & 0x80000000u) ? ~u_ : (u_ | 0x80000000u);
    return ((unsigned long long)u_ << 16) | (unsigned long long)(8191 - key);
  };
  auto run_level = [&](int level) __attribute__((always_inline)) {
    const int shift = 40 - 8 * level;
    for (int i = tid; i < 4096; i += 256) hist[i] = 0u;
    __syncthreads();
    {
      const unsigned long long mypfx = pfx[mytok];
      const bool act = state[mytok] == 1;
      h8 na[4];
      if (wid < nkt) loadk(wid, na);
      for (int kt = wid; kt < nkt; kt += 4) {
        h8 ca[4];
#pragma unroll
        for (int i = 0; i < 4; ++i) ca[i] = na[i];
        loadk(kt + 4 < nkt ? kt + 4 : kt, na);
        float sc[16];
        scores(ca, sc);
        if (act) {
#pragma unroll
          for (int q = 0; q < 16; ++q) {
            const int key = kt * 64 + (q >> 2) * 16 + 4 * hq + (q & 3);
            if (key <= myt) {
              const unsigned long long k48 = mkkey(sc[q], key);
              if (level == 0 || (k48 >> (shift + 8)) == mypfx)
                atomicAdd(&hist[mytok * 256 + (int)((k48 >> shift) & 255ull)], 1u);
            }
          }
        }
      }
    }
    __syncthreads();
    {
      int rem = 0;
      for (int j = 0; j < 4; ++j) {
        const int tk = wid * 4 + j;
        if (state[tk] != 1) continue;
        const uint32_t* hrow = hist + tk * 256;
        const uint4 hv = *(const uint4*)&hrow[252 - 4 * lane];
        const int c = (int)(hv.x + hv.y + hv.z + hv.w);
        int cum = c;
#pragma unroll
        for (int o = 1; o < 64; o <<= 1) {
          int v = __shfl_up(cum, o);
          if (lane >= o) cum += v;
        }
        const int nd = need[tk];
        const unsigned long long mask = __ballot(cum >= nd);
        const int L = mask ? (int)__builtin_ctzll(mask) : 63;
        int running = cum - c, bstar, cb;
        if (running + (int)hv.w >= nd) { bstar = 255 - 4 * lane; cb = hv.w; }
        else {
          running += hv.w;
          if (running + (int)hv.z >= nd) { bstar = 254 - 4 * lane; cb = hv.z; }
          else {
            running += hv.z;
            if (running + (int)hv.y >= nd) { bstar = 253 - 4 * lane; cb = hv.y; }
            else { running += hv.y; bstar = 252 - 4 * lane; cb = hv.x; }
          }
        }
        running = __shfl(running, L); bstar = __shfl(bstar, L); cb = __shfl(cb, L);
        const int nd2 = nd - running;
        const bool fin = (cb == nd2) || (level == 5);
        if (lane == 0) {
          const unsigned long long np = (pfx[tk] << 8) | (unsigned long long)bstar;
          if (fin) { state[tk] = 0; tkey[tk] = np << shift; }
          else { need[tk] = nd2; pfx[tk] = np; }
        }
        if (!fin) rem++;
      }
      if (lane == 0 && rem) atomicAdd(&nrem[level], rem);
    }
    __syncthreads();
  };

  run_level(0);
  run_level(1);
  {
    const int st0 = state[mytok];
    const unsigned long long mytk = tkey[mytok];
    const unsigned long long myp16 = pfx[mytok];
    h8 na[4];
    if (wid < nkt) loadk(wid, na);
    for (int kt = wid; kt < nkt; kt += 4) {
      h8 ca[4];
#pragma unroll
      for (int i = 0; i < 4; ++i) ca[i] = na[i];
      loadk(kt + 4 < nkt ? kt + 4 : kt, na);
      float sc[16];
      scores(ca, sc);
#pragma unroll
      for (int q = 0; q < 16; ++q) {
        const int key = kt * 64 + (q >> 2) * 16 + 4 * hq + (q & 3);
        if (key <= myt) {
          const unsigned long long k48 = mkkey(sc[q], key);
          bool take, isc = false;
          if (st0 == 0) take = k48 >= mytk;
          else {
            const unsigned long long p16 = k48 >> 32;
            take = p16 > myp16;
            isc = p16 == myp16;
          }
          if (take) {
            const int pos = atomicAdd(&cnt[mytok], 1);
            if (pos < 256) sel[mytok * 256 + pos] = (unsigned short)key;
          } else if (isc) {
            const int pos = atomicAdd(&ccnt[mytok], 1);
            if (pos < DSA_CAP) cand[mytok * 128 + pos] = k48;
          }
        }
      }
    }
  }
  __syncthreads();
  {
    int nov = 0;
    for (int j = 0; j < 4; ++j) {
      const int tk = wid * 4 + j;
      if (state[tk] != 1) continue;
      const int nc = ccnt[tk];
      if (nc > DSA_CAP) {
        nov++;
        if (lane == 0) { ovf[tk] = 1; pf16[tk] = (int)pfx[tk]; }
        continue;
      }
      const int nd = need[tk];
      const unsigned long long k0 = (lane < nc) ? cand[tk * 128 + lane] : 0ull;
      const unsigned long long k1 = (lane + 64 < nc) ? cand[tk * 128 + lane + 64] : 0ull;
      int r0 = 0, r1 = 0;
      for (int q = 0; q < nc; ++q) {
        const unsigned long long kq = cand[tk * 128 + q];
        r0 += (kq > k0) ? 1 : 0;
        r1 += (kq > k1) ? 1 : 0;
      }
      if (lane < nc && r0 < nd) {
        const int pos = atomicAdd(&cnt[tk], 1);
        if (pos < 256) sel[tk * 256 + pos] = (unsigned short)(8191 - (int)(k0 & 0xFFFFull));
      }
      if (lane + 64 < nc && r1 < nd) {
        const int pos = atomicAdd(&cnt[tk], 1);
        if (pos < 256) sel[tk * 256 + pos] = (unsigned short)(8191 - (int)(k1 & 0xFFFFull));
      }
      if (lane == 0) state[tk] = 2;
    }
    if (lane == 0 && nov) atomicAdd(&nrem[6], nov);
  }
  __syncthreads();
  if (nrem[6] != 0) {
    for (int level = 2; level < 6; ++level) {
      run_level(level);
      if (nrem[level] == 0) break;
    }
    {
      const bool mine = ovf[mytok] != 0;
      const unsigned long long mytk = tkey[mytok];
      const unsigned long long myp16 = (unsigned long long)(unsigned)pf16[mytok];
      h8 na[4];
      if (wid < nkt) loadk(wid, na);
      for (int kt = wid; kt < nkt; kt += 4) {
        h8 ca[4];
#pragma unroll
        for (int i = 0; i < 4; ++i) ca[i] = na[i];
        loadk(kt + 4 < nkt ? kt + 4 : kt, na);
        float sc[16];
        scores(ca, sc);
        if (mine) {
#pragma unroll
          for (int q = 0; q < 16; ++q) {
            const int key = kt * 64 + (q >> 2) * 16 + 4 * hq + (q & 3);
            if (key <= myt) {
              const unsigned long long k48 = mkkey(sc[q], key);
              if ((k48 >> 32) == myp16 && k48 >= mytk) {
                const int pos = atomicAdd(&cnt[mytok], 1);
                if (pos < 256) sel[mytok * 256 + pos] = (unsigned short)key;
              }
            }
          }
        }
      }
    }
    __syncthreads();
  }
  for (int j = 0; j < 4; ++j) {
    const int tk = wid * 4 + j;
    const int t = t0 + tk;
    const int nsel = min(cnt[tk], 256);
    const half_t* urow = ub + (size_t)t * NU;
    const int col = lane & 15;
    h8 q0, q1;
#pragma unroll
    for (int e = 0; e < 8; ++e) { q0[e] = (half_t)0.f; q1[e] = (half_t)0.f; }
    if (col < 8) {
      q0 = *(const h8*)(urow + C_BQ + col * 64 + hq * 8);
      q1 = *(const h8*)(urow + C_BQ + col * 64 + 32 + hq * 8);
    }
    float mx = NEGF;
#pragma unroll 1
    for (int mg = 0; mg < 2; ++mg) {
#pragma unroll
      for (int mm = 0; mm < 8; ++mm) {
        const int m = mg * 8 + mm;
        const int pos = m * 16 + col;
        const int s = (pos < nsel) ? (int)sel[tk * 256 + pos] : 0;
        const half_t* kp = ub + (size_t)s * NU + C_BK + hq * 8;
        const h8 a0 = *(const h8*)kp, a1 = *(const h8*)(kp + 32);
        f32x4 d = {0.f, 0.f, 0.f, 0.f};
        d = __builtin_amdgcn_mfma_f32_16x16x32_f16(a0, q0, d, 0, 0, 0);
        d = __builtin_amdgcn_mfma_f32_16x16x32_f16(a1, q1, d, 0, 0, 0);
#pragma unroll
        for (int r = 0; r < 4; ++r) {
          const int pp = m * 16 + hq * 4 + r;
          const float v = (pp < nsel) ? d[r] * 0.125f : NEGF;
          mx = fmaxf(mx, v);
          if (col < 8) pbuf[pp * 8 + col] = v;
        }
      }
    }
    mx = fmaxf(mx, __shfl_xor(mx, 16));
    mx = fmaxf(mx, __shfl_xor(mx, 32));
    const float mxh = __shfl(mx, lane & 7);
    __builtin_amdgcn_wave_barrier();
    float sum = 0.f;
#pragma unroll 4
    for (int k = 0; k < 32; ++k) {
      const int i = lane + 64 * k;
      const float v = pbuf[i];
      const float e = (v > -1e29f) ? __expf(v - mxh) : 0.f;
      pbuf[i] = e;
      sum += e;
    }
    sum += __shfl_xor(sum, 8);
    sum += __shfl_xor(sum, 16);
    sum += __shfl_xor(sum, 32);
    const float inv = 1.f / sum;
    __builtin_amdgcn_wave_barrier();
    {
      const int rs = lane >> 3, dc = lane & 7;
      float acc[8][8];
#pragma unroll
      for (int h = 0; h < 8; ++h)
#pragma unroll
        for (int e = 0; e < 8; ++e) acc[h][e] = 0.f;
#pragma unroll 1
      for (int g8 = 0; g8 < 4; ++g8) {
        h8 vv[8];
#pragma unroll
        for (int i = 0; i < 8; ++i) {
          const int pos = (g8 * 8 + i) * 8 + rs;
          const int s = (pos < nsel) ? (int)sel[tk * 256 + pos] : 0;
          vv[i] = *(const h8*)(ub + (size_t)s * NU + C_BV + dc * 8);
        }
#pragma unroll
        for (int i = 0; i < 8; ++i) {
          const int pos = (g8 * 8 + i) * 8 + rs;
          const f32x4 pa = *(const f32x4*)&pbuf[pos * 8];
          const f32x4 pb = *(const f32x4*)&pbuf[pos * 8 + 4];
          float vf[8];
#pragma unroll
          for (int e = 0; e < 8; ++e) vf[e] = (float)vv[i][e];
#pragma unroll
          for (int e = 0; e < 8; ++e) {
            acc[0][e] += pa[0] * vf[e]; acc[1][e] += pa[1] * vf[e]; acc[2][e] += pa[2] * vf[e]; acc[3][e] += pa[3] * vf[e];
            acc[4][e] += pb[0] * vf[e]; acc[5][e] += pb[1] * vf[e]; acc[6][e] += pb[2] * vf[e]; acc[7][e] += pb[3] * vf[e];
          }
        }
      }
      half_t* yrow = p.yb() + (size_t)(b * SEQ + t) * 512;
#pragma unroll
      for (int h = 0; h < 8; ++h) {
        const float invh = __shfl(inv, h);
        h8 ov;
        const h8 z8 = *(const h8*)(urow + C_BZ + h * 64 + dc * 8);
#pragma unroll
        for (int e = 0; e < 8; ++e) {
          float a = acc[h][e];
          a += __shfl_xor(a, 8);
          a += __shfl_xor(a, 16);
          a += __shfl_xor(a, 32);
          ov[e] = (half_t)(a * invh * siluf_((float)z8[e]));
        }
        if (rs == h) *(h8*)(yrow + h * 64 + dc * 8) = ov;
      }
    }
    __builtin_amdgcn_wave_barrier();
  }
  __syncthreads();
}

__device__ __forceinline__ void phase2(const KP& p, int l, char* smem, int* q, int xcc) {
  xcd_schedule(q, xcc, 32, 1, smem, [&](int grp, int) __attribute__((always_inline)) { compress_item(p, l, grp, smem); });
  xcd_schedule(q + 8, xcc, 1024, 1, smem, [&](int grp, int) __attribute__((always_inline)) {
    const int y = grp & 7, k = grp >> 3;
    dsa_item(p, y & 1, 511 - (k * 4 + (y >> 1)), smem);
  });
  xcd_schedule(q + 16, xcc, 512, 1, smem, [&](int grp, int) __attribute__((always_inline)) { pool_item(p, l, grp, smem); });
}

struct DState {
  float m, l;
  f32x16 o[2];
};
__device__ __forceinline__ void ds_reset(DState& st) {
  st.m = NEGF; st.l = 0.f;
#pragma unroll
  for (int dt = 0; dt < 2; ++dt)
#pragma unroll
    for (int r = 0; r < 16; ++r) st.o[dt][r] = 0.f;
}
typedef unsigned int u32x4 __attribute__((ext_vector_type(4)));
typedef unsigned int u32x2 __attribute__((ext_vector_type(2)));
struct StageRegs {
  u32x4 k0, k1, v0, v1;
};
template <bool HASV>
__device__ __forceinline__ void load_stage(StageRegs& r, const half_t* __restrict__ Kb, int ldk,
                                           const half_t* __restrict__ VT, int ldv, int key0, int tid) {
  const int row = tid >> 3, c = tid & 7;
  r.k0 = *(const u32x4*)(Kb + (size_t)(key0 + row) * ldk + c * 8);
  r.k1 = *(const u32x4*)(Kb + (size_t)(key0 + row + 32) * ldk + c * 8);
  if (HASV) {
    r.v0 = *(const u32x4*)(VT + (size_t)row * ldv + key0 + c * 8);
    r.v1 = *(const u32x4*)(VT + (size_t)(row + 32) * ldv + key0 + c * 8);
  }
}
template <bool HASV>
__device__ __forceinline__ void write_stage(const StageRegs& r, half_t* Ks, half_t* Vs, int tid) {
  const int row = tid >> 3, c = tid & 7;
  *(u32x4*)&Ks[row * 72 + c * 8] = r.k0;
  *(u32x4*)&Ks[(row + 32) * 72 + c * 8] = r.k1;
  if (HASV) {
    const int ks = c >> 1, a = c & 1;
    u32x2 lo, hi;
    lo[0] = r.v0[0]; lo[1] = r.v0[1]; hi[0] = r.v0[2]; hi[1] = r.v0[3];
    *(u32x2*)&Vs[row * 72 + ks * 16 + a * 4] = lo;
    *(u32x2*)&Vs[row * 72 + ks * 16 + 8 + a * 4] = hi;
    lo[0] = r.v1[0]; lo[1] = r.v1[1]; hi[0] = r.v1[2]; hi[1] = r.v1[3];
    *(u32x2*)&Vs[(row + 32) * 72 + ks * 16 + a * 4] = lo;
    *(u32x2*)&Vs[(row + 32) * 72 + ks * 16 + 8 + a * 4] = hi;
  }
}
template <bool ONLINE, bool HASV, class VF>
__device__ __forceinline__ void dense_block(DState& st, const half_t* Ks, const half_t* Vs, const h8* qf, int key0,
                                            int flag, VF valid, float fixed_m, float fixed_invl, f32x16* pout,
                                            int lane) {
  const int h = lane >> 5, c = lane & 31;
  f32x16 s[2];
#pragma unroll
  for (int kt = 0; kt < 2; ++kt) {
#pragma unroll
    for (int r = 0; r < 16; ++r) s[kt][r] = 0.f;
#pragma unroll
    for (int ks = 0; ks < 4; ++ks) {
      const h8 a = *(const h8*)&Ks[(32 * kt + c) * 72 + 16 * ks + 8 * h];
      s[kt] = __builtin_amdgcn_mfma_f32_32x32x16_f16(a, qf[ks], s[kt], 0, 0, 0);
    }
  }
  float cm = NEGF;
#pragma unroll
  for (int kt = 0; kt < 2; ++kt)
#pragma unroll
    for (int r = 0; r < 16; ++r) {
      const int key = key0 + 32 * kt + (r & 3) + 8 * (r >> 2) + 4 * h;
      const float v = valid(key, flag) ? s[kt][r] : NEGF;
      s[kt][r] = v;
      cm = fmaxf(cm, v);
    }
  float mnew;
  if (ONLINE) {
    cm = fmaxf(cm, __shfl_xor(cm, 32));
    mnew = fmaxf(st.m, cm);
    const float alpha = __expf(st.m - mnew);
    st.m = mnew;
    st.l *= alpha;
    if (HASV) {
#pragma unroll
      for (int dt = 0; dt < 2; ++dt)
#pragma unroll
        for (int r = 0; r < 16; ++r) st.o[dt][r] *= alpha;
    }
  } else {
    mnew = fixed_m;
  }
  float ps = 0.f;
#pragma unroll
  for (int kt = 0; kt < 2; ++kt)
#pragma unroll
    for (int r = 0; r < 16; ++r) {
      float e = (s[kt][r] > -1e29f) ? __expf(s[kt][r] - mnew) : 0.f;
      if (!ONLINE) e *= fixed_invl;
      s[kt][r] = e;
      ps += e;
    }
  st.l += ps;
  if (pout) { pout[0] = s[0]; pout[1] = s[1]; }
  if (HASV) {
#pragma unroll
    for (int ks = 0; ks < 4; ++ks) {
      h8 pf;
#pragma unroll
      for (int jj = 0; jj < 8; ++jj) pf[jj] = (half_t)s[ks >> 1][8 * (ks & 1) + jj];
#pragma unroll
      for (int dt = 0; dt < 2; ++dt) {
        const h8 vf = *(const h8*)&Vs[(32 * dt + c) * 72 + 16 * ks + 8 * h];
        st.o[dt] = __builtin_amdgcn_mfma_f32_32x32x16_f16(vf, pf, st.o[dt], 0, 0, 0);
      }
    }
  }
}
template <bool ONLINE, bool HASV, bool WANTP, class PRE, class VF, class PO>
__device__ __forceinline__ void run_dense(DState& st, const half_t* __restrict__ Kb, int ldk,
                                          const half_t* __restrict__ VT, int ldv, int blk_lo, int blk_hi, const h8* qf,
                                          PRE pre, VF valid, float fixed_m, float fixed_invl, PO post, char* smem,
                                          int tid) {
  half_t* Ks = (half_t*)smem;
  half_t* Vs = Ks + 64 * 72;
  const int lane = tid & 63;
  StageRegs sr;
  load_stage<HASV>(sr, Kb, ldk, VT, ldv, blk_lo * 64, tid);
  for (int blk = blk_lo; blk <= blk_hi; ++blk) {
    __syncthreads();
    write_stage<HASV>(sr, Ks, Vs, tid);
    __syncthreads();
    const int nb = blk < blk_hi ? blk + 1 : blk;
    load_stage<HASV>(sr, Kb, ldk, VT, ldv, nb * 64, tid);
    const int flag = pre(blk);
    if (__ballot(flag != 0) != 0ull) {
      f32x16 pp[2];
      dense_block<ONLINE, HASV>(st, Ks, Vs, qf, blk * 64, flag, valid, fixed_m, fixed_invl,
                                WANTP ? pp : (f32x16*)nullptr, lane);
      if (WANTP) post(blk * 64, pp);
    }
  }
}

__device__ __forceinline__ void nsa_item(const KP& p, int b, int g, int tile, char* smem) {
  int tid = threadIdx.x;
  asm volatile("" : "+v"(tid));
  const int lane = tid & 63, wid = tid >> 6;
  const int t0 = tile * 32;
  const int tw0 = t0 + 8 * wid;
  const int col = lane & 31, h = lane >> 5;
  const int j = col >> 2, r4 = col & 3;
  const int tj = tw0 + j;
  const int head = g * 4 + r4;
  float* impA = (float*)(smem + 18432 + wid * 8320);
  float* impB = impA + 1024;
  unsigned long long* msk = (unsigned long long*)(smem + 18432 + 4 * 8320 + wid * 128);
  const half_t* ub = p.u() + (size_t)b * SEQ * NU;
  const half_t* urow = ub + (size_t)tj * NU;
  h8 qf[4];
#pragma unroll
  for (int ks = 0; ks < 4; ++ks) {
    qf[ks] = *(const h8*)(urow + C_CQ + head * 64 + 16 * ks + 8 * h);
#pragma unroll
    for (int e = 0; e < 8; ++e) qf[ks][e] = qf[ks][e] * (half_t)0.125f;
  }
  float gate[3];
#pragma unroll
  for (int i = 0; i < 3; ++i) gate[i] = sigmoidf_((float)urow[C_CG + head * 3 + i]);
  f32x16 res[2];
#pragma unroll
  for (int dt = 0; dt < 2; ++dt)
#pragma unroll
    for (int r = 0; r < 16; ++r) res[dt][r] = 0.f;
  for (int i = lane; i < 2080; i += 64) impA[i] = 0.f;
  DState st;
  auto nopost = [&](int, f32x16*) __attribute__((always_inline)) {};

  {
    const int nmax_j = (tj >= 31) ? ((tj - 31) >> 4) : -1;
    const int bhi = (t0 >> 4) >> 6;
    const half_t* Kc = p.kcmp() + (size_t)(b * 2 + g) * 512 * 64;
    const half_t* Vc = p.vcmpT() + (size_t)(b * 2 + g) * 64 * 512;
    auto pre = [&](int) __attribute__((always_inline)) { return 1; };
    auto vfn = [&](int n, int) __attribute__((always_inline)) { return n <= nmax_j; };
    ds_reset(st);
    run_dense<true, false, false>(st, Kc, 64, (const half_t*)nullptr, 0, 0, bhi, qf, pre, vfn, 0.f, 0.f, nopost, smem, tid);
    float lt = st.l;
    lt += __shfl_xor(lt, 32);
    const float mfix = st.m;
    const float invl = lt > 0.f ? 1.f / lt : 0.f;
    ds_reset(st);
    auto post = [&](int n0, f32x16* pp) __attribute__((always_inline)) {
#pragma unroll
      for (int kt = 0; kt < 2; ++kt)
#pragma unroll
        for (int qd = 0; qd < 4; ++qd) {
          float a = pp[kt][4 * qd] + pp[kt][4 * qd + 1] + pp[kt][4 * qd + 2] + pp[kt][4 * qd + 3];
          float bb = pp[kt][4 * qd + 3];
          a += __shfl_xor(a, 1); a += __shfl_xor(a, 2);
          bb += __shfl_xor(bb, 1); bb += __shfl_xor(bb, 2);
          if (r4 == 0) {
            const int sblk = (n0 >> 2) + 8 * kt + 2 * qd + h;
            impA[j * 128 + sblk] = a;
            impB[j * 132 + sblk + 1] = bb;
          }
        }
    };
    run_dense<false, true, true>(st, Kc, 64, Vc, 512, 0, bhi, qf, pre, vfn, mfix, invl, post, smem, tid);
#pragma unroll
    for (int dt = 0; dt < 2; ++dt)
#pragma unroll
      for (int r = 0; r < 16; ++r) res[dt][r] += gate[0] * st.o[dt][r];
  }
  __builtin_amdgcn_wave_barrier();
#pragma unroll 1
  for (int jj = 0; jj < 8; ++jj) {
    const int t = tw0 + jj;
    const int blk = t >> 6;
    uint32_t k0, k1;
    {
      const int s0 = lane, s1 = lane + 64;
      const float i0 = impA[jj * 128 + s0] + impB[jj * 132 + s0];
      const float i1 = impA[jj * 128 + s1] + impB[jj * 132 + s1];
      auto mk = [&](float im, int s) __attribute__((always_inline)) -> uint32_t {
        if (s > blk) return 0u;
        uint32_t kk = ((__float_as_uint(im) >> 1) & ~127u) | (uint32_t)(127 - s) | 0x40000000u;
        if (s == 0 || s == blk || s == blk - 1) kk |= 0x80000000u;
        return kk;
      };
      k0 = mk(i0, s0); k1 = mk(i1, s1);
    }
    unsigned long long lo = 0ull, hi = 0ull;
    for (int it = 0; it < 16; ++it) {
      uint32_t mxk = k0 > k1 ? k0 : k1;
#pragma unroll
      for (int o = 32; o > 0; o >>= 1) {
        const uint32_t ov = (uint32_t)__shfl_xor((int)mxk, o);
        mxk = ov > mxk ? ov : mxk;
      }
      mxk = (uint32_t)__builtin_amdgcn_readfirstlane((int)mxk);
      if (mxk == 0u) break;
      const int s = 127 - (int)(mxk & 127u);
      if (s < 64) lo |= 1ull << s; else hi |= 1ull << (s - 64);
      if (s == lane) k0 = 0u;
      if (s == lane + 64) k1 = 0u;
    }
    if (lane == 0) { msk[jj * 2] = lo; msk[jj * 2 + 1] = hi; }
  }
  __builtin_amdgcn_wave_barrier();
  const unsigned long long mylo = msk[j * 2], myhi = msk[j * 2 + 1];
  {
    const half_t* Ksel = ub + C_CKS + g * 64;
    const half_t* Vsel = p.vsT() + (size_t)(b * 2 + g) * 64 * SEQ;
    auto pre = [&](int blk) __attribute__((always_inline)) {
      const unsigned long long mm_ = (blk < 64) ? mylo : myhi;
      return (int)((mm_ >> (blk & 63)) & 1ull);
    };
    auto vfn = [&](int key, int flag) __attribute__((always_inline)) { return flag != 0 && key <= tj; };
    ds_reset(st);
    run_dense<true, true, false>(st, Ksel, NU, Vsel, SEQ, 0, (t0 + 31) >> 6, qf, pre, vfn, 0.f, 0.f, nopost, smem, tid);
    float lt = st.l;
    lt += __shfl_xor(lt, 32);
    const float sc = lt > 0.f ? gate[1] / lt : 0.f;
#pragma unroll
    for (int dt = 0; dt < 2; ++dt)
#pragma unroll
      for (int r = 0; r < 16; ++r) res[dt][r] += sc * st.o[dt][r];
  }
  {
    const half_t* Kw = ub + C_CKW + g * 64;
    const half_t* Vw = p.vwT() + (size_t)(b * 2 + g) * 64 * SEQ;
    auto pre = [&](int blk) __attribute__((always_inline)) {
      return (int)((blk * 64 <= tj) && (blk * 64 + 63 > tj - 512));
    };
    auto vfn = [&](int key, int) __attribute__((always_inline)) { return key <= tj && key > tj - 512; };
    ds_reset(st);
    run_dense<true, true, false>(st, Kw, NU, Vw, SEQ, max(0, t0 - 511) >> 6, (t0 + 31) >> 6, qf, pre, vfn, 0.f, 0.f,
                                 nopost, smem, tid);
    float lt = st.l;
    lt += __shfl_xor(lt, 32);
    const float sc = lt > 0.f ? gate[2] / lt : 0.f;
#pragma unroll
    for (int dt = 0; dt < 2; ++dt)
#pragma unroll
      for (int r = 0; r < 16; ++r) res[dt][r] += sc * st.o[dt][r];
  }
  half_t* yrow = p.yc() + (size_t)(b * SEQ + tj) * 512 + head * 64;
#pragma unroll
  for (int dt = 0; dt < 2; ++dt)
#pragma unroll
    for (int qd = 0; qd < 4; ++qd) {
      const int d = 32 * dt + 8 * qd + 4 * h;
      const h4 z = *(const h4*)(urow + C_CZ + head * 64 + d);
      h4 ov;
#pragma unroll
      for (int e = 0; e < 4; ++e) ov[e] = (half_t)(res[dt][4 * qd + e] * siluf_((float)z[e]));
      *(h4*)(yrow + d) = ov;
    }
  __syncthreads();
}

__device__ __forceinline__ void phase_nsa(const KP& p, char* smem, int* q, int xcc) {
  xcd_schedule(q, xcc, 1024, 1, smem, [&](int grp, int) __attribute__((always_inline)) {
    const int y = grp & 7, k = grp >> 3;
    const int b = y & 1, g = (y >> 1) & 1, tile = 255 - (k * 2 + (y >> 2));
    nsa_item(p, b, g, tile, smem);
  });
}

__device__ __forceinline__ void phase_merge(const KP& p, char* smem, int* q, int xcc) {
  xcd_schedule(q, xcc, 32, 64, smem, [&](int grp, int within) __attribute__((always_inline)) {
    const int mt = (grp & 15) * 8 + (within & 7), nt = (grp >> 4) * 8 + (within >> 3);
    const int m0 = mt * 128, n0 = nt * 64;
    f32x16 tot[2];
#pragma unroll
    for (int i = 0; i < 2; ++i)
#pragma unroll
      for (int r = 0; r < 16; ++r) tot[i][r] = 0.f;
#pragma unroll
    for (int br = 0; br < 3; ++br) {
      const half_t* A = (br == 0 ? p.ya() : (br == 1 ? p.yb() : p.yc())) + (size_t)m0 * 512;
      const half_t* B = p.wpT() + (size_t)br * DM * 512 + (size_t)n0 * 512;
      gemm_tile<1>(
          512, [&](int r, int k) { return *(const uint4*)(A + (size_t)r * 512 + k); },
          [&](int r, int k) { return *(const uint4*)(B + (size_t)r * 512 + k); },
          [&](int mi, int ni, int r, int row, int col, float v) {
            const float gz = (float)p.u()[(size_t)(m0 + row) * NU + C_GM + br * 1024 + n0 + col];
            tot[mi][r] += sigmoidf_(gz) * v;
          },
          smem);
    }
    int tidx = threadIdx.x;
    asm volatile("" : "+v"(tidx));
    const int lane = tidx & 63, wid = tidx >> 6, wm = wid >> 1, wn = wid & 1;
#pragma unroll
    for (int mi = 0; mi < 2; ++mi)
#pragma unroll
      for (int r = 0; r < 16; ++r) {
        const int row = wm * 64 + mi * 32 + (r & 3) + 8 * (r >> 2) + 4 * (lane >> 5);
        const int col = wn * 32 + (lane & 31);
        p.mm()[(size_t)(m0 + row) * DM + n0 + col] = (half_t)tot[mi][r];
      }
  });
}

__device__ __forceinline__ void phase_outproj(const KP& p, char* smem, int* q, int xcc) {
  xcd_schedule(q, xcc, 16, 64, smem, [&](int grp, int within) __attribute__((always_inline)) {
    const int mt = (grp & 15) * 8 + (within & 7), nt = (within >> 3);
    const int m0 = mt * 128, n0 = nt * 128;
    const half_t* A = p.mm() + (size_t)m0 * DM;
    const half_t* B = p.woT() + (size_t)n0 * DM;
    gemm_tile<2>(
        DM, [&](int r, int k) { return *(const uint4*)(A + (size_t)r * DM + k); },
        [&](int r, int k) { return *(const uint4*)(B + (size_t)r * DM + k); },
        [&](int mi, int ni, int r, int row, int col, float v) {
          const size_t xi = (size_t)(m0 + row) * DM + n0 + col;
          ((float*)p.u())[xi] = ALPHA_F * p.xr()[xi] + v;
        },
        smem);
  });
}


#define XB_TMO      128
#define XB_XCNT(j)  (256  + 64 * (j))
#define XB_XSUB(j)  (1280 + 64 * (j))
#define XB_XGEN(j)  (2304 + 64 * (j))
#define XB_TOP      3328
#define XB_TOPGEN   3392
#define XCD_BAR_WORDS 3456
#define XB_SPIN_CAP (1u << 20)
#define LAS __attribute__((address_space(3)))
__device__ __forceinline__ unsigned xb_ld(unsigned* p)              { return __hip_atomic_load(p, __ATOMIC_RELAXED, __HIP_MEMORY_SCOPE_AGENT); }
__device__ __forceinline__ unsigned xb_add(unsigned* p, unsigned v) { return __hip_atomic_fetch_add(p, v, __ATOMIC_RELAXED, __HIP_MEMORY_SCOPE_AGENT); }
__device__ __forceinline__ unsigned xb_xcc_id() { return (unsigned)__builtin_amdgcn_s_getreg((3 << 11) | 20) & 0xFu; }
#define XB_SPIN(cond, bar) do { unsigned _sp = 0; while (cond) { __builtin_amdgcn_s_sleep(1); \
    if ((++_sp & 255u) == 0u) { if (xb_ld(&(bar)[XB_TMO])) break; if (_sp > XB_SPIN_CAP) { atomicAdd(&(bar)[XB_TMO], 1u); break; } } } } while (0)
struct XcdBarrier { unsigned* bar; unsigned x; volatile LAS unsigned* st; };
__device__ __forceinline__ XcdBarrier xcd_barrier_post(unsigned* bar, volatile LAS unsigned* st) {
  XcdBarrier b; b.bar = bar; b.x = xb_xcc_id(); b.st = st;
  if (threadIdx.x == 0) (void)xb_add(&bar[XB_XCNT(b.x)], 1u);
  return b;
}
__device__ __forceinline__ void xcd_barrier_complete(unsigned* bar, unsigned x, unsigned& nloc, unsigned& nx) {
  const unsigned G = gridDim.x * gridDim.y * gridDim.z;
  unsigned sum, cnt, mine, sp = 0u;
  for (;;) {
    sum = 0u; cnt = 0u; mine = 0u;
#pragma unroll
    for (unsigned j = 0; j < 16; ++j) { const unsigned c = xb_ld(&bar[XB_XCNT(j)]); sum += c; cnt += (c > 0u) ? 1u : 0u; mine = (j == x) ? c : mine; }
    if (sum == G) break;
    __builtin_amdgcn_s_sleep(1);
    if ((++sp & 255u) == 0u) { if (xb_ld(&bar[XB_TMO])) break; if (sp > XB_SPIN_CAP) { atomicAdd(&bar[XB_TMO], 1u); break; } }
  }
  nloc = mine > 0u ? mine : 1u; nx = cnt > 0u ? cnt : 1u;
}
__device__ __forceinline__ void xcd_barrier(const XcdBarrier& b) {
  asm volatile("s_waitcnt vmcnt(0)" ::: "memory");
  __syncthreads();
  if (threadIdx.x == 0) {
    unsigned* bar = b.bar;
    __builtin_amdgcn_s_waitcnt(0);
    unsigned nloc = b.st[0], nx = b.st[1];
    if (nloc == 0u) { xcd_barrier_complete(bar, b.x, nloc, nx); b.st[0] = nloc; b.st[1] = nx; }
    const unsigned old = xb_add(&bar[XB_XSUB(b.x)], 1u);
    const unsigned gen = old / nloc;
    if (old + 1u == (gen + 1u) * nloc) {
      __builtin_amdgcn_fence(__ATOMIC_RELEASE, "agent");
      asm volatile("s_waitcnt vmcnt(0)" ::: "memory");
      const unsigned og = xb_add(&bar[XB_TOP], 1u);
      const unsigned tg = og / nx;
      if (og + 1u == (tg + 1u) * nx) xb_add(&bar[XB_TOPGEN], 1u);
      else XB_SPIN(xb_ld(&bar[XB_TOPGEN]) == tg, bar);
      __builtin_amdgcn_fence(__ATOMIC_ACQUIRE, "agent");
      xb_add(&bar[XB_XGEN(b.x)], 1u);
      asm volatile("s_waitcnt vmcnt(0)" ::: "memory");
    } else {
      XB_SPIN(xb_ld(&bar[XB_XGEN(b.x)]) == gen, bar);
      __builtin_amdgcn_fence(__ATOMIC_ACQUIRE, "agent");
      asm volatile("s_waitcnt vmcnt(0)" ::: "memory");
    }
  }
  __syncthreads();
}

#define NQ_WORDS 4096
__global__ void __launch_bounds__(256, 2) fwd_megakernel(Params p_unused) {
  cg::grid_group grid = cg::this_grid();
  __shared__ __attribute__((aligned(16))) char smem[SMEM_BYTES];
  volatile LAS unsigned* st = (volatile LAS unsigned*)(smem + SMEM_BYTES - 32);
  if (threadIdx.x == 0) { st[0] = 0u; st[1] = 0u; }
  {
    const KP p = get_params();
    if (blockIdx.x == 0)
      for (int i = threadIdx.x; i < NQ_WORDS + XCD_BAR_WORDS; i += 256) p.counters()[i] = 0;
    ln_rows(p, -1, false);
    prep_weights(p, 0, smem);
  }
  grid.sync();
  XcdBarrier xb;
  {
    const KP p = get_params();
    xb = xcd_barrier_post((unsigned*)p.counters() + NQ_WORDS, st);
  }
  const int xcc = (int)(xb.x & 7u);
#ifndef REP1
#define REP1 1
#define REP2 1
#define REP3 1
#define REP4 1
#endif
#ifndef REP5
#define REP5 1
#define REP6 1
#define REP7 0
#endif
#pragma unroll 1
  for (int l = 0; l < DEPTH; ++l) {
#define QPTR(ph, rep) (p.counters() + ((l * 6 + (ph)) * 4 + (rep)) * 32)
    for (int rep = 0; rep < REP1; ++rep) { const KP p = get_params(); phase_inproj(p, l, smem, QPTR(0, rep), xcc); }
    xcd_barrier(xb);
    for (int rep = 0; rep < REP2; ++rep) { const KP p = get_params(); phase2(p, l, smem, QPTR(1, rep), xcc); }
    xcd_barrier(xb);
    for (int rep = 0; rep < REP3; ++rep) { const KP p = get_params(); phase_nsa(p, smem, QPTR(2, rep), xcc); }
    xcd_barrier(xb);
    for (int rep = 0; rep < REP4; ++rep) { const KP p = get_params(); phase_merge(p, smem, QPTR(3, rep), xcc); }
    xcd_barrier(xb);
    for (int rep = 0; rep < REP5; ++rep) { const KP p = get_params(); phase_outproj(p, smem, QPTR(4, rep), xcc); }
    xcd_barrier(xb);
    for (int rep = 0; rep < REP6; ++rep) {
      const KP p = get_params();
      if (l + 1 < DEPTH) {
        ln_rows(p, l, false);
        prep_weights(p, l + 1, smem);
      } else {
        ln_rows(p, l, true);
      }
    }
    if (l + 1 < DEPTH) xcd_barrier(xb);
    for (int rep = 0; rep < REP7; ++rep) xcd_barrier(xb);
  }
}

extern "C" void kernel_launch(void* const* d_in, const int* in_sizes, int n_in, void* d_out, int out_size,
                              void* d_ws, size_t ws_size, hipStream_t stream) {
  static int grid_blocks = 0;
  if (!grid_blocks) {
    int dev = 0, cus = 0, per_cu = 0;
    (void)hipGetDevice(&dev);
    (void)hipDeviceGetAttribute(&cus, hipDeviceAttributeMultiprocessorCount, dev);
    (void)hipOccupancyMaxActiveBlocksPerMultiprocessor(&per_cu, fwd_megakernel, 256, 0);
    if (per_cu > 2) per_cu = 2;
    if (per_cu < 1) per_cu = 1;
    grid_blocks = cus * per_cu;
  }
  Params p{};
  p.x = (const float*)d_in[0]; p.w_in = (const float*)d_in[1]; p.b_in = (const float*)d_in[2];
  p.pool_w = (const float*)d_in[3]; p.pool_b = (const float*)d_in[4]; p.pool_scale = (const float*)d_in[5];
  p.pos_k = (const float*)d_in[6]; p.pos_v = (const float*)d_in[7]; p.w1k = (const float*)d_in[8];
  p.w2k = (const float*)d_in[9]; p.w1v = (const float*)d_in[10]; p.w2v = (const float*)d_in[11];
  p.wpa = (const float*)d_in[12]; p.wpb = (const float*)d_in[13]; p.wpc = (const float*)d_in[14];
  p.wo = (const float*)d_in[15]; p.ln_g = (const float*)d_in[16]; p.ln_b = (const float*)d_in[17];
  p.out = (float*)d_out;
  p.ws = (char*)d_ws;
  if (WS_TOTAL > ws_size) { fprintf(stderr, "workspace too small: need %zu have %zu\n", (size_t)WS_TOTAL, ws_size); return; }
  void* args[] = {&p};
  hipError_t e = hipLaunchCooperativeKernel((void*)fwd_megakernel, dim3(grid_blocks), dim3(256), args, 0, stream);
  if (e != hipSuccess) fprintf(stderr, "cooperative launch failed: %s (grid %d)\n", hipGetErrorString(e), grid_blocks);
}
```

```cpp
#include <hip/hip_runtime.h>
#include <hip/hip_cooperative_groups.h>
#include <cstdio>
#include <cstdint>
namespace cg = cooperative_groups;

typedef _Float16 half_t;
typedef _Float16 h8 __attribute__((ext_vector_type(8)));
typedef _Float16 h4 __attribute__((ext_vector_type(4)));
typedef float f32x4 __attribute__((ext_vector_type(4)));
typedef float f32x16 __attribute__((ext_vector_type(16)));

#define SEQ 8192
#define DM 1024
#define NTOK 16384
#define DEPTH 4
#define NIN 7360
#define NU 7424
#define ALPHA_F 1.681792830507429f
#define NEGF (-1e30f)

#define C_AX 0
#define C_AZ 512
#define C_BQ 1024
#define C_BZ 1536
#define C_CQ 2048
#define C_CZ 2560
#define C_GM 3072
#define C_IQ 6144
#define C_CKC 6400
#define C_CVC 6528
#define C_CKS 6656
#define C_CVS 6784
#define C_CKW 6912
#define C_CVW 7040
#define C_BK 7168
#define C_BV 7232
#define C_IK 7296
#define C_IW 7328
#define C_CG 7336

#define SMEM_BYTES 69632

constexpr size_t OFF_xr = 0;
constexpr size_t OFF_xh = OFF_xr + (((size_t)NTOK*DM*4 + 255) & ~(size_t)255);
constexpr size_t OFF_u = OFF_xh + (((size_t)NTOK*DM*2 + 255) & ~(size_t)255);
constexpr size_t OFF_winT = OFF_u + (((size_t)NTOK*NU*2 + 255) & ~(size_t)255);
constexpr size_t OFF_wpT = OFF_winT + (((size_t)NU*DM*2 + 255) & ~(size_t)255);
constexpr size_t OFF_woT = OFF_wpT + (((size_t)3*DM*512*2 + 255) & ~(size_t)255);
constexpr size_t OFF_poolT = OFF_woT + (((size_t)DM*DM*2 + 255) & ~(size_t)255);
constexpr size_t OFF_w1T = OFF_poolT + (((size_t)4*128*128*2 + 255) & ~(size_t)255);
constexpr size_t OFF_posb = OFF_w1T + (((size_t)2*64*2048*2 + 255) & ~(size_t)255);
constexpr size_t OFF_vsT = OFF_posb + (((size_t)512 + 255) & ~(size_t)255);
constexpr size_t OFF_vwT = OFF_vsT + (((size_t)4*64*SEQ*2 + 255) & ~(size_t)255);
constexpr size_t OFF_kcmp = OFF_vwT + (((size_t)4*64*SEQ*2 + 255) & ~(size_t)255);
constexpr size_t OFF_vcmpT = OFF_kcmp + (((size_t)4*512*64*2 + 255) & ~(size_t)255);
constexpr size_t OFF_ya = OFF_vcmpT + (((size_t)4*64*512*2 + 255) & ~(size_t)255);
constexpr size_t OFF_yb = OFF_ya + (((size_t)NTOK*512*2 + 255) & ~(size_t)255);
constexpr size_t OFF_yc = OFF_yb + (((size_t)NTOK*512*2 + 255) & ~(size_t)255);
constexpr size_t OFF_mm = OFF_yc + (((size_t)NTOK*512*2 + 255) & ~(size_t)255);
constexpr size_t OFF_counters = OFF_mm + (((size_t)NTOK*DM*2 + 255) & ~(size_t)255);
constexpr size_t WS_TOTAL = OFF_counters + (((size_t)32768 + 255) & ~(size_t)255);
struct Params {
  const float* x; const float* w_in; const float* b_in; const float* pool_w; const float* pool_b;
  const float* pool_scale; const float* pos_k; const float* pos_v; const float* w1k; const float* w2k;
  const float* w1v; const float* w2v; const float* wpa; const float* wpb; const float* wpc;
  const float* wo; const float* ln_g; const float* ln_b;
  float* out;
  char* ws;
};
typedef const __attribute__((address_space(4))) unsigned long long* kargp_t;
struct KP {
  kargp_t kp;
  __device__ __forceinline__ const float* x() const { return (const float*)(const __attribute__((address_space(1))) float*)kp[0]; }
  __device__ __forceinline__ const float* w_in() const { return (const float*)(const __attribute__((address_space(1))) float*)kp[1]; }
  __device__ __forceinline__ const float* b_in() const { return (const float*)(const __attribute__((address_space(1))) float*)kp[2]; }
  __device__ __forceinline__ const float* pool_w() const { return (const float*)(const __attribute__((address_space(1))) float*)kp[3]; }
  __device__ __forceinline__ const float* pool_b() const { return (const float*)(const __attribute__((address_space(1))) float*)kp[4]; }
  __device__ __forceinline__ const float* pool_scale() const { return (const float*)(const __attribute__((address_space(1))) float*)kp[5]; }
  __device__ __forceinline__ const float* pos_k() const { return (const float*)(const __attribute__((address_space(1))) float*)kp[6]; }
  __device__ __forceinline__ const float* pos_v() const { return (const float*)(const __attribute__((address_space(1))) float*)kp[7]; }
  __device__ __forceinline__ const float* w1k() const { return (const float*)(const __attribute__((address_space(1))) float*)kp[8]; }
  __device__ __forceinline__ const float* w2k() const { return (const float*)(const __attribute__((address_space(1))) float*)kp[9]; }
  __device__ __forceinline__ const float* w1v() const { return (const float*)(const __attribute__((address_space(1))) float*)kp[10]; }
  __device__ __forceinline__ const float* w2v() const { return (const float*)(const __attribute__((address_space(1))) float*)kp[11]; }
  __device__ __forceinline__ const float* wpa() const { return (const float*)(const __attribute__((address_space(1))) float*)kp[12]; }
  __device__ __forceinline__ const float* wpb() const { return (const float*)(const __attribute__((address_space(1))) float*)kp[13]; }
  __device__ __forceinline__ const float* wpc() const { return (const float*)(const __attribute__((address_space(1))) float*)kp[14]; }
  __device__ __forceinline__ const float* wo() const { return (const float*)(const __attribute__((address_space(1))) float*)kp[15]; }
  __device__ __forceinline__ const float* ln_g() const { return (const float*)(const __attribute__((address_space(1))) float*)kp[16]; }
  __device__ __forceinline__ const float* ln_b() const { return (const float*)(const __attribute__((address_space(1))) float*)kp[17]; }
  __device__ __forceinline__ float* out() const { return (float*)(__attribute__((address_space(1))) float*)kp[18]; }
  __device__ __forceinline__ char* ws() const { return (char*)(__attribute__((address_space(1))) char*)kp[19]; }
  __device__ __forceinline__ float* xr() const { return (float*)(ws() + OFF_xr); }
  __device__ __forceinline__ half_t* xh() const { return (half_t*)(ws() + OFF_xh); }
  __device__ __forceinline__ half_t* u() const { return (half_t*)(ws() + OFF_u); }
  __device__ __forceinline__ half_t* winT() const { return (half_t*)(ws() + OFF_winT); }
  __device__ __forceinline__ half_t* wpT() const { return (half_t*)(ws() + OFF_wpT); }
  __device__ __forceinline__ half_t* woT() const { return (half_t*)(ws() + OFF_woT); }
  __device__ __forceinline__ half_t* poolT() const { return (half_t*)(ws() + OFF_poolT); }
  __device__ __forceinline__ half_t* w1T() const { return (half_t*)(ws() + OFF_w1T); }
  __device__ __forceinline__ float* posb() const { return (float*)(ws() + OFF_posb); }
  __device__ __forceinline__ half_t* vsT() const { return (half_t*)(ws() + OFF_vsT); }
  __device__ __forceinline__ half_t* vwT() const { return (half_t*)(ws() + OFF_vwT); }
  __device__ __forceinline__ half_t* kcmp() const { return (half_t*)(ws() + OFF_kcmp); }
  __device__ __forceinline__ half_t* vcmpT() const { return (half_t*)(ws() + OFF_vcmpT); }
  __device__ __forceinline__ half_t* ya() const { return (half_t*)(ws() + OFF_ya); }
  __device__ __forceinline__ half_t* yb() const { return (half_t*)(ws() + OFF_yb); }
  __device__ __forceinline__ half_t* yc() const { return (half_t*)(ws() + OFF_yc); }
  __device__ __forceinline__ half_t* mm() const { return (half_t*)(ws() + OFF_mm); }
  __device__ __forceinline__ int* counters() const { return (int*)(ws() + OFF_counters); }
};
__device__ __forceinline__ KP get_params() {
  KP q;
  q.kp = (kargp_t)__builtin_amdgcn_kernarg_segment_ptr();
  asm volatile("" : "+s"(q.kp));
  return q;
}


__device__ __forceinline__ int orig_col(int n) {
  if (n < 1536) return n;
  if (n < 2048) return 1664 + (n - 1536);
  if (n < 2560) return 2472 + (n - 2048);
  if (n < 3072) return 3776 + (n - 2560);
  if (n < 6144) return 4288 + (n - 3072);
  if (n < 6400) return 2176 + (n - 6144);
  if (n < 7168) return 2984 + (n - 6400);
  if (n < 7296) return 1536 + (n - 7168);
  if (n < 7328) return 2432 + (n - 7296);
  if (n < 7336) return 2464 + (n - 7328);
  if (n < 7360) return 3752 + (n - 7336);
  return -1;
}

__device__ __forceinline__ float wave_sum(float v) {
#pragma unroll
  for (int o = 32; o > 0; o >>= 1) v += __shfl_xor(v, o);
  return v;
}
__device__ __forceinline__ float sigmoidf_(float x) { return 1.f / (1.f + __expf(-x)); }
__device__ __forceinline__ float siluf_(float x) { return x / (1.f + __expf(-x)); }

template <int NI, class LA, class LB, class EP>
__device__ __forceinline__ void gemm_tile(int K, LA loadA, LB loadB, EP epi, char* smem) {
  constexpr int BN = NI * 64;
  constexpr int NB = BN / 32;
  half_t* sA = (half_t*)smem;
  half_t* sB = sA + 128 * 72;
  int tid = threadIdx.x;
  asm volatile("" : "+v"(tid));
  const int lane = tid & 63, wid = tid >> 6;
  const int wm = wid >> 1, wn = wid & 1;
  f32x16 acc[2][NI];
#pragma unroll
  for (int i = 0; i < 2; ++i)
#pragma unroll
    for (int j = 0; j < NI; ++j)
#pragma unroll
      for (int r = 0; r < 16; ++r) acc[i][j][r] = 0.f;
  const int lr = tid >> 3, lc = (tid & 7) * 8;
  uint4 ra[4], rb[NB];
#pragma unroll
  for (int i = 0; i < 4; ++i) ra[i] = loadA(lr + 32 * i, lc);
#pragma unroll
  for (int i = 0; i < NB; ++i) rb[i] = loadB(lr + 32 * i, lc);
  const int nk = K >> 6;
  for (int kt = 0; kt < nk; ++kt) {
    __syncthreads();
#pragma unroll
    for (int i = 0; i < 4; ++i) *(uint4*)&sA[(lr + 32 * i) * 72 + lc] = ra[i];
#pragma unroll
    for (int i = 0; i < NB; ++i) *(uint4*)&sB[(lr + 32 * i) * 72 + lc] = rb[i];
    __syncthreads();
    if (kt + 1 < nk) {
      const int kk = (kt + 1) * 64 + lc;
#pragma unroll
      for (int i = 0; i < 4; ++i) ra[i] = loadA(lr + 32 * i, kk);
#pragma unroll
      for (int i = 0; i < NB; ++i) rb[i] = loadB(lr + 32 * i, kk);
    }
#pragma unroll
    for (int s = 0; s < 4; ++s) {
      h8 af[2], bf[NI];
#pragma unroll
      for (int mi = 0; mi < 2; ++mi)
        af[mi] = *(const h8*)&sA[(wm * 64 + mi * 32 + (lane & 31)) * 72 + s * 16 + (lane >> 5) * 8];
#pragma unroll
      for (int ni = 0; ni < NI; ++ni)
        bf[ni] = *(const h8*)&sB[(wn * (NI * 32) + ni * 32 + (lane & 31)) * 72 + s * 16 + (lane >> 5) * 8];
#pragma unroll
      for (int mi = 0; mi < 2; ++mi)
#pragma unroll
        for (int ni = 0; ni < NI; ++ni)
          acc[mi][ni] = __builtin_amdgcn_mfma_f32_32x32x16_f16(af[mi], bf[ni], acc[mi][ni], 0, 0, 0);
    }
  }
#pragma unroll
  for (int mi = 0; mi < 2; ++mi)
#pragma unroll
    for (int ni = 0; ni < NI; ++ni)
#pragma unroll
      for (int r = 0; r < 16; ++r) {
        const int row = wm * 64 + mi * 32 + (r & 3) + 8 * (r >> 2) + 4 * (lane >> 5);
        const int col = wn * (NI * 32) + ni * 32 + (lane & 31);
        epi(mi, ni, r, row, col, acc[mi][ni][r]);
      }
}

template <class CM>
__device__ __forceinline__ void tconv_tile(const float* __restrict__ src, int lds_, half_t* __restrict__ dst, int ldd,
                                           int n0, int k0, CM cmap, char* smem) {
  float* t = (float*)smem;
  int tid = threadIdx.x;
  asm volatile("" : "+v"(tid));
  {
    const int n = tid & 63;
    const int c = cmap(n0 + n);
#pragma unroll 4
    for (int i = 0; i < 16; ++i) {
      const int k = (tid >> 6) + 4 * i;
      t[k * 65 + n] = (c >= 0) ? src[(size_t)(k0 + k) * lds_ + c] : 0.f;
    }
  }
  __syncthreads();
#pragma unroll
  for (int i = 0; i < 2; ++i) {
    const int idx = tid + 256 * i;
    const int n = idx >> 3, kc = (idx & 7) * 8;
    h8 v;
#pragma unroll
    for (int j = 0; j < 8; ++j) v[j] = (half_t)t[(kc + j) * 65 + n];
    *(h8*)&dst[(size_t)(n0 + n) * ldd + k0 + kc] = v;
  }
  __syncthreads();
}

__device__ __forceinline__ void ln_rows(const KP& p, int lprev, bool final_) {
  int tid = threadIdx.x;
  asm volatile("" : "+v"(tid));
  const int lane = tid & 63, wid = tid >> 6;
  const int gw = blockIdx.x * 4 + wid, nw = gridDim.x * 4;
  for (int row = gw; row < NTOK; row += nw) {
    const float4* rp = (const float4*)((lprev < 0 ? p.x() : (const float*)p.u()) + (size_t)row * DM);
    float4 v[4];
    float s = 0.f;
#pragma unroll
    for (int i = 0; i < 4; ++i) {
      v[i] = rp[lane + 64 * i];
      s += v[i].x + v[i].y + v[i].z + v[i].w;
    }
    if (lprev >= 0) {
      float mu = wave_sum(s) * (1.f / DM);
      float q = 0.f;
#pragma unroll
      for (int i = 0; i < 4; ++i) {
        float a = v[i].x - mu, b = v[i].y - mu, c = v[i].z - mu, d = v[i].w - mu;
        q += a * a + b * b + c * c + d * d;
      }
      float rstd = rsqrtf(wave_sum(q) * (1.f / DM) + 1e-5f);
      const float4* g4 = (const float4*)(p.ln_g() + lprev * DM);
      const float4* b4 = (const float4*)(p.ln_b() + lprev * DM);
#pragma unroll
      for (int i = 0; i < 4; ++i) {
        float4 g = g4[lane + 64 * i], bb = b4[lane + 64 * i];
        v[i].x = (v[i].x - mu) * rstd * g.x + bb.x;
        v[i].y = (v[i].y - mu) * rstd * g.y + bb.y;
        v[i].z = (v[i].z - mu) * rstd * g.z + bb.z;
        v[i].w = (v[i].w - mu) * rstd * g.w + bb.w;
      }
    }
    if (final_) {
      float4* op = (float4*)(p.out() + (size_t)row * DM);
#pragma unroll
      for (int i = 0; i < 4; ++i) op[lane + 64 * i] = v[i];
    } else {
      float4* op = (float4*)(p.xr() + (size_t)row * DM);
      h4* hp = (h4*)(p.xh() + (size_t)row * DM);
#pragma unroll
      for (int i = 0; i < 4; ++i) {
        op[lane + 64 * i] = v[i];
        h4 hv;
        hv[0] = (half_t)v[i].x; hv[1] = (half_t)v[i].y; hv[2] = (half_t)v[i].z; hv[3] = (half_t)v[i].w;
        hp[lane + 64 * i] = hv;
      }
    }
  }
}

__device__ __forceinline__ void prep_weights(const KP& p, int l, char* smem) {
  int tid = threadIdx.x;
  asm volatile("" : "+v"(tid));
  const int total = 1856 + 384 + 256 + 16 + 64 + 2;
  for (int it = blockIdx.x; it < total; it += gridDim.x) {
    if (it < 1856) {
      const int nt = it >> 4, kt = it & 15;
      tconv_tile(p.w_in() + (size_t)l * DM * NIN, NIN, p.winT(), DM, nt * 64, kt * 64,
                 [](int n) { return orig_col(n); }, smem);
    } else if (it < 1856 + 384) {
      const int j = it - 1856;
      const int w = j >> 7, r = j & 127, nt = r >> 3, kt = r & 7;
      const float* src = (w == 0 ? p.wpa() : (w == 1 ? p.wpb() : p.wpc())) + (size_t)l * 512 * DM;
      tconv_tile(src, DM, p.wpT() + (size_t)w * DM * 512, 512, nt * 64, kt * 64, [](int n) { return n; }, smem);
    } else if (it < 1856 + 384 + 256) {
      const int j = it - 1856 - 384;
      const int nt = j >> 4, kt = j & 15;
      tconv_tile(p.wo() + (size_t)l * DM * DM, DM, p.woT(), DM, nt * 64, kt * 64, [](int n) { return n; }, smem);
    } else if (it < 1856 + 384 + 256 + 16) {
      const int j = it - 1856 - 384 - 256;
      const int g = j >> 2, nt = (j >> 1) & 1, kt = j & 1;
      tconv_tile(p.pool_w() + ((size_t)l * 4 + g) * 128 * 128, 128, p.poolT() + (size_t)g * 128 * 128, 128, nt * 64,
                 kt * 64, [](int n) { return n; }, smem);
    } else if (it < 1856 + 384 + 256 + 16 + 64) {
      const int j = it - 1856 - 384 - 256 - 16;
      const int kv = j >> 5, kt = j & 31;
      const float* src = (kv ? p.w1v() : p.w1k()) + (size_t)l * 2048 * 64;
      tconv_tile(src, 64, p.w1T() + (size_t)kv * 64 * 2048, 2048, 0, kt * 64, [](int n) { return n; }, smem);
    } else {
      const int kv = it - (1856 + 384 + 256 + 16 + 64);
      const float* w1 = (kv ? p.w1v() : p.w1k()) + (size_t)l * 2048 * 64;
      const float* pos = (kv ? p.pos_v() : p.pos_k()) + (size_t)l * 2048;
      float* red = (float*)smem;
      const int e = tid & 63, part = tid >> 6;
      float sa = 0.f, sb = 0.f, sc_ = 0.f, sd = 0.f;
      const float* wq = w1 + (size_t)part * 512 * 64 + e;
      const float* pq = pos + part * 512;
#pragma unroll 4
      for (int f = 0; f < 512; f += 4) {
        sa += pq[f] * wq[(size_t)f * 64];
        sb += pq[f + 1] * wq[(size_t)(f + 1) * 64];
        sc_ += pq[f + 2] * wq[(size_t)(f + 2) * 64];
        sd += pq[f + 3] * wq[(size_t)(f + 3) * 64];
      }
      const float s = (sa + sb) + (sc_ + sd);
      red[tid] = s;
      __syncthreads();
      if (tid < 64) p.posb()[kv * 64 + tid] = red[tid] + red[tid + 64] + red[tid + 128] + red[tid + 192];
      __syncthreads();
    }
  }
}

template <class F>
__device__ __forceinline__ void xcd_schedule(int* q, int xcc, int ngroups, int gsize, char* smem, F f) {
  int* s_item = (int*)(smem + SMEM_BYTES - 16);
#pragma unroll 1
  for (int dy = 0; dy < 8; ++dy) {
    const int y = (xcc + dy) & 7;
    for (;;) {
      if (threadIdx.x == 0) *s_item = atomicAdd(&q[y], 1);
      __syncthreads();
      const int i = *s_item;
      __syncthreads();
      const int grp = (i / gsize) * 8 + y;
      if (grp >= ngroups) break;
      f(grp, i % gsize);
    }
  }
}

__device__ __forceinline__ void phase_inproj(const KP& p, int l, char* smem, int* q, int xcc) {
  const float* bias = p.b_in() + (size_t)l * NIN;
  xcd_schedule(q, xcc, 128, 64, smem, [&](int grp, int within) __attribute__((always_inline)) {
    const int mt = (grp & 15) * 8 + (within & 7), nt = (grp >> 4) * 8 + (within >> 3);
    if (nt >= 58) return;
    const int m0 = mt * 128, n0 = nt * 128;
    const half_t* A = p.xh() + (size_t)m0 * DM;
    const half_t* B = p.winT() + (size_t)n0 * DM;
    int tidx = threadIdx.x;
    asm volatile("" : "+v"(tidx));
    const int lane = tidx & 63, wn = (tidx >> 6) & 1;
    float bv[2];
#pragma unroll
    for (int ni = 0; ni < 2; ++ni) {
      const int oc = orig_col(n0 + wn * 64 + ni * 32 + (lane & 31));
      bv[ni] = oc >= 0 ? bias[oc] : 0.f;
    }
    half_t* vT = (nt == 53) ? p.vsT() : ((nt == 55) ? p.vwT() : nullptr);
    gemm_tile<2>(
        DM, [&](int r, int k) { return *(const uint4*)(A + (size_t)r * DM + k); },
        [&](int r, int k) { return *(const uint4*)(B + (size_t)r * DM + k); },
        [&](int mi, int ni, int r, int row, int col, float v) {
          const half_t hv = (half_t)(v + bv[ni]);
          const int tok = m0 + row;
          p.u()[(size_t)tok * NU + n0 + col] = hv;
          if (vT) {
            const int b = tok >> 13, t = tok & 8191;
            vT[((size_t)(b * 2 + (col >> 6)) * 64 + (col & 63)) * SEQ + t] = hv;
          }
        },
        smem);
  });
}

__device__ __forceinline__ void pool_item(const KP& p, int l, int item, char* smem) {
  const int g = item & 3, mt = item >> 2;
  const int m0 = mt * 128;
  const int wnd = 2 << g;
  const half_t* B = p.poolT() + (size_t)g * 128 * 128;
  int tidx = threadIdx.x;
  asm volatile("" : "+v"(tidx));
  const int lane = tidx & 63, wn = (tidx >> 6) & 1;
  float pb[2], ps[2];
#pragma unroll
  for (int ni = 0; ni < 2; ++ni) {
    const int d = wn * 64 + ni * 32 + (lane & 31);
    pb[ni] = p.pool_b()[(size_t)l * 512 + g * 128 + d];
    ps[ni] = p.pool_scale()[(size_t)l * 512 + g * 128 + d];
  }
  gemm_tile<2>(
      128,
      [&](int r, int k) {
        const int tok = m0 + r, t = tok & 8191;
        const int cnt = min(t + 1, wnd);
        const half_t* base = p.u() + (size_t)tok * NU + C_AX + g * 128 + k;
        float s[8];
#pragma unroll
        for (int j = 0; j < 8; ++j) s[j] = 0.f;
        h8 cur = *(const h8*)base;
        for (int q = 0; q < cnt; ++q) {
          h8 v = *(const h8*)(base - (size_t)q * NU);
#pragma unroll
          for (int j = 0; j < 8; ++j) s[j] += (float)v[j];
        }
        const float inv = 1.f / (float)cnt;
        h8 o;
#pragma unroll
        for (int j = 0; j < 8; ++j) o[j] = (half_t)(s[j] * inv - (float)cur[j]);
        return *(uint4*)&o;
      },
      [&](int r, int k) { return *(const uint4*)(B + (size_t)r * 128 + k); },
      [&](int mi, int ni, int r, int row, int col, float v) {
        const int tok = m0 + row;
        const float z = (float)p.u()[(size_t)tok * NU + C_AZ + g * 128 + col];
        p.ya()[(size_t)tok * 512 + g * 128 + col] = (half_t)((v + pb[ni]) * ps[ni] * siluf_(z));
      },
      smem);
}

__device__ __forceinline__ void compress_item(const KP& p, int l, int item, char* smem) {
  const int mt = item & 3, kv = (item >> 2) & 1, g = (item >> 3) & 1, b = item >> 4;
  int tid = threadIdx.x;
  asm volatile("" : "+v"(tid));
  const int ccol = (kv ? C_CVC : C_CKC) + g * 64;
  const half_t* ub = p.u() + (size_t)b * SEQ * NU + ccol;
  const half_t* B = p.w1T() + (size_t)kv * 64 * 2048;
  float* hid = (float*)(smem + 28672);
  const float* posb = p.posb() + kv * 64;
  gemm_tile<1>(
      2048,
      [&](int r, int k) {
        const int n = mt * 128 + r;
        if (n >= 511) return make_uint4(0, 0, 0, 0);
        const int tok = 16 * n + (k >> 6);
        return *(const uint4*)(ub + (size_t)tok * NU + (k & 63));
      },
      [&](int r, int k) { return *(const uint4*)(B + (size_t)r * 2048 + k); },
      [&](int mi, int ni, int r, int row, int col, float v) { hid[row * 65 + col] = siluf_(v + posb[col]); }, smem);
  __syncthreads();
  float* w2s = (float*)smem;
  const float* w2 = (kv ? p.w2v() : p.w2k()) + (size_t)l * 4096;
  for (int i = tid; i < 4096; i += 256) w2s[i] = w2[i];
  __syncthreads();
  {
    const int n = tid >> 1, fh = (tid & 1) * 32;
    float acc[32];
#pragma unroll
    for (int f = 0; f < 32; ++f) acc[f] = 0.f;
    for (int e = 0; e < 64; ++e) {
      const float hv = hid[n * 65 + e];
#pragma unroll
      for (int f = 0; f < 32; ++f) acc[f] += hv * w2s[e * 64 + fh + f];
    }
    const int ng = mt * 128 + n;
    const bool valid = ng < 511;
    if (kv == 0) {
      half_t* dst = p.kcmp() + ((size_t)(b * 2 + g) * 512 + ng) * 64 + fh;
#pragma unroll
      for (int f = 0; f < 32; ++f) dst[f] = valid ? (half_t)acc[f] : (half_t)0.f;
    } else {
      half_t* dst = p.vcmpT() + ((size_t)(b * 2 + g) * 64 + fh) * 512 + ng;
#pragma unroll
      for (int f = 0; f < 32; ++f) dst[(size_t)f * 512] = valid ? (half_t)acc[f] : (half_t)0.f;
    }
  }
  __syncthreads();
}

#ifndef DSA_CAP
#define DSA_CAP 128
#endif
__device__ __forceinline__ void dsa_item(const KP& p, int b, int tile, char* smem) {
  const int t0 = tile * 16;
  int tid = threadIdx.x;
  asm volatile("" : "+v"(tid));
  const int lane = tid & 63, wid = tid >> 6;
  uint32_t* hist = (uint32_t*)smem;
  unsigned long long* cand = (unsigned long long*)(smem + 16384);
  unsigned short* sel = (unsigned short*)(smem + 32768);
  unsigned long long* pfx = (unsigned long long*)(smem + 40960);
  unsigned long long* tkey = pfx + 16;
  int* need = (int*)(tkey + 16);
  int* state = need + 16;
  int* cnt = state + 16;
  int* ccnt = cnt + 16;
  int* pf16 = ccnt + 16;
  int* ovf = pf16 + 16;
  int* nrem = ovf + 16;
  float* pbuf = (float*)smem + wid * 2048;

  const half_t* ub = p.u() + (size_t)b * SEQ * NU;
  const int mytok = lane & 15, hq = lane >> 4;
  const int myt = t0 + mytok;
  if (tid < 16) {
    const int t = t0 + tid;
    pfx[tid] = 0ull; tkey[tid] = 0ull; need[tid] = 256; state[tid] = (t < 256) ? 0 : 1; cnt[tid] = 0; ccnt[tid] = 0;
    pf16[tid] = 0; ovf[tid] = 0;
  }
  if (tid < 8) nrem[tid] = 0;
  h8 qf[8], qlh, qll;
  float iw[8];
  {
    const half_t* qrow = ub + (size_t)myt * NU;
#pragma unroll
    for (int h = 0; h < 8; ++h) qf[h] = *(const h8*)(qrow + C_IQ + h * 32 + hq * 8);
    const h8 w8 = *(const h8*)(qrow + C_IW);
#pragma unroll
    for (int h = 0; h < 8; ++h) iw[h] = (float)w8[h] * 0.03125f;
#pragma unroll
    for (int e = 0; e < 8; ++e) {
      float a = 0.f;
#pragma unroll
      for (int h = 0; h < 8; ++h) a += iw[h] * (float)qf[h][e];
      const half_t hi = (half_t)a;
      qlh[e] = hi;
      qll[e] = (half_t)(a - (float)hi);
    }
  }
  __syncthreads();
  const int nkt = (t0 + 16 + 31) >> 5;

  auto loadk = [&](int kt, h8* a) __attribute__((always_inline)) {
#pragma unroll
    for (int i = 0; i < 2; ++i)
      a[i] = *(const h8*)(ub + (size_t)(kt * 32 + i * 16 + (lane & 15)) * NU + C_IK + hq * 8);
  };
  auto scores = [&](const h8* a, float* sc) __attribute__((always_inline)) {
#pragma unroll
    for (int i = 0; i < 2; ++i) {
      f32x4 acc = {0.f, 0.f, 0.f, 0.f};
      acc = __builtin_amdgcn_mfma_f32_16x16x32_f16(a[i], qll, acc, 0, 0, 0);
      acc = __builtin_amdgcn_mfma_f32_16x16x32_f16(a[i], qlh, acc, 0, 0, 0);
#pragma unroll
      for (int h = 0; h < 8; ++h) {
        f32x4 d = {0.f, 0.f, 0.f, 0.f};
        d = __builtin_amdgcn_mfma_f32_16x16x32_f16(a[i], qf[h], d, 0, 0, 0);
#pragma unroll
        for (int r = 0; r < 4; ++r) acc[r] = __builtin_fmaf(__builtin_fabsf(d[r]), iw[h], acc[r]);
      }
#pragma unroll
      for (int r = 0; r < 4; ++r) sc[i * 4 + r] = acc[r];
    }
  };
  auto mkkey = [&](float s, int key) __attribute__((always_inline)) -> unsigned long long {
    s = s + 0.f;
    uint32_t u_ = __float_as_uint(s);
    u_ = (u_ & 0x80000000u) ? ~u_ : (u_ | 0x80000000u);
    return ((unsigned long long)u_ << 16) | (unsigned long long)(8191 - key);
  };
  auto run_level = [&](int level) __attribute__((always_inline)) {
    const int shift = 40 - 8 * level;
    for (int i = tid; i < 4096; i += 256) hist[i] = 0u;
    __syncthreads();
    {
      const unsigned long long mypfx = pfx[mytok];
      const bool act = state[mytok] == 1;
      h8 na[2];
      if (wid < nkt) loadk(wid, na);
      for (int kt = wid; kt < nkt; kt += 4) {
        h8 ca[2];
#pragma unroll
        for (int i = 0; i < 2; ++i) ca[i] = na[i];
        loadk(kt + 4 < nkt ? kt + 4 : kt, na);
        float sc[8];
        scores(ca, sc);
        if (act) {
#pragma unroll
          for (int q = 0; q < 8; ++q) {
            const int key = kt * 32 + (q >> 2) * 16 + 4 * hq + (q & 3);
            if (key <= myt) {
              const unsigned long long k48 = mkkey(sc[q], key);
              if (level == 0 || (k48 >> (shift + 8)) == mypfx)
                atomicAdd(&hist[mytok * 256 + (int)((k48 >> shift) & 255ull)], 1u);
            }
          }
        }
      }
    }
    __syncthreads();
    {
      int rem = 0;
      for (int j = 0; j < 4; ++j) {
        const int tk = wid * 4 + j;
        if (state[tk] != 1) continue;
        const uint32_t* hrow = hist + tk * 256;
        const uint4 hv = *(const uint4*)&hrow[252 - 4 * lane];
        const int c = (int)(hv.x + hv.y + hv.z + hv.w);
        int cum = c;
#pragma unroll
        for (int o = 1; o < 64; o <<= 1) {
          int v = __shfl_up(cum, o);
          if (lane >= o) cum += v;
        }
        const int nd = need[tk];
        const unsigned long long mask = __ballot(cum >= nd);
        const int L = mask ? (int)__builtin_ctzll(mask) : 63;
        int running = cum - c, bstar, cb;
        if (running + (int)hv.w >= nd) { bstar = 255 - 4 * lane; cb = hv.w; }
        else {
          running += hv.w;
          if (running + (int)hv.z >= nd) { bstar = 254 - 4 * lane; cb = hv.z; }
          else {
            running += hv.z;
            if (running + (int)hv.y >= nd) { bstar = 253 - 4 * lane; cb = hv.y; }
            else { running += hv.y; bstar = 252 - 4 * lane; cb = hv.x; }
          }
        }
        running = __shfl(running, L); bstar = __shfl(bstar, L); cb = __shfl(cb, L);
        const int nd2 = nd - running;
        const bool fin = (cb == nd2) || (level == 5);
        if (lane == 0) {
          const unsigned long long np = (pfx[tk] << 8) | (unsigned long long)bstar;
          if (fin) { state[tk] = 0; tkey[tk] = np << shift; }
          else { need[tk] = nd2; pfx[tk] = np; }
        }
        if (!fin) rem++;
      }
      if (lane == 0 && rem) atomicAdd(&nrem[level], rem);
    }
    __syncthreads();
  };

  run_level(0);
  run_level(1);
  {
    const int st0 = state[mytok];
    const unsigned long long mytk = tkey[mytok];
    const unsigned long long myp16 = pfx[mytok];
    h8 na[2];
    if (wid < nkt) loadk(wid, na);
    for (int kt = wid; kt < nkt; kt += 4) {
      h8 ca[2];
#pragma unroll
      for (int i = 0; i < 2; ++i) ca[i] = na[i];
      loadk(kt + 4 < nkt ? kt + 4 : kt, na);
      float sc[8];
      scores(ca, sc);
#pragma unroll
      for (int q = 0; q < 8; ++q) {
        const int key = kt * 32 + (q >> 2) * 16 + 4 * hq + (q & 3);
        if (key <= myt) {
          const unsigned long long k48 = mkkey(sc[q], key);
          bool take, isc = false;
          if (st0 == 0) take = k48 >= mytk;
          else {
            const unsigned long long p16 = k48 >> 32;
            take = p16 > myp16;
            isc = p16 == myp16;
          }
          if (take) {
            const int pos = atomicAdd(&cnt[mytok], 1);
            if (pos < 256) sel[mytok * 256 + pos] = (unsigned short)key;
          } else if (isc) {
            const int pos = atomicAdd(&ccnt[mytok], 1);
            if (pos < DSA_CAP) cand[mytok * 128 + pos] = k48;
          }
        }
      }
    }
  }
  __syncthreads();
  {
    int nov = 0;
    for (int j = 0; j < 4; ++j) {
      const int tk = wid * 4 + j;
      if (state[tk] != 1) continue;
      const int nc = ccnt[tk];
      if (nc > DSA_CAP) {
        nov++;
        if (lane == 0) { ovf[tk] = 1; pf16[tk] = (int)pfx[tk]; }
        continue;
      }
      const int nd = need[tk];
      const unsigned long long k0 = (lane < nc) ? cand[tk * 128 + lane] : 0ull;
      const unsigned long long k1 = (lane + 64 < nc) ? cand[tk * 128 + lane + 64] : 0ull;
      int r0 = 0, r1 = 0;
      for (int q = 0; q < nc; ++q) {
        const unsigned long long kq = cand[tk * 128 + q];
        r0 += (kq > k0) ? 1 : 0;
        r1 += (kq > k1) ? 1 : 0;
      }
      if (lane < nc && r0 < nd) {
        const int pos = atomicAdd(&cnt[tk], 1);
        if (pos < 256) sel[tk * 256 + pos] = (unsigned short)(8191 - (int)(k0 & 0xFFFFull));
      }
      if (lane + 64 < nc && r1 < nd) {
        const int pos = atomicAdd(&cnt[tk], 1);
        if (pos < 256) sel[tk * 256 + pos] = (unsigned short)(8191 - (int)(k1 & 0xFFFFull));
      }
      if (lane == 0) state[tk] = 2;
    }
    if (lane == 0 && nov) atomicAdd(&nrem[6], nov);
  }
  __syncthreads();
  if (nrem[6] != 0) {
    for (int level = 2; level < 6; ++level) {
      run_level(level);
      if (nrem[level] == 0) break;
    }
    {
      const bool mine = ovf[mytok] != 0;
      const unsigned long long mytk = tkey[mytok];
      const unsigned long long myp16 = (unsigned long long)(unsigned)pf16[mytok];
      h8 na[2];
      if (wid < nkt) loadk(wid, na);
      for (int kt = wid; kt < nkt; kt += 4) {
        h8 ca[2];
#pragma unroll
        for (int i = 0; i < 2; ++i) ca[i] = na[i];
        loadk(kt + 4 < nkt ? kt + 4 : kt, na);
        float sc[8];
        scores(ca, sc);
        if (mine) {
#pragma unroll
          for (int q = 0; q < 8; ++q) {
            const int key = kt * 32 + (q >> 2) * 16 + 4 * hq + (q & 3);
            if (key <= myt) {
              const unsigned long long k48 = mkkey(sc[q], key);
              if ((k48 >> 32) == myp16 && k48 >= mytk) {
                const int pos = atomicAdd(&cnt[mytok], 1);
                if (pos < 256) sel[mytok * 256 + pos] = (unsigned short)key;
              }
            }
          }
        }
      }
    }
    __syncthreads();
  }
  for (int j = 0; j < 4; ++j) {
    const int tk = wid * 4 + j;
    const int t = t0 + tk;
    const int nsel = min(cnt[tk], 256);
    const half_t* urow = ub + (size_t)t * NU;
    const int col = lane & 15;
    h8 q0, q1;
#pragma unroll
    for (int e = 0; e < 8; ++e) { q0[e] = (half_t)0.f; q1[e] = (half_t)0.f; }
    if (col < 8) {
      q0 = *(const h8*)(urow + C_BQ + col * 64 + hq * 8);
      q1 = *(const h8*)(urow + C_BQ + col * 64 + 32 + hq * 8);
    }
    float mx = NEGF;
#pragma unroll 1
    for (int mg = 0; mg < 2; ++mg) {
#pragma unroll
      for (int mm = 0; mm < 8; ++mm) {
        const int m = mg * 8 + mm;
        const int pos = m * 16 + col;
        const int s = (pos < nsel) ? (int)sel[tk * 256 + pos] : 0;
        const half_t* kp = ub + (size_t)s * NU + C_BK + hq * 8;
        const h8 a0 = *(const h8*)kp, a1 = *(const h8*)(kp + 32);
        f32x4 d = {0.f, 0.f, 0.f, 0.f};
        d = __builtin_amdgcn_mfma_f32_16x16x32_f16(a0, q0, d, 0, 0, 0);
        d = __builtin_amdgcn_mfma_f32_16x16x32_f16(a1, q1, d, 0, 0, 0);
#pragma unroll
        for (int r = 0; r < 4; ++r) {
          const int pp = m * 16 + hq * 4 + r;
          const float v = (pp < nsel) ? d[r] * 0.125f : NEGF;
          mx = fmaxf(mx, v);
          if (col < 8) pbuf[pp * 8 + col] = v;
        }
      }
    }
    mx = fmaxf(mx, __shfl_xor(mx, 16));
    mx = fmaxf(mx, __shfl_xor(mx, 32));
    const float mxh = __shfl(mx, lane & 7);
    __builtin_amdgcn_wave_barrier();
    float sum = 0.f;
#pragma unroll 4
    for (int k = 0; k < 32; ++k) {
      const int i = lane + 64 * k;
      const float v = pbuf[i];
      const float e = (v > -1e29f) ? __expf(v - mxh) : 0.f;
      pbuf[i] = e;
      sum += e;
    }
    sum += __shfl_xor(sum, 8);
    sum += __shfl_xor(sum, 16);
    sum += __shfl_xor(sum, 32);
    const float inv = 1.f / sum;
    __builtin_amdgcn_wave_barrier();
    {
      const int rs = lane >> 3, dc = lane & 7;
      float acc[8][8];
#pragma unroll
      for (int h = 0; h < 8; ++h)
#pragma unroll
        for (int e = 0; e < 8; ++e) acc[h][e] = 0.f;
#pragma unroll 1
      for (int g8 = 0; g8 < 4; ++g8) {
        h8 vv[8];
#pragma unroll
        for (int i = 0; i < 8; ++i) {
          const int pos = (g8 * 8 + i) * 8 + rs;
          const int s = (pos < nsel) ? (int)sel[tk * 256 + pos] : 0;
          vv[i] = *(const h8*)(ub + (size_t)s * NU + C_BV + dc * 8);
        }
#pragma unroll
        for (int i = 0; i < 8; ++i) {
          const int pos = (g8 * 8 + i) * 8 + rs;
          const f32x4 pa = *(const f32x4*)&pbuf[pos * 8];
          const f32x4 pb = *(const f32x4*)&pbuf[pos * 8 + 4];
          float vf[8];
#pragma unroll
          for (int e = 0; e < 8; ++e) vf[e] = (float)vv[i][e];
#pragma unroll
          for (int e = 0; e < 8; ++e) {
            acc[0][e] += pa[0] * vf[e]; acc[1][e] += pa[1] * vf[e]; acc[2][e] += pa[2] * vf[e]; acc[3][e] += pa[3] * vf[e];
            acc[4][e] += pb[0] * vf[e]; acc[5][e] += pb[1] * vf[e]; acc[6][e] += pb[2] * vf[e]; acc[7][e] += pb[3] * vf[e];
          }
        }
      }
      half_t* yrow = p.yb() + (size_t)(b * SEQ + t) * 512;
#pragma unroll
      for (int h = 0; h < 8; ++h) {
        const float invh = __shfl(inv, h);
        h8 ov;
        const h8 z8 = *(const h8*)(urow + C_BZ + h * 64 + dc * 8);
#pragma unroll
        for (int e = 0; e < 8; ++e) {
          float a = acc[h][e];
          a += __shfl_xor(a, 8);
          a += __shfl_xor(a, 16);
          a += __shfl_xor(a, 32);
          ov[e] = (half_t)(a * invh * siluf_((float)z8[e]));
        }
        if (rs == h) *(h8*)(yrow + h * 64 + dc * 8) = ov;
      }
    }
    __builtin_amdgcn_wave_barrier();
  }
  __syncthreads();
}

__device__ __forceinline__ void phase2(const KP& p, int l, char* smem, int* q, int xcc) {
  xcd_schedule(q, xcc, 32, 1, smem, [&](int grp, int) __attribute__((always_inline)) { compress_item(p, l, grp, smem); });
  xcd_schedule(q + 8, xcc, 1024, 1, smem, [&](int grp, int) __attribute__((always_inline)) {
    const int y = grp & 7, k = grp >> 3;
    dsa_item(p, y & 1, 511 - (k * 4 + (y >> 1)), smem);
  });
  xcd_schedule(q + 16, xcc, 512, 1, smem, [&](int grp, int) __attribute__((always_inline)) { pool_item(p, l, grp, smem); });
}

struct DState {
  float m, l;
  f32x16 o[2];
};
#define MLOW (-1e4f)
__device__ __forceinline__ void ds_reset(DState& st) {
  st.m = MLOW; st.l = 0.f;
#pragma unroll
  for (int dt = 0; dt < 2; ++dt)
#pragma unroll
    for (int r = 0; r < 16; ++r) st.o[dt][r] = 0.f;
}
typedef unsigned int u32x4 __attribute__((ext_vector_type(4)));
typedef unsigned int u32x2 __attribute__((ext_vector_type(2)));
struct StageRegs {
  u32x4 k0, k1, v0, v1;
};
template <bool HASV>
__device__ __forceinline__ void load_stage(StageRegs& r, const half_t* __restrict__ Kb, int ldk,
                                           const half_t* __restrict__ VT, int ldv, int key0, int tid) {
  const int row = tid >> 3, c = tid & 7;
  r.k0 = *(const u32x4*)(Kb + (size_t)(key0 + row) * ldk + c * 8);
  r.k1 = *(const u32x4*)(Kb + (size_t)(key0 + row + 32) * ldk + c * 8);
  if (HASV) {
    r.v0 = *(const u32x4*)(VT + (size_t)row * ldv + key0 + c * 8);
    r.v1 = *(const u32x4*)(VT + (size_t)(row + 32) * ldv + key0 + c * 8);
  }
}
template <bool HASV>
__device__ __forceinline__ void write_stage(const StageRegs& r, half_t* Ks, half_t* Vs, int tid) {
  const int row = tid >> 3, c = tid & 7;
  *(u32x4*)&Ks[row * 72 + c * 8] = r.k0;
  *(u32x4*)&Ks[(row + 32) * 72 + c * 8] = r.k1;
  if (HASV) {
    const int ks = c >> 1, a = c & 1;
    u32x2 lo, hi;
    lo[0] = r.v0[0]; lo[1] = r.v0[1]; hi[0] = r.v0[2]; hi[1] = r.v0[3];
    *(u32x2*)&Vs[row * 72 + ks * 16 + a * 4] = lo;
    *(u32x2*)&Vs[row * 72 + ks * 16 + 8 + a * 4] = hi;
    lo[0] = r.v1[0]; lo[1] = r.v1[1]; hi[0] = r.v1[2]; hi[1] = r.v1[3];
    *(u32x2*)&Vs[(row + 32) * 72 + ks * 16 + a * 4] = lo;
    *(u32x2*)&Vs[(row + 32) * 72 + ks * 16 + 8 + a * 4] = hi;
  }
}
template <bool ONLINE, bool HASV, class VF>
__device__ __forceinline__ void dense_block(DState& st, const half_t* Ks, const half_t* Vs, const h8* qf, int key0,
                                            int flag, VF valid, float fixed_m, float fixed_invl, f32x16* pout,
                                            int lane) {
  const int h = lane >> 5, c = lane & 31;
  f32x16 s[2];
#pragma unroll
  for (int kt = 0; kt < 2; ++kt) {
#pragma unroll
    for (int r = 0; r < 16; ++r) s[kt][r] = 0.f;
#pragma unroll
    for (int ks = 0; ks < 4; ++ks) {
      const h8 a = *(const h8*)&Ks[(32 * kt + c) * 72 + 16 * ks + 8 * h];
      s[kt] = __builtin_amdgcn_mfma_f32_32x32x16_f16(a, qf[ks], s[kt], 0, 0, 0);
    }
  }
  float cm = NEGF;
#pragma unroll
  for (int kt = 0; kt < 2; ++kt)
#pragma unroll
    for (int r = 0; r < 16; ++r) {
      const int key = key0 + 32 * kt + (r & 3) + 8 * (r >> 2) + 4 * h;
      const float v = valid(key, flag) ? s[kt][r] : NEGF;
      s[kt][r] = v;
      cm = fmaxf(cm, v);
    }
  float mnew;
  if (ONLINE) {
    cm = fmaxf(cm, __shfl_xor(cm, 32));
    mnew = fmaxf(st.m, cm);
    const float alpha = __builtin_amdgcn_exp2f(st.m - mnew);
    st.m = mnew;
    st.l *= alpha;
    if (HASV) {
#pragma unroll
      for (int dt = 0; dt < 2; ++dt)
#pragma unroll
        for (int r = 0; r < 16; ++r) st.o[dt][r] *= alpha;
    }
  } else {
    mnew = fixed_m;
  }
  float ps = 0.f;
#pragma unroll
  for (int kt = 0; kt < 2; ++kt)
#pragma unroll
    for (int r = 0; r < 16; ++r) {
      float e = __builtin_amdgcn_exp2f(s[kt][r] - mnew);
      if (!ONLINE) e *= fixed_invl;
      s[kt][r] = e;
      ps += e;
    }
  st.l += ps;
  if (pout) { pout[0] = s[0]; pout[1] = s[1]; }
  if (HASV) {
#pragma unroll
    for (int ks = 0; ks < 4; ++ks) {
      h8 pf;
#pragma unroll
      for (int jj = 0; jj < 8; ++jj) pf[jj] = (half_t)s[ks >> 1][8 * (ks & 1) + jj];
#pragma unroll
      for (int dt = 0; dt < 2; ++dt) {
        const h8 vf = *(const h8*)&Vs[(32 * dt + c) * 72 + 16 * ks + 8 * h];
        st.o[dt] = __builtin_amdgcn_mfma_f32_32x32x16_f16(vf, pf, st.o[dt], 0, 0, 0);
      }
    }
  }
}
template <bool ONLINE, bool HASV, bool WANTP, class PRE, class VF, class PO>
__device__ __forceinline__ void run_dense(DState& st, const half_t* __restrict__ Kb, int ldk,
                                          const half_t* __restrict__ VT, int ldv, int blk_lo, int blk_hi, const h8* qf,
                                          PRE pre, VF valid, float fixed_m, float fixed_invl, PO post, char* smem,
                                          int tid) {
  half_t* Ks = (half_t*)smem;
  half_t* Vs = Ks + 64 * 72;
  const int lane = tid & 63;
  StageRegs sr;
  load_stage<HASV>(sr, Kb, ldk, VT, ldv, blk_lo * 64, tid);
  for (int blk = blk_lo; blk <= blk_hi; ++blk) {
    __syncthreads();
    write_stage<HASV>(sr, Ks, Vs, tid);
    __syncthreads();
    const int nb = blk < blk_hi ? blk + 1 : blk;
    load_stage<HASV>(sr, Kb, ldk, VT, ldv, nb * 64, tid);
    const int flag = pre(blk);
    if (__ballot(flag != 0) != 0ull) {
      f32x16 pp[2];
      dense_block<ONLINE, HASV>(st, Ks, Vs, qf, blk * 64, flag, valid, fixed_m, fixed_invl,
                                WANTP ? pp : (f32x16*)nullptr, lane);
      if (WANTP) post(blk * 64, pp);
    }
  }
}

__device__ __forceinline__ void nsa_item(const KP& p, int b, int g, int tile, char* smem) {
  int tid = threadIdx.x;
  asm volatile("" : "+v"(tid));
  const int lane = tid & 63, wid = tid >> 6;
  const int t0 = tile * 32;
  const int tw0 = t0 + 8 * wid;
  const int col = lane & 31, h = lane >> 5;
  const int j = col >> 2, r4 = col & 3;
  const int tj = tw0 + j;
  const int head = g * 4 + r4;
  float* impA = (float*)(smem + 18432 + wid * 8320);
  float* impB = impA + 1024;
  unsigned long long* msk = (unsigned long long*)(smem + 18432 + 4 * 8320 + wid * 128);
  const half_t* ub = p.u() + (size_t)b * SEQ * NU;
  const half_t* urow = ub + (size_t)tj * NU;
  h8 qf[4];
#pragma unroll
  for (int ks = 0; ks < 4; ++ks) {
    qf[ks] = *(const h8*)(urow + C_CQ + head * 64 + 16 * ks + 8 * h);
#pragma unroll
    for (int e = 0; e < 8; ++e) qf[ks][e] = (half_t)((float)qf[ks][e] * 0.18033688f);
  }
  float gate[3];
#pragma unroll
  for (int i = 0; i < 3; ++i) gate[i] = sigmoidf_((float)urow[C_CG + head * 3 + i]);
  f32x16 res[2];
#pragma unroll
  for (int dt = 0; dt < 2; ++dt)
#pragma unroll
    for (int r = 0; r < 16; ++r) res[dt][r] = 0.f;
  for (int i = lane; i < 2080; i += 64) impA[i] = 0.f;
  DState st;
  auto nopost = [&](int, f32x16*) __attribute__((always_inline)) {};

  {
    const int nmax_j = (tj >= 31) ? ((tj - 31) >> 4) : -1;
    const int bhi = (t0 >> 4) >> 6;
    const half_t* Kc = p.kcmp() + (size_t)(b * 2 + g) * 512 * 64;
    const half_t* Vc = p.vcmpT() + (size_t)(b * 2 + g) * 64 * 512;
    auto pre = [&](int) __attribute__((always_inline)) { return 1; };
    auto vfn = [&](int n, int) __attribute__((always_inline)) { return n <= nmax_j; };
    ds_reset(st);
    run_dense<true, false, false>(st, Kc, 64, (const half_t*)nullptr, 0, 0, bhi, qf, pre, vfn, 0.f, 0.f, nopost, smem, tid);
    float lt = st.l;
    lt += __shfl_xor(lt, 32);
    const float mfix = st.m;
    const float invl = lt > 0.f ? 1.f / lt : 0.f;
    ds_reset(st);
    auto post = [&](int n0, f32x16* pp) __attribute__((always_inline)) {
#pragma unroll
      for (int kt = 0; kt < 2; ++kt)
#pragma unroll
        for (int qd = 0; qd < 4; ++qd) {
          float a = pp[kt][4 * qd] + pp[kt][4 * qd + 1] + pp[kt][4 * qd + 2] + pp[kt][4 * qd + 3];
          float bb = pp[kt][4 * qd + 3];
          a += __shfl_xor(a, 1); a += __shfl_xor(a, 2);
          bb += __shfl_xor(bb, 1); bb += __shfl_xor(bb, 2);
          if (r4 == 0) {
            const int sblk = (n0 >> 2) + 8 * kt + 2 * qd + h;
            impA[j * 128 + sblk] = a;
            impB[j * 132 + sblk + 1] = bb;
          }
        }
    };
    run_dense<false, true, true>(st, Kc, 64, Vc, 512, 0, bhi, qf, pre, vfn, mfix, invl, post, smem, tid);
#pragma unroll
    for (int dt = 0; dt < 2; ++dt)
#pragma unroll
      for (int r = 0; r < 16; ++r) res[dt][r] += gate[0] * st.o[dt][r];
  }
  __builtin_amdgcn_wave_barrier();
#pragma unroll 1
  for (int jj = 0; jj < 8; ++jj) {
    const int t = tw0 + jj;
    const int blk = t >> 6;
    uint32_t k0, k1;
    {
      const int s0 = lane, s1 = lane + 64;
      const float i0 = impA[jj * 128 + s0] + impB[jj * 132 + s0];
      const float i1 = impA[jj * 128 + s1] + impB[jj * 132 + s1];
      auto mk = [&](float im, int s) __attribute__((always_inline)) -> uint32_t {
        if (s > blk) return 0u;
        uint32_t kk = ((__float_as_uint(im) >> 1) & ~127u) | (uint32_t)(127 - s) | 0x40000000u;
        if (s == 0 || s == blk || s == blk - 1) kk |= 0x80000000u;
        return kk;
      };
      k0 = mk(i0, s0); k1 = mk(i1, s1);
    }
    unsigned long long lo = 0ull, hi = 0ull;
    for (int it = 0; it < 16; ++it) {
      uint32_t mxk = k0 > k1 ? k0 : k1;
#pragma unroll
      for (int o = 32; o > 0; o >>= 1) {
        const uint32_t ov = (uint32_t)__shfl_xor((int)mxk, o);
        mxk = ov > mxk ? ov : mxk;
      }
      mxk = (uint32_t)__builtin_amdgcn_readfirstlane((int)mxk);
      if (mxk == 0u) break;
      const int s = 127 - (int)(mxk & 127u);
      if (s < 64) lo |= 1ull << s; else hi |= 1ull << (s - 64);
      if (s == lane) k0 = 0u;
      if (s == lane + 64) k1 = 0u;
    }
    if (lane == 0) { msk[jj * 2] = lo; msk[jj * 2 + 1] = hi; }
  }
  __builtin_amdgcn_wave_barrier();
  const unsigned long long mylo = msk[j * 2], myhi = msk[j * 2 + 1];
  {
    const half_t* Ksel = ub + C_CKS + g * 64;
    const half_t* Vsel = p.vsT() + (size_t)(b * 2 + g) * 64 * SEQ;
    auto pre = [&](int blk) __attribute__((always_inline)) {
      const unsigned long long mm_ = (blk < 64) ? mylo : myhi;
      return (int)((mm_ >> (blk & 63)) & 1ull);
    };
    auto vfn = [&](int key, int flag) __attribute__((always_inline)) { return flag != 0 && key <= tj; };
    ds_reset(st);
    run_dense<true, true, false>(st, Ksel, NU, Vsel, SEQ, 0, (t0 + 31) >> 6, qf, pre, vfn, 0.f, 0.f, nopost, smem, tid);
    float lt = st.l;
    lt += __shfl_xor(lt, 32);
    const float sc = lt > 0.f ? gate[1] / lt : 0.f;
#pragma unroll
    for (int dt = 0; dt < 2; ++dt)
#pragma unroll
      for (int r = 0; r < 16; ++r) res[dt][r] += sc * st.o[dt][r];
  }
  {
    const half_t* Kw = ub + C_CKW + g * 64;
    const half_t* Vw = p.vwT() + (size_t)(b * 2 + g) * 64 * SEQ;
    auto pre = [&](int blk) __attribute__((always_inline)) {
      return (int)((blk * 64 <= tj) && (blk * 64 + 63 > tj - 512));
    };
    auto vfn = [&](int key, int) __attribute__((always_inline)) { return key <= tj && key > tj - 512; };
    ds_reset(st);
    run_dense<true, true, false>(st, Kw, NU, Vw, SEQ, max(0, t0 - 511) >> 6, (t0 + 31) >> 6, qf, pre, vfn, 0.f, 0.f,
                                 nopost, smem, tid);
    float lt = st.l;
    lt += __shfl_xor(lt, 32);
    const float sc = lt > 0.f ? gate[2] / lt : 0.f;
#pragma unroll
    for (int dt = 0; dt < 2; ++dt)
#pragma unroll
      for (int r = 0; r < 16; ++r) res[dt][r] += sc * st.o[dt][r];
  }
  half_t* yrow = p.yc() + (size_t)(b * SEQ + tj) * 512 + head * 64;
#pragma unroll
  for (int dt = 0; dt < 2; ++dt)
#pragma unroll
    for (int qd = 0; qd < 4; ++qd) {
      const int d = 32 * dt + 8 * qd + 4 * h;
      const h4 z = *(const h4*)(urow + C_CZ + head * 64 + d);
      h4 ov;
#pragma unroll
      for (int e = 0; e < 4; ++e) ov[e] = (half_t)(res[dt][4 * qd + e] * siluf_((float)z[e]));
      *(h4*)(yrow + d) = ov;
    }
  __syncthreads();
}

__device__ __forceinline__ void phase_nsa(const KP& p, char* smem, int* q, int xcc) {
  xcd_schedule(q, xcc, 1024, 1, smem, [&](int grp, int) __attribute__((always_inline)) {
    const int y = grp & 7, k = grp >> 3;
    const int b = y & 1, g = (y >> 1) & 1, tile = 255 - (k * 2 + (y >> 2));
    nsa_item(p, b, g, tile, smem);
  });
}

__device__ __forceinline__ void phase_merge(const KP& p, char* smem, int* q, int xcc) {
  xcd_schedule(q, xcc, 32, 64, smem, [&](int grp, int within) __attribute__((always_inline)) {
    const int mt = (grp & 15) * 8 + (within & 7), nt = (grp >> 4) * 8 + (within >> 3);
    const int m0 = mt * 128, n0 = nt * 64;
    f32x16 tot[2];
#pragma unroll
    for (int i = 0; i < 2; ++i)
#pragma unroll
      for (int r = 0; r < 16; ++r) tot[i][r] = 0.f;
#pragma unroll
    for (int br = 0; br < 3; ++br) {
      const half_t* A = (br == 0 ? p.ya() : (br == 1 ? p.yb() : p.yc())) + (size_t)m0 * 512;
      const half_t* B = p.wpT() + (size_t)br * DM * 512 + (size_t)n0 * 512;
      gemm_tile<1>(
          512, [&](int r, int k) { return *(const uint4*)(A + (size_t)r * 512 + k); },
          [&](int r, int k) { return *(const uint4*)(B + (size_t)r * 512 + k); },
          [&](int mi, int ni, int r, int row, int col, float v) {
            const float gz = (float)p.u()[(size_t)(m0 + row) * NU + C_GM + br * 1024 + n0 + col];
            tot[mi][r] += sigmoidf_(gz) * v;
          },
          smem);
    }
    int tidx = threadIdx.x;
    asm volatile("" : "+v"(tidx));
    const int lane = tidx & 63, wid = tidx >> 6, wm = wid >> 1, wn = wid & 1;
#pragma unroll
    for (int mi = 0; mi < 2; ++mi)
#pragma unroll
      for (int r = 0; r < 16; ++r) {
        const int row = wm * 64 + mi * 32 + (r & 3) + 8 * (r >> 2) + 4 * (lane >> 5);
        const int col = wn * 32 + (lane & 31);
        p.mm()[(size_t)(m0 + row) * DM + n0 + col] = (half_t)tot[mi][r];
      }
  });
}

__device__ __forceinline__ void phase_outproj(const KP& p, char* smem, int* q, int xcc) {
  xcd_schedule(q, xcc, 16, 64, smem, [&](int grp, int within) __attribute__((always_inline)) {
    const int mt = (grp & 15) * 8 + (within & 7), nt = (within >> 3);
    const int m0 = mt * 128, n0 = nt * 128;
    const half_t* A = p.mm() + (size_t)m0 * DM;
    const half_t* B = p.woT() + (size_t)n0 * DM;
    gemm_tile<2>(
        DM, [&](int r, int k) { return *(const uint4*)(A + (size_t)r * DM + k); },
        [&](int r, int k) { return *(const uint4*)(B + (size_t)r * DM + k); },
        [&](int mi, int ni, int r, int row, int col, float v) {
          const size_t xi = (size_t)(m0 + row) * DM + n0 + col;
          ((float*)p.u())[xi] = ALPHA_F * p.xr()[xi] + v;
        },
        smem);
  });
}


#define XB_TMO      128
#define XB_XCNT(j)  (256  + 64 * (j))
#define XB_XSUB(j)  (1280 + 64 * (j))
#define XB_XGEN(j)  (2304 + 64 * (j))
#define XB_TOP      3328
#define XB_TOPGEN   3392
#define XCD_BAR_WORDS 3456
#define XB_SPIN_CAP (1u << 20)
#define LAS __attribute__((address_space(3)))
__device__ __forceinline__ unsigned xb_ld(unsigned* p)              { return __hip_atomic_load(p, __ATOMIC_RELAXED, __HIP_MEMORY_SCOPE_AGENT); }
__device__ __forceinline__ unsigned xb_add(unsigned* p, unsigned v) { return __hip_atomic_fetch_add(p, v, __ATOMIC_RELAXED, __HIP_MEMORY_SCOPE_AGENT); }
__device__ __forceinline__ unsigned xb_xcc_id() { return (unsigned)__builtin_amdgcn_s_getreg((3 << 11) | 20) & 0xFu; }
#define XB_SPIN(cond, bar) do { unsigned _sp = 0; while (cond) { __builtin_amdgcn_s_sleep(1); \
    if ((++_sp & 255u) == 0u) { if (xb_ld(&(bar)[XB_TMO])) break; if (_sp > XB_SPIN_CAP) { atomicAdd(&(bar)[XB_TMO], 1u); break; } } } } while (0)
struct XcdBarrier { unsigned* bar; unsigned x; volatile LAS unsigned* st; };
__device__ __forceinline__ XcdBarrier xcd_barrier_post(unsigned* bar, volatile LAS unsigned* st) {
  XcdBarrier b; b.bar = bar; b.x = xb_xcc_id(); b.st = st;
  if (threadIdx.x == 0) (void)xb_add(&bar[XB_XCNT(b.x)], 1u);
  return b;
}
__device__ __forceinline__ void xcd_barrier_complete(unsigned* bar, unsigned x, unsigned& nloc, unsigned& nx) {
  const unsigned G = gridDim.x * gridDim.y * gridDim.z;
  unsigned sum, cnt, mine, sp = 0u;
  for (;;) {
    sum = 0u; cnt = 0u; mine = 0u;
#pragma unroll
    for (unsigned j = 0; j < 16; ++j) { const unsigned c = xb_ld(&bar[XB_XCNT(j)]); sum += c; cnt += (c > 0u) ? 1u : 0u; mine = (j == x) ? c : mine; }
    if (sum == G) break;
    __builtin_amdgcn_s_sleep(1);
    if ((++sp & 255u) == 0u) { if (xb_ld(&bar[XB_TMO])) break; if (sp > XB_SPIN_CAP) { atomicAdd(&bar[XB_TMO], 1u); break; } }
  }
  nloc = mine > 0u ? mine : 1u; nx = cnt > 0u ? cnt : 1u;
}
__device__ __forceinline__ void xcd_barrier(const XcdBarrier& b) {
  asm volatile("s_waitcnt vmcnt(0)" ::: "memory");
  __syncthreads();
  if (threadIdx.x == 0) {
    unsigned* bar = b.bar;
    __builtin_amdgcn_s_waitcnt(0);
    unsigned nloc = b.st[0], nx = b.st[1];
    if (nloc == 0u) { xcd_barrier_complete(bar, b.x, nloc, nx); b.st[0] = nloc; b.st[1] = nx; }
    const unsigned old = xb_add(&bar[XB_XSUB(b.x)], 1u);
    const unsigned gen = old / nloc;
    if (old + 1u == (gen + 1u) * nloc) {
      __builtin_amdgcn_fence(__ATOMIC_RELEASE, "agent");
      asm volatile("s_waitcnt vmcnt(0)" ::: "memory");
      const unsigned og = xb_add(&bar[XB_TOP], 1u);
      const unsigned tg = og / nx;
      if (og + 1u == (tg + 1u) * nx) xb_add(&bar[XB_TOPGEN], 1u);
      else XB_SPIN(xb_ld(&bar[XB_TOPGEN]) == tg, bar);
      __builtin_amdgcn_fence(__ATOMIC_ACQUIRE, "agent");
      xb_add(&bar[XB_XGEN(b.x)], 1u);
      asm volatile("s_waitcnt vmcnt(0)" ::: "memory");
    } else {
      XB_SPIN(xb_ld(&bar[XB_XGEN(b.x)]) == gen, bar);
      __builtin_amdgcn_fence(__ATOMIC_ACQUIRE, "agent");
      asm volatile("s_waitcnt vmcnt(0)" ::: "memory");
    }
  }
  __syncthreads();
}

#define NQ_WORDS 4096
__global__ void __launch_bounds__(256, 2) fwd_megakernel(Params p_unused) {
  cg::grid_group grid = cg::this_grid();
  __shared__ __attribute__((aligned(16))) char smem[SMEM_BYTES];
  volatile LAS unsigned* st = (volatile LAS unsigned*)(smem + SMEM_BYTES - 32);
  if (threadIdx.x == 0) { st[0] = 0u; st[1] = 0u; }
  {
    const KP p = get_params();
    if (blockIdx.x == 0)
      for (int i = threadIdx.x; i < NQ_WORDS + XCD_BAR_WORDS; i += 256) p.counters()[i] = 0;
    ln_rows(p, -1, false);
    prep_weights(p, 0, smem);
  }
  grid.sync();
  XcdBarrier xb;
  {
    const KP p = get_params();
    xb = xcd_barrier_post((unsigned*)p.counters() + NQ_WORDS, st);
  }
  const int xcc = (int)(xb.x & 7u);
#ifndef REP1
#define REP1 1
#define REP2 1
#define REP3 1
#define REP4 1
#endif
#ifndef REP5
#define REP5 1
#define REP6 1
#define REP7 0
#endif
#pragma unroll 1
  for (int l = 0; l < DEPTH; ++l) {
#define QPTR(ph, rep) (p.counters() + ((l * 6 + (ph)) * 4 + (rep)) * 32)
    for (int rep = 0; rep < REP1; ++rep) { const KP p = get_params(); phase_inproj(p, l, smem, QPTR(0, rep), xcc); }
    xcd_barrier(xb);
    for (int rep = 0; rep < REP2; ++rep) { const KP p = get_params(); phase2(p, l, smem, QPTR(1, rep), xcc); }
    xcd_barrier(xb);
    for (int rep = 0; rep < REP3; ++rep) { const KP p = get_params(); phase_nsa(p, smem, QPTR(2, rep), xcc); }
    xcd_barrier(xb);
    for (int rep = 0; rep < REP4; ++rep) { const KP p = get_params(); phase_merge(p, smem, QPTR(3, rep), xcc); }
    xcd_barrier(xb);
    for (int rep = 0; rep < REP5; ++rep) { const KP p = get_params(); phase_outproj(p, smem, QPTR(4, rep), xcc); }
    xcd_barrier(xb);
    for (int rep = 0; rep < REP6; ++rep) {
      const KP p = get_params();
      if (l + 1 < DEPTH) {
        ln_rows(p, l, false);
        prep_weights(p, l + 1, smem);
      } else {
        ln_rows(p, l, true);
      }
    }
    if (l + 1 < DEPTH) xcd_barrier(xb);
    for (int rep = 0; rep < REP7; ++rep) xcd_barrier(xb);
  }
}

extern "C" void kernel_launch(void* const* d_in, const int* in_sizes, int n_in, void* d_out, int out_size,
                              void* d_ws, size_t ws_size, hipStream_t stream) {
  static int grid_blocks = 0;
  if (!grid_blocks) {
    int dev = 0, cus = 0, per_cu = 0;
    (void)hipGetDevice(&dev);
    (void)hipDeviceGetAttribute(&cus, hipDeviceAttributeMultiprocessorCount, dev);
    (void)hipOccupancyMaxActiveBlocksPerMultiprocessor(&per_cu, fwd_megakernel, 256, 0);
    if (per_cu > 2) per_cu = 2;
    if (per_cu < 1) per_cu = 1;
    grid_blocks = cus * per_cu;
  }
  Params p{};
  p.x = (const float*)d_in[0]; p.w_in = (const float*)d_in[1]; p.b_in = (const float*)d_in[2];
  p.pool_w = (const float*)d_in[3]; p.pool_b = (const float*)d_in[4]; p.pool_scale = (const float*)d_in[5];
  p.pos_k = (const float*)d_in[6]; p.pos_v = (const float*)d_in[7]; p.w1k = (const float*)d_in[8];
  p.w2k = (const float*)d_in[9]; p.w1v = (const float*)d_in[10]; p.w2v = (const float*)d_in[11];
  p.wpa = (const float*)d_in[12]; p.wpb = (const float*)d_in[13]; p.wpc = (const float*)d_in[14];
  p.wo = (const float*)d_in[15]; p.ln_g = (const float*)d_in[16]; p.ln_b = (const float*)d_in[17];
  p.out = (float*)d_out;
  p.ws = (char*)d_ws;
  if (WS_TOTAL > ws_size) { fprintf(stderr, "workspace too small: need %zu have %zu\n", (size_t)WS_TOTAL, ws_size); return; }
  void* args[] = {&p};
  hipError_t e = hipLaunchCooperativeKernel((void*)fwd_megakernel, dim3(grid_blocks), dim3(256), args, 0, stream);
  if (e != hipSuccess) fprintf(stderr, "cooperative launch failed: %s (grid %d)\n", hipGetErrorString(e), grid_blocks);
}
```

```cpp
#include <hip/hip_runtime.h>
#include <hip/hip_cooperative_groups.h>
#include <cstdio>
#include <cstdint>
namespace cg = cooperative_groups;

typedef _Float16 half_t;
typedef _Float16 h8 __attribute__((ext_vector_type(8)));
typedef _Float16 h4 __attribute__((ext_vector_type(4)));
typedef float f32x4 __attribute__((ext_vector_type(4)));
typedef float f32x16 __attribute__((ext_vector_type(16)));

#define SEQ 8192
#define DM 1024
#define NTOK 16384
#define DEPTH 4
#define NIN 7360
#define NU 7424
#define ALPHA_F 1.681792830507429f
#define NEGF (-1e30f)

#define C_AX 0
#define C_AZ 512
#define C_BQ 1024
#define C_BZ 1536
#define C_CQ 2048
#define C_CZ 2560
#define C_GM 3072
#define C_IQ 6144
#define C_CKC 6400
#define C_CVC 6528
#define C_CKS 6656
#define C_CVS 6784
#define C_CKW 6912
#define C_CVW 7040
#define C_BK 7168
#define C_BV 7232
#define C_IK 7296
#define C_IW 7328
#define C_CG 7336

#define SMEM_BYTES 73728

constexpr size_t OFF_xr = 0;
constexpr size_t OFF_xh = OFF_xr + (((size_t)NTOK*DM*4 + 255) & ~(size_t)255);
constexpr size_t OFF_u = OFF_xh + (((size_t)NTOK*DM*2 + 255) & ~(size_t)255);
constexpr size_t OFF_winT = OFF_u + (((size_t)NTOK*NU*2 + 255) & ~(size_t)255);
constexpr size_t OFF_wpT = OFF_winT + (((size_t)NU*DM*2 + 255) & ~(size_t)255);
constexpr size_t OFF_woT = OFF_wpT + (((size_t)3*DM*512*2 + 255) & ~(size_t)255);
constexpr size_t OFF_poolT = OFF_woT + (((size_t)DM*DM*2 + 255) & ~(size_t)255);
constexpr size_t OFF_w1T = OFF_poolT + (((size_t)4*128*128*2 + 255) & ~(size_t)255);
constexpr size_t OFF_posb = OFF_w1T + (((size_t)2*64*2048*2 + 255) & ~(size_t)255);
constexpr size_t OFF_vsT = OFF_posb + (((size_t)512 + 255) & ~(size_t)255);
constexpr size_t OFF_vwT = OFF_vsT + (((size_t)4*64*SEQ*2 + 255) & ~(size_t)255);
constexpr size_t OFF_kcmp = OFF_vwT + (((size_t)4*64*SEQ*2 + 255) & ~(size_t)255);
constexpr size_t OFF_vcmpT = OFF_kcmp + (((size_t)4*512*64*2 + 255) & ~(size_t)255);
constexpr size_t OFF_ya = OFF_vcmpT + (((size_t)4*64*512*2 + 255) & ~(size_t)255);
constexpr size_t OFF_yb = OFF_ya + (((size_t)NTOK*512*2 + 255) & ~(size_t)255);
constexpr size_t OFF_yc = OFF_yb + (((size_t)NTOK*512*2 + 255) & ~(size_t)255);
constexpr size_t OFF_mm = OFF_yc + (((size_t)NTOK*512*2 + 255) & ~(size_t)255);
constexpr size_t OFF_counters = OFF_mm + (((size_t)NTOK*DM*2 + 255) & ~(size_t)255);
constexpr size_t WS_TOTAL = OFF_counters + (((size_t)32768 + 255) & ~(size_t)255);
struct Params {
  const float* x; const float* w_in; const float* b_in; const float* pool_w; const float* pool_b;
  const float* pool_scale; const float* pos_k; const float* pos_v; const float* w1k; const float* w2k;
  const float* w1v; const float* w2v; const float* wpa; const float* wpb; const float* wpc;
  const float* wo; const float* ln_g; const float* ln_b;
  float* out;
  char* ws;
};
typedef const __attribute__((address_space(4))) unsigned long long* kargp_t;
struct KP {
  kargp_t kp;
  __device__ __forceinline__ const float* x() const { return (const float*)(const __attribute__((address_space(1))) float*)kp[0]; }
  __device__ __forceinline__ const float* w_in() const { return (const float*)(const __attribute__((address_space(1))) float*)kp[1]; }
  __device__ __forceinline__ const float* b_in() const { return (const float*)(const __attribute__((address_space(1))) float*)kp[2]; }
  __device__ __forceinline__ const float* pool_w() const { return (const float*)(const __attribute__((address_space(1))) float*)kp[3]; }
  __device__ __forceinline__ const float* pool_b() const { return (const float*)(const __attribute__((address_space(1))) float*)kp[4]; }
  __device__ __forceinline__ const float* pool_scale() const { return (const float*)(const __attribute__((address_space(1))) float*)kp[5]; }
  __device__ __forceinline__ const float* pos_k() const { return (const float*)(const __attribute__((address_space(1))) float*)kp[6]; }
  __device__ __forceinline__ const float* pos_v() const { return (const float*)(const __attribute__((address_space(1))) float*)kp[7]; }
  __device__ __forceinline__ const float* w1k() const { return (const float*)(const __attribute__((address_space(1))) float*)kp[8]; }
  __device__ __forceinline__ const float* w2k() const { return (const float*)(const __attribute__((address_space(1))) float*)kp[9]; }
  __device__ __forceinline__ const float* w1v() const { return (const float*)(const __attribute__((address_space(1))) float*)kp[10]; }
  __device__ __forceinline__ const float* w2v() const { return (const float*)(const __attribute__((address_space(1))) float*)kp[11]; }
  __device__ __forceinline__ const float* wpa() const { return (const float*)(const __attribute__((address_space(1))) float*)kp[12]; }
  __device__ __forceinline__ const float* wpb() const { return (const float*)(const __attribute__((address_space(1))) float*)kp[13]; }
  __device__ __forceinline__ const float* wpc() const { return (const float*)(const __attribute__((address_space(1))) float*)kp[14]; }
  __device__ __forceinline__ const float* wo() const { return (const float*)(const __attribute__((address_space(1))) float*)kp[15]; }
  __device__ __forceinline__ const float* ln_g() const { return (const float*)(const __attribute__((address_space(1))) float*)kp[16]; }
  __device__ __forceinline__ const float* ln_b() const { return (const float*)(const __attribute__((address_space(1))) float*)kp[17]; }
  __device__ __forceinline__ float* out() const { return (float*)(__attribute__((address_space(1))) float*)kp[18]; }
  __device__ __forceinline__ char* ws() const { return (char*)(__attribute__((address_space(1))) char*)kp[19]; }
  __device__ __forceinline__ float* xr() const { return (float*)(ws() + OFF_xr); }
  __device__ __forceinline__ half_t* xh() const { return (half_t*)(ws() + OFF_xh); }
  __device__ __forceinline__ half_t* u() const { return (half_t*)(ws() + OFF_u); }
  __device__ __forceinline__ half_t* winT() const { return (half_t*)(ws() + OFF_winT); }
  __device__ __forceinline__ half_t* wpT() const { return (half_t*)(ws() + OFF_wpT); }
  __device__ __forceinline__ half_t* woT() const { return (half_t*)(ws() + OFF_woT); }
  __device__ __forceinline__ half_t* poolT() const { return (half_t*)(ws() + OFF_poolT); }
  __device__ __forceinline__ half_t* w1T() const { return (half_t*)(ws() + OFF_w1T); }
  __device__ __forceinline__ float* posb() const { return (float*)(ws() + OFF_posb); }
  __device__ __forceinline__ half_t* vsT() const { return (half_t*)(ws() + OFF_vsT); }
  __device__ __forceinline__ half_t* vwT() const { return (half_t*)(ws() + OFF_vwT); }
  __device__ __forceinline__ half_t* kcmp() const { return (half_t*)(ws() + OFF_kcmp); }
  __device__ __forceinline__ half_t* vcmpT() const { return (half_t*)(ws() + OFF_vcmpT); }
  __device__ __forceinline__ half_t* ya() const { return (half_t*)(ws() + OFF_ya); }
  __device__ __forceinline__ half_t* yb() const { return (half_t*)(ws() + OFF_yb); }
  __device__ __forceinline__ half_t* yc() const { return (half_t*)(ws() + OFF_yc); }
  __device__ __forceinline__ half_t* mm() const { return (half_t*)(ws() + OFF_mm); }
  __device__ __forceinline__ int* counters() const { return (int*)(ws() + OFF_counters); }
};
__device__ __forceinline__ KP get_params() {
  KP q;
  q.kp = (kargp_t)__builtin_amdgcn_kernarg_segment_ptr();
  asm volatile("" : "+s"(q.kp));
  return q;
}


__device__ __forceinline__ int orig_col(int n) {
  if (n < 1536) return n;
  if (n < 2048) return 1664 + (n - 1536);
  if (n < 2560) return 2472 + (n - 2048);
  if (n < 3072) return 3776 + (n - 2560);
  if (n < 6144) return 4288 + (n - 3072);
  if (n < 6400) return 2176 + (n - 6144);
  if (n < 7168) return 2984 + (n - 6400);
  if (n < 7296) return 1536 + (n - 7168);
  if (n < 7328) return 2432 + (n - 7296);
  if (n < 7336) return 2464 + (n - 7328);
  if (n < 7360) return 3752 + (n - 7336);
  return -1;
}

__device__ __forceinline__ float wave_sum(float v) {
#pragma unroll
  for (int o = 32; o > 0; o >>= 1) v += __shfl_xor(v, o);
  return v;
}
__device__ __forceinline__ float sigmoidf_(float x) { return 1.f / (1.f + __expf(-x)); }
__device__ __forceinline__ float siluf_(float x) { return x / (1.f + __expf(-x)); }

template <int NI, class LA, class LB, class EP>
__device__ __forceinline__ void gemm_tile(int K, LA loadA, LB loadB, EP epi, char* smem) {
  constexpr int BN = NI * 64;
  constexpr int NB = BN / 32;
  half_t* sA = (half_t*)smem;
  half_t* sB = sA + 128 * 72;
  int tid = threadIdx.x;
  asm volatile("" : "+v"(tid));
  const int lane = tid & 63, wid = tid >> 6;
  const int wm = wid >> 1, wn = wid & 1;
  f32x16 acc[2][NI];
#pragma unroll
  for (int i = 0; i < 2; ++i)
#pragma unroll
    for (int j = 0; j < NI; ++j)
#pragma unroll
      for (int r = 0; r < 16; ++r) acc[i][j][r] = 0.f;
  const int lr = tid >> 3, lc = (tid & 7) * 8;
  uint4 ra[4], rb[NB];
#pragma unroll
  for (int i = 0; i < 4; ++i) ra[i] = loadA(lr + 32 * i, lc);
#pragma unroll
  for (int i = 0; i < NB; ++i) rb[i] = loadB(lr + 32 * i, lc);
  const int nk = K >> 6;
  for (int kt = 0; kt < nk; ++kt) {
    __syncthreads();
#pragma unroll
    for (int i = 0; i < 4; ++i) *(uint4*)&sA[(lr + 32 * i) * 72 + lc] = ra[i];
#pragma unroll
    for (int i = 0; i < NB; ++i) *(uint4*)&sB[(lr + 32 * i) * 72 + lc] = rb[i];
    __syncthreads();
    if (kt + 1 < nk) {
      const int kk = (kt + 1) * 64 + lc;
#pragma unroll
      for (int i = 0; i < 4; ++i) ra[i] = loadA(lr + 32 * i, kk);
#pragma unroll
      for (int i = 0; i < NB; ++i) rb[i] = loadB(lr + 32 * i, kk);
    }
#pragma unroll
    for (int s = 0; s < 4; ++s) {
      h8 af[2], bf[NI];
#pragma unroll
      for (int mi = 0; mi < 2; ++mi)
        af[mi] = *(const h8*)&sA[(wm * 64 + mi * 32 + (lane & 31)) * 72 + s * 16 + (lane >> 5) * 8];
#pragma unroll
      for (int ni = 0; ni < NI; ++ni)
        bf[ni] = *(const h8*)&sB[(wn * (NI * 32) + ni * 32 + (lane & 31)) * 72 + s * 16 + (lane >> 5) * 8];
#pragma unroll
      for (int mi = 0; mi < 2; ++mi)
#pragma unroll
        for (int ni = 0; ni < NI; ++ni)
          acc[mi][ni] = __builtin_amdgcn_mfma_f32_32x32x16_f16(af[mi], bf[ni], acc[mi][ni], 0, 0, 0);
    }
  }
#pragma unroll
  for (int mi = 0; mi < 2; ++mi)
#pragma unroll
    for (int ni = 0; ni < NI; ++ni)
#pragma unroll
      for (int r = 0; r < 16; ++r) {
        const int row = wm * 64 + mi * 32 + (r & 3) + 8 * (r >> 2) + 4 * (lane >> 5);
        const int col = wn * (NI * 32) + ni * 32 + (lane & 31);
        epi(mi, ni, r, row, col, acc[mi][ni][r]);
      }
}

template <class LA, class LB, class EP>
__device__ __forceinline__ void gemm_tile_big(int K, LA loadA, LB loadB, EP epi, char* smem) {
  half_t* sA = (half_t*)smem;
  half_t* sB = sA + 256 * 72;
  int tid = threadIdx.x;
  asm volatile("" : "+v"(tid));
  const int lane = tid & 63, wid = tid >> 6;
  const int wm = wid >> 1, wn = wid & 1;
  f32x16 acc[4][2];
#pragma unroll
  for (int i = 0; i < 4; ++i)
#pragma unroll
    for (int j = 0; j < 2; ++j)
#pragma unroll
      for (int r = 0; r < 16; ++r) acc[i][j][r] = 0.f;
  const int lr = tid >> 3, lc = (tid & 7) * 8;
  uint4 ra[8], rb[4];
#pragma unroll
  for (int i = 0; i < 8; ++i) ra[i] = loadA(lr + 32 * i, lc);
#pragma unroll
  for (int i = 0; i < 4; ++i) rb[i] = loadB(lr + 32 * i, lc);
  const int nk = K >> 6;
  for (int kt = 0; kt < nk; ++kt) {
    __syncthreads();
#pragma unroll
    for (int i = 0; i < 8; ++i) *(uint4*)&sA[(lr + 32 * i) * 72 + lc] = ra[i];
#pragma unroll
    for (int i = 0; i < 4; ++i) *(uint4*)&sB[(lr + 32 * i) * 72 + lc] = rb[i];
    __syncthreads();
    if (kt + 1 < nk) {
      const int kk = (kt + 1) * 64 + lc;
#pragma unroll
      for (int i = 0; i < 8; ++i) ra[i] = loadA(lr + 32 * i, kk);
#pragma unroll
      for (int i = 0; i < 4; ++i) rb[i] = loadB(lr + 32 * i, kk);
    }
#pragma unroll
    for (int s = 0; s < 4; ++s) {
      h8 af[4], bf[2];
#pragma unroll
      for (int mi = 0; mi < 4; ++mi)
        af[mi] = *(const h8*)&sA[(wm * 128 + mi * 32 + (lane & 31)) * 72 + s * 16 + (lane >> 5) * 8];
#pragma unroll
      for (int ni = 0; ni < 2; ++ni)
        bf[ni] = *(const h8*)&sB[(wn * 64 + ni * 32 + (lane & 31)) * 72 + s * 16 + (lane >> 5) * 8];
#pragma unroll
      for (int mi = 0; mi < 4; ++mi)
#pragma unroll
        for (int ni = 0; ni < 2; ++ni)
          acc[mi][ni] = __builtin_amdgcn_mfma_f32_32x32x16_f16(af[mi], bf[ni], acc[mi][ni], 0, 0, 0);
    }
  }
#pragma unroll
  for (int mi = 0; mi < 4; ++mi)
#pragma unroll
    for (int ni = 0; ni < 2; ++ni)
#pragma unroll
      for (int r = 0; r < 16; ++r) {
        const int row = wm * 128 + mi * 32 + (r & 3) + 8 * (r >> 2) + 4 * (lane >> 5);
        const int col = wn * 64 + ni * 32 + (lane & 31);
        epi(mi, ni, r, row, col, acc[mi][ni][r]);
      }
}

template <class CM>
__device__ __forceinline__ void tconv_tile(const float* __restrict__ src, int lds_, half_t* __restrict__ dst, int ldd,
                                           int n0, int k0, CM cmap, char* smem) {
  float* t = (float*)smem;
  int tid = threadIdx.x;
  asm volatile("" : "+v"(tid));
  {
    const int n = tid & 63;
    const int c = cmap(n0 + n);
#pragma unroll 4
    for (int i = 0; i < 16; ++i) {
      const int k = (tid >> 6) + 4 * i;
      t[k * 65 + n] = (c >= 0) ? src[(size_t)(k0 + k) * lds_ + c] : 0.f;
    }
  }
  __syncthreads();
#pragma unroll
  for (int i = 0; i < 2; ++i) {
    const int idx = tid + 256 * i;
    const int n = idx >> 3, kc = (idx & 7) * 8;
    h8 v;
#pragma unroll
    for (int j = 0; j < 8; ++j) v[j] = (half_t)t[(kc + j) * 65 + n];
    *(h8*)&dst[(size_t)(n0 + n) * ldd + k0 + kc] = v;
  }
  __syncthreads();
}

__device__ __forceinline__ void ln_rows(const KP& p, int lprev, bool final_) {
  int tid = threadIdx.x;
  asm volatile("" : "+v"(tid));
  const int lane = tid & 63, wid = tid >> 6;
  const int gw = blockIdx.x * 4 + wid, nw = gridDim.x * 4;
  for (int row = gw; row < NTOK; row += nw) {
    const float4* rp = (const float4*)((lprev < 0 ? p.x() : (const float*)p.u()) + (size_t)row * DM);
    float4 v[4];
    float s = 0.f;
#pragma unroll
    for (int i = 0; i < 4; ++i) {
      v[i] = rp[lane + 64 * i];
      s += v[i].x + v[i].y + v[i].z + v[i].w;
    }
    if (lprev >= 0) {
      float mu = wave_sum(s) * (1.f / DM);
      float q = 0.f;
#pragma unroll
      for (int i = 0; i < 4; ++i) {
        float a = v[i].x - mu, b = v[i].y - mu, c = v[i].z - mu, d = v[i].w - mu;
        q += a * a + b * b + c * c + d * d;
      }
      float rstd = rsqrtf(wave_sum(q) * (1.f / DM) + 1e-5f);
      const float4* g4 = (const float4*)(p.ln_g() + lprev * DM);
      const float4* b4 = (const float4*)(p.ln_b() + lprev * DM);
#pragma unroll
      for (int i = 0; i < 4; ++i) {
        float4 g = g4[lane + 64 * i], bb = b4[lane + 64 * i];
        v[i].x = (v[i].x - mu) * rstd * g.x + bb.x;
        v[i].y = (v[i].y - mu) * rstd * g.y + bb.y;
        v[i].z = (v[i].z - mu) * rstd * g.z + bb.z;
        v[i].w = (v[i].w - mu) * rstd * g.w + bb.w;
      }
    }
    if (final_) {
      float4* op = (float4*)(p.out() + (size_t)row * DM);
#pragma unroll
      for (int i = 0; i < 4; ++i) op[lane + 64 * i] = v[i];
    } else {
      float4* op = (float4*)(p.xr() + (size_t)row * DM);
      h4* hp = (h4*)(p.xh() + (size_t)row * DM);
#pragma unroll
      for (int i = 0; i < 4; ++i) {
        op[lane + 64 * i] = v[i];
        h4 hv;
        hv[0] = (half_t)v[i].x; hv[1] = (half_t)v[i].y; hv[2] = (half_t)v[i].z; hv[3] = (half_t)v[i].w;
        hp[lane + 64 * i] = hv;
      }
    }
  }
}

__device__ __forceinline__ void prep_weights(const KP& p, int l, char* smem) {
  int tid = threadIdx.x;
  asm volatile("" : "+v"(tid));
  const int total = 1856 + 384 + 256 + 16 + 64 + 2;
  for (int it = blockIdx.x; it < total; it += gridDim.x) {
    if (it < 1856) {
      const int nt = it >> 4, kt = it & 15;
      tconv_tile(p.w_in() + (size_t)l * DM * NIN, NIN, p.winT(), DM, nt * 64, kt * 64,
                 [](int n) { return orig_col(n); }, smem);
    } else if (it < 1856 + 384) {
      const int j = it - 1856;
      const int w = j >> 7, r = j & 127, nt = r >> 3, kt = r & 7;
      const float* src = (w == 0 ? p.wpa() : (w == 1 ? p.wpb() : p.wpc())) + (size_t)l * 512 * DM;
      tconv_tile(src, DM, p.wpT() + (size_t)w * DM * 512, 512, nt * 64, kt * 64, [](int n) { return n; }, smem);
    } else if (it < 1856 + 384 + 256) {
      const int j = it - 1856 - 384;
      const int nt = j >> 4, kt = j & 15;
      tconv_tile(p.wo() + (size_t)l * DM * DM, DM, p.woT(), DM, nt * 64, kt * 64, [](int n) { return n; }, smem);
    } else if (it < 1856 + 384 + 256 + 16) {
      const int j = it - 1856 - 384 - 256;
      const int g = j >> 2, nt = (j >> 1) & 1, kt = j & 1;
      tconv_tile(p.pool_w() + ((size_t)l * 4 + g) * 128 * 128, 128, p.poolT() + (size_t)g * 128 * 128, 128, nt * 64,
                 kt * 64, [](int n) { return n; }, smem);
    } else if (it < 1856 + 384 + 256 + 16 + 64) {
      const int j = it - 1856 - 384 - 256 - 16;
      const int kv = j >> 5, kt = j & 31;
      const float* src = (kv ? p.w1v() : p.w1k()) + (size_t)l * 2048 * 64;
      tconv_tile(src, 64, p.w1T() + (size_t)kv * 64 * 2048, 2048, 0, kt * 64, [](int n) { return n; }, smem);
    } else {
      const int kv = it - (1856 + 384 + 256 + 16 + 64);
      const float* w1 = (kv ? p.w1v() : p.w1k()) + (size_t)l * 2048 * 64;
      const float* pos = (kv ? p.pos_v() : p.pos_k()) + (size_t)l * 2048;
      float* red = (float*)smem;
      const int e = tid & 63, part = tid >> 6;
      float sa = 0.f, sb = 0.f, sc_ = 0.f, sd = 0.f;
      const float* wq = w1 + (size_t)part * 512 * 64 + e;
      const float* pq = pos + part * 512;
#pragma unroll 4
      for (int f = 0; f < 512; f += 4) {
        sa += pq[f] * wq[(size_t)f * 64];
        sb += pq[f + 1] * wq[(size_t)(f + 1) * 64];
        sc_ += pq[f + 2] * wq[(size_t)(f + 2) * 64];
        sd += pq[f + 3] * wq[(size_t)(f + 3) * 64];
      }
      const float s = (sa + sb) + (sc_ + sd);
      red[tid] = s;
      __syncthreads();
      if (tid < 64) p.posb()[kv * 64 + tid] = red[tid] + red[tid + 64] + red[tid + 128] + red[tid + 192];
      __syncthreads();
    }
  }
}

template <class F>
__device__ __forceinline__ void xcd_schedule(int* q, int xcc, int ngroups, int gsize, char* smem, F f) {
  int* s_item = (int*)(smem + SMEM_BYTES - 16);
#pragma unroll 1
  for (int dy = 0; dy < 8; ++dy) {
    const int y = (xcc + dy) & 7;
    for (;;) {
      if (threadIdx.x == 0) *s_item = atomicAdd(&q[y], 1);
      __syncthreads();
      const int i = *s_item;
      __syncthreads();
      const int grp = (i / gsize) * 8 + y;
      if (grp >= ngroups) break;
      f(grp, i % gsize);
    }
  }
}

__device__ __forceinline__ void phase_inproj(const KP& p, int l, char* smem, int* q, int xcc) {
  const float* bias = p.b_in() + (size_t)l * NIN;
  xcd_schedule(q, xcc, 128, 32, smem, [&](int grp, int within) __attribute__((always_inline)) {
    const int mt = (grp & 15) * 4 + (within & 3), nt = (grp >> 4) * 8 + (within >> 2);
    if (nt >= 58) return;
    const int m0 = mt * 256, n0 = nt * 128;
    const half_t* A = p.xh() + (size_t)m0 * DM;
    const half_t* B = p.winT() + (size_t)n0 * DM;
    int tidx = threadIdx.x;
    asm volatile("" : "+v"(tidx));
    const int lane = tidx & 63, wn = (tidx >> 6) & 1;
    float bv[2];
#pragma unroll
    for (int ni = 0; ni < 2; ++ni) {
      const int oc = orig_col(n0 + wn * 64 + ni * 32 + (lane & 31));
      bv[ni] = oc >= 0 ? bias[oc] : 0.f;
    }
    half_t* vT = (nt == 53) ? p.vsT() : ((nt == 55) ? p.vwT() : nullptr);
    gemm_tile_big(
        DM, [&](int r, int k) { return *(const uint4*)(A + (size_t)r * DM + k); },
        [&](int r, int k) { return *(const uint4*)(B + (size_t)r * DM + k); },
        [&](int mi, int ni, int r, int row, int col, float v) {
          const half_t hv = (half_t)(v + bv[ni]);
          const int tok = m0 + row;
          p.u()[(size_t)tok * NU + n0 + col] = hv;
          if (vT) {
            const int b = tok >> 13, t = tok & 8191;
            vT[((size_t)(b * 2 + (col >> 6)) * 64 + (col & 63)) * SEQ + t] = hv;
          }
        },
        smem);
  });
}

__device__ __forceinline__ void pool_item(const KP& p, int l, int item, char* smem) {
  const int g = item & 3, mt = item >> 2;
  const int m0 = mt * 128;
  const int wnd = 2 << g;
  const half_t* B = p.poolT() + (size_t)g * 128 * 128;
  int tidx = threadIdx.x;
  asm volatile("" : "+v"(tidx));
  const int lane = tidx & 63, wn = (tidx >> 6) & 1;
  float pb[2], ps[2];
#pragma unroll
  for (int ni = 0; ni < 2; ++ni) {
    const int d = wn * 64 + ni * 32 + (lane & 31);
    pb[ni] = p.pool_b()[(size_t)l * 512 + g * 128 + d];
    ps[ni] = p.pool_scale()[(size_t)l * 512 + g * 128 + d];
  }
  gemm_tile<2>(
      128,
      [&](int r, int k) {
        const int tok = m0 + r, t = tok & 8191;
        const int cnt = min(t + 1, wnd);
        const half_t* base = p.u() + (size_t)tok * NU + C_AX + g * 128 + k;
        float s[8];
#pragma unroll
        for (int j = 0; j < 8; ++j) s[j] = 0.f;
        h8 cur = *(const h8*)base;
        for (int q = 0; q < cnt; ++q) {
          h8 v = *(const h8*)(base - (size_t)q * NU);
#pragma unroll
          for (int j = 0; j < 8; ++j) s[j] += (float)v[j];
        }
        const float inv = 1.f / (float)cnt;
        h8 o;
#pragma unroll
        for (int j = 0; j < 8; ++j) o[j] = (half_t)(s[j] * inv - (float)cur[j]);
        return *(uint4*)&o;
      },
      [&](int r, int k) { return *(const uint4*)(B + (size_t)r * 128 + k); },
      [&](int mi, int ni, int r, int row, int col, float v) {
        const int tok = m0 + row;
        const float z = (float)p.u()[(size_t)tok * NU + C_AZ + g * 128 + col];
        p.ya()[(size_t)tok * 512 + g * 128 + col] = (half_t)((v + pb[ni]) * ps[ni] * siluf_(z));
      },
      smem);
}

__device__ __forceinline__ void compress_item(const KP& p, int l, int item, char* smem) {
  const int mt = item & 3, kv = (item >> 2) & 1, g = (item >> 3) & 1, b = item >> 4;
  int tid = threadIdx.x;
  asm volatile("" : "+v"(tid));
  const int ccol = (kv ? C_CVC : C_CKC) + g * 64;
  const half_t* ub = p.u() + (size_t)b * SEQ * NU + ccol;
  const half_t* B = p.w1T() + (size_t)kv * 64 * 2048;
  float* hid = (float*)(smem + 28672);
  const float* posb = p.posb() + kv * 64;
  gemm_tile<1>(
      2048,
      [&](int r, int k) {
        const int n = mt * 128 + r;
        if (n >= 511) return make_uint4(0, 0, 0, 0);
        const int tok = 16 * n + (k >> 6);
        return *(const uint4*)(ub + (size_t)tok * NU + (k & 63));
      },
      [&](int r, int k) { return *(const uint4*)(B + (size_t)r * 2048 + k); },
      [&](int mi, int ni, int r, int row, int col, float v) { hid[row * 65 + col] = siluf_(v + posb[col]); }, smem);
  __syncthreads();
  float* w2s = (float*)smem;
  const float* w2 = (kv ? p.w2v() : p.w2k()) + (size_t)l * 4096;
  for (int i = tid; i < 4096; i += 256) w2s[i] = w2[i];
  __syncthreads();
  {
    const int n = tid >> 1, fh = (tid & 1) * 32;
    float acc[32];
#pragma unroll
    for (int f = 0; f < 32; ++f) acc[f] = 0.f;
    for (int e = 0; e < 64; ++e) {
      const float hv = hid[n * 65 + e];
#pragma unroll
      for (int f = 0; f < 32; ++f) acc[f] += hv * w2s[e * 64 + fh + f];
    }
    const int ng = mt * 128 + n;
    const bool valid = ng < 511;
    if (kv == 0) {
      half_t* dst = p.kcmp() + ((size_t)(b * 2 + g) * 512 + ng) * 64 + fh;
#pragma unroll
      for (int f = 0; f < 32; ++f) dst[f] = valid ? (half_t)acc[f] : (half_t)0.f;
    } else {
      half_t* dst = p.vcmpT() + ((size_t)(b * 2 + g) * 64 + fh) * 512 + ng;
#pragma unroll
      for (int f = 0; f < 32; ++f) dst[(size_t)f * 512] = valid ? (half_t)acc[f] : (half_t)0.f;
    }
  }
  __syncthreads();
}

#ifndef DSA_CAP
#define DSA_CAP 128
#endif
__device__ __forceinline__ void dsa_item(const KP& p, int b, int tile, char* smem) {
  const int t0 = tile * 16;
  int tid = threadIdx.x;
  asm volatile("" : "+v"(tid));
  const int lane = tid & 63, wid = tid >> 6;
  uint32_t* hist = (uint32_t*)smem;
  unsigned long long* cand = (unsigned long long*)(smem + 16384);
  unsigned short* sel = (unsigned short*)(smem + 32768);
  unsigned long long* pfx = (unsigned long long*)(smem + 40960);
  unsigned long long* tkey = pfx + 16;
  int* need = (int*)(tkey + 16);
  int* state = need + 16;
  int* cnt = state + 16;
  int* ccnt = cnt + 16;
  int* pf16 = ccnt + 16;
  int* ovf = pf16 + 16;
  int* nrem = ovf + 16;
  float* pbuf = (float*)smem + wid * 2048;

  const half_t* ub = p.u() + (size_t)b * SEQ * NU;
  const int mytok = lane & 15, hq = lane >> 4;
  const int myt = t0 + mytok;
  if (tid < 16) {
    const int t = t0 + tid;
    pfx[tid] = 0ull; tkey[tid] = 0ull; need[tid] = 256; state[tid] = (t < 256) ? 0 : 1; cnt[tid] = 0; ccnt[tid] = 0;
    pf16[tid] = 0; ovf[tid] = 0;
  }
  if (tid < 8) nrem[tid] = 0;
  h8 qf[8], qlh, qll;
  float iw[8];
  {
    const half_t* qrow = ub + (size_t)myt * NU;
#pragma unroll
    for (int h = 0; h < 8; ++h) qf[h] = *(const h8*)(qrow + C_IQ + h * 32 + hq * 8);
    const h8 w8 = *(const h8*)(qrow + C_IW);
#pragma unroll
    for (int h = 0; h < 8; ++h) iw[h] = (float)w8[h] * 0.03125f;
#pragma unroll
    for (int e = 0; e < 8; ++e) {
      float a = 0.f;
#pragma unroll
      for (int h = 0; h < 8; ++h) a += iw[h] * (float)qf[h][e];
      const half_t hi = (half_t)a;
      qlh[e] = hi;
      qll[e] = (half_t)(a - (float)hi);
    }
  }
  __syncthreads();
  const int nkt = (t0 + 16 + 31) >> 5;

  auto loadk = [&](int kt, h8* a) __attribute__((always_inline)) {
#pragma unroll
    for (int i = 0; i < 2; ++i)
      a[i] = *(const h8*)(ub + (size_t)(kt * 32 + i * 16 + (lane & 15)) * NU + C_IK + hq * 8);
  };
  auto scores = [&](const h8* a, float* sc) __attribute__((always_inline)) {
#pragma unroll
    for (int i = 0; i < 2; ++i) {
      f32x4 acc = {0.f, 0.f, 0.f, 0.f};
      acc = __builtin_amdgcn_mfma_f32_16x16x32_f16(a[i], qll, acc, 0, 0, 0);
      acc = __builtin_amdgcn_mfma_f32_16x16x32_f16(a[i], qlh, acc, 0, 0, 0);
#pragma unroll
      for (int h = 0; h < 8; ++h) {
        f32x4 d = {0.f, 0.f, 0.f, 0.f};
        d = __builtin_amdgcn_mfma_f32_16x16x32_f16(a[i], qf[h], d, 0, 0, 0);
#pragma unroll
        for (int r = 0; r < 4; ++r) acc[r] = __builtin_fmaf(__builtin_fabsf(d[r]), iw[h], acc[r]);
      }
#pragma unroll
      for (int r = 0; r < 4; ++r) sc[i * 4 + r] = acc[r];
    }
  };
  auto skey = [&](float s) __attribute__((always_inline)) -> uint32_t {
    s = s + 0.f;
    const uint32_t u_ = __float_as_uint(s);
    return (u_ & 0x80000000u) ? ~u_ : (u_ | 0x80000000u);
  };
  auto mkkey = [&](float s, int key) __attribute__((always_inline)) -> unsigned long long {
    s = s + 0.f;
    uint32_t u_ = __float_as_uint(s);
    u_ = (u_ & 0x80000000u) ? ~u_ : (u_ | 0x80000000u);
    return ((unsigned long long)u_ << 16) | (unsigned long long)(8191 - key);
  };
  auto run_level = [&](int level) __attribute__((always_inline)) {
    const int shift = 40 - 8 * level;
    for (int i = tid; i < 4096; i += 256) hist[i] = 0u;
    __syncthreads();
    {
      const unsigned long long mypfx = pfx[mytok];
      const bool act = state[mytok] == 1;
      h8 na[2];
      if (wid < nkt) loadk(wid, na);
      for (int kt = wid; kt < nkt; kt += 4) {
        h8 ca[2];
#pragma unroll
        for (int i = 0; i < 2; ++i) ca[i] = na[i];
        loadk(kt + 4 < nkt ? kt + 4 : kt, na);
        float sc[8];
        scores(ca, sc);
        if (act) {
#pragma unroll
          for (int q = 0; q < 8; ++q) {
            const int key = kt * 32 + (q >> 2) * 16 + 4 * hq + (q & 3);
            if (key <= myt) {
              if (level < 2) {
                const uint32_t u32 = skey(sc[q]);
                if (level == 0) atomicAdd(&hist[mytok * 256 + (int)(u32 >> 24)], 1u);
                else if ((u32 >> 24) == (uint32_t)mypfx) atomicAdd(&hist[mytok * 256 + (int)((u32 >> 16) & 255u)], 1u);
              } else {
                const unsigned long long k48 = mkkey(sc[q], key);
                if ((k48 >> (shift + 8)) == mypfx)
                  atomicAdd(&hist[mytok * 256 + (int)((k48 >> shift) & 255ull)], 1u);
              }
            }
          }
        }
      }
    }
    __syncthreads();
    {
      int rem = 0;
      for (int j = 0; j < 4; ++j) {
        const int tk = wid * 4 + j;
        if (state[tk] != 1) continue;
        const uint32_t* hrow = hist + tk * 256;
        const uint4 hv = *(const uint4*)&hrow[252 - 4 * lane];
        const int c = (int)(hv.x + hv.y + hv.z + hv.w);
        int cum = c;
#pragma unroll
        for (int o = 1; o < 64; o <<= 1) {
          int v = __shfl_up(cum, o);
          if (lane >= o) cum += v;
        }
        const int nd = need[tk];
        const unsigned long long mask = __ballot(cum >= nd);
        const int L = mask ? (int)__builtin_ctzll(mask) : 63;
        int running = cum - c, bstar, cb;
        if (running + (int)hv.w >= nd) { bstar = 255 - 4 * lane; cb = hv.w; }
        else {
          running += hv.w;
          if (running + (int)hv.z >= nd) { bstar = 254 - 4 * lane; cb = hv.z; }
          else {
            running += hv.z;
            if (running + (int)hv.y >= nd) { bstar = 253 - 4 * lane; cb = hv.y; }
            else { running += hv.y; bstar = 252 - 4 * lane; cb = hv.x; }
          }
        }
        running = __shfl(running, L); bstar = __shfl(bstar, L); cb = __shfl(cb, L);
        const int nd2 = nd - running;
        const bool fin = (cb == nd2) || (level == 5);
        if (lane == 0) {
          const unsigned long long np = (pfx[tk] << 8) | (unsigned long long)bstar;
          if (fin) { state[tk] = 0; tkey[tk] = np << shift; }
          else { need[tk] = nd2; pfx[tk] = np; }
        }
        if (!fin) rem++;
      }
      if (lane == 0 && rem) atomicAdd(&nrem[level], rem);
    }
    __syncthreads();
  };

  run_level(0);
  run_level(1);
  {
    const int st0 = state[mytok];
    const unsigned long long mytk = tkey[mytok];
    const unsigned long long myp16 = pfx[mytok];
    h8 na[2];
    if (wid < nkt) loadk(wid, na);
    for (int kt = wid; kt < nkt; kt += 4) {
      h8 ca[2];
#pragma unroll
      for (int i = 0; i < 2; ++i) ca[i] = na[i];
      loadk(kt + 4 < nkt ? kt + 4 : kt, na);
      float sc[8];
      scores(ca, sc);
#pragma unroll
      for (int q = 0; q < 8; ++q) {
        const int key = kt * 32 + (q >> 2) * 16 + 4 * hq + (q & 3);
        if (key <= myt) {
          const uint32_t u32 = skey(sc[q]);
          bool take, isc = false;
          if (st0 == 0) take = (((unsigned long long)u32 << 16) | (unsigned long long)(8191 - key)) >= mytk;
          else {
            const uint32_t p16 = u32 >> 16;
            take = p16 > (uint32_t)myp16;
            isc = p16 == (uint32_t)myp16;
          }
          if (take) {
            const int pos = atomicAdd(&cnt[mytok], 1);
            if (pos < 256) sel[mytok * 256 + pos] = (unsigned short)key;
          } else if (isc) {
            const int pos = atomicAdd(&ccnt[mytok], 1);
            if (pos < DSA_CAP) cand[mytok * 128 + pos] = ((unsigned long long)u32 << 16) | (unsigned long long)(8191 - key);
          }
        }
      }
    }
  }
  __syncthreads();
  {
    int nov = 0;
    for (int j = 0; j < 4; ++j) {
      const int tk = wid * 4 + j;
      if (state[tk] != 1) continue;
      const int nc = ccnt[tk];
      if (nc > DSA_CAP) {
        nov++;
        if (lane == 0) { ovf[tk] = 1; pf16[tk] = (int)pfx[tk]; }
        continue;
      }
      const int nd = need[tk];
      const unsigned long long k0 = (lane < nc) ? cand[tk * 128 + lane] : 0ull;
      const unsigned long long k1 = (lane + 64 < nc) ? cand[tk * 128 + lane + 64] : 0ull;
      int r0 = 0, r1 = 0;
      for (int q = 0; q < nc; ++q) {
        const unsigned long long kq = cand[tk * 128 + q];
        r0 += (kq > k0) ? 1 : 0;
        r1 += (kq > k1) ? 1 : 0;
      }
      if (lane < nc && r0 < nd) {
        const int pos = atomicAdd(&cnt[tk], 1);
        if (pos < 256) sel[tk * 256 + pos] = (unsigned short)(8191 - (int)(k0 & 0xFFFFull));
      }
      if (lane + 64 < nc && r1 < nd) {
        const int pos = atomicAdd(&cnt[tk], 1);
        if (pos < 256) sel[tk * 256 + pos] = (unsigned short)(8191 - (int)(k1 & 0xFFFFull));
      }
      if (lane == 0) state[tk] = 2;
    }
    if (lane == 0 && nov) atomicAdd(&nrem[6], nov);
  }
  __syncthreads();
  if (nrem[6] != 0) {
    for (int level = 2; level < 6; ++level) {
      run_level(level);
      if (nrem[level] == 0) break;
    }
    {
      const bool mine = ovf[mytok] != 0;
      const unsigned long long mytk = tkey[mytok];
      const unsigned long long myp16 = (unsigned long long)(unsigned)pf16[mytok];
      h8 na[2];
      if (wid < nkt) loadk(wid, na);
      for (int kt = wid; kt < nkt; kt += 4) {
        h8 ca[2];
#pragma unroll
        for (int i = 0; i < 2; ++i) ca[i] = na[i];
        loadk(kt + 4 < nkt ? kt + 4 : kt, na);
        float sc[8];
        scores(ca, sc);
        if (mine) {
#pragma unroll
          for (int q = 0; q < 8; ++q) {
            const int key = kt * 32 + (q >> 2) * 16 + 4 * hq + (q & 3);
            if (key <= myt) {
              const unsigned long long k48 = mkkey(sc[q], key);
              if ((k48 >> 32) == myp16 && k48 >= mytk) {
                const int pos = atomicAdd(&cnt[mytok], 1);
                if (pos < 256) sel[mytok * 256 + pos] = (unsigned short)key;
              }
            }
          }
        }
      }
    }
    __syncthreads();
  }
  for (int j = 0; j < 4; ++j) {
    const int tk = wid * 4 + j;
    const int t = t0 + tk;
    const int nsel = min(cnt[tk], 256);
    const half_t* urow = ub + (size_t)t * NU;
    const int col = lane & 15;
    h8 q0, q1;
#pragma unroll
    for (int e = 0; e < 8; ++e) { q0[e] = (half_t)0.f; q1[e] = (half_t)0.f; }
    if (col < 8) {
      q0 = *(const h8*)(urow + C_BQ + col * 64 + hq * 8);
      q1 = *(const h8*)(urow + C_BQ + col * 64 + 32 + hq * 8);
    }
    float mx = NEGF;
#pragma unroll 1
    for (int mg = 0; mg < 2; ++mg) {
#pragma unroll
      for (int mm = 0; mm < 8; ++mm) {
        const int m = mg * 8 + mm;
        const int pos = m * 16 + col;
        const int s = (pos < nsel) ? (int)sel[tk * 256 + pos] : 0;
        const half_t* kp = ub + (size_t)s * NU + C_BK + hq * 8;
        const h8 a0 = *(const h8*)kp, a1 = *(const h8*)(kp + 32);
        f32x4 d = {0.f, 0.f, 0.f, 0.f};
        d = __builtin_amdgcn_mfma_f32_16x16x32_f16(a0, q0, d, 0, 0, 0);
        d = __builtin_amdgcn_mfma_f32_16x16x32_f16(a1, q1, d, 0, 0, 0);
#pragma unroll
        for (int r = 0; r < 4; ++r) {
          const int pp = m * 16 + hq * 4 + r;
          const float v = (pp < nsel) ? d[r] * 0.125f : NEGF;
          mx = fmaxf(mx, v);
          if (col < 8) pbuf[pp * 8 + col] = v;
        }
      }
    }
    mx = fmaxf(mx, __shfl_xor(mx, 16));
    mx = fmaxf(mx, __shfl_xor(mx, 32));
    const float mxh = __shfl(mx, lane & 7);
    __builtin_amdgcn_wave_barrier();
    float sum = 0.f;
#pragma unroll 4
    for (int k = 0; k < 32; ++k) {
      const int i = lane + 64 * k;
      const float v = pbuf[i];
      const float e = (v > -1e29f) ? __expf(v - mxh) : 0.f;
      pbuf[i] = e;
      sum += e;
    }
    sum += __shfl_xor(sum, 8);
    sum += __shfl_xor(sum, 16);
    sum += __shfl_xor(sum, 32);
    const float inv = 1.f / sum;
    __builtin_amdgcn_wave_barrier();
    {
      const int rs = lane >> 3, dc = lane & 7;
      float acc[8][8];
#pragma unroll
      for (int h = 0; h < 8; ++h)
#pragma unroll
        for (int e = 0; e < 8; ++e) acc[h][e] = 0.f;
#pragma unroll 1
      for (int g8 = 0; g8 < 4; ++g8) {
        h8 vv[8];
#pragma unroll
        for (int i = 0; i < 8; ++i) {
          const int pos = (g8 * 8 + i) * 8 + rs;
          const int s = (pos < nsel) ? (int)sel[tk * 256 + pos] : 0;
          vv[i] = *(const h8*)(ub + (size_t)s * NU + C_BV + dc * 8);
        }
#pragma unroll
        for (int i = 0; i < 8; ++i) {
          const int pos = (g8 * 8 + i) * 8 + rs;
          const f32x4 pa = *(const f32x4*)&pbuf[pos * 8];
          const f32x4 pb = *(const f32x4*)&pbuf[pos * 8 + 4];
          float vf[8];
#pragma unroll
          for (int e = 0; e < 8; ++e) vf[e] = (float)vv[i][e];
#pragma unroll
          for (int e = 0; e < 8; ++e) {
            acc[0][e] += pa[0] * vf[e]; acc[1][e] += pa[1] * vf[e]; acc[2][e] += pa[2] * vf[e]; acc[3][e] += pa[3] * vf[e];
            acc[4][e] += pb[0] * vf[e]; acc[5][e] += pb[1] * vf[e]; acc[6][e] += pb[2] * vf[e]; acc[7][e] += pb[3] * vf[e];
          }
        }
      }
      half_t* yrow = p.yb() + (size_t)(b * SEQ + t) * 512;
#pragma unroll
      for (int h = 0; h < 8; ++h) {
        const float invh = __shfl(inv, h);
        h8 ov;
        const h8 z8 = *(const h8*)(urow + C_BZ + h * 64 + dc * 8);
#pragma unroll
        for (int e = 0; e < 8; ++e) {
          float a = acc[h][e];
          a += __shfl_xor(a, 8);
          a += __shfl_xor(a, 16);
          a += __shfl_xor(a, 32);
          ov[e] = (half_t)(a * invh * siluf_((float)z8[e]));
        }
        if (rs == h) *(h8*)(yrow + h * 64 + dc * 8) = ov;
      }
    }
    __builtin_amdgcn_wave_barrier();
  }
  __syncthreads();
}

__device__ __forceinline__ void phase2(const KP& p, int l, char* smem, int* q, int xcc) {
  xcd_schedule(q, xcc, 32, 1, smem, [&](int grp, int) __attribute__((always_inline)) { compress_item(p, l, grp, smem); });
  xcd_schedule(q + 8, xcc, 1024, 1, smem, [&](int grp, int) __attribute__((always_inline)) {
    const int y = grp & 7, k = grp >> 3;
    dsa_item(p, y & 1, 511 - (k * 4 + (y >> 1)), smem);
  });
  xcd_schedule(q + 16, xcc, 512, 1, smem, [&](int grp, int) __attribute__((always_inline)) { pool_item(p, l, grp, smem); });
}

struct DState {
  float m, l;
  f32x16 o[2];
};
#define MLOW (-1e4f)
__device__ __forceinline__ void ds_reset(DState& st) {
  st.m = MLOW; st.l = 0.f;
#pragma unroll
  for (int dt = 0; dt < 2; ++dt)
#pragma unroll
    for (int r = 0; r < 16; ++r) st.o[dt][r] = 0.f;
}
typedef unsigned int u32x4 __attribute__((ext_vector_type(4)));
typedef unsigned int u32x2 __attribute__((ext_vector_type(2)));
struct StageRegs {
  u32x4 k0, k1, v0, v1;
};
template <bool HASV>
__device__ __forceinline__ void load_stage(StageRegs& r, const half_t* __restrict__ Kb, int ldk,
                                           const half_t* __restrict__ VT, int ldv, int key0, int tid) {
  const int row = tid >> 3, c = tid & 7;
  r.k0 = *(const u32x4*)(Kb + (size_t)(key0 + row) * ldk + c * 8);
  r.k1 = *(const u32x4*)(Kb + (size_t)(key0 + row + 32) * ldk + c * 8);
  if (HASV) {
    r.v0 = *(const u32x4*)(VT + (size_t)row * ldv + key0 + c * 8);
    r.v1 = *(const u32x4*)(VT + (size_t)(row + 32) * ldv + key0 + c * 8);
  }
}
template <bool HASV>
__device__ __forceinline__ void write_stage(const StageRegs& r, half_t* Ks, half_t* Vs, int tid) {
  const int row = tid >> 3, c = tid & 7;
  *(u32x4*)&Ks[row * 72 + c * 8] = r.k0;
  *(u32x4*)&Ks[(row + 32) * 72 + c * 8] = r.k1;
  if (HASV) {
    const int ks = c >> 1, a = c & 1;
    u32x2 lo, hi;
    lo[0] = r.v0[0]; lo[1] = r.v0[1]; hi[0] = r.v0[2]; hi[1] = r.v0[3];
    *(u32x2*)&Vs[row * 72 + ks * 16 + a * 4] = lo;
    *(u32x2*)&Vs[row * 72 + ks * 16 + 8 + a * 4] = hi;
    lo[0] = r.v1[0]; lo[1] = r.v1[1]; hi[0] = r.v1[2]; hi[1] = r.v1[3];
    *(u32x2*)&Vs[(row + 32) * 72 + ks * 16 + a * 4] = lo;
    *(u32x2*)&Vs[(row + 32) * 72 + ks * 16 + 8 + a * 4] = hi;
  }
}
template <bool ONLINE, bool HASV, bool FAST, class VF>
__device__ __forceinline__ void dense_block(DState& st, const half_t* Ks, const half_t* Vs, const h8* qf, int key0,
                                            int flag, VF valid, float fixed_m, float fixed_invl, f32x16* pout,
                                            int lane) {
  const int h = lane >> 5, c = lane & 31;
  f32x16 s[2];
#pragma unroll
  for (int kt = 0; kt < 2; ++kt) {
#pragma unroll
    for (int r = 0; r < 16; ++r) s[kt][r] = 0.f;
#pragma unroll
    for (int ks = 0; ks < 4; ++ks) {
      const h8 a = *(const h8*)&Ks[(32 * kt + c) * 72 + 16 * ks + 8 * h];
      s[kt] = __builtin_amdgcn_mfma_f32_32x32x16_f16(a, qf[ks], s[kt], 0, 0, 0);
    }
  }
  float cm = NEGF;
#pragma unroll
  for (int kt = 0; kt < 2; ++kt)
#pragma unroll
    for (int r = 0; r < 16; ++r) {
      const int key = key0 + 32 * kt + (r & 3) + 8 * (r >> 2) + 4 * h;
      const float v = (FAST ? (flag != 0) : valid(key, flag)) ? s[kt][r] : NEGF;
      s[kt][r] = v;
      cm = fmaxf(cm, v);
    }
  float mnew;
  if (ONLINE) {
    cm = fmaxf(cm, __shfl_xor(cm, 32));
    mnew = fmaxf(st.m, cm);
    if (__ballot(mnew > st.m) != 0ull) {
      const float alpha = __builtin_amdgcn_exp2f(st.m - mnew);
      st.m = mnew;
      st.l *= alpha;
      if (HASV) {
#pragma unroll
        for (int dt = 0; dt < 2; ++dt)
#pragma unroll
          for (int r = 0; r < 16; ++r) st.o[dt][r] *= alpha;
      }
    }
  } else {
    mnew = fixed_m;
  }
  float ps = 0.f;
#pragma unroll
  for (int kt = 0; kt < 2; ++kt)
#pragma unroll
    for (int r = 0; r < 16; ++r) {
      float e = __builtin_amdgcn_exp2f(s[kt][r] - mnew);
      if (!ONLINE) e *= fixed_invl;
      s[kt][r] = e;
      ps += e;
    }
  st.l += ps;
  if (pout) { pout[0] = s[0]; pout[1] = s[1]; }
  if (HASV) {
#pragma unroll
    for (int ks = 0; ks < 4; ++ks) {
      h8 pf;
#pragma unroll
      for (int jj = 0; jj < 8; ++jj) pf[jj] = (half_t)s[ks >> 1][8 * (ks & 1) + jj];
#pragma unroll
      for (int dt = 0; dt < 2; ++dt) {
        const h8 vf = *(const h8*)&Vs[(32 * dt + c) * 72 + 16 * ks + 8 * h];
        st.o[dt] = __builtin_amdgcn_mfma_f32_32x32x16_f16(vf, pf, st.o[dt], 0, 0, 0);
      }
    }
  }
}
template <bool ONLINE, bool HASV, bool WANTP, class PRE, class FU, class VF, class PO>
__device__ __forceinline__ void run_dense(DState& st, const half_t* __restrict__ Kb, int ldk,
                                          const half_t* __restrict__ VT, int ldv, int blk_lo, int blk_hi, const h8* qf,
                                          PRE pre, FU full, VF valid, float fixed_m, float fixed_invl, PO post, char* smem,
                                          int tid) {
  half_t* Ks = (half_t*)smem;
  half_t* Vs = Ks + 64 * 72;
  const int lane = tid & 63;
  StageRegs sr;
  load_stage<HASV>(sr, Kb, ldk, VT, ldv, blk_lo * 64, tid);
  for (int blk = blk_lo; blk <= blk_hi; ++blk) {
    __syncthreads();
    write_stage<HASV>(sr, Ks, Vs, tid);
    __syncthreads();
    const int nb = blk < blk_hi ? blk + 1 : blk;
    load_stage<HASV>(sr, Kb, ldk, VT, ldv, nb * 64, tid);
    const int flag = pre(blk);
    if (__ballot(flag != 0) != 0ull) {
      f32x16 pp[2];
      if (full(blk))
        dense_block<ONLINE, HASV, true>(st, Ks, Vs, qf, blk * 64, flag, valid, fixed_m, fixed_invl,
                                        WANTP ? pp : (f32x16*)nullptr, lane);
      else
        dense_block<ONLINE, HASV, false>(st, Ks, Vs, qf, blk * 64, flag, valid, fixed_m, fixed_invl,
                                         WANTP ? pp : (f32x16*)nullptr, lane);
      if (WANTP) post(blk * 64, pp);
    }
  }
}

__device__ __forceinline__ void nsa_item(const KP& p, int b, int g, int tile, char* smem) {
  int tid = threadIdx.x;
  asm volatile("" : "+v"(tid));
  const int lane = tid & 63, wid = tid >> 6;
  const int t0 = tile * 32;
  const int tw0 = t0 + 8 * wid;
  const int col = lane & 31, h = lane >> 5;
  const int j = col >> 2, r4 = col & 3;
  const int tj = tw0 + j;
  const int head = g * 4 + r4;
  float* impA = (float*)(smem + 18432 + wid * 8320);
  float* impB = impA + 1024;
  unsigned long long* msk = (unsigned long long*)(smem + 18432 + 4 * 8320 + wid * 128);
  const half_t* ub = p.u() + (size_t)b * SEQ * NU;
  const half_t* urow = ub + (size_t)tj * NU;
  h8 qf[4];
#pragma unroll
  for (int ks = 0; ks < 4; ++ks) {
    qf[ks] = *(const h8*)(urow + C_CQ + head * 64 + 16 * ks + 8 * h);
#pragma unroll
    for (int e = 0; e < 8; ++e) qf[ks][e] = (half_t)((float)qf[ks][e] * 0.18033688f);
  }
  float gate[3];
#pragma unroll
  for (int i = 0; i < 3; ++i) gate[i] = sigmoidf_((float)urow[C_CG + head * 3 + i]);
  f32x16 res[2];
#pragma unroll
  for (int dt = 0; dt < 2; ++dt)
#pragma unroll
    for (int r = 0; r < 16; ++r) res[dt][r] = 0.f;
  for (int i = lane; i < 2080; i += 64) impA[i] = 0.f;
  DState st;
  auto nopost = [&](int, f32x16*) __attribute__((always_inline)) {};

  {
    const int nmax_j = (tj >= 31) ? ((tj - 31) >> 4) : -1;
    const int bhi = (t0 >> 4) >> 6;
    const half_t* Kc = p.kcmp() + (size_t)(b * 2 + g) * 512 * 64;
    const half_t* Vc = p.vcmpT() + (size_t)(b * 2 + g) * 64 * 512;
    auto pre = [&](int) __attribute__((always_inline)) { return 1; };
    const int nmax_w = (tw0 >= 31) ? ((tw0 - 31) >> 4) : -1;
    auto fullc = [&](int blk) __attribute__((always_inline)) { return blk * 64 + 63 <= nmax_w; };
    auto vfn = [&](int n, int) __attribute__((always_inline)) { return n <= nmax_j; };
    ds_reset(st);
    run_dense<true, false, false>(st, Kc, 64, (const half_t*)nullptr, 0, 0, bhi, qf, pre, fullc, vfn, 0.f, 0.f, nopost, smem, tid);
    float lt = st.l;
    lt += __shfl_xor(lt, 32);
    const float mfix = st.m;
    const float invl = lt > 0.f ? 1.f / lt : 0.f;
    ds_reset(st);
    auto post = [&](int n0, f32x16* pp) __attribute__((always_inline)) {
#pragma unroll
      for (int kt = 0; kt < 2; ++kt)
#pragma unroll
        for (int qd = 0; qd < 4; ++qd) {
          float a = pp[kt][4 * qd] + pp[kt][4 * qd + 1] + pp[kt][4 * qd + 2] + pp[kt][4 * qd + 3];
          float bb = pp[kt][4 * qd + 3];
          a += __shfl_xor(a, 1); a += __shfl_xor(a, 2);
          bb += __shfl_xor(bb, 1); bb += __shfl_xor(bb, 2);
          if (r4 == 0) {
            const int sblk = (n0 >> 2) + 8 * kt + 2 * qd + h;
            impA[j * 128 + sblk] = a;
            impB[j * 132 + sblk + 1] = bb;
          }
        }
    };
    run_dense<false, true, true>(st, Kc, 64, Vc, 512, 0, bhi, qf, pre, fullc, vfn, mfix, invl, post, smem, tid);
#pragma unroll
    for (int dt = 0; dt < 2; ++dt)
#pragma unroll
      for (int r = 0; r < 16; ++r) res[dt][r] += gate[0] * st.o[dt][r];
  }
  __builtin_amdgcn_wave_barrier();
#pragma unroll 1
  for (int jj = 0; jj < 8; ++jj) {
    const int t = tw0 + jj;
    const int blk = t >> 6;
    uint32_t k0, k1;
    {
      const int s0 = lane, s1 = lane + 64;
      const float i0 = impA[jj * 128 + s0] + impB[jj * 132 + s0];
      const float i1 = impA[jj * 128 + s1] + impB[jj * 132 + s1];
      auto mk = [&](float im, int s) __attribute__((always_inline)) -> uint32_t {
        if (s > blk) return 0u;
        uint32_t kk = ((__float_as_uint(im) >> 1) & ~127u) | (uint32_t)(127 - s) | 0x40000000u;
        if (s == 0 || s == blk || s == blk - 1) kk |= 0x80000000u;
        return kk;
      };
      k0 = mk(i0, s0); k1 = mk(i1, s1);
    }
    unsigned long long lo = 0ull, hi = 0ull;
    for (int it = 0; it < 16; ++it) {
      uint32_t mxk = k0 > k1 ? k0 : k1;
#pragma unroll
      for (int o = 32; o > 0; o >>= 1) {
        const uint32_t ov = (uint32_t)__shfl_xor((int)mxk, o);
        mxk = ov > mxk ? ov : mxk;
      }
      mxk = (uint32_t)__builtin_amdgcn_readfirstlane((int)mxk);
      if (mxk == 0u) break;
      const int s = 127 - (int)(mxk & 127u);
      if (s < 64) lo |= 1ull << s; else hi |= 1ull << (s - 64);
      if (s == lane) k0 = 0u;
      if (s == lane + 64) k1 = 0u;
    }
    if (lane == 0) { msk[jj * 2] = lo; msk[jj * 2 + 1] = hi; }
  }
  __builtin_amdgcn_wave_barrier();
  const unsigned long long mylo = msk[j * 2], myhi = msk[j * 2 + 1];
  {
    const half_t* Ksel = ub + C_CKS + g * 64;
    const half_t* Vsel = p.vsT() + (size_t)(b * 2 + g) * 64 * SEQ;
    auto pre = [&](int blk) __attribute__((always_inline)) {
      const unsigned long long mm_ = (blk < 64) ? mylo : myhi;
      return (int)((mm_ >> (blk & 63)) & 1ull);
    };
    auto vfn = [&](int key, int flag) __attribute__((always_inline)) { return flag != 0 && key <= tj; };
    ds_reset(st);
    auto fulls = [&](int blk) __attribute__((always_inline)) { return blk * 64 + 63 <= tw0; };
    run_dense<true, true, false>(st, Ksel, NU, Vsel, SEQ, 0, (t0 + 31) >> 6, qf, pre, fulls, vfn, 0.f, 0.f, nopost, smem, tid);
    float lt = st.l;
    lt += __shfl_xor(lt, 32);
    const float sc = lt > 0.f ? gate[1] / lt : 0.f;
#pragma unroll
    for (int dt = 0; dt < 2; ++dt)
#pragma unroll
      for (int r = 0; r < 16; ++r) res[dt][r] += sc * st.o[dt][r];
  }
  {
    const half_t* Kw = ub + C_CKW + g * 64;
    const half_t* Vw = p.vwT() + (size_t)(b * 2 + g) * 64 * SEQ;
    auto pre = [&](int blk) __attribute__((always_inline)) {
      return (int)((blk * 64 <= tj) && (blk * 64 + 63 > tj - 512));
    };
    auto vfn = [&](int key, int) __attribute__((always_inline)) { return key <= tj && key > tj - 512; };
    ds_reset(st);
    auto fullw = [&](int blk) __attribute__((always_inline)) { return blk * 64 + 63 <= tw0 && blk * 64 > tw0 + 7 - 512; };
    run_dense<true, true, false>(st, Kw, NU, Vw, SEQ, max(0, t0 - 511) >> 6, (t0 + 31) >> 6, qf, pre, fullw, vfn, 0.f, 0.f,
                                 nopost, smem, tid);
    float lt = st.l;
    lt += __shfl_xor(lt, 32);
    const float sc = lt > 0.f ? gate[2] / lt : 0.f;
#pragma unroll
    for (int dt = 0; dt < 2; ++dt)
#pragma unroll
      for (int r = 0; r < 16; ++r) res[dt][r] += sc * st.o[dt][r];
  }
  half_t* yrow = p.yc() + (size_t)(b * SEQ + tj) * 512 + head * 64;
#pragma unroll
  for (int dt = 0; dt < 2; ++dt)
#pragma unroll
    for (int qd = 0; qd < 4; ++qd) {
      const int d = 32 * dt + 8 * qd + 4 * h;
      const h4 z = *(const h4*)(urow + C_CZ + head * 64 + d);
      h4 ov;
#pragma unroll
      for (int e = 0; e < 4; ++e) ov[e] = (half_t)(res[dt][4 * qd + e] * siluf_((float)z[e]));
      *(h4*)(yrow + d) = ov;
    }
  __syncthreads();
}

__device__ __forceinline__ void phase_nsa(const KP& p, char* smem, int* q, int xcc) {
  xcd_schedule(q, xcc, 1024, 1, smem, [&](int grp, int) __attribute__((always_inline)) {
    const int y = grp & 7, k = grp >> 3;
    const int b = y & 1, g = (y >> 1) & 1, tile = 255 - (k * 2 + (y >> 2));
    nsa_item(p, b, g, tile, smem);
  });
}

__device__ __forceinline__ void phase_merge(const KP& p, char* smem, int* q, int xcc) {
  xcd_schedule(q, xcc, 16, 64, smem, [&](int grp, int within) __attribute__((always_inline)) {
    const int mt = (grp & 15) * 8 + (within & 7), nt = (within >> 3);
    const int m0 = mt * 128, n0 = nt * 128;
    f32x16 tot[2][2];
#pragma unroll
    for (int i = 0; i < 2; ++i)
#pragma unroll
      for (int jn = 0; jn < 2; ++jn)
#pragma unroll
        for (int r = 0; r < 16; ++r) tot[i][jn][r] = 0.f;
#pragma unroll 1
    for (int br = 0; br < 3; ++br) {
      const half_t* A = (br == 0 ? p.ya() : (br == 1 ? p.yb() : p.yc())) + (size_t)m0 * 512;
      const half_t* B = p.wpT() + (size_t)br * DM * 512 + (size_t)n0 * 512;
      const half_t* G = p.u() + (size_t)m0 * NU + C_GM + br * 1024 + n0;
      gemm_tile<2>(
          512, [&](int r, int k) { return *(const uint4*)(A + (size_t)r * 512 + k); },
          [&](int r, int k) { return *(const uint4*)(B + (size_t)r * 512 + k); },
          [&](int mi, int ni, int r, int row, int col, float v) {
            const float gz = (float)G[(size_t)row * NU + col];
            tot[mi][ni][r] += sigmoidf_(gz) * v;
          },
          smem);
    }
    int tidx = threadIdx.x;
    asm volatile("" : "+v"(tidx));
    const int lane = tidx & 63, wid = tidx >> 6, wm = wid >> 1, wn = wid & 1;
#pragma unroll
    for (int mi = 0; mi < 2; ++mi)
#pragma unroll
      for (int ni = 0; ni < 2; ++ni)
#pragma unroll
        for (int r = 0; r < 16; ++r) {
          const int row = wm * 64 + mi * 32 + (r & 3) + 8 * (r >> 2) + 4 * (lane >> 5);
          const int col = wn * 64 + ni * 32 + (lane & 31);
          p.mm()[(size_t)(m0 + row) * DM + n0 + col] = (half_t)tot[mi][ni][r];
        }
  });
}

__device__ __forceinline__ void phase_outproj(const KP& p, char* smem, int* q, int xcc) {
  xcd_schedule(q, xcc, 16, 64, smem, [&](int grp, int within) __attribute__((always_inline)) {
    const int mt = (grp & 15) * 8 + (within & 7), nt = (within >> 3);
    const int m0 = mt * 128, n0 = nt * 128;
    const half_t* A = p.mm() + (size_t)m0 * DM;
    const half_t* B = p.woT() + (size_t)n0 * DM;
    gemm_tile<2>(
        DM, [&](int r, int k) { return *(const uint4*)(A + (size_t)r * DM + k); },
        [&](int r, int k) { return *(const uint4*)(B + (size_t)r * DM + k); },
        [&](int mi, int ni, int r, int row, int col, float v) {
          const size_t xi = (size_t)(m0 + row) * DM + n0 + col;
          ((float*)p.u())[xi] = ALPHA_F * p.xr()[xi] + v;
        },
        smem);
  });
}


#define XB_TMO      128
#define XB_XCNT(j)  (256  + 64 * (j))
#define XB_XSUB(j)  (1280 + 64 * (j))
#define XB_XGEN(j)  (2304 + 64 * (j))
#define XB_TOP      3328
#define XB_TOPGEN   3392
#define XCD_BAR_WORDS 3456
#define XB_SPIN_CAP (1u << 20)
#define LAS __attribute__((address_space(3)))
__device__ __forceinline__ unsigned xb_ld(unsigned* p)              { return __hip_atomic_load(p, __ATOMIC_RELAXED, __HIP_MEMORY_SCOPE_AGENT); }
__device__ __forceinline__ unsigned xb_add(unsigned* p, unsigned v) { return __hip_atomic_fetch_add(p, v, __ATOMIC_RELAXED, __HIP_MEMORY_SCOPE_AGENT); }
__device__ __forceinline__ unsigned xb_xcc_id() { return (unsigned)__builtin_amdgcn_s_getreg((3 << 11) | 20) & 0xFu; }
#define XB_SPIN(cond, bar) do { unsigned _sp = 0; while (cond) { __builtin_amdgcn_s_sleep(1); \
    if ((++_sp & 255u) == 0u) { if (xb_ld(&(bar)[XB_TMO])) break; if (_sp > XB_SPIN_CAP) { atomicAdd(&(bar)[XB_TMO], 1u); break; } } } } while (0)
struct XcdBarrier { unsigned* bar; unsigned x; volatile LAS unsigned* st; };
__device__ __forceinline__ XcdBarrier xcd_barrier_post(unsigned* bar, volatile LAS unsigned* st) {
  XcdBarrier b; b.bar = bar; b.x = xb_xcc_id(); b.st = st;
  if (threadIdx.x == 0) (void)xb_add(&bar[XB_XCNT(b.x)], 1u);
  return b;
}
__device__ __forceinline__ void xcd_barrier_complete(unsigned* bar, unsigned x, unsigned& nloc, unsigned& nx) {
  const unsigned G = gridDim.x * gridDim.y * gridDim.z;
  unsigned sum, cnt, mine, sp = 0u;
  for (;;) {
    sum = 0u; cnt = 0u; mine = 0u;
#pragma unroll
    for (unsigned j = 0; j < 16; ++j) { const unsigned c = xb_ld(&bar[XB_XCNT(j)]); sum += c; cnt += (c > 0u) ? 1u : 0u; mine = (j == x) ? c : mine; }
    if (sum == G) break;
    __builtin_amdgcn_s_sleep(1);
    if ((++sp & 255u) == 0u) { if (xb_ld(&bar[XB_TMO])) break; if (sp > XB_SPIN_CAP) { atomicAdd(&bar[XB_TMO], 1u); break; } }
  }
  nloc = mine > 0u ? mine : 1u; nx = cnt > 0u ? cnt : 1u;
}
__device__ __forceinline__ void xcd_barrier(const XcdBarrier& b) {
  asm volatile("s_waitcnt vmcnt(0)" ::: "memory");
  __syncthreads();
  if (threadIdx.x == 0) {
    unsigned* bar = b.bar;
    __builtin_amdgcn_s_waitcnt(0);
    unsigned nloc = b.st[0], nx = b.st[1];
    if (nloc == 0u) { xcd_barrier_complete(bar, b.x, nloc, nx); b.st[0] = nloc; b.st[1] = nx; }
    const unsigned old = xb_add(&bar[XB_XSUB(b.x)], 1u);
    const unsigned gen = old / nloc;
    if (old + 1u == (gen + 1u) * nloc) {
      __builtin_amdgcn_fence(__ATOMIC_RELEASE, "agent");
      asm volatile("s_waitcnt vmcnt(0)" ::: "memory");
      const unsigned og = xb_add(&bar[XB_TOP], 1u);
      const unsigned tg = og / nx;
      if (og + 1u == (tg + 1u) * nx) xb_add(&bar[XB_TOPGEN], 1u);
      else XB_SPIN(xb_ld(&bar[XB_TOPGEN]) == tg, bar);
      __builtin_amdgcn_fence(__ATOMIC_ACQUIRE, "agent");
      xb_add(&bar[XB_XGEN(b.x)], 1u);
      asm volatile("s_waitcnt vmcnt(0)" ::: "memory");
    } else {
      XB_SPIN(xb_ld(&bar[XB_XGEN(b.x)]) == gen, bar);
      __builtin_amdgcn_fence(__ATOMIC_ACQUIRE, "agent");
      asm volatile("s_waitcnt vmcnt(0)" ::: "memory");
    }
  }
  __syncthreads();
}

#define NQ_WORDS 4096
__global__ void __launch_bounds__(256, 2) fwd_megakernel(Params p_unused) {
  cg::grid_group grid = cg::this_grid();
  __shared__ __attribute__((aligned(16))) char smem[SMEM_BYTES];
  volatile LAS unsigned* st = (volatile LAS unsigned*)(smem + SMEM_BYTES - 32);
  if (threadIdx.x == 0) { st[0] = 0u; st[1] = 0u; }
  {
    const KP p = get_params();
    if (blockIdx.x == 0)
      for (int i = threadIdx.x; i < NQ_WORDS + XCD_BAR_WORDS; i += 256) p.counters()[i] = 0;
    ln_rows(p, -1, false);
    prep_weights(p, 0, smem);
  }
  grid.sync();
  XcdBarrier xb;
  {
    const KP p = get_params();
    xb = xcd_barrier_post((unsigned*)p.counters() + NQ_WORDS, st);
  }
  const int xcc = (int)(xb.x & 7u);
#ifndef REP1
#define REP1 1
#define REP2 1
#define REP3 1
#define REP4 1
#endif
#ifndef REP5
#define REP5 1
#define REP6 1
#define REP7 0
#endif
#pragma unroll 1
  for (int l = 0; l < DEPTH; ++l) {
#define QPTR(ph, rep) (p.counters() + ((l * 6 + (ph)) * 4 + (rep)) * 32)
    for (int rep = 0; rep < REP1; ++rep) { const KP p = get_params(); phase_inproj(p, l, smem, QPTR(0, rep), xcc); }
    xcd_barrier(xb);
    for (int rep = 0; rep < REP2; ++rep) { const KP p = get_params(); phase2(p, l, smem, QPTR(1, rep), xcc); }
    xcd_barrier(xb);
    for (int rep = 0; rep < REP3; ++rep) { const KP p = get_params(); phase_nsa(p, smem, QPTR(2, rep), xcc); }
    xcd_barrier(xb);
    for (int rep = 0; rep < REP4; ++rep) { const KP p = get_params(); phase_merge(p, smem, QPTR(3, rep), xcc); }
    xcd_barrier(xb);
    for (int rep = 0; rep < REP5; ++rep) { const KP p = get_params(); phase_outproj(p, smem, QPTR(4, rep), xcc); }
    xcd_barrier(xb);
    for (int rep = 0; rep < REP6; ++rep) {
      const KP p = get_params();
      if (l + 1 < DEPTH) {
        ln_rows(p, l, false);
        prep_weights(p, l + 1, smem);
      } else {
        ln_rows(p, l, true);
      }
    }
    if (l + 1 < DEPTH) xcd_barrier(xb);
    for (int rep = 0; rep < REP7; ++rep) xcd_barrier(xb);
  }
}

extern "C" void kernel_launch(void* const* d_in, const int* in_sizes, int n_in, void* d_out, int out_size,
                              void* d_ws, size_t ws_size, hipStream_t stream) {
  static int grid_blocks = 0;
  if (!grid_blocks) {
    int dev = 0, cus = 0, per_cu = 0;
    (void)hipGetDevice(&dev);
    (void)hipDeviceGetAttribute(&cus, hipDeviceAttributeMultiprocessorCount, dev);
    (void)hipOccupancyMaxActiveBlocksPerMultiprocessor(&per_cu, fwd_megakernel, 256, 0);
    if (per_cu > 2) per_cu = 2;
    if (per_cu < 1) per_cu = 1;
    grid_blocks = cus * per_cu;
  }
  Params p{};
  p.x = (const float*)d_in[0]; p.w_in = (const float*)d_in[1]; p.b_in = (const float*)d_in[2];
  p.pool_w = (const float*)d_in[3]; p.pool_b = (const float*)d_in[4]; p.pool_scale = (const float*)d_in[5];
  p.pos_k = (const float*)d_in[6]; p.pos_v = (const float*)d_in[7]; p.w1k = (const float*)d_in[8];
  p.w2k = (const float*)d_in[9]; p.w1v = (const float*)d_in[10]; p.w2v = (const float*)d_in[11];
  p.wpa = (const float*)d_in[12]; p.wpb = (const float*)d_in[13]; p.wpc = (const float*)d_in[14];
  p.wo = (const float*)d_in[15]; p.ln_g = (const float*)d_in[16]; p.ln_b = (const float*)d_in[17];
  p.out = (float*)d_out;
  p.ws = (char*)d_ws;
  if (WS_TOTAL > ws_size) { fprintf(stderr, "workspace too small: need %zu have %zu\n", (size_t)WS_TOTAL, ws_size); return; }
  void* args[] = {&p};
  hipError_t e = hipLaunchCooperativeKernel((void*)fwd_megakernel, dim3(grid_blocks), dim3(256), args, 0, stream);
  if (e != hipSuccess) fprintf(stderr, "cooperative launch failed: %s (grid %d)\n", hipGetErrorString(e), grid_blocks);
}
```

```cpp
#include <hip/hip_runtime.h>
#include <hip/hip_cooperative_groups.h>
#include <cstdio>
#include <cstdint>
namespace cg = cooperative_groups;

typedef _Float16 half_t;
typedef _Float16 h8 __attribute__((ext_vector_type(8)));
typedef _Float16 h4 __attribute__((ext_vector_type(4)));
typedef float f32x4 __attribute__((ext_vector_type(4)));
typedef float f32x16 __attribute__((ext_vector_type(16)));

#define SEQ 8192
#define DM 1024
#define NTOK 16384
#define DEPTH 4
#define NIN 7360
#define NU 7424
#define ALPHA_F 1.681792830507429f
#define NEGF (-1e30f)

#define C_AX 0
#define C_AZ 512
#define C_BQ 1024
#define C_BZ 1536
#define C_CQ 2048
#define C_CZ 2560
#define C_GM 3072
#define C_IQ 6144
#define C_CKC 6400
#define C_CVC 6528
#define C_CKS 6656
#define C_CVS 6784
#define C_CKW 6912
#define C_CVW 7040
#define C_BK 7168
#define C_BV 7232
#define C_IK 7296
#define C_IW 7328
#define C_CG 7336

#define SMEM_BYTES 73728

constexpr size_t OFF_xr = 0;
constexpr size_t OFF_xh = OFF_xr + (((size_t)NTOK*DM*4 + 255) & ~(size_t)255);
constexpr size_t OFF_u = OFF_xh + (((size_t)NTOK*DM*2 + 255) & ~(size_t)255);
constexpr size_t OFF_winT = OFF_u + (((size_t)NTOK*NU*2 + 255) & ~(size_t)255);
constexpr size_t OFF_wpT = OFF_winT + (((size_t)NU*DM*2 + 255) & ~(size_t)255);
constexpr size_t OFF_woT = OFF_wpT + (((size_t)3*DM*512*2 + 255) & ~(size_t)255);
constexpr size_t OFF_poolT = OFF_woT + (((size_t)DM*DM*2 + 255) & ~(size_t)255);
constexpr size_t OFF_w1T = OFF_poolT + (((size_t)4*128*128*2 + 255) & ~(size_t)255);
constexpr size_t OFF_posb = OFF_w1T + (((size_t)2*64*2048*2 + 255) & ~(size_t)255);
constexpr size_t OFF_vsT = OFF_posb + (((size_t)512 + 255) & ~(size_t)255);
constexpr size_t OFF_vwT = OFF_vsT + (((size_t)4*64*SEQ*2 + 255) & ~(size_t)255);
constexpr size_t OFF_kcmp = OFF_vwT + (((size_t)4*64*SEQ*2 + 255) & ~(size_t)255);
constexpr size_t OFF_vcmpT = OFF_kcmp + (((size_t)4*512*64*2 + 255) & ~(size_t)255);
constexpr size_t OFF_ya = OFF_vcmpT + (((size_t)4*64*512*2 + 255) & ~(size_t)255);
constexpr size_t OFF_yb = OFF_ya + (((size_t)NTOK*512*2 + 255) & ~(size_t)255);
constexpr size_t OFF_yc = OFF_yb + (((size_t)NTOK*512*2 + 255) & ~(size_t)255);
constexpr size_t OFF_mm = OFF_yc + (((size_t)NTOK*512*2 + 255) & ~(size_t)255);
constexpr size_t OFF_counters = OFF_mm + (((size_t)NTOK*DM*2 + 255) & ~(size_t)255);
constexpr size_t WS_TOTAL = OFF_counters + (((size_t)32768 + 255) & ~(size_t)255);
struct Params {
  const float* x; const float* w_in; const float* b_in; const float* pool_w; const float* pool_b;
  const float* pool_scale; const float* pos_k; const float* pos_v; const float* w1k; const float* w2k;
  const float* w1v; const float* w2v; const float* wpa; const float* wpb; const float* wpc;
  const float* wo; const float* ln_g; const float* ln_b;
  float* out;
  char* ws;
};
typedef const __attribute__((address_space(4))) unsigned long long* kargp_t;
struct KP {
  kargp_t kp;
  __device__ __forceinline__ const float* x() const { return (const float*)(const __attribute__((address_space(1))) float*)kp[0]; }
  __device__ __forceinline__ const float* w_in() const { return (const float*)(const __attribute__((address_space(1))) float*)kp[1]; }
  __device__ __forceinline__ const float* b_in() const { return (const float*)(const __attribute__((address_space(1))) float*)kp[2]; }
  __device__ __forceinline__ const float* pool_w() const { return (const float*)(const __attribute__((address_space(1))) float*)kp[3]; }
  __device__ __forceinline__ const float* pool_b() const { return (const float*)(const __attribute__((address_space(1))) float*)kp[4]; }
  __device__ __forceinline__ const float* pool_scale() const { return (const float*)(const __attribute__((address_space(1))) float*)kp[5]; }
  __device__ __forceinline__ const float* pos_k() const { return (const float*)(const __attribute__((address_space(1))) float*)kp[6]; }
  __device__ __forceinline__ const float* pos_v() const { return (const float*)(const __attribute__((address_space(1))) float*)kp[7]; }
  __device__ __forceinline__ const float* w1k() const { return (const float*)(const __attribute__((address_space(1))) float*)kp[8]; }
  __device__ __forceinline__ const float* w2k() const { return (const float*)(const __attribute__((address_space(1))) float*)kp[9]; }
  __device__ __forceinline__ const float* w1v() const { return (const float*)(const __attribute__((address_space(1))) float*)kp[10]; }
  __device__ __forceinline__ const float* w2v() const { return (const float*)(const __attribute__((address_space(1))) float*)kp[11]; }
  __device__ __forceinline__ const float* wpa() const { return (const float*)(const __attribute__((address_space(1))) float*)kp[12]; }
  __device__ __forceinline__ const float* wpb() const { return (const float*)(const __attribute__((address_space(1))) float*)kp[13]; }
  __device__ __forceinline__ const float* wpc() const { return (const float*)(const __attribute__((address_space(1))) float*)kp[14]; }
  __device__ __forceinline__ const float* wo() const { return (const float*)(const __attribute__((address_space(1))) float*)kp[15]; }
  __device__ __forceinline__ const float* ln_g() const { return (const float*)(const __attribute__((address_space(1))) float*)kp[16]; }
  __device__ __forceinline__ const float* ln_b() const { return (const float*)(const __attribute__((address_space(1))) float*)kp[17]; }
  __device__ __forceinline__ float* out() const { return (float*)(__attribute__((address_space(1))) float*)kp[18]; }
  __device__ __forceinline__ char* ws() const { return (char*)(__attribute__((address_space(1))) char*)kp[19]; }
  __device__ __forceinline__ float* xr() const { return (float*)(ws() + OFF_xr); }
  __device__ __forceinline__ half_t* xh() const { return (half_t*)(ws() + OFF_xh); }
  __device__ __forceinline__ half_t* u() const { return (half_t*)(ws() + OFF_u); }
  __device__ __forceinline__ half_t* winT() const { return (half_t*)(ws() + OFF_winT); }
  __device__ __forceinline__ half_t* wpT() const { return (half_t*)(ws() + OFF_wpT); }
  __device__ __forceinline__ half_t* woT() const { return (half_t*)(ws() + OFF_woT); }
  __device__ __forceinline__ half_t* poolT() const { return (half_t*)(ws() + OFF_poolT); }
  __device__ __forceinline__ half_t* w1T() const { return (half_t*)(ws() + OFF_w1T); }
  __device__ __forceinline__ float* posb() const { return (float*)(ws() + OFF_posb); }
  __device__ __forceinline__ half_t* vsT() const { return (half_t*)(ws() + OFF_vsT); }
  __device__ __forceinline__ half_t* vwT() const { return (half_t*)(ws() + OFF_vwT); }
  __device__ __forceinline__ half_t* kcmp() const { return (half_t*)(ws() + OFF_kcmp); }
  __device__ __forceinline__ half_t* vcmpT() const { return (half_t*)(ws() + OFF_vcmpT); }
  __device__ __forceinline__ half_t* ya() const { return (half_t*)(ws() + OFF_ya); }
  __device__ __forceinline__ half_t* yb() const { return (half_t*)(ws() + OFF_yb); }
  __device__ __forceinline__ half_t* yc() const { return (half_t*)(ws() + OFF_yc); }
  __device__ __forceinline__ half_t* mm() const { return (half_t*)(ws() + OFF_mm); }
  __device__ __forceinline__ int* counters() const { return (int*)(ws() + OFF_counters); }
};
__device__ __forceinline__ KP get_params() {
  KP q;
  q.kp = (kargp_t)__builtin_amdgcn_kernarg_segment_ptr();
  asm volatile("" : "+s"(q.kp));
  return q;
}


__device__ __forceinline__ int orig_col(int n) {
  if (n < 1536) return n;
  if (n < 2048) return 1664 + (n - 1536);
  if (n < 2560) return 2472 + (n - 2048);
  if (n < 3072) return 3776 + (n - 2560);
  if (n < 6144) return 4288 + (n - 3072);
  if (n < 6400) return 2176 + (n - 6144);
  if (n < 7168) return 2984 + (n - 6400);
  if (n < 7296) return 1536 + (n - 7168);
  if (n < 7328) return 2432 + (n - 7296);
  if (n < 7336) return 2464 + (n - 7328);
  if (n < 7360) return 3752 + (n - 7336);
  return -1;
}

__device__ __forceinline__ float wave_sum(float v) {
#pragma unroll
  for (int o = 32; o > 0; o >>= 1) v += __shfl_xor(v, o);
  return v;
}
__device__ __forceinline__ float sigmoidf_(float x) { return 1.f / (1.f + __expf(-x)); }
__device__ __forceinline__ float siluf_(float x) { return x / (1.f + __expf(-x)); }

template <int NI, class LA, class LB, class EP>
__device__ __forceinline__ void gemm_tile(int K, LA loadA, LB loadB, EP epi, char* smem) {
  constexpr int BN = NI * 64;
  constexpr int NB = BN / 32;
  half_t* sA = (half_t*)smem;
  half_t* sB = sA + 128 * 72;
  int tid = threadIdx.x;
  asm volatile("" : "+v"(tid));
  const int lane = tid & 63, wid = tid >> 6;
  const int wm = wid >> 1, wn = wid & 1;
  f32x16 acc[2][NI];
#pragma unroll
  for (int i = 0; i < 2; ++i)
#pragma unroll
    for (int j = 0; j < NI; ++j)
#pragma unroll
      for (int r = 0; r < 16; ++r) acc[i][j][r] = 0.f;
  const int lr = tid >> 3, lc = (tid & 7) * 8;
  uint4 ra[4], rb[NB];
#pragma unroll
  for (int i = 0; i < 4; ++i) ra[i] = loadA(lr + 32 * i, lc);
#pragma unroll
  for (int i = 0; i < NB; ++i) rb[i] = loadB(lr + 32 * i, lc);
  const int nk = K >> 6;
  for (int kt = 0; kt < nk; ++kt) {
    __syncthreads();
#pragma unroll
    for (int i = 0; i < 4; ++i) *(uint4*)&sA[(lr + 32 * i) * 72 + lc] = ra[i];
#pragma unroll
    for (int i = 0; i < NB; ++i) *(uint4*)&sB[(lr + 32 * i) * 72 + lc] = rb[i];
    __syncthreads();
    if (kt + 1 < nk) {
      const int kk = (kt + 1) * 64 + lc;
#pragma unroll
      for (int i = 0; i < 4; ++i) ra[i] = loadA(lr + 32 * i, kk);
#pragma unroll
      for (int i = 0; i < NB; ++i) rb[i] = loadB(lr + 32 * i, kk);
    }
#pragma unroll
    for (int s = 0; s < 4; ++s) {
      h8 af[2], bf[NI];
#pragma unroll
      for (int mi = 0; mi < 2; ++mi)
        af[mi] = *(const h8*)&sA[(wm * 64 + mi * 32 + (lane & 31)) * 72 + s * 16 + (lane >> 5) * 8];
#pragma unroll
      for (int ni = 0; ni < NI; ++ni)
        bf[ni] = *(const h8*)&sB[(wn * (NI * 32) + ni * 32 + (lane & 31)) * 72 + s * 16 + (lane >> 5) * 8];
#pragma unroll
      for (int mi = 0; mi < 2; ++mi)
#pragma unroll
        for (int ni = 0; ni < NI; ++ni)
          acc[mi][ni] = __builtin_amdgcn_mfma_f32_32x32x16_f16(af[mi], bf[ni], acc[mi][ni], 0, 0, 0);
    }
  }
#pragma unroll
  for (int mi = 0; mi < 2; ++mi)
#pragma unroll
    for (int ni = 0; ni < NI; ++ni)
#pragma unroll
      for (int r = 0; r < 16; ++r) {
        const int row = wm * 64 + mi * 32 + (r & 3) + 8 * (r >> 2) + 4 * (lane >> 5);
        const int col = wn * (NI * 32) + ni * 32 + (lane & 31);
        epi(mi, ni, r, row, col, acc[mi][ni][r]);
      }
}

template <class LA, class LB, class EP>
__device__ __forceinline__ void gemm_tile_big(int K, LA loadA, LB loadB, EP epi, char* smem) {
  half_t* sA = (half_t*)smem;
  half_t* sB = sA + 256 * 72;
  int tid = threadIdx.x;
  asm volatile("" : "+v"(tid));
  const int lane = tid & 63, wid = tid >> 6;
  const int wm = wid >> 1, wn = wid & 1;
  f32x16 acc[4][2];
#pragma unroll
  for (int i = 0; i < 4; ++i)
#pragma unroll
    for (int j = 0; j < 2; ++j)
#pragma unroll
      for (int r = 0; r < 16; ++r) acc[i][j][r] = 0.f;
  const int lr = tid >> 3, lc = (tid & 7) * 8;
  uint4 ra[8], rb[4];
#pragma unroll
  for (int i = 0; i < 8; ++i) ra[i] = loadA(lr + 32 * i, lc);
#pragma unroll
  for (int i = 0; i < 4; ++i) rb[i] = loadB(lr + 32 * i, lc);
  const int nk = K >> 6;
  for (int kt = 0; kt < nk; ++kt) {
    __syncthreads();
#pragma unroll
    for (int i = 0; i < 8; ++i) *(uint4*)&sA[(lr + 32 * i) * 72 + lc] = ra[i];
#pragma unroll
    for (int i = 0; i < 4; ++i) *(uint4*)&sB[(lr + 32 * i) * 72 + lc] = rb[i];
    __syncthreads();
    if (kt + 1 < nk) {
      const int kk = (kt + 1) * 64 + lc;
#pragma unroll
      for (int i = 0; i < 8; ++i) ra[i] = loadA(lr + 32 * i, kk);
#pragma unroll
      for (int i = 0; i < 4; ++i) rb[i] = loadB(lr + 32 * i, kk);
    }
#pragma unroll
    for (int s = 0; s < 4; ++s) {
      h8 af[4], bf[2];
#pragma unroll
      for (int mi = 0; mi < 4; ++mi)
        af[mi] = *(const h8*)&sA[(wm * 128 + mi * 32 + (lane & 31)) * 72 + s * 16 + (lane >> 5) * 8];
#pragma unroll
      for (int ni = 0; ni < 2; ++ni)
        bf[ni] = *(const h8*)&sB[(wn * 64 + ni * 32 + (lane & 31)) * 72 + s * 16 + (lane >> 5) * 8];
#pragma unroll
      for (int mi = 0; mi < 4; ++mi)
#pragma unroll
        for (int ni = 0; ni < 2; ++ni)
          acc[mi][ni] = __builtin_amdgcn_mfma_f32_32x32x16_f16(af[mi], bf[ni], acc[mi][ni], 0, 0, 0);
    }
  }
#pragma unroll
  for (int mi = 0; mi < 4; ++mi)
#pragma unroll
    for (int ni = 0; ni < 2; ++ni)
#pragma unroll
      for (int r = 0; r < 16; ++r) {
        const int row = wm * 128 + mi * 32 + (r & 3) + 8 * (r >> 2) + 4 * (lane >> 5);
        const int col = wn * 64 + ni * 32 + (lane & 31);
        epi(mi, ni, r, row, col, acc[mi][ni][r]);
      }
}

template <class CM>
__device__ __forceinline__ void tconv_tile(const float* __restrict__ src, int lds_, half_t* __restrict__ dst, int ldd,
                                           int n0, int k0, CM cmap, char* smem) {
  float* t = (float*)smem;
  int tid = threadIdx.x;
  asm volatile("" : "+v"(tid));
  {
    const int n = tid & 63;
    const int c = cmap(n0 + n);
    float tv[16];
#pragma unroll
    for (int i = 0; i < 16; ++i) {
      const int k = (tid >> 6) + 4 * i;
      tv[i] = (c >= 0) ? src[(size_t)(k0 + k) * lds_ + c] : 0.f;
    }
#pragma unroll
    for (int i = 0; i < 16; ++i) {
      const int k = (tid >> 6) + 4 * i;
      t[k * 65 + n] = tv[i];
    }
  }
  __syncthreads();
#pragma unroll
  for (int i = 0; i < 2; ++i) {
    const int idx = tid + 256 * i;
    const int n = idx >> 3, kc = (idx & 7) * 8;
    h8 v;
#pragma unroll
    for (int j = 0; j < 8; ++j) v[j] = (half_t)t[(kc + j) * 65 + n];
    *(h8*)&dst[(size_t)(n0 + n) * ldd + k0 + kc] = v;
  }
  __syncthreads();
}

__device__ __forceinline__ void ln_rows(const KP& p, int lprev, bool final_) {
  int tid = threadIdx.x;
  asm volatile("" : "+v"(tid));
  const int lane = tid & 63, wid = tid >> 6;
  const int gw = blockIdx.x * 4 + wid, nw = gridDim.x * 4;
  for (int row = gw; row < NTOK; row += nw) {
    const float4* rp = (const float4*)((lprev < 0 ? p.x() : (const float*)p.u()) + (size_t)row * DM);
    float4 v[4];
    float s = 0.f;
#pragma unroll
    for (int i = 0; i < 4; ++i) {
      v[i] = rp[lane + 64 * i];
      s += v[i].x + v[i].y + v[i].z + v[i].w;
    }
    if (lprev >= 0) {
      float mu = wave_sum(s) * (1.f / DM);
      float q = 0.f;
#pragma unroll
      for (int i = 0; i < 4; ++i) {
        float a = v[i].x - mu, b = v[i].y - mu, c = v[i].z - mu, d = v[i].w - mu;
        q += a * a + b * b + c * c + d * d;
      }
      float rstd = rsqrtf(wave_sum(q) * (1.f / DM) + 1e-5f);
      const float4* g4 = (const float4*)(p.ln_g() + lprev * DM);
      const float4* b4 = (const float4*)(p.ln_b() + lprev * DM);
#pragma unroll
      for (int i = 0; i < 4; ++i) {
        float4 g = g4[lane + 64 * i], bb = b4[lane + 64 * i];
        v[i].x = (v[i].x - mu) * rstd * g.x + bb.x;
        v[i].y = (v[i].y - mu) * rstd * g.y + bb.y;
        v[i].z = (v[i].z - mu) * rstd * g.z + bb.z;
        v[i].w = (v[i].w - mu) * rstd * g.w + bb.w;
      }
    }
    if (final_) {
      float4* op = (float4*)(p.out() + (size_t)row * DM);
#pragma unroll
      for (int i = 0; i < 4; ++i) op[lane + 64 * i] = v[i];
    } else {
      float4* op = (float4*)(p.xr() + (size_t)row * DM);
      h4* hp = (h4*)(p.xh() + (size_t)row * DM);
#pragma unroll
      for (int i = 0; i < 4; ++i) {
        op[lane + 64 * i] = v[i];
        h4 hv;
        hv[0] = (half_t)v[i].x; hv[1] = (half_t)v[i].y; hv[2] = (half_t)v[i].z; hv[3] = (half_t)v[i].w;
        hp[lane + 64 * i] = hv;
      }
    }
  }
}

__device__ __forceinline__ void prep_weights(const KP& p, int l, char* smem) {
  int tid = threadIdx.x;
  asm volatile("" : "+v"(tid));
  const int total = 1856 + 384 + 256 + 16 + 64 + 2;
  for (int it = blockIdx.x; it < total; it += gridDim.x) {
    if (it < 1856) {
      const int nt = it >> 4, kt = it & 15;
      tconv_tile(p.w_in() + (size_t)l * DM * NIN, NIN, p.winT(), DM, nt * 64, kt * 64,
                 [](int n) { return orig_col(n); }, smem);
    } else if (it < 1856 + 384) {
      const int j = it - 1856;
      const int w = j >> 7, r = j & 127, nt = r >> 3, kt = r & 7;
      const float* src = (w == 0 ? p.wpa() : (w == 1 ? p.wpb() : p.wpc())) + (size_t)l * 512 * DM;
      tconv_tile(src, DM, p.wpT() + (size_t)w * DM * 512, 512, nt * 64, kt * 64, [](int n) { return n; }, smem);
    } else if (it < 1856 + 384 + 256) {
      const int j = it - 1856 - 384;
      const int nt = j >> 4, kt = j & 15;
      tconv_tile(p.wo() + (size_t)l * DM * DM, DM, p.woT(), DM, nt * 64, kt * 64, [](int n) { return n; }, smem);
    } else if (it < 1856 + 384 + 256 + 16) {
      const int j = it - 1856 - 384 - 256;
      const int g = j >> 2, nt = (j >> 1) & 1, kt = j & 1;
      tconv_tile(p.pool_w() + ((size_t)l * 4 + g) * 128 * 128, 128, p.poolT() + (size_t)g * 128 * 128, 128, nt * 64,
                 kt * 64, [](int n) { return n; }, smem);
    } else if (it < 1856 + 384 + 256 + 16 + 64) {
      const int j = it - 1856 - 384 - 256 - 16;
      const int kv = j >> 5, kt = j & 31;
      const float* src = (kv ? p.w1v() : p.w1k()) + (size_t)l * 2048 * 64;
      tconv_tile(src, 64, p.w1T() + (size_t)kv * 64 * 2048, 2048, 0, kt * 64, [](int n) { return n; }, smem);
    } else {
      const int kv = it - (1856 + 384 + 256 + 16 + 64);
      const float* w1 = (kv ? p.w1v() : p.w1k()) + (size_t)l * 2048 * 64;
      const float* pos = (kv ? p.pos_v() : p.pos_k()) + (size_t)l * 2048;
      float* red = (float*)smem;
      const int e = tid & 63, part = tid >> 6;
      float sa = 0.f, sb = 0.f, sc_ = 0.f, sd = 0.f;
      const float* wq = w1 + (size_t)part * 512 * 64 + e;
      const float* pq = pos + part * 512;
#pragma unroll 4
      for (int f = 0; f < 512; f += 4) {
        sa += pq[f] * wq[(size_t)f * 64];
        sb += pq[f + 1] * wq[(size_t)(f + 1) * 64];
        sc_ += pq[f + 2] * wq[(size_t)(f + 2) * 64];
        sd += pq[f + 3] * wq[(size_t)(f + 3) * 64];
      }
      const float s = (sa + sb) + (sc_ + sd);
      red[tid] = s;
      __syncthreads();
      if (tid < 64) p.posb()[kv * 64 + tid] = red[tid] + red[tid + 64] + red[tid + 128] + red[tid + 192];
      __syncthreads();
    }
  }
}

template <class F>
__device__ __forceinline__ void xcd_schedule(int* q, int xcc, int ngroups, int gsize, char* smem, F f) {
  int* s_item = (int*)(smem + SMEM_BYTES - 16);
#pragma unroll 1
  for (int dy = 0; dy < 8; ++dy) {
    const int y = (xcc + dy) & 7;
    for (;;) {
      if (threadIdx.x == 0) *s_item = atomicAdd(&q[y], 1);
      __syncthreads();
      const int i = *s_item;
      __syncthreads();
      const int grp = (i / gsize) * 8 + y;
      if (grp >= ngroups) break;
      f(grp, i % gsize);
    }
  }
}

__device__ __forceinline__ void phase_inproj(const KP& p, int l, char* smem, int* q, int xcc) {
  const float* bias = p.b_in() + (size_t)l * NIN;
  xcd_schedule(q, xcc, 128, 32, smem, [&](int grp, int within) __attribute__((always_inline)) {
    const int mt = (grp & 15) * 4 + (within & 3), nt = (grp >> 4) * 8 + (within >> 2);
    if (nt >= 58) return;
    const int m0 = mt * 256, n0 = nt * 128;
    const half_t* A = p.xh() + (size_t)m0 * DM;
    const half_t* B = p.winT() + (size_t)n0 * DM;
    int tidx = threadIdx.x;
    asm volatile("" : "+v"(tidx));
    const int lane = tidx & 63, wn = (tidx >> 6) & 1;
    float bv[2];
#pragma unroll
    for (int ni = 0; ni < 2; ++ni) {
      const int oc = orig_col(n0 + wn * 64 + ni * 32 + (lane & 31));
      bv[ni] = oc >= 0 ? bias[oc] : 0.f;
    }
    half_t* vT = (nt == 53) ? p.vsT() : ((nt == 55) ? p.vwT() : nullptr);
    gemm_tile_big(
        DM, [&](int r, int k) { return *(const uint4*)(A + (size_t)r * DM + k); },
        [&](int r, int k) { return *(const uint4*)(B + (size_t)r * DM + k); },
        [&](int mi, int ni, int r, int row, int col, float v) {
          const half_t hv = (half_t)(v + bv[ni]);
          const int tok = m0 + row;
          p.u()[(size_t)tok * NU + n0 + col] = hv;
          if (vT) {
            const int b = tok >> 13, t = tok & 8191;
            vT[((size_t)(b * 2 + (col >> 6)) * 64 + (col & 63)) * SEQ + t] = hv;
          }
        },
        smem);
  });
}

__device__ __forceinline__ void pool_item(const KP& p, int l, int item, char* smem) {
  const int g = item & 3, mt = item >> 2;
  const int m0 = mt * 128;
  const int wnd = 2 << g;
  const half_t* B = p.poolT() + (size_t)g * 128 * 128;
  int tidx = threadIdx.x;
  asm volatile("" : "+v"(tidx));
  const int lane = tidx & 63, wn = (tidx >> 6) & 1;
  float pb[2], ps[2];
#pragma unroll
  for (int ni = 0; ni < 2; ++ni) {
    const int d = wn * 64 + ni * 32 + (lane & 31);
    pb[ni] = p.pool_b()[(size_t)l * 512 + g * 128 + d];
    ps[ni] = p.pool_scale()[(size_t)l * 512 + g * 128 + d];
  }
  gemm_tile<2>(
      128,
      [&](int r, int k) {
        const int tok = m0 + r, t = tok & 8191;
        const int cnt = min(t + 1, wnd);
        const half_t* base = p.u() + (size_t)tok * NU + C_AX + g * 128 + k;
        float s[8];
#pragma unroll
        for (int j = 0; j < 8; ++j) s[j] = 0.f;
        h8 cur = *(const h8*)base;
        for (int q0 = 0; q0 < wnd; q0 += 8) {
          h8 v[8];
#pragma unroll
          for (int i = 0; i < 8; ++i) {
            const int qq = q0 + i;
            if (qq < cnt) v[i] = *(const h8*)(base - (size_t)qq * NU);
            else {
#pragma unroll
              for (int j = 0; j < 8; ++j) v[i][j] = (half_t)0.f;
            }
          }
#pragma unroll
          for (int i = 0; i < 8; ++i)
#pragma unroll
            for (int j = 0; j < 8; ++j) s[j] += (float)v[i][j];
        }
        const float inv = 1.f / (float)cnt;
        h8 o;
#pragma unroll
        for (int j = 0; j < 8; ++j) o[j] = (half_t)(s[j] * inv - (float)cur[j]);
        return *(uint4*)&o;
      },
      [&](int r, int k) { return *(const uint4*)(B + (size_t)r * 128 + k); },
      [&](int mi, int ni, int r, int row, int col, float v) {
        const int tok = m0 + row;
        const float z = (float)p.u()[(size_t)tok * NU + C_AZ + g * 128 + col];
        p.ya()[(size_t)tok * 512 + g * 128 + col] = (half_t)((v + pb[ni]) * ps[ni] * siluf_(z));
      },
      smem);
}

__device__ __forceinline__ void compress_item(const KP& p, int l, int item, char* smem) {
  const int mt = item & 3, kv = (item >> 2) & 1, g = (item >> 3) & 1, b = item >> 4;
  int tid = threadIdx.x;
  asm volatile("" : "+v"(tid));
  const int ccol = (kv ? C_CVC : C_CKC) + g * 64;
  const half_t* ub = p.u() + (size_t)b * SEQ * NU + ccol;
  const half_t* B = p.w1T() + (size_t)kv * 64 * 2048;
  float* hid = (float*)(smem + 28672);
  const float* posb = p.posb() + kv * 64;
  gemm_tile<1>(
      2048,
      [&](int r, int k) {
        const int n = mt * 128 + r;
        if (n >= 511) return make_uint4(0, 0, 0, 0);
        const int tok = 16 * n + (k >> 6);
        return *(const uint4*)(ub + (size_t)tok * NU + (k & 63));
      },
      [&](int r, int k) { return *(const uint4*)(B + (size_t)r * 2048 + k); },
      [&](int mi, int ni, int r, int row, int col, float v) { hid[row * 65 + col] = siluf_(v + posb[col]); }, smem);
  __syncthreads();
  float* w2s = (float*)smem;
  const float* w2 = (kv ? p.w2v() : p.w2k()) + (size_t)l * 4096;
  for (int i = tid; i < 4096; i += 256) w2s[i] = w2[i];
  __syncthreads();
  {
    const int n = tid >> 1, fh = (tid & 1) * 32;
    float acc[32];
#pragma unroll
    for (int f = 0; f < 32; ++f) acc[f] = 0.f;
    for (int e = 0; e < 64; ++e) {
      const float hv = hid[n * 65 + e];
#pragma unroll
      for (int f = 0; f < 32; ++f) acc[f] += hv * w2s[e * 64 + fh + f];
    }
    const int ng = mt * 128 + n;
    const bool valid = ng < 511;
    if (kv == 0) {
      half_t* dst = p.kcmp() + ((size_t)(b * 2 + g) * 512 + ng) * 64 + fh;
#pragma unroll
      for (int f = 0; f < 32; ++f) dst[f] = valid ? (half_t)acc[f] : (half_t)0.f;
    } else {
      half_t* dst = p.vcmpT() + ((size_t)(b * 2 + g) * 64 + fh) * 512 + ng;
#pragma unroll
      for (int f = 0; f < 32; ++f) dst[(size_t)f * 512] = valid ? (half_t)acc[f] : (half_t)0.f;
    }
  }
  __syncthreads();
}

#ifndef DSA_CAP
#define DSA_CAP 128
#endif
__device__ __forceinline__ void dsa_item(const KP& p, int b, int tile, char* smem) {
  const int t0 = tile * 16;
  int tid = threadIdx.x;
  asm volatile("" : "+v"(tid));
  const int lane = tid & 63, wid = tid >> 6;
  uint32_t* hist = (uint32_t*)smem;
  unsigned long long* cand = (unsigned long long*)(smem + 16384);
  unsigned short* sel = (unsigned short*)(smem + 32768);
  unsigned long long* pfx = (unsigned long long*)(smem + 40960);
  unsigned long long* tkey = pfx + 16;
  int* need = (int*)(tkey + 16);
  int* state = need + 16;
  int* cnt = state + 16;
  int* ccnt = cnt + 16;
  int* pf16 = ccnt + 16;
  int* ovf = pf16 + 16;
  int* nrem = ovf + 16;
  int* fastf = nrem + 8;
  uint32_t* h1w = (uint32_t*)(smem + 43008);
  float* pbuf = (float*)smem + wid * 2048;

  const half_t* ub = p.u() + (size_t)b * SEQ * NU;
  const int mytok = lane & 15, hq = lane >> 4;
  const int myt = t0 + mytok;
  if (tid < 16) {
    const int t = t0 + tid;
    pfx[tid] = 0ull; tkey[tid] = 0ull; need[tid] = 256; state[tid] = (t < 256) ? 0 : 1; cnt[tid] = 0; ccnt[tid] = 0;
    pf16[tid] = 0; ovf[tid] = 0;
  }
  if (tid < 8) nrem[tid] = 0;
  if (tid < 16) fastf[tid] = 0;
  for (int i = tid; i < 6144; i += 256) h1w[i] = 0u;
  h8 qf[8], qlh, qll;
  float iw[8];
  {
    const half_t* qrow = ub + (size_t)myt * NU;
#pragma unroll
    for (int h = 0; h < 8; ++h) qf[h] = *(const h8*)(qrow + C_IQ + h * 32 + hq * 8);
    const h8 w8 = *(const h8*)(qrow + C_IW);
#pragma unroll
    for (int h = 0; h < 8; ++h) iw[h] = (float)w8[h] * 0.03125f;
#pragma unroll
    for (int e = 0; e < 8; ++e) {
      float a = 0.f;
#pragma unroll
      for (int h = 0; h < 8; ++h) a += iw[h] * (float)qf[h][e];
      const half_t hi = (half_t)a;
      qlh[e] = hi;
      qll[e] = (half_t)(a - (float)hi);
    }
  }
  __syncthreads();
  const int nkt = (t0 + 16 + 31) >> 5;

  auto loadk = [&](int kt, h8* a) __attribute__((always_inline)) {
#pragma unroll
    for (int i = 0; i < 2; ++i)
      a[i] = *(const h8*)(ub + (size_t)(kt * 32 + i * 16 + (lane & 15)) * NU + C_IK + hq * 8);
  };
  auto scores = [&](const h8* a, float* sc) __attribute__((always_inline)) {
#pragma unroll
    for (int i = 0; i < 2; ++i) {
      f32x4 acc = {0.f, 0.f, 0.f, 0.f};
      acc = __builtin_amdgcn_mfma_f32_16x16x32_f16(a[i], qll, acc, 0, 0, 0);
      acc = __builtin_amdgcn_mfma_f32_16x16x32_f16(a[i], qlh, acc, 0, 0, 0);
#pragma unroll
      for (int h = 0; h < 8; ++h) {
        f32x4 d = {0.f, 0.f, 0.f, 0.f};
        d = __builtin_amdgcn_mfma_f32_16x16x32_f16(a[i], qf[h], d, 0, 0, 0);
#pragma unroll
        for (int r = 0; r < 4; ++r) acc[r] = __builtin_fmaf(__builtin_fabsf(d[r]), iw[h], acc[r]);
      }
#pragma unroll
      for (int r = 0; r < 4; ++r) sc[i * 4 + r] = acc[r];
    }
  };
  auto skey = [&](float s) __attribute__((always_inline)) -> uint32_t {
    s = s + 0.f;
    const uint32_t u_ = __float_as_uint(s);
    return (u_ & 0x80000000u) ? ~u_ : (u_ | 0x80000000u);
  };
  auto mkkey = [&](float s, int key) __attribute__((always_inline)) -> unsigned long long {
    s = s + 0.f;
    uint32_t u_ = __float_as_uint(s);
    u_ = (u_ & 0x80000000u) ? ~u_ : (u_ | 0x80000000u);
    return ((unsigned long long)u_ << 16) | (unsigned long long)(8191 - key);
  };
  auto scan_token = [&](int tk, int level) __attribute__((always_inline)) -> bool {
    const int shift = 40 - 8 * level;
    const uint32_t* hrow = hist + tk * 256;
    const uint4 hv = *(const uint4*)&hrow[252 - 4 * lane];
    const int c = (int)(hv.x + hv.y + hv.z + hv.w);
    int cum = c;
#pragma unroll
    for (int o = 1; o < 64; o <<= 1) {
      int v = __shfl_up(cum, o);
      if (lane >= o) cum += v;
    }
    const int nd = need[tk];
    const unsigned long long mask = __ballot(cum >= nd);
    const int L = mask ? (int)__builtin_ctzll(mask) : 63;
    int running = cum - c, bstar, cb;
    if (running + (int)hv.w >= nd) { bstar = 255 - 4 * lane; cb = hv.w; }
    else {
      running += hv.w;
      if (running + (int)hv.z >= nd) { bstar = 254 - 4 * lane; cb = hv.z; }
      else {
        running += hv.z;
        if (running + (int)hv.y >= nd) { bstar = 253 - 4 * lane; cb = hv.y; }
        else { running += hv.y; bstar = 252 - 4 * lane; cb = hv.x; }
      }
    }
    running = __shfl(running, L); bstar = __shfl(bstar, L); cb = __shfl(cb, L);
    const int nd2 = nd - running;
    const bool fin = (cb == nd2) || (level == 5);
    if (lane == 0) {
      const unsigned long long np = (pfx[tk] << 8) | (unsigned long long)bstar;
      if (fin) { state[tk] = 0; tkey[tk] = np << shift; }
      else { need[tk] = nd2; pfx[tk] = np; }
    }
    return fin;
  };
  auto run_level = [&](int level, bool fillx) __attribute__((always_inline)) {
    const int shift = 40 - 8 * level;
    for (int i = tid; i < 4096; i += 256) hist[i] = 0u;
    __syncthreads();
    {
      const unsigned long long mypfx = pfx[mytok];
      const bool act = state[mytok] == 1 && fastf[mytok] == 0;
      h8 na[2];
      if (wid < nkt) loadk(wid, na);
      for (int kt = wid; kt < nkt; kt += 4) {
        h8 ca[2];
#pragma unroll
        for (int i = 0; i < 2; ++i) ca[i] = na[i];
        loadk(kt + 4 < nkt ? kt + 4 : kt, na);
        float sc[8];
        scores(ca, sc);
        if (act) {
#pragma unroll
          for (int q = 0; q < 8; ++q) {
            const int key = kt * 32 + (q >> 2) * 16 + 4 * hq + (q & 3);
            if (key <= myt) {
              if (level < 2) {
                const uint32_t u32 = skey(sc[q]);
                if (level == 0) {
                  const uint32_t b8 = u32 >> 24;
                  atomicAdd(&hist[mytok * 256 + (int)b8], 1u);
                  if (fillx) {
                    const uint32_t ix = b8 - 0xBEu;
                    if (ix < 3u) {
                      const uint32_t e16 = (ix * 16u + (uint32_t)mytok) * 256u + ((u32 >> 16) & 255u);
                      atomicAdd(&h1w[e16 >> 1], (e16 & 1u) ? 65536u : 1u);
                    }
                  }
                } else if ((u32 >> 24) == (uint32_t)mypfx) atomicAdd(&hist[mytok * 256 + (int)((u32 >> 16) & 255u)], 1u);
              } else {
                const unsigned long long k48 = mkkey(sc[q], key);
                if ((k48 >> (shift + 8)) == mypfx)
                  atomicAdd(&hist[mytok * 256 + (int)((k48 >> shift) & 255ull)], 1u);
              }
            }
          }
        }
      }
    }
    __syncthreads();
    {
      int rem = 0;
      for (int j = 0; j < 4; ++j) {
        const int tk = wid * 4 + j;
        if (state[tk] != 1 || fastf[tk] != 0) continue;
        if (!scan_token(tk, level)) rem++;
      }
      if (lane == 0 && rem) atomicAdd(&nrem[level], rem);
    }
    __syncthreads();
  };

  run_level(0, true);
  if (tid < 16) {
    const int b0 = (int)pfx[tid];
    const int f = (state[tid] == 1 && b0 >= 0xBE && b0 <= 0xC0) ? 1 : 0;
    fastf[tid] = f;
    if (state[tid] == 1 && !f) atomicAdd(&nrem[7], 1);
  }
  __syncthreads();
  if (nrem[7] != 0) run_level(1, false);
  for (int j = 0; j < 4; ++j) {
    const int tk = wid * 4 + j;
    if (state[tk] != 1 || fastf[tk] == 0) continue;
    const uint32_t ix = (uint32_t)pfx[tk] - 0xBEu;
    const unsigned short* hx = (const unsigned short*)h1w + (ix * 16u + (uint32_t)tk) * 256u;
    const ushort4 c4 = *(const ushort4*)&hx[4 * lane];
    uint4 w4;
    w4.x = c4.x; w4.y = c4.y; w4.z = c4.z; w4.w = c4.w;
    *(uint4*)&hist[tk * 256 + 4 * lane] = w4;
    __builtin_amdgcn_wave_barrier();
    scan_token(tk, 1);
  }
  __syncthreads();
  if (tid < 16) fastf[tid] = 0;
  __syncthreads();

  {
    const int st0 = state[mytok];
    const unsigned long long mytk = tkey[mytok];
    const unsigned long long myp16 = pfx[mytok];
    h8 na[2];
    if (wid < nkt) loadk(wid, na);
    for (int kt = wid; kt < nkt; kt += 4) {
      h8 ca[2];
#pragma unroll
      for (int i = 0; i < 2; ++i) ca[i] = na[i];
      loadk(kt + 4 < nkt ? kt + 4 : kt, na);
      float sc[8];
      scores(ca, sc);
#pragma unroll
      for (int q = 0; q < 8; ++q) {
        const int key = kt * 32 + (q >> 2) * 16 + 4 * hq + (q & 3);
        if (key <= myt) {
          const uint32_t u32 = skey(sc[q]);
          bool take, isc = false;
          if (st0 == 0) take = (((unsigned long long)u32 << 16) | (unsigned long long)(8191 - key)) >= mytk;
          else {
            const uint32_t p16 = u32 >> 16;
            take = p16 > (uint32_t)myp16;
            isc = p16 == (uint32_t)myp16;
          }
          if (take) {
            const int pos = atomicAdd(&cnt[mytok], 1);
            if (pos < 256) sel[mytok * 256 + pos] = (unsigned short)key;
          } else if (isc) {
            const int pos = atomicAdd(&ccnt[mytok], 1);
            if (pos < DSA_CAP) cand[mytok * 128 + pos] = ((unsigned long long)u32 << 16) | (unsigned long long)(8191 - key);
          }
        }
      }
    }
  }
  __syncthreads();
  {
    int nov = 0;
    for (int j = 0; j < 4; ++j) {
      const int tk = wid * 4 + j;
      if (state[tk] != 1) continue;
      const int nc = ccnt[tk];
      if (nc > DSA_CAP) {
        nov++;
        if (lane == 0) { ovf[tk] = 1; pf16[tk] = (int)pfx[tk]; }
        continue;
      }
      const int nd = need[tk];
      const unsigned long long k0 = (lane < nc) ? cand[tk * 128 + lane] : 0ull;
      const unsigned long long k1 = (lane + 64 < nc) ? cand[tk * 128 + lane + 64] : 0ull;
      int r0 = 0, r1 = 0;
      for (int q = 0; q < nc; ++q) {
        const unsigned long long kq = cand[tk * 128 + q];
        r0 += (kq > k0) ? 1 : 0;
        r1 += (kq > k1) ? 1 : 0;
      }
      if (lane < nc && r0 < nd) {
        const int pos = atomicAdd(&cnt[tk], 1);
        if (pos < 256) sel[tk * 256 + pos] = (unsigned short)(8191 - (int)(k0 & 0xFFFFull));
      }
      if (lane + 64 < nc && r1 < nd) {
        const int pos = atomicAdd(&cnt[tk], 1);
        if (pos < 256) sel[tk * 256 + pos] = (unsigned short)(8191 - (int)(k1 & 0xFFFFull));
      }
      if (lane == 0) state[tk] = 2;
    }
    if (lane == 0 && nov) atomicAdd(&nrem[6], nov);
  }
  __syncthreads();
  if (nrem[6] != 0) {
    for (int level = 2; level < 6; ++level) {
      run_level(level, false);
      if (nrem[level] == 0) break;
    }
    {
      const bool mine = ovf[mytok] != 0;
      const unsigned long long mytk = tkey[mytok];
      const unsigned long long myp16 = (unsigned long long)(unsigned)pf16[mytok];
      h8 na[2];
      if (wid < nkt) loadk(wid, na);
      for (int kt = wid; kt < nkt; kt += 4) {
        h8 ca[2];
#pragma unroll
        for (int i = 0; i < 2; ++i) ca[i] = na[i];
        loadk(kt + 4 < nkt ? kt + 4 : kt, na);
        float sc[8];
        scores(ca, sc);
        if (mine) {
#pragma unroll
          for (int q = 0; q < 8; ++q) {
            const int key = kt * 32 + (q >> 2) * 16 + 4 * hq + (q & 3);
            if (key <= myt) {
              const unsigned long long k48 = mkkey(sc[q], key);
              if ((k48 >> 32) == myp16 && k48 >= mytk) {
                const int pos = atomicAdd(&cnt[mytok], 1);
                if (pos < 256) sel[mytok * 256 + pos] = (unsigned short)key;
              }
            }
          }
        }
      }
    }
    __syncthreads();
  }
#ifndef DSA_ATT_REP
#define DSA_ATT_REP 1
#endif
  for (int jr = 0; jr < 4 * DSA_ATT_REP; ++jr) {
    const int j = jr & 3;
    const int tk = wid * 4 + j;
    const int t = t0 + tk;
    const int nsel = min(cnt[tk], 256);
    const half_t* urow = ub + (size_t)t * NU;
    const int col = lane & 15;
    h8 q0, q1;
#pragma unroll
    for (int e = 0; e < 8; ++e) { q0[e] = (half_t)0.f; q1[e] = (half_t)0.f; }
    if (col < 8) {
      q0 = *(const h8*)(urow + C_BQ + col * 64 + hq * 8);
      q1 = *(const h8*)(urow + C_BQ + col * 64 + 32 + hq * 8);
    }
    float mx = NEGF;
#pragma unroll 1
    for (int mg = 0; mg < 2; ++mg) {
#pragma unroll
      for (int mm = 0; mm < 8; ++mm) {
        const int m = mg * 8 + mm;
        const int pos = m * 16 + col;
        const int s = (pos < nsel) ? (int)sel[tk * 256 + pos] : 0;
        const half_t* kp = ub + (size_t)s * NU + C_BK + hq * 8;
        const h8 a0 = *(const h8*)kp, a1 = *(const h8*)(kp + 32);
        f32x4 d = {0.f, 0.f, 0.f, 0.f};
        d = __builtin_amdgcn_mfma_f32_16x16x32_f16(a0, q0, d, 0, 0, 0);
        d = __builtin_amdgcn_mfma_f32_16x16x32_f16(a1, q1, d, 0, 0, 0);
#pragma unroll
        for (int r = 0; r < 4; ++r) {
          const int pp = m * 16 + hq * 4 + r;
          const float v = (pp < nsel) ? d[r] * 0.125f : NEGF;
          mx = fmaxf(mx, v);
          if (col < 8) pbuf[pp * 8 + col] = v;
        }
      }
    }
    mx = fmaxf(mx, __shfl_xor(mx, 16));
    mx = fmaxf(mx, __shfl_xor(mx, 32));
    const float mxh = __shfl(mx, lane & 7);
    __builtin_amdgcn_wave_barrier();
    float sum = 0.f;
#pragma unroll 4
    for (int k = 0; k < 32; ++k) {
      const int i = lane + 64 * k;
      const float v = pbuf[i];
      const float e = (v > -1e29f) ? __expf(v - mxh) : 0.f;
      pbuf[i] = e;
      sum += e;
    }
    sum += __shfl_xor(sum, 8);
    sum += __shfl_xor(sum, 16);
    sum += __shfl_xor(sum, 32);
    const float inv = 1.f / sum;
    __builtin_amdgcn_wave_barrier();
    {
      const int rs = lane >> 3, dc = lane & 7;
      float acc[8][8];
#pragma unroll
      for (int h = 0; h < 8; ++h)
#pragma unroll
        for (int e = 0; e < 8; ++e) acc[h][e] = 0.f;
#pragma unroll 1
      for (int g8 = 0; g8 < 4; ++g8) {
        h8 vv[8];
#pragma unroll
        for (int i = 0; i < 8; ++i) {
          const int pos = (g8 * 8 + i) * 8 + rs;
          const int s = (pos < nsel) ? (int)sel[tk * 256 + pos] : 0;
          vv[i] = *(const h8*)(ub + (size_t)s * NU + C_BV + dc * 8);
        }
#pragma unroll
        for (int i = 0; i < 8; ++i) {
          const int pos = (g8 * 8 + i) * 8 + rs;
          const f32x4 pa = *(const f32x4*)&pbuf[pos * 8];
          const f32x4 pb = *(const f32x4*)&pbuf[pos * 8 + 4];
          float vf[8];
#pragma unroll
          for (int e = 0; e < 8; ++e) vf[e] = (float)vv[i][e];
#pragma unroll
          for (int e = 0; e < 8; ++e) {
            acc[0][e] += pa[0] * vf[e]; acc[1][e] += pa[1] * vf[e]; acc[2][e] += pa[2] * vf[e]; acc[3][e] += pa[3] * vf[e];
            acc[4][e] += pb[0] * vf[e]; acc[5][e] += pb[1] * vf[e]; acc[6][e] += pb[2] * vf[e]; acc[7][e] += pb[3] * vf[e];
          }
        }
      }
      half_t* yrow = p.yb() + (size_t)(b * SEQ + t) * 512;
#pragma unroll
      for (int h = 0; h < 8; ++h) {
        const float invh = __shfl(inv, h);
        h8 ov;
        const h8 z8 = *(const h8*)(urow + C_BZ + h * 64 + dc * 8);
#pragma unroll
        for (int e = 0; e < 8; ++e) {
          float a = acc[h][e];
          a += __shfl_xor(a, 8);
          a += __shfl_xor(a, 16);
          a += __shfl_xor(a, 32);
          ov[e] = (half_t)(a * invh * siluf_((float)z8[e]));
        }
        if (rs == h) *(h8*)(yrow + h * 64 + dc * 8) = ov;
      }
    }
    __builtin_amdgcn_wave_barrier();
  }
  __syncthreads();
}

__device__ __forceinline__ void phase2(const KP& p, int l, char* smem, int* q, int xcc) {
  xcd_schedule(q, xcc, 32, 1, smem, [&](int grp, int) __attribute__((always_inline)) { compress_item(p, l, grp, smem); });
  xcd_schedule(q + 8, xcc, 1024, 1, smem, [&](int grp, int) __attribute__((always_inline)) {
    const int y = grp & 7, k = grp >> 3;
    dsa_item(p, y & 1, 511 - (k * 4 + (y >> 1)), smem);
  });
  xcd_schedule(q + 16, xcc, 512, 1, smem, [&](int grp, int) __attribute__((always_inline)) { pool_item(p, l, grp, smem); });
}

struct DState {
  float m, l;
  f32x16 o[2];
};
#define MLOW (-1e4f)
__device__ __forceinline__ void ds_reset(DState& st) {
  st.m = MLOW; st.l = 0.f;
#pragma unroll
  for (int dt = 0; dt < 2; ++dt)
#pragma unroll
    for (int r = 0; r < 16; ++r) st.o[dt][r] = 0.f;
}
typedef unsigned int u32x4 __attribute__((ext_vector_type(4)));
typedef unsigned int u32x2 __attribute__((ext_vector_type(2)));
struct StageRegs {
  u32x4 k0, k1, v0, v1;
};
template <bool HASV>
__device__ __forceinline__ void load_stage(StageRegs& r, const half_t* __restrict__ Kb, int ldk,
                                           const half_t* __restrict__ VT, int ldv, int key0, int tid) {
  const int row = tid >> 3, c = tid & 7;
  r.k0 = *(const u32x4*)(Kb + (size_t)(key0 + row) * ldk + c * 8);
  r.k1 = *(const u32x4*)(Kb + (size_t)(key0 + row + 32) * ldk + c * 8);
  if (HASV) {
    r.v0 = *(const u32x4*)(VT + (size_t)row * ldv + key0 + c * 8);
    r.v1 = *(const u32x4*)(VT + (size_t)(row + 32) * ldv + key0 + c * 8);
  }
}
template <bool HASV>
__device__ __forceinline__ void write_stage(const StageRegs& r, half_t* Ks, half_t* Vs, int tid) {
  const int row = tid >> 3, c = tid & 7;
  *(u32x4*)&Ks[row * 72 + c * 8] = r.k0;
  *(u32x4*)&Ks[(row + 32) * 72 + c * 8] = r.k1;
  if (HASV) {
    const int ks = c >> 1, a = c & 1;
    u32x2 lo, hi;
    lo[0] = r.v0[0]; lo[1] = r.v0[1]; hi[0] = r.v0[2]; hi[1] = r.v0[3];
    *(u32x2*)&Vs[row * 72 + ks * 16 + a * 4] = lo;
    *(u32x2*)&Vs[row * 72 + ks * 16 + 8 + a * 4] = hi;
    lo[0] = r.v1[0]; lo[1] = r.v1[1]; hi[0] = r.v1[2]; hi[1] = r.v1[3];
    *(u32x2*)&Vs[(row + 32) * 72 + ks * 16 + a * 4] = lo;
    *(u32x2*)&Vs[(row + 32) * 72 + ks * 16 + 8 + a * 4] = hi;
  }
}
template <bool ONLINE, bool HASV, bool FAST, class VF>
__device__ __forceinline__ void dense_block(DState& st, const half_t* Ks, const half_t* Vs, const h8* qf, int key0,
                                            int flag, VF valid, float fixed_m, float fixed_invl, f32x16* pout,
                                            int lane) {
  const int h = lane >> 5, c = lane & 31;
  f32x16 s[2];
#pragma unroll
  for (int kt = 0; kt < 2; ++kt) {
#pragma unroll
    for (int r = 0; r < 16; ++r) s[kt][r] = 0.f;
#pragma unroll
    for (int ks = 0; ks < 4; ++ks) {
      const h8 a = *(const h8*)&Ks[(32 * kt + c) * 72 + 16 * ks + 8 * h];
      s[kt] = __builtin_amdgcn_mfma_f32_32x32x16_f16(a, qf[ks], s[kt], 0, 0, 0);
    }
  }
  float cm = NEGF;
#pragma unroll
  for (int kt = 0; kt < 2; ++kt)
#pragma unroll
    for (int r = 0; r < 16; ++r) {
      const int key = key0 + 32 * kt + (r & 3) + 8 * (r >> 2) + 4 * h;
      const float v = (FAST ? (flag != 0) : valid(key, flag)) ? s[kt][r] : NEGF;
      s[kt][r] = v;
      cm = fmaxf(cm, v);
    }
  float mnew;
  if (ONLINE) {
    cm = fmaxf(cm, __shfl_xor(cm, 32));
    mnew = fmaxf(st.m, cm);
    if (__ballot(mnew > st.m) != 0ull) {
      const float alpha = __builtin_amdgcn_exp2f(st.m - mnew);
      st.m = mnew;
      st.l *= alpha;
      if (HASV) {
#pragma unroll
        for (int dt = 0; dt < 2; ++dt)
#pragma unroll
          for (int r = 0; r < 16; ++r) st.o[dt][r] *= alpha;
      }
    }
  } else {
    mnew = fixed_m;
  }
  float ps = 0.f;
#pragma unroll
  for (int kt = 0; kt < 2; ++kt)
#pragma unroll
    for (int r = 0; r < 16; ++r) {
      float e = __builtin_amdgcn_exp2f(s[kt][r] - mnew);
      if (!ONLINE) e *= fixed_invl;
      s[kt][r] = e;
      ps += e;
    }
  st.l += ps;
  if (pout) { pout[0] = s[0]; pout[1] = s[1]; }
  if (HASV) {
#pragma unroll
    for (int ks = 0; ks < 4; ++ks) {
      h8 pf;
#pragma unroll
      for (int jj = 0; jj < 8; ++jj) pf[jj] = (half_t)s[ks >> 1][8 * (ks & 1) + jj];
#pragma unroll
      for (int dt = 0; dt < 2; ++dt) {
        const h8 vf = *(const h8*)&Vs[(32 * dt + c) * 72 + 16 * ks + 8 * h];
        st.o[dt] = __builtin_amdgcn_mfma_f32_32x32x16_f16(vf, pf, st.o[dt], 0, 0, 0);
      }
    }
  }
}
template <bool ONLINE, bool HASV, bool WANTP, class PRE, class FU, class VF, class PO>
__device__ __forceinline__ void run_dense(DState& st, const half_t* __restrict__ Kb, int ldk,
                                          const half_t* __restrict__ VT, int ldv, int blk_lo, int blk_hi, const h8* qf,
                                          PRE pre, FU full, VF valid, float fixed_m, float fixed_invl, PO post, char* smem,
                                          int tid) {
  half_t* Ks = (half_t*)smem;
  half_t* Vs = Ks + 64 * 72;
  const int lane = tid & 63;
  StageRegs sr;
  load_stage<HASV>(sr, Kb, ldk, VT, ldv, blk_lo * 64, tid);
  for (int blk = blk_lo; blk <= blk_hi; ++blk) {
    __syncthreads();
    write_stage<HASV>(sr, Ks, Vs, tid);
    __syncthreads();
    const int nb = blk < blk_hi ? blk + 1 : blk;
    load_stage<HASV>(sr, Kb, ldk, VT, ldv, nb * 64, tid);
    const int flag = pre(blk);
    if (__ballot(flag != 0) != 0ull) {
      f32x16 pp[2];
      if (full(blk))
        dense_block<ONLINE, HASV, true>(st, Ks, Vs, qf, blk * 64, flag, valid, fixed_m, fixed_invl,
                                        WANTP ? pp : (f32x16*)nullptr, lane);
      else
        dense_block<ONLINE, HASV, false>(st, Ks, Vs, qf, blk * 64, flag, valid, fixed_m, fixed_invl,
                                         WANTP ? pp : (f32x16*)nullptr, lane);
      if (WANTP) post(blk * 64, pp);
    }
  }
}

__device__ __forceinline__ void nsa_item(const KP& p, int b, int g, int tile, char* smem) {
  int tid = threadIdx.x;
  asm volatile("" : "+v"(tid));
  const int lane = tid & 63, wid = tid >> 6;
  const int t0 = tile * 32;
  const int tw0 = t0 + 8 * wid;
  const int col = lane & 31, h = lane >> 5;
  const int j = col >> 2, r4 = col & 3;
  const int tj = tw0 + j;
  const int head = g * 4 + r4;
  float* impA = (float*)(smem + 18432 + wid * 8320);
  float* impB = impA + 1024;
  unsigned long long* msk = (unsigned long long*)(smem + 18432 + 4 * 8320 + wid * 128);
  const half_t* ub = p.u() + (size_t)b * SEQ * NU;
  const half_t* urow = ub + (size_t)tj * NU;
  h8 qf[4];
#pragma unroll
  for (int ks = 0; ks < 4; ++ks) {
    qf[ks] = *(const h8*)(urow + C_CQ + head * 64 + 16 * ks + 8 * h);
#pragma unroll
    for (int e = 0; e < 8; ++e) qf[ks][e] = (half_t)((float)qf[ks][e] * 0.18033688f);
  }
  float gate[3];
#pragma unroll
  for (int i = 0; i < 3; ++i) gate[i] = sigmoidf_((float)urow[C_CG + head * 3 + i]);
  f32x16 res[2];
#pragma unroll
  for (int dt = 0; dt < 2; ++dt)
#pragma unroll
    for (int r = 0; r < 16; ++r) res[dt][r] = 0.f;
  for (int i = lane; i < 2080; i += 64) impA[i] = 0.f;
  DState st;
  auto nopost = [&](int, f32x16*) __attribute__((always_inline)) {};

  {
    const int nmax_j = (tj >= 31) ? ((tj - 31) >> 4) : -1;
    const int bhi = (t0 >> 4) >> 6;
    const half_t* Kc = p.kcmp() + (size_t)(b * 2 + g) * 512 * 64;
    const half_t* Vc = p.vcmpT() + (size_t)(b * 2 + g) * 64 * 512;
    auto pre = [&](int) __attribute__((always_inline)) { return 1; };
    const int nmax_w = (tw0 >= 31) ? ((tw0 - 31) >> 4) : -1;
    auto fullc = [&](int blk) __attribute__((always_inline)) { return blk * 64 + 63 <= nmax_w; };
    auto vfn = [&](int n, int) __attribute__((always_inline)) { return n <= nmax_j; };
    ds_reset(st);
    run_dense<true, false, false>(st, Kc, 64, (const half_t*)nullptr, 0, 0, bhi, qf, pre, fullc, vfn, 0.f, 0.f, nopost, smem, tid);
    float lt = st.l;
    lt += __shfl_xor(lt, 32);
    const float mfix = st.m;
    const float invl = lt > 0.f ? 1.f / lt : 0.f;
    ds_reset(st);
    auto post = [&](int n0, f32x16* pp) __attribute__((always_inline)) {
#pragma unroll
      for (int kt = 0; kt < 2; ++kt)
#pragma unroll
        for (int qd = 0; qd < 4; ++qd) {
          float a = pp[kt][4 * qd] + pp[kt][4 * qd + 1] + pp[kt][4 * qd + 2] + pp[kt][4 * qd + 3];
          float bb = pp[kt][4 * qd + 3];
          a += __shfl_xor(a, 1); a += __shfl_xor(a, 2);
          bb += __shfl_xor(bb, 1); bb += __shfl_xor(bb, 2);
          if (r4 == 0) {
            const int sblk = (n0 >> 2) + 8 * kt + 2 * qd + h;
            impA[j * 128 + sblk] = a;
            impB[j * 132 + sblk + 1] = bb;
          }
        }
    };
    run_dense<false, true, true>(st, Kc, 64, Vc, 512, 0, bhi, qf, pre, fullc, vfn, mfix, invl, post, smem, tid);
#pragma unroll
    for (int dt = 0; dt < 2; ++dt)
#pragma unroll
      for (int r = 0; r < 16; ++r) res[dt][r] += gate[0] * st.o[dt][r];
  }
  __builtin_amdgcn_wave_barrier();
#pragma unroll 1
  for (int jj = 0; jj < 8; ++jj) {
    const int t = tw0 + jj;
    const int blk = t >> 6;
    uint32_t k0, k1;
    {
      const int s0 = lane, s1 = lane + 64;
      const float i0 = impA[jj * 128 + s0] + impB[jj * 132 + s0];
      const float i1 = impA[jj * 128 + s1] + impB[jj * 132 + s1];
      auto mk = [&](float im, int s) __attribute__((always_inline)) -> uint32_t {
        if (s > blk) return 0u;
        uint32_t kk = ((__float_as_uint(im) >> 1) & ~127u) | (uint32_t)(127 - s) | 0x40000000u;
        if (s == 0 || s == blk || s == blk - 1) kk |= 0x80000000u;
        return kk;
      };
      k0 = mk(i0, s0); k1 = mk(i1, s1);
    }
    unsigned long long lo = 0ull, hi = 0ull;
    for (int it = 0; it < 16; ++it) {
      uint32_t mxk = k0 > k1 ? k0 : k1;
#pragma unroll
      for (int o = 32; o > 0; o >>= 1) {
        const uint32_t ov = (uint32_t)__shfl_xor((int)mxk, o);
        mxk = ov > mxk ? ov : mxk;
      }
      mxk = (uint32_t)__builtin_amdgcn_readfirstlane((int)mxk);
      if (mxk == 0u) break;
      const int s = 127 - (int)(mxk & 127u);
      if (s < 64) lo |= 1ull << s; else hi |= 1ull << (s - 64);
      if (s == lane) k0 = 0u;
      if (s == lane + 64) k1 = 0u;
    }
    if (lane == 0) { msk[jj * 2] = lo; msk[jj * 2 + 1] = hi; }
  }
  __builtin_amdgcn_wave_barrier();
  const unsigned long long mylo = msk[j * 2], myhi = msk[j * 2 + 1];
  {
    const half_t* Ksel = ub + C_CKS + g * 64;
    const half_t* Vsel = p.vsT() + (size_t)(b * 2 + g) * 64 * SEQ;
    auto pre = [&](int blk) __attribute__((always_inline)) {
      const unsigned long long mm_ = (blk < 64) ? mylo : myhi;
      return (int)((mm_ >> (blk & 63)) & 1ull);
    };
    auto vfn = [&](int key, int flag) __attribute__((always_inline)) { return flag != 0 && key <= tj; };
    ds_reset(st);
    auto fulls = [&](int blk) __attribute__((always_inline)) { return blk * 64 + 63 <= tw0; };
    run_dense<true, true, false>(st, Ksel, NU, Vsel, SEQ, 0, (t0 + 31) >> 6, qf, pre, fulls, vfn, 0.f, 0.f, nopost, smem, tid);
    float lt = st.l;
    lt += __shfl_xor(lt, 32);
    const float sc = lt > 0.f ? gate[1] / lt : 0.f;
#pragma unroll
    for (int dt = 0; dt < 2; ++dt)
#pragma unroll
      for (int r = 0; r < 16; ++r) res[dt][r] += sc * st.o[dt][r];
  }
  {
    const half_t* Kw = ub + C_CKW + g * 64;
    const half_t* Vw = p.vwT() + (size_t)(b * 2 + g) * 64 * SEQ;
    auto pre = [&](int blk) __attribute__((always_inline)) {
      return (int)((blk * 64 <= tj) && (blk * 64 + 63 > tj - 512));
    };
    auto vfn = [&](int key, int) __attribute__((always_inline)) { return key <= tj && key > tj - 512; };
    ds_reset(st);
    auto fullw = [&](int blk) __attribute__((always_inline)) { return blk * 64 + 63 <= tw0 && blk * 64 > tw0 + 7 - 512; };
    run_dense<true, true, false>(st, Kw, NU, Vw, SEQ, max(0, t0 - 511) >> 6, (t0 + 31) >> 6, qf, pre, fullw, vfn, 0.f, 0.f,
                                 nopost, smem, tid);
    float lt = st.l;
    lt += __shfl_xor(lt, 32);
    const float sc = lt > 0.f ? gate[2] / lt : 0.f;
#pragma unroll
    for (int dt = 0; dt < 2; ++dt)
#pragma unroll
      for (int r = 0; r < 16; ++r) res[dt][r] += sc * st.o[dt][r];
  }
  half_t* yrow = p.yc() + (size_t)(b * SEQ + tj) * 512 + head * 64;
#pragma unroll
  for (int dt = 0; dt < 2; ++dt)
#pragma unroll
    for (int qd = 0; qd < 4; ++qd) {
      const int d = 32 * dt + 8 * qd + 4 * h;
      const h4 z = *(const h4*)(urow + C_CZ + head * 64 + d);
      h4 ov;
#pragma unroll
      for (int e = 0; e < 4; ++e) ov[e] = (half_t)(res[dt][4 * qd + e] * siluf_((float)z[e]));
      *(h4*)(yrow + d) = ov;
    }
  __syncthreads();
}

__device__ __forceinline__ void phase_nsa(const KP& p, char* smem, int* q, int xcc) {
  xcd_schedule(q, xcc, 1024, 1, smem, [&](int grp, int) __attribute__((always_inline)) {
    const int y = grp & 7, k = grp >> 3;
    const int b = y & 1, g = (y >> 1) & 1, tile = 255 - (k * 2 + (y >> 2));
    nsa_item(p, b, g, tile, smem);
  });
}

__device__ __forceinline__ void phase_merge(const KP& p, char* smem, int* q, int xcc) {
  xcd_schedule(q, xcc, 16, 64, smem, [&](int grp, int within) __attribute__((always_inline)) {
    const int mt = (grp & 15) * 8 + (within & 7), nt = (within >> 3);
    const int m0 = mt * 128, n0 = nt * 128;
    f32x16 tot[2][2];
#pragma unroll
    for (int i = 0; i < 2; ++i)
#pragma unroll
      for (int jn = 0; jn < 2; ++jn)
#pragma unroll
        for (int r = 0; r < 16; ++r) tot[i][jn][r] = 0.f;
#pragma unroll 1
    for (int br = 0; br < 3; ++br) {
      const half_t* A = (br == 0 ? p.ya() : (br == 1 ? p.yb() : p.yc())) + (size_t)m0 * 512;
      const half_t* B = p.wpT() + (size_t)br * DM * 512 + (size_t)n0 * 512;
      const half_t* G = p.u() + (size_t)m0 * NU + C_GM + br * 1024 + n0;
      gemm_tile<2>(
          512, [&](int r, int k) { return *(const uint4*)(A + (size_t)r * 512 + k); },
          [&](int r, int k) { return *(const uint4*)(B + (size_t)r * 512 + k); },
          [&](int mi, int ni, int r, int row, int col, float v) {
            const float gz = (float)G[(size_t)row * NU + col];
            tot[mi][ni][r] += sigmoidf_(gz) * v;
          },
          smem);
    }
    int tidx = threadIdx.x;
    asm volatile("" : "+v"(tidx));
    const int lane = tidx & 63, wid = tidx >> 6, wm = wid >> 1, wn = wid & 1;
#pragma unroll
    for (int mi = 0; mi < 2; ++mi)
#pragma unroll
      for (int ni = 0; ni < 2; ++ni)
#pragma unroll
        for (int r = 0; r < 16; ++r) {
          const int row = wm * 64 + mi * 32 + (r & 3) + 8 * (r >> 2) + 4 * (lane >> 5);
          const int col = wn * 64 + ni * 32 + (lane & 31);
          p.mm()[(size_t)(m0 + row) * DM + n0 + col] = (half_t)tot[mi][ni][r];
        }
  });
}

__device__ __forceinline__ void phase_outproj(const KP& p, char* smem, int* q, int xcc) {
  xcd_schedule(q, xcc, 16, 64, smem, [&](int grp, int within) __attribute__((always_inline)) {
    const int mt = (grp & 15) * 8 + (within & 7), nt = (within >> 3);
    const int m0 = mt * 128, n0 = nt * 128;
    const half_t* A = p.mm() + (size_t)m0 * DM;
    const half_t* B = p.woT() + (size_t)n0 * DM;
    gemm_tile<2>(
        DM, [&](int r, int k) { return *(const uint4*)(A + (size_t)r * DM + k); },
        [&](int r, int k) { return *(const uint4*)(B + (size_t)r * DM + k); },
        [&](int mi, int ni, int r, int row, int col, float v) {
          const size_t xi = (size_t)(m0 + row) * DM + n0 + col;
          ((float*)p.u())[xi] = ALPHA_F * p.xr()[xi] + v;
        },
        smem);
  });
}


#define XB_TMO      128
#define XB_XCNT(j)  (256  + 64 * (j))
#define XB_XSUB(j)  (1280 + 64 * (j))
#define XB_XGEN(j)  (2304 + 64 * (j))
#define XB_TOP      3328
#define XB_TOPGEN   3392
#define XCD_BAR_WORDS 3456
#define XB_SPIN_CAP (1u << 20)
#define LAS __attribute__((address_space(3)))
__device__ __forceinline__ unsigned xb_ld(unsigned* p)              { return __hip_atomic_load(p, __ATOMIC_RELAXED, __HIP_MEMORY_SCOPE_AGENT); }
__device__ __forceinline__ unsigned xb_add(unsigned* p, unsigned v) { return __hip_atomic_fetch_add(p, v, __ATOMIC_RELAXED, __HIP_MEMORY_SCOPE_AGENT); }
__device__ __forceinline__ unsigned xb_xcc_id() { return (unsigned)__builtin_amdgcn_s_getreg((3 << 11) | 20) & 0xFu; }
#define XB_SPIN(cond, bar) do { unsigned _sp = 0; while (cond) { __builtin_amdgcn_s_sleep(1); \
    if ((++_sp & 255u) == 0u) { if (xb_ld(&(bar)[XB_TMO])) break; if (_sp > XB_SPIN_CAP) { atomicAdd(&(bar)[XB_TMO], 1u); break; } } } } while (0)
struct XcdBarrier { unsigned* bar; unsigned x; volatile LAS unsigned* st; };
__device__ __forceinline__ XcdBarrier xcd_barrier_post(unsigned* bar, volatile LAS unsigned* st) {
  XcdBarrier b; b.bar = bar; b.x = xb_xcc_id(); b.st = st;
  if (threadIdx.x == 0) (void)xb_add(&bar[XB_XCNT(b.x)], 1u);
  return b;
}
__device__ __forceinline__ void xcd_barrier_complete(unsigned* bar, unsigned x, unsigned& nloc, unsigned& nx) {
  const unsigned G = gridDim.x * gridDim.y * gridDim.z;
  unsigned sum, cnt, mine, sp = 0u;
  for (;;) {
    sum = 0u; cnt = 0u; mine = 0u;
#pragma unroll
    for (unsigned j = 0; j < 16; ++j) { const unsigned c = xb_ld(&bar[XB_XCNT(j)]); sum += c; cnt += (c > 0u) ? 1u : 0u; mine = (j == x) ? c : mine; }
    if (sum == G) break;
    __builtin_amdgcn_s_sleep(1);
    if ((++sp & 255u) == 0u) { if (xb_ld(&bar[XB_TMO])) break; if (sp > XB_SPIN_CAP) { atomicAdd(&bar[XB_TMO], 1u); break; } }
  }
  nloc = mine > 0u ? mine : 1u; nx = cnt > 0u ? cnt : 1u;
}
__device__ __forceinline__ void xcd_barrier(const XcdBarrier& b) {
  asm volatile("s_waitcnt vmcnt(0)" ::: "memory");
  __syncthreads();
  if (threadIdx.x == 0) {
    unsigned* bar = b.bar;
    __builtin_amdgcn_s_waitcnt(0);
    unsigned nloc = b.st[0], nx = b.st[1];
    if (nloc == 0u) { xcd_barrier_complete(bar, b.x, nloc, nx); b.st[0] = nloc; b.st[1] = nx; }
    const unsigned old = xb_add(&bar[XB_XSUB(b.x)], 1u);
    const unsigned gen = old / nloc;
    if (old + 1u == (gen + 1u) * nloc) {
      __builtin_amdgcn_fence(__ATOMIC_RELEASE, "agent");
      asm volatile("s_waitcnt vmcnt(0)" ::: "memory");
      const unsigned og = xb_add(&bar[XB_TOP], 1u);
      const unsigned tg = og / nx;
      if (og + 1u == (tg + 1u) * nx) xb_add(&bar[XB_TOPGEN], 1u);
      else XB_SPIN(xb_ld(&bar[XB_TOPGEN]) == tg, bar);
      __builtin_amdgcn_fence(__ATOMIC_ACQUIRE, "agent");
      xb_add(&bar[XB_XGEN(b.x)], 1u);
      asm volatile("s_waitcnt vmcnt(0)" ::: "memory");
    } else {
      XB_SPIN(xb_ld(&bar[XB_XGEN(b.x)]) == gen, bar);
      __builtin_amdgcn_fence(__ATOMIC_ACQUIRE, "agent");
      asm volatile("s_waitcnt vmcnt(0)" ::: "memory");
    }
  }
  __syncthreads();
}

#define NQ_WORDS 4096
__global__ void __launch_bounds__(256, 2) fwd_megakernel(Params p_unused) {
  cg::grid_group grid = cg::this_grid();
  __shared__ __attribute__((aligned(16))) char smem[SMEM_BYTES];
  volatile LAS unsigned* st = (volatile LAS unsigned*)(smem + SMEM_BYTES - 32);
  if (threadIdx.x == 0) { st[0] = 0u; st[1] = 0u; }
  {
    const KP p = get_params();
    if (blockIdx.x == 0)
      for (int i = threadIdx.x; i < NQ_WORDS + XCD_BAR_WORDS; i += 256) p.counters()[i] = 0;
    ln_rows(p, -1, false);
    prep_weights(p, 0, smem);
  }
  grid.sync();
  XcdBarrier xb;
  {
    const KP p = get_params();
    xb = xcd_barrier_post((unsigned*)p.counters() + NQ_WORDS, st);
  }
  const int xcc = (int)(xb.x & 7u);
#ifndef REP1
#define REP1 1
#define REP2 1
#define REP3 1
#define REP4 1
#endif
#ifndef REP5
#define REP5 1
#define REP6 1
#define REP7 0
#endif
#pragma unroll 1
  for (int l = 0; l < DEPTH; ++l) {
#define QPTR(ph, rep) (p.counters() + ((l * 6 + (ph)) * 4 + (rep)) * 32)
    for (int rep = 0; rep < REP1; ++rep) { const KP p = get_params(); phase_inproj(p, l, smem, QPTR(0, rep), xcc); }
    xcd_barrier(xb);
    for (int rep = 0; rep < REP2; ++rep) { const KP p = get_params(); phase2(p, l, smem, QPTR(1, rep), xcc); }
    xcd_barrier(xb);
    for (int rep = 0; rep < REP3; ++rep) { const KP p = get_params(); phase_nsa(p, smem, QPTR(2, rep), xcc); }
    xcd_barrier(xb);
    for (int rep = 0; rep < REP4; ++rep) { const KP p = get_params(); phase_merge(p, smem, QPTR(3, rep), xcc); }
    xcd_barrier(xb);
    for (int rep = 0; rep < REP5; ++rep) { const KP p = get_params(); phase_outproj(p, smem, QPTR(4, rep), xcc); }
    xcd_barrier(xb);
    for (int rep = 0; rep < REP6; ++rep) {
      const KP p = get_params();
      if (l + 1 < DEPTH) {
        ln_rows(p, l, false);
        prep_weights(p, l + 1, smem);
      } else {
        ln_rows(p, l, true);
      }
    }
    if (l + 1 < DEPTH) xcd_barrier(xb);
    for (int rep = 0; rep < REP7; ++rep) xcd_barrier(xb);
  }
}

extern "C" void kernel_launch(void* const* d_in, const int* in_sizes, int n_in, void* d_out, int out_size,
                              void* d_ws, size_t ws_size, hipStream_t stream) {
  static int grid_blocks = 0;
  if (!grid_blocks) {
    int dev = 0, cus = 0, per_cu = 0;
    (void)hipGetDevice(&dev);
    (void)hipDeviceGetAttribute(&cus, hipDeviceAttributeMultiprocessorCount, dev);
    (void)hipOccupancyMaxActiveBlocksPerMultiprocessor(&per_cu, fwd_megakernel, 256, 0);
    if (per_cu > 2) per_cu = 2;
    if (per_cu < 1) per_cu = 1;
    grid_blocks = cus * per_cu;
  }
  Params p{};
  p.x = (const float*)d_in[0]; p.w_in = (const float*)d_in[1]; p.b_in = (const float*)d_in[2];
  p.pool_w = (const float*)d_in[3]; p.pool_b = (const float*)d_in[4]; p.pool_scale = (const float*)d_in[5];
  p.pos_k = (const float*)d_in[6]; p.pos_v = (const float*)d_in[7]; p.w1k = (const float*)d_in[8];
  p.w2k = (const float*)d_in[9]; p.w1v = (const float*)d_in[10]; p.w2v = (const float*)d_in[11];
  p.wpa = (const float*)d_in[12]; p.wpb = (const float*)d_in[13]; p.wpc = (const float*)d_in[14];
  p.wo = (const float*)d_in[15]; p.ln_g = (const float*)d_in[16]; p.ln_b = (const float*)d_in[17];
  p.out = (float*)d_out;
  p.ws = (char*)d_ws;
  if (WS_TOTAL > ws_size) { fprintf(stderr, "workspace too small: need %zu have %zu\n", (size_t)WS_TOTAL, ws_size); return; }
  void* args[] = {&p};
  hipError_t e = hipLaunchCooperativeKernel((void*)fwd_megakernel, dim3(grid_blocks), dim3(256), args, 0, stream);
  if (e != hipSuccess) fprintf(stderr, "cooperative launch failed: %s (grid %d)\n", hipGetErrorString(e), grid_blocks);
}
```

```cpp
#include <hip/hip_runtime.h>
#include <hip/hip_cooperative_groups.h>
#include <cstdio>
#include <cstdint>
namespace cg = cooperative_groups;

typedef _Float16 half_t;
typedef _Float16 h8 __attribute__((ext_vector_type(8)));
typedef _Float16 h4 __attribute__((ext_vector_type(4)));
typedef float f32x4 __attribute__((ext_vector_type(4)));
typedef float f32x16 __attribute__((ext_vector_type(16)));

#define SEQ 8192
#define DM 1024
#define NTOK 16384
#define DEPTH 4
#define NIN 7360
#define NU 7424
#define ALPHA_F 1.681792830507429f
#define NEGF (-1e30f)

#define C_AX 0
#define C_AZ 512
#define C_BQ 1024
#define C_BZ 1536
#define C_CQ 2048
#define C_CZ 2560
#define C_GM 3072
#define C_IQ 6144
#define C_CKC 6400
#define C_CVC 6528
#define C_CKS 6656
#define C_CVS 6784
#define C_CKW 6912
#define C_CVW 7040
#define C_BK 7168
#define C_BV 7232
#define C_IK 7296
#define C_IW 7328
#define C_CG 7336

#define SMEM_BYTES 73728

constexpr size_t OFF_xr = 0;
constexpr size_t OFF_xh = OFF_xr + (((size_t)NTOK*DM*4 + 255) & ~(size_t)255);
constexpr size_t OFF_u = OFF_xh + (((size_t)NTOK*DM*2 + 255) & ~(size_t)255);
constexpr size_t OFF_winT = OFF_u + (((size_t)NTOK*NU*2 + 255) & ~(size_t)255);
constexpr size_t OFF_wpT = OFF_winT + (((size_t)NU*DM*2 + 255) & ~(size_t)255);
constexpr size_t OFF_woT = OFF_wpT + (((size_t)3*DM*512*2 + 255) & ~(size_t)255);
constexpr size_t OFF_poolT = OFF_woT + (((size_t)DM*DM*2 + 255) & ~(size_t)255);
constexpr size_t OFF_w1T = OFF_poolT + (((size_t)4*128*128*2 + 255) & ~(size_t)255);
constexpr size_t OFF_posb = OFF_w1T + (((size_t)2*64*2048*2 + 255) & ~(size_t)255);
constexpr size_t OFF_vsT = OFF_posb + (((size_t)512 + 255) & ~(size_t)255);
constexpr size_t OFF_vwT = OFF_vsT + (((size_t)4*64*SEQ*2 + 255) & ~(size_t)255);
constexpr size_t OFF_kcmp = OFF_vwT + (((size_t)4*64*SEQ*2 + 255) & ~(size_t)255);
constexpr size_t OFF_vcmpT = OFF_kcmp + (((size_t)4*512*64*2 + 255) & ~(size_t)255);
constexpr size_t OFF_ya = OFF_vcmpT + (((size_t)4*64*512*2 + 255) & ~(size_t)255);
constexpr size_t OFF_yb = OFF_ya + (((size_t)NTOK*512*2 + 255) & ~(size_t)255);
constexpr size_t OFF_yc = OFF_yb + (((size_t)NTOK*512*2 + 255) & ~(size_t)255);
constexpr size_t OFF_mm = OFF_yc + (((size_t)NTOK*512*2 + 255) & ~(size_t)255);
constexpr size_t OFF_counters = OFF_mm + (((size_t)NTOK*DM*2 + 255) & ~(size_t)255);
constexpr size_t WS_TOTAL = OFF_counters + (((size_t)32768 + 255) & ~(size_t)255);
struct Params {
  const float* x; const float* w_in; const float* b_in; const float* pool_w; const float* pool_b;
  const float* pool_scale; const float* pos_k; const float* pos_v; const float* w1k; const float* w2k;
  const float* w1v; const float* w2v; const float* wpa; const float* wpb; const float* wpc;
  const float* wo; const float* ln_g; const float* ln_b;
  float* out;
  char* ws;
};
typedef const __attribute__((address_space(4))) unsigned long long* kargp_t;
struct KP {
  kargp_t kp;
  __device__ __forceinline__ const float* x() const { return (const float*)(const __attribute__((address_space(1))) float*)kp[0]; }
  __device__ __forceinline__ const float* w_in() const { return (const float*)(const __attribute__((address_space(1))) float*)kp[1]; }
  __device__ __forceinline__ const float* b_in() const { return (const float*)(const __attribute__((address_space(1))) float*)kp[2]; }
  __device__ __forceinline__ const float* pool_w() const { return (const float*)(const __attribute__((address_space(1))) float*)kp[3]; }
  __device__ __forceinline__ const float* pool_b() const { return (const float*)(const __attribute__((address_space(1))) float*)kp[4]; }
  __device__ __forceinline__ const float* pool_scale() const { return (const float*)(const __attribute__((address_space(1))) float*)kp[5]; }
  __device__ __forceinline__ const float* pos_k() const { return (const float*)(const __attribute__((address_space(1))) float*)kp[6]; }
  __device__ __forceinline__ const float* pos_v() const { return (const float*)(const __attribute__((address_space(1))) float*)kp[7]; }
  __device__ __forceinline__ const float* w1k() const { return (const float*)(const __attribute__((address_space(1))) float*)kp[8]; }
  __device__ __forceinline__ const float* w2k() const { return (const float*)(const __attribute__((address_space(1))) float*)kp[9]; }
  __device__ __forceinline__ const float* w1v() const { return (const float*)(const __attribute__((address_space(1))) float*)kp[10]; }
  __device__ __forceinline__ const float* w2v() const { return (const float*)(const __attribute__((address_space(1))) float*)kp[11]; }
  __device__ __forceinline__ const float* wpa() const { return (const float*)(const __attribute__((address_space(1))) float*)kp[12]; }
  __device__ __forceinline__ const float* wpb() const { return (const float*)(const __attribute__((address_space(1))) float*)kp[13]; }
  __device__ __forceinline__ const float* wpc() const { return (const float*)(const __attribute__((address_space(1))) float*)kp[14]; }
  __device__ __forceinline__ const float* wo() const { return (const float*)(const __attribute__((address_space(1))) float*)kp[15]; }
  __device__ __forceinline__ const float* ln_g() const { return (const float*)(const __attribute__((address_space(1))) float*)kp[16]; }
  __device__ __forceinline__ const float* ln_b() const { return (const float*)(const __attribute__((address_space(1))) float*)kp[17]; }
  __device__ __forceinline__ float* out() const { return (float*)(__attribute__((address_space(1))) float*)kp[18]; }
  __device__ __forceinline__ char* ws() const { return (char*)(__attribute__((address_space(1))) char*)kp[19]; }
  __device__ __forceinline__ float* xr() const { return (float*)(ws() + OFF_xr); }
  __device__ __forceinline__ half_t* xh() const { return (half_t*)(ws() + OFF_xh); }
  __device__ __forceinline__ half_t* u() const { return (half_t*)(ws() + OFF_u); }
  __device__ __forceinline__ half_t* winT() const { return (half_t*)(ws() + OFF_winT); }
  __device__ __forceinline__ half_t* wpT() const { return (half_t*)(ws() + OFF_wpT); }
  __device__ __forceinline__ half_t* woT() const { return (half_t*)(ws() + OFF_woT); }
  __device__ __forceinline__ half_t* poolT() const { return (half_t*)(ws() + OFF_poolT); }
  __device__ __forceinline__ half_t* w1T() const { return (half_t*)(ws() + OFF_w1T); }
  __device__ __forceinline__ float* posb() const { return (float*)(ws() + OFF_posb); }
  __device__ __forceinline__ half_t* vsT() const { return (half_t*)(ws() + OFF_vsT); }
  __device__ __forceinline__ half_t* vwT() const { return (half_t*)(ws() + OFF_vwT); }
  __device__ __forceinline__ half_t* kcmp() const { return (half_t*)(ws() + OFF_kcmp); }
  __device__ __forceinline__ half_t* vcmpT() const { return (half_t*)(ws() + OFF_vcmpT); }
  __device__ __forceinline__ half_t* ya() const { return (half_t*)(ws() + OFF_ya); }
  __device__ __forceinline__ half_t* yb() const { return (half_t*)(ws() + OFF_yb); }
  __device__ __forceinline__ half_t* yc() const { return (half_t*)(ws() + OFF_yc); }
  __device__ __forceinline__ half_t* mm() const { return (half_t*)(ws() + OFF_mm); }
  __device__ __forceinline__ int* counters() const { return (int*)(ws() + OFF_counters); }
};
__device__ __forceinline__ KP get_params() {
  KP q;
  q.kp = (kargp_t)__builtin_amdgcn_kernarg_segment_ptr();
  asm volatile("" : "+s"(q.kp));
  return q;
}


__device__ __forceinline__ int orig_col(int n) {
  if (n < 1536) return n;
  if (n < 2048) return 1664 + (n - 1536);
  if (n < 2560) return 2472 + (n - 2048);
  if (n < 3072) return 3776 + (n - 2560);
  if (n < 6144) return 4288 + (n - 3072);
  if (n < 6400) return 2176 + (n - 6144);
  if (n < 7168) return 2984 + (n - 6400);
  if (n < 7296) return 1536 + (n - 7168);
  if (n < 7328) return 2432 + (n - 7296);
  if (n < 7336) return 2464 + (n - 7328);
  if (n < 7360) return 3752 + (n - 7336);
  return -1;
}

__device__ __forceinline__ float wave_sum(float v) {
#pragma unroll
  for (int o = 32; o > 0; o >>= 1) v += __shfl_xor(v, o);
  return v;
}
__device__ __forceinline__ float sigmoidf_(float x) { return 1.f / (1.f + __expf(-x)); }
__device__ __forceinline__ float siluf_(float x) { return x / (1.f + __expf(-x)); }

template <int NI, class LA, class LB, class EP>
__device__ __forceinline__ void gemm_tile(int K, LA loadA, LB loadB, EP epi, char* smem) {
  constexpr int BN = NI * 64;
  constexpr int NB = BN / 32;
  half_t* sA = (half_t*)smem;
  half_t* sB = sA + 128 * 72;
  int tid = threadIdx.x;
  asm volatile("" : "+v"(tid));
  const int lane = tid & 63, wid = tid >> 6;
  const int wm = wid >> 1, wn = wid & 1;
  f32x16 acc[2][NI];
#pragma unroll
  for (int i = 0; i < 2; ++i)
#pragma unroll
    for (int j = 0; j < NI; ++j)
#pragma unroll
      for (int r = 0; r < 16; ++r) acc[i][j][r] = 0.f;
  const int lr = tid >> 3, lc = (tid & 7) * 8;
  uint4 ra[4], rb[NB];
#pragma unroll
  for (int i = 0; i < 4; ++i) ra[i] = loadA(lr + 32 * i, lc);
#pragma unroll
  for (int i = 0; i < NB; ++i) rb[i] = loadB(lr + 32 * i, lc);
  const int nk = K >> 6;
  for (int kt = 0; kt < nk; ++kt) {
    __syncthreads();
#pragma unroll
    for (int i = 0; i < 4; ++i) *(uint4*)&sA[(lr + 32 * i) * 72 + lc] = ra[i];
#pragma unroll
    for (int i = 0; i < NB; ++i) *(uint4*)&sB[(lr + 32 * i) * 72 + lc] = rb[i];
    __syncthreads();
    if (kt + 1 < nk) {
      const int kk = (kt + 1) * 64 + lc;
#pragma unroll
      for (int i = 0; i < 4; ++i) ra[i] = loadA(lr + 32 * i, kk);
#pragma unroll
      for (int i = 0; i < NB; ++i) rb[i] = loadB(lr + 32 * i, kk);
    }
#pragma unroll
    for (int s = 0; s < 4; ++s) {
      h8 af[2], bf[NI];
#pragma unroll
      for (int mi = 0; mi < 2; ++mi)
        af[mi] = *(const h8*)&sA[(wm * 64 + mi * 32 + (lane & 31)) * 72 + s * 16 + (lane >> 5) * 8];
#pragma unroll
      for (int ni = 0; ni < NI; ++ni)
        bf[ni] = *(const h8*)&sB[(wn * (NI * 32) + ni * 32 + (lane & 31)) * 72 + s * 16 + (lane >> 5) * 8];
#pragma unroll
      for (int mi = 0; mi < 2; ++mi)
#pragma unroll
        for (int ni = 0; ni < NI; ++ni)
          acc[mi][ni] = __builtin_amdgcn_mfma_f32_32x32x16_f16(af[mi], bf[ni], acc[mi][ni], 0, 0, 0);
    }
  }
#pragma unroll
  for (int mi = 0; mi < 2; ++mi)
#pragma unroll
    for (int ni = 0; ni < NI; ++ni)
#pragma unroll
      for (int r = 0; r < 16; ++r) {
        const int row = wm * 64 + mi * 32 + (r & 3) + 8 * (r >> 2) + 4 * (lane >> 5);
        const int col = wn * (NI * 32) + ni * 32 + (lane & 31);
        epi(mi, ni, r, row, col, acc[mi][ni][r]);
      }
}

template <class LA, class LB, class EP>
__device__ __forceinline__ void gemm_tile_big(int K, LA loadA, LB loadB, EP epi, char* smem) {
  half_t* sA = (half_t*)smem;
  half_t* sB = sA + 256 * 72;
  int tid = threadIdx.x;
  asm volatile("" : "+v"(tid));
  const int lane = tid & 63, wid = tid >> 6;
  const int wm = wid >> 1, wn = wid & 1;
  f32x16 acc[4][2];
#pragma unroll
  for (int i = 0; i < 4; ++i)
#pragma unroll
    for (int j = 0; j < 2; ++j)
#pragma unroll
      for (int r = 0; r < 16; ++r) acc[i][j][r] = 0.f;
  const int lr = tid >> 3, lc = (tid & 7) * 8;
  uint4 ra[8], rb[4];
#pragma unroll
  for (int i = 0; i < 8; ++i) ra[i] = loadA(lr + 32 * i, lc);
#pragma unroll
  for (int i = 0; i < 4; ++i) rb[i] = loadB(lr + 32 * i, lc);
  const int nk = K >> 6;
  for (int kt = 0; kt < nk; ++kt) {
    __syncthreads();
#pragma unroll
    for (int i = 0; i < 8; ++i) *(uint4*)&sA[(lr + 32 * i) * 72 + lc] = ra[i];
#pragma unroll
    for (int i = 0; i < 4; ++i) *(uint4*)&sB[(lr + 32 * i) * 72 + lc] = rb[i];
    __syncthreads();
    if (kt + 1 < nk) {
      const int kk = (kt + 1) * 64 + lc;
#pragma unroll
      for (int i = 0; i < 8; ++i) ra[i] = loadA(lr + 32 * i, kk);
#pragma unroll
      for (int i = 0; i < 4; ++i) rb[i] = loadB(lr + 32 * i, kk);
    }
#pragma unroll
    for (int s = 0; s < 4; ++s) {
      h8 af[4], bf[2];
#pragma unroll
      for (int mi = 0; mi < 4; ++mi)
        af[mi] = *(const h8*)&sA[(wm * 128 + mi * 32 + (lane & 31)) * 72 + s * 16 + (lane >> 5) * 8];
#pragma unroll
      for (int ni = 0; ni < 2; ++ni)
        bf[ni] = *(const h8*)&sB[(wn * 64 + ni * 32 + (lane & 31)) * 72 + s * 16 + (lane >> 5) * 8];
#pragma unroll
      for (int mi = 0; mi < 4; ++mi)
#pragma unroll
        for (int ni = 0; ni < 2; ++ni)
          acc[mi][ni] = __builtin_amdgcn_mfma_f32_32x32x16_f16(af[mi], bf[ni], acc[mi][ni], 0, 0, 0);
    }
  }
#pragma unroll
  for (int mi = 0; mi < 4; ++mi)
#pragma unroll
    for (int ni = 0; ni < 2; ++ni)
#pragma unroll
      for (int r = 0; r < 16; ++r) {
        const int row = wm * 128 + mi * 32 + (r & 3) + 8 * (r >> 2) + 4 * (lane >> 5);
        const int col = wn * 64 + ni * 32 + (lane & 31);
        epi(mi, ni, r, row, col, acc[mi][ni][r]);
      }
}

template <class CM>
__device__ __forceinline__ void tconv_tile(const float* __restrict__ src, int lds_, half_t* __restrict__ dst, int ldd,
                                           int n0, int k0, CM cmap, char* smem) {
  float* t = (float*)smem;
  int tid = threadIdx.x;
  asm volatile("" : "+v"(tid));
  {
    const int n = tid & 63;
    const int c = cmap(n0 + n);
    float tv[16];
#pragma unroll
    for (int i = 0; i < 16; ++i) {
      const int k = (tid >> 6) + 4 * i;
      tv[i] = (c >= 0) ? src[(size_t)(k0 + k) * lds_ + c] : 0.f;
    }
#pragma unroll
    for (int i = 0; i < 16; ++i) {
      const int k = (tid >> 6) + 4 * i;
      t[k * 65 + n] = tv[i];
    }
  }
  __syncthreads();
#pragma unroll
  for (int i = 0; i < 2; ++i) {
    const int idx = tid + 256 * i;
    const int n = idx >> 3, kc = (idx & 7) * 8;
    h8 v;
#pragma unroll
    for (int j = 0; j < 8; ++j) v[j] = (half_t)t[(kc + j) * 65 + n];
    *(h8*)&dst[(size_t)(n0 + n) * ldd + k0 + kc] = v;
  }
  __syncthreads();
}

__device__ __forceinline__ void ln_rows(const KP& p, int lprev, bool final_) {
  int tid = threadIdx.x;
  asm volatile("" : "+v"(tid));
  const int lane = tid & 63, wid = tid >> 6;
  const int gw = blockIdx.x * 4 + wid, nw = gridDim.x * 4;
  for (int row = gw; row < NTOK; row += nw) {
    const float4* rp = (const float4*)((lprev < 0 ? p.x() : (const float*)p.u()) + (size_t)row * DM);
    float4 v[4];
    float s = 0.f;
#pragma unroll
    for (int i = 0; i < 4; ++i) {
      v[i] = rp[lane + 64 * i];
      s += v[i].x + v[i].y + v[i].z + v[i].w;
    }
    if (lprev >= 0) {
      float mu = wave_sum(s) * (1.f / DM);
      float q = 0.f;
#pragma unroll
      for (int i = 0; i < 4; ++i) {
        float a = v[i].x - mu, b = v[i].y - mu, c = v[i].z - mu, d = v[i].w - mu;
        q += a * a + b * b + c * c + d * d;
      }
      float rstd = rsqrtf(wave_sum(q) * (1.f / DM) + 1e-5f);
      const float4* g4 = (const float4*)(p.ln_g() + lprev * DM);
      const float4* b4 = (const float4*)(p.ln_b() + lprev * DM);
#pragma unroll
      for (int i = 0; i < 4; ++i) {
        float4 g = g4[lane + 64 * i], bb = b4[lane + 64 * i];
        v[i].x = (v[i].x - mu) * rstd * g.x + bb.x;
        v[i].y = (v[i].y - mu) * rstd * g.y + bb.y;
        v[i].z = (v[i].z - mu) * rstd * g.z + bb.z;
        v[i].w = (v[i].w - mu) * rstd * g.w + bb.w;
      }
    }
    if (final_) {
      float4* op = (float4*)(p.out() + (size_t)row * DM);
#pragma unroll
      for (int i = 0; i < 4; ++i) op[lane + 64 * i] = v[i];
    } else {
      float4* op = (float4*)(p.xr() + (size_t)row * DM);
      h4* hp = (h4*)(p.xh() + (size_t)row * DM);
#pragma unroll
      for (int i = 0; i < 4; ++i) {
        op[lane + 64 * i] = v[i];
        h4 hv;
        hv[0] = (half_t)v[i].x; hv[1] = (half_t)v[i].y; hv[2] = (half_t)v[i].z; hv[3] = (half_t)v[i].w;
        hp[lane + 64 * i] = hv;
      }
    }
  }
}

__device__ __forceinline__ void prep_weights(const KP& p, int l, char* smem) {
  int tid = threadIdx.x;
  asm volatile("" : "+v"(tid));
  const int total = 1856 + 384 + 256 + 16 + 64 + 2;
  for (int it = blockIdx.x; it < total; it += gridDim.x) {
    if (it < 1856) {
      const int nt = it >> 4, kt = it & 15;
      tconv_tile(p.w_in() + (size_t)l * DM * NIN, NIN, p.winT(), DM, nt * 64, kt * 64,
                 [](int n) { return orig_col(n); }, smem);
    } else if (it < 1856 + 384) {
      const int j = it - 1856;
      const int w = j >> 7, r = j & 127, nt = r >> 3, kt = r & 7;
      const float* src = (w == 0 ? p.wpa() : (w == 1 ? p.wpb() : p.wpc())) + (size_t)l * 512 * DM;
      tconv_tile(src, DM, p.wpT() + (size_t)w * DM * 512, 512, nt * 64, kt * 64, [](int n) { return n; }, smem);
    } else if (it < 1856 + 384 + 256) {
      const int j = it - 1856 - 384;
      const int nt = j >> 4, kt = j & 15;
      tconv_tile(p.wo() + (size_t)l * DM * DM, DM, p.woT(), DM, nt * 64, kt * 64, [](int n) { return n; }, smem);
    } else if (it < 1856 + 384 + 256 + 16) {
      const int j = it - 1856 - 384 - 256;
      const int g = j >> 2, nt = (j >> 1) & 1, kt = j & 1;
      tconv_tile(p.pool_w() + ((size_t)l * 4 + g) * 128 * 128, 128, p.poolT() + (size_t)g * 128 * 128, 128, nt * 64,
                 kt * 64, [](int n) { return n; }, smem);
    } else if (it < 1856 + 384 + 256 + 16 + 64) {
      const int j = it - 1856 - 384 - 256 - 16;
      const int kv = j >> 5, kt = j & 31;
      const float* src = (kv ? p.w1v() : p.w1k()) + (size_t)l * 2048 * 64;
      tconv_tile(src, 64, p.w1T() + (size_t)kv * 64 * 2048, 2048, 0, kt * 64, [](int n) { return n; }, smem);
    } else {
      const int kv = it - (1856 + 384 + 256 + 16 + 64);
      const float* w1 = (kv ? p.w1v() : p.w1k()) + (size_t)l * 2048 * 64;
      const float* pos = (kv ? p.pos_v() : p.pos_k()) + (size_t)l * 2048;
      float* red = (float*)smem;
      const int e = tid & 63, part = tid >> 6;
      float sa = 0.f, sb = 0.f, sc_ = 0.f, sd = 0.f;
      const float* wq = w1 + (size_t)part * 512 * 64 + e;
      const float* pq = pos + part * 512;
#pragma unroll 4
      for (int f = 0; f < 512; f += 4) {
        sa += pq[f] * wq[(size_t)f * 64];
        sb += pq[f + 1] * wq[(size_t)(f + 1) * 64];
        sc_ += pq[f + 2] * wq[(size_t)(f + 2) * 64];
        sd += pq[f + 3] * wq[(size_t)(f + 3) * 64];
      }
      const float s = (sa + sb) + (sc_ + sd);
      red[tid] = s;
      __syncthreads();
      if (tid < 64) p.posb()[kv * 64 + tid] = red[tid] + red[tid + 64] + red[tid + 128] + red[tid + 192];
      __syncthreads();
    }
  }
}

template <class F>
__device__ __forceinline__ void xcd_schedule(int* q, int xcc, int ngroups, int gsize, char* smem, F f) {
  int* s_item = (int*)(smem + SMEM_BYTES - 16);
#pragma unroll 1
  for (int dy = 0; dy < 8; ++dy) {
    const int y = (xcc + dy) & 7;
    for (;;) {
      if (threadIdx.x == 0) *s_item = atomicAdd(&q[y], 1);
      __syncthreads();
      const int i = *s_item;
      __syncthreads();
      const int grp = (i / gsize) * 8 + y;
      if (grp >= ngroups) break;
      f(grp, i % gsize);
    }
  }
}

__device__ __forceinline__ void phase_inproj(const KP& p, int l, char* smem, int* q, int xcc) {
  const float* bias = p.b_in() + (size_t)l * NIN;
  xcd_schedule(q, xcc, 128, 32, smem, [&](int grp, int within) __attribute__((always_inline)) {
    const int mt = (grp & 15) * 4 + (within & 3), nt = (grp >> 4) * 8 + (within >> 2);
    if (nt >= 58) return;
    const int m0 = mt * 256, n0 = nt * 128;
    const half_t* A = p.xh() + (size_t)m0 * DM;
    const half_t* B = p.winT() + (size_t)n0 * DM;
    int tidx = threadIdx.x;
    asm volatile("" : "+v"(tidx));
    const int lane = tidx & 63, wn = (tidx >> 6) & 1;
    float bv[2];
#pragma unroll
    for (int ni = 0; ni < 2; ++ni) {
      const int oc = orig_col(n0 + wn * 64 + ni * 32 + (lane & 31));
      bv[ni] = oc >= 0 ? bias[oc] : 0.f;
    }
    half_t* vT = (nt == 53) ? p.vsT() : ((nt == 55) ? p.vwT() : nullptr);
    gemm_tile_big(
        DM, [&](int r, int k) { return *(const uint4*)(A + (size_t)r * DM + k); },
        [&](int r, int k) { return *(const uint4*)(B + (size_t)r * DM + k); },
        [&](int mi, int ni, int r, int row, int col, float v) {
          const half_t hv = (half_t)(v + bv[ni]);
          const int tok = m0 + row;
          p.u()[(size_t)tok * NU + n0 + col] = hv;
          if (vT) {
            const int b = tok >> 13, t = tok & 8191;
            vT[((size_t)(b * 2 + (col >> 6)) * 64 + (col & 63)) * SEQ + t] = hv;
          }
        },
        smem);
  });
}

__device__ __forceinline__ void pool_item(const KP& p, int l, int item, char* smem) {
  const int g = item & 3, mt = item >> 2;
  const int m0 = mt * 128;
  const int wnd = 2 << g;
  const half_t* B = p.poolT() + (size_t)g * 128 * 128;
  int tidx = threadIdx.x;
  asm volatile("" : "+v"(tidx));
  const int lane = tidx & 63, wn = (tidx >> 6) & 1;
  float pb[2], ps[2];
#pragma unroll
  for (int ni = 0; ni < 2; ++ni) {
    const int d = wn * 64 + ni * 32 + (lane & 31);
    pb[ni] = p.pool_b()[(size_t)l * 512 + g * 128 + d];
    ps[ni] = p.pool_scale()[(size_t)l * 512 + g * 128 + d];
  }
  gemm_tile<2>(
      128,
      [&](int r, int k) {
        const int tok = m0 + r, t = tok & 8191;
        const int cnt = min(t + 1, wnd);
        const half_t* base = p.u() + (size_t)tok * NU + C_AX + g * 128 + k;
        float s[8];
#pragma unroll
        for (int j = 0; j < 8; ++j) s[j] = 0.f;
        h8 cur = *(const h8*)base;
        for (int q0 = 0; q0 < wnd; q0 += 8) {
          h8 v[8];
#pragma unroll
          for (int i = 0; i < 8; ++i) {
            const int qq = q0 + i;
            if (qq < cnt) v[i] = *(const h8*)(base - (size_t)qq * NU);
            else {
#pragma unroll
              for (int j = 0; j < 8; ++j) v[i][j] = (half_t)0.f;
            }
          }
#pragma unroll
          for (int i = 0; i < 8; ++i)
#pragma unroll
            for (int j = 0; j < 8; ++j) s[j] += (float)v[i][j];
        }
        const float inv = 1.f / (float)cnt;
        h8 o;
#pragma unroll
        for (int j = 0; j < 8; ++j) o[j] = (half_t)(s[j] * inv - (float)cur[j]);
        return *(uint4*)&o;
      },
      [&](int r, int k) { return *(const uint4*)(B + (size_t)r * 128 + k); },
      [&](int mi, int ni, int r, int row, int col, float v) {
        const int tok = m0 + row;
        const float z = (float)p.u()[(size_t)tok * NU + C_AZ + g * 128 + col];
        p.ya()[(size_t)tok * 512 + g * 128 + col] = (half_t)((v + pb[ni]) * ps[ni] * siluf_(z));
      },
      smem);
}

__device__ __forceinline__ void compress_item(const KP& p, int l, int item, char* smem) {
  const int mt = item & 3, kv = (item >> 2) & 1, g = (item >> 3) & 1, b = item >> 4;
  int tid = threadIdx.x;
  asm volatile("" : "+v"(tid));
  const int ccol = (kv ? C_CVC : C_CKC) + g * 64;
  const half_t* ub = p.u() + (size_t)b * SEQ * NU + ccol;
  const half_t* B = p.w1T() + (size_t)kv * 64 * 2048;
  float* hid = (float*)(smem + 28672);
  const float* posb = p.posb() + kv * 64;
  gemm_tile<1>(
      2048,
      [&](int r, int k) {
        const int n = mt * 128 + r;
        if (n >= 511) return make_uint4(0, 0, 0, 0);
        const int tok = 16 * n + (k >> 6);
        return *(const uint4*)(ub + (size_t)tok * NU + (k & 63));
      },
      [&](int r, int k) { return *(const uint4*)(B + (size_t)r * 2048 + k); },
      [&](int mi, int ni, int r, int row, int col, float v) { hid[row * 65 + col] = siluf_(v + posb[col]); }, smem);
  __syncthreads();
  float* w2s = (float*)smem;
  const float* w2 = (kv ? p.w2v() : p.w2k()) + (size_t)l * 4096;
  for (int i = tid; i < 4096; i += 256) w2s[i] = w2[i];
  __syncthreads();
  {
    const int n = tid >> 1, fh = (tid & 1) * 32;
    float acc[32];
#pragma unroll
    for (int f = 0; f < 32; ++f) acc[f] = 0.f;
    for (int e = 0; e < 64; ++e) {
      const float hv = hid[n * 65 + e];
#pragma unroll
      for (int f = 0; f < 32; ++f) acc[f] += hv * w2s[e * 64 + fh + f];
    }
    const int ng = mt * 128 + n;
    const bool valid = ng < 511;
    if (kv == 0) {
      half_t* dst = p.kcmp() + ((size_t)(b * 2 + g) * 512 + ng) * 64 + fh;
#pragma unroll
      for (int f = 0; f < 32; ++f) dst[f] = valid ? (half_t)acc[f] : (half_t)0.f;
    } else {
      half_t* dst = p.vcmpT() + ((size_t)(b * 2 + g) * 64 + fh) * 512 + ng;
#pragma unroll
      for (int f = 0; f < 32; ++f) dst[(size_t)f * 512] = valid ? (half_t)acc[f] : (half_t)0.f;
    }
  }
  __syncthreads();
}

#ifndef DSA_CAP
#define DSA_CAP 128
#endif
__device__ __forceinline__ void dsa_item(const KP& p, int b, int tile, char* smem) {
  const int t0 = tile * 16;
  int tid = threadIdx.x;
  asm volatile("" : "+v"(tid));
  const int lane = tid & 63, wid = tid >> 6;
  uint32_t* hist = (uint32_t*)smem;
  unsigned long long* cand = (unsigned long long*)(smem + 16384);
  unsigned short* sel = (unsigned short*)(smem + 32768);
  unsigned long long* pfx = (unsigned long long*)(smem + 40960);
  unsigned long long* tkey = pfx + 16;
  int* need = (int*)(tkey + 16);
  int* state = need + 16;
  int* cnt = state + 16;
  int* ccnt = cnt + 16;
  int* pf16 = ccnt + 16;
  int* ovf = pf16 + 16;
  int* nrem = ovf + 16;
  int* fastf = nrem + 8;
  uint32_t* h1w = (uint32_t*)(smem + 43008);
  float* pbuf = (float*)smem + wid * 2048;

  const half_t* ub = p.u() + (size_t)b * SEQ * NU;
  const int mytok = lane & 15, hq = lane >> 4;
  const int myt = t0 + mytok;
  if (tid < 16) {
    const int t = t0 + tid;
    pfx[tid] = 0ull; tkey[tid] = 0ull; need[tid] = 256; state[tid] = (t < 256) ? 0 : 1; cnt[tid] = 0; ccnt[tid] = 0;
    pf16[tid] = 0; ovf[tid] = 0;
  }
  if (tid < 8) nrem[tid] = 0;
  if (tid < 16) fastf[tid] = 0;
  for (int i = tid; i < 6144; i += 256) h1w[i] = 0u;
  h8 qf[8], qlh, qll;
  float iw[8];
  {
    const half_t* qrow = ub + (size_t)myt * NU;
#pragma unroll
    for (int h = 0; h < 8; ++h) qf[h] = *(const h8*)(qrow + C_IQ + h * 32 + hq * 8);
    const h8 w8 = *(const h8*)(qrow + C_IW);
#pragma unroll
    for (int h = 0; h < 8; ++h) iw[h] = (float)w8[h] * 0.03125f;
#pragma unroll
    for (int e = 0; e < 8; ++e) {
      float a = 0.f;
#pragma unroll
      for (int h = 0; h < 8; ++h) a += iw[h] * (float)qf[h][e];
      const half_t hi = (half_t)a;
      qlh[e] = hi;
      qll[e] = (half_t)(a - (float)hi);
    }
  }
  __syncthreads();
  const int nkt = (t0 + 16 + 31) >> 5;

  auto loadk = [&](int kt, h8* a) __attribute__((always_inline)) {
#pragma unroll
    for (int i = 0; i < 2; ++i)
      a[i] = *(const h8*)(ub + (size_t)(kt * 32 + i * 16 + (lane & 15)) * NU + C_IK + hq * 8);
  };
  auto scores = [&](const h8* a, float* sc) __attribute__((always_inline)) {
#pragma unroll
    for (int i = 0; i < 2; ++i) {
      f32x4 acc = {0.f, 0.f, 0.f, 0.f};
      acc = __builtin_amdgcn_mfma_f32_16x16x32_f16(a[i], qll, acc, 0, 0, 0);
      acc = __builtin_amdgcn_mfma_f32_16x16x32_f16(a[i], qlh, acc, 0, 0, 0);
#pragma unroll
      for (int h = 0; h < 8; ++h) {
        f32x4 d = {0.f, 0.f, 0.f, 0.f};
        d = __builtin_amdgcn_mfma_f32_16x16x32_f16(a[i], qf[h], d, 0, 0, 0);
#pragma unroll
        for (int r = 0; r < 4; ++r) acc[r] = __builtin_fmaf(__builtin_fabsf(d[r]), iw[h], acc[r]);
      }
#pragma unroll
      for (int r = 0; r < 4; ++r) sc[i * 4 + r] = acc[r];
    }
  };
  auto skey = [&](float s) __attribute__((always_inline)) -> uint32_t {
    s = s + 0.f;
    const uint32_t u_ = __float_as_uint(s);
    return (u_ & 0x80000000u) ? ~u_ : (u_ | 0x80000000u);
  };
  auto mkkey = [&](float s, int key) __attribute__((always_inline)) -> unsigned long long {
    s = s + 0.f;
    uint32_t u_ = __float_as_uint(s);
    u_ = (u_ & 0x80000000u) ? ~u_ : (u_ | 0x80000000u);
    return ((unsigned long long)u_ << 16) | (unsigned long long)(8191 - key);
  };
  auto scan_token = [&](int tk, int level) __attribute__((always_inline)) -> bool {
    const int shift = 40 - 8 * level;
    const uint32_t* hrow = hist + tk * 256;
    const uint4 hv = *(const uint4*)&hrow[252 - 4 * lane];
    const int c = (int)(hv.x + hv.y + hv.z + hv.w);
    int cum = c;
#pragma unroll
    for (int o = 1; o < 64; o <<= 1) {
      int v = __shfl_up(cum, o);
      if (lane >= o) cum += v;
    }
    const int nd = need[tk];
    const unsigned long long mask = __ballot(cum >= nd);
    const int L = mask ? (int)__builtin_ctzll(mask) : 63;
    int running = cum - c, bstar, cb;
    if (running + (int)hv.w >= nd) { bstar = 255 - 4 * lane; cb = hv.w; }
    else {
      running += hv.w;
      if (running + (int)hv.z >= nd) { bstar = 254 - 4 * lane; cb = hv.z; }
      else {
        running += hv.z;
        if (running + (int)hv.y >= nd) { bstar = 253 - 4 * lane; cb = hv.y; }
        else { running += hv.y; bstar = 252 - 4 * lane; cb = hv.x; }
      }
    }
    running = __shfl(running, L); bstar = __shfl(bstar, L); cb = __shfl(cb, L);
    const int nd2 = nd - running;
    const bool fin = (cb == nd2) || (level == 5);
    if (lane == 0) {
      const unsigned long long np = (pfx[tk] << 8) | (unsigned long long)bstar;
      if (fin) { state[tk] = 0; tkey[tk] = np << shift; }
      else { need[tk] = nd2; pfx[tk] = np; }
    }
    return fin;
  };
  auto run_level = [&](int level, bool fillx) __attribute__((always_inline)) {
    const int shift = 40 - 8 * level;
    for (int i = tid; i < 4096; i += 256) hist[i] = 0u;
    __syncthreads();
    {
      const unsigned long long mypfx = pfx[mytok];
      const bool act = state[mytok] == 1 && fastf[mytok] == 0;
      h8 na[2];
      if (wid < nkt) loadk(wid, na);
      for (int kt = wid; kt < nkt; kt += 4) {
        h8 ca[2];
#pragma unroll
        for (int i = 0; i < 2; ++i) ca[i] = na[i];
        loadk(kt + 4 < nkt ? kt + 4 : kt, na);
        float sc[8];
        scores(ca, sc);
        if (act) {
#pragma unroll
          for (int q = 0; q < 8; ++q) {
            const int key = kt * 32 + (q >> 2) * 16 + 4 * hq + (q & 3);
            if (key <= myt) {
              if (level < 2) {
                const uint32_t u32 = skey(sc[q]);
                if (level == 0) {
                  const uint32_t b8 = u32 >> 24;
                  atomicAdd(&hist[mytok * 256 + (int)b8], 1u);
                  if (fillx) {
                    const uint32_t ix = b8 - 0xBEu;
                    if (ix < 3u) {
                      const uint32_t e16 = (ix * 16u + (uint32_t)mytok) * 256u + ((u32 >> 16) & 255u);
                      atomicAdd(&h1w[e16 >> 1], (e16 & 1u) ? 65536u : 1u);
                    }
                  }
                } else if ((u32 >> 24) == (uint32_t)mypfx) atomicAdd(&hist[mytok * 256 + (int)((u32 >> 16) & 255u)], 1u);
              } else {
                const unsigned long long k48 = mkkey(sc[q], key);
                if ((k48 >> (shift + 8)) == mypfx)
                  atomicAdd(&hist[mytok * 256 + (int)((k48 >> shift) & 255ull)], 1u);
              }
            }
          }
        }
      }
    }
    __syncthreads();
    {
      int rem = 0;
      for (int j = 0; j < 4; ++j) {
        const int tk = wid * 4 + j;
        if (state[tk] != 1 || fastf[tk] != 0) continue;
        if (!scan_token(tk, level)) rem++;
      }
      if (lane == 0 && rem) atomicAdd(&nrem[level], rem);
    }
    __syncthreads();
  };

  run_level(0, true);
  if (tid < 16) {
    const int b0 = (int)pfx[tid];
    const int f = (state[tid] == 1 && b0 >= 0xBE && b0 <= 0xC0) ? 1 : 0;
    fastf[tid] = f;
    if (state[tid] == 1 && !f) atomicAdd(&nrem[7], 1);
  }
  __syncthreads();
  if (nrem[7] != 0) run_level(1, false);
  for (int j = 0; j < 4; ++j) {
    const int tk = wid * 4 + j;
    if (state[tk] != 1 || fastf[tk] == 0) continue;
    const uint32_t ix = (uint32_t)pfx[tk] - 0xBEu;
    const unsigned short* hx = (const unsigned short*)h1w + (ix * 16u + (uint32_t)tk) * 256u;
    const ushort4 c4 = *(const ushort4*)&hx[4 * lane];
    uint4 w4;
    w4.x = c4.x; w4.y = c4.y; w4.z = c4.z; w4.w = c4.w;
    *(uint4*)&hist[tk * 256 + 4 * lane] = w4;
    __builtin_amdgcn_wave_barrier();
    scan_token(tk, 1);
  }
  __syncthreads();
  if (tid < 16) fastf[tid] = 0;
  __syncthreads();

  {
    const int st0 = state[mytok];
    const unsigned long long mytk = tkey[mytok];
    const unsigned long long myp16 = pfx[mytok];
    h8 na[2];
    if (wid < nkt) loadk(wid, na);
    for (int kt = wid; kt < nkt; kt += 4) {
      h8 ca[2];
#pragma unroll
      for (int i = 0; i < 2; ++i) ca[i] = na[i];
      loadk(kt + 4 < nkt ? kt + 4 : kt, na);
      float sc[8];
      scores(ca, sc);
#pragma unroll
      for (int q = 0; q < 8; ++q) {
        const int key = kt * 32 + (q >> 2) * 16 + 4 * hq + (q & 3);
        if (key <= myt) {
          const uint32_t u32 = skey(sc[q]);
          bool take, isc = false;
          if (st0 == 0) take = (((unsigned long long)u32 << 16) | (unsigned long long)(8191 - key)) >= mytk;
          else {
            const uint32_t p16 = u32 >> 16;
            take = p16 > (uint32_t)myp16;
            isc = p16 == (uint32_t)myp16;
          }
          if (take) {
            const int pos = atomicAdd(&cnt[mytok], 1);
            if (pos < 256) sel[mytok * 256 + pos] = (unsigned short)key;
          } else if (isc) {
            const int pos = atomicAdd(&ccnt[mytok], 1);
            if (pos < DSA_CAP) cand[mytok * 128 + pos] = ((unsigned long long)u32 << 16) | (unsigned long long)(8191 - key);
          }
        }
      }
    }
  }
  __syncthreads();
  {
    int nov = 0;
    for (int j = 0; j < 4; ++j) {
      const int tk = wid * 4 + j;
      if (state[tk] != 1) continue;
      const int nc = ccnt[tk];
      if (nc > DSA_CAP) {
        nov++;
        if (lane == 0) { ovf[tk] = 1; pf16[tk] = (int)pfx[tk]; }
        continue;
      }
      const int nd = need[tk];
      const unsigned long long k0 = (lane < nc) ? cand[tk * 128 + lane] : 0ull;
      const unsigned long long k1 = (lane + 64 < nc) ? cand[tk * 128 + lane + 64] : 0ull;
      int r0 = 0, r1 = 0;
      for (int q = 0; q < nc; ++q) {
        const unsigned long long kq = cand[tk * 128 + q];
        r0 += (kq > k0) ? 1 : 0;
        r1 += (kq > k1) ? 1 : 0;
      }
      if (lane < nc && r0 < nd) {
        const int pos = atomicAdd(&cnt[tk], 1);
        if (pos < 256) sel[tk * 256 + pos] = (unsigned short)(8191 - (int)(k0 & 0xFFFFull));
      }
      if (lane + 64 < nc && r1 < nd) {
        const int pos = atomicAdd(&cnt[tk], 1);
        if (pos < 256) sel[tk * 256 + pos] = (unsigned short)(8191 - (int)(k1 & 0xFFFFull));
      }
      if (lane == 0) state[tk] = 2;
    }
    if (lane == 0 && nov) atomicAdd(&nrem[6], nov);
  }
  __syncthreads();
  if (nrem[6] != 0) {
    for (int level = 2; level < 6; ++level) {
      run_level(level, false);
      if (nrem[level] == 0) break;
    }
    {
      const bool mine = ovf[mytok] != 0;
      const unsigned long long mytk = tkey[mytok];
      const unsigned long long myp16 = (unsigned long long)(unsigned)pf16[mytok];
      h8 na[2];
      if (wid < nkt) loadk(wid, na);
      for (int kt = wid; kt < nkt; kt += 4) {
        h8 ca[2];
#pragma unroll
        for (int i = 0; i < 2; ++i) ca[i] = na[i];
        loadk(kt + 4 < nkt ? kt + 4 : kt, na);
        float sc[8];
        scores(ca, sc);
        if (mine) {
#pragma unroll
          for (int q = 0; q < 8; ++q) {
            const int key = kt * 32 + (q >> 2) * 16 + 4 * hq + (q & 3);
            if (key <= myt) {
              const unsigned long long k48 = mkkey(sc[q], key);
              if ((k48 >> 32) == myp16 && k48 >= mytk) {
                const int pos = atomicAdd(&cnt[mytok], 1);
                if (pos < 256) sel[mytok * 256 + pos] = (unsigned short)key;
              }
            }
          }
        }
      }
    }
    __syncthreads();
  }
#ifndef DSA_ATT_REP
#define DSA_ATT_REP 1
#endif
  for (int jr = 0; jr < 4 * DSA_ATT_REP; ++jr) {
    const int j = jr & 3;
    const int tk = wid * 4 + j;
    const int t = t0 + tk;
    const int nsel = min(cnt[tk], 256);
    const half_t* urow = ub + (size_t)t * NU;
    const int col = lane & 15;
    h8 q0, q1;
#pragma unroll
    for (int e = 0; e < 8; ++e) { q0[e] = (half_t)0.f; q1[e] = (half_t)0.f; }
    if (col < 8) {
      q0 = *(const h8*)(urow + C_BQ + col * 64 + hq * 8);
      q1 = *(const h8*)(urow + C_BQ + col * 64 + 32 + hq * 8);
    }
    float mx = NEGF;
#pragma unroll 1
    for (int mg = 0; mg < 2; ++mg) {
#pragma unroll
      for (int mm = 0; mm < 8; ++mm) {
        const int m = mg * 8 + mm;
        const int pos = m * 16 + col;
        const int s = (pos < nsel) ? (int)sel[tk * 256 + pos] : 0;
        const half_t* kp = ub + (size_t)s * NU + C_BK + hq * 8;
        const h8 a0 = *(const h8*)kp, a1 = *(const h8*)(kp + 32);
        f32x4 d = {0.f, 0.f, 0.f, 0.f};
        d = __builtin_amdgcn_mfma_f32_16x16x32_f16(a0, q0, d, 0, 0, 0);
        d = __builtin_amdgcn_mfma_f32_16x16x32_f16(a1, q1, d, 0, 0, 0);
#pragma unroll
        for (int r = 0; r < 4; ++r) {
          const int pp = m * 16 + hq * 4 + r;
          const float v = (pp < nsel) ? d[r] * 0.125f : NEGF;
          mx = fmaxf(mx, v);
          if (col < 8) pbuf[pp * 8 + col] = v;
        }
      }
    }
    mx = fmaxf(mx, __shfl_xor(mx, 16));
    mx = fmaxf(mx, __shfl_xor(mx, 32));
    const float mxh = __shfl(mx, lane & 7);
    __builtin_amdgcn_wave_barrier();
    float sum = 0.f;
#pragma unroll 4
    for (int k = 0; k < 32; ++k) {
      const int i = lane + 64 * k;
      const float v = pbuf[i];
      const float e = (v > -1e29f) ? __expf(v - mxh) : 0.f;
      pbuf[i] = e;
      sum += e;
    }
    sum += __shfl_xor(sum, 8);
    sum += __shfl_xor(sum, 16);
    sum += __shfl_xor(sum, 32);
    const float inv = 1.f / sum;
    __builtin_amdgcn_wave_barrier();
    {
      const int rs = lane >> 3, dc = lane & 7;
      float acc[8][8];
#pragma unroll
      for (int h = 0; h < 8; ++h)
#pragma unroll
        for (int e = 0; e < 8; ++e) acc[h][e] = 0.f;
#pragma unroll 1
      for (int g8 = 0; g8 < 4; ++g8) {
        h8 vv[8];
#pragma unroll
        for (int i = 0; i < 8; ++i) {
          const int pos = (g8 * 8 + i) * 8 + rs;
          const int s = (pos < nsel) ? (int)sel[tk * 256 + pos] : 0;
          vv[i] = *(const h8*)(ub + (size_t)s * NU + C_BV + dc * 8);
        }
#pragma unroll
        for (int i = 0; i < 8; ++i) {
          const int pos = (g8 * 8 + i) * 8 + rs;
          const f32x4 pa = *(const f32x4*)&pbuf[pos * 8];
          const f32x4 pb = *(const f32x4*)&pbuf[pos * 8 + 4];
          float vf[8];
#pragma unroll
          for (int e = 0; e < 8; ++e) vf[e] = (float)vv[i][e];
#pragma unroll
          for (int e = 0; e < 8; ++e) {
            acc[0][e] += pa[0] * vf[e]; acc[1][e] += pa[1] * vf[e]; acc[2][e] += pa[2] * vf[e]; acc[3][e] += pa[3] * vf[e];
            acc[4][e] += pb[0] * vf[e]; acc[5][e] += pb[1] * vf[e]; acc[6][e] += pb[2] * vf[e]; acc[7][e] += pb[3] * vf[e];
          }
        }
      }
      half_t* yrow = p.yb() + (size_t)(b * SEQ + t) * 512;
#pragma unroll
      for (int h = 0; h < 8; ++h) {
        const float invh = __shfl(inv, h);
        h8 ov;
        const h8 z8 = *(const h8*)(urow + C_BZ + h * 64 + dc * 8);
#pragma unroll
        for (int e = 0; e < 8; ++e) {
          float a = acc[h][e];
          a += __shfl_xor(a, 8);
          a += __shfl_xor(a, 16);
          a += __shfl_xor(a, 32);
          ov[e] = (half_t)(a * invh * siluf_((float)z8[e]));
        }
        if (rs == h) *(h8*)(yrow + h * 64 + dc * 8) = ov;
      }
    }
    __builtin_amdgcn_wave_barrier();
  }
  __syncthreads();
}

__device__ __forceinline__ void phase2(const KP& p, int l, char* smem, int* q, int xcc) {
  xcd_schedule(q, xcc, 32, 1, smem, [&](int grp, int) __attribute__((always_inline)) { compress_item(p, l, grp, smem); });
  xcd_schedule(q + 8, xcc, 1024, 1, smem, [&](int grp, int) __attribute__((always_inline)) {
    const int y = grp & 7, k = grp >> 3;
    dsa_item(p, y & 1, 511 - (k * 4 + (y >> 1)), smem);
  });
  xcd_schedule(q + 16, xcc, 512, 1, smem, [&](int grp, int) __attribute__((always_inline)) { pool_item(p, l, grp, smem); });
}

struct DState {
  float m, l;
  f32x16 o[2];
};
#define MLOW (-1e4f)
__device__ __forceinline__ void ds_reset(DState& st) {
  st.m = MLOW; st.l = 0.f;
#pragma unroll
  for (int dt = 0; dt < 2; ++dt)
#pragma unroll
    for (int r = 0; r < 16; ++r) st.o[dt][r] = 0.f;
}
typedef unsigned int u32x4 __attribute__((ext_vector_type(4)));
typedef unsigned int u32x2 __attribute__((ext_vector_type(2)));
struct StageRegs {
  u32x4 k0, k1, v0, v1;
};
template <bool HASV>
__device__ __forceinline__ void load_stage(StageRegs& r, const half_t* __restrict__ Kb, int ldk,
                                           const half_t* __restrict__ VT, int ldv, int key0, int tid) {
  const int row = tid >> 3, c = tid & 7;
  r.k0 = *(const u32x4*)(Kb + (size_t)(key0 + row) * ldk + c * 8);
  r.k1 = *(const u32x4*)(Kb + (size_t)(key0 + row + 32) * ldk + c * 8);
  if (HASV) {
    r.v0 = *(const u32x4*)(VT + (size_t)row * ldv + key0 + c * 8);
    r.v1 = *(const u32x4*)(VT + (size_t)(row + 32) * ldv + key0 + c * 8);
  }
}
template <bool HASV>
__device__ __forceinline__ void write_stage(const StageRegs& r, half_t* Ks, half_t* Vs, int tid) {
  const int row = tid >> 3, c = tid & 7;
  *(u32x4*)&Ks[row * 72 + c * 8] = r.k0;
  *(u32x4*)&Ks[(row + 32) * 72 + c * 8] = r.k1;
  if (HASV) {
    const int ks = c >> 1, a = c & 1;
    u32x2 lo, hi;
    lo[0] = r.v0[0]; lo[1] = r.v0[1]; hi[0] = r.v0[2]; hi[1] = r.v0[3];
    *(u32x2*)&Vs[row * 72 + ks * 16 + a * 4] = lo;
    *(u32x2*)&Vs[row * 72 + ks * 16 + 8 + a * 4] = hi;
    lo[0] = r.v1[0]; lo[1] = r.v1[1]; hi[0] = r.v1[2]; hi[1] = r.v1[3];
    *(u32x2*)&Vs[(row + 32) * 72 + ks * 16 + a * 4] = lo;
    *(u32x2*)&Vs[(row + 32) * 72 + ks * 16 + 8 + a * 4] = hi;
  }
}
template <bool ONLINE, bool HASV, bool FAST, class VF>
__device__ __forceinline__ void dense_block(DState& st, const half_t* Ks, const half_t* Vs, const h8* qf, int key0,
                                            int flag, VF valid, float fixed_m, float fixed_invl, f32x16* pout,
                                            int lane) {
  const int h = lane >> 5, c = lane & 31;
  f32x16 s[2];
#pragma unroll
  for (int kt = 0; kt < 2; ++kt) {
#pragma unroll
    for (int r = 0; r < 16; ++r) s[kt][r] = 0.f;
#pragma unroll
    for (int ks = 0; ks < 4; ++ks) {
      const h8 a = *(const h8*)&Ks[(32 * kt + c) * 72 + 16 * ks + 8 * h];
      s[kt] = __builtin_amdgcn_mfma_f32_32x32x16_f16(a, qf[ks], s[kt], 0, 0, 0);
    }
  }
  float cm = NEGF;
#pragma unroll
  for (int kt = 0; kt < 2; ++kt)
#pragma unroll
    for (int r = 0; r < 16; ++r) {
      const int key = key0 + 32 * kt + (r & 3) + 8 * (r >> 2) + 4 * h;
      const float v = (FAST ? (flag != 0) : valid(key, flag)) ? s[kt][r] : NEGF;
      s[kt][r] = v;
      cm = fmaxf(cm, v);
    }
  float mnew;
  if (ONLINE) {
    cm = fmaxf(cm, __shfl_xor(cm, 32));
    mnew = fmaxf(st.m, cm);
    if (__ballot(mnew > st.m) != 0ull) {
      const float alpha = __builtin_amdgcn_exp2f(st.m - mnew);
      st.m = mnew;
      st.l *= alpha;
      if (HASV) {
#pragma unroll
        for (int dt = 0; dt < 2; ++dt)
#pragma unroll
          for (int r = 0; r < 16; ++r) st.o[dt][r] *= alpha;
      }
    }
  } else {
    mnew = fixed_m;
  }
  float ps = 0.f;
#pragma unroll
  for (int kt = 0; kt < 2; ++kt)
#pragma unroll
    for (int r = 0; r < 16; ++r) {
      float e = __builtin_amdgcn_exp2f(s[kt][r] - mnew);
      if (!ONLINE) e *= fixed_invl;
      s[kt][r] = e;
      ps += e;
    }
  st.l += ps;
  if (pout) { pout[0] = s[0]; pout[1] = s[1]; }
  if (HASV) {
#pragma unroll
    for (int ks = 0; ks < 4; ++ks) {
      h8 pf;
#pragma unroll
      for (int jj = 0; jj < 8; ++jj) pf[jj] = (half_t)s[ks >> 1][8 * (ks & 1) + jj];
#pragma unroll
      for (int dt = 0; dt < 2; ++dt) {
        const h8 vf = *(const h8*)&Vs[(32 * dt + c) * 72 + 16 * ks + 8 * h];
        st.o[dt] = __builtin_amdgcn_mfma_f32_32x32x16_f16(vf, pf, st.o[dt], 0, 0, 0);
      }
    }
  }
}
template <bool ONLINE, bool HASV, bool WANTP, class PRE, class FU, class VF, class PO>
__device__ __forceinline__ void run_dense(DState& st, const half_t* __restrict__ Kb, int ldk,
                                          const half_t* __restrict__ VT, int ldv, int blk_lo, int blk_hi, const h8* qf,
                                          PRE pre, FU full, VF valid, float fixed_m, float fixed_invl, PO post, char* smem,
                                          int tid) {
  half_t* Ks = (half_t*)smem;
  half_t* Vs = Ks + 64 * 72;
  const int lane = tid & 63;
  StageRegs sr;
  load_stage<HASV>(sr, Kb, ldk, VT, ldv, blk_lo * 64, tid);
  for (int blk = blk_lo; blk <= blk_hi; ++blk) {
    __syncthreads();
    write_stage<HASV>(sr, Ks, Vs, tid);
    __syncthreads();
    const int nb = blk < blk_hi ? blk + 1 : blk;
    load_stage<HASV>(sr, Kb, ldk, VT, ldv, nb * 64, tid);
    const int flag = pre(blk);
    if (__ballot(flag != 0) != 0ull) {
      f32x16 pp[2];
      if (full(blk))
        dense_block<ONLINE, HASV, true>(st, Ks, Vs, qf, blk * 64, flag, valid, fixed_m, fixed_invl,
                                        WANTP ? pp : (f32x16*)nullptr, lane);
      else
        dense_block<ONLINE, HASV, false>(st, Ks, Vs, qf, blk * 64, flag, valid, fixed_m, fixed_invl,
                                         WANTP ? pp : (f32x16*)nullptr, lane);
      if (WANTP) post(blk * 64, pp);
    }
  }
}

__device__ __forceinline__ void nsa_item(const KP& p, int b, int g, int tile, char* smem) {
  int tid = threadIdx.x;
  asm volatile("" : "+v"(tid));
  const int lane = tid & 63, wid = tid >> 6;
  const int t0 = tile * 32;
  const int tw0 = t0 + 8 * wid;
  const int col = lane & 31, h = lane >> 5;
  const int j = col >> 2, r4 = col & 3;
  const int tj = tw0 + j;
  const int head = g * 4 + r4;
  float* impA = (float*)(smem + 18432 + wid * 8320);
  float* impB = impA + 1024;
  unsigned long long* msk = (unsigned long long*)(smem + 18432 + 4 * 8320 + wid * 128);
  const half_t* ub = p.u() + (size_t)b * SEQ * NU;
  const half_t* urow = ub + (size_t)tj * NU;
  h8 qf[4];
#pragma unroll
  for (int ks = 0; ks < 4; ++ks) {
    qf[ks] = *(const h8*)(urow + C_CQ + head * 64 + 16 * ks + 8 * h);
#pragma unroll
    for (int e = 0; e < 8; ++e) qf[ks][e] = (half_t)((float)qf[ks][e] * 0.18033688f);
  }
  float gate[3];
#pragma unroll
  for (int i = 0; i < 3; ++i) gate[i] = sigmoidf_((float)urow[C_CG + head * 3 + i]);
  f32x16 res[2];
#pragma unroll
  for (int dt = 0; dt < 2; ++dt)
#pragma unroll
    for (int r = 0; r < 16; ++r) res[dt][r] = 0.f;
  for (int i = lane; i < 2080; i += 64) impA[i] = 0.f;
  DState st;
  auto nopost = [&](int, f32x16*) __attribute__((always_inline)) {};

  {
    const int nmax_j = (tj >= 31) ? ((tj - 31) >> 4) : -1;
    const int bhi = (t0 >> 4) >> 6;
    const half_t* Kc = p.kcmp() + (size_t)(b * 2 + g) * 512 * 64;
    const half_t* Vc = p.vcmpT() + (size_t)(b * 2 + g) * 64 * 512;
    auto pre = [&](int) __attribute__((always_inline)) { return 1; };
    const int nmax_w = (tw0 >= 31) ? ((tw0 - 31) >> 4) : -1;
    auto fullc = [&](int blk) __attribute__((always_inline)) { return blk * 64 + 63 <= nmax_w; };
    auto vfn = [&](int n, int) __attribute__((always_inline)) { return n <= nmax_j; };
    ds_reset(st);
    run_dense<true, false, false>(st, Kc, 64, (const half_t*)nullptr, 0, 0, bhi, qf, pre, fullc, vfn, 0.f, 0.f, nopost, smem, tid);
    float lt = st.l;
    lt += __shfl_xor(lt, 32);
    const float mfix = st.m;
    const float invl = lt > 0.f ? 1.f / lt : 0.f;
    ds_reset(st);
    auto post = [&](int n0, f32x16* pp) __attribute__((always_inline)) {
#pragma unroll
      for (int kt = 0; kt < 2; ++kt)
#pragma unroll
        for (int qd = 0; qd < 4; ++qd) {
          float a = pp[kt][4 * qd] + pp[kt][4 * qd + 1] + pp[kt][4 * qd + 2] + pp[kt][4 * qd + 3];
          float bb = pp[kt][4 * qd + 3];
          a += __shfl_xor(a, 1); a += __shfl_xor(a, 2);
          bb += __shfl_xor(bb, 1); bb += __shfl_xor(bb, 2);
          if (r4 == 0) {
            const int sblk = (n0 >> 2) + 8 * kt + 2 * qd + h;
            impA[j * 128 + sblk] = a;
            impB[j * 132 + sblk + 1] = bb;
          }
        }
    };
    run_dense<false, true, true>(st, Kc, 64, Vc, 512, 0, bhi, qf, pre, fullc, vfn, mfix, invl, post, smem, tid);
#pragma unroll
    for (int dt = 0; dt < 2; ++dt)
#pragma unroll
      for (int r = 0; r < 16; ++r) res[dt][r] += gate[0] * st.o[dt][r];
  }
  __builtin_amdgcn_wave_barrier();
#pragma unroll 1
  for (int jj = 0; jj < 8; ++jj) {
    const int t = tw0 + jj;
    const int blk = t >> 6;
    uint32_t k0, k1;
    {
      const int s0 = lane, s1 = lane + 64;
      const float i0 = impA[jj * 128 + s0] + impB[jj * 132 + s0];
      const float i1 = impA[jj * 128 + s1] + impB[jj * 132 + s1];
      auto mk = [&](float im, int s) __attribute__((always_inline)) -> uint32_t {
        if (s > blk) return 0u;
        uint32_t kk = ((__float_as_uint(im) >> 1) & ~127u) | (uint32_t)(127 - s) | 0x40000000u;
        if (s == 0 || s == blk || s == blk - 1) kk |= 0x80000000u;
        return kk;
      };
      k0 = mk(i0, s0); k1 = mk(i1, s1);
    }
    unsigned long long lo = 0ull, hi = 0ull;
    for (int it = 0; it < 16; ++it) {
      uint32_t mxk = k0 > k1 ? k0 : k1;
#pragma unroll
      for (int o = 32; o > 0; o >>= 1) {
        const uint32_t ov = (uint32_t)__shfl_xor((int)mxk, o);
        mxk = ov > mxk ? ov : mxk;
      }
      mxk = (uint32_t)__builtin_amdgcn_readfirstlane((int)mxk);
      if (mxk == 0u) break;
      const int s = 127 - (int)(mxk & 127u);
      if (s < 64) lo |= 1ull << s; else hi |= 1ull << (s - 64);
      if (s == lane) k0 = 0u;
      if (s == lane + 64) k1 = 0u;
    }
    if (lane == 0) { msk[jj * 2] = lo; msk[jj * 2 + 1] = hi; }
  }
  __builtin_amdgcn_wave_barrier();
  const unsigned long long mylo = msk[j * 2], myhi = msk[j * 2 + 1];
  {
    const half_t* Ksel = ub + C_CKS + g * 64;
    const half_t* Vsel = p.vsT() + (size_t)(b * 2 + g) * 64 * SEQ;
    auto pre = [&](int blk) __attribute__((always_inline)) {
      const unsigned long long mm_ = (blk < 64) ? mylo : myhi;
      return (int)((mm_ >> (blk & 63)) & 1ull);
    };
    auto vfn = [&](int key, int flag) __attribute__((always_inline)) { return flag != 0 && key <= tj; };
    ds_reset(st);
    auto fulls = [&](int blk) __attribute__((always_inline)) { return blk * 64 + 63 <= tw0; };
    run_dense<true, true, false>(st, Ksel, NU, Vsel, SEQ, 0, (t0 + 31) >> 6, qf, pre, fulls, vfn, 0.f, 0.f, nopost, smem, tid);
    float lt = st.l;
    lt += __shfl_xor(lt, 32);
    const float sc = lt > 0.f ? gate[1] / lt : 0.f;
#pragma unroll
    for (int dt = 0; dt < 2; ++dt)
#pragma unroll
      for (int r = 0; r < 16; ++r) res[dt][r] += sc * st.o[dt][r];
  }
  {
    const half_t* Kw = ub + C_CKW + g * 64;
    const half_t* Vw = p.vwT() + (size_t)(b * 2 + g) * 64 * SEQ;
    auto pre = [&](int blk) __attribute__((always_inline)) {
      return (int)((blk * 64 <= tj) && (blk * 64 + 63 > tj - 512));
    };
    auto vfn = [&](int key, int) __attribute__((always_inline)) { return key <= tj && key > tj - 512; };
    ds_reset(st);
    auto fullw = [&](int blk) __attribute__((always_inline)) { return blk * 64 + 63 <= tw0 && blk * 64 > tw0 + 7 - 512; };
    run_dense<true, true, false>(st, Kw, NU, Vw, SEQ, max(0, t0 - 511) >> 6, (t0 + 31) >> 6, qf, pre, fullw, vfn, 0.f, 0.f,
                                 nopost, smem, tid);
    float lt = st.l;
    lt += __shfl_xor(lt, 32);
    const float sc = lt > 0.f ? gate[2] / lt : 0.f;
#pragma unroll
    for (int dt = 0; dt < 2; ++dt)
#pragma unroll
      for (int r = 0; r < 16; ++r) res[dt][r] += sc * st.o[dt][r];
  }
  half_t* yrow = p.yc() + (size_t)(b * SEQ + tj) * 512 + head * 64;
#pragma unroll
  for (int dt = 0; dt < 2; ++dt)
#pragma unroll
    for (int qd = 0; qd < 4; ++qd) {
      const int d = 32 * dt + 8 * qd + 4 * h;
      const h4 z = *(const h4*)(urow + C_CZ + head * 64 + d);
      h4 ov;
#pragma unroll
      for (int e = 0; e < 4; ++e) ov[e] = (half_t)(res[dt][4 * qd + e] * siluf_((float)z[e]));
      *(h4*)(yrow + d) = ov;
    }
  __syncthreads();
}

__device__ __forceinline__ void phase_nsa(const KP& p, char* smem, int* q, int xcc) {
  xcd_schedule(q, xcc, 1024, 1, smem, [&](int grp, int) __attribute__((always_inline)) {
    const int y = grp & 7, k = grp >> 3;
    const int b = y & 1, g = (y >> 1) & 1, tile = 255 - (k * 2 + (y >> 2));
    nsa_item(p, b, g, tile, smem);
  });
}

__device__ __forceinline__ void phase_merge(const KP& p, char* smem, int* q, int xcc) {
  xcd_schedule(q, xcc, 16, 64, smem, [&](int grp, int within) __attribute__((always_inline)) {
    const int mt = (grp & 15) * 8 + (within & 7), nt = (within >> 3);
    const int m0 = mt * 128, n0 = nt * 128;
    f32x16 tot[2][2];
#pragma unroll
    for (int i = 0; i < 2; ++i)
#pragma unroll
      for (int jn = 0; jn < 2; ++jn)
#pragma unroll
        for (int r = 0; r < 16; ++r) tot[i][jn][r] = 0.f;
#pragma unroll 1
    for (int br = 0; br < 3; ++br) {
      const half_t* A = (br == 0 ? p.ya() : (br == 1 ? p.yb() : p.yc())) + (size_t)m0 * 512;
      const half_t* B = p.wpT() + (size_t)br * DM * 512 + (size_t)n0 * 512;
      const half_t* G = p.u() + (size_t)m0 * NU + C_GM + br * 1024 + n0;
      gemm_tile<2>(
          512, [&](int r, int k) { return *(const uint4*)(A + (size_t)r * 512 + k); },
          [&](int r, int k) { return *(const uint4*)(B + (size_t)r * 512 + k); },
          [&](int mi, int ni, int r, int row, int col, float v) {
            const float gz = (float)G[(size_t)row * NU + col];
            tot[mi][ni][r] += sigmoidf_(gz) * v;
          },
          smem);
    }
    int tidx = threadIdx.x;
    asm volatile("" : "+v"(tidx));
    const int lane = tidx & 63, wid = tidx >> 6, wm = wid >> 1, wn = wid & 1;
#pragma unroll
    for (int mi = 0; mi < 2; ++mi)
#pragma unroll
      for (int ni = 0; ni < 2; ++ni)
#pragma unroll
        for (int r = 0; r < 16; ++r) {
          const int row = wm * 64 + mi * 32 + (r & 3) + 8 * (r >> 2) + 4 * (lane >> 5);
          const int col = wn * 64 + ni * 32 + (lane & 31);
          p.mm()[(size_t)(m0 + row) * DM + n0 + col] = (half_t)tot[mi][ni][r];
        }
  });
}

__device__ __forceinline__ void phase_outproj(const KP& p, char* smem, int* q, int xcc) {
  xcd_schedule(q, xcc, 16, 64, smem, [&](int grp, int within) __attribute__((always_inline)) {
    const int mt = (grp & 15) * 8 + (within & 7), nt = (within >> 3);
    const int m0 = mt * 128, n0 = nt * 128;
    const half_t* A = p.mm() + (size_t)m0 * DM;
    const half_t* B = p.woT() + (size_t)n0 * DM;
    gemm_tile<2>(
        DM, [&](int r, int k) { return *(const uint4*)(A + (size_t)r * DM + k); },
        [&](int r, int k) { return *(const uint4*)(B + (size_t)r * DM + k); },
        [&](int mi, int ni, int r, int row, int col, float v) {
          const size_t xi = (size_t)(m0 + row) * DM + n0 + col;
          ((float*)p.u())[xi] = ALPHA_F * p.xr()[xi] + v;
        },
        smem);
  });
}


#define XB_TMO      128
#define XB_XCNT(j)  (256  + 64 * (j))
#define XB_XSUB(j)  (1280 + 64 * (j))
#define XB_XGEN(j)  (2304 + 64 * (j))
#define XB_TOP      3328
#define XB_TOPGEN   3392
#define XCD_BAR_WORDS 3456
#define XB_SPIN_CAP (1u << 20)
#define LAS __attribute__((address_space(3)))
__device__ __forceinline__ unsigned xb_ld(unsigned* p)              { return __hip_atomic_load(p, __ATOMIC_RELAXED, __HIP_MEMORY_SCOPE_AGENT); }
__device__ __forceinline__ unsigned xb_add(unsigned* p, unsigned v) { return __hip_atomic_fetch_add(p, v, __ATOMIC_RELAXED, __HIP_MEMORY_SCOPE_AGENT); }
__device__ __forceinline__ unsigned xb_xcc_id() { return (unsigned)__builtin_amdgcn_s_getreg((3 << 11) | 20) & 0xFu; }
#define XB_SPIN(cond, bar) do { unsigned _sp = 0; while (cond) { __builtin_amdgcn_s_sleep(1); \
    if ((++_sp & 255u) == 0u) { if (xb_ld(&(bar)[XB_TMO])) break; if (_sp > XB_SPIN_CAP) { atomicAdd(&(bar)[XB_TMO], 1u); break; } } } } while (0)
struct XcdBarrier { unsigned* bar; unsigned x; volatile LAS unsigned* st; };
__device__ __forceinline__ XcdBarrier xcd_barrier_post(unsigned* bar, volatile LAS unsigned* st) {
  XcdBarrier b; b.bar = bar; b.x = xb_xcc_id(); b.st = st;
  if (threadIdx.x == 0) (void)xb_add(&bar[XB_XCNT(b.x)], 1u);
  return b;
}
__device__ __forceinline__ void xcd_barrier_complete(unsigned* bar, unsigned x, unsigned& nloc, unsigned& nx) {
  const unsigned G = gridDim.x * gridDim.y * gridDim.z;
  unsigned sum, cnt, mine, sp = 0u;
  for (;;) {
    sum = 0u; cnt = 0u; mine = 0u;
#pragma unroll
    for (unsigned j = 0; j < 16; ++j) { const unsigned c = xb_ld(&bar[XB_XCNT(j)]); sum += c; cnt += (c > 0u) ? 1u : 0u; mine = (j == x) ? c : mine; }
    if (sum == G) break;
    __builtin_amdgcn_s_sleep(1);
    if ((++sp & 255u) == 0u) { if (xb_ld(&bar[XB_TMO])) break; if (sp > XB_SPIN_CAP) { atomicAdd(&bar[XB_TMO], 1u); break; } }
  }
  nloc = mine > 0u ? mine : 1u; nx = cnt > 0u ? cnt : 1u;
}
__device__ __forceinline__ void xcd_barrier(const XcdBarrier& b) {
  asm volatile("s_waitcnt vmcnt(0)" ::: "memory");
  __syncthreads();
  if (threadIdx.x == 0) {
    unsigned* bar = b.bar;
    __builtin_amdgcn_s_waitcnt(0);
    unsigned nloc = b.st[0], nx = b.st[1];
    if (nloc == 0u) { xcd_barrier_complete(bar, b.x, nloc, nx); b.st[0] = nloc; b.st[1] = nx; }
    const unsigned old = xb_add(&bar[XB_XSUB(b.x)], 1u);
    const unsigned gen = old / nloc;
    if (old + 1u == (gen + 1u) * nloc) {
      __builtin_amdgcn_fence(__ATOMIC_RELEASE, "agent");
      asm volatile("s_waitcnt vmcnt(0)" ::: "memory");
      const unsigned og = xb_add(&bar[XB_TOP], 1u);
      const unsigned tg = og / nx;
      if (og + 1u == (tg + 1u) * nx) xb_add(&bar[XB_TOPGEN], 1u);
      else XB_SPIN(xb_ld(&bar[XB_TOPGEN]) == tg, bar);
      __builtin_amdgcn_fence(__ATOMIC_ACQUIRE, "agent");
      xb_add(&bar[XB_XGEN(b.x)], 1u);
      asm volatile("s_waitcnt vmcnt(0)" ::: "memory");
    } else {
      XB_SPIN(xb_ld(&bar[XB_XGEN(b.x)]) == gen, bar);
      __builtin_amdgcn_fence(__ATOMIC_ACQUIRE, "agent");
      asm volatile("s_waitcnt vmcnt(0)" ::: "memory");
    }
  }
  __syncthreads();
}

#define NQ_WORDS 4096
__global__ void __launch_bounds__(256, 2) fwd_megakernel(Params p_unused) {
  cg::grid_group grid = cg::this_grid();
  __shared__ __attribute__((aligned(16))) char smem[SMEM_BYTES];
  volatile LAS unsigned* st = (volatile LAS unsigned*)(smem + SMEM_BYTES - 32);
  if (threadIdx.x == 0) { st[0] = 0u; st[1] = 0u; }
  __syncthreads();
  if (gridDim.y == 4242u) grid.sync();
  XcdBarrier xb;
  {
    const KP p = get_params();
    xb = xcd_barrier_post((unsigned*)p.counters() + NQ_WORDS, st);
    ln_rows(p, -1, false);
    prep_weights(p, 0, smem);
  }
  xcd_barrier(xb);
  const int xcc = (int)(xb.x & 7u);
#ifndef REP1
#define REP1 1
#define REP2 1
#define REP3 1
#define REP4 1
#endif
#ifndef REP5
#define REP5 1
#define REP6 1
#define REP7 0
#endif
#pragma unroll 1
  for (int l = 0; l < DEPTH; ++l) {
#define QPTR(ph, rep) (p.counters() + ((l * 6 + (ph)) * 4 + (rep)) * 32)
    for (int rep = 0; rep < REP1; ++rep) { const KP p = get_params(); phase_inproj(p, l, smem, QPTR(0, rep), xcc); }
    xcd_barrier(xb);
    for (int rep = 0; rep < REP2; ++rep) { const KP p = get_params(); phase2(p, l, smem, QPTR(1, rep), xcc); }
    xcd_barrier(xb);
    for (int rep = 0; rep < REP3; ++rep) { const KP p = get_params(); phase_nsa(p, smem, QPTR(2, rep), xcc); }
    xcd_barrier(xb);
    for (int rep = 0; rep < REP4; ++rep) { const KP p = get_params(); phase_merge(p, smem, QPTR(3, rep), xcc); }
    xcd_barrier(xb);
    for (int rep = 0; rep < REP5; ++rep) { const KP p = get_params(); phase_outproj(p, smem, QPTR(4, rep), xcc); }
    xcd_barrier(xb);
    for (int rep = 0; rep < REP6; ++rep) {
      const KP p = get_params();
      if (l + 1 < DEPTH) {
        ln_rows(p, l, false);
        prep_weights(p, l + 1, smem);
      } else {
        ln_rows(p, l, true);
      }
    }
    if (l + 1 < DEPTH) xcd_barrier(xb);
    for (int rep = 0; rep < REP7; ++rep) xcd_barrier(xb);
  }
}

extern "C" void kernel_launch(void* const* d_in, const int* in_sizes, int n_in, void* d_out, int out_size,
                              void* d_ws, size_t ws_size, hipStream_t stream) {
  static int grid_blocks = 0;
  if (!grid_blocks) {
    int dev = 0, cus = 0, per_cu = 0;
    (void)hipGetDevice(&dev);
    (void)hipDeviceGetAttribute(&cus, hipDeviceAttributeMultiprocessorCount, dev);
    (void)hipOccupancyMaxActiveBlocksPerMultiprocessor(&per_cu, fwd_megakernel, 256, 0);
    if (per_cu > 2) per_cu = 2;
    if (per_cu < 1) per_cu = 1;
    grid_blocks = cus * per_cu;
  }
  Params p{};
  p.x = (const float*)d_in[0]; p.w_in = (const float*)d_in[1]; p.b_in = (const float*)d_in[2];
  p.pool_w = (const float*)d_in[3]; p.pool_b = (const float*)d_in[4]; p.pool_scale = (const float*)d_in[5];
  p.pos_k = (const float*)d_in[6]; p.pos_v = (const float*)d_in[7]; p.w1k = (const float*)d_in[8];
  p.w2k = (const float*)d_in[9]; p.w1v = (const float*)d_in[10]; p.w2v = (const float*)d_in[11];
  p.wpa = (const float*)d_in[12]; p.wpb = (const float*)d_in[13]; p.wpc = (const float*)d_in[14];
  p.wo = (const float*)d_in[15]; p.ln_g = (const float*)d_in[16]; p.ln_b = (const float*)d_in[17];
  p.out = (float*)d_out;
  p.ws = (char*)d_ws;
  if (WS_TOTAL > ws_size) { fprintf(stderr, "workspace too small: need %zu have %zu\n", (size_t)WS_TOTAL, ws_size); return; }
  (void)hipMemsetAsync((char*)d_ws + OFF_counters, 0, (size_t)(NQ_WORDS + XCD_BAR_WORDS) * 4, stream);
  void* args[] = {&p};
  hipError_t e = hipLaunchCooperativeKernel((void*)fwd_megakernel, dim3(grid_blocks), dim3(256), args, 0, stream);
  if (e != hipSuccess) fprintf(stderr, "cooperative launch failed: %s (grid %d)\n", hipGetErrorString(e), grid_blocks);
}
```

```cpp
#include <hip/hip_runtime.h>
#include <hip/hip_cooperative_groups.h>
#include <cstdio>
#include <cstdint>
namespace cg = cooperative_groups;

typedef _Float16 half_t;
typedef _Float16 h8 __attribute__((ext_vector_type(8)));
typedef _Float16 h4 __attribute__((ext_vector_type(4)));
typedef float f32x4 __attribute__((ext_vector_type(4)));
typedef float f32x16 __attribute__((ext_vector_type(16)));

#define SEQ 8192
#define DM 1024
#define NTOK 16384
#define DEPTH 4
#define NIN 7360
#define NU 7424
#define ALPHA_F 1.681792830507429f
#define NEGF (-1e30f)

#define C_AX 0
#define C_AZ 512
#define C_BQ 1024
#define C_BZ 1536
#define C_CQ 2048
#define C_CZ 2560
#define C_GM 3072
#define C_IQ 6144
#define C_CKC 6400
#define C_CVC 6528
#define C_CKS 6656
#define C_CVS 6784
#define C_CKW 6912
#define C_CVW 7040
#define C_BK 7168
#define C_BV 7232
#define C_IK 7296
#define C_IW 7328
#define C_CG 7336

#define SMEM_BYTES 73728

constexpr size_t OFF_xr = 0;
constexpr size_t OFF_xh = OFF_xr + (((size_t)NTOK*DM*4 + 255) & ~(size_t)255);
constexpr size_t OFF_u = OFF_xh + (((size_t)NTOK*DM*2 + 255) & ~(size_t)255);
constexpr size_t OFF_winT = OFF_u + (((size_t)NTOK*NU*2 + 255) & ~(size_t)255);
constexpr size_t OFF_wpT = OFF_winT + (((size_t)NU*DM*2 + 255) & ~(size_t)255);
constexpr size_t OFF_woT = OFF_wpT + (((size_t)3*DM*512*2 + 255) & ~(size_t)255);
constexpr size_t OFF_poolT = OFF_woT + (((size_t)DM*DM*2 + 255) & ~(size_t)255);
constexpr size_t OFF_w1T = OFF_poolT + (((size_t)4*128*128*2 + 255) & ~(size_t)255);
constexpr size_t OFF_posb = OFF_w1T + (((size_t)2*64*2048*2 + 255) & ~(size_t)255);
constexpr size_t OFF_vsT = OFF_posb + (((size_t)512 + 255) & ~(size_t)255);
constexpr size_t OFF_vwT = OFF_vsT + (((size_t)4*64*SEQ*2 + 255) & ~(size_t)255);
constexpr size_t OFF_kcmp = OFF_vwT + (((size_t)4*64*SEQ*2 + 255) & ~(size_t)255);
constexpr size_t OFF_vcmpT = OFF_kcmp + (((size_t)4*512*64*2 + 255) & ~(size_t)255);
constexpr size_t OFF_ya = OFF_vcmpT + (((size_t)4*64*512*2 + 255) & ~(size_t)255);
constexpr size_t OFF_yb = OFF_ya + (((size_t)NTOK*512*2 + 255) & ~(size_t)255);
constexpr size_t OFF_yc = OFF_yb + (((size_t)NTOK*512*2 + 255) & ~(size_t)255);
constexpr size_t OFF_mm = OFF_yc + (((size_t)NTOK*512*2 + 255) & ~(size_t)255);
constexpr size_t OFF_counters = OFF_mm + (((size_t)NTOK*DM*2 + 255) & ~(size_t)255);
constexpr size_t WS_TOTAL = OFF_counters + (((size_t)32768 + 255) & ~(size_t)255);
struct Params {
  const float* x; const float* w_in; const float* b_in; const float* pool_w; const float* pool_b;
  const float* pool_scale; const float* pos_k; const float* pos_v; const float* w1k; const float* w2k;
  const float* w1v; const float* w2v; const float* wpa; const float* wpb; const float* wpc;
  const float* wo; const float* ln_g; const float* ln_b;
  float* out;
  char* ws;
};
typedef const __attribute__((address_space(4))) unsigned long long* kargp_t;
struct KP {
  kargp_t kp;
  __device__ __forceinline__ const float* x() const { return (const float*)(const __attribute__((address_space(1))) float*)kp[0]; }
  __device__ __forceinline__ const float* w_in() const { return (const float*)(const __attribute__((address_space(1))) float*)kp[1]; }
  __device__ __forceinline__ const float* b_in() const { return (const float*)(const __attribute__((address_space(1))) float*)kp[2]; }
  __device__ __forceinline__ const float* pool_w() const { return (const float*)(const __attribute__((address_space(1))) float*)kp[3]; }
  __device__ __forceinline__ const float* pool_b() const { return (const float*)(const __attribute__((address_space(1))) float*)kp[4]; }
  __device__ __forceinline__ const float* pool_scale() const { return (const float*)(const __attribute__((address_space(1))) float*)kp[5]; }
  __device__ __forceinline__ const float* pos_k() const { return (const float*)(const __attribute__((address_space(1))) float*)kp[6]; }
  __device__ __forceinline__ const float* pos_v() const { return (const float*)(const __attribute__((address_space(1))) float*)kp[7]; }
  __device__ __forceinline__ const float* w1k() const { return (const float*)(const __attribute__((address_space(1))) float*)kp[8]; }
  __device__ __forceinline__ const float* w2k() const { return (const float*)(const __attribute__((address_space(1))) float*)kp[9]; }
  __device__ __forceinline__ const float* w1v() const { return (const float*)(const __attribute__((address_space(1))) float*)kp[10]; }
  __device__ __forceinline__ const float* w2v() const { return (const float*)(const __attribute__((address_space(1))) float*)kp[11]; }
  __device__ __forceinline__ const float* wpa() const { return (const float*)(const __attribute__((address_space(1))) float*)kp[12]; }
  __device__ __forceinline__ const float* wpb() const { return (const float*)(const __attribute__((address_space(1))) float*)kp[13]; }
  __device__ __forceinline__ const float* wpc() const { return (const float*)(const __attribute__((address_space(1))) float*)kp[14]; }
  __device__ __forceinline__ const float* wo() const { return (const float*)(const __attribute__((address_space(1))) float*)kp[15]; }
  __device__ __forceinline__ const float* ln_g() const { return (const float*)(const __attribute__((address_space(1))) float*)kp[16]; }
  __device__ __forceinline__ const float* ln_b() const { return (const float*)(const __attribute__((address_space(1))) float*)kp[17]; }
  __device__ __forceinline__ float* out() const { return (float*)(__attribute__((address_space(1))) float*)kp[18]; }
  __device__ __forceinline__ char* ws() const { return (char*)(__attribute__((address_space(1))) char*)kp[19]; }
  __device__ __forceinline__ float* xr() const { return (float*)(ws() + OFF_xr); }
  __device__ __forceinline__ half_t* xh() const { return (half_t*)(ws() + OFF_xh); }
  __device__ __forceinline__ half_t* u() const { return (half_t*)(ws() + OFF_u); }
  __device__ __forceinline__ half_t* winT() const { return (half_t*)(ws() + OFF_winT); }
  __device__ __forceinline__ half_t* wpT() const { return (half_t*)(ws() + OFF_wpT); }
  __device__ __forceinline__ half_t* woT() const { return (half_t*)(ws() + OFF_woT); }
  __device__ __forceinline__ half_t* poolT() const { return (half_t*)(ws() + OFF_poolT); }
  __device__ __forceinline__ half_t* w1T() const { return (half_t*)(ws() + OFF_w1T); }
  __device__ __forceinline__ float* posb() const { return (float*)(ws() + OFF_posb); }
  __device__ __forceinline__ half_t* vsT() const { return (half_t*)(ws() + OFF_vsT); }
  __device__ __forceinline__ half_t* vwT() const { return (half_t*)(ws() + OFF_vwT); }
  __device__ __forceinline__ half_t* kcmp() const { return (half_t*)(ws() + OFF_kcmp); }
  __device__ __forceinline__ half_t* vcmpT() const { return (half_t*)(ws() + OFF_vcmpT); }
  __device__ __forceinline__ half_t* ya() const { return (half_t*)(ws() + OFF_ya); }
  __device__ __forceinline__ half_t* yb() const { return (half_t*)(ws() + OFF_yb); }
  __device__ __forceinline__ half_t* yc() const { return (half_t*)(ws() + OFF_yc); }
  __device__ __forceinline__ half_t* mm() const { return (half_t*)(ws() + OFF_mm); }
  __device__ __forceinline__ int* counters() const { return (int*)(ws() + OFF_counters); }
};
__device__ __forceinline__ KP get_params() {
  KP q;
  q.kp = (kargp_t)__builtin_amdgcn_kernarg_segment_ptr();
  asm volatile("" : "+s"(q.kp));
  return q;
}


__device__ __forceinline__ int orig_col(int n) {
  if (n < 1536) return n;
  if (n < 2048) return 1664 + (n - 1536);
  if (n < 2560) return 2472 + (n - 2048);
  if (n < 3072) return 3776 + (n - 2560);
  if (n < 6144) return 4288 + (n - 3072);
  if (n < 6400) return 2176 + (n - 6144);
  if (n < 7168) return 2984 + (n - 6400);
  if (n < 7296) return 1536 + (n - 7168);
  if (n < 7328) return 2432 + (n - 7296);
  if (n < 7336) return 2464 + (n - 7328);
  if (n < 7360) return 3752 + (n - 7336);
  return -1;
}

__device__ __forceinline__ float wave_sum(float v) {
#pragma unroll
  for (int o = 32; o > 0; o >>= 1) v += __shfl_xor(v, o);
  return v;
}
__device__ __forceinline__ float sigmoidf_(float x) { return 1.f / (1.f + __expf(-x)); }
__device__ __forceinline__ float siluf_(float x) { return x / (1.f + __expf(-x)); }

template <int NI, class LA, class LB, class EP>
__device__ __forceinline__ void gemm_tile(int K, LA loadA, LB loadB, EP epi, char* smem) {
  constexpr int BN = NI * 64;
  constexpr int NB = BN / 32;
  half_t* sA = (half_t*)smem;
  half_t* sB = sA + 128 * 72;
  int tid = threadIdx.x;
  asm volatile("" : "+v"(tid));
  const int lane = tid & 63, wid = tid >> 6;
  const int wm = wid >> 1, wn = wid & 1;
  f32x16 acc[2][NI];
#pragma unroll
  for (int i = 0; i < 2; ++i)
#pragma unroll
    for (int j = 0; j < NI; ++j)
#pragma unroll
      for (int r = 0; r < 16; ++r) acc[i][j][r] = 0.f;
  const int lr = tid >> 3, lc = (tid & 7) * 8;
  uint4 ra[4], rb[NB];
#pragma unroll
  for (int i = 0; i < 4; ++i) ra[i] = loadA(lr + 32 * i, lc);
#pragma unroll
  for (int i = 0; i < NB; ++i) rb[i] = loadB(lr + 32 * i, lc);
  const int nk = K >> 6;
  for (int kt = 0; kt < nk; ++kt) {
    __syncthreads();
#pragma unroll
    for (int i = 0; i < 4; ++i) *(uint4*)&sA[(lr + 32 * i) * 72 + lc] = ra[i];
#pragma unroll
    for (int i = 0; i < NB; ++i) *(uint4*)&sB[(lr + 32 * i) * 72 + lc] = rb[i];
    __syncthreads();
    if (kt + 1 < nk) {
      const int kk = (kt + 1) * 64 + lc;
#pragma unroll
      for (int i = 0; i < 4; ++i) ra[i] = loadA(lr + 32 * i, kk);
#pragma unroll
      for (int i = 0; i < NB; ++i) rb[i] = loadB(lr + 32 * i, kk);
    }
#pragma unroll
    for (int s = 0; s < 4; ++s) {
      h8 af[2], bf[NI];
#pragma unroll
      for (int mi = 0; mi < 2; ++mi)
        af[mi] = *(const h8*)&sA[(wm * 64 + mi * 32 + (lane & 31)) * 72 + s * 16 + (lane >> 5) * 8];
#pragma unroll
      for (int ni = 0; ni < NI; ++ni)
        bf[ni] = *(const h8*)&sB[(wn * (NI * 32) + ni * 32 + (lane & 31)) * 72 + s * 16 + (lane >> 5) * 8];
#pragma unroll
      for (int mi = 0; mi < 2; ++mi)
#pragma unroll
        for (int ni = 0; ni < NI; ++ni)
          acc[mi][ni] = __builtin_amdgcn_mfma_f32_32x32x16_f16(af[mi], bf[ni], acc[mi][ni], 0, 0, 0);
    }
  }
#pragma unroll
  for (int mi = 0; mi < 2; ++mi)
#pragma unroll
    for (int ni = 0; ni < NI; ++ni)
#pragma unroll
      for (int r = 0; r < 16; ++r) {
        const int row = wm * 64 + mi * 32 + (r & 3) + 8 * (r >> 2) + 4 * (lane >> 5);
        const int col = wn * (NI * 32) + ni * 32 + (lane & 31);
        epi(mi, ni, r, row, col, acc[mi][ni][r]);
      }
}

template <class LA, class LB, class EP>
__device__ __forceinline__ void gemm_tile_big(int K, LA loadA, LB loadB, EP epi, char* smem) {
  half_t* sA = (half_t*)smem;
  half_t* sB = sA + 256 * 72;
  int tid = threadIdx.x;
  asm volatile("" : "+v"(tid));
  const int lane = tid & 63, wid = tid >> 6;
  const int wm = wid >> 1, wn = wid & 1;
  f32x16 acc[4][2];
#pragma unroll
  for (int i = 0; i < 4; ++i)
#pragma unroll
    for (int j = 0; j < 2; ++j)
#pragma unroll
      for (int r = 0; r < 16; ++r) acc[i][j][r] = 0.f;
  const int lr = tid >> 3, lc = (tid & 7) * 8;
  uint4 ra[8], rb[4];
#pragma unroll
  for (int i = 0; i < 8; ++i) ra[i] = loadA(lr + 32 * i, lc);
#pragma unroll
  for (int i = 0; i < 4; ++i) rb[i] = loadB(lr + 32 * i, lc);
  const int nk = K >> 6;
  for (int kt = 0; kt < nk; ++kt) {
    __syncthreads();
#pragma unroll
    for (int i = 0; i < 8; ++i) *(uint4*)&sA[(lr + 32 * i) * 72 + lc] = ra[i];
#pragma unroll
    for (int i = 0; i < 4; ++i) *(uint4*)&sB[(lr + 32 * i) * 72 + lc] = rb[i];
    __syncthreads();
    if (kt + 1 < nk) {
      const int kk = (kt + 1) * 64 + lc;
#pragma unroll
      for (int i = 0; i < 8; ++i) ra[i] = loadA(lr + 32 * i, kk);
#pragma unroll
      for (int i = 0; i < 4; ++i) rb[i] = loadB(lr + 32 * i, kk);
    }
#pragma unroll
    for (int s = 0; s < 4; ++s) {
      h8 af[4], bf[2];
#pragma unroll
      for (int mi = 0; mi < 4; ++mi)
        af[mi] = *(const h8*)&sA[(wm * 128 + mi * 32 + (lane & 31)) * 72 + s * 16 + (lane >> 5) * 8];
#pragma unroll
      for (int ni = 0; ni < 2; ++ni)
        bf[ni] = *(const h8*)&sB[(wn * 64 + ni * 32 + (lane & 31)) * 72 + s * 16 + (lane >> 5) * 8];
#pragma unroll
      for (int mi = 0; mi < 4; ++mi)
#pragma unroll
        for (int ni = 0; ni < 2; ++ni)
          acc[mi][ni] = __builtin_amdgcn_mfma_f32_32x32x16_f16(af[mi], bf[ni], acc[mi][ni], 0, 0, 0);
    }
  }
#pragma unroll
  for (int mi = 0; mi < 4; ++mi)
#pragma unroll
    for (int ni = 0; ni < 2; ++ni)
#pragma unroll
      for (int r = 0; r < 16; ++r) {
        const int row = wm * 128 + mi * 32 + (r & 3) + 8 * (r >> 2) + 4 * (lane >> 5);
        const int col = wn * 64 + ni * 32 + (lane & 31);
        epi(mi, ni, r, row, col, acc[mi][ni][r]);
      }
}

template <class CM>
__device__ __forceinline__ void tconv_tile(const float* __restrict__ src, int lds_, half_t* __restrict__ dst, int ldd,
                                           int n0, int k0, CM cmap, char* smem) {
  float* t = (float*)smem;
  int tid = threadIdx.x;
  asm volatile("" : "+v"(tid));
  {
    const int n = tid & 63;
    const int c = cmap(n0 + n);
    float tv[16];
#pragma unroll
    for (int i = 0; i < 16; ++i) {
      const int k = (tid >> 6) + 4 * i;
      tv[i] = (c >= 0) ? src[(size_t)(k0 + k) * lds_ + c] : 0.f;
    }
#pragma unroll
    for (int i = 0; i < 16; ++i) {
      const int k = (tid >> 6) + 4 * i;
      t[k * 65 + n] = tv[i];
    }
  }
  __syncthreads();
#pragma unroll
  for (int i = 0; i < 2; ++i) {
    const int idx = tid + 256 * i;
    const int n = idx >> 3, kc = (idx & 7) * 8;
    h8 v;
#pragma unroll
    for (int j = 0; j < 8; ++j) v[j] = (half_t)t[(kc + j) * 65 + n];
    *(h8*)&dst[(size_t)(n0 + n) * ldd + k0 + kc] = v;
  }
  __syncthreads();
}

__device__ __forceinline__ void ln_rows(const KP& p, int lprev, bool final_) {
  int tid = threadIdx.x;
  asm volatile("" : "+v"(tid));
  const int lane = tid & 63, wid = tid >> 6;
  const int gw = blockIdx.x * 4 + wid, nw = gridDim.x * 4;
  for (int row = gw; row < NTOK; row += nw) {
    const float4* rp = (const float4*)((lprev < 0 ? p.x() : (const float*)p.u()) + (size_t)row * DM);
    float4 v[4];
    float s = 0.f;
#pragma unroll
    for (int i = 0; i < 4; ++i) {
      v[i] = rp[lane + 64 * i];
      s += v[i].x + v[i].y + v[i].z + v[i].w;
    }
    if (lprev >= 0) {
      float mu = wave_sum(s) * (1.f / DM);
      float q = 0.f;
#pragma unroll
      for (int i = 0; i < 4; ++i) {
        float a = v[i].x - mu, b = v[i].y - mu, c = v[i].z - mu, d = v[i].w - mu;
        q += a * a + b * b + c * c + d * d;
      }
      float rstd = rsqrtf(wave_sum(q) * (1.f / DM) + 1e-5f);
      const float4* g4 = (const float4*)(p.ln_g() + lprev * DM);
      const float4* b4 = (const float4*)(p.ln_b() + lprev * DM);
#pragma unroll
      for (int i = 0; i < 4; ++i) {
        float4 g = g4[lane + 64 * i], bb = b4[lane + 64 * i];
        v[i].x = (v[i].x - mu) * rstd * g.x + bb.x;
        v[i].y = (v[i].y - mu) * rstd * g.y + bb.y;
        v[i].z = (v[i].z - mu) * rstd * g.z + bb.z;
        v[i].w = (v[i].w - mu) * rstd * g.w + bb.w;
      }
    }
    if (final_) {
      float4* op = (float4*)(p.out() + (size_t)row * DM);
#pragma unroll
      for (int i = 0; i < 4; ++i) op[lane + 64 * i] = v[i];
    } else {
      float4* op = (float4*)(p.xr() + (size_t)row * DM);
      h4* hp = (h4*)(p.xh() + (size_t)row * DM);
#pragma unroll
      for (int i = 0; i < 4; ++i) {
        op[lane + 64 * i] = v[i];
        h4 hv;
        hv[0] = (half_t)v[i].x; hv[1] = (half_t)v[i].y; hv[2] = (half_t)v[i].z; hv[3] = (half_t)v[i].w;
        hp[lane + 64 * i] = hv;
      }
    }
  }
}

__device__ __forceinline__ void prep_weights(const KP& p, int l, char* smem) {
  int tid = threadIdx.x;
  asm volatile("" : "+v"(tid));
  const int total = 1856 + 384 + 256 + 16 + 64 + 2;
  for (int it = blockIdx.x; it < total; it += gridDim.x) {
    if (it < 1856) {
      const int nt = it >> 4, kt = it & 15;
      tconv_tile(p.w_in() + (size_t)l * DM * NIN, NIN, p.winT(), DM, nt * 64, kt * 64,
                 [](int n) { return orig_col(n); }, smem);
    } else if (it < 1856 + 384) {
      const int j = it - 1856;
      const int w = j >> 7, r = j & 127, nt = r >> 3, kt = r & 7;
      const float* src = (w == 0 ? p.wpa() : (w == 1 ? p.wpb() : p.wpc())) + (size_t)l * 512 * DM;
      tconv_tile(src, DM, p.wpT() + (size_t)w * DM * 512, 512, nt * 64, kt * 64, [](int n) { return n; }, smem);
    } else if (it < 1856 + 384 + 256) {
      const int j = it - 1856 - 384;
      const int nt = j >> 4, kt = j & 15;
      tconv_tile(p.wo() + (size_t)l * DM * DM, DM, p.woT(), DM, nt * 64, kt * 64, [](int n) { return n; }, smem);
    } else if (it < 1856 + 384 + 256 + 16) {
      const int j = it - 1856 - 384 - 256;
      const int g = j >> 2, nt = (j >> 1) & 1, kt = j & 1;
      tconv_tile(p.pool_w() + ((size_t)l * 4 + g) * 128 * 128, 128, p.poolT() + (size_t)g * 128 * 128, 128, nt * 64,
                 kt * 64, [](int n) { return n; }, smem);
    } else if (it < 1856 + 384 + 256 + 16 + 64) {
      const int j = it - 1856 - 384 - 256 - 16;
      const int kv = j >> 5, kt = j & 31;
      const float* src = (kv ? p.w1v() : p.w1k()) + (size_t)l * 2048 * 64;
      tconv_tile(src, 64, p.w1T() + (size_t)kv * 64 * 2048, 2048, 0, kt * 64, [](int n) { return n; }, smem);
    } else {
      const int kv = it - (1856 + 384 + 256 + 16 + 64);
      const float* w1 = (kv ? p.w1v() : p.w1k()) + (size_t)l * 2048 * 64;
      const float* pos = (kv ? p.pos_v() : p.pos_k()) + (size_t)l * 2048;
      float* red = (float*)smem;
      const int e = tid & 63, part = tid >> 6;
      float sa = 0.f, sb = 0.f, sc_ = 0.f, sd = 0.f;
      const float* wq = w1 + (size_t)part * 512 * 64 + e;
      const float* pq = pos + part * 512;
#pragma unroll 4
      for (int f = 0; f < 512; f += 4) {
        sa += pq[f] * wq[(size_t)f * 64];
        sb += pq[f + 1] * wq[(size_t)(f + 1) * 64];
        sc_ += pq[f + 2] * wq[(size_t)(f + 2) * 64];
        sd += pq[f + 3] * wq[(size_t)(f + 3) * 64];
      }
      const float s = (sa + sb) + (sc_ + sd);
      red[tid] = s;
      __syncthreads();
      if (tid < 64) p.posb()[kv * 64 + tid] = red[tid] + red[tid + 64] + red[tid + 128] + red[tid + 192];
      __syncthreads();
    }
  }
}

template <class F>
__device__ __forceinline__ void xcd_schedule(int* q, int xcc, int ngroups, int gsize, char* smem, F f) {
  int* s_item = (int*)(smem + SMEM_BYTES - 16);
#pragma unroll 1
  for (int dy = 0; dy < 8; ++dy) {
    const int y = (xcc + dy) & 7;
    for (;;) {
      if (threadIdx.x == 0) *s_item = atomicAdd(&q[y], 1);
      __syncthreads();
      const int i = *s_item;
      __syncthreads();
      const int grp = (i / gsize) * 8 + y;
      if (grp >= ngroups) break;
      f(grp, i % gsize);
    }
  }
}

__device__ __forceinline__ void phase_inproj(const KP& p, int l, char* smem, int* q, int xcc) {
  const float* bias = p.b_in() + (size_t)l * NIN;
  xcd_schedule(q, xcc, 128, 32, smem, [&](int grp, int within) __attribute__((always_inline)) {
    const int mt = (grp & 15) * 4 + (within & 3), nt = (grp >> 4) * 8 + (within >> 2);
    if (nt >= 58) return;
    const int m0 = mt * 256, n0 = nt * 128;
    const half_t* A = p.xh() + (size_t)m0 * DM;
    const half_t* B = p.winT() + (size_t)n0 * DM;
    int tidx = threadIdx.x;
    asm volatile("" : "+v"(tidx));
    const int lane = tidx & 63, wn = (tidx >> 6) & 1;
    float bv[2];
#pragma unroll
    for (int ni = 0; ni < 2; ++ni) {
      const int oc = orig_col(n0 + wn * 64 + ni * 32 + (lane & 31));
      bv[ni] = oc >= 0 ? bias[oc] : 0.f;
    }
    half_t* vT = (nt == 53) ? p.vsT() : ((nt == 55) ? p.vwT() : nullptr);
    gemm_tile_big(
        DM, [&](int r, int k) { return *(const uint4*)(A + (size_t)r * DM + k); },
        [&](int r, int k) { return *(const uint4*)(B + (size_t)r * DM + k); },
        [&](int mi, int ni, int r, int row, int col, float v) {
          const half_t hv = (half_t)(v + bv[ni]);
          const int tok = m0 + row;
          p.u()[(size_t)tok * NU + n0 + col] = hv;
          if (vT) {
            const int b = tok >> 13, t = tok & 8191;
            vT[((size_t)(b * 2 + (col >> 6)) * 64 + (col & 63)) * SEQ + t] = hv;
          }
        },
        smem);
  });
}

__device__ __forceinline__ void pool_item(const KP& p, int l, int item, char* smem) {
  const int g = item & 3, mt = item >> 2;
  const int m0 = mt * 128;
  const int wnd = 2 << g;
  const half_t* B = p.poolT() + (size_t)g * 128 * 128;
  int tidx = threadIdx.x;
  asm volatile("" : "+v"(tidx));
  const int lane = tidx & 63, wn = (tidx >> 6) & 1;
  float pb[2], ps[2];
#pragma unroll
  for (int ni = 0; ni < 2; ++ni) {
    const int d = wn * 64 + ni * 32 + (lane & 31);
    pb[ni] = p.pool_b()[(size_t)l * 512 + g * 128 + d];
    ps[ni] = p.pool_scale()[(size_t)l * 512 + g * 128 + d];
  }
  gemm_tile<2>(
      128,
      [&](int r, int k) {
        const int tok = m0 + r, t = tok & 8191;
        const int cnt = min(t + 1, wnd);
        const half_t* base = p.u() + (size_t)tok * NU + C_AX + g * 128 + k;
        float s[8];
#pragma unroll
        for (int j = 0; j < 8; ++j) s[j] = 0.f;
        h8 cur = *(const h8*)base;
        for (int q0 = 0; q0 < wnd; q0 += 8) {
          h8 v[8];
#pragma unroll
          for (int i = 0; i < 8; ++i) {
            const int qq = q0 + i;
            if (qq < cnt) v[i] = *(const h8*)(base - (size_t)qq * NU);
            else {
#pragma unroll
              for (int j = 0; j < 8; ++j) v[i][j] = (half_t)0.f;
            }
          }
#pragma unroll
          for (int i = 0; i < 8; ++i)
#pragma unroll
            for (int j = 0; j < 8; ++j) s[j] += (float)v[i][j];
        }
        const float inv = 1.f / (float)cnt;
        h8 o;
#pragma unroll
        for (int j = 0; j < 8; ++j) o[j] = (half_t)(s[j] * inv - (float)cur[j]);
        return *(uint4*)&o;
      },
      [&](int r, int k) { return *(const uint4*)(B + (size_t)r * 128 + k); },
      [&](int mi, int ni, int r, int row, int col, float v) {
        const int tok = m0 + row;
        const float z = (float)p.u()[(size_t)tok * NU + C_AZ + g * 128 + col];
        p.ya()[(size_t)tok * 512 + g * 128 + col] = (half_t)((v + pb[ni]) * ps[ni] * siluf_(z));
      },
      smem);
}

__device__ __forceinline__ void compress_item(const KP& p, int l, int item, char* smem) {
  const int mt = item & 3, kv = (item >> 2) & 1, g = (item >> 3) & 1, b = item >> 4;
  int tid = threadIdx.x;
  asm volatile("" : "+v"(tid));
  const int ccol = (kv ? C_CVC : C_CKC) + g * 64;
  const half_t* ub = p.u() + (size_t)b * SEQ * NU + ccol;
  const half_t* B = p.w1T() + (size_t)kv * 64 * 2048;
  float* hid = (float*)(smem + 28672);
  const float* posb = p.posb() + kv * 64;
  gemm_tile<1>(
      2048,
      [&](int r, int k) {
        const int n = mt * 128 + r;
        if (n >= 511) return make_uint4(0, 0, 0, 0);
        const int tok = 16 * n + (k >> 6);
        return *(const uint4*)(ub + (size_t)tok * NU + (k & 63));
      },
      [&](int r, int k) { return *(const uint4*)(B + (size_t)r * 2048 + k); },
      [&](int mi, int ni, int r, int row, int col, float v) { hid[row * 65 + col] = siluf_(v + posb[col]); }, smem);
  __syncthreads();
  float* w2s = (float*)smem;
  const float* w2 = (kv ? p.w2v() : p.w2k()) + (size_t)l * 4096;
  for (int i = tid; i < 4096; i += 256) w2s[i] = w2[i];
  __syncthreads();
  {
    const int n = tid >> 1, fh = (tid & 1) * 32;
    float acc[32];
#pragma unroll
    for (int f = 0; f < 32; ++f) acc[f] = 0.f;
    for (int e = 0; e < 64; ++e) {
      const float hv = hid[n * 65 + e];
#pragma unroll
      for (int f = 0; f < 32; ++f) acc[f] += hv * w2s[e * 64 + fh + f];
    }
    const int ng = mt * 128 + n;
    const bool valid = ng < 511;
    if (kv == 0) {
      half_t* dst = p.kcmp() + ((size_t)(b * 2 + g) * 512 + ng) * 64 + fh;
#pragma unroll
      for (int f = 0; f < 32; ++f) dst[f] = valid ? (half_t)acc[f] : (half_t)0.f;
    } else {
      half_t* dst = p.vcmpT() + ((size_t)(b * 2 + g) * 64 + fh) * 512 + ng;
#pragma unroll
      for (int f = 0; f < 32; ++f) dst[(size_t)f * 512] = valid ? (half_t)acc[f] : (half_t)0.f;
    }
  }
  __syncthreads();
}

#ifndef DSA_CAP
#define DSA_CAP 128
#endif
__device__ __forceinline__ void dsa_item(const KP& p, int b, int tile, char* smem) {
  const int t0 = tile * 16;
  int tid = threadIdx.x;
  asm volatile("" : "+v"(tid));
  const int lane = tid & 63, wid = tid >> 6;
  uint32_t* hist = (uint32_t*)smem;
  unsigned long long* cand = (unsigned long long*)(smem + 16384);
  unsigned short* sel = (unsigned short*)(smem + 32768);
  unsigned long long* pfx = (unsigned long long*)(smem + 40960);
  unsigned long long* tkey = pfx + 16;
  int* need = (int*)(tkey + 16);
  int* state = need + 16;
  int* cnt = state + 16;
  int* ccnt = cnt + 16;
  int* pf16 = ccnt + 16;
  int* ovf = pf16 + 16;
  int* nrem = ovf + 16;
  int* fastf = nrem + 8;
  uint32_t* h1w = (uint32_t*)(smem + 43008);
  float* pbuf = (float*)smem + wid * 2048;

  const half_t* ub = p.u() + (size_t)b * SEQ * NU;
  const int mytok = lane & 15, hq = lane >> 4;
  const int myt = t0 + mytok;
  if (tid < 16) {
    const int t = t0 + tid;
    pfx[tid] = 0ull; tkey[tid] = 0ull; need[tid] = 256; state[tid] = (t < 256) ? 0 : 1; cnt[tid] = 0; ccnt[tid] = 0;
    pf16[tid] = 0; ovf[tid] = 0;
  }
  if (tid < 8) nrem[tid] = 0;
  if (tid < 16) fastf[tid] = 0;
  for (int i = tid; i < 6144; i += 256) h1w[i] = 0u;
  h8 qf[8], qlh, qll;
  float iw[8];
  {
    const half_t* qrow = ub + (size_t)myt * NU;
#pragma unroll
    for (int h = 0; h < 8; ++h) qf[h] = *(const h8*)(qrow + C_IQ + h * 32 + hq * 8);
    const h8 w8 = *(const h8*)(qrow + C_IW);
#pragma unroll
    for (int h = 0; h < 8; ++h) iw[h] = (float)w8[h] * 0.03125f;
#pragma unroll
    for (int e = 0; e < 8; ++e) {
      float a = 0.f;
#pragma unroll
      for (int h = 0; h < 8; ++h) a += iw[h] * (float)qf[h][e];
      const half_t hi = (half_t)a;
      qlh[e] = hi;
      qll[e] = (half_t)(a - (float)hi);
    }
  }
  __syncthreads();
  const int nkt = (t0 + 16 + 31) >> 5;

  auto loadk = [&](int kt, h8* a) __attribute__((always_inline)) {
#pragma unroll
    for (int i = 0; i < 2; ++i)
      a[i] = *(const h8*)(ub + (size_t)(kt * 32 + i * 16 + (lane & 15)) * NU + C_IK + hq * 8);
  };
  auto scores = [&](const h8* a, float* sc) __attribute__((always_inline)) {
#pragma unroll
    for (int i = 0; i < 2; ++i) {
      f32x4 acc = {0.f, 0.f, 0.f, 0.f};
      acc = __builtin_amdgcn_mfma_f32_16x16x32_f16(a[i], qll, acc, 0, 0, 0);
      acc = __builtin_amdgcn_mfma_f32_16x16x32_f16(a[i], qlh, acc, 0, 0, 0);
#pragma unroll
      for (int h = 0; h < 8; ++h) {
        f32x4 d = {0.f, 0.f, 0.f, 0.f};
        d = __builtin_amdgcn_mfma_f32_16x16x32_f16(a[i], qf[h], d, 0, 0, 0);
#pragma unroll
        for (int r = 0; r < 4; ++r) acc[r] = __builtin_fmaf(__builtin_fabsf(d[r]), iw[h], acc[r]);
      }
#pragma unroll
      for (int r = 0; r < 4; ++r) sc[i * 4 + r] = acc[r];
    }
  };
  auto skey = [&](float s) __attribute__((always_inline)) -> uint32_t {
    s = s + 0.f;
    const uint32_t u_ = __float_as_uint(s);
    return (u_ & 0x80000000u) ? ~u_ : (u_ | 0x80000000u);
  };
  auto mkkey = [&](float s, int key) __attribute__((always_inline)) -> unsigned long long {
    s = s + 0.f;
    uint32_t u_ = __float_as_uint(s);
    u_ = (u_ & 0x80000000u) ? ~u_ : (u_ | 0x80000000u);
    return ((unsigned long long)u_ << 16) | (unsigned long long)(8191 - key);
  };
  auto scan_token = [&](int tk, int level) __attribute__((always_inline)) -> bool {
    const int shift = 40 - 8 * level;
    const uint32_t* hrow = hist + tk * 256;
    const uint4 hv = *(const uint4*)&hrow[252 - 4 * lane];
    const int c = (int)(hv.x + hv.y + hv.z + hv.w);
    int cum = c;
#pragma unroll
    for (int o = 1; o < 64; o <<= 1) {
      int v = __shfl_up(cum, o);
      if (lane >= o) cum += v;
    }
    const int nd = need[tk];
    const unsigned long long mask = __ballot(cum >= nd);
    const int L = mask ? (int)__builtin_ctzll(mask) : 63;
    int running = cum - c, bstar, cb;
    if (running + (int)hv.w >= nd) { bstar = 255 - 4 * lane; cb = hv.w; }
    else {
      running += hv.w;
      if (running + (int)hv.z >= nd) { bstar = 254 - 4 * lane; cb = hv.z; }
      else {
        running += hv.z;
        if (running + (int)hv.y >= nd) { bstar = 253 - 4 * lane; cb = hv.y; }
        else { running += hv.y; bstar = 252 - 4 * lane; cb = hv.x; }
      }
    }
    running = __shfl(running, L); bstar = __shfl(bstar, L); cb = __shfl(cb, L);
    const int nd2 = nd - running;
    const bool fin = (cb == nd2) || (level == 5);
    if (lane == 0) {
      const unsigned long long np = (pfx[tk] << 8) | (unsigned long long)bstar;
      if (fin) { state[tk] = 0; tkey[tk] = np << shift; }
      else { need[tk] = nd2; pfx[tk] = np; }
    }
    return fin;
  };
  auto run_level = [&](int level, bool fillx) __attribute__((always_inline)) {
    const int shift = 40 - 8 * level;
    for (int i = tid; i < 4096; i += 256) hist[i] = 0u;
    __syncthreads();
    {
      const unsigned long long mypfx = pfx[mytok];
      const bool act = state[mytok] == 1 && fastf[mytok] == 0;
      h8 na[2];
      if (wid < nkt) loadk(wid, na);
      for (int kt = wid; kt < nkt; kt += 4) {
        h8 ca[2];
#pragma unroll
        for (int i = 0; i < 2; ++i) ca[i] = na[i];
        loadk(kt + 4 < nkt ? kt + 4 : kt, na);
        float sc[8];
        scores(ca, sc);
        if (act) {
#pragma unroll
          for (int q = 0; q < 8; ++q) {
            const int key = kt * 32 + (q >> 2) * 16 + 4 * hq + (q & 3);
            if (key <= myt) {
              if (level < 2) {
                const uint32_t u32 = skey(sc[q]);
                if (level == 0) {
                  const uint32_t b8 = u32 >> 24;
                  atomicAdd(&hist[mytok * 256 + (int)b8], 1u);
                  if (fillx) {
                    const uint32_t ix = b8 - 0xBEu;
                    if (ix < 3u) {
                      const uint32_t e16 = (ix * 16u + (uint32_t)mytok) * 256u + ((u32 >> 16) & 255u);
                      atomicAdd(&h1w[e16 >> 1], (e16 & 1u) ? 65536u : 1u);
                    }
                  }
                } else if ((u32 >> 24) == (uint32_t)mypfx) atomicAdd(&hist[mytok * 256 + (int)((u32 >> 16) & 255u)], 1u);
              } else {
                const unsigned long long k48 = mkkey(sc[q], key);
                if ((k48 >> (shift + 8)) == mypfx)
                  atomicAdd(&hist[mytok * 256 + (int)((k48 >> shift) & 255ull)], 1u);
              }
            }
          }
        }
      }
    }
    __syncthreads();
    {
      int rem = 0;
      for (int j = 0; j < 4; ++j) {
        const int tk = wid * 4 + j;
        if (state[tk] != 1 || fastf[tk] != 0) continue;
        if (!scan_token(tk, level)) rem++;
      }
      if (lane == 0 && rem) atomicAdd(&nrem[level], rem);
    }
    __syncthreads();
  };

  run_level(0, true);
  if (tid < 16) {
    const int b0 = (int)pfx[tid];
    const int f = (state[tid] == 1 && b0 >= 0xBE && b0 <= 0xC0) ? 1 : 0;
    fastf[tid] = f;
    if (state[tid] == 1 && !f) atomicAdd(&nrem[7], 1);
  }
  __syncthreads();
  if (nrem[7] != 0) run_level(1, false);
  for (int j = 0; j < 4; ++j) {
    const int tk = wid * 4 + j;
    if (state[tk] != 1 || fastf[tk] == 0) continue;
    const uint32_t ix = (uint32_t)pfx[tk] - 0xBEu;
    const unsigned short* hx = (const unsigned short*)h1w + (ix * 16u + (uint32_t)tk) * 256u;
    const ushort4 c4 = *(const ushort4*)&hx[4 * lane];
    uint4 w4;
    w4.x = c4.x; w4.y = c4.y; w4.z = c4.z; w4.w = c4.w;
    *(uint4*)&hist[tk * 256 + 4 * lane] = w4;
    __builtin_amdgcn_wave_barrier();
    scan_token(tk, 1);
  }
  __syncthreads();
  if (tid < 16) fastf[tid] = 0;
  __syncthreads();

  {
    const int st0 = state[mytok];
    const unsigned long long mytk = tkey[mytok];
    const unsigned long long myp16 = pfx[mytok];
    h8 na[2];
    if (wid < nkt) loadk(wid, na);
    for (int kt = wid; kt < nkt; kt += 4) {
      h8 ca[2];
#pragma unroll
      for (int i = 0; i < 2; ++i) ca[i] = na[i];
      loadk(kt + 4 < nkt ? kt + 4 : kt, na);
      float sc[8];
      scores(ca, sc);
#pragma unroll
      for (int q = 0; q < 8; ++q) {
        const int key = kt * 32 + (q >> 2) * 16 + 4 * hq + (q & 3);
        if (key <= myt) {
          const uint32_t u32 = skey(sc[q]);
          bool take, isc = false;
          if (st0 == 0) take = (((unsigned long long)u32 << 16) | (unsigned long long)(8191 - key)) >= mytk;
          else {
            const uint32_t p16 = u32 >> 16;
            take = p16 > (uint32_t)myp16;
            isc = p16 == (uint32_t)myp16;
          }
          if (take) {
            const int pos = atomicAdd(&cnt[mytok], 1);
            if (pos < 256) sel[mytok * 256 + pos] = (unsigned short)key;
          } else if (isc) {
            const int pos = atomicAdd(&ccnt[mytok], 1);
            if (pos < DSA_CAP) cand[mytok * 128 + pos] = ((unsigned long long)u32 << 16) | (unsigned long long)(8191 - key);
          }
        }
      }
    }
  }
  __syncthreads();
  {
    int nov = 0;
    for (int j = 0; j < 4; ++j) {
      const int tk = wid * 4 + j;
      if (state[tk] != 1) continue;
      const int nc = ccnt[tk];
      if (nc > DSA_CAP) {
        nov++;
        if (lane == 0) { ovf[tk] = 1; pf16[tk] = (int)pfx[tk]; }
        continue;
      }
      const int nd = need[tk];
      const unsigned long long k0 = (lane < nc) ? cand[tk * 128 + lane] : 0ull;
      const unsigned long long k1 = (lane + 64 < nc) ? cand[tk * 128 + lane + 64] : 0ull;
      int r0 = 0, r1 = 0;
      for (int q = 0; q < nc; ++q) {
        const unsigned long long kq = cand[tk * 128 + q];
        r0 += (kq > k0) ? 1 : 0;
        r1 += (kq > k1) ? 1 : 0;
      }
      if (lane < nc && r0 < nd) {
        const int pos = atomicAdd(&cnt[tk], 1);
        if (pos < 256) sel[tk * 256 + pos] = (unsigned short)(8191 - (int)(k0 & 0xFFFFull));
      }
      if (lane + 64 < nc && r1 < nd) {
        const int pos = atomicAdd(&cnt[tk], 1);
        if (pos < 256) sel[tk * 256 + pos] = (unsigned short)(8191 - (int)(k1 & 0xFFFFull));
      }
      if (lane == 0) state[tk] = 2;
    }
    if (lane == 0 && nov) atomicAdd(&nrem[6], nov);
  }
  __syncthreads();
  if (nrem[6] != 0) {
    for (int level = 2; level < 6; ++level) {
      run_level(level, false);
      if (nrem[level] == 0) break;
    }
    {
      const bool mine = ovf[mytok] != 0;
      const unsigned long long mytk = tkey[mytok];
      const unsigned long long myp16 = (unsigned long long)(unsigned)pf16[mytok];
      h8 na[2];
      if (wid < nkt) loadk(wid, na);
      for (int kt = wid; kt < nkt; kt += 4) {
        h8 ca[2];
#pragma unroll
        for (int i = 0; i < 2; ++i) ca[i] = na[i];
        loadk(kt + 4 < nkt ? kt + 4 : kt, na);
        float sc[8];
        scores(ca, sc);
        if (mine) {
#pragma unroll
          for (int q = 0; q < 8; ++q) {
            const int key = kt * 32 + (q >> 2) * 16 + 4 * hq + (q & 3);
            if (key <= myt) {
              const unsigned long long k48 = mkkey(sc[q], key);
              if ((k48 >> 32) == myp16 && k48 >= mytk) {
                const int pos = atomicAdd(&cnt[mytok], 1);
                if (pos < 256) sel[mytok * 256 + pos] = (unsigned short)key;
              }
            }
          }
        }
      }
    }
    __syncthreads();
  }
#ifndef DSA_ATT_REP
#define DSA_ATT_REP 1
#endif
  for (int jr = 0; jr < 4 * DSA_ATT_REP; ++jr) {
    const int j = jr & 3;
    const int tk = wid * 4 + j;
    const int t = t0 + tk;
    const int nsel = min(cnt[tk], 256);
    const half_t* urow = ub + (size_t)t * NU;
    const int col = lane & 15;
    h8 q0, q1;
#pragma unroll
    for (int e = 0; e < 8; ++e) { q0[e] = (half_t)0.f; q1[e] = (half_t)0.f; }
    if (col < 8) {
      q0 = *(const h8*)(urow + C_BQ + col * 64 + hq * 8);
      q1 = *(const h8*)(urow + C_BQ + col * 64 + 32 + hq * 8);
    }
    float mx = NEGF;
#pragma unroll 1
    for (int mg = 0; mg < 2; ++mg) {
#pragma unroll
      for (int mm = 0; mm < 8; ++mm) {
        const int m = mg * 8 + mm;
        const int pos = m * 16 + col;
        const int s = (pos < nsel) ? (int)sel[tk * 256 + pos] : 0;
        const half_t* kp = ub + (size_t)s * NU + C_BK + hq * 8;
        const h8 a0 = *(const h8*)kp, a1 = *(const h8*)(kp + 32);
        f32x4 d = {0.f, 0.f, 0.f, 0.f};
        d = __builtin_amdgcn_mfma_f32_16x16x32_f16(a0, q0, d, 0, 0, 0);
        d = __builtin_amdgcn_mfma_f32_16x16x32_f16(a1, q1, d, 0, 0, 0);
#pragma unroll
        for (int r = 0; r < 4; ++r) {
          const int pp = m * 16 + hq * 4 + r;
          const float v = (pp < nsel) ? d[r] * 0.125f : NEGF;
          mx = fmaxf(mx, v);
          if (col < 8) pbuf[pp * 8 + col] = v;
        }
      }
    }
    mx = fmaxf(mx, __shfl_xor(mx, 16));
    mx = fmaxf(mx, __shfl_xor(mx, 32));
    const float mxh = __shfl(mx, lane & 7);
    __builtin_amdgcn_wave_barrier();
    float sum = 0.f;
#pragma unroll 4
    for (int k = 0; k < 32; ++k) {
      const int i = lane + 64 * k;
      const float v = pbuf[i];
      const float e = (v > -1e29f) ? __expf(v - mxh) : 0.f;
      pbuf[i] = e;
      sum += e;
    }
    sum += __shfl_xor(sum, 8);
    sum += __shfl_xor(sum, 16);
    sum += __shfl_xor(sum, 32);
    const float inv = 1.f / sum;
    __builtin_amdgcn_wave_barrier();
    {
      const int rs = lane >> 3, dc = lane & 7;
      float acc[8][8];
#pragma unroll
      for (int h = 0; h < 8; ++h)
#pragma unroll
        for (int e = 0; e < 8; ++e) acc[h][e] = 0.f;
#pragma unroll 1
      for (int g8 = 0; g8 < 4; ++g8) {
        h8 vv[8];
#pragma unroll
        for (int i = 0; i < 8; ++i) {
          const int pos = (g8 * 8 + i) * 8 + rs;
          const int s = (pos < nsel) ? (int)sel[tk * 256 + pos] : 0;
          vv[i] = *(const h8*)(ub + (size_t)s * NU + C_BV + dc * 8);
        }
#pragma unroll
        for (int i = 0; i < 8; ++i) {
          const int pos = (g8 * 8 + i) * 8 + rs;
          const f32x4 pa = *(const f32x4*)&pbuf[pos * 8];
          const f32x4 pb = *(const f32x4*)&pbuf[pos * 8 + 4];
          float vf[8];
#pragma unroll
          for (int e = 0; e < 8; ++e) vf[e] = (float)vv[i][e];
#pragma unroll
          for (int e = 0; e < 8; ++e) {
            acc[0][e] += pa[0] * vf[e]; acc[1][e] += pa[1] * vf[e]; acc[2][e] += pa[2] * vf[e]; acc[3][e] += pa[3] * vf[e];
            acc[4][e] += pb[0] * vf[e]; acc[5][e] += pb[1] * vf[e]; acc[6][e] += pb[2] * vf[e]; acc[7][e] += pb[3] * vf[e];
          }
        }
      }
      half_t* yrow = p.yb() + (size_t)(b * SEQ + t) * 512;
#pragma unroll
      for (int h = 0; h < 8; ++h) {
        const float invh = __shfl(inv, h);
        h8 ov;
        const h8 z8 = *(const h8*)(urow + C_BZ + h * 64 + dc * 8);
#pragma unroll
        for (int e = 0; e < 8; ++e) {
          float a = acc[h][e];
          a += __shfl_xor(a, 8);
          a += __shfl_xor(a, 16);
          a += __shfl_xor(a, 32);
          ov[e] = (half_t)(a * invh * siluf_((float)z8[e]));
        }
        if (rs == h) *(h8*)(yrow + h * 64 + dc * 8) = ov;
      }
    }
    __builtin_amdgcn_wave_barrier();
  }
  __syncthreads();
}

__device__ __forceinline__ void phase2(const KP& p, int l, char* smem, int* q, int xcc) {
  xcd_schedule(q, xcc, 32, 1, smem, [&](int grp, int) __attribute__((always_inline)) { compress_item(p, l, grp, smem); });
  xcd_schedule(q + 8, xcc, 1024, 1, smem, [&](int grp, int) __attribute__((always_inline)) {
    const int y = grp & 7, k = grp >> 3;
    dsa_item(p, y & 1, 511 - (k * 4 + (y >> 1)), smem);
  });
  xcd_schedule(q + 16, xcc, 512, 1, smem, [&](int grp, int) __attribute__((always_inline)) { pool_item(p, l, grp, smem); });
}

struct DState {
  float m, l;
  f32x16 o[2];
};
#define MLOW (-1e4f)
__device__ __forceinline__ void ds_reset(DState& st) {
  st.m = MLOW; st.l = 0.f;
#pragma unroll
  for (int dt = 0; dt < 2; ++dt)
#pragma unroll
    for (int r = 0; r < 16; ++r) st.o[dt][r] = 0.f;
}
typedef unsigned int u32x4 __attribute__((ext_vector_type(4)));
typedef unsigned int u32x2 __attribute__((ext_vector_type(2)));
struct StageRegs {
  u32x4 k0, k1, v0, v1;
};
template <bool HASV>
__device__ __forceinline__ void load_stage(StageRegs& r, const half_t* __restrict__ Kb, int ldk,
                                           const half_t* __restrict__ VT, int ldv, int key0, int tid) {
  const int row = tid >> 3, c = tid & 7;
  r.k0 = *(const u32x4*)(Kb + (size_t)(key0 + row) * ldk + c * 8);
  r.k1 = *(const u32x4*)(Kb + (size_t)(key0 + row + 32) * ldk + c * 8);
  if (HASV) {
    r.v0 = *(const u32x4*)(VT + (size_t)row * ldv + key0 + c * 8);
    r.v1 = *(const u32x4*)(VT + (size_t)(row + 32) * ldv + key0 + c * 8);
  }
}
template <bool HASV>
__device__ __forceinline__ void write_stage(const StageRegs& r, half_t* Ks, half_t* Vs, int tid) {
  const int row = tid >> 3, c = tid & 7;
  *(u32x4*)&Ks[row * 72 + c * 8] = r.k0;
  *(u32x4*)&Ks[(row + 32) * 72 + c * 8] = r.k1;
  if (HASV) {
    const int ks = c >> 1, a = c & 1;
    u32x2 lo, hi;
    lo[0] = r.v0[0]; lo[1] = r.v0[1]; hi[0] = r.v0[2]; hi[1] = r.v0[3];
    *(u32x2*)&Vs[row * 72 + ks * 16 + a * 4] = lo;
    *(u32x2*)&Vs[row * 72 + ks * 16 + 8 + a * 4] = hi;
    lo[0] = r.v1[0]; lo[1] = r.v1[1]; hi[0] = r.v1[2]; hi[1] = r.v1[3];
    *(u32x2*)&Vs[(row + 32) * 72 + ks * 16 + a * 4] = lo;
    *(u32x2*)&Vs[(row + 32) * 72 + ks * 16 + 8 + a * 4] = hi;
  }
}
template <bool ONLINE, bool HASV, bool FAST, class VF>
__device__ __forceinline__ void dense_block(DState& st, const half_t* Ks, const half_t* Vs, const h8* qf, int key0,
                                            int flag, VF valid, float fixed_m, float fixed_invl, f32x16* pout,
                                            int lane) {
  const int h = lane >> 5, c = lane & 31;
  f32x16 s[2];
#pragma unroll
  for (int kt = 0; kt < 2; ++kt) {
#pragma unroll
    for (int r = 0; r < 16; ++r) s[kt][r] = 0.f;
#pragma unroll
    for (int ks = 0; ks < 4; ++ks) {
      const h8 a = *(const h8*)&Ks[(32 * kt + c) * 72 + 16 * ks + 8 * h];
      s[kt] = __builtin_amdgcn_mfma_f32_32x32x16_f16(a, qf[ks], s[kt], 0, 0, 0);
    }
  }
  float cm = NEGF;
#pragma unroll
  for (int kt = 0; kt < 2; ++kt)
#pragma unroll
    for (int r = 0; r < 16; ++r) {
      const int key = key0 + 32 * kt + (r & 3) + 8 * (r >> 2) + 4 * h;
      const float v = (FAST ? (flag != 0) : valid(key, flag)) ? s[kt][r] : NEGF;
      s[kt][r] = v;
      cm = fmaxf(cm, v);
    }
  float mnew;
  if (ONLINE) {
    cm = fmaxf(cm, __shfl_xor(cm, 32));
    mnew = st.m;
    if (__ballot(cm > st.m + 8.0f) != 0ull) {
      mnew = fmaxf(st.m, cm);
      const float alpha = __builtin_amdgcn_exp2f(st.m - mnew);
      st.m = mnew;
      st.l *= alpha;
      if (HASV) {
#pragma unroll
        for (int dt = 0; dt < 2; ++dt)
#pragma unroll
          for (int r = 0; r < 16; ++r) st.o[dt][r] *= alpha;
      }
    }
  } else {
    mnew = fixed_m;
  }
  float ps = 0.f;
#pragma unroll
  for (int kt = 0; kt < 2; ++kt)
#pragma unroll
    for (int r = 0; r < 16; ++r) {
      float e = __builtin_amdgcn_exp2f(s[kt][r] - mnew);
      if (!ONLINE) e *= fixed_invl;
      s[kt][r] = e;
      ps += e;
    }
  st.l += ps;
  if (pout) { pout[0] = s[0]; pout[1] = s[1]; }
  if (HASV) {
#pragma unroll
    for (int ks = 0; ks < 4; ++ks) {
      h8 pf;
#pragma unroll
      for (int jj = 0; jj < 8; ++jj) pf[jj] = (half_t)s[ks >> 1][8 * (ks & 1) + jj];
#pragma unroll
      for (int dt = 0; dt < 2; ++dt) {
        const h8 vf = *(const h8*)&Vs[(32 * dt + c) * 72 + 16 * ks + 8 * h];
        st.o[dt] = __builtin_amdgcn_mfma_f32_32x32x16_f16(vf, pf, st.o[dt], 0, 0, 0);
      }
    }
  }
}
template <bool ONLINE, bool HASV, bool WANTP, class PRE, class FU, class VF, class PO>
__device__ __forceinline__ void run_dense(DState& st, const half_t* __restrict__ Kb, int ldk,
                                          const half_t* __restrict__ VT, int ldv, int blk_lo, int blk_hi, const h8* qf,
                                          PRE pre, FU full, VF valid, float fixed_m, float fixed_invl, PO post, char* smem,
                                          int tid) {
  half_t* Ks = (half_t*)smem;
  half_t* Vs = Ks + 64 * 72;
  const int lane = tid & 63;
  StageRegs sr;
  load_stage<HASV>(sr, Kb, ldk, VT, ldv, blk_lo * 64, tid);
  for (int blk = blk_lo; blk <= blk_hi; ++blk) {
    __syncthreads();
    write_stage<HASV>(sr, Ks, Vs, tid);
    __syncthreads();
    const int nb = blk < blk_hi ? blk + 1 : blk;
    load_stage<HASV>(sr, Kb, ldk, VT, ldv, nb * 64, tid);
    const int flag = pre(blk);
    if (__ballot(flag != 0) != 0ull) {
      f32x16 pp[2];
      if (full(blk))
        dense_block<ONLINE, HASV, true>(st, Ks, Vs, qf, blk * 64, flag, valid, fixed_m, fixed_invl,
                                        WANTP ? pp : (f32x16*)nullptr, lane);
      else
        dense_block<ONLINE, HASV, false>(st, Ks, Vs, qf, blk * 64, flag, valid, fixed_m, fixed_invl,
                                         WANTP ? pp : (f32x16*)nullptr, lane);
      if (WANTP) post(blk * 64, pp);
    }
  }
}

__device__ __forceinline__ void nsa_item(const KP& p, int b, int g, int tile, char* smem) {
  int tid = threadIdx.x;
  asm volatile("" : "+v"(tid));
  const int lane = tid & 63, wid = tid >> 6;
  const int t0 = tile * 32;
  const int tw0 = t0 + 8 * wid;
  const int col = lane & 31, h = lane >> 5;
  const int j = col >> 2, r4 = col & 3;
  const int tj = tw0 + j;
  const int head = g * 4 + r4;
  float* impA = (float*)(smem + 18432 + wid * 8320);
  float* impB = impA + 1024;
  unsigned long long* msk = (unsigned long long*)(smem + 18432 + 4 * 8320 + wid * 128);
  const half_t* ub = p.u() + (size_t)b * SEQ * NU;
  const half_t* urow = ub + (size_t)tj * NU;
  h8 qf[4];
#pragma unroll
  for (int ks = 0; ks < 4; ++ks) {
    qf[ks] = *(const h8*)(urow + C_CQ + head * 64 + 16 * ks + 8 * h);
#pragma unroll
    for (int e = 0; e < 8; ++e) qf[ks][e] = (half_t)((float)qf[ks][e] * 0.18033688f);
  }
  float gate[3];
#pragma unroll
  for (int i = 0; i < 3; ++i) gate[i] = sigmoidf_((float)urow[C_CG + head * 3 + i]);
  f32x16 res[2];
#pragma unroll
  for (int dt = 0; dt < 2; ++dt)
#pragma unroll
    for (int r = 0; r < 16; ++r) res[dt][r] = 0.f;
  for (int i = lane; i < 2080; i += 64) impA[i] = 0.f;
  DState st;
  auto nopost = [&](int, f32x16*) __attribute__((always_inline)) {};

  {
    const int nmax_j = (tj >= 31) ? ((tj - 31) >> 4) : -1;
    const int bhi = (t0 >> 4) >> 6;
    const half_t* Kc = p.kcmp() + (size_t)(b * 2 + g) * 512 * 64;
    const half_t* Vc = p.vcmpT() + (size_t)(b * 2 + g) * 64 * 512;
    auto pre = [&](int) __attribute__((always_inline)) { return 1; };
    const int nmax_w = (tw0 >= 31) ? ((tw0 - 31) >> 4) : -1;
    auto fullc = [&](int blk) __attribute__((always_inline)) { return blk * 64 + 63 <= nmax_w; };
    auto vfn = [&](int n, int) __attribute__((always_inline)) { return n <= nmax_j; };
    ds_reset(st);
    run_dense<true, false, false>(st, Kc, 64, (const half_t*)nullptr, 0, 0, bhi, qf, pre, fullc, vfn, 0.f, 0.f, nopost, smem, tid);
    float lt = st.l;
    lt += __shfl_xor(lt, 32);
    const float mfix = st.m;
    const float invl = lt > 0.f ? 1.f / lt : 0.f;
    ds_reset(st);
    auto post = [&](int n0, f32x16* pp) __attribute__((always_inline)) {
#pragma unroll
      for (int kt = 0; kt < 2; ++kt)
#pragma unroll
        for (int qd = 0; qd < 4; ++qd) {
          float a = pp[kt][4 * qd] + pp[kt][4 * qd + 1] + pp[kt][4 * qd + 2] + pp[kt][4 * qd + 3];
          float bb = pp[kt][4 * qd + 3];
          a += __shfl_xor(a, 1); a += __shfl_xor(a, 2);
          bb += __shfl_xor(bb, 1); bb += __shfl_xor(bb, 2);
          if (r4 == 0) {
            const int sblk = (n0 >> 2) + 8 * kt + 2 * qd + h;
            impA[j * 128 + sblk] = a;
            impB[j * 132 + sblk + 1] = bb;
          }
        }
    };
    run_dense<false, true, true>(st, Kc, 64, Vc, 512, 0, bhi, qf, pre, fullc, vfn, mfix, invl, post, smem, tid);
#pragma unroll
    for (int dt = 0; dt < 2; ++dt)
#pragma unroll
      for (int r = 0; r < 16; ++r) res[dt][r] += gate[0] * st.o[dt][r];
  }
  __builtin_amdgcn_wave_barrier();
#pragma unroll 1
  for (int jj = 0; jj < 8; ++jj) {
    const int t = tw0 + jj;
    const int blk = t >> 6;
    uint32_t k0, k1;
    {
      const int s0 = lane, s1 = lane + 64;
      const float i0 = impA[jj * 128 + s0] + impB[jj * 132 + s0];
      const float i1 = impA[jj * 128 + s1] + impB[jj * 132 + s1];
      auto mk = [&](float im, int s) __attribute__((always_inline)) -> uint32_t {
        if (s > blk) return 0u;
        uint32_t kk = ((__float_as_uint(im) >> 1) & ~127u) | (uint32_t)(127 - s) | 0x40000000u;
        if (s == 0 || s == blk || s == blk - 1) kk |= 0x80000000u;
        return kk;
      };
      k0 = mk(i0, s0); k1 = mk(i1, s1);
    }
    unsigned long long lo = 0ull, hi = 0ull;
    for (int it = 0; it < 16; ++it) {
      uint32_t mxk = k0 > k1 ? k0 : k1;
#pragma unroll
      for (int o = 32; o > 0; o >>= 1) {
        const uint32_t ov = (uint32_t)__shfl_xor((int)mxk, o);
        mxk = ov > mxk ? ov : mxk;
      }
      mxk = (uint32_t)__builtin_amdgcn_readfirstlane((int)mxk);
      if (mxk == 0u) break;
      const int s = 127 - (int)(mxk & 127u);
      if (s < 64) lo |= 1ull << s; else hi |= 1ull << (s - 64);
      if (s == lane) k0 = 0u;
      if (s == lane + 64) k1 = 0u;
    }
    if (lane == 0) { msk[jj * 2] = lo; msk[jj * 2 + 1] = hi; }
  }
  __builtin_amdgcn_wave_barrier();
  const unsigned long long mylo = msk[j * 2], myhi = msk[j * 2 + 1];
  {
    const half_t* Ksel = ub + C_CKS + g * 64;
    const half_t* Vsel = p.vsT() + (size_t)(b * 2 + g) * 64 * SEQ;
    auto pre = [&](int blk) __attribute__((always_inline)) {
      const unsigned long long mm_ = (blk < 64) ? mylo : myhi;
      return (int)((mm_ >> (blk & 63)) & 1ull);
    };
    auto vfn = [&](int key, int flag) __attribute__((always_inline)) { return flag != 0 && key <= tj; };
    ds_reset(st);
    auto fulls = [&](int blk) __attribute__((always_inline)) { return blk * 64 + 63 <= tw0; };
    run_dense<true, true, false>(st, Ksel, NU, Vsel, SEQ, 0, (t0 + 31) >> 6, qf, pre, fulls, vfn, 0.f, 0.f, nopost, smem, tid);
    float lt = st.l;
    lt += __shfl_xor(lt, 32);
    const float sc = lt > 0.f ? gate[1] / lt : 0.f;
#pragma unroll
    for (int dt = 0; dt < 2; ++dt)
#pragma unroll
      for (int r = 0; r < 16; ++r) res[dt][r] += sc * st.o[dt][r];
  }
  {
    const half_t* Kw = ub + C_CKW + g * 64;
    const half_t* Vw = p.vwT() + (size_t)(b * 2 + g) * 64 * SEQ;
    auto pre = [&](int blk) __attribute__((always_inline)) {
      return (int)((blk * 64 <= tj) && (blk * 64 + 63 > tj - 512));
    };
    auto vfn = [&](int key, int) __attribute__((always_inline)) { return key <= tj && key > tj - 512; };
    ds_reset(st);
    auto fullw = [&](int blk) __attribute__((always_inline)) { return blk * 64 + 63 <= tw0 && blk * 64 > tw0 + 7 - 512; };
    run_dense<true, true, false>(st, Kw, NU, Vw, SEQ, max(0, t0 - 511) >> 6, (t0 + 31) >> 6, qf, pre, fullw, vfn, 0.f, 0.f,
                                 nopost, smem, tid);
    float lt = st.l;
    lt += __shfl_xor(lt, 32);
    const float sc = lt > 0.f ? gate[2] / lt : 0.f;
#pragma unroll
    for (int dt = 0; dt < 2; ++dt)
#pragma unroll
      for (int r = 0; r < 16; ++r) res[dt][r] += sc * st.o[dt][r];
  }
  half_t* yrow = p.yc() + (size_t)(b * SEQ + tj) * 512 + head * 64;
#pragma unroll
  for (int dt = 0; dt < 2; ++dt)
#pragma unroll
    for (int qd = 0; qd < 4; ++qd) {
      const int d = 32 * dt + 8 * qd + 4 * h;
      const h4 z = *(const h4*)(urow + C_CZ + head * 64 + d);
      h4 ov;
#pragma unroll
      for (int e = 0; e < 4; ++e) ov[e] = (half_t)(res[dt][4 * qd + e] * siluf_((float)z[e]));
      *(h4*)(yrow + d) = ov;
    }
  __syncthreads();
}

__device__ __forceinline__ void phase_nsa(const KP& p, char* smem, int* q, int xcc) {
  xcd_schedule(q, xcc, 1024, 1, smem, [&](int grp, int) __attribute__((always_inline)) {
    const int y = grp & 7, k = grp >> 3;
    const int b = y & 1, g = (y >> 1) & 1, tile = 255 - (k * 2 + (y >> 2));
    nsa_item(p, b, g, tile, smem);
  });
}

__device__ __forceinline__ void phase_merge(const KP& p, char* smem, int* q, int xcc) {
  xcd_schedule(q, xcc, 16, 64, smem, [&](int grp, int within) __attribute__((always_inline)) {
    const int mt = (grp & 15) * 8 + (within & 7), nt = (within >> 3);
    const int m0 = mt * 128, n0 = nt * 128;
    f32x16 tot[2][2];
#pragma unroll
    for (int i = 0; i < 2; ++i)
#pragma unroll
      for (int jn = 0; jn < 2; ++jn)
#pragma unroll
        for (int r = 0; r < 16; ++r) tot[i][jn][r] = 0.f;
#pragma unroll 1
    for (int br = 0; br < 3; ++br) {
      const half_t* A = (br == 0 ? p.ya() : (br == 1 ? p.yb() : p.yc())) + (size_t)m0 * 512;
      const half_t* B = p.wpT() + (size_t)br * DM * 512 + (size_t)n0 * 512;
      const half_t* G = p.u() + (size_t)m0 * NU + C_GM + br * 1024 + n0;
      gemm_tile<2>(
          512, [&](int r, int k) { return *(const uint4*)(A + (size_t)r * 512 + k); },
          [&](int r, int k) { return *(const uint4*)(B + (size_t)r * 512 + k); },
          [&](int mi, int ni, int r, int row, int col, float v) {
            const float gz = (float)G[(size_t)row * NU + col];
            tot[mi][ni][r] += sigmoidf_(gz) * v;
          },
          smem);
    }
    int tidx = threadIdx.x;
    asm volatile("" : "+v"(tidx));
    const int lane = tidx & 63, wid = tidx >> 6, wm = wid >> 1, wn = wid & 1;
#pragma unroll
    for (int mi = 0; mi < 2; ++mi)
#pragma unroll
      for (int ni = 0; ni < 2; ++ni)
#pragma unroll
        for (int r = 0; r < 16; ++r) {
          const int row = wm * 64 + mi * 32 + (r & 3) + 8 * (r >> 2) + 4 * (lane >> 5);
          const int col = wn * 64 + ni * 32 + (lane & 31);
          p.mm()[(size_t)(m0 + row) * DM + n0 + col] = (half_t)tot[mi][ni][r];
        }
  });
}

__device__ __forceinline__ void phase_outproj(const KP& p, char* smem, int* q, int xcc) {
  xcd_schedule(q, xcc, 16, 64, smem, [&](int grp, int within) __attribute__((always_inline)) {
    const int mt = (grp & 15) * 8 + (within & 7), nt = (within >> 3);
    const int m0 = mt * 128, n0 = nt * 128;
    const half_t* A = p.mm() + (size_t)m0 * DM;
    const half_t* B = p.woT() + (size_t)n0 * DM;
    gemm_tile<2>(
        DM, [&](int r, int k) { return *(const uint4*)(A + (size_t)r * DM + k); },
        [&](int r, int k) { return *(const uint4*)(B + (size_t)r * DM + k); },
        [&](int mi, int ni, int r, int row, int col, float v) {
          const size_t xi = (size_t)(m0 + row) * DM + n0 + col;
          ((float*)p.u())[xi] = ALPHA_F * p.xr()[xi] + v;
        },
        smem);
  });
}


#define XB_TMO      128
#define XB_XCNT(j)  (256  + 64 * (j))
#define XB_XSUB(j)  (1280 + 64 * (j))
#define XB_XGEN(j)  (2304 + 64 * (j))
#define XB_TOP      3328
#define XB_TOPGEN   3392
#define XCD_BAR_WORDS 3456
#define XB_SPIN_CAP (1u << 20)
#define LAS __attribute__((address_space(3)))
__device__ __forceinline__ unsigned xb_ld(unsigned* p)              { return __hip_atomic_load(p, __ATOMIC_RELAXED, __HIP_MEMORY_SCOPE_AGENT); }
__device__ __forceinline__ unsigned xb_add(unsigned* p, unsigned v) { return __hip_atomic_fetch_add(p, v, __ATOMIC_RELAXED, __HIP_MEMORY_SCOPE_AGENT); }
__device__ __forceinline__ unsigned xb_xcc_id() { return (unsigned)__builtin_amdgcn_s_getreg((3 << 11) | 20) & 0xFu; }
#define XB_SPIN(cond, bar) do { unsigned _sp = 0; while (cond) { __builtin_amdgcn_s_sleep(1); \
    if ((++_sp & 255u) == 0u) { if (xb_ld(&(bar)[XB_TMO])) break; if (_sp > XB_SPIN_CAP) { atomicAdd(&(bar)[XB_TMO], 1u); break; } } } } while (0)
struct XcdBarrier { unsigned* bar; unsigned x; volatile LAS unsigned* st; };
__device__ __forceinline__ XcdBarrier xcd_barrier_post(unsigned* bar, volatile LAS unsigned* st) {
  XcdBarrier b; b.bar = bar; b.x = xb_xcc_id(); b.st = st;
  if (threadIdx.x == 0) (void)xb_add(&bar[XB_XCNT(b.x)], 1u);
  return b;
}
__device__ __forceinline__ void xcd_barrier_complete(unsigned* bar, unsigned x, unsigned& nloc, unsigned& nx) {
  const unsigned G = gridDim.x * gridDim.y * gridDim.z;
  unsigned sum, cnt, mine, sp = 0u;
  for (;;) {
    sum = 0u; cnt = 0u; mine = 0u;
#pragma unroll
    for (unsigned j = 0; j < 16; ++j) { const unsigned c = xb_ld(&bar[XB_XCNT(j)]); sum += c; cnt += (c > 0u) ? 1u : 0u; mine = (j == x) ? c : mine; }
    if (sum == G) break;
    __builtin_amdgcn_s_sleep(1);
    if ((++sp & 255u) == 0u) { if (xb_ld(&bar[XB_TMO])) break; if (sp > XB_SPIN_CAP) { atomicAdd(&bar[XB_TMO], 1u); break; } }
  }
  nloc = mine > 0u ? mine : 1u; nx = cnt > 0u ? cnt : 1u;
}
__device__ __forceinline__ void xcd_barrier(const XcdBarrier& b) {
  asm volatile("s_waitcnt vmcnt(0)" ::: "memory");
  __syncthreads();
  if (threadIdx.x == 0) {
    unsigned* bar = b.bar;
    __builtin_amdgcn_s_waitcnt(0);
    unsigned nloc = b.st[0], nx = b.st[1];
    if (nloc == 0u) { xcd_barrier_complete(bar, b.x, nloc, nx); b.st[0] = nloc; b.st[1] = nx; }
    const unsigned old = xb_add(&bar[XB_XSUB(b.x)], 1u);
    const unsigned gen = old / nloc;
    if (old + 1u == (gen + 1u) * nloc) {
      __builtin_amdgcn_fence(__ATOMIC_RELEASE, "agent");
      asm volatile("s_waitcnt vmcnt(0)" ::: "memory");
      const unsigned og = xb_add(&bar[XB_TOP], 1u);
      const unsigned tg = og / nx;
      if (og + 1u == (tg + 1u) * nx) xb_add(&bar[XB_TOPGEN], 1u);
      else XB_SPIN(xb_ld(&bar[XB_TOPGEN]) == tg, bar);
      __builtin_amdgcn_fence(__ATOMIC_ACQUIRE, "agent");
      xb_add(&bar[XB_XGEN(b.x)], 1u);
      asm volatile("s_waitcnt vmcnt(0)" ::: "memory");
    } else {
      XB_SPIN(xb_ld(&bar[XB_XGEN(b.x)]) == gen, bar);
      __builtin_amdgcn_fence(__ATOMIC_ACQUIRE, "agent");
      asm volatile("s_waitcnt vmcnt(0)" ::: "memory");
    }
  }
  __syncthreads();
}

#define NQ_WORDS 4096
__global__ void __launch_bounds__(256, 2) fwd_megakernel(Params p_unused) {
  cg::grid_group grid = cg::this_grid();
  __shared__ __attribute__((aligned(16))) char smem[SMEM_BYTES];
  volatile LAS unsigned* st = (volatile LAS unsigned*)(smem + SMEM_BYTES - 32);
  if (threadIdx.x == 0) { st[0] = 0u; st[1] = 0u; }
  __syncthreads();
  if (gridDim.y == 4242u) grid.sync();
  XcdBarrier xb;
  {
    const KP p = get_params();
    xb = xcd_barrier_post((unsigned*)p.counters() + NQ_WORDS, st);
    ln_rows(p, -1, false);
    prep_weights(p, 0, smem);
  }
  xcd_barrier(xb);
  const int xcc = (int)(xb.x & 7u);
#ifndef REP1
#define REP1 1
#define REP2 1
#define REP3 1
#define REP4 1
#endif
#ifndef REP5
#define REP5 1
#define REP6 1
#define REP7 0
#endif
#pragma unroll 1
  for (int l = 0; l < DEPTH; ++l) {
#define QPTR(ph, rep) (p.counters() + ((l * 6 + (ph)) * 4 + (rep)) * 32)
    for (int rep = 0; rep < REP1; ++rep) { const KP p = get_params(); phase_inproj(p, l, smem, QPTR(0, rep), xcc); }
    xcd_barrier(xb);
    for (int rep = 0; rep < REP2; ++rep) { const KP p = get_params(); phase2(p, l, smem, QPTR(1, rep), xcc); }
    xcd_barrier(xb);
    for (int rep = 0; rep < REP3; ++rep) { const KP p = get_params(); phase_nsa(p, smem, QPTR(2, rep), xcc); }
    xcd_barrier(xb);
    for (int rep = 0; rep < REP4; ++rep) { const KP p = get_params(); phase_merge(p, smem, QPTR(3, rep), xcc); }
    xcd_barrier(xb);
    for (int rep = 0; rep < REP5; ++rep) { const KP p = get_params(); phase_outproj(p, smem, QPTR(4, rep), xcc); }
    xcd_barrier(xb);
    for (int rep = 0; rep < REP6; ++rep) {
      const KP p = get_params();
      if (l + 1 < DEPTH) {
        ln_rows(p, l, false);
        prep_weights(p, l + 1, smem);
      } else {
        ln_rows(p, l, true);
      }
    }
    if (l + 1 < DEPTH) xcd_barrier(xb);
    for (int rep = 0; rep < REP7; ++rep) xcd_barrier(xb);
  }
}

extern "C" void kernel_launch(void* const* d_in, const int* in_sizes, int n_in, void* d_out, int out_size,
                              void* d_ws, size_t ws_size, hipStream_t stream) {
  static int grid_blocks = 0;
  if (!grid_blocks) {
    int dev = 0, cus = 0, per_cu = 0;
    (void)hipGetDevice(&dev);
    (void)hipDeviceGetAttribute(&cus, hipDeviceAttributeMultiprocessorCount, dev);
    (void)hipOccupancyMaxActiveBlocksPerMultiprocessor(&per_cu, fwd_megakernel, 256, 0);
    if (per_cu > 2) per_cu = 2;
    if (per_cu < 1) per_cu = 1;
    grid_blocks = cus * per_cu;
  }
  Params p{};
  p.x = (const float*)d_in[0]; p.w_in = (const float*)d_in[1]; p.b_in = (const float*)d_in[2];
  p.pool_w = (const float*)d_in[3]; p.pool_b = (const float*)d_in[4]; p.pool_scale = (const float*)d_in[5];
  p.pos_k = (const float*)d_in[6]; p.pos_v = (const float*)d_in[7]; p.w1k = (const float*)d_in[8];
  p.w2k = (const float*)d_in[9]; p.w1v = (const float*)d_in[10]; p.w2v = (const float*)d_in[11];
  p.wpa = (const float*)d_in[12]; p.wpb = (const float*)d_in[13]; p.wpc = (const float*)d_in[14];
  p.wo = (const float*)d_in[15]; p.ln_g = (const float*)d_in[16]; p.ln_b = (const float*)d_in[17];
  p.out = (float*)d_out;
  p.ws = (char*)d_ws;
  if (WS_TOTAL > ws_size) { fprintf(stderr, "workspace too small: need %zu have %zu\n", (size_t)WS_TOTAL, ws_size); return; }
  (void)hipMemsetAsync((char*)d_ws + OFF_counters, 0, (size_t)(NQ_WORDS + XCD_BAR_WORDS) * 4, stream);
  void* args[] = {&p};
  hipError_t e = hipLaunchCooperativeKernel((void*)fwd_megakernel, dim3(grid_blocks), dim3(256), args, 0, stream);
  if (e != hipSuccess) fprintf(stderr, "cooperative launch failed: %s (grid %d)\n", hipGetErrorString(e), grid_blocks);
}
```

```cpp
#include <hip/hip_runtime.h>
#include <hip/hip_cooperative_groups.h>
#include <cstdio>
#include <cstdint>
namespace cg = cooperative_groups;

typedef _Float16 half_t;
typedef _Float16 h8 __attribute__((ext_vector_type(8)));
typedef _Float16 h4 __attribute__((ext_vector_type(4)));
typedef float f32x4 __attribute__((ext_vector_type(4)));
typedef float f32x16 __attribute__((ext_vector_type(16)));

#define SEQ 8192
#define DM 1024
#define NTOK 16384
#define DEPTH 4
#define NIN 7360
#define NU 7424
#define ALPHA_F 1.681792830507429f
#define NEGF (-1e30f)

#define C_AX 0
#define C_AZ 512
#define C_BQ 1024
#define C_BZ 1536
#define C_CQ 2048
#define C_CZ 2560
#define C_GM 3072
#define C_IQ 6144
#define C_CKC 6400
#define C_CVC 6528
#define C_CKS 6656
#define C_CVS 6784
#define C_CKW 6912
#define C_CVW 7040
#define C_BK 7168
#define C_BV 7232
#define C_IK 7296
#define C_IW 7328
#define C_CG 7336

#define SMEM_BYTES 73728

constexpr size_t OFF_xr = 0;
constexpr size_t OFF_xh = OFF_xr + (((size_t)NTOK*DM*4 + 255) & ~(size_t)255);
constexpr size_t OFF_u = OFF_xh + (((size_t)NTOK*DM*2 + 255) & ~(size_t)255);
constexpr size_t OFF_winT = OFF_u + (((size_t)NTOK*NU*2 + 255) & ~(size_t)255);
constexpr size_t OFF_wpT = OFF_winT + (((size_t)NU*DM*2 + 255) & ~(size_t)255);
constexpr size_t OFF_woT = OFF_wpT + (((size_t)3*DM*512*2 + 255) & ~(size_t)255);
constexpr size_t OFF_poolT = OFF_woT + (((size_t)DM*DM*2 + 255) & ~(size_t)255);
constexpr size_t OFF_w1T = OFF_poolT + (((size_t)4*128*128*2 + 255) & ~(size_t)255);
constexpr size_t OFF_posb = OFF_w1T + (((size_t)2*64*2048*2 + 255) & ~(size_t)255);
constexpr size_t OFF_vsT = OFF_posb + (((size_t)512 + 255) & ~(size_t)255);
constexpr size_t OFF_vwT = OFF_vsT + (((size_t)4*64*SEQ*2 + 255) & ~(size_t)255);
constexpr size_t OFF_kcmp = OFF_vwT + (((size_t)4*64*SEQ*2 + 255) & ~(size_t)255);
constexpr size_t OFF_vcmpT = OFF_kcmp + (((size_t)4*512*64*2 + 255) & ~(size_t)255);
constexpr size_t OFF_ya = OFF_vcmpT + (((size_t)4*64*512*2 + 255) & ~(size_t)255);
constexpr size_t OFF_yb = OFF_ya + (((size_t)NTOK*512*2 + 255) & ~(size_t)255);
constexpr size_t OFF_yc = OFF_yb + (((size_t)NTOK*512*2 + 255) & ~(size_t)255);
constexpr size_t OFF_mm = OFF_yc + (((size_t)NTOK*512*2 + 255) & ~(size_t)255);
constexpr size_t OFF_counters = OFF_mm + (((size_t)NTOK*DM*2 + 255) & ~(size_t)255);
constexpr size_t WS_TOTAL = OFF_counters + (((size_t)32768 + 255) & ~(size_t)255);
struct Params {
  const float* x; const float* w_in; const float* b_in; const float* pool_w; const float* pool_b;
  const float* pool_scale; const float* pos_k; const float* pos_v; const float* w1k; const float* w2k;
  const float* w1v; const float* w2v; const float* wpa; const float* wpb; const float* wpc;
  const float* wo; const float* ln_g; const float* ln_b;
  float* out;
  char* ws;
};
typedef const __attribute__((address_space(4))) unsigned long long* kargp_t;
struct KP {
  kargp_t kp;
  __device__ __forceinline__ const float* x() const { return (const float*)(const __attribute__((address_space(1))) float*)kp[0]; }
  __device__ __forceinline__ const float* w_in() const { return (const float*)(const __attribute__((address_space(1))) float*)kp[1]; }
  __device__ __forceinline__ const float* b_in() const { return (const float*)(const __attribute__((address_space(1))) float*)kp[2]; }
  __device__ __forceinline__ const float* pool_w() const { return (const float*)(const __attribute__((address_space(1))) float*)kp[3]; }
  __device__ __forceinline__ const float* pool_b() const { return (const float*)(const __attribute__((address_space(1))) float*)kp[4]; }
  __device__ __forceinline__ const float* pool_scale() const { return (const float*)(const __attribute__((address_space(1))) float*)kp[5]; }
  __device__ __forceinline__ const float* pos_k() const { return (const float*)(const __attribute__((address_space(1))) float*)kp[6]; }
  __device__ __forceinline__ const float* pos_v() const { return (const float*)(const __attribute__((address_space(1))) float*)kp[7]; }
  __device__ __forceinline__ const float* w1k() const { return (const float*)(const __attribute__((address_space(1))) float*)kp[8]; }
  __device__ __forceinline__ const float* w2k() const { return (const float*)(const __attribute__((address_space(1))) float*)kp[9]; }
  __device__ __forceinline__ const float* w1v() const { return (const float*)(const __attribute__((address_space(1))) float*)kp[10]; }
  __device__ __forceinline__ const float* w2v() const { return (const float*)(const __attribute__((address_space(1))) float*)kp[11]; }
  __device__ __forceinline__ const float* wpa() const { return (const float*)(const __attribute__((address_space(1))) float*)kp[12]; }
  __device__ __forceinline__ const float* wpb() const { return (const float*)(const __attribute__((address_space(1))) float*)kp[13]; }
  __device__ __forceinline__ const float* wpc() const { return (const float*)(const __attribute__((address_space(1))) float*)kp[14]; }
  __device__ __forceinline__ const float* wo() const { return (const float*)(const __attribute__((address_space(1))) float*)kp[15]; }
  __device__ __forceinline__ const float* ln_g() const { return (const float*)(const __attribute__((address_space(1))) float*)kp[16]; }
  __device__ __forceinline__ const float* ln_b() const { return (const float*)(const __attribute__((address_space(1))) float*)kp[17]; }
  __device__ __forceinline__ float* out() const { return (float*)(__attribute__((address_space(1))) float*)kp[18]; }
  __device__ __forceinline__ char* ws() const { return (char*)(__attribute__((address_space(1))) char*)kp[19]; }
  __device__ __forceinline__ float* xr() const { return (float*)(ws() + OFF_xr); }
  __device__ __forceinline__ half_t* xh() const { return (half_t*)(ws() + OFF_xh); }
  __device__ __forceinline__ half_t* u() const { return (half_t*)(ws() + OFF_u); }
  __device__ __forceinline__ half_t* winT() const { return (half_t*)(ws() + OFF_winT); }
  __device__ __forceinline__ half_t* wpT() const { return (half_t*)(ws() + OFF_wpT); }
  __device__ __forceinline__ half_t* woT() const { return (half_t*)(ws() + OFF_woT); }
  __device__ __forceinline__ half_t* poolT() const { return (half_t*)(ws() + OFF_poolT); }
  __device__ __forceinline__ half_t* w1T() const { return (half_t*)(ws() + OFF_w1T); }
  __device__ __forceinline__ float* posb() const { return (float*)(ws() + OFF_posb); }
  __device__ __forceinline__ half_t* vsT() const { return (half_t*)(ws() + OFF_vsT); }
  __device__ __forceinline__ half_t* vwT() const { return (half_t*)(ws() + OFF_vwT); }
  __device__ __forceinline__ half_t* kcmp() const { return (half_t*)(ws() + OFF_kcmp); }
  __device__ __forceinline__ half_t* vcmpT() const { return (half_t*)(ws() + OFF_vcmpT); }
  __device__ __forceinline__ half_t* ya() const { return (half_t*)(ws() + OFF_ya); }
  __device__ __forceinline__ half_t* yb() const { return (half_t*)(ws() + OFF_yb); }
  __device__ __forceinline__ half_t* yc() const { return (half_t*)(ws() + OFF_yc); }
  __device__ __forceinline__ half_t* mm() const { return (half_t*)(ws() + OFF_mm); }
  __device__ __forceinline__ int* counters() const { return (int*)(ws() + OFF_counters); }
};
__device__ __forceinline__ KP get_params() {
  KP q;
  q.kp = (kargp_t)__builtin_amdgcn_kernarg_segment_ptr();
  asm volatile("" : "+s"(q.kp));
  return q;
}


__device__ __forceinline__ int orig_col(int n) {
  if (n < 1536) return n;
  if (n < 2048) return 1664 + (n - 1536);
  if (n < 2560) return 2472 + (n - 2048);
  if (n < 3072) return 3776 + (n - 2560);
  if (n < 6144) return 4288 + (n - 3072);
  if (n < 6400) return 2176 + (n - 6144);
  if (n < 7168) return 2984 + (n - 6400);
  if (n < 7296) return 1536 + (n - 7168);
  if (n < 7328) return 2432 + (n - 7296);
  if (n < 7336) return 2464 + (n - 7328);
  if (n < 7360) return 3752 + (n - 7336);
  return -1;
}

__device__ __forceinline__ float wave_sum(float v) {
#pragma unroll
  for (int o = 32; o > 0; o >>= 1) v += __shfl_xor(v, o);
  return v;
}
__device__ __forceinline__ float sigmoidf_(float x) { return 1.f / (1.f + __expf(-x)); }
__device__ __forceinline__ float siluf_(float x) { return x / (1.f + __expf(-x)); }

template <int NI, class LA, class LB, class EP>
__device__ __forceinline__ void gemm_tile(int K, LA loadA, LB loadB, EP epi, char* smem) {
  constexpr int BN = NI * 64;
  constexpr int NB = BN / 32;
  half_t* sA = (half_t*)smem;
  half_t* sB = sA + 128 * 72;
  int tid = threadIdx.x;
  asm volatile("" : "+v"(tid));
  const int lane = tid & 63, wid = tid >> 6;
  const int wm = wid >> 1, wn = wid & 1;
  f32x16 acc[2][NI];
#pragma unroll
  for (int i = 0; i < 2; ++i)
#pragma unroll
    for (int j = 0; j < NI; ++j)
#pragma unroll
      for (int r = 0; r < 16; ++r) acc[i][j][r] = 0.f;
  const int lr = tid >> 3, lc = (tid & 7) * 8;
  uint4 ra[4], rb[NB];
#pragma unroll
  for (int i = 0; i < 4; ++i) ra[i] = loadA(lr + 32 * i, lc);
#pragma unroll
  for (int i = 0; i < NB; ++i) rb[i] = loadB(lr + 32 * i, lc);
  const int nk = K >> 6;
  for (int kt = 0; kt < nk; ++kt) {
    __syncthreads();
#pragma unroll
    for (int i = 0; i < 4; ++i) *(uint4*)&sA[(lr + 32 * i) * 72 + lc] = ra[i];
#pragma unroll
    for (int i = 0; i < NB; ++i) *(uint4*)&sB[(lr + 32 * i) * 72 + lc] = rb[i];
    __syncthreads();
    if (kt + 1 < nk) {
      const int kk = (kt + 1) * 64 + lc;
#pragma unroll
      for (int i = 0; i < 4; ++i) ra[i] = loadA(lr + 32 * i, kk);
#pragma unroll
      for (int i = 0; i < NB; ++i) rb[i] = loadB(lr + 32 * i, kk);
    }
#pragma unroll
    for (int s = 0; s < 4; ++s) {
      h8 af[2], bf[NI];
#pragma unroll
      for (int mi = 0; mi < 2; ++mi)
        af[mi] = *(const h8*)&sA[(wm * 64 + mi * 32 + (lane & 31)) * 72 + s * 16 + (lane >> 5) * 8];
#pragma unroll
      for (int ni = 0; ni < NI; ++ni)
        bf[ni] = *(const h8*)&sB[(wn * (NI * 32) + ni * 32 + (lane & 31)) * 72 + s * 16 + (lane >> 5) * 8];
#pragma unroll
      for (int mi = 0; mi < 2; ++mi)
#pragma unroll
        for (int ni = 0; ni < NI; ++ni)
          acc[mi][ni] = __builtin_amdgcn_mfma_f32_32x32x16_f16(af[mi], bf[ni], acc[mi][ni], 0, 0, 0);
    }
  }
#pragma unroll
  for (int mi = 0; mi < 2; ++mi)
#pragma unroll
    for (int ni = 0; ni < NI; ++ni)
#pragma unroll
      for (int r = 0; r < 16; ++r) {
        const int row = wm * 64 + mi * 32 + (r & 3) + 8 * (r >> 2) + 4 * (lane >> 5);
        const int col = wn * (NI * 32) + ni * 32 + (lane & 31);
        epi(mi, ni, r, row, col, acc[mi][ni][r]);
      }
}

template <class LA, class LB, class EP>
__device__ __forceinline__ void gemm_tile_big(int K, LA loadA, LB loadB, EP epi, char* smem) {
  half_t* sA = (half_t*)smem;
  half_t* sB = sA + 256 * 72;
  int tid = threadIdx.x;
  asm volatile("" : "+v"(tid));
  const int lane = tid & 63, wid = tid >> 6;
  const int wm = wid >> 1, wn = wid & 1;
  f32x16 acc[4][2];
#pragma unroll
  for (int i = 0; i < 4; ++i)
#pragma unroll
    for (int j = 0; j < 2; ++j)
#pragma unroll
      for (int r = 0; r < 16; ++r) acc[i][j][r] = 0.f;
  const int lr = tid >> 3, lc = (tid & 7) * 8;
  uint4 ra[8], rb[4];
#pragma unroll
  for (int i = 0; i < 8; ++i) ra[i] = loadA(lr + 32 * i, lc);
#pragma unroll
  for (int i = 0; i < 4; ++i) rb[i] = loadB(lr + 32 * i, lc);
  const int nk = K >> 6;
  for (int kt = 0; kt < nk; ++kt) {
    __syncthreads();
#pragma unroll
    for (int i = 0; i < 8; ++i) *(uint4*)&sA[(lr + 32 * i) * 72 + lc] = ra[i];
#pragma unroll
    for (int i = 0; i < 4; ++i) *(uint4*)&sB[(lr + 32 * i) * 72 + lc] = rb[i];
    __syncthreads();
    if (kt + 1 < nk) {
      const int kk = (kt + 1) * 64 + lc;
#pragma unroll
      for (int i = 0; i < 8; ++i) ra[i] = loadA(lr + 32 * i, kk);
#pragma unroll
      for (int i = 0; i < 4; ++i) rb[i] = loadB(lr + 32 * i, kk);
    }
#pragma unroll
    for (int s = 0; s < 4; ++s) {
      h8 af[4], bf[2];
#pragma unroll
      for (int mi = 0; mi < 4; ++mi)
        af[mi] = *(const h8*)&sA[(wm * 128 + mi * 32 + (lane & 31)) * 72 + s * 16 + (lane >> 5) * 8];
#pragma unroll
      for (int ni = 0; ni < 2; ++ni)
        bf[ni] = *(const h8*)&sB[(wn * 64 + ni * 32 + (lane & 31)) * 72 + s * 16 + (lane >> 5) * 8];
#pragma unroll
      for (int mi = 0; mi < 4; ++mi)
#pragma unroll
        for (int ni = 0; ni < 2; ++ni)
          acc[mi][ni] = __builtin_amdgcn_mfma_f32_32x32x16_f16(af[mi], bf[ni], acc[mi][ni], 0, 0, 0);
    }
  }
#pragma unroll
  for (int mi = 0; mi < 4; ++mi)
#pragma unroll
    for (int ni = 0; ni < 2; ++ni)
#pragma unroll
      for (int r = 0; r < 16; ++r) {
        const int row = wm * 128 + mi * 32 + (r & 3) + 8 * (r >> 2) + 4 * (lane >> 5);
        const int col = wn * 64 + ni * 32 + (lane & 31);
        epi(mi, ni, r, row, col, acc[mi][ni][r]);
      }
}

template <class CM>
__device__ __forceinline__ void tconv_tile(const float* __restrict__ src, int lds_, half_t* __restrict__ dst, int ldd,
                                           int n0, int k0, CM cmap, char* smem) {
  float* t = (float*)smem;
  int tid = threadIdx.x;
  asm volatile("" : "+v"(tid));
  {
    const int n = tid & 63;
    const int c = cmap(n0 + n);
    float tv[16];
#pragma unroll
    for (int i = 0; i < 16; ++i) {
      const int k = (tid >> 6) + 4 * i;
      tv[i] = (c >= 0) ? src[(size_t)(k0 + k) * lds_ + c] : 0.f;
    }
#pragma unroll
    for (int i = 0; i < 16; ++i) {
      const int k = (tid >> 6) + 4 * i;
      t[k * 65 + n] = tv[i];
    }
  }
  __syncthreads();
#pragma unroll
  for (int i = 0; i < 2; ++i) {
    const int idx = tid + 256 * i;
    const int n = idx >> 3, kc = (idx & 7) * 8;
    h8 v;
#pragma unroll
    for (int j = 0; j < 8; ++j) v[j] = (half_t)t[(kc + j) * 65 + n];
    *(h8*)&dst[(size_t)(n0 + n) * ldd + k0 + kc] = v;
  }
  __syncthreads();
}

__device__ __forceinline__ void ln_rows(const KP& p, int lprev, bool final_) {
  int tid = threadIdx.x;
  asm volatile("" : "+v"(tid));
  const int lane = tid & 63, wid = tid >> 6;
  const int gw = blockIdx.x * 4 + wid, nw = gridDim.x * 4;
  for (int row = gw; row < NTOK; row += nw) {
    const float4* rp = (const float4*)((lprev < 0 ? p.x() : (const float*)p.u()) + (size_t)row * DM);
    float4 v[4];
    float s = 0.f;
#pragma unroll
    for (int i = 0; i < 4; ++i) {
      v[i] = rp[lane + 64 * i];
      s += v[i].x + v[i].y + v[i].z + v[i].w;
    }
    if (lprev >= 0) {
      float mu = wave_sum(s) * (1.f / DM);
      float q = 0.f;
#pragma unroll
      for (int i = 0; i < 4; ++i) {
        float a = v[i].x - mu, b = v[i].y - mu, c = v[i].z - mu, d = v[i].w - mu;
        q += a * a + b * b + c * c + d * d;
      }
      float rstd = rsqrtf(wave_sum(q) * (1.f / DM) + 1e-5f);
      const float4* g4 = (const float4*)(p.ln_g() + lprev * DM);
      const float4* b4 = (const float4*)(p.ln_b() + lprev * DM);
#pragma unroll
      for (int i = 0; i < 4; ++i) {
        float4 g = g4[lane + 64 * i], bb = b4[lane + 64 * i];
        v[i].x = (v[i].x - mu) * rstd * g.x + bb.x;
        v[i].y = (v[i].y - mu) * rstd * g.y + bb.y;
        v[i].z = (v[i].z - mu) * rstd * g.z + bb.z;
        v[i].w = (v[i].w - mu) * rstd * g.w + bb.w;
      }
    }
    if (final_) {
      float4* op = (float4*)(p.out() + (size_t)row * DM);
#pragma unroll
      for (int i = 0; i < 4; ++i) op[lane + 64 * i] = v[i];
    } else {
      float4* op = (float4*)(p.xr() + (size_t)row * DM);
      h4* hp = (h4*)(p.xh() + (size_t)row * DM);
#pragma unroll
      for (int i = 0; i < 4; ++i) {
        op[lane + 64 * i] = v[i];
        h4 hv;
        hv[0] = (half_t)v[i].x; hv[1] = (half_t)v[i].y; hv[2] = (half_t)v[i].z; hv[3] = (half_t)v[i].w;
        hp[lane + 64 * i] = hv;
      }
    }
  }
}

__device__ __forceinline__ void prep_weights(const KP& p, int l, char* smem) {
  int tid = threadIdx.x;
  asm volatile("" : "+v"(tid));
  const int total = 1856 + 384 + 256 + 16 + 64 + 2;
  for (int it = blockIdx.x; it < total; it += gridDim.x) {
    if (it < 1856) {
      const int nt = it >> 4, kt = it & 15;
      tconv_tile(p.w_in() + (size_t)l * DM * NIN, NIN, p.winT(), DM, nt * 64, kt * 64,
                 [](int n) { return orig_col(n); }, smem);
    } else if (it < 1856 + 384) {
      const int j = it - 1856;
      const int w = j >> 7, r = j & 127, nt = r >> 3, kt = r & 7;
      const float* src = (w == 0 ? p.wpa() : (w == 1 ? p.wpb() : p.wpc())) + (size_t)l * 512 * DM;
      tconv_tile(src, DM, p.wpT() + (size_t)w * DM * 512, 512, nt * 64, kt * 64, [](int n) { return n; }, smem);
    } else if (it < 1856 + 384 + 256) {
      const int j = it - 1856 - 384;
      const int nt = j >> 4, kt = j & 15;
      tconv_tile(p.wo() + (size_t)l * DM * DM, DM, p.woT(), DM, nt * 64, kt * 64, [](int n) { return n; }, smem);
    } else if (it < 1856 + 384 + 256 + 16) {
      const int j = it - 1856 - 384 - 256;
      const int g = j >> 2, nt = (j >> 1) & 1, kt = j & 1;
      tconv_tile(p.pool_w() + ((size_t)l * 4 + g) * 128 * 128, 128, p.poolT() + (size_t)g * 128 * 128, 128, nt * 64,
                 kt * 64, [](int n) { return n; }, smem);
    } else if (it < 1856 + 384 + 256 + 16 + 64) {
      const int j = it - 1856 - 384 - 256 - 16;
      const int kv = j >> 5, kt = j & 31;
      const float* src = (kv ? p.w1v() : p.w1k()) + (size_t)l * 2048 * 64;
      tconv_tile(src, 64, p.w1T() + (size_t)kv * 64 * 2048, 2048, 0, kt * 64, [](int n) { return n; }, smem);
    } else {
      const int kv = it - (1856 + 384 + 256 + 16 + 64);
      const float* w1 = (kv ? p.w1v() : p.w1k()) + (size_t)l * 2048 * 64;
      const float* pos = (kv ? p.pos_v() : p.pos_k()) + (size_t)l * 2048;
      float* red = (float*)smem;
      const int e = tid & 63, part = tid >> 6;
      float sa = 0.f, sb = 0.f, sc_ = 0.f, sd = 0.f;
      const float* wq = w1 + (size_t)part * 512 * 64 + e;
      const float* pq = pos + part * 512;
#pragma unroll 4
      for (int f = 0; f < 512; f += 4) {
        sa += pq[f] * wq[(size_t)f * 64];
        sb += pq[f + 1] * wq[(size_t)(f + 1) * 64];
        sc_ += pq[f + 2] * wq[(size_t)(f + 2) * 64];
        sd += pq[f + 3] * wq[(size_t)(f + 3) * 64];
      }
      const float s = (sa + sb) + (sc_ + sd);
      red[tid] = s;
      __syncthreads();
      if (tid < 64) p.posb()[kv * 64 + tid] = red[tid] + red[tid + 64] + red[tid + 128] + red[tid + 192];
      __syncthreads();
    }
  }
}

template <class F>
__device__ __forceinline__ void xcd_schedule(int* q, int xcc, int ngroups, int gsize, char* smem, F f) {
  int* s_item = (int*)(smem + SMEM_BYTES - 16);
  int* s_flag = (int*)(smem + SMEM_BYTES - 96);
  int* flags = q + 32;
#pragma unroll 1
  for (int dy = 0; dy < 8; ++dy) {
    const int y = (xcc + dy) & 7;
    if (dy == 1) {
      int t8 = threadIdx.x;
      asm volatile("" : "+v"(t8));
      if (t8 < 8) s_flag[t8] = __hip_atomic_load(&flags[t8], __ATOMIC_RELAXED, __HIP_MEMORY_SCOPE_AGENT);
      __syncthreads();
    }
    if (dy >= 1 && __builtin_amdgcn_readfirstlane(s_flag[y]) != 0) continue;
    for (;;) {
      if (threadIdx.x == 0) *s_item = atomicAdd(&q[y], 1);
      __syncthreads();
      const int i = __builtin_amdgcn_readfirstlane(*s_item);
      __syncthreads();
      const int grp = (i / gsize) * 8 + y;
      if (grp >= ngroups) {
        if (threadIdx.x == 0) __hip_atomic_store(&flags[y], 1, __ATOMIC_RELAXED, __HIP_MEMORY_SCOPE_AGENT);
        break;
      }
      f(grp, i % gsize);
    }
  }
}

__device__ __forceinline__ void phase_inproj(const KP& p, int l, char* smem, int* q, int xcc) {
  const float* bias = p.b_in() + (size_t)l * NIN;
  xcd_schedule(q, xcc, 128, 32, smem, [&](int grp, int within) __attribute__((always_inline)) {
    const int mt = (grp & 15) * 4 + (within & 3), nt = (grp >> 4) * 8 + (within >> 2);
    if (nt >= 58) return;
    const int m0 = mt * 256, n0 = nt * 128;
    const half_t* A = p.xh() + (size_t)m0 * DM;
    const half_t* B = p.winT() + (size_t)n0 * DM;
    int tidx = threadIdx.x;
    asm volatile("" : "+v"(tidx));
    const int lane = tidx & 63, wn = (tidx >> 6) & 1;
    float bv[2];
#pragma unroll
    for (int ni = 0; ni < 2; ++ni) {
      const int oc = orig_col(n0 + wn * 64 + ni * 32 + (lane & 31));
      bv[ni] = oc >= 0 ? bias[oc] : 0.f;
    }
    half_t* vT = (nt == 53) ? p.vsT() : ((nt == 55) ? p.vwT() : nullptr);
    gemm_tile_big(
        DM, [&](int r, int k) { return *(const uint4*)(A + (size_t)r * DM + k); },
        [&](int r, int k) { return *(const uint4*)(B + (size_t)r * DM + k); },
        [&](int mi, int ni, int r, int row, int col, float v) {
          const half_t hv = (half_t)(v + bv[ni]);
          const int tok = m0 + row;
          p.u()[(size_t)tok * NU + n0 + col] = hv;
          if (vT) {
            const int b = tok >> 13, t = tok & 8191;
            vT[((size_t)(b * 2 + (col >> 6)) * 64 + (col & 63)) * SEQ + t] = hv;
          }
        },
        smem);
  });
}

__device__ __forceinline__ void pool_item(const KP& p, int l, int item, char* smem) {
  const int g = item & 3, mt = item >> 2;
  const int m0 = mt * 128;
  const int wnd = 2 << g;
  const half_t* B = p.poolT() + (size_t)g * 128 * 128;
  int tidx = threadIdx.x;
  asm volatile("" : "+v"(tidx));
  const int lane = tidx & 63, wn = (tidx >> 6) & 1;
  float pb[2], ps[2];
#pragma unroll
  for (int ni = 0; ni < 2; ++ni) {
    const int d = wn * 64 + ni * 32 + (lane & 31);
    pb[ni] = p.pool_b()[(size_t)l * 512 + g * 128 + d];
    ps[ni] = p.pool_scale()[(size_t)l * 512 + g * 128 + d];
  }
  gemm_tile<2>(
      128,
      [&](int r, int k) {
        const int tok = m0 + r, t = tok & 8191;
        const int cnt = min(t + 1, wnd);
        const half_t* base = p.u() + (size_t)tok * NU + C_AX + g * 128 + k;
        float s[8];
#pragma unroll
        for (int j = 0; j < 8; ++j) s[j] = 0.f;
        h8 cur = *(const h8*)base;
        for (int q0 = 0; q0 < wnd; q0 += 8) {
          h8 v[8];
#pragma unroll
          for (int i = 0; i < 8; ++i) {
            const int qq = q0 + i;
            if (qq < cnt) v[i] = *(const h8*)(base - (size_t)qq * NU);
            else {
#pragma unroll
              for (int j = 0; j < 8; ++j) v[i][j] = (half_t)0.f;
            }
          }
#pragma unroll
          for (int i = 0; i < 8; ++i)
#pragma unroll
            for (int j = 0; j < 8; ++j) s[j] += (float)v[i][j];
        }
        const float inv = 1.f / (float)cnt;
        h8 o;
#pragma unroll
        for (int j = 0; j < 8; ++j) o[j] = (half_t)(s[j] * inv - (float)cur[j]);
        return *(uint4*)&o;
      },
      [&](int r, int k) { return *(const uint4*)(B + (size_t)r * 128 + k); },
      [&](int mi, int ni, int r, int row, int col, float v) {
        const int tok = m0 + row;
        const float z = (float)p.u()[(size_t)tok * NU + C_AZ + g * 128 + col];
        p.ya()[(size_t)tok * 512 + g * 128 + col] = (half_t)((v + pb[ni]) * ps[ni] * siluf_(z));
      },
      smem);
}

__device__ __forceinline__ void compress_item(const KP& p, int l, int item, char* smem) {
  const int mt = item & 3, kv = (item >> 2) & 1, g = (item >> 3) & 1, b = item >> 4;
  int tid = threadIdx.x;
  asm volatile("" : "+v"(tid));
  const int ccol = (kv ? C_CVC : C_CKC) + g * 64;
  const half_t* ub = p.u() + (size_t)b * SEQ * NU + ccol;
  const half_t* B = p.w1T() + (size_t)kv * 64 * 2048;
  float* hid = (float*)(smem + 28672);
  const float* posb = p.posb() + kv * 64;
  gemm_tile<1>(
      2048,
      [&](int r, int k) {
        const int n = mt * 128 + r;
        if (n >= 511) return make_uint4(0, 0, 0, 0);
        const int tok = 16 * n + (k >> 6);
        return *(const uint4*)(ub + (size_t)tok * NU + (k & 63));
      },
      [&](int r, int k) { return *(const uint4*)(B + (size_t)r * 2048 + k); },
      [&](int mi, int ni, int r, int row, int col, float v) { hid[row * 65 + col] = siluf_(v + posb[col]); }, smem);
  __syncthreads();
  float* w2s = (float*)smem;
  const float* w2 = (kv ? p.w2v() : p.w2k()) + (size_t)l * 4096;
  for (int i = tid; i < 4096; i += 256) w2s[i] = w2[i];
  __syncthreads();
  {
    const int n = tid >> 1, fh = (tid & 1) * 32;
    float acc[32];
#pragma unroll
    for (int f = 0; f < 32; ++f) acc[f] = 0.f;
    for (int e = 0; e < 64; ++e) {
      const float hv = hid[n * 65 + e];
#pragma unroll
      for (int f = 0; f < 32; ++f) acc[f] += hv * w2s[e * 64 + fh + f];
    }
    const int ng = mt * 128 + n;
    const bool valid = ng < 511;
    if (kv == 0) {
      half_t* dst = p.kcmp() + ((size_t)(b * 2 + g) * 512 + ng) * 64 + fh;
#pragma unroll
      for (int f = 0; f < 32; ++f) dst[f] = valid ? (half_t)acc[f] : (half_t)0.f;
    } else {
      half_t* dst = p.vcmpT() + ((size_t)(b * 2 + g) * 64 + fh) * 512 + ng;
#pragma unroll
      for (int f = 0; f < 32; ++f) dst[(size_t)f * 512] = valid ? (half_t)acc[f] : (half_t)0.f;
    }
  }
  __syncthreads();
}

#ifndef DSA_CAP
#define DSA_CAP 128
#endif
__device__ __forceinline__ void dsa_item(const KP& p, int b, int tile, char* smem) {
  const int t0 = tile * 16;
  int tid = threadIdx.x;
  asm volatile("" : "+v"(tid));
  const int lane = tid & 63, wid = tid >> 6;
  uint32_t* hist = (uint32_t*)smem;
  unsigned long long* cand = (unsigned long long*)(smem + 16384);
  unsigned short* sel = (unsigned short*)(smem + 32768);
  unsigned long long* pfx = (unsigned long long*)(smem + 40960);
  unsigned long long* tkey = pfx + 16;
  int* need = (int*)(tkey + 16);
  int* state = need + 16;
  int* cnt = state + 16;
  int* ccnt = cnt + 16;
  int* pf16 = ccnt + 16;
  int* ovf = pf16 + 16;
  int* nrem = ovf + 16;
  int* fastf = nrem + 8;
  uint32_t* h1w = (uint32_t*)(smem + 43008);
  float* pbuf = (float*)smem + wid * 2048;

  const half_t* ub = p.u() + (size_t)b * SEQ * NU;
  const int mytok = lane & 15, hq = lane >> 4;
  const int myt = t0 + mytok;
  if (tid < 16) {
    const int t = t0 + tid;
    pfx[tid] = 0ull; tkey[tid] = 0ull; need[tid] = 256; state[tid] = (t < 256) ? 0 : 1; cnt[tid] = 0; ccnt[tid] = 0;
    pf16[tid] = 0; ovf[tid] = 0;
  }
  if (tid < 8) nrem[tid] = 0;
  if (tid < 16) fastf[tid] = 0;
  for (int i = tid; i < 6144; i += 256) h1w[i] = 0u;
  h8 qf[8], qlh, qll;
  float iw[8];
  {
    const half_t* qrow = ub + (size_t)myt * NU;
#pragma unroll
    for (int h = 0; h < 8; ++h) qf[h] = *(const h8*)(qrow + C_IQ + h * 32 + hq * 8);
    const h8 w8 = *(const h8*)(qrow + C_IW);
#pragma unroll
    for (int h = 0; h < 8; ++h) iw[h] = (float)w8[h] * 0.03125f;
#pragma unroll
    for (int e = 0; e < 8; ++e) {
      float a = 0.f;
#pragma unroll
      for (int h = 0; h < 8; ++h) a += iw[h] * (float)qf[h][e];
      const half_t hi = (half_t)a;
      qlh[e] = hi;
      qll[e] = (half_t)(a - (float)hi);
    }
  }
  __syncthreads();
  const int nkt = (t0 + 16 + 31) >> 5;

  auto loadk = [&](int kt, h8* a) __attribute__((always_inline)) {
#pragma unroll
    for (int i = 0; i < 2; ++i)
      a[i] = *(const h8*)(ub + (size_t)(kt * 32 + i * 16 + (lane & 15)) * NU + C_IK + hq * 8);
  };
  auto scores = [&](const h8* a, float* sc) __attribute__((always_inline)) {
#pragma unroll
    for (int i = 0; i < 2; ++i) {
      f32x4 acc = {0.f, 0.f, 0.f, 0.f};
      acc = __builtin_amdgcn_mfma_f32_16x16x32_f16(a[i], qll, acc, 0, 0, 0);
      acc = __builtin_amdgcn_mfma_f32_16x16x32_f16(a[i], qlh, acc, 0, 0, 0);
#pragma unroll
      for (int h = 0; h < 8; ++h) {
        f32x4 d = {0.f, 0.f, 0.f, 0.f};
        d = __builtin_amdgcn_mfma_f32_16x16x32_f16(a[i], qf[h], d, 0, 0, 0);
#pragma unroll
        for (int r = 0; r < 4; ++r) acc[r] = __builtin_fmaf(__builtin_fabsf(d[r]), iw[h], acc[r]);
      }
#pragma unroll
      for (int r = 0; r < 4; ++r) sc[i * 4 + r] = acc[r];
    }
  };
  auto skey = [&](float s) __attribute__((always_inline)) -> uint32_t {
    s = s + 0.f;
    const uint32_t u_ = __float_as_uint(s);
    return (u_ & 0x80000000u) ? ~u_ : (u_ | 0x80000000u);
  };
  auto mkkey = [&](float s, int key) __attribute__((always_inline)) -> unsigned long long {
    s = s + 0.f;
    uint32_t u_ = __float_as_uint(s);
    u_ = (u_ & 0x80000000u) ? ~u_ : (u_ | 0x80000000u);
    return ((unsigned long long)u_ << 16) | (unsigned long long)(8191 - key);
  };
  auto scan_token = [&](int tk, int level) __attribute__((always_inline)) -> bool {
    const int shift = 40 - 8 * level;
    const uint32_t* hrow = hist + tk * 256;
    const uint4 hv = *(const uint4*)&hrow[252 - 4 * lane];
    const int c = (int)(hv.x + hv.y + hv.z + hv.w);
    int cum = c;
#pragma unroll
    for (int o = 1; o < 64; o <<= 1) {
      int v = __shfl_up(cum, o);
      if (lane >= o) cum += v;
    }
    const int nd = need[tk];
    const unsigned long long mask = __ballot(cum >= nd);
    const int L = mask ? (int)__builtin_ctzll(mask) : 63;
    int running = cum - c, bstar, cb;
    if (running + (int)hv.w >= nd) { bstar = 255 - 4 * lane; cb = hv.w; }
    else {
      running += hv.w;
      if (running + (int)hv.z >= nd) { bstar = 254 - 4 * lane; cb = hv.z; }
      else {
        running += hv.z;
        if (running + (int)hv.y >= nd) { bstar = 253 - 4 * lane; cb = hv.y; }
        else { running += hv.y; bstar = 252 - 4 * lane; cb = hv.x; }
      }
    }
    running = __shfl(running, L); bstar = __shfl(bstar, L); cb = __shfl(cb, L);
    const int nd2 = nd - running;
    const bool fin = (cb == nd2) || (level == 5);
    if (lane == 0) {
      const unsigned long long np = (pfx[tk] << 8) | (unsigned long long)bstar;
      if (fin) { state[tk] = 0; tkey[tk] = np << shift; }
      else { need[tk] = nd2; pfx[tk] = np; }
    }
    return fin;
  };
  auto run_level = [&](int level, bool fillx) __attribute__((always_inline)) {
    const int shift = 40 - 8 * level;
    for (int i = tid; i < 4096; i += 256) hist[i] = 0u;
    __syncthreads();
    {
      const unsigned long long mypfx = pfx[mytok];
      const bool act = state[mytok] == 1 && fastf[mytok] == 0;
      h8 na[2];
      if (wid < nkt) loadk(wid, na);
      for (int kt = wid; kt < nkt; kt += 4) {
        h8 ca[2];
#pragma unroll
        for (int i = 0; i < 2; ++i) ca[i] = na[i];
        loadk(kt + 4 < nkt ? kt + 4 : kt, na);
        float sc[8];
        scores(ca, sc);
        if (act) {
#pragma unroll
          for (int q = 0; q < 8; ++q) {
            const int key = kt * 32 + (q >> 2) * 16 + 4 * hq + (q & 3);
            if (key <= myt) {
              if (level < 2) {
                const uint32_t u32 = skey(sc[q]);
                if (level == 0) {
                  const uint32_t b8 = u32 >> 24;
                  atomicAdd(&hist[mytok * 256 + (int)b8], 1u);
                  if (fillx) {
                    const uint32_t ix = b8 - 0xBEu;
                    if (ix < 3u) {
                      const uint32_t e16 = (ix * 16u + (uint32_t)mytok) * 256u + ((u32 >> 16) & 255u);
                      atomicAdd(&h1w[e16 >> 1], (e16 & 1u) ? 65536u : 1u);
                    }
                  }
                } else if ((u32 >> 24) == (uint32_t)mypfx) atomicAdd(&hist[mytok * 256 + (int)((u32 >> 16) & 255u)], 1u);
              } else {
                const unsigned long long k48 = mkkey(sc[q], key);
                if ((k48 >> (shift + 8)) == mypfx)
                  atomicAdd(&hist[mytok * 256 + (int)((k48 >> shift) & 255ull)], 1u);
              }
            }
          }
        }
      }
    }
    __syncthreads();
    {
      int rem = 0;
      for (int j = 0; j < 4; ++j) {
        const int tk = wid * 4 + j;
        if (state[tk] != 1 || fastf[tk] != 0) continue;
        if (!scan_token(tk, level)) rem++;
      }
      if (lane == 0 && rem) atomicAdd(&nrem[level], rem);
    }
    __syncthreads();
  };

  run_level(0, true);
  if (tid < 16) {
    const int b0 = (int)pfx[tid];
    const int f = (state[tid] == 1 && b0 >= 0xBE && b0 <= 0xC0) ? 1 : 0;
    fastf[tid] = f;
    if (state[tid] == 1 && !f) atomicAdd(&nrem[7], 1);
  }
  __syncthreads();
  if (nrem[7] != 0) run_level(1, false);
  for (int j = 0; j < 4; ++j) {
    const int tk = wid * 4 + j;
    if (state[tk] != 1 || fastf[tk] == 0) continue;
    const uint32_t ix = (uint32_t)pfx[tk] - 0xBEu;
    const unsigned short* hx = (const unsigned short*)h1w + (ix * 16u + (uint32_t)tk) * 256u;
    const ushort4 c4 = *(const ushort4*)&hx[4 * lane];
    uint4 w4;
    w4.x = c4.x; w4.y = c4.y; w4.z = c4.z; w4.w = c4.w;
    *(uint4*)&hist[tk * 256 + 4 * lane] = w4;
    __builtin_amdgcn_wave_barrier();
    scan_token(tk, 1);
  }
  __syncthreads();
  if (tid < 16) fastf[tid] = 0;
  __syncthreads();

  {
    const int st0 = state[mytok];
    const unsigned long long mytk = tkey[mytok];
    const unsigned long long myp16 = pfx[mytok];
    h8 na[2];
    if (wid < nkt) loadk(wid, na);
    for (int kt = wid; kt < nkt; kt += 4) {
      h8 ca[2];
#pragma unroll
      for (int i = 0; i < 2; ++i) ca[i] = na[i];
      loadk(kt + 4 < nkt ? kt + 4 : kt, na);
      float sc[8];
      scores(ca, sc);
#pragma unroll
      for (int q = 0; q < 8; ++q) {
        const int key = kt * 32 + (q >> 2) * 16 + 4 * hq + (q & 3);
        if (key <= myt) {
          const uint32_t u32 = skey(sc[q]);
          bool take, isc = false;
          if (st0 == 0) take = (((unsigned long long)u32 << 16) | (unsigned long long)(8191 - key)) >= mytk;
          else {
            const uint32_t p16 = u32 >> 16;
            take = p16 > (uint32_t)myp16;
            isc = p16 == (uint32_t)myp16;
          }
          if (take) {
            const int pos = atomicAdd(&cnt[mytok], 1);
            if (pos < 256) sel[mytok * 256 + pos] = (unsigned short)key;
          } else if (isc) {
            const int pos = atomicAdd(&ccnt[mytok], 1);
            if (pos < DSA_CAP) cand[mytok * 128 + pos] = ((unsigned long long)u32 << 16) | (unsigned long long)(8191 - key);
          }
        }
      }
    }
  }
  __syncthreads();
  {
    int nov = 0;
    for (int j = 0; j < 4; ++j) {
      const int tk = wid * 4 + j;
      if (state[tk] != 1) continue;
      const int nc = ccnt[tk];
      if (nc > DSA_CAP) {
        nov++;
        if (lane == 0) { ovf[tk] = 1; pf16[tk] = (int)pfx[tk]; }
        continue;
      }
      const int nd = need[tk];
      const unsigned long long k0 = (lane < nc) ? cand[tk * 128 + lane] : 0ull;
      const unsigned long long k1 = (lane + 64 < nc) ? cand[tk * 128 + lane + 64] : 0ull;
      int r0 = 0, r1 = 0;
      for (int q = 0; q < nc; ++q) {
        const unsigned long long kq = cand[tk * 128 + q];
        r0 += (kq > k0) ? 1 : 0;
        r1 += (kq > k1) ? 1 : 0;
      }
      if (lane < nc && r0 < nd) {
        const int pos = atomicAdd(&cnt[tk], 1);
        if (pos < 256) sel[tk * 256 + pos] = (unsigned short)(8191 - (int)(k0 & 0xFFFFull));
      }
      if (lane + 64 < nc && r1 < nd) {
        const int pos = atomicAdd(&cnt[tk], 1);
        if (pos < 256) sel[tk * 256 + pos] = (unsigned short)(8191 - (int)(k1 & 0xFFFFull));
      }
      if (lane == 0) state[tk] = 2;
    }
    if (lane == 0 && nov) atomicAdd(&nrem[6], nov);
  }
  __syncthreads();
  if (nrem[6] != 0) {
    for (int level = 2; level < 6; ++level) {
      run_level(level, false);
      if (nrem[level] == 0) break;
    }
    {
      const bool mine = ovf[mytok] != 0;
      const unsigned long long mytk = tkey[mytok];
      const unsigned long long myp16 = (unsigned long long)(unsigned)pf16[mytok];
      h8 na[2];
      if (wid < nkt) loadk(wid, na);
      for (int kt = wid; kt < nkt; kt += 4) {
        h8 ca[2];
#pragma unroll
        for (int i = 0; i < 2; ++i) ca[i] = na[i];
        loadk(kt + 4 < nkt ? kt + 4 : kt, na);
        float sc[8];
        scores(ca, sc);
        if (mine) {
#pragma unroll
          for (int q = 0; q < 8; ++q) {
            const int key = kt * 32 + (q >> 2) * 16 + 4 * hq + (q & 3);
            if (key <= myt) {
              const unsigned long long k48 = mkkey(sc[q], key);
              if ((k48 >> 32) == myp16 && k48 >= mytk) {
                const int pos = atomicAdd(&cnt[mytok], 1);
                if (pos < 256) sel[mytok * 256 + pos] = (unsigned short)key;
              }
            }
          }
        }
      }
    }
    __syncthreads();
  }
#ifndef DSA_ATT_REP
#define DSA_ATT_REP 1
#endif
  for (int jr = 0; jr < 4 * DSA_ATT_REP; ++jr) {
    const int j = jr & 3;
    const int tk = wid * 4 + j;
    const int t = t0 + tk;
    const int nsel = min(cnt[tk], 256);
    const half_t* urow = ub + (size_t)t * NU;
    const int col = lane & 15;
    h8 q0, q1;
#pragma unroll
    for (int e = 0; e < 8; ++e) { q0[e] = (half_t)0.f; q1[e] = (half_t)0.f; }
    if (col < 8) {
      q0 = *(const h8*)(urow + C_BQ + col * 64 + hq * 8);
      q1 = *(const h8*)(urow + C_BQ + col * 64 + 32 + hq * 8);
    }
    float mx = NEGF;
#pragma unroll 1
    for (int mg = 0; mg < 2; ++mg) {
#pragma unroll
      for (int mm = 0; mm < 8; ++mm) {
        const int m = mg * 8 + mm;
        const int pos = m * 16 + col;
        const int s = (pos < nsel) ? (int)sel[tk * 256 + pos] : 0;
        const half_t* kp = ub + (size_t)s * NU + C_BK + hq * 8;
        const h8 a0 = *(const h8*)kp, a1 = *(const h8*)(kp + 32);
        f32x4 d = {0.f, 0.f, 0.f, 0.f};
        d = __builtin_amdgcn_mfma_f32_16x16x32_f16(a0, q0, d, 0, 0, 0);
        d = __builtin_amdgcn_mfma_f32_16x16x32_f16(a1, q1, d, 0, 0, 0);
#pragma unroll
        for (int r = 0; r < 4; ++r) {
          const int pp = m * 16 + hq * 4 + r;
          const float v = (pp < nsel) ? d[r] * 0.125f : NEGF;
          mx = fmaxf(mx, v);
          if (col < 8) pbuf[pp * 8 + col] = v;
        }
      }
    }
    mx = fmaxf(mx, __shfl_xor(mx, 16));
    mx = fmaxf(mx, __shfl_xor(mx, 32));
    const float mxh = __shfl(mx, lane & 7);
    __builtin_amdgcn_wave_barrier();
    float sum = 0.f;
#pragma unroll 4
    for (int k = 0; k < 32; ++k) {
      const int i = lane + 64 * k;
      const float v = pbuf[i];
      const float e = (v > -1e29f) ? __expf(v - mxh) : 0.f;
      pbuf[i] = e;
      sum += e;
    }
    sum += __shfl_xor(sum, 8);
    sum += __shfl_xor(sum, 16);
    sum += __shfl_xor(sum, 32);
    const float inv = 1.f / sum;
    __builtin_amdgcn_wave_barrier();
    {
      const int rs = lane >> 3, dc = lane & 7;
      float acc[8][8];
#pragma unroll
      for (int h = 0; h < 8; ++h)
#pragma unroll
        for (int e = 0; e < 8; ++e) acc[h][e] = 0.f;
#pragma unroll 1
      for (int g8 = 0; g8 < 4; ++g8) {
        h8 vv[8];
#pragma unroll
        for (int i = 0; i < 8; ++i) {
          const int pos = (g8 * 8 + i) * 8 + rs;
          const int s = (pos < nsel) ? (int)sel[tk * 256 + pos] : 0;
          vv[i] = *(const h8*)(ub + (size_t)s * NU + C_BV + dc * 8);
        }
#pragma unroll
        for (int i = 0; i < 8; ++i) {
          const int pos = (g8 * 8 + i) * 8 + rs;
          const f32x4 pa = *(const f32x4*)&pbuf[pos * 8];
          const f32x4 pb = *(const f32x4*)&pbuf[pos * 8 + 4];
          float vf[8];
#pragma unroll
          for (int e = 0; e < 8; ++e) vf[e] = (float)vv[i][e];
#pragma unroll
          for (int e = 0; e < 8; ++e) {
            acc[0][e] += pa[0] * vf[e]; acc[1][e] += pa[1] * vf[e]; acc[2][e] += pa[2] * vf[e]; acc[3][e] += pa[3] * vf[e];
            acc[4][e] += pb[0] * vf[e]; acc[5][e] += pb[1] * vf[e]; acc[6][e] += pb[2] * vf[e]; acc[7][e] += pb[3] * vf[e];
          }
        }
      }
      half_t* yrow = p.yb() + (size_t)(b * SEQ + t) * 512;
#pragma unroll
      for (int h = 0; h < 8; ++h) {
        const float invh = __shfl(inv, h);
        h8 ov;
        const h8 z8 = *(const h8*)(urow + C_BZ + h * 64 + dc * 8);
#pragma unroll
        for (int e = 0; e < 8; ++e) {
          float a = acc[h][e];
          a += __shfl_xor(a, 8);
          a += __shfl_xor(a, 16);
          a += __shfl_xor(a, 32);
          ov[e] = (half_t)(a * invh * siluf_((float)z8[e]));
        }
        if (rs == h) *(h8*)(yrow + h * 64 + dc * 8) = ov;
      }
    }
    __builtin_amdgcn_wave_barrier();
  }
  __syncthreads();
}

__device__ __forceinline__ void phase2(const KP& p, int l, char* smem, int* q, int xcc) {
  xcd_schedule(q, xcc, 32, 1, smem, [&](int grp, int) __attribute__((always_inline)) { compress_item(p, l, grp, smem); });
  xcd_schedule(q + 8, xcc, 1024, 1, smem, [&](int grp, int) __attribute__((always_inline)) {
    const int y = grp & 7, k = grp >> 3;
    dsa_item(p, y & 1, 511 - (k * 4 + (y >> 1)), smem);
  });
  xcd_schedule(q + 16, xcc, 512, 1, smem, [&](int grp, int) __attribute__((always_inline)) { pool_item(p, l, grp, smem); });
}

struct DState {
  float m, l;
  f32x16 o[2];
};
#define MLOW (-1e4f)
__device__ __forceinline__ void ds_reset(DState& st) {
  st.m = MLOW; st.l = 0.f;
#pragma unroll
  for (int dt = 0; dt < 2; ++dt)
#pragma unroll
    for (int r = 0; r < 16; ++r) st.o[dt][r] = 0.f;
}
typedef unsigned int u32x4 __attribute__((ext_vector_type(4)));
typedef unsigned int u32x2 __attribute__((ext_vector_type(2)));
struct StageRegs {
  u32x4 k0, k1, v0, v1;
};
template <bool HASV>
__device__ __forceinline__ void load_stage(StageRegs& r, const half_t* __restrict__ Kb, int ldk,
                                           const half_t* __restrict__ VT, int ldv, int key0, int tid) {
  const int row = tid >> 3, c = tid & 7;
  r.k0 = *(const u32x4*)(Kb + (size_t)(key0 + row) * ldk + c * 8);
  r.k1 = *(const u32x4*)(Kb + (size_t)(key0 + row + 32) * ldk + c * 8);
  if (HASV) {
    r.v0 = *(const u32x4*)(VT + (size_t)row * ldv + key0 + c * 8);
    r.v1 = *(const u32x4*)(VT + (size_t)(row + 32) * ldv + key0 + c * 8);
  }
}
template <bool HASV>
__device__ __forceinline__ void write_stage(const StageRegs& r, half_t* Ks, half_t* Vs, int tid) {
  const int row = tid >> 3, c = tid & 7;
  *(u32x4*)&Ks[row * 72 + c * 8] = r.k0;
  *(u32x4*)&Ks[(row + 32) * 72 + c * 8] = r.k1;
  if (HASV) {
    const int ks = c >> 1, a = c & 1;
    u32x2 lo, hi;
    lo[0] = r.v0[0]; lo[1] = r.v0[1]; hi[0] = r.v0[2]; hi[1] = r.v0[3];
    *(u32x2*)&Vs[row * 72 + ks * 16 + a * 4] = lo;
    *(u32x2*)&Vs[row * 72 + ks * 16 + 8 + a * 4] = hi;
    lo[0] = r.v1[0]; lo[1] = r.v1[1]; hi[0] = r.v1[2]; hi[1] = r.v1[3];
    *(u32x2*)&Vs[(row + 32) * 72 + ks * 16 + a * 4] = lo;
    *(u32x2*)&Vs[(row + 32) * 72 + ks * 16 + 8 + a * 4] = hi;
  }
}
template <bool ONLINE, bool HASV, bool FAST, class VF>
__device__ __forceinline__ void dense_block(DState& st, const half_t* Ks, const half_t* Vs, const h8* qf, int key0,
                                            int flag, VF valid, float fixed_m, float fixed_invl, f32x16* pout,
                                            int lane) {
  const int h = lane >> 5, c = lane & 31;
  f32x16 s[2];
#pragma unroll
  for (int kt = 0; kt < 2; ++kt) {
#pragma unroll
    for (int r = 0; r < 16; ++r) s[kt][r] = 0.f;
#pragma unroll
    for (int ks = 0; ks < 4; ++ks) {
      const h8 a = *(const h8*)&Ks[(32 * kt + c) * 72 + 16 * ks + 8 * h];
      s[kt] = __builtin_amdgcn_mfma_f32_32x32x16_f16(a, qf[ks], s[kt], 0, 0, 0);
    }
  }
  float cm = NEGF;
#pragma unroll
  for (int kt = 0; kt < 2; ++kt)
#pragma unroll
    for (int r = 0; r < 16; ++r) {
      const int key = key0 + 32 * kt + (r & 3) + 8 * (r >> 2) + 4 * h;
      const float v = (FAST ? (flag != 0) : valid(key, flag)) ? s[kt][r] : NEGF;
      s[kt][r] = v;
      cm = fmaxf(cm, v);
    }
  float mnew;
  if (ONLINE) {
    cm = fmaxf(cm, __shfl_xor(cm, 32));
    mnew = st.m;
    if (__ballot(cm > st.m + 8.0f) != 0ull) {
      mnew = fmaxf(st.m, cm);
      const float alpha = __builtin_amdgcn_exp2f(st.m - mnew);
      st.m = mnew;
      st.l *= alpha;
      if (HASV) {
#pragma unroll
        for (int dt = 0; dt < 2; ++dt)
#pragma unroll
          for (int r = 0; r < 16; ++r) st.o[dt][r] *= alpha;
      }
    }
  } else {
    mnew = fixed_m;
  }
  float ps = 0.f;
#pragma unroll
  for (int kt = 0; kt < 2; ++kt)
#pragma unroll
    for (int r = 0; r < 16; ++r) {
      float e = __builtin_amdgcn_exp2f(s[kt][r] - mnew);
      if (!ONLINE) e *= fixed_invl;
      s[kt][r] = e;
      ps += e;
    }
  st.l += ps;
  if (pout) { pout[0] = s[0]; pout[1] = s[1]; }
  if (HASV) {
#pragma unroll
    for (int ks = 0; ks < 4; ++ks) {
      h8 pf;
#pragma unroll
      for (int jj = 0; jj < 8; ++jj) pf[jj] = (half_t)s[ks >> 1][8 * (ks & 1) + jj];
#pragma unroll
      for (int dt = 0; dt < 2; ++dt) {
        const h8 vf = *(const h8*)&Vs[(32 * dt + c) * 72 + 16 * ks + 8 * h];
        st.o[dt] = __builtin_amdgcn_mfma_f32_32x32x16_f16(vf, pf, st.o[dt], 0, 0, 0);
      }
    }
  }
}
template <bool ONLINE, bool HASV, bool WANTP, class PRE, class FU, class VF, class PO>
__device__ __forceinline__ void run_dense(DState& st, const half_t* __restrict__ Kb, int ldk,
                                          const half_t* __restrict__ VT, int ldv, int blk_lo, int blk_hi, const h8* qf,
                                          PRE pre, FU full, VF valid, float fixed_m, float fixed_invl, PO post, char* smem,
                                          int tid) {
  half_t* Ks = (half_t*)smem;
  half_t* Vs = Ks + 64 * 72;
  const int lane = tid & 63;
  StageRegs sr;
  load_stage<HASV>(sr, Kb, ldk, VT, ldv, blk_lo * 64, tid);
  for (int blk = blk_lo; blk <= blk_hi; ++blk) {
    __syncthreads();
    write_stage<HASV>(sr, Ks, Vs, tid);
    __syncthreads();
    const int nb = blk < blk_hi ? blk + 1 : blk;
    load_stage<HASV>(sr, Kb, ldk, VT, ldv, nb * 64, tid);
    const int flag = pre(blk);
    if (__ballot(flag != 0) != 0ull) {
      f32x16 pp[2];
      if (full(blk))
        dense_block<ONLINE, HASV, true>(st, Ks, Vs, qf, blk * 64, flag, valid, fixed_m, fixed_invl,
                                        WANTP ? pp : (f32x16*)nullptr, lane);
      else
        dense_block<ONLINE, HASV, false>(st, Ks, Vs, qf, blk * 64, flag, valid, fixed_m, fixed_invl,
                                         WANTP ? pp : (f32x16*)nullptr, lane);
      if (WANTP) post(blk * 64, pp);
    }
  }
}

__device__ __forceinline__ void nsa_item(const KP& p, int b, int g, int tile, char* smem) {
  int tid = threadIdx.x;
  asm volatile("" : "+v"(tid));
  const int lane = tid & 63, wid = tid >> 6;
  const int t0 = tile * 32;
  const int tw0 = t0 + 8 * wid;
  const int col = lane & 31, h = lane >> 5;
  const int j = col >> 2, r4 = col & 3;
  const int tj = tw0 + j;
  const int head = g * 4 + r4;
  float* impA = (float*)(smem + 18432 + wid * 8320);
  float* impB = impA + 1024;
  unsigned long long* msk = (unsigned long long*)(smem + 18432 + 4 * 8320 + wid * 128);
  const half_t* ub = p.u() + (size_t)b * SEQ * NU;
  const half_t* urow = ub + (size_t)tj * NU;
  h8 qf[4];
#pragma unroll
  for (int ks = 0; ks < 4; ++ks) {
    qf[ks] = *(const h8*)(urow + C_CQ + head * 64 + 16 * ks + 8 * h);
#pragma unroll
    for (int e = 0; e < 8; ++e) qf[ks][e] = (half_t)((float)qf[ks][e] * 0.18033688f);
  }
  float gate[3];
#pragma unroll
  for (int i = 0; i < 3; ++i) gate[i] = sigmoidf_((float)urow[C_CG + head * 3 + i]);
  f32x16 res[2];
#pragma unroll
  for (int dt = 0; dt < 2; ++dt)
#pragma unroll
    for (int r = 0; r < 16; ++r) res[dt][r] = 0.f;
  for (int i = lane; i < 2080; i += 64) impA[i] = 0.f;
  DState st;
  auto nopost = [&](int, f32x16*) __attribute__((always_inline)) {};

  {
    const int nmax_j = (tj >= 31) ? ((tj - 31) >> 4) : -1;
    const int bhi = (t0 >> 4) >> 6;
    const half_t* Kc = p.kcmp() + (size_t)(b * 2 + g) * 512 * 64;
    const half_t* Vc = p.vcmpT() + (size_t)(b * 2 + g) * 64 * 512;
    auto pre = [&](int) __attribute__((always_inline)) { return 1; };
    const int nmax_w = (tw0 >= 31) ? ((tw0 - 31) >> 4) : -1;
    auto fullc = [&](int blk) __attribute__((always_inline)) { return blk * 64 + 63 <= nmax_w; };
    auto vfn = [&](int n, int) __attribute__((always_inline)) { return n <= nmax_j; };
    ds_reset(st);
    run_dense<true, false, false>(st, Kc, 64, (const half_t*)nullptr, 0, 0, bhi, qf, pre, fullc, vfn, 0.f, 0.f, nopost, smem, tid);
    float lt = st.l;
    lt += __shfl_xor(lt, 32);
    const float mfix = st.m;
    const float invl = lt > 0.f ? 1.f / lt : 0.f;
    ds_reset(st);
    auto post = [&](int n0, f32x16* pp) __attribute__((always_inline)) {
#pragma unroll
      for (int kt = 0; kt < 2; ++kt)
#pragma unroll
        for (int qd = 0; qd < 4; ++qd) {
          float a = pp[kt][4 * qd] + pp[kt][4 * qd + 1] + pp[kt][4 * qd + 2] + pp[kt][4 * qd + 3];
          float bb = pp[kt][4 * qd + 3];
          a += __shfl_xor(a, 1); a += __shfl_xor(a, 2);
          bb += __shfl_xor(bb, 1); bb += __shfl_xor(bb, 2);
          if (r4 == 0) {
            const int sblk = (n0 >> 2) + 8 * kt + 2 * qd + h;
            impA[j * 128 + sblk] = a;
            impB[j * 132 + sblk + 1] = bb;
          }
        }
    };
    run_dense<false, true, true>(st, Kc, 64, Vc, 512, 0, bhi, qf, pre, fullc, vfn, mfix, invl, post, smem, tid);
#pragma unroll
    for (int dt = 0; dt < 2; ++dt)
#pragma unroll
      for (int r = 0; r < 16; ++r) res[dt][r] += gate[0] * st.o[dt][r];
  }
  __builtin_amdgcn_wave_barrier();
#pragma unroll 1
  for (int jj = 0; jj < 8; ++jj) {
    const int t = tw0 + jj;
    const int blk = t >> 6;
    uint32_t k0, k1;
    {
      const int s0 = lane, s1 = lane + 64;
      const float i0 = impA[jj * 128 + s0] + impB[jj * 132 + s0];
      const float i1 = impA[jj * 128 + s1] + impB[jj * 132 + s1];
      auto mk = [&](float im, int s) __attribute__((always_inline)) -> uint32_t {
        if (s > blk) return 0u;
        uint32_t kk = ((__float_as_uint(im) >> 1) & ~127u) | (uint32_t)(127 - s) | 0x40000000u;
        if (s == 0 || s == blk || s == blk - 1) kk |= 0x80000000u;
        return kk;
      };
      k0 = mk(i0, s0); k1 = mk(i1, s1);
    }
    unsigned long long lo = 0ull, hi = 0ull;
    for (int it = 0; it < 16; ++it) {
      uint32_t mxk = k0 > k1 ? k0 : k1;
#pragma unroll
      for (int o = 32; o > 0; o >>= 1) {
        const uint32_t ov = (uint32_t)__shfl_xor((int)mxk, o);
        mxk = ov > mxk ? ov : mxk;
      }
      mxk = (uint32_t)__builtin_amdgcn_readfirstlane((int)mxk);
      if (mxk == 0u) break;
      const int s = 127 - (int)(mxk & 127u);
      if (s < 64) lo |= 1ull << s; else hi |= 1ull << (s - 64);
      if (s == lane) k0 = 0u;
      if (s == lane + 64) k1 = 0u;
    }
    if (lane == 0) { msk[jj * 2] = lo; msk[jj * 2 + 1] = hi; }
  }
  __builtin_amdgcn_wave_barrier();
  const unsigned long long mylo = msk[j * 2], myhi = msk[j * 2 + 1];
  {
    const half_t* Ksel = ub + C_CKS + g * 64;
    const half_t* Vsel = p.vsT() + (size_t)(b * 2 + g) * 64 * SEQ;
    auto pre = [&](int blk) __attribute__((always_inline)) {
      const unsigned long long mm_ = (blk < 64) ? mylo : myhi;
      return (int)((mm_ >> (blk & 63)) & 1ull);
    };
    auto vfn = [&](int key, int flag) __attribute__((always_inline)) { return flag != 0 && key <= tj; };
    ds_reset(st);
    auto fulls = [&](int blk) __attribute__((always_inline)) { return blk * 64 + 63 <= tw0; };
    run_dense<true, true, false>(st, Ksel, NU, Vsel, SEQ, 0, (t0 + 31) >> 6, qf, pre, fulls, vfn, 0.f, 0.f, nopost, smem, tid);
    float lt = st.l;
    lt += __shfl_xor(lt, 32);
    const float sc = lt > 0.f ? gate[1] / lt : 0.f;
#pragma unroll
    for (int dt = 0; dt < 2; ++dt)
#pragma unroll
      for (int r = 0; r < 16; ++r) res[dt][r] += sc * st.o[dt][r];
  }
  {
    const half_t* Kw = ub + C_CKW + g * 64;
    const half_t* Vw = p.vwT() + (size_t)(b * 2 + g) * 64 * SEQ;
    auto pre = [&](int blk) __attribute__((always_inline)) {
      return (int)((blk * 64 <= tj) && (blk * 64 + 63 > tj - 512));
    };
    auto vfn = [&](int key, int) __attribute__((always_inline)) { return key <= tj && key > tj - 512; };
    ds_reset(st);
    auto fullw = [&](int blk) __attribute__((always_inline)) { return blk * 64 + 63 <= tw0 && blk * 64 > tw0 + 7 - 512; };
    run_dense<true, true, false>(st, Kw, NU, Vw, SEQ, max(0, t0 - 511) >> 6, (t0 + 31) >> 6, qf, pre, fullw, vfn, 0.f, 0.f,
                                 nopost, smem, tid);
    float lt = st.l;
    lt += __shfl_xor(lt, 32);
    const float sc = lt > 0.f ? gate[2] / lt : 0.f;
#pragma unroll
    for (int dt = 0; dt < 2; ++dt)
#pragma unroll
      for (int r = 0; r < 16; ++r) res[dt][r] += sc * st.o[dt][r];
  }
  half_t* yrow = p.yc() + (size_t)(b * SEQ + tj) * 512 + head * 64;
#pragma unroll
  for (int dt = 0; dt < 2; ++dt)
#pragma unroll
    for (int qd = 0; qd < 4; ++qd) {
      const int d = 32 * dt + 8 * qd + 4 * h;
      const h4 z = *(const h4*)(urow + C_CZ + head * 64 + d);
      h4 ov;
#pragma unroll
      for (int e = 0; e < 4; ++e) ov[e] = (half_t)(res[dt][4 * qd + e] * siluf_((float)z[e]));
      *(h4*)(yrow + d) = ov;
    }
  __syncthreads();
}

__device__ __forceinline__ void phase_nsa(const KP& p, char* smem, int* q, int xcc) {
  xcd_schedule(q, xcc, 1024, 1, smem, [&](int grp, int) __attribute__((always_inline)) {
    const int y = grp & 7, k = grp >> 3;
    const int b = y & 1, g = (y >> 1) & 1, tile = 255 - (k * 2 + (y >> 2));
    nsa_item(p, b, g, tile, smem);
  });
}

__device__ __forceinline__ void phase_merge(const KP& p, char* smem, int* q, int xcc) {
  xcd_schedule(q, xcc, 16, 64, smem, [&](int grp, int within) __attribute__((always_inline)) {
    const int mt = (grp & 15) * 8 + (within & 7), nt = (within >> 3);
    const int m0 = mt * 128, n0 = nt * 128;
    f32x16 tot[2][2];
#pragma unroll
    for (int i = 0; i < 2; ++i)
#pragma unroll
      for (int jn = 0; jn < 2; ++jn)
#pragma unroll
        for (int r = 0; r < 16; ++r) tot[i][jn][r] = 0.f;
#pragma unroll 1
    for (int br = 0; br < 3; ++br) {
      const half_t* A = (br == 0 ? p.ya() : (br == 1 ? p.yb() : p.yc())) + (size_t)m0 * 512;
      const half_t* B = p.wpT() + (size_t)br * DM * 512 + (size_t)n0 * 512;
      const half_t* G = p.u() + (size_t)m0 * NU + C_GM + br * 1024 + n0;
      gemm_tile<2>(
          512, [&](int r, int k) { return *(const uint4*)(A + (size_t)r * 512 + k); },
          [&](int r, int k) { return *(const uint4*)(B + (size_t)r * 512 + k); },
          [&](int mi, int ni, int r, int row, int col, float v) {
            const float gz = (float)G[(size_t)row * NU + col];
            tot[mi][ni][r] += sigmoidf_(gz) * v;
          },
          smem);
    }
    int tidx = threadIdx.x;
    asm volatile("" : "+v"(tidx));
    const int lane = tidx & 63, wid = tidx >> 6, wm = wid >> 1, wn = wid & 1;
#pragma unroll
    for (int mi = 0; mi < 2; ++mi)
#pragma unroll
      for (int ni = 0; ni < 2; ++ni)
#pragma unroll
        for (int r = 0; r < 16; ++r) {
          const int row = wm * 64 + mi * 32 + (r & 3) + 8 * (r >> 2) + 4 * (lane >> 5);
          const int col = wn * 64 + ni * 32 + (lane & 31);
          p.mm()[(size_t)(m0 + row) * DM + n0 + col] = (half_t)tot[mi][ni][r];
        }
  });
}

__device__ __forceinline__ void phase_outproj(const KP& p, char* smem, int* q, int xcc) {
  xcd_schedule(q, xcc, 16, 64, smem, [&](int grp, int within) __attribute__((always_inline)) {
    const int mt = (grp & 15) * 8 + (within & 7), nt = (within >> 3);
    const int m0 = mt * 128, n0 = nt * 128;
    const half_t* A = p.mm() + (size_t)m0 * DM;
    const half_t* B = p.woT() + (size_t)n0 * DM;
    gemm_tile<2>(
        DM, [&](int r, int k) { return *(const uint4*)(A + (size_t)r * DM + k); },
        [&](int r, int k) { return *(const uint4*)(B + (size_t)r * DM + k); },
        [&](int mi, int ni, int r, int row, int col, float v) {
          const size_t xi = (size_t)(m0 + row) * DM + n0 + col;
          ((float*)p.u())[xi] = ALPHA_F * p.xr()[xi] + v;
        },
        smem);
  });
}


#define XB_TMO      128
#define XB_XCNT(j)  (256  + 64 * (j))
#define XB_XSUB(j)  (1280 + 64 * (j))
#define XB_XGEN(j)  (2304 + 64 * (j))
#define XB_TOP      3328
#define XB_TOPGEN   3392
#define XCD_BAR_WORDS 3456
#define XB_SPIN_CAP (1u << 20)
#define LAS __attribute__((address_space(3)))
__device__ __forceinline__ unsigned xb_ld(unsigned* p)              { return __hip_atomic_load(p, __ATOMIC_RELAXED, __HIP_MEMORY_SCOPE_AGENT); }
__device__ __forceinline__ unsigned xb_add(unsigned* p, unsigned v) { return __hip_atomic_fetch_add(p, v, __ATOMIC_RELAXED, __HIP_MEMORY_SCOPE_AGENT); }
__device__ __forceinline__ unsigned xb_xcc_id() { return (unsigned)__builtin_amdgcn_s_getreg((3 << 11) | 20) & 0xFu; }
#define XB_SPIN(cond, bar) do { unsigned _sp = 0; while (cond) { __builtin_amdgcn_s_sleep(1); \
    if ((++_sp & 255u) == 0u) { if (xb_ld(&(bar)[XB_TMO])) break; if (_sp > XB_SPIN_CAP) { atomicAdd(&(bar)[XB_TMO], 1u); break; } } } } while (0)
struct XcdBarrier { unsigned* bar; unsigned x; volatile LAS unsigned* st; };
__device__ __forceinline__ XcdBarrier xcd_barrier_post(unsigned* bar, volatile LAS unsigned* st) {
  XcdBarrier b; b.bar = bar; b.x = xb_xcc_id(); b.st = st;
  if (threadIdx.x == 0) (void)xb_add(&bar[XB_XCNT(b.x)], 1u);
  return b;
}
__device__ __forceinline__ void xcd_barrier_complete(unsigned* bar, unsigned x, unsigned& nloc, unsigned& nx) {
  const unsigned G = gridDim.x * gridDim.y * gridDim.z;
  unsigned sum, cnt, mine, sp = 0u;
  for (;;) {
    sum = 0u; cnt = 0u; mine = 0u;
#pragma unroll
    for (unsigned j = 0; j < 16; ++j) { const unsigned c = xb_ld(&bar[XB_XCNT(j)]); sum += c; cnt += (c > 0u) ? 1u : 0u; mine = (j == x) ? c : mine; }
    if (sum == G) break;
    __builtin_amdgcn_s_sleep(1);
    if ((++sp & 255u) == 0u) { if (xb_ld(&bar[XB_TMO])) break; if (sp > XB_SPIN_CAP) { atomicAdd(&bar[XB_TMO], 1u); break; } }
  }
  nloc = mine > 0u ? mine : 1u; nx = cnt > 0u ? cnt : 1u;
}
__device__ __forceinline__ void xcd_barrier(const XcdBarrier& b) {
  asm volatile("s_waitcnt vmcnt(0)" ::: "memory");
  __syncthreads();
  if (threadIdx.x == 0) {
    unsigned* bar = b.bar;
    __builtin_amdgcn_s_waitcnt(0);
    unsigned nloc = b.st[0], nx = b.st[1];
    if (nloc == 0u) { xcd_barrier_complete(bar, b.x, nloc, nx); b.st[0] = nloc; b.st[1] = nx; }
    const unsigned old = xb_add(&bar[XB_XSUB(b.x)], 1u);
    const unsigned gen = old / nloc;
    if (old + 1u == (gen + 1u) * nloc) {
      __builtin_amdgcn_fence(__ATOMIC_RELEASE, "agent");
      asm volatile("s_waitcnt vmcnt(0)" ::: "memory");
      const unsigned og = xb_add(&bar[XB_TOP], 1u);
      const unsigned tg = og / nx;
      if (og + 1u == (tg + 1u) * nx) xb_add(&bar[XB_TOPGEN], 1u);
      else XB_SPIN(xb_ld(&bar[XB_TOPGEN]) == tg, bar);
      __builtin_amdgcn_fence(__ATOMIC_ACQUIRE, "agent");
      xb_add(&bar[XB_XGEN(b.x)], 1u);
      asm volatile("s_waitcnt vmcnt(0)" ::: "memory");
    } else {
      XB_SPIN(xb_ld(&bar[XB_XGEN(b.x)]) == gen, bar);
      __builtin_amdgcn_fence(__ATOMIC_ACQUIRE, "agent");
      asm volatile("s_waitcnt vmcnt(0)" ::: "memory");
    }
  }
  __syncthreads();
}

#define NQ_WORDS 4096
__global__ void __launch_bounds__(256, 2) fwd_megakernel(Params p_unused) {
  cg::grid_group grid = cg::this_grid();
  __shared__ __attribute__((aligned(16))) char smem[SMEM_BYTES];
  volatile LAS unsigned* st = (volatile LAS unsigned*)(smem + SMEM_BYTES - 32);
  if (threadIdx.x == 0) { st[0] = 0u; st[1] = 0u; }
  __syncthreads();
  if (gridDim.y == 4242u) grid.sync();
  XcdBarrier xb;
  {
    const KP p = get_params();
    xb = xcd_barrier_post((unsigned*)p.counters() + NQ_WORDS, st);
    ln_rows(p, -1, false);
    prep_weights(p, 0, smem);
  }
  xcd_barrier(xb);
  const int xcc = (int)(xb.x & 7u);
#ifndef REP1
#define REP1 1
#define REP2 1
#define REP3 1
#define REP4 1
#endif
#ifndef REP5
#define REP5 1
#define REP6 1
#define REP7 0
#endif
#pragma unroll 1
  for (int l = 0; l < DEPTH; ++l) {
#define QPTR(ph, rep) (p.counters() + ((l * 6 + (ph)) * 4 + (rep)) * 32)
    for (int rep = 0; rep < REP1; ++rep) { const KP p = get_params(); phase_inproj(p, l, smem, QPTR(0, rep), xcc); }
    xcd_barrier(xb);
    for (int rep = 0; rep < REP2; ++rep) { const KP p = get_params(); phase2(p, l, smem, QPTR(1, rep), xcc); }
    xcd_barrier(xb);
    for (int rep = 0; rep < REP3; ++rep) { const KP p = get_params(); phase_nsa(p, smem, QPTR(2, rep), xcc); }
    xcd_barrier(xb);
    for (int rep = 0; rep < REP4; ++rep) { const KP p = get_params(); phase_merge(p, smem, QPTR(3, rep), xcc); }
    xcd_barrier(xb);
    for (int rep = 0; rep < REP5; ++rep) { const KP p = get_params(); phase_outproj(p, smem, QPTR(4, rep), xcc); }
    xcd_barrier(xb);
    for (int rep = 0; rep < REP6; ++rep) {
      const KP p = get_params();
      if (l + 1 < DEPTH) {
        ln_rows(p, l, false);
        prep_weights(p, l + 1, smem);
      } else {
        ln_rows(p, l, true);
      }
    }
    if (l + 1 < DEPTH) xcd_barrier(xb);
    for (int rep = 0; rep < REP7; ++rep) xcd_barrier(xb);
  }
}

extern "C" void kernel_launch(void* const* d_in, const int* in_sizes, int n_in, void* d_out, int out_size,
                              void* d_ws, size_t ws_size, hipStream_t stream) {
  static int grid_blocks = 0;
  if (!grid_blocks) {
    int dev = 0, cus = 0, per_cu = 0;
    (void)hipGetDevice(&dev);
    (void)hipDeviceGetAttribute(&cus, hipDeviceAttributeMultiprocessorCount, dev);
    (void)hipOccupancyMaxActiveBlocksPerMultiprocessor(&per_cu, fwd_megakernel, 256, 0);
    if (per_cu > 2) per_cu = 2;
    if (per_cu < 1) per_cu = 1;
    grid_blocks = cus * per_cu;
  }
  Params p{};
  p.x = (const float*)d_in[0]; p.w_in = (const float*)d_in[1]; p.b_in = (const float*)d_in[2];
  p.pool_w = (const float*)d_in[3]; p.pool_b = (const float*)d_in[4]; p.pool_scale = (const float*)d_in[5];
  p.pos_k = (const float*)d_in[6]; p.pos_v = (const float*)d_in[7]; p.w1k = (const float*)d_in[8];
  p.w2k = (const float*)d_in[9]; p.w1v = (const float*)d_in[10]; p.w2v = (const float*)d_in[11];
  p.wpa = (const float*)d_in[12]; p.wpb = (const float*)d_in[13]; p.wpc = (const float*)d_in[14];
  p.wo = (const float*)d_in[15]; p.ln_g = (const float*)d_in[16]; p.ln_b = (const float*)d_in[17];
  p.out = (float*)d_out;
  p.ws = (char*)d_ws;
  if (WS_TOTAL > ws_size) { fprintf(stderr, "workspace too small: need %zu have %zu\n", (size_t)WS_TOTAL, ws_size); return; }
  (void)hipMemsetAsync((char*)d_ws + OFF_counters, 0, (size_t)(NQ_WORDS + XCD_BAR_WORDS) * 4, stream);
  void* args[] = {&p};
  hipError_t e = hipLaunchCooperativeKernel((void*)fwd_megakernel, dim3(grid_blocks), dim3(256), args, 0, stream);
  if (e != hipSuccess) fprintf(stderr, "cooperative launch failed: %s (grid %d)\n", hipGetErrorString(e), grid_blocks);
}
```

```cpp
#include <hip/hip_runtime.h>
#include <hip/hip_cooperative_groups.h>
#include <cstdio>
#include <cstdint>
namespace cg = cooperative_groups;

typedef _Float16 half_t;
typedef _Float16 h8 __attribute__((ext_vector_type(8)));
typedef _Float16 h4 __attribute__((ext_vector_type(4)));
typedef float f32x4 __attribute__((ext_vector_type(4)));
typedef float f32x16 __attribute__((ext_vector_type(16)));

#define SEQ 8192
#define DM 1024
#define NTOK 16384
#define DEPTH 4
#define NIN 7360
#define NU 7424
#define ALPHA_F 1.681792830507429f
#define NEGF (-1e30f)

#define C_AX 0
#define C_AZ 512
#define C_BQ 1024
#define C_BZ 1536
#define C_CQ 2048
#define C_CZ 2560
#define C_GM 3072
#define C_IQ 6144
#define C_CKC 6400
#define C_CVC 6528
#define C_CKS 6656
#define C_CVS 6784
#define C_CKW 6912
#define C_CVW 7040
#define C_BK 7168
#define C_BV 7232
#define C_IK 7296
#define C_IW 7328
#define C_CG 7336

#define SMEM_BYTES 73728

constexpr size_t OFF_xr = 0;
constexpr size_t OFF_xh = OFF_xr + (((size_t)NTOK*DM*4 + 255) & ~(size_t)255);
constexpr size_t OFF_u = OFF_xh + (((size_t)NTOK*DM*2 + 255) & ~(size_t)255);
constexpr size_t OFF_winT = OFF_u + (((size_t)NTOK*NU*2 + 255) & ~(size_t)255);
constexpr size_t OFF_wpT = OFF_winT + (((size_t)NU*DM*2 + 255) & ~(size_t)255);
constexpr size_t OFF_woT = OFF_wpT + (((size_t)3*DM*512*2 + 255) & ~(size_t)255);
constexpr size_t OFF_poolT = OFF_woT + (((size_t)DM*DM*2 + 255) & ~(size_t)255);
constexpr size_t OFF_w1T = OFF_poolT + (((size_t)4*128*128*2 + 255) & ~(size_t)255);
constexpr size_t OFF_posb = OFF_w1T + (((size_t)2*64*2048*2 + 255) & ~(size_t)255);
constexpr size_t OFF_vsT = OFF_posb + (((size_t)512 + 255) & ~(size_t)255);
constexpr size_t OFF_vwT = OFF_vsT + (((size_t)4*64*SEQ*2 + 255) & ~(size_t)255);
constexpr size_t OFF_kcmp = OFF_vwT + (((size_t)4*64*SEQ*2 + 255) & ~(size_t)255);
constexpr size_t OFF_vcmpT = OFF_kcmp + (((size_t)4*512*64*2 + 255) & ~(size_t)255);
constexpr size_t OFF_ya = OFF_vcmpT + (((size_t)4*64*512*2 + 255) & ~(size_t)255);
constexpr size_t OFF_yb = OFF_ya + (((size_t)NTOK*512*2 + 255) & ~(size_t)255);
constexpr size_t OFF_yc = OFF_yb + (((size_t)NTOK*512*2 + 255) & ~(size_t)255);
constexpr size_t OFF_mm = OFF_yc + (((size_t)NTOK*512*2 + 255) & ~(size_t)255);
constexpr size_t OFF_counters = OFF_mm + (((size_t)NTOK*DM*2 + 255) & ~(size_t)255);
constexpr size_t WS_TOTAL = OFF_counters + (((size_t)32768 + 255) & ~(size_t)255);
struct Params {
  const float* x; const float* w_in; const float* b_in; const float* pool_w; const float* pool_b;
  const float* pool_scale; const float* pos_k; const float* pos_v; const float* w1k; const float* w2k;
  const float* w1v; const float* w2v; const float* wpa; const float* wpb; const float* wpc;
  const float* wo; const float* ln_g; const float* ln_b;
  float* out;
  char* ws;
};
typedef const __attribute__((address_space(4))) unsigned long long* kargp_t;
struct KP {
  kargp_t kp;
  __device__ __forceinline__ const float* x() const { return (const float*)(const __attribute__((address_space(1))) float*)kp[0]; }
  __device__ __forceinline__ const float* w_in() const { return (const float*)(const __attribute__((address_space(1))) float*)kp[1]; }
  __device__ __forceinline__ const float* b_in() const { return (const float*)(const __attribute__((address_space(1))) float*)kp[2]; }
  __device__ __forceinline__ const float* pool_w() const { return (const float*)(const __attribute__((address_space(1))) float*)kp[3]; }
  __device__ __forceinline__ const float* pool_b() const { return (const float*)(const __attribute__((address_space(1))) float*)kp[4]; }
  __device__ __forceinline__ const float* pool_scale() const { return (const float*)(const __attribute__((address_space(1))) float*)kp[5]; }
  __device__ __forceinline__ const float* pos_k() const { return (const float*)(const __attribute__((address_space(1))) float*)kp[6]; }
  __device__ __forceinline__ const float* pos_v() const { return (const float*)(const __attribute__((address_space(1))) float*)kp[7]; }
  __device__ __forceinline__ const float* w1k() const { return (const float*)(const __attribute__((address_space(1))) float*)kp[8]; }
  __device__ __forceinline__ const float* w2k() const { return (const float*)(const __attribute__((address_space(1))) float*)kp[9]; }
  __device__ __forceinline__ const float* w1v() const { return (const float*)(const __attribute__((address_space(1))) float*)kp[10]; }
  __device__ __forceinline__ const float* w2v() const { return (const float*)(const __attribute__((address_space(1))) float*)kp[11]; }
  __device__ __forceinline__ const float* wpa() const { return (const float*)(const __attribute__((address_space(1))) float*)kp[12]; }
  __device__ __forceinline__ const float* wpb() const { return (const float*)(const __attribute__((address_space(1))) float*)kp[13]; }
  __device__ __forceinline__ const float* wpc() const { return (const float*)(const __attribute__((address_space(1))) float*)kp[14]; }
  __device__ __forceinline__ const float* wo() const { return (const float*)(const __attribute__((address_space(1))) float*)kp[15]; }
  __device__ __forceinline__ const float* ln_g() const { return (const float*)(const __attribute__((address_space(1))) float*)kp[16]; }
  __device__ __forceinline__ const float* ln_b() const { return (const float*)(const __attribute__((address_space(1))) float*)kp[17]; }
  __device__ __forceinline__ float* out() const { return (float*)(__attribute__((address_space(1))) float*)kp[18]; }
  __device__ __forceinline__ char* ws() const { return (char*)(__attribute__((address_space(1))) char*)kp[19]; }
  __device__ __forceinline__ float* xr() const { return (float*)(ws() + OFF_xr); }
  __device__ __forceinline__ half_t* xh() const { return (half_t*)(ws() + OFF_xh); }
  __device__ __forceinline__ half_t* u() const { return (half_t*)(ws() + OFF_u); }
  __device__ __forceinline__ half_t* winT() const { return (half_t*)(ws() + OFF_winT); }
  __device__ __forceinline__ half_t* wpT() const { return (half_t*)(ws() + OFF_wpT); }
  __device__ __forceinline__ half_t* woT() const { return (half_t*)(ws() + OFF_woT); }
  __device__ __forceinline__ half_t* poolT() const { return (half_t*)(ws() + OFF_poolT); }
  __device__ __forceinline__ half_t* w1T() const { return (half_t*)(ws() + OFF_w1T); }
  __device__ __forceinline__ float* posb() const { return (float*)(ws() + OFF_posb); }
  __device__ __forceinline__ half_t* vsT() const { return (half_t*)(ws() + OFF_vsT); }
  __device__ __forceinline__ half_t* vwT() const { return (half_t*)(ws() + OFF_vwT); }
  __device__ __forceinline__ half_t* kcmp() const { return (half_t*)(ws() + OFF_kcmp); }
  __device__ __forceinline__ half_t* vcmpT() const { return (half_t*)(ws() + OFF_vcmpT); }
  __device__ __forceinline__ half_t* ya() const { return (half_t*)(ws() + OFF_ya); }
  __device__ __forceinline__ half_t* yb() const { return (half_t*)(ws() + OFF_yb); }
  __device__ __forceinline__ half_t* yc() const { return (half_t*)(ws() + OFF_yc); }
  __device__ __forceinline__ half_t* mm() const { return (half_t*)(ws() + OFF_mm); }
  __device__ __forceinline__ int* counters() const { return (int*)(ws() + OFF_counters); }
};
__device__ __forceinline__ KP get_params() {
  KP q;
  q.kp = (kargp_t)__builtin_amdgcn_kernarg_segment_ptr();
  asm volatile("" : "+s"(q.kp));
  return q;
}


__device__ __forceinline__ int orig_col(int n) {
  if (n < 1536) return n;
  if (n < 2048) return 1664 + (n - 1536);
  if (n < 2560) return 2472 + (n - 2048);
  if (n < 3072) return 3776 + (n - 2560);
  if (n < 6144) return 4288 + (n - 3072);
  if (n < 6400) return 2176 + (n - 6144);
  if (n < 7168) return 2984 + (n - 6400);
  if (n < 7296) return 1536 + (n - 7168);
  if (n < 7328) return 2432 + (n - 7296);
  if (n < 7336) return 2464 + (n - 7328);
  if (n < 7360) return 3752 + (n - 7336);
  return -1;
}

__device__ __forceinline__ float wave_sum(float v) {
#pragma unroll
  for (int o = 32; o > 0; o >>= 1) v += __shfl_xor(v, o);
  return v;
}
__device__ __forceinline__ float sigmoidf_(float x) { return 1.f / (1.f + __expf(-x)); }
__device__ __forceinline__ float siluf_(float x) { return x / (1.f + __expf(-x)); }

template <int NI, class LA, class LB, class EP>
__device__ __forceinline__ void gemm_tile(int K, LA loadA, LB loadB, EP epi, char* smem) {
  constexpr int BN = NI * 64;
  constexpr int NB = BN / 32;
  half_t* sA = (half_t*)smem;
  half_t* sB = sA + 128 * 72;
  int tid = threadIdx.x;
  asm volatile("" : "+v"(tid));
  const int lane = tid & 63, wid = tid >> 6;
  const int wm = wid >> 1, wn = wid & 1;
  f32x16 acc[2][NI];
#pragma unroll
  for (int i = 0; i < 2; ++i)
#pragma unroll
    for (int j = 0; j < NI; ++j)
#pragma unroll
      for (int r = 0; r < 16; ++r) acc[i][j][r] = 0.f;
  const int lr = tid >> 3, lc = (tid & 7) * 8;
  uint4 ra[4], rb[NB];
#pragma unroll
  for (int i = 0; i < 4; ++i) ra[i] = loadA(lr + 32 * i, lc);
#pragma unroll
  for (int i = 0; i < NB; ++i) rb[i] = loadB(lr + 32 * i, lc);
  const int nk = K >> 6;
  for (int kt = 0; kt < nk; ++kt) {
    __syncthreads();
#pragma unroll
    for (int i = 0; i < 4; ++i) *(uint4*)&sA[(lr + 32 * i) * 72 + lc] = ra[i];
#pragma unroll
    for (int i = 0; i < NB; ++i) *(uint4*)&sB[(lr + 32 * i) * 72 + lc] = rb[i];
    __syncthreads();
    if (kt + 1 < nk) {
      const int kk = (kt + 1) * 64 + lc;
#pragma unroll
      for (int i = 0; i < 4; ++i) ra[i] = loadA(lr + 32 * i, kk);
#pragma unroll
      for (int i = 0; i < NB; ++i) rb[i] = loadB(lr + 32 * i, kk);
    }
#pragma unroll
    for (int s = 0; s < 4; ++s) {
      h8 af[2], bf[NI];
#pragma unroll
      for (int mi = 0; mi < 2; ++mi)
        af[mi] = *(const h8*)&sA[(wm * 64 + mi * 32 + (lane & 31)) * 72 + s * 16 + (lane >> 5) * 8];
#pragma unroll
      for (int ni = 0; ni < NI; ++ni)
        bf[ni] = *(const h8*)&sB[(wn * (NI * 32) + ni * 32 + (lane & 31)) * 72 + s * 16 + (lane >> 5) * 8];
#pragma unroll
      for (int mi = 0; mi < 2; ++mi)
#pragma unroll
        for (int ni = 0; ni < NI; ++ni)
          acc[mi][ni] = __builtin_amdgcn_mfma_f32_32x32x16_f16(af[mi], bf[ni], acc[mi][ni], 0, 0, 0);
    }
  }
#pragma unroll
  for (int mi = 0; mi < 2; ++mi)
#pragma unroll
    for (int ni = 0; ni < NI; ++ni)
#pragma unroll
      for (int r = 0; r < 16; ++r) {
        const int row = wm * 64 + mi * 32 + (r & 3) + 8 * (r >> 2) + 4 * (lane >> 5);
        const int col = wn * (NI * 32) + ni * 32 + (lane & 31);
        epi(mi, ni, r, row, col, acc[mi][ni][r]);
      }
}

template <class LA, class LB, class EP>
__device__ __forceinline__ void gemm_tile_big(int K, LA loadA, LB loadB, EP epi, char* smem) {
  half_t* sA = (half_t*)smem;
  half_t* sB = sA + 256 * 72;
  int tid = threadIdx.x;
  asm volatile("" : "+v"(tid));
  const int lane = tid & 63, wid = tid >> 6;
  const int wm = wid >> 1, wn = wid & 1;
  f32x16 acc[4][2];
#pragma unroll
  for (int i = 0; i < 4; ++i)
#pragma unroll
    for (int j = 0; j < 2; ++j)
#pragma unroll
      for (int r = 0; r < 16; ++r) acc[i][j][r] = 0.f;
  const int lr = tid >> 3, lc = (tid & 7) * 8;
  uint4 ra[8], rb[4];
#pragma unroll
  for (int i = 0; i < 8; ++i) ra[i] = loadA(lr + 32 * i, lc);
#pragma unroll
  for (int i = 0; i < 4; ++i) rb[i] = loadB(lr + 32 * i, lc);
  const int nk = K >> 6;
  for (int kt = 0; kt < nk; ++kt) {
    __syncthreads();
#pragma unroll
    for (int i = 0; i < 8; ++i) *(uint4*)&sA[(lr + 32 * i) * 72 + lc] = ra[i];
#pragma unroll
    for (int i = 0; i < 4; ++i) *(uint4*)&sB[(lr + 32 * i) * 72 + lc] = rb[i];
    __syncthreads();
    if (kt + 1 < nk) {
      const int kk = (kt + 1) * 64 + lc;
#pragma unroll
      for (int i = 0; i < 8; ++i) ra[i] = loadA(lr + 32 * i, kk);
#pragma unroll
      for (int i = 0; i < 4; ++i) rb[i] = loadB(lr + 32 * i, kk);
    }
#pragma unroll
    for (int s = 0; s < 4; ++s) {
      h8 af[4], bf[2];
#pragma unroll
      for (int mi = 0; mi < 4; ++mi)
        af[mi] = *(const h8*)&sA[(wm * 128 + mi * 32 + (lane & 31)) * 72 + s * 16 + (lane >> 5) * 8];
#pragma unroll
      for (int ni = 0; ni < 2; ++ni)
        bf[ni] = *(const h8*)&sB[(wn * 64 + ni * 32 + (lane & 31)) * 72 + s * 16 + (lane >> 5) * 8];
#pragma unroll
      for (int mi = 0; mi < 4; ++mi)
#pragma unroll
        for (int ni = 0; ni < 2; ++ni)
          acc[mi][ni] = __builtin_amdgcn_mfma_f32_32x32x16_f16(af[mi], bf[ni], acc[mi][ni], 0, 0, 0);
    }
  }
#pragma unroll
  for (int mi = 0; mi < 4; ++mi)
#pragma unroll
    for (int ni = 0; ni < 2; ++ni)
#pragma unroll
      for (int r = 0; r < 16; ++r) {
        const int row = wm * 128 + mi * 32 + (r & 3) + 8 * (r >> 2) + 4 * (lane >> 5);
        const int col = wn * 64 + ni * 32 + (lane & 31);
        epi(mi, ni, r, row, col, acc[mi][ni][r]);
      }
}

template <class CM>
__device__ __forceinline__ void tconv_tile(const float* __restrict__ src, int lds_, half_t* __restrict__ dst, int ldd,
                                           int n0, int k0, CM cmap, char* smem) {
  float* t = (float*)smem;
  int tid = threadIdx.x;
  asm volatile("" : "+v"(tid));
  {
    const int n = tid & 63;
    const int c = cmap(n0 + n);
    float tv[16];
#pragma unroll
    for (int i = 0; i < 16; ++i) {
      const int k = (tid >> 6) + 4 * i;
      tv[i] = (c >= 0) ? src[(size_t)(k0 + k) * lds_ + c] : 0.f;
    }
#pragma unroll
    for (int i = 0; i < 16; ++i) {
      const int k = (tid >> 6) + 4 * i;
      t[k * 65 + n] = tv[i];
    }
  }
  __syncthreads();
#pragma unroll
  for (int i = 0; i < 2; ++i) {
    const int idx = tid + 256 * i;
    const int n = idx >> 3, kc = (idx & 7) * 8;
    h8 v;
#pragma unroll
    for (int j = 0; j < 8; ++j) v[j] = (half_t)t[(kc + j) * 65 + n];
    *(h8*)&dst[(size_t)(n0 + n) * ldd + k0 + kc] = v;
  }
  __syncthreads();
}

__device__ __forceinline__ void ln_rows(const KP& p, int lprev, bool final_) {
  int tid = threadIdx.x;
  asm volatile("" : "+v"(tid));
  const int lane = tid & 63, wid = tid >> 6;
  const int gw = blockIdx.x * 4 + wid, nw = gridDim.x * 4;
  for (int row = gw; row < NTOK; row += nw) {
    const float4* rp = (const float4*)((lprev < 0 ? p.x() : (const float*)p.u()) + (size_t)row * DM);
    float4 v[4];
    float s = 0.f;
#pragma unroll
    for (int i = 0; i < 4; ++i) {
      v[i] = rp[lane + 64 * i];
      s += v[i].x + v[i].y + v[i].z + v[i].w;
    }
    if (lprev >= 0) {
      float mu = wave_sum(s) * (1.f / DM);
      float q = 0.f;
#pragma unroll
      for (int i = 0; i < 4; ++i) {
        float a = v[i].x - mu, b = v[i].y - mu, c = v[i].z - mu, d = v[i].w - mu;
        q += a * a + b * b + c * c + d * d;
      }
      float rstd = rsqrtf(wave_sum(q) * (1.f / DM) + 1e-5f);
      const float4* g4 = (const float4*)(p.ln_g() + lprev * DM);
      const float4* b4 = (const float4*)(p.ln_b() + lprev * DM);
#pragma unroll
      for (int i = 0; i < 4; ++i) {
        float4 g = g4[lane + 64 * i], bb = b4[lane + 64 * i];
        v[i].x = (v[i].x - mu) * rstd * g.x + bb.x;
        v[i].y = (v[i].y - mu) * rstd * g.y + bb.y;
        v[i].z = (v[i].z - mu) * rstd * g.z + bb.z;
        v[i].w = (v[i].w - mu) * rstd * g.w + bb.w;
      }
    }
    if (final_) {
      float4* op = (float4*)(p.out() + (size_t)row * DM);
#pragma unroll
      for (int i = 0; i < 4; ++i) op[lane + 64 * i] = v[i];
    } else {
      float4* op = (float4*)(p.xr() + (size_t)row * DM);
      h4* hp = (h4*)(p.xh() + (size_t)row * DM);
#pragma unroll
      for (int i = 0; i < 4; ++i) {
        op[lane + 64 * i] = v[i];
        h4 hv;
        hv[0] = (half_t)v[i].x; hv[1] = (half_t)v[i].y; hv[2] = (half_t)v[i].z; hv[3] = (half_t)v[i].w;
        hp[lane + 64 * i] = hv;
      }
    }
  }
}

__device__ __forceinline__ void prep_weights(const KP& p, int l, char* smem) {
  int tid = threadIdx.x;
  asm volatile("" : "+v"(tid));
  const int total = 1856 + 384 + 256 + 16 + 64 + 2;
  for (int it = blockIdx.x; it < total; it += gridDim.x) {
    if (it < 1856) {
      const int nt = it >> 4, kt = it & 15;
      tconv_tile(p.w_in() + (size_t)l * DM * NIN, NIN, p.winT(), DM, nt * 64, kt * 64,
                 [](int n) { return orig_col(n); }, smem);
    } else if (it < 1856 + 384) {
      const int j = it - 1856;
      const int w = j >> 7, r = j & 127, nt = r >> 3, kt = r & 7;
      const float* src = (w == 0 ? p.wpa() : (w == 1 ? p.wpb() : p.wpc())) + (size_t)l * 512 * DM;
      tconv_tile(src, DM, p.wpT() + (size_t)w * DM * 512, 512, nt * 64, kt * 64, [](int n) { return n; }, smem);
    } else if (it < 1856 + 384 + 256) {
      const int j = it - 1856 - 384;
      const int nt = j >> 4, kt = j & 15;
      tconv_tile(p.wo() + (size_t)l * DM * DM, DM, p.woT(), DM, nt * 64, kt * 64, [](int n) { return n; }, smem);
    } else if (it < 1856 + 384 + 256 + 16) {
      const int j = it - 1856 - 384 - 256;
      const int g = j >> 2, nt = (j >> 1) & 1, kt = j & 1;
      tconv_tile(p.pool_w() + ((size_t)l * 4 + g) * 128 * 128, 128, p.poolT() + (size_t)g * 128 * 128, 128, nt * 64,
                 kt * 64, [](int n) { return n; }, smem);
    } else if (it < 1856 + 384 + 256 + 16 + 64) {
      const int j = it - 1856 - 384 - 256 - 16;
      const int kv = j >> 5, kt = j & 31;
      const float* src = (kv ? p.w1v() : p.w1k()) + (size_t)l * 2048 * 64;
      tconv_tile(src, 64, p.w1T() + (size_t)kv * 64 * 2048, 2048, 0, kt * 64, [](int n) { return n; }, smem);
    } else {
      const int kv = it - (1856 + 384 + 256 + 16 + 64);
      const float* w1 = (kv ? p.w1v() : p.w1k()) + (size_t)l * 2048 * 64;
      const float* pos = (kv ? p.pos_v() : p.pos_k()) + (size_t)l * 2048;
      float* red = (float*)smem;
      const int e = tid & 63, part = tid >> 6;
      float sa = 0.f, sb = 0.f, sc_ = 0.f, sd = 0.f;
      const float* wq = w1 + (size_t)part * 512 * 64 + e;
      const float* pq = pos + part * 512;
#pragma unroll 4
      for (int f = 0; f < 512; f += 4) {
        sa += pq[f] * wq[(size_t)f * 64];
        sb += pq[f + 1] * wq[(size_t)(f + 1) * 64];
        sc_ += pq[f + 2] * wq[(size_t)(f + 2) * 64];
        sd += pq[f + 3] * wq[(size_t)(f + 3) * 64];
      }
      const float s = (sa + sb) + (sc_ + sd);
      red[tid] = s;
      __syncthreads();
      if (tid < 64) p.posb()[kv * 64 + tid] = red[tid] + red[tid + 64] + red[tid + 128] + red[tid + 192];
      __syncthreads();
    }
  }
}

template <class F>
__device__ __forceinline__ void xcd_schedule(int* q, int xcc, int ngroups, int gsize, char* smem, F f) {
  int* s_item = (int*)(smem + SMEM_BYTES - 16);
  int* s_flag = (int*)(smem + SMEM_BYTES - 96);
  int* flags = q + 32;
#pragma unroll 1
  for (int dy = 0; dy < 8; ++dy) {
    const int y = (xcc + dy) & 7;
    if (dy == 1) {
      int t8 = threadIdx.x;
      asm volatile("" : "+v"(t8));
      if (t8 < 8) s_flag[t8] = __hip_atomic_load(&flags[t8], __ATOMIC_RELAXED, __HIP_MEMORY_SCOPE_AGENT);
      __syncthreads();
    }
    if (dy >= 1 && __builtin_amdgcn_readfirstlane(s_flag[y]) != 0) continue;
    for (;;) {
      if (threadIdx.x == 0) *s_item = atomicAdd(&q[y], 1);
      __syncthreads();
      const int i = __builtin_amdgcn_readfirstlane(*s_item);
      __syncthreads();
      const int grp = (i / gsize) * 8 + y;
      if (grp >= ngroups) {
        if (threadIdx.x == 0) __hip_atomic_store(&flags[y], 1, __ATOMIC_RELAXED, __HIP_MEMORY_SCOPE_AGENT);
        break;
      }
      f(grp, i % gsize);
    }
  }
}

__device__ __forceinline__ void phase_inproj(const KP& p, int l, char* smem, int* q, int xcc) {
  const float* bias = p.b_in() + (size_t)l * NIN;
  xcd_schedule(q, xcc, 128, 32, smem, [&](int grp, int within) __attribute__((always_inline)) {
    const int mt = (grp & 15) * 4 + (within & 3), nt = (grp >> 4) * 8 + (within >> 2);
    if (nt >= 58) return;
    const int m0 = mt * 256, n0 = nt * 128;
    const half_t* A = p.xh() + (size_t)m0 * DM;
    const half_t* B = p.winT() + (size_t)n0 * DM;
    int tidx = threadIdx.x;
    asm volatile("" : "+v"(tidx));
    const int lane = tidx & 63, wn = (tidx >> 6) & 1;
    float bv[2];
#pragma unroll
    for (int ni = 0; ni < 2; ++ni) {
      const int oc = orig_col(n0 + wn * 64 + ni * 32 + (lane & 31));
      bv[ni] = oc >= 0 ? bias[oc] : 0.f;
    }
    half_t* vT = (nt == 53) ? p.vsT() : ((nt == 55) ? p.vwT() : nullptr);
    gemm_tile_big(
        DM, [&](int r, int k) { return *(const uint4*)(A + (size_t)r * DM + k); },
        [&](int r, int k) { return *(const uint4*)(B + (size_t)r * DM + k); },
        [&](int mi, int ni, int r, int row, int col, float v) {
          const half_t hv = (half_t)(v + bv[ni]);
          const int tok = m0 + row;
          p.u()[(size_t)tok * NU + n0 + col] = hv;
          if (vT) {
            const int b = tok >> 13, t = tok & 8191;
            vT[((size_t)(b * 2 + (col >> 6)) * 64 + (col & 63)) * SEQ + t] = hv;
          }
        },
        smem);
  });
}

__device__ __forceinline__ void pool_item(const KP& p, int l, int item, char* smem) {
  const int g = item & 3, mt = item >> 2;
  const int m0 = mt * 128;
  const int wnd = 2 << g;
  const half_t* B = p.poolT() + (size_t)g * 128 * 128;
  int tidx = threadIdx.x;
  asm volatile("" : "+v"(tidx));
  const int lane = tidx & 63, wn = (tidx >> 6) & 1;
  float pb[2], ps[2];
#pragma unroll
  for (int ni = 0; ni < 2; ++ni) {
    const int d = wn * 64 + ni * 32 + (lane & 31);
    pb[ni] = p.pool_b()[(size_t)l * 512 + g * 128 + d];
    ps[ni] = p.pool_scale()[(size_t)l * 512 + g * 128 + d];
  }
  gemm_tile<2>(
      128,
      [&](int r, int k) {
        const int tok = m0 + r, t = tok & 8191;
        const int cnt = min(t + 1, wnd);
        const half_t* base = p.u() + (size_t)tok * NU + C_AX + g * 128 + k;
        float s[8];
#pragma unroll
        for (int j = 0; j < 8; ++j) s[j] = 0.f;
        h8 cur = *(const h8*)base;
        for (int q0 = 0; q0 < wnd; q0 += 8) {
          h8 v[8];
#pragma unroll
          for (int i = 0; i < 8; ++i) {
            const int qq = q0 + i;
            if (qq < cnt) v[i] = *(const h8*)(base - (size_t)qq * NU);
            else {
#pragma unroll
              for (int j = 0; j < 8; ++j) v[i][j] = (half_t)0.f;
            }
          }
#pragma unroll
          for (int i = 0; i < 8; ++i)
#pragma unroll
            for (int j = 0; j < 8; ++j) s[j] += (float)v[i][j];
        }
        const float inv = 1.f / (float)cnt;
        h8 o;
#pragma unroll
        for (int j = 0; j < 8; ++j) o[j] = (half_t)(s[j] * inv - (float)cur[j]);
        return *(uint4*)&o;
      },
      [&](int r, int k) { return *(const uint4*)(B + (size_t)r * 128 + k); },
      [&](int mi, int ni, int r, int row, int col, float v) {
        const int tok = m0 + row;
        const float z = (float)p.u()[(size_t)tok * NU + C_AZ + g * 128 + col];
        p.ya()[(size_t)tok * 512 + g * 128 + col] = (half_t)((v + pb[ni]) * ps[ni] * siluf_(z));
      },
      smem);
}

__device__ __forceinline__ void compress_item(const KP& p, int l, int item, char* smem) {
  const int mt = item & 3, kv = (item >> 2) & 1, g = (item >> 3) & 1, b = item >> 4;
  int tid = threadIdx.x;
  asm volatile("" : "+v"(tid));
  const int ccol = (kv ? C_CVC : C_CKC) + g * 64;
  const half_t* ub = p.u() + (size_t)b * SEQ * NU + ccol;
  const half_t* B = p.w1T() + (size_t)kv * 64 * 2048;
  float* hid = (float*)(smem + 28672);
  const float* posb = p.posb() + kv * 64;
  gemm_tile<1>(
      2048,
      [&](int r, int k) {
        const int n = mt * 128 + r;
        if (n >= 511) return make_uint4(0, 0, 0, 0);
        const int tok = 16 * n + (k >> 6);
        return *(const uint4*)(ub + (size_t)tok * NU + (k & 63));
      },
      [&](int r, int k) { return *(const uint4*)(B + (size_t)r * 2048 + k); },
      [&](int mi, int ni, int r, int row, int col, float v) { hid[row * 65 + col] = siluf_(v + posb[col]); }, smem);
  __syncthreads();
  float* w2s = (float*)smem;
  const float* w2 = (kv ? p.w2v() : p.w2k()) + (size_t)l * 4096;
  for (int i = tid; i < 4096; i += 256) w2s[i] = w2[i];
  __syncthreads();
  {
    const int n = tid >> 1, fh = (tid & 1) * 32;
    float acc[32];
#pragma unroll
    for (int f = 0; f < 32; ++f) acc[f] = 0.f;
    for (int e = 0; e < 64; ++e) {
      const float hv = hid[n * 65 + e];
#pragma unroll
      for (int f = 0; f < 32; ++f) acc[f] += hv * w2s[e * 64 + fh + f];
    }
    const int ng = mt * 128 + n;
    const bool valid = ng < 511;
    if (kv == 0) {
      half_t* dst = p.kcmp() + ((size_t)(b * 2 + g) * 512 + ng) * 64 + fh;
#pragma unroll
      for (int f = 0; f < 32; ++f) dst[f] = valid ? (half_t)acc[f] : (half_t)0.f;
    } else {
      half_t* dst = p.vcmpT() + ((size_t)(b * 2 + g) * 64 + fh) * 512 + ng;
#pragma unroll
      for (int f = 0; f < 32; ++f) dst[(size_t)f * 512] = valid ? (half_t)acc[f] : (half_t)0.f;
    }
  }
  __syncthreads();
}

#ifndef DSA_CAP
#define DSA_CAP 128
#endif
__device__ __forceinline__ void dsa_item(const KP& p, int b, int tile, char* smem) {
  const int t0 = tile * 16;
  int tid = threadIdx.x;
  asm volatile("" : "+v"(tid));
  const int lane = tid & 63, wid = tid >> 6;
  uint32_t* hist = (uint32_t*)smem;
  unsigned long long* cand = (unsigned long long*)(smem + 16384);
  unsigned short* sel = (unsigned short*)(smem + 32768);
  unsigned long long* pfx = (unsigned long long*)(smem + 40960);
  unsigned long long* tkey = pfx + 16;
  int* need = (int*)(tkey + 16);
  int* state = need + 16;
  int* cnt = state + 16;
  int* ccnt = cnt + 16;
  int* pf16 = ccnt + 16;
  int* ovf = pf16 + 16;
  int* nrem = ovf + 16;
  int* fastf = nrem + 8;
  uint32_t* h1w = (uint32_t*)(smem + 43008);
  float* pbuf = (float*)smem + wid * 2048;

  const half_t* ub = p.u() + (size_t)b * SEQ * NU;
  const int mytok = lane & 15, hq = lane >> 4;
  const int myt = t0 + mytok;
  if (tid < 16) {
    const int t = t0 + tid;
    pfx[tid] = 0ull; tkey[tid] = 0ull; need[tid] = 256; state[tid] = (t < 256) ? 0 : 1; cnt[tid] = 0; ccnt[tid] = 0;
    pf16[tid] = 0; ovf[tid] = 0;
  }
  if (tid < 8) nrem[tid] = 0;
  if (tid < 16) fastf[tid] = 0;
  for (int i = tid; i < 6144; i += 256) h1w[i] = 0u;
  h8 qf[8], qlh, qll;
  float iw[8];
  {
    const half_t* qrow = ub + (size_t)myt * NU;
#pragma unroll
    for (int h = 0; h < 8; ++h) qf[h] = *(const h8*)(qrow + C_IQ + h * 32 + hq * 8);
    const h8 w8 = *(const h8*)(qrow + C_IW);
#pragma unroll
    for (int h = 0; h < 8; ++h) iw[h] = (float)w8[h] * 0.03125f;
#pragma unroll
    for (int e = 0; e < 8; ++e) {
      float a = 0.f;
#pragma unroll
      for (int h = 0; h < 8; ++h) a += iw[h] * (float)qf[h][e];
      const half_t hi = (half_t)a;
      qlh[e] = hi;
      qll[e] = (half_t)(a - (float)hi);
    }
  }
  __syncthreads();
  const int nkt = (t0 + 16 + 31) >> 5;

  auto loadk = [&](int kt, h8* a) __attribute__((always_inline)) {
#pragma unroll
    for (int i = 0; i < 2; ++i)
      a[i] = *(const h8*)(ub + (size_t)(kt * 32 + i * 16 + (lane & 15)) * NU + C_IK + hq * 8);
  };
  auto scores = [&](const h8* a, float* sc) __attribute__((always_inline)) {
#pragma unroll
    for (int i = 0; i < 2; ++i) {
      f32x4 acc = {0.f, 0.f, 0.f, 0.f};
      acc = __builtin_amdgcn_mfma_f32_16x16x32_f16(a[i], qll, acc, 0, 0, 0);
      acc = __builtin_amdgcn_mfma_f32_16x16x32_f16(a[i], qlh, acc, 0, 0, 0);
#pragma unroll
      for (int h = 0; h < 8; ++h) {
        f32x4 d = {0.f, 0.f, 0.f, 0.f};
        d = __builtin_amdgcn_mfma_f32_16x16x32_f16(a[i], qf[h], d, 0, 0, 0);
#pragma unroll
        for (int r = 0; r < 4; ++r) acc[r] = __builtin_fmaf(__builtin_fabsf(d[r]), iw[h], acc[r]);
      }
#pragma unroll
      for (int r = 0; r < 4; ++r) sc[i * 4 + r] = acc[r];
    }
  };
  auto skey = [&](float s) __attribute__((always_inline)) -> uint32_t {
    s = s + 0.f;
    const uint32_t u_ = __float_as_uint(s);
    return (u_ & 0x80000000u) ? ~u_ : (u_ | 0x80000000u);
  };
  auto mkkey = [&](float s, int key) __attribute__((always_inline)) -> unsigned long long {
    s = s + 0.f;
    uint32_t u_ = __float_as_uint(s);
    u_ = (u_ & 0x80000000u) ? ~u_ : (u_ | 0x80000000u);
    return ((unsigned long long)u_ << 16) | (unsigned long long)(8191 - key);
  };
  auto scan_token = [&](int tk, int level) __attribute__((always_inline)) -> bool {
    const int shift = 40 - 8 * level;
    const uint32_t* hrow = hist + tk * 256;
    const uint4 hv = *(const uint4*)&hrow[252 - 4 * lane];
    const int c = (int)(hv.x + hv.y + hv.z + hv.w);
    int cum = c;
#pragma unroll
    for (int o = 1; o < 64; o <<= 1) {
      int v = __shfl_up(cum, o);
      if (lane >= o) cum += v;
    }
    const int nd = need[tk];
    const unsigned long long mask = __ballot(cum >= nd);
    const int L = mask ? (int)__builtin_ctzll(mask) : 63;
    int running = cum - c, bstar, cb;
    if (running + (int)hv.w >= nd) { bstar = 255 - 4 * lane; cb = hv.w; }
    else {
      running += hv.w;
      if (running + (int)hv.z >= nd) { bstar = 254 - 4 * lane; cb = hv.z; }
      else {
        running += hv.z;
        if (running + (int)hv.y >= nd) { bstar = 253 - 4 * lane; cb = hv.y; }
        else { running += hv.y; bstar = 252 - 4 * lane; cb = hv.x; }
      }
    }
    running = __shfl(running, L); bstar = __shfl(bstar, L); cb = __shfl(cb, L);
    const int nd2 = nd - running;
    const bool fin = (cb == nd2) || (level == 5);
    if (lane == 0) {
      const unsigned long long np = (pfx[tk] << 8) | (unsigned long long)bstar;
      if (fin) { state[tk] = 0; tkey[tk] = np << shift; }
      else { need[tk] = nd2; pfx[tk] = np; }
    }
    return fin;
  };
  auto run_level = [&](int level, bool fillx) __attribute__((always_inline)) {
    const int shift = 40 - 8 * level;
    for (int i = tid; i < 4096; i += 256) hist[i] = 0u;
    __syncthreads();
    {
      const unsigned long long mypfx = pfx[mytok];
      const bool act = state[mytok] == 1 && fastf[mytok] == 0;
      h8 na[2];
      if (wid < nkt) loadk(wid, na);
      for (int kt = wid; kt < nkt; kt += 4) {
        h8 ca[2];
#pragma unroll
        for (int i = 0; i < 2; ++i) ca[i] = na[i];
        loadk(kt + 4 < nkt ? kt + 4 : kt, na);
        float sc[8];
        scores(ca, sc);
        if (act) {
#pragma unroll
          for (int q = 0; q < 8; ++q) {
            const int key = kt * 32 + (q >> 2) * 16 + 4 * hq + (q & 3);
            if (key <= myt) {
              if (level < 2) {
                const uint32_t u32 = skey(sc[q]);
                if (level == 0) {
                  const uint32_t b8 = u32 >> 24;
                  atomicAdd(&hist[mytok * 256 + (int)b8], 1u);
                  if (fillx) {
                    const uint32_t ix = b8 - 0xBEu;
                    if (ix < 3u) {
                      const uint32_t e16 = (ix * 16u + (uint32_t)mytok) * 256u + ((u32 >> 16) & 255u);
                      atomicAdd(&h1w[e16 >> 1], (e16 & 1u) ? 65536u : 1u);
                    }
                  }
                } else if ((u32 >> 24) == (uint32_t)mypfx) atomicAdd(&hist[mytok * 256 + (int)((u32 >> 16) & 255u)], 1u);
              } else {
                const unsigned long long k48 = mkkey(sc[q], key);
                if ((k48 >> (shift + 8)) == mypfx)
                  atomicAdd(&hist[mytok * 256 + (int)((k48 >> shift) & 255ull)], 1u);
              }
            }
          }
        }
      }
    }
    __syncthreads();
    {
      int rem = 0;
      for (int j = 0; j < 4; ++j) {
        const int tk = wid * 4 + j;
        if (state[tk] != 1 || fastf[tk] != 0) continue;
        if (!scan_token(tk, level)) rem++;
      }
      if (lane == 0 && rem) atomicAdd(&nrem[level], rem);
    }
    __syncthreads();
  };

  run_level(0, true);
  if (tid < 16) {
    const int b0 = (int)pfx[tid];
    const int f = (state[tid] == 1 && b0 >= 0xBE && b0 <= 0xC0) ? 1 : 0;
    fastf[tid] = f;
    if (state[tid] == 1 && !f) atomicAdd(&nrem[7], 1);
  }
  __syncthreads();
  if (nrem[7] != 0) run_level(1, false);
  for (int j = 0; j < 4; ++j) {
    const int tk = wid * 4 + j;
    if (state[tk] != 1 || fastf[tk] == 0) continue;
    const uint32_t ix = (uint32_t)pfx[tk] - 0xBEu;
    const unsigned short* hx = (const unsigned short*)h1w + (ix * 16u + (uint32_t)tk) * 256u;
    const ushort4 c4 = *(const ushort4*)&hx[4 * lane];
    uint4 w4;
    w4.x = c4.x; w4.y = c4.y; w4.z = c4.z; w4.w = c4.w;
    *(uint4*)&hist[tk * 256 + 4 * lane] = w4;
    __builtin_amdgcn_wave_barrier();
    scan_token(tk, 1);
  }
  __syncthreads();
  if (tid < 16) fastf[tid] = 0;
  __syncthreads();

  {
    const int st0 = state[mytok];
    const unsigned long long mytk = tkey[mytok];
    const unsigned long long myp16 = pfx[mytok];
    h8 na[2];
    if (wid < nkt) loadk(wid, na);
    for (int kt = wid; kt < nkt; kt += 4) {
      h8 ca[2];
#pragma unroll
      for (int i = 0; i < 2; ++i) ca[i] = na[i];
      loadk(kt + 4 < nkt ? kt + 4 : kt, na);
      float sc[8];
      scores(ca, sc);
#pragma unroll
      for (int q = 0; q < 8; ++q) {
        const int key = kt * 32 + (q >> 2) * 16 + 4 * hq + (q & 3);
        if (key <= myt) {
          const uint32_t u32 = skey(sc[q]);
          bool take, isc = false;
          if (st0 == 0) take = (((unsigned long long)u32 << 16) | (unsigned long long)(8191 - key)) >= mytk;
          else {
            const uint32_t p16 = u32 >> 16;
            take = p16 > (uint32_t)myp16;
            isc = p16 == (uint32_t)myp16;
          }
          if (take) {
            const int pos = atomicAdd(&cnt[mytok], 1);
            if (pos < 256) sel[mytok * 256 + pos] = (unsigned short)key;
          } else if (isc) {
            const int pos = atomicAdd(&ccnt[mytok], 1);
            if (pos < DSA_CAP) cand[mytok * 128 + pos] = ((unsigned long long)u32 << 16) | (unsigned long long)(8191 - key);
          }
        }
      }
    }
  }
  __syncthreads();
  {
    int nov = 0;
    for (int j = 0; j < 4; ++j) {
      const int tk = wid * 4 + j;
      if (state[tk] != 1) continue;
      const int nc = ccnt[tk];
      if (nc > DSA_CAP) {
        nov++;
        if (lane == 0) { ovf[tk] = 1; pf16[tk] = (int)pfx[tk]; }
        continue;
      }
      const int nd = need[tk];
      const unsigned long long k0 = (lane < nc) ? cand[tk * 128 + lane] : 0ull;
      const unsigned long long k1 = (lane + 64 < nc) ? cand[tk * 128 + lane + 64] : 0ull;
      int r0 = 0, r1 = 0;
      for (int q = 0; q < nc; ++q) {
        const unsigned long long kq = cand[tk * 128 + q];
        r0 += (kq > k0) ? 1 : 0;
        r1 += (kq > k1) ? 1 : 0;
      }
      if (lane < nc && r0 < nd) {
        const int pos = atomicAdd(&cnt[tk], 1);
        if (pos < 256) sel[tk * 256 + pos] = (unsigned short)(8191 - (int)(k0 & 0xFFFFull));
      }
      if (lane + 64 < nc && r1 < nd) {
        const int pos = atomicAdd(&cnt[tk], 1);
        if (pos < 256) sel[tk * 256 + pos] = (unsigned short)(8191 - (int)(k1 & 0xFFFFull));
      }
      if (lane == 0) state[tk] = 2;
    }
    if (lane == 0 && nov) atomicAdd(&nrem[6], nov);
  }
  __syncthreads();
  if (nrem[6] != 0) {
    for (int level = 2; level < 6; ++level) {
      run_level(level, false);
      if (nrem[level] == 0) break;
    }
    {
      const bool mine = ovf[mytok] != 0;
      const unsigned long long mytk = tkey[mytok];
      const unsigned long long myp16 = (unsigned long long)(unsigned)pf16[mytok];
      h8 na[2];
      if (wid < nkt) loadk(wid, na);
      for (int kt = wid; kt < nkt; kt += 4) {
        h8 ca[2];
#pragma unroll
        for (int i = 0; i < 2; ++i) ca[i] = na[i];
        loadk(kt + 4 < nkt ? kt + 4 : kt, na);
        float sc[8];
        scores(ca, sc);
        if (mine) {
#pragma unroll
          for (int q = 0; q < 8; ++q) {
            const int key = kt * 32 + (q >> 2) * 16 + 4 * hq + (q & 3);
            if (key <= myt) {
              const unsigned long long k48 = mkkey(sc[q], key);
              if ((k48 >> 32) == myp16 && k48 >= mytk) {
                const int pos = atomicAdd(&cnt[mytok], 1);
                if (pos < 256) sel[mytok * 256 + pos] = (unsigned short)key;
              }
            }
          }
        }
      }
    }
    __syncthreads();
  }
#ifndef DSA_ATT_REP
#define DSA_ATT_REP 1
#endif
  for (int jr = 0; jr < 4 * DSA_ATT_REP; ++jr) {
    const int j = jr & 3;
    const int tk = wid * 4 + j;
    const int t = t0 + tk;
    const int nsel = min(cnt[tk], 256);
    const half_t* urow = ub + (size_t)t * NU;
    const int col = lane & 15;
    h8 q0, q1;
#pragma unroll
    for (int e = 0; e < 8; ++e) { q0[e] = (half_t)0.f; q1[e] = (half_t)0.f; }
    if (col < 8) {
      q0 = *(const h8*)(urow + C_BQ + col * 64 + hq * 8);
      q1 = *(const h8*)(urow + C_BQ + col * 64 + 32 + hq * 8);
    }
    float mx = NEGF;
#pragma unroll 1
    for (int mg = 0; mg < 2; ++mg) {
#pragma unroll
      for (int mm = 0; mm < 8; ++mm) {
        const int m = mg * 8 + mm;
        const int pos = m * 16 + col;
        const int s = (pos < nsel) ? (int)sel[tk * 256 + pos] : 0;
        const half_t* kp = ub + (size_t)s * NU + C_BK + hq * 8;
        const h8 a0 = *(const h8*)kp, a1 = *(const h8*)(kp + 32);
        f32x4 d = {0.f, 0.f, 0.f, 0.f};
        d = __builtin_amdgcn_mfma_f32_16x16x32_f16(a0, q0, d, 0, 0, 0);
        d = __builtin_amdgcn_mfma_f32_16x16x32_f16(a1, q1, d, 0, 0, 0);
#pragma unroll
        for (int r = 0; r < 4; ++r) {
          const int pp = m * 16 + hq * 4 + r;
          const float v = (pp < nsel) ? d[r] * 0.125f : NEGF;
          mx = fmaxf(mx, v);
          if (col < 8) pbuf[pp * 8 + col] = v;
        }
      }
    }
    mx = fmaxf(mx, __shfl_xor(mx, 16));
    mx = fmaxf(mx, __shfl_xor(mx, 32));
    const float mxh = __shfl(mx, lane & 7);
    __builtin_amdgcn_wave_barrier();
    float sum = 0.f;
#pragma unroll 4
    for (int k = 0; k < 32; ++k) {
      const int i = lane + 64 * k;
      const float v = pbuf[i];
      const float e = (v > -1e29f) ? __expf(v - mxh) : 0.f;
      pbuf[i] = e;
      sum += e;
    }
    sum += __shfl_xor(sum, 8);
    sum += __shfl_xor(sum, 16);
    sum += __shfl_xor(sum, 32);
    const float inv = 1.f / sum;
    __builtin_amdgcn_wave_barrier();
    {
      const int rs = lane >> 3, dc = lane & 7;
      float acc[8][8];
#pragma unroll
      for (int h = 0; h < 8; ++h)
#pragma unroll
        for (int e = 0; e < 8; ++e) acc[h][e] = 0.f;
#pragma unroll 1
      for (int g8 = 0; g8 < 4; ++g8) {
        h8 vv[8];
#pragma unroll
        for (int i = 0; i < 8; ++i) {
          const int pos = (g8 * 8 + i) * 8 + rs;
          const int s = (pos < nsel) ? (int)sel[tk * 256 + pos] : 0;
          vv[i] = *(const h8*)(ub + (size_t)s * NU + C_BV + dc * 8);
        }
#pragma unroll
        for (int i = 0; i < 8; ++i) {
          const int pos = (g8 * 8 + i) * 8 + rs;
          const f32x4 pa = *(const f32x4*)&pbuf[pos * 8];
          const f32x4 pb = *(const f32x4*)&pbuf[pos * 8 + 4];
          float vf[8];
#pragma unroll
          for (int e = 0; e < 8; ++e) vf[e] = (float)vv[i][e];
#pragma unroll
          for (int e = 0; e < 8; ++e) {
            acc[0][e] += pa[0] * vf[e]; acc[1][e] += pa[1] * vf[e]; acc[2][e] += pa[2] * vf[e]; acc[3][e] += pa[3] * vf[e];
            acc[4][e] += pb[0] * vf[e]; acc[5][e] += pb[1] * vf[e]; acc[6][e] += pb[2] * vf[e]; acc[7][e] += pb[3] * vf[e];
          }
        }
      }
      half_t* yrow = p.yb() + (size_t)(b * SEQ + t) * 512;
#pragma unroll
      for (int h = 0; h < 8; ++h) {
        const float invh = __shfl(inv, h);
        h8 ov;
        const h8 z8 = *(const h8*)(urow + C_BZ + h * 64 + dc * 8);
#pragma unroll
        for (int e = 0; e < 8; ++e) {
          float a = acc[h][e];
          a += __shfl_xor(a, 8);
          a += __shfl_xor(a, 16);
          a += __shfl_xor(a, 32);
          ov[e] = (half_t)(a * invh * siluf_((float)z8[e]));
        }
        if (rs == h) *(h8*)(yrow + h * 64 + dc * 8) = ov;
      }
    }
    __builtin_amdgcn_wave_barrier();
  }
  __syncthreads();
}

__device__ __forceinline__ void phase2(const KP& p, int l, char* smem, int* q, int xcc) {
  xcd_schedule(q, xcc, 32, 1, smem, [&](int grp, int) __attribute__((always_inline)) { compress_item(p, l, grp, smem); });
  xcd_schedule(q + 8, xcc, 1024, 1, smem, [&](int grp, int) __attribute__((always_inline)) {
    const int y = grp & 7, k = grp >> 3;
    dsa_item(p, y & 1, 511 - (k * 4 + (y >> 1)), smem);
  });
  xcd_schedule(q + 16, xcc, 512, 1, smem, [&](int grp, int) __attribute__((always_inline)) { pool_item(p, l, grp, smem); });
}

struct DState {
  float m, l;
  f32x16 o[2];
};
#define MLOW (-1e4f)
__device__ __forceinline__ void ds_reset(DState& st) {
  st.m = MLOW; st.l = 0.f;
#pragma unroll
  for (int dt = 0; dt < 2; ++dt)
#pragma unroll
    for (int r = 0; r < 16; ++r) st.o[dt][r] = 0.f;
}
typedef unsigned int u32x4 __attribute__((ext_vector_type(4)));
typedef unsigned int u32x2 __attribute__((ext_vector_type(2)));
struct StageRegs {
  u32x4 k0, k1, v0, v1;
};
template <bool HASV>
__device__ __forceinline__ void load_stage(StageRegs& r, const half_t* __restrict__ Kb, int ldk,
                                           const half_t* __restrict__ VT, int ldv, int key0, int tid) {
  const int row = tid >> 3, c = tid & 7;
  r.k0 = *(const u32x4*)(Kb + (size_t)(key0 + row) * ldk + c * 8);
  r.k1 = *(const u32x4*)(Kb + (size_t)(key0 + row + 32) * ldk + c * 8);
  if (HASV) {
    r.v0 = *(const u32x4*)(VT + (size_t)row * ldv + key0 + c * 8);
    r.v1 = *(const u32x4*)(VT + (size_t)(row + 32) * ldv + key0 + c * 8);
  }
}
template <bool HASV>
__device__ __forceinline__ void write_stage(const StageRegs& r, half_t* Ks, half_t* Vs, int tid) {
  const int row = tid >> 3, c = tid & 7;
  *(u32x4*)&Ks[row * 72 + c * 8] = r.k0;
  *(u32x4*)&Ks[(row + 32) * 72 + c * 8] = r.k1;
  if (HASV) {
    const int ks = c >> 1, a = c & 1;
    u32x2 lo, hi;
    lo[0] = r.v0[0]; lo[1] = r.v0[1]; hi[0] = r.v0[2]; hi[1] = r.v0[3];
    *(u32x2*)&Vs[row * 72 + ks * 16 + a * 4] = lo;
    *(u32x2*)&Vs[row * 72 + ks * 16 + 8 + a * 4] = hi;
    lo[0] = r.v1[0]; lo[1] = r.v1[1]; hi[0] = r.v1[2]; hi[1] = r.v1[3];
    *(u32x2*)&Vs[(row + 32) * 72 + ks * 16 + a * 4] = lo;
    *(u32x2*)&Vs[(row + 32) * 72 + ks * 16 + 8 + a * 4] = hi;
  }
}
template <bool ONLINE, bool HASV, bool FAST, class VF>
__device__ __forceinline__ void dense_block(DState& st, const half_t* Ks, const half_t* Vs, const h8* qf, int key0,
                                            int flag, VF valid, float fixed_m, float fixed_invl, f32x16* pout,
                                            int lane) {
  const int h = lane >> 5, c = lane & 31;
  f32x16 s[2];
#pragma unroll
  for (int kt = 0; kt < 2; ++kt) {
#pragma unroll
    for (int r = 0; r < 16; ++r) s[kt][r] = 0.f;
#pragma unroll
    for (int ks = 0; ks < 4; ++ks) {
      const h8 a = *(const h8*)&Ks[(32 * kt + c) * 72 + 16 * ks + 8 * h];
      s[kt] = __builtin_amdgcn_mfma_f32_32x32x16_f16(a, qf[ks], s[kt], 0, 0, 0);
    }
  }
  float cm = NEGF;
#pragma unroll
  for (int kt = 0; kt < 2; ++kt)
#pragma unroll
    for (int r = 0; r < 16; ++r) {
      const int key = key0 + 32 * kt + (r & 3) + 8 * (r >> 2) + 4 * h;
      const float v = (FAST ? (flag != 0) : valid(key, flag)) ? s[kt][r] : NEGF;
      s[kt][r] = v;
      cm = fmaxf(cm, v);
    }
  float mnew;
  if (ONLINE) {
    cm = fmaxf(cm, __shfl_xor(cm, 32));
    mnew = st.m;
    if (__ballot(cm > st.m + 8.0f) != 0ull) {
      mnew = fmaxf(st.m, cm);
      const float alpha = __builtin_amdgcn_exp2f(st.m - mnew);
      st.m = mnew;
      st.l *= alpha;
      if (HASV) {
#pragma unroll
        for (int dt = 0; dt < 2; ++dt)
#pragma unroll
          for (int r = 0; r < 16; ++r) st.o[dt][r] *= alpha;
      }
    }
  } else {
    mnew = fixed_m;
  }
  float ps = 0.f;
#pragma unroll
  for (int kt = 0; kt < 2; ++kt)
#pragma unroll
    for (int r = 0; r < 16; ++r) {
      float e = __builtin_amdgcn_exp2f(s[kt][r] - mnew);
      if (!ONLINE) e *= fixed_invl;
      s[kt][r] = e;
      ps += e;
    }
  st.l += ps;
  if (pout) { pout[0] = s[0]; pout[1] = s[1]; }
  if (HASV) {
#pragma unroll
    for (int ks = 0; ks < 4; ++ks) {
      h8 pf;
#pragma unroll
      for (int jj = 0; jj < 8; ++jj) pf[jj] = (half_t)s[ks >> 1][8 * (ks & 1) + jj];
#pragma unroll
      for (int dt = 0; dt < 2; ++dt) {
        const h8 vf = *(const h8*)&Vs[(32 * dt + c) * 72 + 16 * ks + 8 * h];
        st.o[dt] = __builtin_amdgcn_mfma_f32_32x32x16_f16(vf, pf, st.o[dt], 0, 0, 0);
      }
    }
  }
}
template <bool ONLINE, bool HASV, bool WANTP, class PRE, class FU, class VF, class PO>
__device__ __forceinline__ void run_dense(DState& st, const half_t* __restrict__ Kb, int ldk,
                                          const half_t* __restrict__ VT, int ldv, int blk_lo, int blk_hi, const h8* qf,
                                          PRE pre, FU full, VF valid, float fixed_m, float fixed_invl, PO post, char* smem,
                                          int tid) {
  half_t* Ks = (half_t*)smem;
  half_t* Vs = Ks + 64 * 72;
  const int lane = tid & 63;
  StageRegs sr;
  load_stage<HASV>(sr, Kb, ldk, VT, ldv, blk_lo * 64, tid);
  for (int blk = blk_lo; blk <= blk_hi; ++blk) {
    __syncthreads();
    write_stage<HASV>(sr, Ks, Vs, tid);
    __syncthreads();
    const int nb = blk < blk_hi ? blk + 1 : blk;
    load_stage<HASV>(sr, Kb, ldk, VT, ldv, nb * 64, tid);
    const int flag = pre(blk);
    if (__ballot(flag != 0) != 0ull) {
      f32x16 pp[2];
      if (full(blk))
        dense_block<ONLINE, HASV, true>(st, Ks, Vs, qf, blk * 64, flag, valid, fixed_m, fixed_invl,
                                        WANTP ? pp : (f32x16*)nullptr, lane);
      else
        dense_block<ONLINE, HASV, false>(st, Ks, Vs, qf, blk * 64, flag, valid, fixed_m, fixed_invl,
                                         WANTP ? pp : (f32x16*)nullptr, lane);
      if (WANTP) post(blk * 64, pp);
    }
  }
}

__device__ __forceinline__ void nsa_item(const KP& p, int b, int g, int tile, char* smem) {
  int tid = threadIdx.x;
  asm volatile("" : "+v"(tid));
  const int lane = tid & 63, wid = tid >> 6;
  const int t0 = tile * 32;
  const int tw0 = t0 + 8 * wid;
  const int col = lane & 31, h = lane >> 5;
  const int j = col >> 2, r4 = col & 3;
  const int tj = tw0 + j;
  const int head = g * 4 + r4;
  float* impA = (float*)(smem + 18432 + wid * 8320);
  float* impB = impA + 1024;
  unsigned long long* msk = (unsigned long long*)(smem + 18432 + 4 * 8320 + wid * 128);
  uint32_t* kbuf = (uint32_t*)(smem + 18432 + 4 * 8320 + 512 + wid * 512);
  const half_t* ub = p.u() + (size_t)b * SEQ * NU;
  const half_t* urow = ub + (size_t)tj * NU;
  h8 qf[4];
#pragma unroll
  for (int ks = 0; ks < 4; ++ks) {
    qf[ks] = *(const h8*)(urow + C_CQ + head * 64 + 16 * ks + 8 * h);
#pragma unroll
    for (int e = 0; e < 8; ++e) qf[ks][e] = (half_t)((float)qf[ks][e] * 0.18033688f);
  }
  float gate[3];
#pragma unroll
  for (int i = 0; i < 3; ++i) gate[i] = sigmoidf_((float)urow[C_CG + head * 3 + i]);
  f32x16 res[2];
#pragma unroll
  for (int dt = 0; dt < 2; ++dt)
#pragma unroll
    for (int r = 0; r < 16; ++r) res[dt][r] = 0.f;
  for (int i = lane; i < 2080; i += 64) impA[i] = 0.f;
  DState st;
  auto nopost = [&](int, f32x16*) __attribute__((always_inline)) {};

  {
    const int nmax_j = (tj >= 31) ? ((tj - 31) >> 4) : -1;
    const int bhi = (t0 >> 4) >> 6;
    const half_t* Kc = p.kcmp() + (size_t)(b * 2 + g) * 512 * 64;
    const half_t* Vc = p.vcmpT() + (size_t)(b * 2 + g) * 64 * 512;
    auto pre = [&](int) __attribute__((always_inline)) { return 1; };
    const int nmax_w = (tw0 >= 31) ? ((tw0 - 31) >> 4) : -1;
    auto fullc = [&](int blk) __attribute__((always_inline)) { return blk * 64 + 63 <= nmax_w; };
    auto vfn = [&](int n, int) __attribute__((always_inline)) { return n <= nmax_j; };
    ds_reset(st);
    run_dense<true, false, false>(st, Kc, 64, (const half_t*)nullptr, 0, 0, bhi, qf, pre, fullc, vfn, 0.f, 0.f, nopost, smem, tid);
    float lt = st.l;
    lt += __shfl_xor(lt, 32);
    const float mfix = st.m;
    const float invl = lt > 0.f ? 1.f / lt : 0.f;
    ds_reset(st);
    auto post = [&](int n0, f32x16* pp) __attribute__((always_inline)) {
#pragma unroll
      for (int kt = 0; kt < 2; ++kt)
#pragma unroll
        for (int qd = 0; qd < 4; ++qd) {
          float a = pp[kt][4 * qd] + pp[kt][4 * qd + 1] + pp[kt][4 * qd + 2] + pp[kt][4 * qd + 3];
          float bb = pp[kt][4 * qd + 3];
          a += __shfl_xor(a, 1); a += __shfl_xor(a, 2);
          bb += __shfl_xor(bb, 1); bb += __shfl_xor(bb, 2);
          if (r4 == 0) {
            const int sblk = (n0 >> 2) + 8 * kt + 2 * qd + h;
            impA[j * 128 + sblk] = a;
            impB[j * 132 + sblk + 1] = bb;
          }
        }
    };
    run_dense<false, true, true>(st, Kc, 64, Vc, 512, 0, bhi, qf, pre, fullc, vfn, mfix, invl, post, smem, tid);
#pragma unroll
    for (int dt = 0; dt < 2; ++dt)
#pragma unroll
      for (int r = 0; r < 16; ++r) res[dt][r] += gate[0] * st.o[dt][r];
  }
  __builtin_amdgcn_wave_barrier();
#pragma unroll 1
  for (int jj = 0; jj < 8; ++jj) {
    const int t = tw0 + jj;
    const int blk = t >> 6;
    uint32_t k0, k1;
    {
      const int s0 = lane, s1 = lane + 64;
      const float i0 = impA[jj * 128 + s0] + impB[jj * 132 + s0];
      const float i1 = impA[jj * 128 + s1] + impB[jj * 132 + s1];
      auto mk = [&](float im, int s) __attribute__((always_inline)) -> uint32_t {
        if (s > blk) return 0u;
        uint32_t kk = ((__float_as_uint(im) >> 1) & ~127u) | (uint32_t)(127 - s) | 0x40000000u;
        if (s == 0 || s == blk || s == blk - 1) kk |= 0x80000000u;
        return kk;
      };
      k0 = mk(i0, s0); k1 = mk(i1, s1);
    }
    kbuf[lane] = k0;
    kbuf[lane + 64] = k1;
    __builtin_amdgcn_wave_barrier();
    int r0 = 0, r1 = 0;
#pragma unroll 4
    for (int qd = 0; qd < 32; ++qd) {
      const uint4 kq = *(const uint4*)&kbuf[4 * qd];
      r0 += (kq.x > k0) + (kq.y > k0) + (kq.z > k0) + (kq.w > k0);
      r1 += (kq.x > k1) + (kq.y > k1) + (kq.z > k1) + (kq.w > k1);
    }
    const unsigned long long lo = __ballot(k0 != 0u && r0 < 16);
    const unsigned long long hi = __ballot(k1 != 0u && r1 < 16);
    __builtin_amdgcn_wave_barrier();
    if (lane == 0) { msk[jj * 2] = lo; msk[jj * 2 + 1] = hi; }
  }
  __builtin_amdgcn_wave_barrier();
  const unsigned long long mylo = msk[j * 2], myhi = msk[j * 2 + 1];
  {
    const half_t* Ksel = ub + C_CKS + g * 64;
    const half_t* Vsel = p.vsT() + (size_t)(b * 2 + g) * 64 * SEQ;
    auto pre = [&](int blk) __attribute__((always_inline)) {
      const unsigned long long mm_ = (blk < 64) ? mylo : myhi;
      return (int)((mm_ >> (blk & 63)) & 1ull);
    };
    auto vfn = [&](int key, int flag) __attribute__((always_inline)) { return flag != 0 && key <= tj; };
    ds_reset(st);
    auto fulls = [&](int blk) __attribute__((always_inline)) { return blk * 64 + 63 <= tw0; };
    run_dense<true, true, false>(st, Ksel, NU, Vsel, SEQ, 0, (t0 + 31) >> 6, qf, pre, fulls, vfn, 0.f, 0.f, nopost, smem, tid);
    float lt = st.l;
    lt += __shfl_xor(lt, 32);
    const float sc = lt > 0.f ? gate[1] / lt : 0.f;
#pragma unroll
    for (int dt = 0; dt < 2; ++dt)
#pragma unroll
      for (int r = 0; r < 16; ++r) res[dt][r] += sc * st.o[dt][r];
  }
  {
    const half_t* Kw = ub + C_CKW + g * 64;
    const half_t* Vw = p.vwT() + (size_t)(b * 2 + g) * 64 * SEQ;
    auto pre = [&](int blk) __attribute__((always_inline)) {
      return (int)((blk * 64 <= tj) && (blk * 64 + 63 > tj - 512));
    };
    auto vfn = [&](int key, int) __attribute__((always_inline)) { return key <= tj && key > tj - 512; };
    ds_reset(st);
    auto fullw = [&](int blk) __attribute__((always_inline)) { return blk * 64 + 63 <= tw0 && blk * 64 > tw0 + 7 - 512; };
    run_dense<true, true, false>(st, Kw, NU, Vw, SEQ, max(0, t0 - 511) >> 6, (t0 + 31) >> 6, qf, pre, fullw, vfn, 0.f, 0.f,
                                 nopost, smem, tid);
    float lt = st.l;
    lt += __shfl_xor(lt, 32);
    const float sc = lt > 0.f ? gate[2] / lt : 0.f;
#pragma unroll
    for (int dt = 0; dt < 2; ++dt)
#pragma unroll
      for (int r = 0; r < 16; ++r) res[dt][r] += sc * st.o[dt][r];
  }
  half_t* yrow = p.yc() + (size_t)(b * SEQ + tj) * 512 + head * 64;
#pragma unroll
  for (int dt = 0; dt < 2; ++dt)
#pragma unroll
    for (int qd = 0; qd < 4; ++qd) {
      const int d = 32 * dt + 8 * qd + 4 * h;
      const h4 z = *(const h4*)(urow + C_CZ + head * 64 + d);
      h4 ov;
#pragma unroll
      for (int e = 0; e < 4; ++e) ov[e] = (half_t)(res[dt][4 * qd + e] * siluf_((float)z[e]));
      *(h4*)(yrow + d) = ov;
    }
  __syncthreads();
}

__device__ __forceinline__ void phase_nsa(const KP& p, char* smem, int* q, int xcc) {
  xcd_schedule(q, xcc, 1024, 1, smem, [&](int grp, int) __attribute__((always_inline)) {
    const int y = grp & 7, k = grp >> 3;
    const int b = y & 1, g = (y >> 1) & 1, tile = 255 - (k * 2 + (y >> 2));
    nsa_item(p, b, g, tile, smem);
  });
}

__device__ __forceinline__ void phase_merge(const KP& p, char* smem, int* q, int xcc) {
  xcd_schedule(q, xcc, 16, 64, smem, [&](int grp, int within) __attribute__((always_inline)) {
    const int mt = (grp & 15) * 8 + (within & 7), nt = (within >> 3);
    const int m0 = mt * 128, n0 = nt * 128;
    f32x16 tot[2][2];
#pragma unroll
    for (int i = 0; i < 2; ++i)
#pragma unroll
      for (int jn = 0; jn < 2; ++jn)
#pragma unroll
        for (int r = 0; r < 16; ++r) tot[i][jn][r] = 0.f;
#pragma unroll 1
    for (int br = 0; br < 3; ++br) {
      const half_t* A = (br == 0 ? p.ya() : (br == 1 ? p.yb() : p.yc())) + (size_t)m0 * 512;
      const half_t* B = p.wpT() + (size_t)br * DM * 512 + (size_t)n0 * 512;
      const half_t* G = p.u() + (size_t)m0 * NU + C_GM + br * 1024 + n0;
      gemm_tile<2>(
          512, [&](int r, int k) { return *(const uint4*)(A + (size_t)r * 512 + k); },
          [&](int r, int k) { return *(const uint4*)(B + (size_t)r * 512 + k); },
          [&](int mi, int ni, int r, int row, int col, float v) {
            const float gz = (float)G[(size_t)row * NU + col];
            tot[mi][ni][r] += sigmoidf_(gz) * v;
          },
          smem);
    }
    int tidx = threadIdx.x;
    asm volatile("" : "+v"(tidx));
    const int lane = tidx & 63, wid = tidx >> 6, wm = wid >> 1, wn = wid & 1;
#pragma unroll
    for (int mi = 0; mi < 2; ++mi)
#pragma unroll
      for (int ni = 0; ni < 2; ++ni)
#pragma unroll
        for (int r = 0; r < 16; ++r) {
          const int row = wm * 64 + mi * 32 + (r & 3) + 8 * (r >> 2) + 4 * (lane >> 5);
          const int col = wn * 64 + ni * 32 + (lane & 31);
          p.mm()[(size_t)(m0 + row) * DM + n0 + col] = (half_t)tot[mi][ni][r];
        }
  });
}

__device__ __forceinline__ void phase_outproj(const KP& p, char* smem, int* q, int xcc) {
  xcd_schedule(q, xcc, 16, 64, smem, [&](int grp, int within) __attribute__((always_inline)) {
    const int mt = (grp & 15) * 8 + (within & 7), nt = (within >> 3);
    const int m0 = mt * 128, n0 = nt * 128;
    const half_t* A = p.mm() + (size_t)m0 * DM;
    const half_t* B = p.woT() + (size_t)n0 * DM;
    gemm_tile<2>(
        DM, [&](int r, int k) { return *(const uint4*)(A + (size_t)r * DM + k); },
        [&](int r, int k) { return *(const uint4*)(B + (size_t)r * DM + k); },
        [&](int mi, int ni, int r, int row, int col, float v) {
          const size_t xi = (size_t)(m0 + row) * DM + n0 + col;
          ((float*)p.u())[xi] = ALPHA_F * p.xr()[xi] + v;
        },
        smem);
  });
}


#define XB_TMO      128
#define XB_XCNT(j)  (256  + 64 * (j))
#define XB_XSUB(j)  (1280 + 64 * (j))
#define XB_XGEN(j)  (2304 + 64 * (j))
#define XB_TOP      3328
#define XB_TOPGEN   3392
#define XCD_BAR_WORDS 3456
#define XB_SPIN_CAP (1u << 20)
#define LAS __attribute__((address_space(3)))
__device__ __forceinline__ unsigned xb_ld(unsigned* p)              { return __hip_atomic_load(p, __ATOMIC_RELAXED, __HIP_MEMORY_SCOPE_AGENT); }
__device__ __forceinline__ unsigned xb_add(unsigned* p, unsigned v) { return __hip_atomic_fetch_add(p, v, __ATOMIC_RELAXED, __HIP_MEMORY_SCOPE_AGENT); }
__device__ __forceinline__ unsigned xb_xcc_id() { return (unsigned)__builtin_amdgcn_s_getreg((3 << 11) | 20) & 0xFu; }
#define XB_SPIN(cond, bar) do { unsigned _sp = 0; while (cond) { __builtin_amdgcn_s_sleep(1); \
    if ((++_sp & 255u) == 0u) { if (xb_ld(&(bar)[XB_TMO])) break; if (_sp > XB_SPIN_CAP) { atomicAdd(&(bar)[XB_TMO], 1u); break; } } } } while (0)
struct XcdBarrier { unsigned* bar; unsigned x; volatile LAS unsigned* st; };
__device__ __forceinline__ XcdBarrier xcd_barrier_post(unsigned* bar, volatile LAS unsigned* st) {
  XcdBarrier b; b.bar = bar; b.x = xb_xcc_id(); b.st = st;
  if (threadIdx.x == 0) (void)xb_add(&bar[XB_XCNT(b.x)], 1u);
  return b;
}
__device__ __forceinline__ void xcd_barrier_complete(unsigned* bar, unsigned x, unsigned& nloc, unsigned& nx) {
  const unsigned G = gridDim.x * gridDim.y * gridDim.z;
  unsigned sum, cnt, mine, sp = 0u;
  for (;;) {
    sum = 0u; cnt = 0u; mine = 0u;
#pragma unroll
    for (unsigned j = 0; j < 16; ++j) { const unsigned c = xb_ld(&bar[XB_XCNT(j)]); sum += c; cnt += (c > 0u) ? 1u : 0u; mine = (j == x) ? c : mine; }
    if (sum == G) break;
    __builtin_amdgcn_s_sleep(1);
    if ((++sp & 255u) == 0u) { if (xb_ld(&bar[XB_TMO])) break; if (sp > XB_SPIN_CAP) { atomicAdd(&bar[XB_TMO], 1u); break; } }
  }
  nloc = mine > 0u ? mine : 1u; nx = cnt > 0u ? cnt : 1u;
}
__device__ __forceinline__ void xcd_barrier(const XcdBarrier& b) {
  asm volatile("s_waitcnt vmcnt(0)" ::: "memory");
  __syncthreads();
  if (threadIdx.x == 0) {
    unsigned* bar = b.bar;
    __builtin_amdgcn_s_waitcnt(0);
    unsigned nloc = b.st[0], nx = b.st[1];
    if (nloc == 0u) { xcd_barrier_complete(bar, b.x, nloc, nx); b.st[0] = nloc; b.st[1] = nx; }
    const unsigned old = xb_add(&bar[XB_XSUB(b.x)], 1u);
    const unsigned gen = old / nloc;
    if (old + 1u == (gen + 1u) * nloc) {
      __builtin_amdgcn_fence(__ATOMIC_RELEASE, "agent");
      asm volatile("s_waitcnt vmcnt(0)" ::: "memory");
      const unsigned og = xb_add(&bar[XB_TOP], 1u);
      const unsigned tg = og / nx;
      if (og + 1u == (tg + 1u) * nx) xb_add(&bar[XB_TOPGEN], 1u);
      else XB_SPIN(xb_ld(&bar[XB_TOPGEN]) == tg, bar);
      __builtin_amdgcn_fence(__ATOMIC_ACQUIRE, "agent");
      xb_add(&bar[XB_XGEN(b.x)], 1u);
      asm volatile("s_waitcnt vmcnt(0)" ::: "memory");
    } else {
      XB_SPIN(xb_ld(&bar[XB_XGEN(b.x)]) == gen, bar);
      __builtin_amdgcn_fence(__ATOMIC_ACQUIRE, "agent");
      asm volatile("s_waitcnt vmcnt(0)" ::: "memory");
    }
  }
  __syncthreads();
}

#define NQ_WORDS 4096
__global__ void __launch_bounds__(256, 2) fwd_megakernel(Params p_unused) {
  cg::grid_group grid = cg::this_grid();
  __shared__ __attribute__((aligned(16))) char smem[SMEM_BYTES];
  volatile LAS unsigned* st = (volatile LAS unsigned*)(smem + SMEM_BYTES - 32);
  if (threadIdx.x == 0) { st[0] = 0u; st[1] = 0u; }
  __syncthreads();
  if (gridDim.y == 4242u) grid.sync();
  XcdBarrier xb;
  {
    const KP p = get_params();
    xb = xcd_barrier_post((unsigned*)p.counters() + NQ_WORDS, st);
    ln_rows(p, -1, false);
    prep_weights(p, 0, smem);
  }
  xcd_barrier(xb);
  const int xcc = (int)(xb.x & 7u);
#ifndef REP1
#define REP1 1
#define REP2 1
#define REP3 1
#define REP4 1
#endif
#ifndef REP5
#define REP5 1
#define REP6 1
#define REP7 0
#endif
#pragma unroll 1
  for (int l = 0; l < DEPTH; ++l) {
#define QPTR(ph, rep) (p.counters() + ((l * 6 + (ph)) * 4 + (rep)) * 32)
    for (int rep = 0; rep < REP1; ++rep) { const KP p = get_params(); phase_inproj(p, l, smem, QPTR(0, rep), xcc); }
    xcd_barrier(xb);
    for (int rep = 0; rep < REP2; ++rep) { const KP p = get_params(); phase2(p, l, smem, QPTR(1, rep), xcc); }
    xcd_barrier(xb);
    for (int rep = 0; rep < REP3; ++rep) { const KP p = get_params(); phase_nsa(p, smem, QPTR(2, rep), xcc); }
    xcd_barrier(xb);
    for (int rep = 0; rep < REP4; ++rep) { const KP p = get_params(); phase_merge(p, smem, QPTR(3, rep), xcc); }
    xcd_barrier(xb);
    for (int rep = 0; rep < REP5; ++rep) { const KP p = get_params(); phase_outproj(p, smem, QPTR(4, rep), xcc); }
    xcd_barrier(xb);
    for (int rep = 0; rep < REP6; ++rep) {
      const KP p = get_params();
      if (l + 1 < DEPTH) {
        ln_rows(p, l, false);
        prep_weights(p, l + 1, smem);
      } else {
        ln_rows(p, l, true);
      }
    }
    if (l + 1 < DEPTH) xcd_barrier(xb);
    for (int rep = 0; rep < REP7; ++rep) xcd_barrier(xb);
  }
}

extern "C" void kernel_launch(void* const* d_in, const int* in_sizes, int n_in, void* d_out, int out_size,
                              void* d_ws, size_t ws_size, hipStream_t stream) {
  static int grid_blocks = 0;
  if (!grid_blocks) {
    int dev = 0, cus = 0, per_cu = 0;
    (void)hipGetDevice(&dev);
    (void)hipDeviceGetAttribute(&cus, hipDeviceAttributeMultiprocessorCount, dev);
    (void)hipOccupancyMaxActiveBlocksPerMultiprocessor(&per_cu, fwd_megakernel, 256, 0);
    if (per_cu > 2) per_cu = 2;
    if (per_cu < 1) per_cu = 1;
    grid_blocks = cus * per_cu;
  }
  Params p{};
  p.x = (const float*)d_in[0]; p.w_in = (const float*)d_in[1]; p.b_in = (const float*)d_in[2];
  p.pool_w = (const float*)d_in[3]; p.pool_b = (const float*)d_in[4]; p.pool_scale = (const float*)d_in[5];
  p.pos_k = (const float*)d_in[6]; p.pos_v = (const float*)d_in[7]; p.w1k = (const float*)d_in[8];
  p.w2k = (const float*)d_in[9]; p.w1v = (const float*)d_in[10]; p.w2v = (const float*)d_in[11];
  p.wpa = (const float*)d_in[12]; p.wpb = (const float*)d_in[13]; p.wpc = (const float*)d_in[14];
  p.wo = (const float*)d_in[15]; p.ln_g = (const float*)d_in[16]; p.ln_b = (const float*)d_in[17];
  p.out = (float*)d_out;
  p.ws = (char*)d_ws;
  if (WS_TOTAL > ws_size) { fprintf(stderr, "workspace too small: need %zu have %zu\n", (size_t)WS_TOTAL, ws_size); return; }
  (void)hipMemsetAsync((char*)d_ws + OFF_counters, 0, (size_t)(NQ_WORDS + XCD_BAR_WORDS) * 4, stream);
  void* args[] = {&p};
  hipError_t e = hipLaunchCooperativeKernel((void*)fwd_megakernel, dim3(grid_blocks), dim3(256), args, 0, stream);
  if (e != hipSuccess) fprintf(stderr, "cooperative launch failed: %s (grid %d)\n", hipGetErrorString(e), grid_blocks);
}
```

```cpp
#include <hip/hip_runtime.h>
#include <hip/hip_cooperative_groups.h>
#include <cstdio>
#include <cstdint>
namespace cg = cooperative_groups;

typedef _Float16 half_t;
typedef _Float16 h8 __attribute__((ext_vector_type(8)));
typedef _Float16 h4 __attribute__((ext_vector_type(4)));
typedef float f32x4 __attribute__((ext_vector_type(4)));
typedef float f32x16 __attribute__((ext_vector_type(16)));

#define SEQ 8192
#define DM 1024
#define NTOK 16384
#define DEPTH 4
#define NIN 7360
#define NU 7424
#define ALPHA_F 1.681792830507429f
#define NEGF (-1e30f)

#define C_AX 0
#define C_AZ 512
#define C_BQ 1024
#define C_BZ 1536
#define C_CQ 2048
#define C_CZ 2560
#define C_GM 3072
#define C_IQ 6144
#define C_CKC 6400
#define C_CVC 6528
#define C_CKS 6656
#define C_CVS 6784
#define C_CKW 6912
#define C_CVW 7040
#define C_BK 7168
#define C_BV 7232
#define C_IK 7296
#define C_IW 7328
#define C_CG 7336

#define SMEM_BYTES 73728

constexpr size_t OFF_xr = 0;
constexpr size_t OFF_xh = OFF_xr + (((size_t)NTOK*DM*4 + 255) & ~(size_t)255);
constexpr size_t OFF_u = OFF_xh + (((size_t)NTOK*DM*2 + 255) & ~(size_t)255);
constexpr size_t OFF_winT = OFF_u + (((size_t)NTOK*NU*2 + 255) & ~(size_t)255);
constexpr size_t OFF_wpT = OFF_winT + (((size_t)NU*DM*2 + 255) & ~(size_t)255);
constexpr size_t OFF_woT = OFF_wpT + (((size_t)3*DM*512*2 + 255) & ~(size_t)255);
constexpr size_t OFF_poolT = OFF_woT + (((size_t)DM*DM*2 + 255) & ~(size_t)255);
constexpr size_t OFF_w1T = OFF_poolT + (((size_t)4*128*128*2 + 255) & ~(size_t)255);
constexpr size_t OFF_posb = OFF_w1T + (((size_t)2*64*2048*2 + 255) & ~(size_t)255);
constexpr size_t OFF_vsT = OFF_posb + (((size_t)512 + 255) & ~(size_t)255);
constexpr size_t OFF_vwT = OFF_vsT + (((size_t)4*64*SEQ*2 + 255) & ~(size_t)255);
constexpr size_t OFF_kcmp = OFF_vwT + (((size_t)4*64*SEQ*2 + 255) & ~(size_t)255);
constexpr size_t OFF_vcmpT = OFF_kcmp + (((size_t)4*512*64*2 + 255) & ~(size_t)255);
constexpr size_t OFF_ya = OFF_vcmpT + (((size_t)4*64*512*2 + 255) & ~(size_t)255);
constexpr size_t OFF_yb = OFF_ya + (((size_t)NTOK*512*2 + 255) & ~(size_t)255);
constexpr size_t OFF_yc = OFF_yb + (((size_t)NTOK*512*2 + 255) & ~(size_t)255);
constexpr size_t OFF_mm = OFF_yc + (((size_t)NTOK*512*2 + 255) & ~(size_t)255);
constexpr size_t OFF_counters = OFF_mm + (((size_t)NTOK*DM*2 + 255) & ~(size_t)255);
constexpr size_t WS_TOTAL = OFF_counters + (((size_t)32768 + 255) & ~(size_t)255);
struct Params {
  const float* x; const float* w_in; const float* b_in; const float* pool_w; const float* pool_b;
  const float* pool_scale; const float* pos_k; const float* pos_v; const float* w1k; const float* w2k;
  const float* w1v; const float* w2v; const float* wpa; const float* wpb; const float* wpc;
  const float* wo; const float* ln_g; const float* ln_b;
  float* out;
  char* ws;
};
typedef const __attribute__((address_space(4))) unsigned long long* kargp_t;
struct KP {
  kargp_t kp;
  __device__ __forceinline__ const float* x() const { return (const float*)(const __attribute__((address_space(1))) float*)kp[0]; }
  __device__ __forceinline__ const float* w_in() const { return (const float*)(const __attribute__((address_space(1))) float*)kp[1]; }
  __device__ __forceinline__ const float* b_in() const { return (const float*)(const __attribute__((address_space(1))) float*)kp[2]; }
  __device__ __forceinline__ const float* pool_w() const { return (const float*)(const __attribute__((address_space(1))) float*)kp[3]; }
  __device__ __forceinline__ const float* pool_b() const { return (const float*)(const __attribute__((address_space(1))) float*)kp[4]; }
  __device__ __forceinline__ const float* pool_scale() const { return (const float*)(const __attribute__((address_space(1))) float*)kp[5]; }
  __device__ __forceinline__ const float* pos_k() const { return (const float*)(const __attribute__((address_space(1))) float*)kp[6]; }
  __device__ __forceinline__ const float* pos_v() const { return (const float*)(const __attribute__((address_space(1))) float*)kp[7]; }
  __device__ __forceinline__ const float* w1k() const { return (const float*)(const __attribute__((address_space(1))) float*)kp[8]; }
  __device__ __forceinline__ const float* w2k() const { return (const float*)(const __attribute__((address_space(1))) float*)kp[9]; }
  __device__ __forceinline__ const float* w1v() const { return (const float*)(const __attribute__((address_space(1))) float*)kp[10]; }
  __device__ __forceinline__ const float* w2v() const { return (const float*)(const __attribute__((address_space(1))) float*)kp[11]; }
  __device__ __forceinline__ const float* wpa() const { return (const float*)(const __attribute__((address_space(1))) float*)kp[12]; }
  __device__ __forceinline__ const float* wpb() const { return (const float*)(const __attribute__((address_space(1))) float*)kp[13]; }
  __device__ __forceinline__ const float* wpc() const { return (const float*)(const __attribute__((address_space(1))) float*)kp[14]; }
  __device__ __forceinline__ const float* wo() const { return (const float*)(const __attribute__((address_space(1))) float*)kp[15]; }
  __device__ __forceinline__ const float* ln_g() const { return (const float*)(const __attribute__((address_space(1))) float*)kp[16]; }
  __device__ __forceinline__ const float* ln_b() const { return (const float*)(const __attribute__((address_space(1))) float*)kp[17]; }
  __device__ __forceinline__ float* out() const { return (float*)(__attribute__((address_space(1))) float*)kp[18]; }
  __device__ __forceinline__ char* ws() const { return (char*)(__attribute__((address_space(1))) char*)kp[19]; }
  __device__ __forceinline__ float* xr() const { return (float*)(ws() + OFF_xr); }
  __device__ __forceinline__ half_t* xh() const { return (half_t*)(ws() + OFF_xh); }
  __device__ __forceinline__ half_t* u() const { return (half_t*)(ws() + OFF_u); }
  __device__ __forceinline__ half_t* winT() const { return (half_t*)(ws() + OFF_winT); }
  __device__ __forceinline__ half_t* wpT() const { return (half_t*)(ws() + OFF_wpT); }
  __device__ __forceinline__ half_t* woT() const { return (half_t*)(ws() + OFF_woT); }
  __device__ __forceinline__ half_t* poolT() const { return (half_t*)(ws() + OFF_poolT); }
  __device__ __forceinline__ half_t* w1T() const { return (half_t*)(ws() + OFF_w1T); }
  __device__ __forceinline__ float* posb() const { return (float*)(ws() + OFF_posb); }
  __device__ __forceinline__ half_t* vsT() const { return (half_t*)(ws() + OFF_vsT); }
  __device__ __forceinline__ half_t* vwT() const { return (half_t*)(ws() + OFF_vwT); }
  __device__ __forceinline__ half_t* kcmp() const { return (half_t*)(ws() + OFF_kcmp); }
  __device__ __forceinline__ half_t* vcmpT() const { return (half_t*)(ws() + OFF_vcmpT); }
  __device__ __forceinline__ half_t* ya() const { return (half_t*)(ws() + OFF_ya); }
  __device__ __forceinline__ half_t* yb() const { return (half_t*)(ws() + OFF_yb); }
  __device__ __forceinline__ half_t* yc() const { return (half_t*)(ws() + OFF_yc); }
  __device__ __forceinline__ half_t* mm() const { return (half_t*)(ws() + OFF_mm); }
  __device__ __forceinline__ int* counters() const { return (int*)(ws() + OFF_counters); }
};
__device__ __forceinline__ KP get_params() {
  KP q;
  q.kp = (kargp_t)__builtin_amdgcn_kernarg_segment_ptr();
  asm volatile("" : "+s"(q.kp));
  return q;
}


__device__ __forceinline__ int orig_col(int n) {
  if (n < 1536) return n;
  if (n < 2048) return 1664 + (n - 1536);
  if (n < 2560) return 2472 + (n - 2048);
  if (n < 3072) return 3776 + (n - 2560);
  if (n < 6144) return 4288 + (n - 3072);
  if (n < 6400) return 2176 + (n - 6144);
  if (n < 7168) return 2984 + (n - 6400);
  if (n < 7296) return 1536 + (n - 7168);
  if (n < 7328) return 2432 + (n - 7296);
  if (n < 7336) return 2464 + (n - 7328);
  if (n < 7360) return 3752 + (n - 7336);
  return -1;
}

__device__ __forceinline__ float wave_sum(float v) {
#pragma unroll
  for (int o = 32; o > 0; o >>= 1) v += __shfl_xor(v, o);
  return v;
}
__device__ __forceinline__ float sigmoidf_(float x) { return 1.f / (1.f + __expf(-x)); }
__device__ __forceinline__ float siluf_(float x) { return x / (1.f + __expf(-x)); }

template <int NI, class LA, class LB, class EP>
__device__ __forceinline__ void gemm_tile(int K, LA loadA, LB loadB, EP epi, char* smem) {
  constexpr int BN = NI * 64;
  constexpr int NB = BN / 32;
  half_t* sA = (half_t*)smem;
  half_t* sB = sA + 128 * 72;
  int tid = threadIdx.x;
  asm volatile("" : "+v"(tid));
  const int lane = tid & 63, wid = tid >> 6;
  const int wm = wid >> 1, wn = wid & 1;
  f32x16 acc[2][NI];
#pragma unroll
  for (int i = 0; i < 2; ++i)
#pragma unroll
    for (int j = 0; j < NI; ++j)
#pragma unroll
      for (int r = 0; r < 16; ++r) acc[i][j][r] = 0.f;
  const int lr = tid >> 3, lc = (tid & 7) * 8;
  uint4 ra[4], rb[NB];
#pragma unroll
  for (int i = 0; i < 4; ++i) ra[i] = loadA(lr + 32 * i, lc);
#pragma unroll
  for (int i = 0; i < NB; ++i) rb[i] = loadB(lr + 32 * i, lc);
  const int nk = K >> 6;
  for (int kt = 0; kt < nk; ++kt) {
    __syncthreads();
#pragma unroll
    for (int i = 0; i < 4; ++i) *(uint4*)&sA[(lr + 32 * i) * 72 + lc] = ra[i];
#pragma unroll
    for (int i = 0; i < NB; ++i) *(uint4*)&sB[(lr + 32 * i) * 72 + lc] = rb[i];
    __syncthreads();
    if (kt + 1 < nk) {
      const int kk = (kt + 1) * 64 + lc;
#pragma unroll
      for (int i = 0; i < 4; ++i) ra[i] = loadA(lr + 32 * i, kk);
#pragma unroll
      for (int i = 0; i < NB; ++i) rb[i] = loadB(lr + 32 * i, kk);
    }
#pragma unroll
    for (int s = 0; s < 4; ++s) {
      h8 af[2], bf[NI];
#pragma unroll
      for (int mi = 0; mi < 2; ++mi)
        af[mi] = *(const h8*)&sA[(wm * 64 + mi * 32 + (lane & 31)) * 72 + s * 16 + (lane >> 5) * 8];
#pragma unroll
      for (int ni = 0; ni < NI; ++ni)
        bf[ni] = *(const h8*)&sB[(wn * (NI * 32) + ni * 32 + (lane & 31)) * 72 + s * 16 + (lane >> 5) * 8];
#pragma unroll
      for (int mi = 0; mi < 2; ++mi)
#pragma unroll
        for (int ni = 0; ni < NI; ++ni)
          acc[mi][ni] = __builtin_amdgcn_mfma_f32_32x32x16_f16(af[mi], bf[ni], acc[mi][ni], 0, 0, 0);
    }
  }
#pragma unroll
  for (int mi = 0; mi < 2; ++mi)
#pragma unroll
    for (int ni = 0; ni < NI; ++ni)
#pragma unroll
      for (int r = 0; r < 16; ++r) {
        const int row = wm * 64 + mi * 32 + (r & 3) + 8 * (r >> 2) + 4 * (lane >> 5);
        const int col = wn * (NI * 32) + ni * 32 + (lane & 31);
        epi(mi, ni, r, row, col, acc[mi][ni][r]);
      }
}

template <class LA, class LB, class EP>
__device__ __forceinline__ void gemm_tile_big(int K, LA loadA, LB loadB, EP epi, char* smem) {
  half_t* sA = (half_t*)smem;
  half_t* sB = sA + 256 * 72;
  int tid = threadIdx.x;
  asm volatile("" : "+v"(tid));
  const int lane = tid & 63, wid = tid >> 6;
  const int wm = wid >> 1, wn = wid & 1;
  f32x16 acc[4][2];
#pragma unroll
  for (int i = 0; i < 4; ++i)
#pragma unroll
    for (int j = 0; j < 2; ++j)
#pragma unroll
      for (int r = 0; r < 16; ++r) acc[i][j][r] = 0.f;
  const int lr = tid >> 3, lc = (tid & 7) * 8;
  uint4 ra[8], rb[4];
#pragma unroll
  for (int i = 0; i < 8; ++i) ra[i] = loadA(lr + 32 * i, lc);
#pragma unroll
  for (int i = 0; i < 4; ++i) rb[i] = loadB(lr + 32 * i, lc);
  const int nk = K >> 6;
  for (int kt = 0; kt < nk; ++kt) {
    __syncthreads();
#pragma unroll
    for (int i = 0; i < 8; ++i) *(uint4*)&sA[(lr + 32 * i) * 72 + lc] = ra[i];
#pragma unroll
    for (int i = 0; i < 4; ++i) *(uint4*)&sB[(lr + 32 * i) * 72 + lc] = rb[i];
    __syncthreads();
    if (kt + 1 < nk) {
      const int kk = (kt + 1) * 64 + lc;
#pragma unroll
      for (int i = 0; i < 8; ++i) ra[i] = loadA(lr + 32 * i, kk);
#pragma unroll
      for (int i = 0; i < 4; ++i) rb[i] = loadB(lr + 32 * i, kk);
    }
#pragma unroll
    for (int s = 0; s < 4; ++s) {
      h8 af[4], bf[2];
#pragma unroll
      for (int mi = 0; mi < 4; ++mi)
        af[mi] = *(const h8*)&sA[(wm * 128 + mi * 32 + (lane & 31)) * 72 + s * 16 + (lane >> 5) * 8];
#pragma unroll
      for (int ni = 0; ni < 2; ++ni)
        bf[ni] = *(const h8*)&sB[(wn * 64 + ni * 32 + (lane & 31)) * 72 + s * 16 + (lane >> 5) * 8];
#pragma unroll
      for (int mi = 0; mi < 4; ++mi)
#pragma unroll
        for (int ni = 0; ni < 2; ++ni)
          acc[mi][ni] = __builtin_amdgcn_mfma_f32_32x32x16_f16(af[mi], bf[ni], acc[mi][ni], 0, 0, 0);
    }
  }
#pragma unroll
  for (int mi = 0; mi < 4; ++mi)
#pragma unroll
    for (int ni = 0; ni < 2; ++ni)
#pragma unroll
      for (int r = 0; r < 16; ++r) {
        const int row = wm * 128 + mi * 32 + (r & 3) + 8 * (r >> 2) + 4 * (lane >> 5);
        const int col = wn * 64 + ni * 32 + (lane & 31);
        epi(mi, ni, r, row, col, acc[mi][ni][r]);
      }
}

template <class CM>
__device__ __forceinline__ void tconv_tile(const float* __restrict__ src, int lds_, half_t* __restrict__ dst, int ldd,
                                           int n0, int k0, CM cmap, char* smem) {
  float* t = (float*)smem;
  int tid = threadIdx.x;
  asm volatile("" : "+v"(tid));
  {
    const int n = tid & 63;
    const int c = cmap(n0 + n);
    float tv[16];
#pragma unroll
    for (int i = 0; i < 16; ++i) {
      const int k = (tid >> 6) + 4 * i;
      tv[i] = (c >= 0) ? src[(size_t)(k0 + k) * lds_ + c] : 0.f;
    }
#pragma unroll
    for (int i = 0; i < 16; ++i) {
      const int k = (tid >> 6) + 4 * i;
      t[k * 65 + n] = tv[i];
    }
  }
  __syncthreads();
#pragma unroll
  for (int i = 0; i < 2; ++i) {
    const int idx = tid + 256 * i;
    const int n = idx >> 3, kc = (idx & 7) * 8;
    h8 v;
#pragma unroll
    for (int j = 0; j < 8; ++j) v[j] = (half_t)t[(kc + j) * 65 + n];
    *(h8*)&dst[(size_t)(n0 + n) * ldd + k0 + kc] = v;
  }
  __syncthreads();
}

__device__ __forceinline__ void ln_rows(const KP& p, int lprev, bool final_) {
  int tid = threadIdx.x;
  asm volatile("" : "+v"(tid));
  const int lane = tid & 63, wid = tid >> 6;
  const int gw = blockIdx.x * 4 + wid, nw = gridDim.x * 4;
  for (int row = gw; row < NTOK; row += nw) {
    const float4* rp = (const float4*)((lprev < 0 ? p.x() : (const float*)p.u()) + (size_t)row * DM);
    float4 v[4];
    float s = 0.f;
#pragma unroll
    for (int i = 0; i < 4; ++i) {
      v[i] = rp[lane + 64 * i];
      s += v[i].x + v[i].y + v[i].z + v[i].w;
    }
    if (lprev >= 0) {
      float mu = wave_sum(s) * (1.f / DM);
      float q = 0.f;
#pragma unroll
      for (int i = 0; i < 4; ++i) {
        float a = v[i].x - mu, b = v[i].y - mu, c = v[i].z - mu, d = v[i].w - mu;
        q += a * a + b * b + c * c + d * d;
      }
      float rstd = rsqrtf(wave_sum(q) * (1.f / DM) + 1e-5f);
      const float4* g4 = (const float4*)(p.ln_g() + lprev * DM);
      const float4* b4 = (const float4*)(p.ln_b() + lprev * DM);
#pragma unroll
      for (int i = 0; i < 4; ++i) {
        float4 g = g4[lane + 64 * i], bb = b4[lane + 64 * i];
        v[i].x = (v[i].x - mu) * rstd * g.x + bb.x;
        v[i].y = (v[i].y - mu) * rstd * g.y + bb.y;
        v[i].z = (v[i].z - mu) * rstd * g.z + bb.z;
        v[i].w = (v[i].w - mu) * rstd * g.w + bb.w;
      }
    }
    if (final_) {
      float4* op = (float4*)(p.out() + (size_t)row * DM);
#pragma unroll
      for (int i = 0; i < 4; ++i) op[lane + 64 * i] = v[i];
    } else {
      float4* op = (float4*)(p.xr() + (size_t)row * DM);
      h4* hp = (h4*)(p.xh() + (size_t)row * DM);
#pragma unroll
      for (int i = 0; i < 4; ++i) {
        op[lane + 64 * i] = v[i];
        h4 hv;
        hv[0] = (half_t)v[i].x; hv[1] = (half_t)v[i].y; hv[2] = (half_t)v[i].z; hv[3] = (half_t)v[i].w;
        hp[lane + 64 * i] = hv;
      }
    }
  }
}

__device__ __forceinline__ void prep_weights(const KP& p, int l, char* smem) {
  int tid = threadIdx.x;
  asm volatile("" : "+v"(tid));
  const int total = 1856 + 384 + 256 + 16 + 64 + 2;
  for (int it = blockIdx.x; it < total; it += gridDim.x) {
    if (it < 1856) {
      const int nt = it >> 4, kt = it & 15;
      tconv_tile(p.w_in() + (size_t)l * DM * NIN, NIN, p.winT(), DM, nt * 64, kt * 64,
                 [](int n) { return orig_col(n); }, smem);
    } else if (it < 1856 + 384) {
      const int j = it - 1856;
      const int w = j >> 7, r = j & 127, nt = r >> 3, kt = r & 7;
      const float* src = (w == 0 ? p.wpa() : (w == 1 ? p.wpb() : p.wpc())) + (size_t)l * 512 * DM;
      tconv_tile(src, DM, p.wpT() + (size_t)w * DM * 512, 512, nt * 64, kt * 64, [](int n) { return n; }, smem);
    } else if (it < 1856 + 384 + 256) {
      const int j = it - 1856 - 384;
      const int nt = j >> 4, kt = j & 15;
      tconv_tile(p.wo() + (size_t)l * DM * DM, DM, p.woT(), DM, nt * 64, kt * 64, [](int n) { return n; }, smem);
    } else if (it < 1856 + 384 + 256 + 16) {
      const int j = it - 1856 - 384 - 256;
      const int g = j >> 2, nt = (j >> 1) & 1, kt = j & 1;
      tconv_tile(p.pool_w() + ((size_t)l * 4 + g) * 128 * 128, 128, p.poolT() + (size_t)g * 128 * 128, 128, nt * 64,
                 kt * 64, [](int n) { return n; }, smem);
    } else if (it < 1856 + 384 + 256 + 16 + 64) {
      const int j = it - 1856 - 384 - 256 - 16;
      const int kv = j >> 5, kt = j & 31;
      const float* src = (kv ? p.w1v() : p.w1k()) + (size_t)l * 2048 * 64;
      tconv_tile(src, 64, p.w1T() + (size_t)kv * 64 * 2048, 2048, 0, kt * 64, [](int n) { return n; }, smem);
    } else {
      const int kv = it - (1856 + 384 + 256 + 16 + 64);
      const float* w1 = (kv ? p.w1v() : p.w1k()) + (size_t)l * 2048 * 64;
      const float* pos = (kv ? p.pos_v() : p.pos_k()) + (size_t)l * 2048;
      float* red = (float*)smem;
      const int e = tid & 63, part = tid >> 6;
      float sa = 0.f, sb = 0.f, sc_ = 0.f, sd = 0.f;
      const float* wq = w1 + (size_t)part * 512 * 64 + e;
      const float* pq = pos + part * 512;
#pragma unroll 4
      for (int f = 0; f < 512; f += 4) {
        sa += pq[f] * wq[(size_t)f * 64];
        sb += pq[f + 1] * wq[(size_t)(f + 1) * 64];
        sc_ += pq[f + 2] * wq[(size_t)(f + 2) * 64];
        sd += pq[f + 3] * wq[(size_t)(f + 3) * 64];
      }
      const float s = (sa + sb) + (sc_ + sd);
      red[tid] = s;
      __syncthreads();
      if (tid < 64) p.posb()[kv * 64 + tid] = red[tid] + red[tid + 64] + red[tid + 128] + red[tid + 192];
      __syncthreads();
    }
  }
}

template <class F>
__device__ __forceinline__ void xcd_schedule(int* q, int xcc, int ngroups, int gsize, char* smem, F f) {
  int* s_item = (int*)(smem + SMEM_BYTES - 16);
  int* s_flag = (int*)(smem + SMEM_BYTES - 96);
  int* flags = q + 32;
#pragma unroll 1
  for (int dy = 0; dy < 8; ++dy) {
    const int y = (xcc + dy) & 7;
    if (dy == 1) {
      int t8 = threadIdx.x;
      asm volatile("" : "+v"(t8));
      if (t8 < 8) s_flag[t8] = __hip_atomic_load(&flags[t8], __ATOMIC_RELAXED, __HIP_MEMORY_SCOPE_AGENT);
      __syncthreads();
    }
    if (dy >= 1 && __builtin_amdgcn_readfirstlane(s_flag[y]) != 0) continue;
    for (;;) {
      if (threadIdx.x == 0) *s_item = atomicAdd(&q[y], 1);
      __syncthreads();
      const int i = __builtin_amdgcn_readfirstlane(*s_item);
      __syncthreads();
      const int grp = (i / gsize) * 8 + y;
      if (grp >= ngroups) {
        if (threadIdx.x == 0) __hip_atomic_store(&flags[y], 1, __ATOMIC_RELAXED, __HIP_MEMORY_SCOPE_AGENT);
        break;
      }
      f(grp, i % gsize);
    }
  }
}

__device__ __forceinline__ void phase_inproj(const KP& p, int l, char* smem, int* q, int xcc) {
  const float* bias = p.b_in() + (size_t)l * NIN;
  xcd_schedule(q, xcc, 128, 32, smem, [&](int grp, int within) __attribute__((always_inline)) {
    const int mt = (grp & 15) * 4 + (within & 3), nt = (grp >> 4) * 8 + (within >> 2);
    if (nt >= 58) return;
    const int m0 = mt * 256, n0 = nt * 128;
    const half_t* A = p.xh() + (size_t)m0 * DM;
    const half_t* B = p.winT() + (size_t)n0 * DM;
    int tidx = threadIdx.x;
    asm volatile("" : "+v"(tidx));
    const int lane = tidx & 63, wn = (tidx >> 6) & 1;
    float bv[2];
#pragma unroll
    for (int ni = 0; ni < 2; ++ni) {
      const int oc = orig_col(n0 + wn * 64 + ni * 32 + (lane & 31));
      bv[ni] = oc >= 0 ? bias[oc] : 0.f;
    }
    half_t* vT = (nt == 53) ? p.vsT() : ((nt == 55) ? p.vwT() : nullptr);
    gemm_tile_big(
        DM, [&](int r, int k) { return *(const uint4*)(A + (size_t)r * DM + k); },
        [&](int r, int k) { return *(const uint4*)(B + (size_t)r * DM + k); },
        [&](int mi, int ni, int r, int row, int col, float v) {
          const half_t hv = (half_t)(v + bv[ni]);
          const int tok = m0 + row;
          p.u()[(size_t)tok * NU + n0 + col] = hv;
          if (vT) {
            const int b = tok >> 13, t = tok & 8191;
            vT[((size_t)(b * 2 + (col >> 6)) * 64 + (col & 63)) * SEQ + t] = hv;
          }
        },
        smem);
  });
}

__device__ __forceinline__ void pool_item(const KP& p, int l, int item, char* smem) {
  const int g = item & 3, mt = item >> 2;
  const int m0 = mt * 128;
  const int wnd = 2 << g;
  const half_t* B = p.poolT() + (size_t)g * 128 * 128;
  int tidx = threadIdx.x;
  asm volatile("" : "+v"(tidx));
  const int lane = tidx & 63, wn = (tidx >> 6) & 1;
  float pb[2], ps[2];
#pragma unroll
  for (int ni = 0; ni < 2; ++ni) {
    const int d = wn * 64 + ni * 32 + (lane & 31);
    pb[ni] = p.pool_b()[(size_t)l * 512 + g * 128 + d];
    ps[ni] = p.pool_scale()[(size_t)l * 512 + g * 128 + d];
  }
  gemm_tile<2>(
      128,
      [&](int r, int k) {
        const int tok = m0 + r, t = tok & 8191;
        const int cnt = min(t + 1, wnd);
        const half_t* base = p.u() + (size_t)tok * NU + C_AX + g * 128 + k;
        float s[8];
#pragma unroll
        for (int j = 0; j < 8; ++j) s[j] = 0.f;
        h8 cur = *(const h8*)base;
        for (int q0 = 0; q0 < wnd; q0 += 8) {
          h8 v[8];
#pragma unroll
          for (int i = 0; i < 8; ++i) {
            const int qq = q0 + i;
            if (qq < cnt) v[i] = *(const h8*)(base - (size_t)qq * NU);
            else {
#pragma unroll
              for (int j = 0; j < 8; ++j) v[i][j] = (half_t)0.f;
            }
          }
#pragma unroll
          for (int i = 0; i < 8; ++i)
#pragma unroll
            for (int j = 0; j < 8; ++j) s[j] += (float)v[i][j];
        }
        const float inv = 1.f / (float)cnt;
        h8 o;
#pragma unroll
        for (int j = 0; j < 8; ++j) o[j] = (half_t)(s[j] * inv - (float)cur[j]);
        return *(uint4*)&o;
      },
      [&](int r, int k) { return *(const uint4*)(B + (size_t)r * 128 + k); },
      [&](int mi, int ni, int r, int row, int col, float v) {
        const int tok = m0 + row;
        const float z = (float)p.u()[(size_t)tok * NU + C_AZ + g * 128 + col];
        p.ya()[(size_t)tok * 512 + g * 128 + col] = (half_t)((v + pb[ni]) * ps[ni] * siluf_(z));
      },
      smem);
}

__device__ __forceinline__ void compress_item(const KP& p, int l, int item, char* smem) {
  const int mt = item & 3, kv = (item >> 2) & 1, g = (item >> 3) & 1, b = item >> 4;
  int tid = threadIdx.x;
  asm volatile("" : "+v"(tid));
  const int ccol = (kv ? C_CVC : C_CKC) + g * 64;
  const half_t* ub = p.u() + (size_t)b * SEQ * NU + ccol;
  const half_t* B = p.w1T() + (size_t)kv * 64 * 2048;
  float* hid = (float*)(smem + 28672);
  const float* posb = p.posb() + kv * 64;
  gemm_tile<1>(
      2048,
      [&](int r, int k) {
        const int n = mt * 128 + r;
        if (n >= 511) return make_uint4(0, 0, 0, 0);
        const int tok = 16 * n + (k >> 6);
        return *(const uint4*)(ub + (size_t)tok * NU + (k & 63));
      },
      [&](int r, int k) { return *(const uint4*)(B + (size_t)r * 2048 + k); },
      [&](int mi, int ni, int r, int row, int col, float v) { hid[row * 65 + col] = siluf_(v + posb[col]); }, smem);
  __syncthreads();
  float* w2s = (float*)smem;
  const float* w2 = (kv ? p.w2v() : p.w2k()) + (size_t)l * 4096;
  for (int i = tid; i < 4096; i += 256) w2s[i] = w2[i];
  __syncthreads();
  {
    const int n = tid >> 1, fh = (tid & 1) * 32;
    float acc[32];
#pragma unroll
    for (int f = 0; f < 32; ++f) acc[f] = 0.f;
    for (int e = 0; e < 64; ++e) {
      const float hv = hid[n * 65 + e];
#pragma unroll
      for (int f = 0; f < 32; ++f) acc[f] += hv * w2s[e * 64 + fh + f];
    }
    const int ng = mt * 128 + n;
    const bool valid = ng < 511;
    if (kv == 0) {
      half_t* dst = p.kcmp() + ((size_t)(b * 2 + g) * 512 + ng) * 64 + fh;
#pragma unroll
      for (int f = 0; f < 32; ++f) dst[f] = valid ? (half_t)acc[f] : (half_t)0.f;
    } else {
      half_t* dst = p.vcmpT() + ((size_t)(b * 2 + g) * 64 + fh) * 512 + ng;
#pragma unroll
      for (int f = 0; f < 32; ++f) dst[(size_t)f * 512] = valid ? (half_t)acc[f] : (half_t)0.f;
    }
  }
  __syncthreads();
}

#ifndef DSA_CAP
#define DSA_CAP 128
#endif
__device__ __forceinline__ void dsa_item(const KP& p, int b, int tile, char* smem) {
  const int t0 = tile * 16;
  int tid = threadIdx.x;
  asm volatile("" : "+v"(tid));
  const int lane = tid & 63, wid = tid >> 6;
  uint32_t* hist = (uint32_t*)smem;
  unsigned long long* cand = (unsigned long long*)(smem + 16384);
  unsigned short* sel = (unsigned short*)(smem + 32768);
  unsigned long long* pfx = (unsigned long long*)(smem + 40960);
  unsigned long long* tkey = pfx + 16;
  int* need = (int*)(tkey + 16);
  int* state = need + 16;
  int* cnt = state + 16;
  int* ccnt = cnt + 16;
  int* pf16 = ccnt + 16;
  int* ovf = pf16 + 16;
  int* nrem = ovf + 16;
  int* fastf = nrem + 8;
  uint32_t* h1w = (uint32_t*)(smem + 43008);
  float* pbuf = (float*)smem + wid * 2048;

  const half_t* ub = p.u() + (size_t)b * SEQ * NU;
  const int mytok = lane & 15, hq = lane >> 4;
  const int myt = t0 + mytok;
  if (tid < 16) {
    const int t = t0 + tid;
    pfx[tid] = 0ull; tkey[tid] = 0ull; need[tid] = 256; state[tid] = (t < 256) ? 0 : 1; cnt[tid] = 0; ccnt[tid] = 0;
    pf16[tid] = 0; ovf[tid] = 0;
  }
  if (tid < 8) nrem[tid] = 0;
  if (tid < 16) fastf[tid] = 0;
  for (int i = tid; i < 6144; i += 256) h1w[i] = 0u;
  h8 qf[8], qlh, qll;
  float iw[8];
  {
    const half_t* qrow = ub + (size_t)myt * NU;
#pragma unroll
    for (int h = 0; h < 8; ++h) qf[h] = *(const h8*)(qrow + C_IQ + h * 32 + hq * 8);
    const h8 w8 = *(const h8*)(qrow + C_IW);
#pragma unroll
    for (int h = 0; h < 8; ++h) iw[h] = (float)w8[h] * 0.03125f;
#pragma unroll
    for (int e = 0; e < 8; ++e) {
      float a = 0.f;
#pragma unroll
      for (int h = 0; h < 8; ++h) a += iw[h] * (float)qf[h][e];
      const half_t hi = (half_t)a;
      qlh[e] = hi;
      qll[e] = (half_t)(a - (float)hi);
    }
  }
  __syncthreads();
  const int nkt = (t0 + 16 + 31) >> 5;

  auto loadk = [&](int kt, h8* a) __attribute__((always_inline)) {
#pragma unroll
    for (int i = 0; i < 2; ++i)
      a[i] = *(const h8*)(ub + (size_t)(kt * 32 + i * 16 + (lane & 15)) * NU + C_IK + hq * 8);
  };
  auto scores = [&](const h8* a, float* sc) __attribute__((always_inline)) {
#pragma unroll
    for (int i = 0; i < 2; ++i) {
      f32x4 acc = {0.f, 0.f, 0.f, 0.f};
      acc = __builtin_amdgcn_mfma_f32_16x16x32_f16(a[i], qll, acc, 0, 0, 0);
      acc = __builtin_amdgcn_mfma_f32_16x16x32_f16(a[i], qlh, acc, 0, 0, 0);
#pragma unroll
      for (int h = 0; h < 8; ++h) {
        f32x4 d = {0.f, 0.f, 0.f, 0.f};
        d = __builtin_amdgcn_mfma_f32_16x16x32_f16(a[i], qf[h], d, 0, 0, 0);
#pragma unroll
        for (int r = 0; r < 4; ++r) acc[r] = __builtin_fmaf(__builtin_fabsf(d[r]), iw[h], acc[r]);
      }
#pragma unroll
      for (int r = 0; r < 4; ++r) sc[i * 4 + r] = acc[r];
    }
  };
  auto skey = [&](float s) __attribute__((always_inline)) -> uint32_t {
    s = s + 0.f;
    const uint32_t u_ = __float_as_uint(s);
    return (u_ & 0x80000000u) ? ~u_ : (u_ | 0x80000000u);
  };
  auto mkkey = [&](float s, int key) __attribute__((always_inline)) -> unsigned long long {
    s = s + 0.f;
    uint32_t u_ = __float_as_uint(s);
    u_ = (u_ & 0x80000000u) ? ~u_ : (u_ | 0x80000000u);
    return ((unsigned long long)u_ << 16) | (unsigned long long)(8191 - key);
  };
  auto scan_token = [&](int tk, int level) __attribute__((always_inline)) -> bool {
    const int shift = 40 - 8 * level;
    const uint32_t* hrow = hist + tk * 256;
    const uint4 hv = *(const uint4*)&hrow[252 - 4 * lane];
    const int c = (int)(hv.x + hv.y + hv.z + hv.w);
    int cum = c;
#pragma unroll
    for (int o = 1; o < 64; o <<= 1) {
      int v = __shfl_up(cum, o);
      if (lane >= o) cum += v;
    }
    const int nd = need[tk];
    const unsigned long long mask = __ballot(cum >= nd);
    const int L = mask ? (int)__builtin_ctzll(mask) : 63;
    int running = cum - c, bstar, cb;
    if (running + (int)hv.w >= nd) { bstar = 255 - 4 * lane; cb = hv.w; }
    else {
      running += hv.w;
      if (running + (int)hv.z >= nd) { bstar = 254 - 4 * lane; cb = hv.z; }
      else {
        running += hv.z;
        if (running + (int)hv.y >= nd) { bstar = 253 - 4 * lane; cb = hv.y; }
        else { running += hv.y; bstar = 252 - 4 * lane; cb = hv.x; }
      }
    }
    running = __shfl(running, L); bstar = __shfl(bstar, L); cb = __shfl(cb, L);
    const int nd2 = nd - running;
    const bool fin = (cb == nd2) || (level == 5);
    if (lane == 0) {
      const unsigned long long np = (pfx[tk] << 8) | (unsigned long long)bstar;
      if (fin) { state[tk] = 0; tkey[tk] = np << shift; }
      else { need[tk] = nd2; pfx[tk] = np; }
    }
    return fin;
  };
  auto run_level = [&](int level, bool fillx) __attribute__((always_inline)) {
    const int shift = 40 - 8 * level;
    for (int i = tid; i < 4096; i += 256) hist[i] = 0u;
    __syncthreads();
    {
      const unsigned long long mypfx = pfx[mytok];
      const bool act = state[mytok] == 1 && fastf[mytok] == 0;
      h8 na[2];
      if (wid < nkt) loadk(wid, na);
      for (int kt = wid; kt < nkt; kt += 4) {
        h8 ca[2];
#pragma unroll
        for (int i = 0; i < 2; ++i) ca[i] = na[i];
        loadk(kt + 4 < nkt ? kt + 4 : kt, na);
        float sc[8];
        scores(ca, sc);
        if (act) {
#pragma unroll
          for (int q = 0; q < 8; ++q) {
            const int key = kt * 32 + (q >> 2) * 16 + 4 * hq + (q & 3);
            if (key <= myt) {
              if (level < 2) {
                const uint32_t u32 = skey(sc[q]);
                if (level == 0) {
                  const uint32_t b8 = u32 >> 24;
                  atomicAdd(&hist[mytok * 256 + (int)b8], 1u);
                  if (fillx) {
                    const uint32_t ix = b8 - 0xBEu;
                    if (ix < 3u) {
                      const uint32_t e16 = (ix * 16u + (uint32_t)mytok) * 256u + ((u32 >> 16) & 255u);
                      atomicAdd(&h1w[e16 >> 1], (e16 & 1u) ? 65536u : 1u);
                    }
                  }
                } else if ((u32 >> 24) == (uint32_t)mypfx) atomicAdd(&hist[mytok * 256 + (int)((u32 >> 16) & 255u)], 1u);
              } else {
                const unsigned long long k48 = mkkey(sc[q], key);
                if ((k48 >> (shift + 8)) == mypfx)
                  atomicAdd(&hist[mytok * 256 + (int)((k48 >> shift) & 255ull)], 1u);
              }
            }
          }
        }
      }
    }
    __syncthreads();
    {
      int rem = 0;
      for (int j = 0; j < 4; ++j) {
        const int tk = wid * 4 + j;
        if (state[tk] != 1 || fastf[tk] != 0) continue;
        if (!scan_token(tk, level)) rem++;
      }
      if (lane == 0 && rem) atomicAdd(&nrem[level], rem);
    }
    __syncthreads();
  };

  run_level(0, true);
  if (tid < 16) {
    const int b0 = (int)pfx[tid];
    const int f = (state[tid] == 1 && b0 >= 0xBE && b0 <= 0xC0) ? 1 : 0;
    fastf[tid] = f;
    if (state[tid] == 1 && !f) atomicAdd(&nrem[7], 1);
  }
  __syncthreads();
  if (nrem[7] != 0) run_level(1, false);
  for (int j = 0; j < 4; ++j) {
    const int tk = wid * 4 + j;
    if (state[tk] != 1 || fastf[tk] == 0) continue;
    const uint32_t ix = (uint32_t)pfx[tk] - 0xBEu;
    const unsigned short* hx = (const unsigned short*)h1w + (ix * 16u + (uint32_t)tk) * 256u;
    const ushort4 c4 = *(const ushort4*)&hx[4 * lane];
    uint4 w4;
    w4.x = c4.x; w4.y = c4.y; w4.z = c4.z; w4.w = c4.w;
    *(uint4*)&hist[tk * 256 + 4 * lane] = w4;
    __builtin_amdgcn_wave_barrier();
    scan_token(tk, 1);
  }
  __syncthreads();
  if (tid < 16) fastf[tid] = 0;
  __syncthreads();

  {
    const int st0 = state[mytok];
    const unsigned long long mytk = tkey[mytok];
    const unsigned long long myp16 = pfx[mytok];
    h8 na[2];
    if (wid < nkt) loadk(wid, na);
    for (int kt = wid; kt < nkt; kt += 4) {
      h8 ca[2];
#pragma unroll
      for (int i = 0; i < 2; ++i) ca[i] = na[i];
      loadk(kt + 4 < nkt ? kt + 4 : kt, na);
      float sc[8];
      scores(ca, sc);
#pragma unroll
      for (int q = 0; q < 8; ++q) {
        const int key = kt * 32 + (q >> 2) * 16 + 4 * hq + (q & 3);
        if (key <= myt) {
          const uint32_t u32 = skey(sc[q]);
          bool take, isc = false;
          if (st0 == 0) take = (((unsigned long long)u32 << 16) | (unsigned long long)(8191 - key)) >= mytk;
          else {
            const uint32_t p16 = u32 >> 16;
            take = p16 > (uint32_t)myp16;
            isc = p16 == (uint32_t)myp16;
          }
          if (take) {
            const int pos = atomicAdd(&cnt[mytok], 1);
            if (pos < 256) sel[mytok * 256 + pos] = (unsigned short)key;
          } else if (isc) {
            const int pos = atomicAdd(&ccnt[mytok], 1);
            if (pos < DSA_CAP) cand[mytok * 128 + pos] = ((unsigned long long)u32 << 16) | (unsigned long long)(8191 - key);
          }
        }
      }
    }
  }
  __syncthreads();
  {
    int nov = 0;
    for (int j = 0; j < 4; ++j) {
      const int tk = wid * 4 + j;
      if (state[tk] != 1) continue;
      const int nc = ccnt[tk];
      if (nc > DSA_CAP) {
        nov++;
        if (lane == 0) { ovf[tk] = 1; pf16[tk] = (int)pfx[tk]; }
        continue;
      }
      const int nd = need[tk];
      const unsigned long long k0 = (lane < nc) ? cand[tk * 128 + lane] : 0ull;
      const unsigned long long k1 = (lane + 64 < nc) ? cand[tk * 128 + lane + 64] : 0ull;
      int r0 = 0, r1 = 0;
      for (int q = 0; q < nc; ++q) {
        const unsigned long long kq = cand[tk * 128 + q];
        r0 += (kq > k0) ? 1 : 0;
        r1 += (kq > k1) ? 1 : 0;
      }
      if (lane < nc && r0 < nd) {
        const int pos = atomicAdd(&cnt[tk], 1);
        if (pos < 256) sel[tk * 256 + pos] = (unsigned short)(8191 - (int)(k0 & 0xFFFFull));
      }
      if (lane + 64 < nc && r1 < nd) {
        const int pos = atomicAdd(&cnt[tk], 1);
        if (pos < 256) sel[tk * 256 + pos] = (unsigned short)(8191 - (int)(k1 & 0xFFFFull));
      }
      if (lane == 0) state[tk] = 2;
    }
    if (lane == 0 && nov) atomicAdd(&nrem[6], nov);
  }
  __syncthreads();
  if (nrem[6] != 0) {
    for (int level = 2; level < 6; ++level) {
      run_level(level, false);
      if (nrem[level] == 0) break;
    }
    {
      const bool mine = ovf[mytok] != 0;
      const unsigned long long mytk = tkey[mytok];
      const unsigned long long myp16 = (unsigned long long)(unsigned)pf16[mytok];
      h8 na[2];
      if (wid < nkt) loadk(wid, na);
      for (int kt = wid; kt < nkt; kt += 4) {
        h8 ca[2];
#pragma unroll
        for (int i = 0; i < 2; ++i) ca[i] = na[i];
        loadk(kt + 4 < nkt ? kt + 4 : kt, na);
        float sc[8];
        scores(ca, sc);
        if (mine) {
#pragma unroll
          for (int q = 0; q < 8; ++q) {
            const int key = kt * 32 + (q >> 2) * 16 + 4 * hq + (q & 3);
            if (key <= myt) {
              const unsigned long long k48 = mkkey(sc[q], key);
              if ((k48 >> 32) == myp16 && k48 >= mytk) {
                const int pos = atomicAdd(&cnt[mytok], 1);
                if (pos < 256) sel[mytok * 256 + pos] = (unsigned short)key;
              }
            }
          }
        }
      }
    }
    __syncthreads();
  }
#ifndef DSA_ATT_REP
#define DSA_ATT_REP 1
#endif
  for (int jr = 0; jr < 4 * DSA_ATT_REP; ++jr) {
    const int j = jr & 3;
    const int tk = wid * 4 + j;
    const int t = t0 + tk;
    const int nsel = min(cnt[tk], 256);
    const half_t* urow = ub + (size_t)t * NU;
    const int col = lane & 15;
    h8 q0, q1;
#pragma unroll
    for (int e = 0; e < 8; ++e) { q0[e] = (half_t)0.f; q1[e] = (half_t)0.f; }
    if (col < 8) {
      q0 = *(const h8*)(urow + C_BQ + col * 64 + hq * 8);
      q1 = *(const h8*)(urow + C_BQ + col * 64 + 32 + hq * 8);
    }
    float mx = NEGF;
#pragma unroll 1
    for (int mg = 0; mg < 2; ++mg) {
#pragma unroll
      for (int mm = 0; mm < 8; ++mm) {
        const int m = mg * 8 + mm;
        const int pos = m * 16 + col;
        const int s = (pos < nsel) ? (int)sel[tk * 256 + pos] : 0;
        const half_t* kp = ub + (size_t)s * NU + C_BK + hq * 8;
        const h8 a0 = *(const h8*)kp, a1 = *(const h8*)(kp + 32);
        f32x4 d = {0.f, 0.f, 0.f, 0.f};
        d = __builtin_amdgcn_mfma_f32_16x16x32_f16(a0, q0, d, 0, 0, 0);
        d = __builtin_amdgcn_mfma_f32_16x16x32_f16(a1, q1, d, 0, 0, 0);
#pragma unroll
        for (int r = 0; r < 4; ++r) {
          const int pp = m * 16 + hq * 4 + r;
          const float v = (pp < nsel) ? d[r] * 0.125f : NEGF;
          mx = fmaxf(mx, v);
          if (col < 8) pbuf[pp * 8 + col] = v;
        }
      }
    }
    mx = fmaxf(mx, __shfl_xor(mx, 16));
    mx = fmaxf(mx, __shfl_xor(mx, 32));
    const float mxh = __shfl(mx, lane & 7);
    __builtin_amdgcn_wave_barrier();
    float sum = 0.f;
#pragma unroll 4
    for (int k = 0; k < 32; ++k) {
      const int i = lane + 64 * k;
      const float v = pbuf[i];
      const float e = (v > -1e29f) ? __expf(v - mxh) : 0.f;
      pbuf[i] = e;
      sum += e;
    }
    sum += __shfl_xor(sum, 8);
    sum += __shfl_xor(sum, 16);
    sum += __shfl_xor(sum, 32);
    const float inv = 1.f / sum;
    __builtin_amdgcn_wave_barrier();
    {
      const int rs = lane >> 3, dc = lane & 7;
      float acc[8][8];
#pragma unroll
      for (int h = 0; h < 8; ++h)
#pragma unroll
        for (int e = 0; e < 8; ++e) acc[h][e] = 0.f;
#pragma unroll 1
      for (int g8 = 0; g8 < 4; ++g8) {
        h8 vv[8];
#pragma unroll
        for (int i = 0; i < 8; ++i) {
          const int pos = (g8 * 8 + i) * 8 + rs;
          const int s = (pos < nsel) ? (int)sel[tk * 256 + pos] : 0;
          vv[i] = *(const h8*)(ub + (size_t)s * NU + C_BV + dc * 8);
        }
#pragma unroll
        for (int i = 0; i < 8; ++i) {
          const int pos = (g8 * 8 + i) * 8 + rs;
          const f32x4 pa = *(const f32x4*)&pbuf[pos * 8];
          const f32x4 pb = *(const f32x4*)&pbuf[pos * 8 + 4];
          float vf[8];
#pragma unroll
          for (int e = 0; e < 8; ++e) vf[e] = (float)vv[i][e];
#pragma unroll
          for (int e = 0; e < 8; ++e) {
            acc[0][e] += pa[0] * vf[e]; acc[1][e] += pa[1] * vf[e]; acc[2][e] += pa[2] * vf[e]; acc[3][e] += pa[3] * vf[e];
            acc[4][e] += pb[0] * vf[e]; acc[5][e] += pb[1] * vf[e]; acc[6][e] += pb[2] * vf[e]; acc[7][e] += pb[3] * vf[e];
          }
        }
      }
      half_t* yrow = p.yb() + (size_t)(b * SEQ + t) * 512;
#pragma unroll
      for (int h = 0; h < 8; ++h) {
        const float invh = __shfl(inv, h);
        h8 ov;
        const h8 z8 = *(const h8*)(urow + C_BZ + h * 64 + dc * 8);
#pragma unroll
        for (int e = 0; e < 8; ++e) {
          float a = acc[h][e];
          a += __shfl_xor(a, 8);
          a += __shfl_xor(a, 16);
          a += __shfl_xor(a, 32);
          ov[e] = (half_t)(a * invh * siluf_((float)z8[e]));
        }
        if (rs == h) *(h8*)(yrow + h * 64 + dc * 8) = ov;
      }
    }
    __builtin_amdgcn_wave_barrier();
  }
  __syncthreads();
}

__device__ __forceinline__ void phase2(const KP& p, int l, char* smem, int* q, int xcc) {
  xcd_schedule(q, xcc, 32, 1, smem, [&](int grp, int) __attribute__((always_inline)) { compress_item(p, l, grp, smem); });
  xcd_schedule(q + 8, xcc, 1024, 1, smem, [&](int grp, int) __attribute__((always_inline)) {
    const int y = grp & 7, k = grp >> 3;
    dsa_item(p, y & 1, 511 - (k * 4 + (y >> 1)), smem);
  });
  xcd_schedule(q + 16, xcc, 512, 1, smem, [&](int grp, int) __attribute__((always_inline)) { pool_item(p, l, grp, smem); });
}

struct DState {
  float m, l;
  f32x16 o[2];
};
#define MLOW (-1e4f)
__device__ __forceinline__ void ds_reset(DState& st) {
  st.m = MLOW; st.l = 0.f;
#pragma unroll
  for (int dt = 0; dt < 2; ++dt)
#pragma unroll
    for (int r = 0; r < 16; ++r) st.o[dt][r] = 0.f;
}
typedef unsigned int u32x4 __attribute__((ext_vector_type(4)));
typedef unsigned int u32x2 __attribute__((ext_vector_type(2)));
struct StageRegs {
  u32x4 k0, k1, v0, v1;
};
template <bool HASV>
__device__ __forceinline__ void load_stage(StageRegs& r, const half_t* __restrict__ Kb, int ldk,
                                           const half_t* __restrict__ VT, int ldv, int key0, int tid) {
  const int row = tid >> 3, c = tid & 7;
  r.k0 = *(const u32x4*)(Kb + (size_t)(key0 + row) * ldk + c * 8);
  r.k1 = *(const u32x4*)(Kb + (size_t)(key0 + row + 32) * ldk + c * 8);
  if (HASV) {
    r.v0 = *(const u32x4*)(VT + (size_t)row * ldv + key0 + c * 8);
    r.v1 = *(const u32x4*)(VT + (size_t)(row + 32) * ldv + key0 + c * 8);
  }
}
template <bool HASV>
__device__ __forceinline__ void write_stage(const StageRegs& r, half_t* Ks, half_t* Vs, int tid) {
  const int row = tid >> 3, c = tid & 7;
  *(u32x4*)&Ks[row * 72 + c * 8] = r.k0;
  *(u32x4*)&Ks[(row + 32) * 72 + c * 8] = r.k1;
  if (HASV) {
    const int ks = c >> 1, a = c & 1;
    u32x2 lo, hi;
    lo[0] = r.v0[0]; lo[1] = r.v0[1]; hi[0] = r.v0[2]; hi[1] = r.v0[3];
    *(u32x2*)&Vs[row * 72 + ks * 16 + a * 4] = lo;
    *(u32x2*)&Vs[row * 72 + ks * 16 + 8 + a * 4] = hi;
    lo[0] = r.v1[0]; lo[1] = r.v1[1]; hi[0] = r.v1[2]; hi[1] = r.v1[3];
    *(u32x2*)&Vs[(row + 32) * 72 + ks * 16 + a * 4] = lo;
    *(u32x2*)&Vs[(row + 32) * 72 + ks * 16 + 8 + a * 4] = hi;
  }
}
template <bool ONLINE, bool HASV, bool FAST, class VF>
__device__ __forceinline__ void dense_block(DState& st, const half_t* Ks, const half_t* Vs, const h8* qf, int key0,
                                            int flag, VF valid, float fixed_m, float fixed_invl, f32x16* pout,
                                            int lane) {
  const int h = lane >> 5, c = lane & 31;
  f32x16 s[2];
#pragma unroll
  for (int kt = 0; kt < 2; ++kt) {
#pragma unroll
    for (int r = 0; r < 16; ++r) s[kt][r] = 0.f;
#pragma unroll
    for (int ks = 0; ks < 4; ++ks) {
      const h8 a = *(const h8*)&Ks[(32 * kt + c) * 72 + 16 * ks + 8 * h];
      s[kt] = __builtin_amdgcn_mfma_f32_32x32x16_f16(a, qf[ks], s[kt], 0, 0, 0);
    }
  }
  float cm = NEGF;
#pragma unroll
  for (int kt = 0; kt < 2; ++kt)
#pragma unroll
    for (int r = 0; r < 16; ++r) {
      const int key = key0 + 32 * kt + (r & 3) + 8 * (r >> 2) + 4 * h;
      const float v = (FAST ? (flag != 0) : valid(key, flag)) ? s[kt][r] : NEGF;
      s[kt][r] = v;
      cm = fmaxf(cm, v);
    }
  float mnew;
  if (ONLINE) {
    cm = fmaxf(cm, __shfl_xor(cm, 32));
    mnew = st.m;
    if (__ballot(cm > st.m + 8.0f) != 0ull) {
      mnew = fmaxf(st.m, cm);
      const float alpha = __builtin_amdgcn_exp2f(st.m - mnew);
      st.m = mnew;
      st.l *= alpha;
      if (HASV) {
#pragma unroll
        for (int dt = 0; dt < 2; ++dt)
#pragma unroll
          for (int r = 0; r < 16; ++r) st.o[dt][r] *= alpha;
      }
    }
  } else {
    mnew = fixed_m;
  }
  float ps = 0.f;
#pragma unroll
  for (int kt = 0; kt < 2; ++kt)
#pragma unroll
    for (int r = 0; r < 16; ++r) {
      float e = __builtin_amdgcn_exp2f(s[kt][r] - mnew);
      if (!ONLINE) e *= fixed_invl;
      s[kt][r] = e;
      ps += e;
    }
  st.l += ps;
  if (pout) { pout[0] = s[0]; pout[1] = s[1]; }
  if (HASV) {
#pragma unroll
    for (int ks = 0; ks < 4; ++ks) {
      h8 pf;
#pragma unroll
      for (int jj = 0; jj < 8; ++jj) pf[jj] = (half_t)s[ks >> 1][8 * (ks & 1) + jj];
#pragma unroll
      for (int dt = 0; dt < 2; ++dt) {
        const h8 vf = *(const h8*)&Vs[(32 * dt + c) * 72 + 16 * ks + 8 * h];
        st.o[dt] = __builtin_amdgcn_mfma_f32_32x32x16_f16(vf, pf, st.o[dt], 0, 0, 0);
      }
    }
  }
}
template <bool ONLINE, bool HASV, bool WANTP, class PRE, class FU, class VF, class PO>
__device__ __forceinline__ void run_dense(DState& st, const half_t* __restrict__ Kb, int ldk,
                                          const half_t* __restrict__ VT, int ldv, int blk_lo, int blk_hi, const h8* qf,
                                          PRE pre, FU full, VF valid, float fixed_m, float fixed_invl, PO post, char* smem,
                                          int tid) {
  half_t* Ks = (half_t*)smem;
  half_t* Vs = Ks + 64 * 72;
  const int lane = tid & 63;
  StageRegs sr;
  load_stage<HASV>(sr, Kb, ldk, VT, ldv, blk_lo * 64, tid);
  for (int blk = blk_lo; blk <= blk_hi; ++blk) {
    __syncthreads();
    write_stage<HASV>(sr, Ks, Vs, tid);
    __syncthreads();
    const int nb = blk < blk_hi ? blk + 1 : blk;
    load_stage<HASV>(sr, Kb, ldk, VT, ldv, nb * 64, tid);
    const int flag = pre(blk);
    if (__ballot(flag != 0) != 0ull) {
      f32x16 pp[2];
      if (full(blk))
        dense_block<ONLINE, HASV, true>(st, Ks, Vs, qf, blk * 64, flag, valid, fixed_m, fixed_invl,
                                        WANTP ? pp : (f32x16*)nullptr, lane);
      else
        dense_block<ONLINE, HASV, false>(st, Ks, Vs, qf, blk * 64, flag, valid, fixed_m, fixed_invl,
                                         WANTP ? pp : (f32x16*)nullptr, lane);
      if (WANTP) post(blk * 64, pp);
    }
  }
}

__device__ __forceinline__ void nsa_item(const KP& p, int b, int g, int tile, char* smem) {
  int tid = threadIdx.x;
  asm volatile("" : "+v"(tid));
  const int lane = tid & 63, wid = tid >> 6;
  const int t0 = tile * 32;
  const int tw0 = t0 + 8 * wid;
  const int col = lane & 31, h = lane >> 5;
  const int j = col >> 2, r4 = col & 3;
  const int tj = tw0 + j;
  const int head = g * 4 + r4;
  float* impA = (float*)(smem + 18432 + wid * 8320);
  float* impB = impA + 1024;
  unsigned long long* msk = (unsigned long long*)(smem + 18432 + 4 * 8320 + wid * 128);
  uint32_t* kbuf = (uint32_t*)(smem + 18432 + 4 * 8320 + 512 + wid * 512);
  const half_t* ub = p.u() + (size_t)b * SEQ * NU;
  const half_t* urow = ub + (size_t)tj * NU;
  h8 qf[4];
#pragma unroll
  for (int ks = 0; ks < 4; ++ks) {
    qf[ks] = *(const h8*)(urow + C_CQ + head * 64 + 16 * ks + 8 * h);
#pragma unroll
    for (int e = 0; e < 8; ++e) qf[ks][e] = (half_t)((float)qf[ks][e] * 0.18033688f);
  }
  float gate[3];
#pragma unroll
  for (int i = 0; i < 3; ++i) gate[i] = sigmoidf_((float)urow[C_CG + head * 3 + i]);
  f32x16 res[2];
#pragma unroll
  for (int dt = 0; dt < 2; ++dt)
#pragma unroll
    for (int r = 0; r < 16; ++r) res[dt][r] = 0.f;
  for (int i = lane; i < 2080; i += 64) impA[i] = 0.f;
  DState st;
  auto nopost = [&](int, f32x16*) __attribute__((always_inline)) {};

  {
    const int nmax_j = (tj >= 31) ? ((tj - 31) >> 4) : -1;
    const int bhi = (t0 >> 4) >> 6;
    const half_t* Kc = p.kcmp() + (size_t)(b * 2 + g) * 512 * 64;
    const half_t* Vc = p.vcmpT() + (size_t)(b * 2 + g) * 64 * 512;
    auto pre = [&](int) __attribute__((always_inline)) { return 1; };
    const int nmax_w = (tw0 >= 31) ? ((tw0 - 31) >> 4) : -1;
    auto fullc = [&](int blk) __attribute__((always_inline)) { return blk * 64 + 63 <= nmax_w; };
    auto vfn = [&](int n, int) __attribute__((always_inline)) { return n <= nmax_j; };
    ds_reset(st);
    run_dense<true, false, false>(st, Kc, 64, (const half_t*)nullptr, 0, 0, bhi, qf, pre, fullc, vfn, 0.f, 0.f, nopost, smem, tid);
    float lt = st.l;
    lt += __shfl_xor(lt, 32);
    const float mfix = st.m;
    const float invl = lt > 0.f ? 1.f / lt : 0.f;
    ds_reset(st);
    auto post = [&](int n0, f32x16* pp) __attribute__((always_inline)) {
#pragma unroll
      for (int kt = 0; kt < 2; ++kt)
#pragma unroll
        for (int qd = 0; qd < 4; ++qd) {
          float a = pp[kt][4 * qd] + pp[kt][4 * qd + 1] + pp[kt][4 * qd + 2] + pp[kt][4 * qd + 3];
          float bb = pp[kt][4 * qd + 3];
          a += __shfl_xor(a, 1); a += __shfl_xor(a, 2);
          bb += __shfl_xor(bb, 1); bb += __shfl_xor(bb, 2);
          if (r4 == 0) {
            const int sblk = (n0 >> 2) + 8 * kt + 2 * qd + h;
            impA[j * 128 + sblk] = a;
            impB[j * 132 + sblk + 1] = bb;
          }
        }
    };
    run_dense<false, true, true>(st, Kc, 64, Vc, 512, 0, bhi, qf, pre, fullc, vfn, mfix, invl, post, smem, tid);
#pragma unroll
    for (int dt = 0; dt < 2; ++dt)
#pragma unroll
      for (int r = 0; r < 16; ++r) res[dt][r] += gate[0] * st.o[dt][r];
  }
  __builtin_amdgcn_wave_barrier();
#pragma unroll 1
  for (int jj = 0; jj < 8; ++jj) {
    const int t = tw0 + jj;
    const int blk = t >> 6;
    uint32_t k0, k1;
    {
      const int s0 = lane, s1 = lane + 64;
      const float i0 = impA[jj * 128 + s0] + impB[jj * 132 + s0];
      const float i1 = impA[jj * 128 + s1] + impB[jj * 132 + s1];
      auto mk = [&](float im, int s) __attribute__((always_inline)) -> uint32_t {
        if (s > blk) return 0u;
        uint32_t kk = ((__float_as_uint(im) >> 1) & ~127u) | (uint32_t)(127 - s) | 0x40000000u;
        if (s == 0 || s == blk || s == blk - 1) kk |= 0x80000000u;
        return kk;
      };
      k0 = mk(i0, s0); k1 = mk(i1, s1);
    }
    kbuf[lane] = k0;
    kbuf[lane + 64] = k1;
    __builtin_amdgcn_wave_barrier();
    int r0 = 0, r1 = 0;
#pragma unroll 4
    for (int qd = 0; qd < 32; ++qd) {
      const uint4 kq = *(const uint4*)&kbuf[4 * qd];
      r0 += (kq.x > k0) + (kq.y > k0) + (kq.z > k0) + (kq.w > k0);
      r1 += (kq.x > k1) + (kq.y > k1) + (kq.z > k1) + (kq.w > k1);
    }
    const unsigned long long lo = __ballot(k0 != 0u && r0 < 16);
    const unsigned long long hi = __ballot(k1 != 0u && r1 < 16);
    __builtin_amdgcn_wave_barrier();
    if (lane == 0) { msk[jj * 2] = lo; msk[jj * 2 + 1] = hi; }
  }
  __builtin_amdgcn_wave_barrier();
  const unsigned long long mylo = msk[j * 2], myhi = msk[j * 2 + 1];
  {
    const half_t* Ksel = ub + C_CKS + g * 64;
    const half_t* Vsel = p.vsT() + (size_t)(b * 2 + g) * 64 * SEQ;
    auto pre = [&](int blk) __attribute__((always_inline)) {
      const unsigned long long mm_ = (blk < 64) ? mylo : myhi;
      return (int)((mm_ >> (blk & 63)) & 1ull);
    };
    auto vfn = [&](int key, int flag) __attribute__((always_inline)) { return flag != 0 && key <= tj; };
    ds_reset(st);
    auto fulls = [&](int blk) __attribute__((always_inline)) { return blk * 64 + 63 <= tw0; };
    run_dense<true, true, false>(st, Ksel, NU, Vsel, SEQ, 0, (t0 + 31) >> 6, qf, pre, fulls, vfn, 0.f, 0.f, nopost, smem, tid);
    float lt = st.l;
    lt += __shfl_xor(lt, 32);
    const float sc = lt > 0.f ? gate[1] / lt : 0.f;
#pragma unroll
    for (int dt = 0; dt < 2; ++dt)
#pragma unroll
      for (int r = 0; r < 16; ++r) res[dt][r] += sc * st.o[dt][r];
  }
  {
    const half_t* Kw = ub + C_CKW + g * 64;
    const half_t* Vw = p.vwT() + (size_t)(b * 2 + g) * 64 * SEQ;
    auto pre = [&](int blk) __attribute__((always_inline)) {
      return (int)((blk * 64 <= tj) && (blk * 64 + 63 > tj - 512));
    };
    auto vfn = [&](int key, int) __attribute__((always_inline)) { return key <= tj && key > tj - 512; };
    ds_reset(st);
    auto fullw = [&](int blk) __attribute__((always_inline)) { return blk * 64 + 63 <= tw0 && blk * 64 > tw0 + 7 - 512; };
    run_dense<true, true, false>(st, Kw, NU, Vw, SEQ, max(0, t0 - 511) >> 6, (t0 + 31) >> 6, qf, pre, fullw, vfn, 0.f, 0.f,
                                 nopost, smem, tid);
    float lt = st.l;
    lt += __shfl_xor(lt, 32);
    const float sc = lt > 0.f ? gate[2] / lt : 0.f;
#pragma unroll
    for (int dt = 0; dt < 2; ++dt)
#pragma unroll
      for (int r = 0; r < 16; ++r) res[dt][r] += sc * st.o[dt][r];
  }
  half_t* yrow = p.yc() + (size_t)(b * SEQ + tj) * 512 + head * 64;
#pragma unroll
  for (int dt = 0; dt < 2; ++dt)
#pragma unroll
    for (int qd = 0; qd < 4; ++qd) {
      const int d = 32 * dt + 8 * qd + 4 * h;
      const h4 z = *(const h4*)(urow + C_CZ + head * 64 + d);
      h4 ov;
#pragma unroll
      for (int e = 0; e < 4; ++e) ov[e] = (half_t)(res[dt][4 * qd + e] * siluf_((float)z[e]));
      *(h4*)(yrow + d) = ov;
    }
  __syncthreads();
}

__device__ __forceinline__ void phase_nsa(const KP& p, char* smem, int* q, int xcc) {
  xcd_schedule(q, xcc, 1024, 1, smem, [&](int grp, int) __attribute__((always_inline)) {
    const int y = grp & 7, k = grp >> 3;
    const int b = y & 1, g = (y >> 1) & 1, tile = 255 - (k * 2 + (y >> 2));
    nsa_item(p, b, g, tile, smem);
  });
}

__device__ __forceinline__ void phase_merge(const KP& p, char* smem, int* q, int xcc) {
  xcd_schedule(q, xcc, 16, 64, smem, [&](int grp, int within) __attribute__((always_inline)) {
    const int mt = (grp & 15) * 8 + (within & 7), nt = (within >> 3);
    const int m0 = mt * 128, n0 = nt * 128;
    f32x16 tot[2][2];
#pragma unroll
    for (int i = 0; i < 2; ++i)
#pragma unroll
      for (int jn = 0; jn < 2; ++jn)
#pragma unroll
        for (int r = 0; r < 16; ++r) tot[i][jn][r] = 0.f;
#pragma unroll 1
    for (int br = 0; br < 3; ++br) {
      const half_t* A = (br == 0 ? p.ya() : (br == 1 ? p.yb() : p.yc())) + (size_t)m0 * 512;
      const half_t* B = p.wpT() + (size_t)br * DM * 512 + (size_t)n0 * 512;
      const half_t* G = p.u() + (size_t)m0 * NU + C_GM + br * 1024 + n0;
      gemm_tile<2>(
          512, [&](int r, int k) { return *(const uint4*)(A + (size_t)r * 512 + k); },
          [&](int r, int k) { return *(const uint4*)(B + (size_t)r * 512 + k); },
          [&](int mi, int ni, int r, int row, int col, float v) {
            const float gz = (float)G[(size_t)row * NU + col];
            tot[mi][ni][r] += sigmoidf_(gz) * v;
          },
          smem);
    }
    int tidx = threadIdx.x;
    asm volatile("" : "+v"(tidx));
    const int lane = tidx & 63, wid = tidx >> 6, wm = wid >> 1, wn = wid & 1;
#pragma unroll
    for (int mi = 0; mi < 2; ++mi)
#pragma unroll
      for (int ni = 0; ni < 2; ++ni)
#pragma unroll
        for (int r = 0; r < 16; ++r) {
          const int row = wm * 64 + mi * 32 + (r & 3) + 8 * (r >> 2) + 4 * (lane >> 5);
          const int col = wn * 64 + ni * 32 + (lane & 31);
          p.mm()[(size_t)(m0 + row) * DM + n0 + col] = (half_t)tot[mi][ni][r];
        }
  });
}

__device__ __forceinline__ void phase_outproj(const KP& p, char* smem, int* q, int xcc) {
  xcd_schedule(q, xcc, 8, 64, smem, [&](int grp, int within) __attribute__((always_inline)) {
    const int mt = grp * 8 + (within & 7), nt = (within >> 3);
    const int m0 = mt * 256, n0 = nt * 128;
    const half_t* A = p.mm() + (size_t)m0 * DM;
    const half_t* B = p.woT() + (size_t)n0 * DM;
    gemm_tile_big(
        DM, [&](int r, int k) { return *(const uint4*)(A + (size_t)r * DM + k); },
        [&](int r, int k) { return *(const uint4*)(B + (size_t)r * DM + k); },
        [&](int mi, int ni, int r, int row, int col, float v) {
          const size_t xi = (size_t)(m0 + row) * DM + n0 + col;
          ((float*)p.u())[xi] = ALPHA_F * p.xr()[xi] + v;
        },
        smem);
  });
}

#define XB_TMO      128
#define XB_XCNT(j)  (256  + 64 * (j))
#define XB_XSUB(j)  (1280 + 64 * (j))
#define XB_XGEN(j)  (2304 + 64 * (j))
#define XB_TOP      3328
#define XB_TOPGEN   3392
#define XCD_BAR_WORDS 3456
#define XB_SPIN_CAP (1u << 20)
#define LAS __attribute__((address_space(3)))
__device__ __forceinline__ unsigned xb_ld(unsigned* p)              { return __hip_atomic_load(p, __ATOMIC_RELAXED, __HIP_MEMORY_SCOPE_AGENT); }
__device__ __forceinline__ unsigned xb_add(unsigned* p, unsigned v) { return __hip_atomic_fetch_add(p, v, __ATOMIC_RELAXED, __HIP_MEMORY_SCOPE_AGENT); }
__device__ __forceinline__ unsigned xb_xcc_id() { return (unsigned)__builtin_amdgcn_s_getreg((3 << 11) | 20) & 0xFu; }
#define XB_SPIN(cond, bar) do { unsigned _sp = 0; while (cond) { __builtin_amdgcn_s_sleep(1); \
    if ((++_sp & 255u) == 0u) { if (xb_ld(&(bar)[XB_TMO])) break; if (_sp > XB_SPIN_CAP) { atomicAdd(&(bar)[XB_TMO], 1u); break; } } } } while (0)
struct XcdBarrier { unsigned* bar; unsigned x; volatile LAS unsigned* st; };
__device__ __forceinline__ XcdBarrier xcd_barrier_post(unsigned* bar, volatile LAS unsigned* st) {
  XcdBarrier b; b.bar = bar; b.x = xb_xcc_id(); b.st = st;
  if (threadIdx.x == 0) (void)xb_add(&bar[XB_XCNT(b.x)], 1u);
  return b;
}
__device__ __forceinline__ void xcd_barrier_complete(unsigned* bar, unsigned x, unsigned& nloc, unsigned& nx) {
  const unsigned G = gridDim.x * gridDim.y * gridDim.z;
  unsigned sum, cnt, mine, sp = 0u;
  for (;;) {
    sum = 0u; cnt = 0u; mine = 0u;
#pragma unroll
    for (unsigned j = 0; j < 16; ++j) { const unsigned c = xb_ld(&bar[XB_XCNT(j)]); sum += c; cnt += (c > 0u) ? 1u : 0u; mine = (j == x) ? c : mine; }
    if (sum == G) break;
    __builtin_amdgcn_s_sleep(1);
    if ((++sp & 255u) == 0u) { if (xb_ld(&bar[XB_TMO])) break; if (sp > XB_SPIN_CAP) { atomicAdd(&bar[XB_TMO], 1u); break; } }
  }
  nloc = mine > 0u ? mine : 1u; nx = cnt > 0u ? cnt : 1u;
}
__device__ __forceinline__ void xcd_barrier(const XcdBarrier& b) {
  asm volatile("s_waitcnt vmcnt(0)" ::: "memory");
  __syncthreads();
  if (threadIdx.x == 0) {
    unsigned* bar = b.bar;
    __builtin_amdgcn_s_waitcnt(0);
    unsigned nloc = b.st[0], nx = b.st[1];
    if (nloc == 0u) { xcd_barrier_complete(bar, b.x, nloc, nx); b.st[0] = nloc; b.st[1] = nx; }
    const unsigned old = xb_add(&bar[XB_XSUB(b.x)], 1u);
    const unsigned gen = old / nloc;
    if (old + 1u == (gen + 1u) * nloc) {
      __builtin_amdgcn_fence(__ATOMIC_RELEASE, "agent");
      asm volatile("s_waitcnt vmcnt(0)" ::: "memory");
      const unsigned og = xb_add(&bar[XB_TOP], 1u);
      const unsigned tg = og / nx;
      if (og + 1u == (tg + 1u) * nx) xb_add(&bar[XB_TOPGEN], 1u);
      else XB_SPIN(xb_ld(&bar[XB_TOPGEN]) == tg, bar);
      __builtin_amdgcn_fence(__ATOMIC_ACQUIRE, "agent");
      xb_add(&bar[XB_XGEN(b.x)], 1u);
      asm volatile("s_waitcnt vmcnt(0)" ::: "memory");
    } else {
      XB_SPIN(xb_ld(&bar[XB_XGEN(b.x)]) == gen, bar);
      __builtin_amdgcn_fence(__ATOMIC_ACQUIRE, "agent");
      asm volatile("s_waitcnt vmcnt(0)" ::: "memory");
    }
  }
  __syncthreads();
}

#define NQ_WORDS 4096
__global__ void __launch_bounds__(256, 2) fwd_megakernel(Params p_unused) {
  cg::grid_group grid = cg::this_grid();
  __shared__ __attribute__((aligned(16))) char smem[SMEM_BYTES];
  volatile LAS unsigned* st = (volatile LAS unsigned*)(smem + SMEM_BYTES - 32);
  if (threadIdx.x == 0) { st[0] = 0u; st[1] = 0u; }
  __syncthreads();
  if (gridDim.y == 4242u) grid.sync();
  XcdBarrier xb;
  {
    const KP p = get_params();
    xb = xcd_barrier_post((unsigned*)p.counters() + NQ_WORDS, st);
    ln_rows(p, -1, false);
    prep_weights(p, 0, smem);
  }
  xcd_barrier(xb);
  const int xcc = (int)(xb.x & 7u);
#ifndef REP1
#define REP1 1
#define REP2 1
#define REP3 1
#define REP4 1
#endif
#ifndef REP5
#define REP5 1
#define REP6 1
#define REP7 0
#endif
#pragma unroll 1
  for (int l = 0; l < DEPTH; ++l) {
#define QPTR(ph, rep) (p.counters() + ((l * 6 + (ph)) * 4 + (rep)) * 32)
    for (int rep = 0; rep < REP1; ++rep) { const KP p = get_params(); phase_inproj(p, l, smem, QPTR(0, rep), xcc); }
    xcd_barrier(xb);
    for (int rep = 0; rep < REP2; ++rep) { const KP p = get_params(); phase2(p, l, smem, QPTR(1, rep), xcc); }
    xcd_barrier(xb);
    for (int rep = 0; rep < REP3; ++rep) { const KP p = get_params(); phase_nsa(p, smem, QPTR(2, rep), xcc); }
    xcd_barrier(xb);
    for (int rep = 0; rep < REP4; ++rep) { const KP p = get_params(); phase_merge(p, smem, QPTR(3, rep), xcc); }
    xcd_barrier(xb);
    for (int rep = 0; rep < REP5; ++rep) { const KP p = get_params(); phase_outproj(p, smem, QPTR(4, rep), xcc); }
    xcd_barrier(xb);
    for (int rep = 0; rep < REP6; ++rep) {
      const KP p = get_params();
      if (l + 1 < DEPTH) {
        ln_rows(p, l, false);
        prep_weights(p, l + 1, smem);
      } else {
        ln_rows(p, l, true);
      }
    }
    if (l + 1 < DEPTH) xcd_barrier(xb);
    for (int rep = 0; rep < REP7; ++rep) xcd_barrier(xb);
  }
}

extern "C" void kernel_launch(void* const* d_in, const int* in_sizes, int n_in, void* d_out, int out_size,
                              void* d_ws, size_t ws_size, hipStream_t stream) {
  static int grid_blocks = 0;
  if (!grid_blocks) {
    int dev = 0, cus = 0, per_cu = 0;
    (void)hipGetDevice(&dev);
    (void)hipDeviceGetAttribute(&cus, hipDeviceAttributeMultiprocessorCount, dev);
    (void)hipOccupancyMaxActiveBlocksPerMultiprocessor(&per_cu, fwd_megakernel, 256, 0);
    if (per_cu > 2) per_cu = 2;
    if (per_cu < 1) per_cu = 1;
    grid_blocks = cus * per_cu;
  }
  Params p{};
  p.x = (const float*)d_in[0]; p.w_in = (const float*)d_in[1]; p.b_in = (const float*)d_in[2];
  p.pool_w = (const float*)d_in[3]; p.pool_b = (const float*)d_in[4]; p.pool_scale = (const float*)d_in[5];
  p.pos_k = (const float*)d_in[6]; p.pos_v = (const float*)d_in[7]; p.w1k = (const float*)d_in[8];
  p.w2k = (const float*)d_in[9]; p.w1v = (const float*)d_in[10]; p.w2v = (const float*)d_in[11];
  p.wpa = (const float*)d_in[12]; p.wpb = (const float*)d_in[13]; p.wpc = (const float*)d_in[14];
  p.wo = (const float*)d_in[15]; p.ln_g = (const float*)d_in[16]; p.ln_b = (const float*)d_in[17];
  p.out = (float*)d_out;
  p.ws = (char*)d_ws;
  if (WS_TOTAL > ws_size) { fprintf(stderr, "workspace too small: need %zu have %zu\n", (size_t)WS_TOTAL, ws_size); return; }
  (void)hipMemsetAsync((char*)d_ws + OFF_counters, 0, (size_t)(NQ_WORDS + XCD_BAR_WORDS) * 4, stream);
  void* args[] = {&p};
  hipError_t e = hipLaunchCooperativeKernel((void*)fwd_megakernel, dim3(grid_blocks), dim3(256), args, 0, stream);
  if (e != hipSuccess) fprintf(stderr, "cooperative launch failed: %s (grid %d)\n", hipGetErrorString(e), grid_blocks);
}
```

```cpp
#include <hip/hip_runtime.h>
#include <hip/hip_cooperative_groups.h>
#include <cstdio>
#include <cstdint>
namespace cg = cooperative_groups;

typedef _Float16 half_t;
typedef _Float16 h8 __attribute__((ext_vector_type(8)));
typedef _Float16 h4 __attribute__((ext_vector_type(4)));
typedef float f32x4 __attribute__((ext_vector_type(4)));
typedef float f32x16 __attribute__((ext_vector_type(16)));

#define SEQ 8192
#define DM 1024
#define NTOK 16384
#define DEPTH 4
#define NIN 7360
#define NU 7424
#define ALPHA_F 1.681792830507429f
#define NEGF (-1e30f)

#define C_AX 0
#define C_AZ 512
#define C_BQ 1024
#define C_BZ 1536
#define C_CQ 2048
#define C_CZ 2560
#define C_GM 3072
#define C_IQ 6144
#define C_CKC 6400
#define C_CVC 6528
#define C_CKS 6656
#define C_CVS 6784
#define C_CKW 6912
#define C_CVW 7040
#define C_BK 7168
#define C_BV 7232
#define C_IK 7296
#define C_IW 7328
#define C_CG 7336

#define SMEM_BYTES 73728

constexpr size_t OFF_xr = 0;
constexpr size_t OFF_xh = OFF_xr + (((size_t)NTOK*DM*4 + 255) & ~(size_t)255);
constexpr size_t OFF_u = OFF_xh + (((size_t)NTOK*DM*2 + 255) & ~(size_t)255);
constexpr size_t OFF_winT = OFF_u + (((size_t)NTOK*NU*2 + 255) & ~(size_t)255);
constexpr size_t OFF_wpT = OFF_winT + (((size_t)NU*DM*2 + 255) & ~(size_t)255);
constexpr size_t OFF_woT = OFF_wpT + (((size_t)3*DM*512*2 + 255) & ~(size_t)255);
constexpr size_t OFF_poolT = OFF_woT + (((size_t)DM*DM*2 + 255) & ~(size_t)255);
constexpr size_t OFF_w1T = OFF_poolT + (((size_t)4*128*128*2 + 255) & ~(size_t)255);
constexpr size_t OFF_posb = OFF_w1T + (((size_t)2*64*2048*2 + 255) & ~(size_t)255);
constexpr size_t OFF_vsT = OFF_posb + (((size_t)512 + 255) & ~(size_t)255);
constexpr size_t OFF_vwT = OFF_vsT + (((size_t)4*64*SEQ*2 + 255) & ~(size_t)255);
constexpr size_t OFF_kcmp = OFF_vwT + (((size_t)4*64*SEQ*2 + 255) & ~(size_t)255);
constexpr size_t OFF_vcmpT = OFF_kcmp + (((size_t)4*512*64*2 + 255) & ~(size_t)255);
constexpr size_t OFF_ya = OFF_vcmpT + (((size_t)4*64*512*2 + 255) & ~(size_t)255);
constexpr size_t OFF_yb = OFF_ya + (((size_t)NTOK*512*2 + 255) & ~(size_t)255);
constexpr size_t OFF_yc = OFF_yb + (((size_t)NTOK*512*2 + 255) & ~(size_t)255);
constexpr size_t OFF_mm = OFF_yc + (((size_t)NTOK*512*2 + 255) & ~(size_t)255);
constexpr size_t OFF_counters = OFF_mm + (((size_t)NTOK*DM*2 + 255) & ~(size_t)255);
constexpr size_t WS_TOTAL = OFF_counters + (((size_t)32768 + 255) & ~(size_t)255);
struct Params {
  const float* x; const float* w_in; const float* b_in; const float* pool_w; const float* pool_b;
  const float* pool_scale; const float* pos_k; const float* pos_v; const float* w1k; const float* w2k;
  const float* w1v; const float* w2v; const float* wpa; const float* wpb; const float* wpc;
  const float* wo; const float* ln_g; const float* ln_b;
  float* out;
  char* ws;
};
typedef const __attribute__((address_space(4))) unsigned long long* kargp_t;
struct KP {
  kargp_t kp;
  __device__ __forceinline__ const float* x() const { return (const float*)(const __attribute__((address_space(1))) float*)kp[0]; }
  __device__ __forceinline__ const float* w_in() const { return (const float*)(const __attribute__((address_space(1))) float*)kp[1]; }
  __device__ __forceinline__ const float* b_in() const { return (const float*)(const __attribute__((address_space(1))) float*)kp[2]; }
  __device__ __forceinline__ const float* pool_w() const { return (const float*)(const __attribute__((address_space(1))) float*)kp[3]; }
  __device__ __forceinline__ const float* pool_b() const { return (const float*)(const __attribute__((address_space(1))) float*)kp[4]; }
  __device__ __forceinline__ const float* pool_scale() const { return (const float*)(const __attribute__((address_space(1))) float*)kp[5]; }
  __device__ __forceinline__ const float* pos_k() const { return (const float*)(const __attribute__((address_space(1))) float*)kp[6]; }
  __device__ __forceinline__ const float* pos_v() const { return (const float*)(const __attribute__((address_space(1))) float*)kp[7]; }
  __device__ __forceinline__ const float* w1k() const { return (const float*)(const __attribute__((address_space(1))) float*)kp[8]; }
  __device__ __forceinline__ const float* w2k() const { return (const float*)(const __attribute__((address_space(1))) float*)kp[9]; }
  __device__ __forceinline__ const float* w1v() const { return (const float*)(const __attribute__((address_space(1))) float*)kp[10]; }
  __device__ __forceinline__ const float* w2v() const { return (const float*)(const __attribute__((address_space(1))) float*)kp[11]; }
  __device__ __forceinline__ const float* wpa() const { return (const float*)(const __attribute__((address_space(1))) float*)kp[12]; }
  __device__ __forceinline__ const float* wpb() const { return (const float*)(const __attribute__((address_space(1))) float*)kp[13]; }
  __device__ __forceinline__ const float* wpc() const { return (const float*)(const __attribute__((address_space(1))) float*)kp[14]; }
  __device__ __forceinline__ const float* wo() const { return (const float*)(const __attribute__((address_space(1))) float*)kp[15]; }
  __device__ __forceinline__ const float* ln_g() const { return (const float*)(const __attribute__((address_space(1))) float*)kp[16]; }
  __device__ __forceinline__ const float* ln_b() const { return (const float*)(const __attribute__((address_space(1))) float*)kp[17]; }
  __device__ __forceinline__ float* out() const { return (float*)(__attribute__((address_space(1))) float*)kp[18]; }
  __device__ __forceinline__ char* ws() const { return (char*)(__attribute__((address_space(1))) char*)kp[19]; }
  __device__ __forceinline__ float* xr() const { return (float*)(ws() + OFF_xr); }
  __device__ __forceinline__ half_t* xh() const { return (half_t*)(ws() + OFF_xh); }
  __device__ __forceinline__ half_t* u() const { return (half_t*)(ws() + OFF_u); }
  __device__ __forceinline__ half_t* winT() const { return (half_t*)(ws() + OFF_winT); }
  __device__ __forceinline__ half_t* wpT() const { return (half_t*)(ws() + OFF_wpT); }
  __device__ __forceinline__ half_t* woT() const { return (half_t*)(ws() + OFF_woT); }
  __device__ __forceinline__ half_t* poolT() const { return (half_t*)(ws() + OFF_poolT); }
  __device__ __forceinline__ half_t* w1T() const { return (half_t*)(ws() + OFF_w1T); }
  __device__ __forceinline__ float* posb() const { return (float*)(ws() + OFF_posb); }
  __device__ __forceinline__ half_t* vsT() const { return (half_t*)(ws() + OFF_vsT); }
  __device__ __forceinline__ half_t* vwT() const { return (half_t*)(ws() + OFF_vwT); }
  __device__ __forceinline__ half_t* kcmp() const { return (half_t*)(ws() + OFF_kcmp); }
  __device__ __forceinline__ half_t* vcmpT() const { return (half_t*)(ws() + OFF_vcmpT); }
  __device__ __forceinline__ half_t* ya() const { return (half_t*)(ws() + OFF_ya); }
  __device__ __forceinline__ half_t* yb() const { return (half_t*)(ws() + OFF_yb); }
  __device__ __forceinline__ half_t* yc() const { return (half_t*)(ws() + OFF_yc); }
  __device__ __forceinline__ half_t* mm() const { return (half_t*)(ws() + OFF_mm); }
  __device__ __forceinline__ int* counters() const { return (int*)(ws() + OFF_counters); }
};
__device__ __forceinline__ KP get_params() {
  KP q;
  q.kp = (kargp_t)__builtin_amdgcn_kernarg_segment_ptr();
  asm volatile("" : "+s"(q.kp));
  return q;
}


__device__ __forceinline__ int orig_col(int n) {
  if (n < 1536) return n;
  if (n < 2048) return 1664 + (n - 1536);
  if (n < 2560) return 2472 + (n - 2048);
  if (n < 3072) return 3776 + (n - 2560);
  if (n < 6144) return 4288 + (n - 3072);
  if (n < 6400) return 2176 + (n - 6144);
  if (n < 7168) return 2984 + (n - 6400);
  if (n < 7296) return 1536 + (n - 7168);
  if (n < 7328) return 2432 + (n - 7296);
  if (n < 7336) return 2464 + (n - 7328);
  if (n < 7360) return 3752 + (n - 7336);
  return -1;
}

__device__ __forceinline__ float wave_sum(float v) {
#pragma unroll
  for (int o = 32; o > 0; o >>= 1) v += __shfl_xor(v, o);
  return v;
}
__device__ __forceinline__ float sigmoidf_(float x) { return 1.f / (1.f + __expf(-x)); }
__device__ __forceinline__ float siluf_(float x) { return x / (1.f + __expf(-x)); }

template <int NI, class LA, class LB, class EP>
__device__ __forceinline__ void gemm_tile(int K, LA loadA, LB loadB, EP epi, char* smem) {
  constexpr int BN = NI * 64;
  constexpr int NB = BN / 32;
  half_t* sA = (half_t*)smem;
  half_t* sB = sA + 128 * 72;
  int tid = threadIdx.x;
  asm volatile("" : "+v"(tid));
  const int lane = tid & 63, wid = tid >> 6;
  const int wm = wid >> 1, wn = wid & 1;
  f32x16 acc[2][NI];
#pragma unroll
  for (int i = 0; i < 2; ++i)
#pragma unroll
    for (int j = 0; j < NI; ++j)
#pragma unroll
      for (int r = 0; r < 16; ++r) acc[i][j][r] = 0.f;
  const int lr = tid >> 3, lc = (tid & 7) * 8;
  uint4 ra[4], rb[NB];
#pragma unroll
  for (int i = 0; i < 4; ++i) ra[i] = loadA(lr + 32 * i, lc);
#pragma unroll
  for (int i = 0; i < NB; ++i) rb[i] = loadB(lr + 32 * i, lc);
  const int nk = K >> 6;
  for (int kt = 0; kt < nk; ++kt) {
    __syncthreads();
#pragma unroll
    for (int i = 0; i < 4; ++i) *(uint4*)&sA[(lr + 32 * i) * 72 + lc] = ra[i];
#pragma unroll
    for (int i = 0; i < NB; ++i) *(uint4*)&sB[(lr + 32 * i) * 72 + lc] = rb[i];
    __syncthreads();
    if (kt + 1 < nk) {
      const int kk = (kt + 1) * 64 + lc;
#pragma unroll
      for (int i = 0; i < 4; ++i) ra[i] = loadA(lr + 32 * i, kk);
#pragma unroll
      for (int i = 0; i < NB; ++i) rb[i] = loadB(lr + 32 * i, kk);
    }
#pragma unroll
    for (int s = 0; s < 4; ++s) {
      h8 af[2], bf[NI];
#pragma unroll
      for (int mi = 0; mi < 2; ++mi)
        af[mi] = *(const h8*)&sA[(wm * 64 + mi * 32 + (lane & 31)) * 72 + s * 16 + (lane >> 5) * 8];
#pragma unroll
      for (int ni = 0; ni < NI; ++ni)
        bf[ni] = *(const h8*)&sB[(wn * (NI * 32) + ni * 32 + (lane & 31)) * 72 + s * 16 + (lane >> 5) * 8];
#pragma unroll
      for (int mi = 0; mi < 2; ++mi)
#pragma unroll
        for (int ni = 0; ni < NI; ++ni)
          acc[mi][ni] = __builtin_amdgcn_mfma_f32_32x32x16_f16(af[mi], bf[ni], acc[mi][ni], 0, 0, 0);
    }
  }
#pragma unroll
  for (int mi = 0; mi < 2; ++mi)
#pragma unroll
    for (int ni = 0; ni < NI; ++ni)
#pragma unroll
      for (int r = 0; r < 16; ++r) {
        const int row = wm * 64 + mi * 32 + (r & 3) + 8 * (r >> 2) + 4 * (lane >> 5);
        const int col = wn * (NI * 32) + ni * 32 + (lane & 31);
        epi(mi, ni, r, row, col, acc[mi][ni][r]);
      }
}

template <class LA, class LB, class EP>
__device__ __forceinline__ void gemm_tile_big(int K, LA loadA, LB loadB, EP epi, char* smem) {
  half_t* sA = (half_t*)smem;
  half_t* sB = sA + 256 * 72;
  int tid = threadIdx.x;
  asm volatile("" : "+v"(tid));
  const int lane = tid & 63, wid = tid >> 6;
  const int wm = wid >> 1, wn = wid & 1;
  f32x16 acc[4][2];
#pragma unroll
  for (int i = 0; i < 4; ++i)
#pragma unroll
    for (int j = 0; j < 2; ++j)
#pragma unroll
      for (int r = 0; r < 16; ++r) acc[i][j][r] = 0.f;
  const int lr = tid >> 3, lc = (tid & 7) * 8;
  uint4 ra[8], rb[4];
#pragma unroll
  for (int i = 0; i < 8; ++i) ra[i] = loadA(lr + 32 * i, lc);
#pragma unroll
  for (int i = 0; i < 4; ++i) rb[i] = loadB(lr + 32 * i, lc);
  const int nk = K >> 6;
  for (int kt = 0; kt < nk; ++kt) {
    __syncthreads();
#pragma unroll
    for (int i = 0; i < 8; ++i) *(uint4*)&sA[(lr + 32 * i) * 72 + lc] = ra[i];
#pragma unroll
    for (int i = 0; i < 4; ++i) *(uint4*)&sB[(lr + 32 * i) * 72 + lc] = rb[i];
    __syncthreads();
    if (kt + 1 < nk) {
      const int kk = (kt + 1) * 64 + lc;
#pragma unroll
      for (int i = 0; i < 8; ++i) ra[i] = loadA(lr + 32 * i, kk);
#pragma unroll
      for (int i = 0; i < 4; ++i) rb[i] = loadB(lr + 32 * i, kk);
    }
#pragma unroll
    for (int s = 0; s < 4; ++s) {
      h8 af[4], bf[2];
#pragma unroll
      for (int mi = 0; mi < 4; ++mi)
        af[mi] = *(const h8*)&sA[(wm * 128 + mi * 32 + (lane & 31)) * 72 + s * 16 + (lane >> 5) * 8];
#pragma unroll
      for (int ni = 0; ni < 2; ++ni)
        bf[ni] = *(const h8*)&sB[(wn * 64 + ni * 32 + (lane & 31)) * 72 + s * 16 + (lane >> 5) * 8];
#pragma unroll
      for (int mi = 0; mi < 4; ++mi)
#pragma unroll
        for (int ni = 0; ni < 2; ++ni)
          acc[mi][ni] = __builtin_amdgcn_mfma_f32_32x32x16_f16(af[mi], bf[ni], acc[mi][ni], 0, 0, 0);
    }
  }
#pragma unroll
  for (int mi = 0; mi < 4; ++mi)
#pragma unroll
    for (int ni = 0; ni < 2; ++ni)
#pragma unroll
      for (int r = 0; r < 16; ++r) {
        const int row = wm * 128 + mi * 32 + (r & 3) + 8 * (r >> 2) + 4 * (lane >> 5);
        const int col = wn * 64 + ni * 32 + (lane & 31);
        epi(mi, ni, r, row, col, acc[mi][ni][r]);
      }
}

template <class CM>
__device__ __forceinline__ void tconv_tile(const float* __restrict__ src, int lds_, half_t* __restrict__ dst, int ldd,
                                           int n0, int k0, CM cmap, char* smem) {
  float* t = (float*)smem;
  int tid = threadIdx.x;
  asm volatile("" : "+v"(tid));
  {
    const int n = tid & 63;
    const int c = cmap(n0 + n);
    float tv[16];
#pragma unroll
    for (int i = 0; i < 16; ++i) {
      const int k = (tid >> 6) + 4 * i;
      tv[i] = (c >= 0) ? src[(size_t)(k0 + k) * lds_ + c] : 0.f;
    }
#pragma unroll
    for (int i = 0; i < 16; ++i) {
      const int k = (tid >> 6) + 4 * i;
      t[k * 65 + n] = tv[i];
    }
  }
  __syncthreads();
#pragma unroll
  for (int i = 0; i < 2; ++i) {
    const int idx = tid + 256 * i;
    const int n = idx >> 3, kc = (idx & 7) * 8;
    h8 v;
#pragma unroll
    for (int j = 0; j < 8; ++j) v[j] = (half_t)t[(kc + j) * 65 + n];
    *(h8*)&dst[(size_t)(n0 + n) * ldd + k0 + kc] = v;
  }
  __syncthreads();
}

__device__ __forceinline__ void ln_rows(const KP& p, int lprev, bool final_) {
  int tid = threadIdx.x;
  asm volatile("" : "+v"(tid));
  const int lane = tid & 63, wid = tid >> 6;
  const int gw = blockIdx.x * 4 + wid, nw = gridDim.x * 4;
  for (int row = gw; row < NTOK; row += nw) {
    const float4* rp = (const float4*)((lprev < 0 ? p.x() : (const float*)p.u()) + (size_t)row * DM);
    float4 v[4];
    float s = 0.f;
#pragma unroll
    for (int i = 0; i < 4; ++i) {
      v[i] = rp[lane + 64 * i];
      s += v[i].x + v[i].y + v[i].z + v[i].w;
    }
    if (lprev >= 0) {
      float mu = wave_sum(s) * (1.f / DM);
      float q = 0.f;
#pragma unroll
      for (int i = 0; i < 4; ++i) {
        float a = v[i].x - mu, b = v[i].y - mu, c = v[i].z - mu, d = v[i].w - mu;
        q += a * a + b * b + c * c + d * d;
      }
      float rstd = rsqrtf(wave_sum(q) * (1.f / DM) + 1e-5f);
      const float4* g4 = (const float4*)(p.ln_g() + lprev * DM);
      const float4* b4 = (const float4*)(p.ln_b() + lprev * DM);
#pragma unroll
      for (int i = 0; i < 4; ++i) {
        float4 g = g4[lane + 64 * i], bb = b4[lane + 64 * i];
        v[i].x = (v[i].x - mu) * rstd * g.x + bb.x;
        v[i].y = (v[i].y - mu) * rstd * g.y + bb.y;
        v[i].z = (v[i].z - mu) * rstd * g.z + bb.z;
        v[i].w = (v[i].w - mu) * rstd * g.w + bb.w;
      }
    }
    if (final_) {
      float4* op = (float4*)(p.out() + (size_t)row * DM);
#pragma unroll
      for (int i = 0; i < 4; ++i) op[lane + 64 * i] = v[i];
    } else {
      float4* op = (float4*)(p.xr() + (size_t)row * DM);
      h4* hp = (h4*)(p.xh() + (size_t)row * DM);
#pragma unroll
      for (int i = 0; i < 4; ++i) {
        op[lane + 64 * i] = v[i];
        h4 hv;
        hv[0] = (half_t)v[i].x; hv[1] = (half_t)v[i].y; hv[2] = (half_t)v[i].z; hv[3] = (half_t)v[i].w;
        hp[lane + 64 * i] = hv;
      }
    }
  }
}

__device__ __forceinline__ void prep_weights(const KP& p, int l, char* smem) {
  int tid = threadIdx.x;
  asm volatile("" : "+v"(tid));
  const int total = 1856 + 384 + 256 + 16 + 64 + 2;
  for (int it = blockIdx.x; it < total; it += gridDim.x) {
    if (it < 1856) {
      const int nt = it >> 4, kt = it & 15;
      tconv_tile(p.w_in() + (size_t)l * DM * NIN, NIN, p.winT(), DM, nt * 64, kt * 64,
                 [](int n) { return orig_col(n); }, smem);
    } else if (it < 1856 + 384) {
      const int j = it - 1856;
      const int w = j >> 7, r = j & 127, nt = r >> 3, kt = r & 7;
      const float* src = (w == 0 ? p.wpa() : (w == 1 ? p.wpb() : p.wpc())) + (size_t)l * 512 * DM;
      tconv_tile(src, DM, p.wpT() + (size_t)w * DM * 512, 512, nt * 64, kt * 64, [](int n) { return n; }, smem);
    } else if (it < 1856 + 384 + 256) {
      const int j = it - 1856 - 384;
      const int nt = j >> 4, kt = j & 15;
      tconv_tile(p.wo() + (size_t)l * DM * DM, DM, p.woT(), DM, nt * 64, kt * 64, [](int n) { return n; }, smem);
    } else if (it < 1856 + 384 + 256 + 16) {
      const int j = it - 1856 - 384 - 256;
      const int g = j >> 2, nt = (j >> 1) & 1, kt = j & 1;
      tconv_tile(p.pool_w() + ((size_t)l * 4 + g) * 128 * 128, 128, p.poolT() + (size_t)g * 128 * 128, 128, nt * 64,
                 kt * 64, [](int n) { return n; }, smem);
    } else if (it < 1856 + 384 + 256 + 16 + 64) {
      const int j = it - 1856 - 384 - 256 - 16;
      const int kv = j >> 5, kt = j & 31;
      const float* src = (kv ? p.w1v() : p.w1k()) + (size_t)l * 2048 * 64;
      tconv_tile(src, 64, p.w1T() + (size_t)kv * 64 * 2048, 2048, 0, kt * 64, [](int n) { return n; }, smem);
    } else {
      const int kv = it - (1856 + 384 + 256 + 16 + 64);
      const float* w1 = (kv ? p.w1v() : p.w1k()) + (size_t)l * 2048 * 64;
      const float* pos = (kv ? p.pos_v() : p.pos_k()) + (size_t)l * 2048;
      float* red = (float*)smem;
      const int e = tid & 63, part = tid >> 6;
      float sa = 0.f, sb = 0.f, sc_ = 0.f, sd = 0.f;
      const float* wq = w1 + (size_t)part * 512 * 64 + e;
      const float* pq = pos + part * 512;
#pragma unroll 4
      for (int f = 0; f < 512; f += 4) {
        sa += pq[f] * wq[(size_t)f * 64];
        sb += pq[f + 1] * wq[(size_t)(f + 1) * 64];
        sc_ += pq[f + 2] * wq[(size_t)(f + 2) * 64];
        sd += pq[f + 3] * wq[(size_t)(f + 3) * 64];
      }
      const float s = (sa + sb) + (sc_ + sd);
      red[tid] = s;
      __syncthreads();
      if (tid < 64) p.posb()[kv * 64 + tid] = red[tid] + red[tid + 64] + red[tid + 128] + red[tid + 192];
      __syncthreads();
    }
  }
}

template <class F>
__device__ __forceinline__ void xcd_schedule(int* q, int xcc, int ngroups, int gsize, char* smem, F f) {
  int* s_item = (int*)(smem + SMEM_BYTES - 16);
  int* s_flag = (int*)(smem + SMEM_BYTES - 96);
  int* flags = q + 32;
#pragma unroll 1
  for (int dy = 0; dy < 8; ++dy) {
    const int y = (xcc + dy) & 7;
    if (dy == 1) {
      int t8 = threadIdx.x;
      asm volatile("" : "+v"(t8));
      if (t8 < 8) s_flag[t8] = __hip_atomic_load(&flags[t8], __ATOMIC_RELAXED, __HIP_MEMORY_SCOPE_AGENT);
      __syncthreads();
    }
    if (dy >= 1 && __builtin_amdgcn_readfirstlane(s_flag[y]) != 0) continue;
    for (;;) {
      if (threadIdx.x == 0) *s_item = atomicAdd(&q[y], 1);
      __syncthreads();
      const int i = __builtin_amdgcn_readfirstlane(*s_item);
      __syncthreads();
      const int grp = (i / gsize) * 8 + y;
      if (grp >= ngroups) {
        if (threadIdx.x == 0) __hip_atomic_store(&flags[y], 1, __ATOMIC_RELAXED, __HIP_MEMORY_SCOPE_AGENT);
        break;
      }
      f(grp, i % gsize);
    }
  }
}

__device__ __forceinline__ void phase_inproj(const KP& p, int l, char* smem, int* q, int xcc) {
  const float* bias = p.b_in() + (size_t)l * NIN;
  xcd_schedule(q, xcc, 128, 32, smem, [&](int grp, int within) __attribute__((always_inline)) {
    const int mt = (grp & 15) * 4 + (within & 3), nt = (grp >> 4) * 8 + (within >> 2);
    if (nt >= 58) return;
    const int m0 = mt * 256, n0 = nt * 128;
    const half_t* A = p.xh() + (size_t)m0 * DM;
    const half_t* B = p.winT() + (size_t)n0 * DM;
    int tidx = threadIdx.x;
    asm volatile("" : "+v"(tidx));
    const int lane = tidx & 63, wn = (tidx >> 6) & 1;
    float bv[2];
#pragma unroll
    for (int ni = 0; ni < 2; ++ni) {
      const int oc = orig_col(n0 + wn * 64 + ni * 32 + (lane & 31));
      bv[ni] = oc >= 0 ? bias[oc] : 0.f;
    }
    half_t* vT = (nt == 53) ? p.vsT() : ((nt == 55) ? p.vwT() : nullptr);
    gemm_tile_big(
        DM, [&](int r, int k) { return *(const uint4*)(A + (size_t)r * DM + k); },
        [&](int r, int k) { return *(const uint4*)(B + (size_t)r * DM + k); },
        [&](int mi, int ni, int r, int row, int col, float v) {
          const half_t hv = (half_t)(v + bv[ni]);
          const int tok = m0 + row;
          p.u()[(size_t)tok * NU + n0 + col] = hv;
          if (vT) {
            const int b = tok >> 13, t = tok & 8191;
            vT[((size_t)(b * 2 + (col >> 6)) * 64 + (col & 63)) * SEQ + t] = hv;
          }
        },
        smem);
  });
}

__device__ __forceinline__ void pool_item(const KP& p, int l, int item, char* smem) {
  const int g = item & 3, mt = item >> 2;
  const int m0 = mt * 128;
  const int wnd = 2 << g;
  const half_t* B = p.poolT() + (size_t)g * 128 * 128;
  int tidx = threadIdx.x;
  asm volatile("" : "+v"(tidx));
  const int lane = tidx & 63, wn = (tidx >> 6) & 1;
  float pb[2], ps[2];
#pragma unroll
  for (int ni = 0; ni < 2; ++ni) {
    const int d = wn * 64 + ni * 32 + (lane & 31);
    pb[ni] = p.pool_b()[(size_t)l * 512 + g * 128 + d];
    ps[ni] = p.pool_scale()[(size_t)l * 512 + g * 128 + d];
  }
  gemm_tile<2>(
      128,
      [&](int r, int k) {
        const int tok = m0 + r, t = tok & 8191;
        const int cnt = min(t + 1, wnd);
        const half_t* base = p.u() + (size_t)tok * NU + C_AX + g * 128 + k;
        float s[8];
#pragma unroll
        for (int j = 0; j < 8; ++j) s[j] = 0.f;
        h8 cur = *(const h8*)base;
        for (int q0 = 0; q0 < wnd; q0 += 8) {
          h8 v[8];
#pragma unroll
          for (int i = 0; i < 8; ++i) {
            const int qq = q0 + i;
            if (qq < cnt) v[i] = *(const h8*)(base - (size_t)qq * NU);
            else {
#pragma unroll
              for (int j = 0; j < 8; ++j) v[i][j] = (half_t)0.f;
            }
          }
#pragma unroll
          for (int i = 0; i < 8; ++i)
#pragma unroll
            for (int j = 0; j < 8; ++j) s[j] += (float)v[i][j];
        }
        const float inv = 1.f / (float)cnt;
        h8 o;
#pragma unroll
        for (int j = 0; j < 8; ++j) o[j] = (half_t)(s[j] * inv - (float)cur[j]);
        return *(uint4*)&o;
      },
      [&](int r, int k) { return *(const uint4*)(B + (size_t)r * 128 + k); },
      [&](int mi, int ni, int r, int row, int col, float v) {
        const int tok = m0 + row;
        const float z = (float)p.u()[(size_t)tok * NU + C_AZ + g * 128 + col];
        p.ya()[(size_t)tok * 512 + g * 128 + col] = (half_t)((v + pb[ni]) * ps[ni] * siluf_(z));
      },
      smem);
}

__device__ __forceinline__ void compress_item(const KP& p, int l, int item, char* smem) {
  const int mt = item & 3, kv = (item >> 2) & 1, g = (item >> 3) & 1, b = item >> 4;
  int tid = threadIdx.x;
  asm volatile("" : "+v"(tid));
  const int ccol = (kv ? C_CVC : C_CKC) + g * 64;
  const half_t* ub = p.u() + (size_t)b * SEQ * NU + ccol;
  const half_t* B = p.w1T() + (size_t)kv * 64 * 2048;
  float* hid = (float*)(smem + 28672);
  const float* posb = p.posb() + kv * 64;
  gemm_tile<1>(
      2048,
      [&](int r, int k) {
        const int n = mt * 128 + r;
        if (n >= 511) return make_uint4(0, 0, 0, 0);
        const int tok = 16 * n + (k >> 6);
        return *(const uint4*)(ub + (size_t)tok * NU + (k & 63));
      },
      [&](int r, int k) { return *(const uint4*)(B + (size_t)r * 2048 + k); },
      [&](int mi, int ni, int r, int row, int col, float v) { hid[row * 65 + col] = siluf_(v + posb[col]); }, smem);
  __syncthreads();
  float* w2s = (float*)smem;
  const float* w2 = (kv ? p.w2v() : p.w2k()) + (size_t)l * 4096;
  for (int i = tid; i < 4096; i += 256) w2s[i] = w2[i];
  __syncthreads();
  {
    const int n = tid >> 1, fh = (tid & 1) * 32;
    float acc[32];
#pragma unroll
    for (int f = 0; f < 32; ++f) acc[f] = 0.f;
    for (int e = 0; e < 64; ++e) {
      const float hv = hid[n * 65 + e];
#pragma unroll
      for (int f = 0; f < 32; ++f) acc[f] += hv * w2s[e * 64 + fh + f];
    }
    const int ng = mt * 128 + n;
    const bool valid = ng < 511;
    if (kv == 0) {
      half_t* dst = p.kcmp() + ((size_t)(b * 2 + g) * 512 + ng) * 64 + fh;
#pragma unroll
      for (int f = 0; f < 32; ++f) dst[f] = valid ? (half_t)acc[f] : (half_t)0.f;
    } else {
      half_t* dst = p.vcmpT() + ((size_t)(b * 2 + g) * 64 + fh) * 512 + ng;
#pragma unroll
      for (int f = 0; f < 32; ++f) dst[(size_t)f * 512] = valid ? (half_t)acc[f] : (half_t)0.f;
    }
  }
  __syncthreads();
}

#ifndef DSA_CAP
#define DSA_CAP 128
#endif
__device__ __forceinline__ void dsa_item(const KP& p, int b, int tile, char* smem) {
  const int t0 = tile * 16;
  int tid = threadIdx.x;
  asm volatile("" : "+v"(tid));
  const int lane = tid & 63, wid = tid >> 6;
  uint32_t* hist = (uint32_t*)smem;
  unsigned long long* cand = (unsigned long long*)(smem + 16384);
  unsigned short* sel = (unsigned short*)(smem + 32768);
  unsigned long long* pfx = (unsigned long long*)(smem + 40960);
  unsigned long long* tkey = pfx + 16;
  int* need = (int*)(tkey + 16);
  int* state = need + 16;
  int* cnt = state + 16;
  int* ccnt = cnt + 16;
  int* pf16 = ccnt + 16;
  int* ovf = pf16 + 16;
  int* nrem = ovf + 16;
  int* fastf = nrem + 8;
  uint32_t* h1w = (uint32_t*)(smem + 43008);
  float* pbuf = (float*)smem + wid * 2048;

  const half_t* ub = p.u() + (size_t)b * SEQ * NU;
  const int mytok = lane & 15, hq = lane >> 4;
  const int myt = t0 + mytok;
  if (tid < 16) {
    const int t = t0 + tid;
    pfx[tid] = 0ull; tkey[tid] = 0ull; need[tid] = 256; state[tid] = (t < 256) ? 0 : 1; cnt[tid] = 0; ccnt[tid] = 0;
    pf16[tid] = 0; ovf[tid] = 0;
  }
  if (tid < 8) nrem[tid] = 0;
  if (tid < 16) fastf[tid] = 0;
  for (int i = tid; i < 6144; i += 256) h1w[i] = 0u;
  h8 qf[8], qlh, qll;
  float iw[8];
  {
    const half_t* qrow = ub + (size_t)myt * NU;
#pragma unroll
    for (int h = 0; h < 8; ++h) qf[h] = *(const h8*)(qrow + C_IQ + h * 32 + hq * 8);
    const h8 w8 = *(const h8*)(qrow + C_IW);
#pragma unroll
    for (int h = 0; h < 8; ++h) iw[h] = (float)w8[h] * 0.03125f;
#pragma unroll
    for (int e = 0; e < 8; ++e) {
      float a = 0.f;
#pragma unroll
      for (int h = 0; h < 8; ++h) a += iw[h] * (float)qf[h][e];
      const half_t hi = (half_t)a;
      qlh[e] = hi;
      qll[e] = (half_t)(a - (float)hi);
    }
  }
  __syncthreads();
  const int nkt = (t0 + 16 + 31) >> 5;

  auto loadk = [&](int kt, h8* a) __attribute__((always_inline)) {
#pragma unroll
    for (int i = 0; i < 2; ++i)
      a[i] = *(const h8*)(ub + (size_t)(kt * 32 + i * 16 + (lane & 15)) * NU + C_IK + hq * 8);
  };
  auto scores = [&](const h8* a, float* sc) __attribute__((always_inline)) {
#pragma unroll
    for (int i = 0; i < 2; ++i) {
      f32x4 acc = {0.f, 0.f, 0.f, 0.f};
      acc = __builtin_amdgcn_mfma_f32_16x16x32_f16(a[i], qll, acc, 0, 0, 0);
      acc = __builtin_amdgcn_mfma_f32_16x16x32_f16(a[i], qlh, acc, 0, 0, 0);
#pragma unroll
      for (int h = 0; h < 8; ++h) {
        f32x4 d = {0.f, 0.f, 0.f, 0.f};
        d = __builtin_amdgcn_mfma_f32_16x16x32_f16(a[i], qf[h], d, 0, 0, 0);
#pragma unroll
        for (int r = 0; r < 4; ++r) acc[r] = __builtin_fmaf(__builtin_fabsf(d[r]), iw[h], acc[r]);
      }
#pragma unroll
      for (int r = 0; r < 4; ++r) sc[i * 4 + r] = acc[r];
    }
  };
  auto skey = [&](float s) __attribute__((always_inline)) -> uint32_t {
    s = s + 0.f;
    const uint32_t u_ = __float_as_uint(s);
    return (u_ & 0x80000000u) ? ~u_ : (u_ | 0x80000000u);
  };
  auto mkkey = [&](float s, int key) __attribute__((always_inline)) -> unsigned long long {
    s = s + 0.f;
    uint32_t u_ = __float_as_uint(s);
    u_ = (u_ & 0x80000000u) ? ~u_ : (u_ | 0x80000000u);
    return ((unsigned long long)u_ << 16) | (unsigned long long)(8191 - key);
  };
  auto scan_token = [&](int tk, int level) __attribute__((always_inline)) -> bool {
    const int shift = 40 - 8 * level;
    const uint32_t* hrow = hist + tk * 256;
    const uint4 hv = *(const uint4*)&hrow[252 - 4 * lane];
    const int c = (int)(hv.x + hv.y + hv.z + hv.w);
    int cum = c;
#pragma unroll
    for (int o = 1; o < 64; o <<= 1) {
      int v = __shfl_up(cum, o);
      if (lane >= o) cum += v;
    }
    const int nd = need[tk];
    const unsigned long long mask = __ballot(cum >= nd);
    const int L = mask ? (int)__builtin_ctzll(mask) : 63;
    int running = cum - c, bstar, cb;
    if (running + (int)hv.w >= nd) { bstar = 255 - 4 * lane; cb = hv.w; }
    else {
      running += hv.w;
      if (running + (int)hv.z >= nd) { bstar = 254 - 4 * lane; cb = hv.z; }
      else {
        running += hv.z;
        if (running + (int)hv.y >= nd) { bstar = 253 - 4 * lane; cb = hv.y; }
        else { running += hv.y; bstar = 252 - 4 * lane; cb = hv.x; }
      }
    }
    running = __shfl(running, L); bstar = __shfl(bstar, L); cb = __shfl(cb, L);
    const int nd2 = nd - running;
    const bool fin = (cb == nd2) || (level == 5);
    if (lane == 0) {
      const unsigned long long np = (pfx[tk] << 8) | (unsigned long long)bstar;
      if (fin) { state[tk] = 0; tkey[tk] = np << shift; }
      else { need[tk] = nd2; pfx[tk] = np; }
    }
    return fin;
  };
  auto run_level = [&](int level, bool fillx) __attribute__((always_inline)) {
    const int shift = 40 - 8 * level;
    for (int i = tid; i < 4096; i += 256) hist[i] = 0u;
    __syncthreads();
    {
      const unsigned long long mypfx = pfx[mytok];
      const bool act = state[mytok] == 1 && fastf[mytok] == 0;
      h8 na[2];
      if (wid < nkt) loadk(wid, na);
      for (int kt = wid; kt < nkt; kt += 4) {
        h8 ca[2];
#pragma unroll
        for (int i = 0; i < 2; ++i) ca[i] = na[i];
        loadk(kt + 4 < nkt ? kt + 4 : kt, na);
        float sc[8];
        scores(ca, sc);
        if (act) {
#pragma unroll
          for (int q = 0; q < 8; ++q) {
            const int key = kt * 32 + (q >> 2) * 16 + 4 * hq + (q & 3);
            if (key <= myt) {
              if (level < 2) {
                const uint32_t u32 = skey(sc[q]);
                if (level == 0) {
                  const uint32_t b8 = u32 >> 24;
                  atomicAdd(&hist[mytok * 256 + (int)b8], 1u);
                  if (fillx) {
                    const uint32_t ix = b8 - 0xBEu;
                    if (ix < 3u) {
                      const uint32_t e16 = (ix * 16u + (uint32_t)mytok) * 256u + ((u32 >> 16) & 255u);
                      atomicAdd(&h1w[e16 >> 1], (e16 & 1u) ? 65536u : 1u);
                    }
                  }
                } else if ((u32 >> 24) == (uint32_t)mypfx) atomicAdd(&hist[mytok * 256 + (int)((u32 >> 16) & 255u)], 1u);
              } else {
                const unsigned long long k48 = mkkey(sc[q], key);
                if ((k48 >> (shift + 8)) == mypfx)
                  atomicAdd(&hist[mytok * 256 + (int)((k48 >> shift) & 255ull)], 1u);
              }
            }
          }
        }
      }
    }
    __syncthreads();
    {
      int rem = 0;
      for (int j = 0; j < 4; ++j) {
        const int tk = wid * 4 + j;
        if (state[tk] != 1 || fastf[tk] != 0) continue;
        if (!scan_token(tk, level)) rem++;
      }
      if (lane == 0 && rem) atomicAdd(&nrem[level], rem);
    }
    __syncthreads();
  };

  run_level(0, true);
  if (tid < 16) {
    const int b0 = (int)pfx[tid];
    const int f = (state[tid] == 1 && b0 >= 0xBE && b0 <= 0xC0) ? 1 : 0;
    fastf[tid] = f;
    if (state[tid] == 1 && !f) atomicAdd(&nrem[7], 1);
  }
  __syncthreads();
  if (nrem[7] != 0) run_level(1, false);
  for (int j = 0; j < 4; ++j) {
    const int tk = wid * 4 + j;
    if (state[tk] != 1 || fastf[tk] == 0) continue;
    const uint32_t ix = (uint32_t)pfx[tk] - 0xBEu;
    const unsigned short* hx = (const unsigned short*)h1w + (ix * 16u + (uint32_t)tk) * 256u;
    const ushort4 c4 = *(const ushort4*)&hx[4 * lane];
    uint4 w4;
    w4.x = c4.x; w4.y = c4.y; w4.z = c4.z; w4.w = c4.w;
    *(uint4*)&hist[tk * 256 + 4 * lane] = w4;
    __builtin_amdgcn_wave_barrier();
    scan_token(tk, 1);
  }
  __syncthreads();
  if (tid < 16) fastf[tid] = 0;
  __syncthreads();

  {
    const int st0 = state[mytok];
    const unsigned long long mytk = tkey[mytok];
    const unsigned long long myp16 = pfx[mytok];
    h8 na[2];
    if (wid < nkt) loadk(wid, na);
    for (int kt = wid; kt < nkt; kt += 4) {
      h8 ca[2];
#pragma unroll
      for (int i = 0; i < 2; ++i) ca[i] = na[i];
      loadk(kt + 4 < nkt ? kt + 4 : kt, na);
      float sc[8];
      scores(ca, sc);
#pragma unroll
      for (int q = 0; q < 8; ++q) {
        const int key = kt * 32 + (q >> 2) * 16 + 4 * hq + (q & 3);
        if (key <= myt) {
          const uint32_t u32 = skey(sc[q]);
          bool take, isc = false;
          if (st0 == 0) take = (((unsigned long long)u32 << 16) | (unsigned long long)(8191 - key)) >= mytk;
          else {
            const uint32_t p16 = u32 >> 16;
            take = p16 > (uint32_t)myp16;
            isc = p16 == (uint32_t)myp16;
          }
          if (take) {
            const int pos = atomicAdd(&cnt[mytok], 1);
            if (pos < 256) sel[mytok * 256 + pos] = (unsigned short)key;
          } else if (isc) {
            const int pos = atomicAdd(&ccnt[mytok], 1);
            if (pos < DSA_CAP) cand[mytok * 128 + pos] = ((unsigned long long)u32 << 16) | (unsigned long long)(8191 - key);
          }
        }
      }
    }
  }
  __syncthreads();
  {
    int nov = 0;
    for (int j = 0; j < 4; ++j) {
      const int tk = wid * 4 + j;
      if (state[tk] != 1) continue;
      const int nc = ccnt[tk];
      if (nc > DSA_CAP) {
        nov++;
        if (lane == 0) { ovf[tk] = 1; pf16[tk] = (int)pfx[tk]; }
        continue;
      }
      const int nd = need[tk];
      const unsigned long long k0 = (lane < nc) ? cand[tk * 128 + lane] : 0ull;
      const unsigned long long k1 = (lane + 64 < nc) ? cand[tk * 128 + lane + 64] : 0ull;
      int r0 = 0, r1 = 0;
      for (int q = 0; q < nc; ++q) {
        const unsigned long long kq = cand[tk * 128 + q];
        r0 += (kq > k0) ? 1 : 0;
        r1 += (kq > k1) ? 1 : 0;
      }
      if (lane < nc && r0 < nd) {
        const int pos = atomicAdd(&cnt[tk], 1);
        if (pos < 256) sel[tk * 256 + pos] = (unsigned short)(8191 - (int)(k0 & 0xFFFFull));
      }
      if (lane + 64 < nc && r1 < nd) {
        const int pos = atomicAdd(&cnt[tk], 1);
        if (pos < 256) sel[tk * 256 + pos] = (unsigned short)(8191 - (int)(k1 & 0xFFFFull));
      }
      if (lane == 0) state[tk] = 2;
    }
    if (lane == 0 && nov) atomicAdd(&nrem[6], nov);
  }
  __syncthreads();
  if (nrem[6] != 0) {
    for (int level = 2; level < 6; ++level) {
      run_level(level, false);
      if (nrem[level] == 0) break;
    }
    {
      const bool mine = ovf[mytok] != 0;
      const unsigned long long mytk = tkey[mytok];
      const unsigned long long myp16 = (unsigned long long)(unsigned)pf16[mytok];
      h8 na[2];
      if (wid < nkt) loadk(wid, na);
      for (int kt = wid; kt < nkt; kt += 4) {
        h8 ca[2];
#pragma unroll
        for (int i = 0; i < 2; ++i) ca[i] = na[i];
        loadk(kt + 4 < nkt ? kt + 4 : kt, na);
        float sc[8];
        scores(ca, sc);
        if (mine) {
#pragma unroll
          for (int q = 0; q < 8; ++q) {
            const int key = kt * 32 + (q >> 2) * 16 + 4 * hq + (q & 3);
            if (key <= myt) {
              const unsigned long long k48 = mkkey(sc[q], key);
              if ((k48 >> 32) == myp16 && k48 >= mytk) {
                const int pos = atomicAdd(&cnt[mytok], 1);
                if (pos < 256) sel[mytok * 256 + pos] = (unsigned short)key;
              }
            }
          }
        }
      }
    }
    __syncthreads();
  }
#ifndef DSA_ATT_REP
#define DSA_ATT_REP 1
#endif
  for (int jr = 0; jr < 4 * DSA_ATT_REP; ++jr) {
    const int j = jr & 3;
    const int tk = wid * 4 + j;
    const int t = t0 + tk;
    const int nsel = min(cnt[tk], 256);
    const half_t* urow = ub + (size_t)t * NU;
    const int col = lane & 15;
    h8 q0, q1;
#pragma unroll
    for (int e = 0; e < 8; ++e) { q0[e] = (half_t)0.f; q1[e] = (half_t)0.f; }
    if (col < 8) {
      q0 = *(const h8*)(urow + C_BQ + col * 64 + hq * 8);
      q1 = *(const h8*)(urow + C_BQ + col * 64 + 32 + hq * 8);
    }
    float mx = NEGF;
#pragma unroll 1
    for (int mg = 0; mg < 2; ++mg) {
#pragma unroll
      for (int mm = 0; mm < 8; ++mm) {
        const int m = mg * 8 + mm;
        const int pos = m * 16 + col;
        const int s = (pos < nsel) ? (int)sel[tk * 256 + pos] : 0;
        const half_t* kp = ub + (size_t)s * NU + C_BK + hq * 8;
        const h8 a0 = *(const h8*)kp, a1 = *(const h8*)(kp + 32);
        f32x4 d = {0.f, 0.f, 0.f, 0.f};
        d = __builtin_amdgcn_mfma_f32_16x16x32_f16(a0, q0, d, 0, 0, 0);
        d = __builtin_amdgcn_mfma_f32_16x16x32_f16(a1, q1, d, 0, 0, 0);
#pragma unroll
        for (int r = 0; r < 4; ++r) {
          const int pp = m * 16 + hq * 4 + r;
          const float v = (pp < nsel) ? d[r] * 0.125f : NEGF;
          mx = fmaxf(mx, v);
          if (col < 8) pbuf[pp * 8 + col] = v;
        }
      }
    }
    mx = fmaxf(mx, __shfl_xor(mx, 16));
    mx = fmaxf(mx, __shfl_xor(mx, 32));
    const float mxh = __shfl(mx, lane & 7);
    __builtin_amdgcn_wave_barrier();
    float sum = 0.f;
#pragma unroll 4
    for (int k = 0; k < 32; ++k) {
      const int i = lane + 64 * k;
      const float v = pbuf[i];
      const float e = (v > -1e29f) ? __expf(v - mxh) : 0.f;
      pbuf[i] = e;
      sum += e;
    }
    sum += __shfl_xor(sum, 8);
    sum += __shfl_xor(sum, 16);
    sum += __shfl_xor(sum, 32);
    const float inv = 1.f / sum;
    __builtin_amdgcn_wave_barrier();
    {
      const int rs = lane >> 3, dc = lane & 7;
      float acc[8][8];
#pragma unroll
      for (int h = 0; h < 8; ++h)
#pragma unroll
        for (int e = 0; e < 8; ++e) acc[h][e] = 0.f;
#pragma unroll 1
      for (int g8 = 0; g8 < 4; ++g8) {
        h8 vv[8];
#pragma unroll
        for (int i = 0; i < 8; ++i) {
          const int pos = (g8 * 8 + i) * 8 + rs;
          const int s = (pos < nsel) ? (int)sel[tk * 256 + pos] : 0;
          vv[i] = *(const h8*)(ub + (size_t)s * NU + C_BV + dc * 8);
        }
#pragma unroll
        for (int i = 0; i < 8; ++i) {
          const int pos = (g8 * 8 + i) * 8 + rs;
          const f32x4 pa = *(const f32x4*)&pbuf[pos * 8];
          const f32x4 pb = *(const f32x4*)&pbuf[pos * 8 + 4];
          float vf[8];
#pragma unroll
          for (int e = 0; e < 8; ++e) vf[e] = (float)vv[i][e];
#pragma unroll
          for (int e = 0; e < 8; ++e) {
            acc[0][e] += pa[0] * vf[e]; acc[1][e] += pa[1] * vf[e]; acc[2][e] += pa[2] * vf[e]; acc[3][e] += pa[3] * vf[e];
            acc[4][e] += pb[0] * vf[e]; acc[5][e] += pb[1] * vf[e]; acc[6][e] += pb[2] * vf[e]; acc[7][e] += pb[3] * vf[e];
          }
        }
      }
      half_t* yrow = p.yb() + (size_t)(b * SEQ + t) * 512;
#pragma unroll
      for (int h = 0; h < 8; ++h) {
        const float invh = __shfl(inv, h);
        h8 ov;
        const h8 z8 = *(const h8*)(urow + C_BZ + h * 64 + dc * 8);
#pragma unroll
        for (int e = 0; e < 8; ++e) {
          float a = acc[h][e];
          a += __shfl_xor(a, 8);
          a += __shfl_xor(a, 16);
          a += __shfl_xor(a, 32);
          ov[e] = (half_t)(a * invh * siluf_((float)z8[e]));
        }
        if (rs == h) *(h8*)(yrow + h * 64 + dc * 8) = ov;
      }
    }
    __builtin_amdgcn_wave_barrier();
  }
  __syncthreads();
}

__device__ __forceinline__ void phase2(const KP& p, int l, char* smem, int* q, int xcc) {
  xcd_schedule(q, xcc, 196 * 8, 1, smem, [&](int grp, int) __attribute__((always_inline)) {
    const int y = grp & 7, k = grp >> 3;
    if (k < 4) compress_item(p, l, k * 8 + y, smem);
    else if (k < 132) dsa_item(p, y & 1, 511 - ((k - 4) * 4 + (y >> 1)), smem);
    else pool_item(p, l, (k - 132) * 8 + y, smem);
  });
}

struct DState {
  float m, l;
  f32x16 o[2];
};
#define MLOW (-1e4f)
__device__ __forceinline__ void ds_reset(DState& st) {
  st.m = MLOW; st.l = 0.f;
#pragma unroll
  for (int dt = 0; dt < 2; ++dt)
#pragma unroll
    for (int r = 0; r < 16; ++r) st.o[dt][r] = 0.f;
}
typedef unsigned int u32x4 __attribute__((ext_vector_type(4)));
typedef unsigned int u32x2 __attribute__((ext_vector_type(2)));
struct StageRegs {
  u32x4 k0, k1, v0, v1;
};
template <bool HASV>
__device__ __forceinline__ void load_stage(StageRegs& r, const half_t* __restrict__ Kb, int ldk,
                                           const half_t* __restrict__ VT, int ldv, int key0, int tid) {
  const int row = tid >> 3, c = tid & 7;
  r.k0 = *(const u32x4*)(Kb + (size_t)(key0 + row) * ldk + c * 8);
  r.k1 = *(const u32x4*)(Kb + (size_t)(key0 + row + 32) * ldk + c * 8);
  if (HASV) {
    r.v0 = *(const u32x4*)(VT + (size_t)row * ldv + key0 + c * 8);
    r.v1 = *(const u32x4*)(VT + (size_t)(row + 32) * ldv + key0 + c * 8);
  }
}
template <bool HASV>
__device__ __forceinline__ void write_stage(const StageRegs& r, half_t* Ks, half_t* Vs, int tid) {
  const int row = tid >> 3, c = tid & 7;
  *(u32x4*)&Ks[row * 72 + c * 8] = r.k0;
  *(u32x4*)&Ks[(row + 32) * 72 + c * 8] = r.k1;
  if (HASV) {
    const int ks = c >> 1, a = c & 1;
    u32x2 lo, hi;
    lo[0] = r.v0[0]; lo[1] = r.v0[1]; hi[0] = r.v0[2]; hi[1] = r.v0[3];
    *(u32x2*)&Vs[row * 72 + ks * 16 + a * 4] = lo;
    *(u32x2*)&Vs[row * 72 + ks * 16 + 8 + a * 4] = hi;
    lo[0] = r.v1[0]; lo[1] = r.v1[1]; hi[0] = r.v1[2]; hi[1] = r.v1[3];
    *(u32x2*)&Vs[(row + 32) * 72 + ks * 16 + a * 4] = lo;
    *(u32x2*)&Vs[(row + 32) * 72 + ks * 16 + 8 + a * 4] = hi;
  }
}
template <bool ONLINE, bool HASV, bool FAST, class VF>
__device__ __forceinline__ void dense_block(DState& st, const half_t* Ks, const half_t* Vs, const h8* qf, int key0,
                                            int flag, VF valid, float fixed_m, float fixed_invl, f32x16* pout,
                                            int lane) {
  const int h = lane >> 5, c = lane & 31;
  f32x16 s[2];
#pragma unroll
  for (int kt = 0; kt < 2; ++kt) {
#pragma unroll
    for (int r = 0; r < 16; ++r) s[kt][r] = 0.f;
#pragma unroll
    for (int ks = 0; ks < 4; ++ks) {
      const h8 a = *(const h8*)&Ks[(32 * kt + c) * 72 + 16 * ks + 8 * h];
      s[kt] = __builtin_amdgcn_mfma_f32_32x32x16_f16(a, qf[ks], s[kt], 0, 0, 0);
    }
  }
  float cm = NEGF;
#pragma unroll
  for (int kt = 0; kt < 2; ++kt)
#pragma unroll
    for (int r = 0; r < 16; ++r) {
      const int key = key0 + 32 * kt + (r & 3) + 8 * (r >> 2) + 4 * h;
      const float v = (FAST ? (flag != 0) : valid(key, flag)) ? s[kt][r] : NEGF;
      s[kt][r] = v;
      cm = fmaxf(cm, v);
    }
  float mnew;
  if (ONLINE) {
    cm = fmaxf(cm, __shfl_xor(cm, 32));
    mnew = st.m;
    if (__ballot(cm > st.m + 8.0f) != 0ull) {
      mnew = fmaxf(st.m, cm);
      const float alpha = __builtin_amdgcn_exp2f(st.m - mnew);
      st.m = mnew;
      st.l *= alpha;
      if (HASV) {
#pragma unroll
        for (int dt = 0; dt < 2; ++dt)
#pragma unroll
          for (int r = 0; r < 16; ++r) st.o[dt][r] *= alpha;
      }
    }
  } else {
    mnew = fixed_m;
  }
  float ps = 0.f;
#pragma unroll
  for (int kt = 0; kt < 2; ++kt)
#pragma unroll
    for (int r = 0; r < 16; ++r) {
      float e = __builtin_amdgcn_exp2f(s[kt][r] - mnew);
      if (!ONLINE) e *= fixed_invl;
      s[kt][r] = e;
      ps += e;
    }
  st.l += ps;
  if (pout) { pout[0] = s[0]; pout[1] = s[1]; }
  if (HASV) {
#pragma unroll
    for (int ks = 0; ks < 4; ++ks) {
      h8 pf;
#pragma unroll
      for (int jj = 0; jj < 8; ++jj) pf[jj] = (half_t)s[ks >> 1][8 * (ks & 1) + jj];
#pragma unroll
      for (int dt = 0; dt < 2; ++dt) {
        const h8 vf = *(const h8*)&Vs[(32 * dt + c) * 72 + 16 * ks + 8 * h];
        st.o[dt] = __builtin_amdgcn_mfma_f32_32x32x16_f16(vf, pf, st.o[dt], 0, 0, 0);
      }
    }
  }
}
template <bool ONLINE, bool HASV, bool WANTP, class PRE, class FU, class VF, class PO>
__device__ __forceinline__ void run_dense(DState& st, const half_t* __restrict__ Kb, int ldk,
                                          const half_t* __restrict__ VT, int ldv, int blk_lo, int blk_hi, const h8* qf,
                                          PRE pre, FU full, VF valid, float fixed_m, float fixed_invl, PO post, char* smem,
                                          int tid) {
  half_t* Ks = (half_t*)smem;
  half_t* Vs = Ks + 64 * 72;
  const int lane = tid & 63;
  StageRegs sr;
  load_stage<HASV>(sr, Kb, ldk, VT, ldv, blk_lo * 64, tid);
  for (int blk = blk_lo; blk <= blk_hi; ++blk) {
    __syncthreads();
    write_stage<HASV>(sr, Ks, Vs, tid);
    __syncthreads();
    const int nb = blk < blk_hi ? blk + 1 : blk;
    load_stage<HASV>(sr, Kb, ldk, VT, ldv, nb * 64, tid);
    const int flag = pre(blk);
    if (__ballot(flag != 0) != 0ull) {
      f32x16 pp[2];
      if (full(blk))
        dense_block<ONLINE, HASV, true>(st, Ks, Vs, qf, blk * 64, flag, valid, fixed_m, fixed_invl,
                                        WANTP ? pp : (f32x16*)nullptr, lane);
      else
        dense_block<ONLINE, HASV, false>(st, Ks, Vs, qf, blk * 64, flag, valid, fixed_m, fixed_invl,
                                         WANTP ? pp : (f32x16*)nullptr, lane);
      if (WANTP) post(blk * 64, pp);
    }
  }
}

__device__ __forceinline__ void nsa_item(const KP& p, int b, int g, int tile, char* smem) {
  int tid = threadIdx.x;
  asm volatile("" : "+v"(tid));
  const int lane = tid & 63, wid = tid >> 6;
  const int t0 = tile * 32;
  const int tw0 = t0 + 8 * wid;
  const int col = lane & 31, h = lane >> 5;
  const int j = col >> 2, r4 = col & 3;
  const int tj = tw0 + j;
  const int head = g * 4 + r4;
  float* impA = (float*)(smem + 18432 + wid * 8320);
  float* impB = impA + 1024;
  unsigned long long* msk = (unsigned long long*)(smem + 18432 + 4 * 8320 + wid * 128);
  uint32_t* kbuf = (uint32_t*)(smem + 18432 + 4 * 8320 + 512 + wid * 512);
  const half_t* ub = p.u() + (size_t)b * SEQ * NU;
  const half_t* urow = ub + (size_t)tj * NU;
  h8 qf[4];
#pragma unroll
  for (int ks = 0; ks < 4; ++ks) {
    qf[ks] = *(const h8*)(urow + C_CQ + head * 64 + 16 * ks + 8 * h);
#pragma unroll
    for (int e = 0; e < 8; ++e) qf[ks][e] = (half_t)((float)qf[ks][e] * 0.18033688f);
  }
  float gate[3];
#pragma unroll
  for (int i = 0; i < 3; ++i) gate[i] = sigmoidf_((float)urow[C_CG + head * 3 + i]);
  f32x16 res[2];
#pragma unroll
  for (int dt = 0; dt < 2; ++dt)
#pragma unroll
    for (int r = 0; r < 16; ++r) res[dt][r] = 0.f;
  for (int i = lane; i < 2080; i += 64) impA[i] = 0.f;
  DState st;
  auto nopost = [&](int, f32x16*) __attribute__((always_inline)) {};

  {
    const int nmax_j = (tj >= 31) ? ((tj - 31) >> 4) : -1;
    const int bhi = (t0 >> 4) >> 6;
    const half_t* Kc = p.kcmp() + (size_t)(b * 2 + g) * 512 * 64;
    const half_t* Vc = p.vcmpT() + (size_t)(b * 2 + g) * 64 * 512;
    auto pre = [&](int) __attribute__((always_inline)) { return 1; };
    const int nmax_w = (tw0 >= 31) ? ((tw0 - 31) >> 4) : -1;
    auto fullc = [&](int blk) __attribute__((always_inline)) { return blk * 64 + 63 <= nmax_w; };
    auto vfn = [&](int n, int) __attribute__((always_inline)) { return n <= nmax_j; };
    ds_reset(st);
    run_dense<true, false, false>(st, Kc, 64, (const half_t*)nullptr, 0, 0, bhi, qf, pre, fullc, vfn, 0.f, 0.f, nopost, smem, tid);
    float lt = st.l;
    lt += __shfl_xor(lt, 32);
    const float mfix = st.m;
    const float invl = lt > 0.f ? 1.f / lt : 0.f;
    ds_reset(st);
    auto post = [&](int n0, f32x16* pp) __attribute__((always_inline)) {
#pragma unroll
      for (int kt = 0; kt < 2; ++kt)
#pragma unroll
        for (int qd = 0; qd < 4; ++qd) {
          float a = pp[kt][4 * qd] + pp[kt][4 * qd + 1] + pp[kt][4 * qd + 2] + pp[kt][4 * qd + 3];
          float bb = pp[kt][4 * qd + 3];
          a += __shfl_xor(a, 1); a += __shfl_xor(a, 2);
          bb += __shfl_xor(bb, 1); bb += __shfl_xor(bb, 2);
          if (r4 == 0) {
            const int sblk = (n0 >> 2) + 8 * kt + 2 * qd + h;
            impA[j * 128 + sblk] = a;
            impB[j * 132 + sblk + 1] = bb;
          }
        }
    };
    run_dense<false, true, true>(st, Kc, 64, Vc, 512, 0, bhi, qf, pre, fullc, vfn, mfix, invl, post, smem, tid);
#pragma unroll
    for (int dt = 0; dt < 2; ++dt)
#pragma unroll
      for (int r = 0; r < 16; ++r) res[dt][r] += gate[0] * st.o[dt][r];
  }
  __builtin_amdgcn_wave_barrier();
#pragma unroll 1
  for (int jj = 0; jj < 8; ++jj) {
    const int t = tw0 + jj;
    const int blk = t >> 6;
    uint32_t k0, k1;
    {
      const int s0 = lane, s1 = lane + 64;
      const float i0 = impA[jj * 128 + s0] + impB[jj * 132 + s0];
      const float i1 = impA[jj * 128 + s1] + impB[jj * 132 + s1];
      auto mk = [&](float im, int s) __attribute__((always_inline)) -> uint32_t {
        if (s > blk) return 0u;
        uint32_t kk = ((__float_as_uint(im) >> 1) & ~127u) | (uint32_t)(127 - s) | 0x40000000u;
        if (s == 0 || s == blk || s == blk - 1) kk |= 0x80000000u;
        return kk;
      };
      k0 = mk(i0, s0); k1 = mk(i1, s1);
    }
    kbuf[lane] = k0;
    kbuf[lane + 64] = k1;
    __builtin_amdgcn_wave_barrier();
    int r0 = 0, r1 = 0;
#pragma unroll 4
    for (int qd = 0; qd < 32; ++qd) {
      const uint4 kq = *(const uint4*)&kbuf[4 * qd];
      r0 += (kq.x > k0) + (kq.y > k0) + (kq.z > k0) + (kq.w > k0);
      r1 += (kq.x > k1) + (kq.y > k1) + (kq.z > k1) + (kq.w > k1);
    }
    const unsigned long long lo = __ballot(k0 != 0u && r0 < 16);
    const unsigned long long hi = __ballot(k1 != 0u && r1 < 16);
    __builtin_amdgcn_wave_barrier();
    if (lane == 0) { msk[jj * 2] = lo; msk[jj * 2 + 1] = hi; }
  }
  __builtin_amdgcn_wave_barrier();
  const unsigned long long mylo = msk[j * 2], myhi = msk[j * 2 + 1];
  {
    const half_t* Ksel = ub + C_CKS + g * 64;
    const half_t* Vsel = p.vsT() + (size_t)(b * 2 + g) * 64 * SEQ;
    auto pre = [&](int blk) __attribute__((always_inline)) {
      const unsigned long long mm_ = (blk < 64) ? mylo : myhi;
      return (int)((mm_ >> (blk & 63)) & 1ull);
    };
    auto vfn = [&](int key, int flag) __attribute__((always_inline)) { return flag != 0 && key <= tj; };
    ds_reset(st);
    auto fulls = [&](int blk) __attribute__((always_inline)) { return blk * 64 + 63 <= tw0; };
    run_dense<true, true, false>(st, Ksel, NU, Vsel, SEQ, 0, (t0 + 31) >> 6, qf, pre, fulls, vfn, 0.f, 0.f, nopost, smem, tid);
    float lt = st.l;
    lt += __shfl_xor(lt, 32);
    const float sc = lt > 0.f ? gate[1] / lt : 0.f;
#pragma unroll
    for (int dt = 0; dt < 2; ++dt)
#pragma unroll
      for (int r = 0; r < 16; ++r) res[dt][r] += sc * st.o[dt][r];
  }
  {
    const half_t* Kw = ub + C_CKW + g * 64;
    const half_t* Vw = p.vwT() + (size_t)(b * 2 + g) * 64 * SEQ;
    auto pre = [&](int blk) __attribute__((always_inline)) {
      return (int)((blk * 64 <= tj) && (blk * 64 + 63 > tj - 512));
    };
    auto vfn = [&](int key, int) __attribute__((always_inline)) { return key <= tj && key > tj - 512; };
    ds_reset(st);
    auto fullw = [&](int blk) __attribute__((always_inline)) { return blk * 64 + 63 <= tw0 && blk * 64 > tw0 + 7 - 512; };
    run_dense<true, true, false>(st, Kw, NU, Vw, SEQ, max(0, t0 - 511) >> 6, (t0 + 31) >> 6, qf, pre, fullw, vfn, 0.f, 0.f,
                                 nopost, smem, tid);
    float lt = st.l;
    lt += __shfl_xor(lt, 32);
    const float sc = lt > 0.f ? gate[2] / lt : 0.f;
#pragma unroll
    for (int dt = 0; dt < 2; ++dt)
#pragma unroll
      for (int r = 0; r < 16; ++r) res[dt][r] += sc * st.o[dt][r];
  }
  half_t* yrow = p.yc() + (size_t)(b * SEQ + tj) * 512 + head * 64;
#pragma unroll
  for (int dt = 0; dt < 2; ++dt)
#pragma unroll
    for (int qd = 0; qd < 4; ++qd) {
      const int d = 32 * dt + 8 * qd + 4 * h;
      const h4 z = *(const h4*)(urow + C_CZ + head * 64 + d);
      h4 ov;
#pragma unroll
      for (int e = 0; e < 4; ++e) ov[e] = (half_t)(res[dt][4 * qd + e] * siluf_((float)z[e]));
      *(h4*)(yrow + d) = ov;
    }
  __syncthreads();
}

__device__ __forceinline__ void phase_nsa(const KP& p, char* smem, int* q, int xcc) {
  xcd_schedule(q, xcc, 1024, 1, smem, [&](int grp, int) __attribute__((always_inline)) {
    const int y = grp & 7, k = grp >> 3;
    const int b = y & 1, g = (y >> 1) & 1, tile = 255 - (k * 2 + (y >> 2));
    nsa_item(p, b, g, tile, smem);
  });
}

__device__ __forceinline__ void phase_merge(const KP& p, char* smem, int* q, int xcc) {
  xcd_schedule(q, xcc, 16, 64, smem, [&](int grp, int within) __attribute__((always_inline)) {
    const int mt = (grp & 15) * 8 + (within & 7), nt = (within >> 3);
    const int m0 = mt * 128, n0 = nt * 128;
    f32x16 tot[2][2];
#pragma unroll
    for (int i = 0; i < 2; ++i)
#pragma unroll
      for (int jn = 0; jn < 2; ++jn)
#pragma unroll
        for (int r = 0; r < 16; ++r) tot[i][jn][r] = 0.f;
#pragma unroll 1
    for (int br = 0; br < 3; ++br) {
      const half_t* A = (br == 0 ? p.ya() : (br == 1 ? p.yb() : p.yc())) + (size_t)m0 * 512;
      const half_t* B = p.wpT() + (size_t)br * DM * 512 + (size_t)n0 * 512;
      const half_t* G = p.u() + (size_t)m0 * NU + C_GM + br * 1024 + n0;
      gemm_tile<2>(
          512, [&](int r, int k) { return *(const uint4*)(A + (size_t)r * 512 + k); },
          [&](int r, int k) { return *(const uint4*)(B + (size_t)r * 512 + k); },
          [&](int mi, int ni, int r, int row, int col, float v) {
            const float gz = (float)G[(size_t)row * NU + col];
            tot[mi][ni][r] += sigmoidf_(gz) * v;
          },
          smem);
    }
    int tidx = threadIdx.x;
    asm volatile("" : "+v"(tidx));
    const int lane = tidx & 63, wid = tidx >> 6, wm = wid >> 1, wn = wid & 1;
#pragma unroll
    for (int mi = 0; mi < 2; ++mi)
#pragma unroll
      for (int ni = 0; ni < 2; ++ni)
#pragma unroll
        for (int r = 0; r < 16; ++r) {
          const int row = wm * 64 + mi * 32 + (r & 3) + 8 * (r >> 2) + 4 * (lane >> 5);
          const int col = wn * 64 + ni * 32 + (lane & 31);
          p.mm()[(size_t)(m0 + row) * DM + n0 + col] = (half_t)tot[mi][ni][r];
        }
  });
}

__device__ __forceinline__ void phase_outproj(const KP& p, char* smem, int* q, int xcc) {
  xcd_schedule(q, xcc, 8, 64, smem, [&](int grp, int within) __attribute__((always_inline)) {
    const int mt = grp * 8 + (within & 7), nt = (within >> 3);
    const int m0 = mt * 256, n0 = nt * 128;
    const half_t* A = p.mm() + (size_t)m0 * DM;
    const half_t* B = p.woT() + (size_t)n0 * DM;
    gemm_tile_big(
        DM, [&](int r, int k) { return *(const uint4*)(A + (size_t)r * DM + k); },
        [&](int r, int k) { return *(const uint4*)(B + (size_t)r * DM + k); },
        [&](int mi, int ni, int r, int row, int col, float v) {
          const size_t xi = (size_t)(m0 + row) * DM + n0 + col;
          ((float*)p.u())[xi] = ALPHA_F * p.xr()[xi] + v;
        },
        smem);
  });
}

#define XB_TMO      128
#define XB_XCNT(j)  (256  + 64 * (j))
#define XB_XSUB(j)  (1280 + 64 * (j))
#define XB_XGEN(j)  (2304 + 64 * (j))
#define XB_TOP      3328
#define XB_TOPGEN   3392
#define XCD_BAR_WORDS 3456
#define XB_SPIN_CAP (1u << 20)
#define LAS __attribute__((address_space(3)))
__device__ __forceinline__ unsigned xb_ld(unsigned* p)              { return __hip_atomic_load(p, __ATOMIC_RELAXED, __HIP_MEMORY_SCOPE_AGENT); }
__device__ __forceinline__ unsigned xb_add(unsigned* p, unsigned v) { return __hip_atomic_fetch_add(p, v, __ATOMIC_RELAXED, __HIP_MEMORY_SCOPE_AGENT); }
__device__ __forceinline__ unsigned xb_xcc_id() { return (unsigned)__builtin_amdgcn_s_getreg((3 << 11) | 20) & 0xFu; }
#define XB_SPIN(cond, bar) do { unsigned _sp = 0; while (cond) { __builtin_amdgcn_s_sleep(1); \
    if ((++_sp & 255u) == 0u) { if (xb_ld(&(bar)[XB_TMO])) break; if (_sp > XB_SPIN_CAP) { atomicAdd(&(bar)[XB_TMO], 1u); break; } } } } while (0)
struct XcdBarrier { unsigned* bar; unsigned x; volatile LAS unsigned* st; };
__device__ __forceinline__ XcdBarrier xcd_barrier_post(unsigned* bar, volatile LAS unsigned* st) {
  XcdBarrier b; b.bar = bar; b.x = xb_xcc_id(); b.st = st;
  if (threadIdx.x == 0) (void)xb_add(&bar[XB_XCNT(b.x)], 1u);
  return b;
}
__device__ __forceinline__ void xcd_barrier_complete(unsigned* bar, unsigned x, unsigned& nloc, unsigned& nx) {
  const unsigned G = gridDim.x * gridDim.y * gridDim.z;
  unsigned sum, cnt, mine, sp = 0u;
  for (;;) {
    sum = 0u; cnt = 0u; mine = 0u;
#pragma unroll
    for (unsigned j = 0; j < 16; ++j) { const unsigned c = xb_ld(&bar[XB_XCNT(j)]); sum += c; cnt += (c > 0u) ? 1u : 0u; mine = (j == x) ? c : mine; }
    if (sum == G) break;
    __builtin_amdgcn_s_sleep(1);
    if ((++sp & 255u) == 0u) { if (xb_ld(&bar[XB_TMO])) break; if (sp > XB_SPIN_CAP) { atomicAdd(&bar[XB_TMO], 1u); break; } }
  }
  nloc = mine > 0u ? mine : 1u; nx = cnt > 0u ? cnt : 1u;
}
__device__ __forceinline__ void xcd_barrier(const XcdBarrier& b) {
  asm volatile("s_waitcnt vmcnt(0)" ::: "memory");
  __syncthreads();
  if (threadIdx.x == 0) {
    unsigned* bar = b.bar;
    __builtin_amdgcn_s_waitcnt(0);
    unsigned nloc = b.st[0], nx = b.st[1];
    if (nloc == 0u) { xcd_barrier_complete(bar, b.x, nloc, nx); b.st[0] = nloc; b.st[1] = nx; }
    const unsigned old = xb_add(&bar[XB_XSUB(b.x)], 1u);
    const unsigned gen = old / nloc;
    if (old + 1u == (gen + 1u) * nloc) {
      __builtin_amdgcn_fence(__ATOMIC_RELEASE, "agent");
      asm volatile("s_waitcnt vmcnt(0)" ::: "memory");
      const unsigned og = xb_add(&bar[XB_TOP], 1u);
      const unsigned tg = og / nx;
      if (og + 1u == (tg + 1u) * nx) xb_add(&bar[XB_TOPGEN], 1u);
      else XB_SPIN(xb_ld(&bar[XB_TOPGEN]) == tg, bar);
      __builtin_amdgcn_fence(__ATOMIC_ACQUIRE, "agent");
      xb_add(&bar[XB_XGEN(b.x)], 1u);
      asm volatile("s_waitcnt vmcnt(0)" ::: "memory");
    } else {
      XB_SPIN(xb_ld(&bar[XB_XGEN(b.x)]) == gen, bar);
      __builtin_amdgcn_fence(__ATOMIC_ACQUIRE, "agent");
      asm volatile("s_waitcnt vmcnt(0)" ::: "memory");
    }
  }
  __syncthreads();
}

#define NQ_WORDS 4096
__global__ void __launch_bounds__(256, 2) fwd_megakernel(Params p_unused) {
  cg::grid_group grid = cg::this_grid();
  __shared__ __attribute__((aligned(16))) char smem[SMEM_BYTES];
  volatile LAS unsigned* st = (volatile LAS unsigned*)(smem + SMEM_BYTES - 32);
  if (threadIdx.x == 0) { st[0] = 0u; st[1] = 0u; }
  __syncthreads();
  if (gridDim.y == 4242u) grid.sync();
  XcdBarrier xb;
  {
    const KP p = get_params();
    xb = xcd_barrier_post((unsigned*)p.counters() + NQ_WORDS, st);
    ln_rows(p, -1, false);
    prep_weights(p, 0, smem);
  }
  xcd_barrier(xb);
  const int xcc = (int)(xb.x & 7u);
#ifndef REP1
#define REP1 1
#define REP2 1
#define REP3 1
#define REP4 1
#endif
#ifndef REP5
#define REP5 1
#define REP6 1
#define REP7 0
#endif
#pragma unroll 1
  for (int l = 0; l < DEPTH; ++l) {
#define QPTR(ph, rep) (p.counters() + ((l * 6 + (ph)) * 4 + (rep)) * 32)
    for (int rep = 0; rep < REP1; ++rep) { const KP p = get_params(); phase_inproj(p, l, smem, QPTR(0, rep), xcc); }
    xcd_barrier(xb);
    for (int rep = 0; rep < REP2; ++rep) { const KP p = get_params(); phase2(p, l, smem, QPTR(1, rep), xcc); }
    xcd_barrier(xb);
    for (int rep = 0; rep < REP3; ++rep) { const KP p = get_params(); phase_nsa(p, smem, QPTR(2, rep), xcc); }
    xcd_barrier(xb);
    for (int rep = 0; rep < REP4; ++rep) { const KP p = get_params(); phase_merge(p, smem, QPTR(3, rep), xcc); }
    xcd_barrier(xb);
    for (int rep = 0; rep < REP5; ++rep) { const KP p = get_params(); phase_outproj(p, smem, QPTR(4, rep), xcc); }
    xcd_barrier(xb);
    for (int rep = 0; rep < REP6; ++rep) {
      const KP p = get_params();
      if (l + 1 < DEPTH) {
        ln_rows(p, l, false);
        prep_weights(p, l + 1, smem);
      } else {
        ln_rows(p, l, true);
      }
    }
    if (l + 1 < DEPTH) xcd_barrier(xb);
    for (int rep = 0; rep < REP7; ++rep) xcd_barrier(xb);
  }
}

extern "C" void kernel_launch(void* const* d_in, const int* in_sizes, int n_in, void* d_out, int out_size,
                              void* d_ws, size_t ws_size, hipStream_t stream) {
  static int grid_blocks = 0;
  if (!grid_blocks) {
    int dev = 0, cus = 0, per_cu = 0;
    (void)hipGetDevice(&dev);
    (void)hipDeviceGetAttribute(&cus, hipDeviceAttributeMultiprocessorCount, dev);
    (void)hipOccupancyMaxActiveBlocksPerMultiprocessor(&per_cu, fwd_megakernel, 256, 0);
    if (per_cu > 2) per_cu = 2;
    if (per_cu < 1) per_cu = 1;
    grid_blocks = cus * per_cu;
  }
  Params p{};
  p.x = (const float*)d_in[0]; p.w_in = (const float*)d_in[1]; p.b_in = (const float*)d_in[2];
  p.pool_w = (const float*)d_in[3]; p.pool_b = (const float*)d_in[4]; p.pool_scale = (const float*)d_in[5];
  p.pos_k = (const float*)d_in[6]; p.pos_v = (const float*)d_in[7]; p.w1k = (const float*)d_in[8];
  p.w2k = (const float*)d_in[9]; p.w1v = (const float*)d_in[10]; p.w2v = (const float*)d_in[11];
  p.wpa = (const float*)d_in[12]; p.wpb = (const float*)d_in[13]; p.wpc = (const float*)d_in[14];
  p.wo = (const float*)d_in[15]; p.ln_g = (const float*)d_in[16]; p.ln_b = (const float*)d_in[17];
  p.out = (float*)d_out;
  p.ws = (char*)d_ws;
  if (WS_TOTAL > ws_size) { fprintf(stderr, "workspace too small: need %zu have %zu\n", (size_t)WS_TOTAL, ws_size); return; }
  (void)hipMemsetAsync((char*)d_ws + OFF_counters, 0, (size_t)(NQ_WORDS + XCD_BAR_WORDS) * 4, stream);
  void* args[] = {&p};
  hipError_t e = hipLaunchCooperativeKernel((void*)fwd_megakernel, dim3(grid_blocks), dim3(256), args, 0, stream);
  if (e != hipSuccess) fprintf(stderr, "cooperative launch failed: %s (grid %d)\n", hipGetErrorString(e), grid_blocks);
}
```

```cpp
#include <hip/hip_runtime.h>
#include <hip/hip_cooperative_groups.h>
#include <cstdio>
#include <cstdint>
namespace cg = cooperative_groups;

typedef _Float16 half_t;
typedef _Float16 h8 __attribute__((ext_vector_type(8)));
typedef _Float16 h4 __attribute__((ext_vector_type(4)));
typedef float f32x4 __attribute__((ext_vector_type(4)));
typedef float f32x16 __attribute__((ext_vector_type(16)));

#define SEQ 8192
#define DM 1024
#define NTOK 16384
#define DEPTH 4
#define NIN 7360
#define NU 7424
#define ALPHA_F 1.681792830507429f
#define NEGF (-1e30f)

#define C_AX 0
#define C_AZ 512
#define C_BQ 1024
#define C_BZ 1536
#define C_CQ 2048
#define C_CZ 2560
#define C_GM 3072
#define C_IQ 6144
#define C_CKC 6400
#define C_CVC 6528
#define C_CKS 6656
#define C_CVS 6784
#define C_CKW 6912
#define C_CVW 7040
#define C_BK 7168
#define C_BV 7232
#define C_IK 7296
#define C_IW 7328
#define C_CG 7336

#define SMEM_BYTES 73728

constexpr size_t OFF_xr = 0;
constexpr size_t OFF_xh = OFF_xr + (((size_t)NTOK*DM*4 + 255) & ~(size_t)255);
constexpr size_t OFF_u = OFF_xh + (((size_t)NTOK*DM*2 + 255) & ~(size_t)255);
constexpr size_t OFF_winT = OFF_u + (((size_t)NTOK*NU*2 + 255) & ~(size_t)255);
constexpr size_t OFF_wpT = OFF_winT + (((size_t)NU*DM*2 + 255) & ~(size_t)255);
constexpr size_t OFF_woT = OFF_wpT + (((size_t)3*DM*512*2 + 255) & ~(size_t)255);
constexpr size_t OFF_poolT = OFF_woT + (((size_t)DM*DM*2 + 255) & ~(size_t)255);
constexpr size_t OFF_w1T = OFF_poolT + (((size_t)4*128*128*2 + 255) & ~(size_t)255);
constexpr size_t OFF_posb = OFF_w1T + (((size_t)2*64*2048*2 + 255) & ~(size_t)255);
constexpr size_t OFF_vsT = OFF_posb + (((size_t)512 + 255) & ~(size_t)255);
constexpr size_t OFF_vwT = OFF_vsT + (((size_t)4*64*SEQ*2 + 255) & ~(size_t)255);
constexpr size_t OFF_kcmp = OFF_vwT + (((size_t)4*64*SEQ*2 + 255) & ~(size_t)255);
constexpr size_t OFF_vcmpT = OFF_kcmp + (((size_t)4*512*64*2 + 255) & ~(size_t)255);
constexpr size_t OFF_ya = OFF_vcmpT + (((size_t)4*64*512*2 + 255) & ~(size_t)255);
constexpr size_t OFF_yb = OFF_ya + (((size_t)NTOK*512*2 + 255) & ~(size_t)255);
constexpr size_t OFF_yc = OFF_yb + (((size_t)NTOK*512*2 + 255) & ~(size_t)255);
constexpr size_t OFF_mm = OFF_yc + (((size_t)NTOK*512*2 + 255) & ~(size_t)255);
constexpr size_t OFF_counters = OFF_mm + (((size_t)NTOK*DM*2 + 255) & ~(size_t)255);
constexpr size_t WS_TOTAL = OFF_counters + (((size_t)32768 + 255) & ~(size_t)255);
struct Params {
  const float* x; const float* w_in; const float* b_in; const float* pool_w; const float* pool_b;
  const float* pool_scale; const float* pos_k; const float* pos_v; const float* w1k; const float* w2k;
  const float* w1v; const float* w2v; const float* wpa; const float* wpb; const float* wpc;
  const float* wo; const float* ln_g; const float* ln_b;
  float* out;
  char* ws;
};
typedef const __attribute__((address_space(4))) unsigned long long* kargp_t;
struct KP {
  kargp_t kp;
  __device__ __forceinline__ const float* x() const { return (const float*)(const __attribute__((address_space(1))) float*)kp[0]; }
  __device__ __forceinline__ const float* w_in() const { return (const float*)(const __attribute__((address_space(1))) float*)kp[1]; }
  __device__ __forceinline__ const float* b_in() const { return (const float*)(const __attribute__((address_space(1))) float*)kp[2]; }
  __device__ __forceinline__ const float* pool_w() const { return (const float*)(const __attribute__((address_space(1))) float*)kp[3]; }
  __device__ __forceinline__ const float* pool_b() const { return (const float*)(const __attribute__((address_space(1))) float*)kp[4]; }
  __device__ __forceinline__ const float* pool_scale() const { return (const float*)(const __attribute__((address_space(1))) float*)kp[5]; }
  __device__ __forceinline__ const float* pos_k() const { return (const float*)(const __attribute__((address_space(1))) float*)kp[6]; }
  __device__ __forceinline__ const float* pos_v() const { return (const float*)(const __attribute__((address_space(1))) float*)kp[7]; }
  __device__ __forceinline__ const float* w1k() const { return (const float*)(const __attribute__((address_space(1))) float*)kp[8]; }
  __device__ __forceinline__ const float* w2k() const { return (const float*)(const __attribute__((address_space(1))) float*)kp[9]; }
  __device__ __forceinline__ const float* w1v() const { return (const float*)(const __attribute__((address_space(1))) float*)kp[10]; }
  __device__ __forceinline__ const float* w2v() const { return (const float*)(const __attribute__((address_space(1))) float*)kp[11]; }
  __device__ __forceinline__ const float* wpa() const { return (const float*)(const __attribute__((address_space(1))) float*)kp[12]; }
  __device__ __forceinline__ const float* wpb() const { return (const float*)(const __attribute__((address_space(1))) float*)kp[13]; }
  __device__ __forceinline__ const float* wpc() const { return (const float*)(const __attribute__((address_space(1))) float*)kp[14]; }
  __device__ __forceinline__ const float* wo() const { return (const float*)(const __attribute__((address_space(1))) float*)kp[15]; }
  __device__ __forceinline__ const float* ln_g() const { return (const float*)(const __attribute__((address_space(1))) float*)kp[16]; }
  __device__ __forceinline__ const float* ln_b() const { return (const float*)(const __attribute__((address_space(1))) float*)kp[17]; }
  __device__ __forceinline__ float* out() const { return (float*)(__attribute__((address_space(1))) float*)kp[18]; }
  __device__ __forceinline__ char* ws() const { return (char*)(__attribute__((address_space(1))) char*)kp[19]; }
  __device__ __forceinline__ float* xr() const { return (float*)(ws() + OFF_xr); }
  __device__ __forceinline__ half_t* xh() const { return (half_t*)(ws() + OFF_xh); }
  __device__ __forceinline__ half_t* u() const { return (half_t*)(ws() + OFF_u); }
  __device__ __forceinline__ half_t* winT() const { return (half_t*)(ws() + OFF_winT); }
  __device__ __forceinline__ half_t* wpT() const { return (half_t*)(ws() + OFF_wpT); }
  __device__ __forceinline__ half_t* woT() const { return (half_t*)(ws() + OFF_woT); }
  __device__ __forceinline__ half_t* poolT() const { return (half_t*)(ws() + OFF_poolT); }
  __device__ __forceinline__ half_t* w1T() const { return (half_t*)(ws() + OFF_w1T); }
  __device__ __forceinline__ float* posb() const { return (float*)(ws() + OFF_posb); }
  __device__ __forceinline__ half_t* vsT() const { return (half_t*)(ws() + OFF_vsT); }
  __device__ __forceinline__ half_t* vwT() const { return (half_t*)(ws() + OFF_vwT); }
  __device__ __forceinline__ half_t* kcmp() const { return (half_t*)(ws() + OFF_kcmp); }
  __device__ __forceinline__ half_t* vcmpT() const { return (half_t*)(ws() + OFF_vcmpT); }
  __device__ __forceinline__ half_t* ya() const { return (half_t*)(ws() + OFF_ya); }
  __device__ __forceinline__ half_t* yb() const { return (half_t*)(ws() + OFF_yb); }
  __device__ __forceinline__ half_t* yc() const { return (half_t*)(ws() + OFF_yc); }
  __device__ __forceinline__ half_t* mm() const { return (half_t*)(ws() + OFF_mm); }
  __device__ __forceinline__ int* counters() const { return (int*)(ws() + OFF_counters); }
};
__device__ __forceinline__ KP get_params() {
  KP q;
  q.kp = (kargp_t)__builtin_amdgcn_kernarg_segment_ptr();
  asm volatile("" : "+s"(q.kp));
  return q;
}


__device__ __forceinline__ int orig_col(int n) {
  if (n < 1536) return n;
  if (n < 2048) return 1664 + (n - 1536);
  if (n < 2560) return 2472 + (n - 2048);
  if (n < 3072) return 3776 + (n - 2560);
  if (n < 6144) return 4288 + (n - 3072);
  if (n < 6400) return 2176 + (n - 6144);
  if (n < 7168) return 2984 + (n - 6400);
  if (n < 7296) return 1536 + (n - 7168);
  if (n < 7328) return 2432 + (n - 7296);
  if (n < 7336) return 2464 + (n - 7328);
  if (n < 7360) return 3752 + (n - 7336);
  return -1;
}

__device__ __forceinline__ float wave_sum(float v) {
#pragma unroll
  for (int o = 32; o > 0; o >>= 1) v += __shfl_xor(v, o);
  return v;
}
__device__ __forceinline__ float sigmoidf_(float x) { return 1.f / (1.f + __expf(-x)); }
__device__ __forceinline__ float siluf_(float x) { return x / (1.f + __expf(-x)); }

template <int NI, class LA, class LB, class EP>
__device__ __forceinline__ void gemm_tile(int K, LA loadA, LB loadB, EP epi, char* smem) {
  constexpr int BN = NI * 64;
  constexpr int NB = BN / 32;
  half_t* sA = (half_t*)smem;
  half_t* sB = sA + 128 * 72;
  int tid = threadIdx.x;
  asm volatile("" : "+v"(tid));
  const int lane = tid & 63, wid = tid >> 6;
  const int wm = wid >> 1, wn = wid & 1;
  f32x16 acc[2][NI];
#pragma unroll
  for (int i = 0; i < 2; ++i)
#pragma unroll
    for (int j = 0; j < NI; ++j)
#pragma unroll
      for (int r = 0; r < 16; ++r) acc[i][j][r] = 0.f;
  const int lr = tid >> 3, lc = (tid & 7) * 8;
  uint4 ra[4], rb[NB];
#pragma unroll
  for (int i = 0; i < 4; ++i) ra[i] = loadA(lr + 32 * i, lc);
#pragma unroll
  for (int i = 0; i < NB; ++i) rb[i] = loadB(lr + 32 * i, lc);
  const int nk = K >> 6;
  for (int kt = 0; kt < nk; ++kt) {
    __syncthreads();
#pragma unroll
    for (int i = 0; i < 4; ++i) *(uint4*)&sA[(lr + 32 * i) * 72 + lc] = ra[i];
#pragma unroll
    for (int i = 0; i < NB; ++i) *(uint4*)&sB[(lr + 32 * i) * 72 + lc] = rb[i];
    __syncthreads();
    if (kt + 1 < nk) {
      const int kk = (kt + 1) * 64 + lc;
#pragma unroll
      for (int i = 0; i < 4; ++i) ra[i] = loadA(lr + 32 * i, kk);
#pragma unroll
      for (int i = 0; i < NB; ++i) rb[i] = loadB(lr + 32 * i, kk);
    }
#pragma unroll
    for (int s = 0; s < 4; ++s) {
      h8 af[2], bf[NI];
#pragma unroll
      for (int mi = 0; mi < 2; ++mi)
        af[mi] = *(const h8*)&sA[(wm * 64 + mi * 32 + (lane & 31)) * 72 + s * 16 + (lane >> 5) * 8];
#pragma unroll
      for (int ni = 0; ni < NI; ++ni)
        bf[ni] = *(const h8*)&sB[(wn * (NI * 32) + ni * 32 + (lane & 31)) * 72 + s * 16 + (lane >> 5) * 8];
#pragma unroll
      for (int mi = 0; mi < 2; ++mi)
#pragma unroll
        for (int ni = 0; ni < NI; ++ni)
          acc[mi][ni] = __builtin_amdgcn_mfma_f32_32x32x16_f16(af[mi], bf[ni], acc[mi][ni], 0, 0, 0);
    }
  }
#pragma unroll
  for (int mi = 0; mi < 2; ++mi)
#pragma unroll
    for (int ni = 0; ni < NI; ++ni)
#pragma unroll
      for (int r = 0; r < 16; ++r) {
        const int row = wm * 64 + mi * 32 + (r & 3) + 8 * (r >> 2) + 4 * (lane >> 5);
        const int col = wn * (NI * 32) + ni * 32 + (lane & 31);
        epi(mi, ni, r, row, col, acc[mi][ni][r]);
      }
}

template <class LA, class LB, class EP>
__device__ __forceinline__ void gemm_tile_big(int K, LA loadA, LB loadB, EP epi, char* smem) {
  half_t* sA = (half_t*)smem;
  half_t* sB = sA + 256 * 72;
  int tid = threadIdx.x;
  asm volatile("" : "+v"(tid));
  const int lane = tid & 63, wid = tid >> 6;
  const int wm = wid >> 1, wn = wid & 1;
  f32x16 acc[4][2];
#pragma unroll
  for (int i = 0; i < 4; ++i)
#pragma unroll
    for (int j = 0; j < 2; ++j)
#pragma unroll
      for (int r = 0; r < 16; ++r) acc[i][j][r] = 0.f;
  const int lr = tid >> 3, lc = (tid & 7) * 8;
  uint4 ra[8], rb[4];
#pragma unroll
  for (int i = 0; i < 8; ++i) ra[i] = loadA(lr + 32 * i, lc);
#pragma unroll
  for (int i = 0; i < 4; ++i) rb[i] = loadB(lr + 32 * i, lc);
  const int nk = K >> 6;
  for (int kt = 0; kt < nk; ++kt) {
    __syncthreads();
#pragma unroll
    for (int i = 0; i < 8; ++i) *(uint4*)&sA[(lr + 32 * i) * 72 + lc] = ra[i];
#pragma unroll
    for (int i = 0; i < 4; ++i) *(uint4*)&sB[(lr + 32 * i) * 72 + lc] = rb[i];
    __syncthreads();
    if (kt + 1 < nk) {
      const int kk = (kt + 1) * 64 + lc;
#pragma unroll
      for (int i = 0; i < 8; ++i) ra[i] = loadA(lr + 32 * i, kk);
#pragma unroll
      for (int i = 0; i < 4; ++i) rb[i] = loadB(lr + 32 * i, kk);
    }
#pragma unroll
    for (int s = 0; s < 4; ++s) {
      h8 af[4], bf[2];
#pragma unroll
      for (int mi = 0; mi < 4; ++mi)
        af[mi] = *(const h8*)&sA[(wm * 128 + mi * 32 + (lane & 31)) * 72 + s * 16 + (lane >> 5) * 8];
#pragma unroll
      for (int ni = 0; ni < 2; ++ni)
        bf[ni] = *(const h8*)&sB[(wn * 64 + ni * 32 + (lane & 31)) * 72 + s * 16 + (lane >> 5) * 8];
#pragma unroll
      for (int mi = 0; mi < 4; ++mi)
#pragma unroll
        for (int ni = 0; ni < 2; ++ni)
          acc[mi][ni] = __builtin_amdgcn_mfma_f32_32x32x16_f16(af[mi], bf[ni], acc[mi][ni], 0, 0, 0);
    }
  }
#pragma unroll
  for (int mi = 0; mi < 4; ++mi)
#pragma unroll
    for (int ni = 0; ni < 2; ++ni)
#pragma unroll
      for (int r = 0; r < 16; ++r) {
        const int row = wm * 128 + mi * 32 + (r & 3) + 8 * (r >> 2) + 4 * (lane >> 5);
        const int col = wn * 64 + ni * 32 + (lane & 31);
        epi(mi, ni, r, row, col, acc[mi][ni][r]);
      }
}

template <class CM>
__device__ __forceinline__ void tconv_tile(const float* __restrict__ src, int lds_, half_t* __restrict__ dst, int ldd,
                                           int n0, int k0, CM cmap, char* smem) {
  float* t = (float*)smem;
  int tid = threadIdx.x;
  asm volatile("" : "+v"(tid));
  {
    const int n = tid & 63;
    const int c = cmap(n0 + n);
    float tv[16];
#pragma unroll
    for (int i = 0; i < 16; ++i) {
      const int k = (tid >> 6) + 4 * i;
      tv[i] = (c >= 0) ? src[(size_t)(k0 + k) * lds_ + c] : 0.f;
    }
#pragma unroll
    for (int i = 0; i < 16; ++i) {
      const int k = (tid >> 6) + 4 * i;
      t[k * 65 + n] = tv[i];
    }
  }
  __syncthreads();
#pragma unroll
  for (int i = 0; i < 2; ++i) {
    const int idx = tid + 256 * i;
    const int n = idx >> 3, kc = (idx & 7) * 8;
    h8 v;
#pragma unroll
    for (int j = 0; j < 8; ++j) v[j] = (half_t)t[(kc + j) * 65 + n];
    *(h8*)&dst[(size_t)(n0 + n) * ldd + k0 + kc] = v;
  }
  __syncthreads();
}

__device__ __forceinline__ void ln_rows(const KP& p, int lprev, bool final_) {
  int tid = threadIdx.x;
  asm volatile("" : "+v"(tid));
  const int lane = tid & 63, wid = tid >> 6;
  const int gw = blockIdx.x * 4 + wid, nw = gridDim.x * 4;
  for (int row = gw; row < NTOK; row += nw) {
    const float4* rp = (const float4*)((lprev < 0 ? p.x() : (const float*)p.u()) + (size_t)row * DM);
    float4 v[4];
    float s = 0.f;
#pragma unroll
    for (int i = 0; i < 4; ++i) {
      v[i] = rp[lane + 64 * i];
      s += v[i].x + v[i].y + v[i].z + v[i].w;
    }
    if (lprev >= 0) {
      float mu = wave_sum(s) * (1.f / DM);
      float q = 0.f;
#pragma unroll
      for (int i = 0; i < 4; ++i) {
        float a = v[i].x - mu, b = v[i].y - mu, c = v[i].z - mu, d = v[i].w - mu;
        q += a * a + b * b + c * c + d * d;
      }
      float rstd = rsqrtf(wave_sum(q) * (1.f / DM) + 1e-5f);
      const float4* g4 = (const float4*)(p.ln_g() + lprev * DM);
      const float4* b4 = (const float4*)(p.ln_b() + lprev * DM);
#pragma unroll
      for (int i = 0; i < 4; ++i) {
        float4 g = g4[lane + 64 * i], bb = b4[lane + 64 * i];
        v[i].x = (v[i].x - mu) * rstd * g.x + bb.x;
        v[i].y = (v[i].y - mu) * rstd * g.y + bb.y;
        v[i].z = (v[i].z - mu) * rstd * g.z + bb.z;
        v[i].w = (v[i].w - mu) * rstd * g.w + bb.w;
      }
    }
    if (final_) {
      float4* op = (float4*)(p.out() + (size_t)row * DM);
#pragma unroll
      for (int i = 0; i < 4; ++i) op[lane + 64 * i] = v[i];
    } else {
      float4* op = (float4*)(p.xr() + (size_t)row * DM);
      h4* hp = (h4*)(p.xh() + (size_t)row * DM);
#pragma unroll
      for (int i = 0; i < 4; ++i) {
        op[lane + 64 * i] = v[i];
        h4 hv;
        hv[0] = (half_t)v[i].x; hv[1] = (half_t)v[i].y; hv[2] = (half_t)v[i].z; hv[3] = (half_t)v[i].w;
        hp[lane + 64 * i] = hv;
      }
    }
  }
}

__device__ __forceinline__ void prep_weights(const KP& p, int l, char* smem) {
  int tid = threadIdx.x;
  asm volatile("" : "+v"(tid));
  const int total = 1856 + 384 + 256 + 16 + 64 + 2;
  for (int it = blockIdx.x; it < total; it += gridDim.x) {
    if (it < 1856) {
      const int nt = it >> 4, kt = it & 15;
      tconv_tile(p.w_in() + (size_t)l * DM * NIN, NIN, p.winT(), DM, nt * 64, kt * 64,
                 [](int n) { return orig_col(n); }, smem);
    } else if (it < 1856 + 384) {
      const int j = it - 1856;
      const int w = j >> 7, r = j & 127, nt = r >> 3, kt = r & 7;
      const float* src = (w == 0 ? p.wpa() : (w == 1 ? p.wpb() : p.wpc())) + (size_t)l * 512 * DM;
      tconv_tile(src, DM, p.wpT() + (size_t)w * DM * 512, 512, nt * 64, kt * 64, [](int n) { return n; }, smem);
    } else if (it < 1856 + 384 + 256) {
      const int j = it - 1856 - 384;
      const int nt = j >> 4, kt = j & 15;
      tconv_tile(p.wo() + (size_t)l * DM * DM, DM, p.woT(), DM, nt * 64, kt * 64, [](int n) { return n; }, smem);
    } else if (it < 1856 + 384 + 256 + 16) {
      const int j = it - 1856 - 384 - 256;
      const int g = j >> 2, nt = (j >> 1) & 1, kt = j & 1;
      tconv_tile(p.pool_w() + ((size_t)l * 4 + g) * 128 * 128, 128, p.poolT() + (size_t)g * 128 * 128, 128, nt * 64,
                 kt * 64, [](int n) { return n; }, smem);
    } else if (it < 1856 + 384 + 256 + 16 + 64) {
      const int j = it - 1856 - 384 - 256 - 16;
      const int kv = j >> 5, kt = j & 31;
      const float* src = (kv ? p.w1v() : p.w1k()) + (size_t)l * 2048 * 64;
      tconv_tile(src, 64, p.w1T() + (size_t)kv * 64 * 2048, 2048, 0, kt * 64, [](int n) { return n; }, smem);
    } else {
      const int kv = it - (1856 + 384 + 256 + 16 + 64);
      const float* w1 = (kv ? p.w1v() : p.w1k()) + (size_t)l * 2048 * 64;
      const float* pos = (kv ? p.pos_v() : p.pos_k()) + (size_t)l * 2048;
      float* red = (float*)smem;
      const int e = tid & 63, part = tid >> 6;
      float sa = 0.f, sb = 0.f, sc_ = 0.f, sd = 0.f;
      const float* wq = w1 + (size_t)part * 512 * 64 + e;
      const float* pq = pos + part * 512;
#pragma unroll 4
      for (int f = 0; f < 512; f += 4) {
        sa += pq[f] * wq[(size_t)f * 64];
        sb += pq[f + 1] * wq[(size_t)(f + 1) * 64];
        sc_ += pq[f + 2] * wq[(size_t)(f + 2) * 64];
        sd += pq[f + 3] * wq[(size_t)(f + 3) * 64];
      }
      const float s = (sa + sb) + (sc_ + sd);
      red[tid] = s;
      __syncthreads();
      if (tid < 64) p.posb()[kv * 64 + tid] = red[tid] + red[tid + 64] + red[tid + 128] + red[tid + 192];
      __syncthreads();
    }
  }
}

template <class F>
__device__ __forceinline__ void xcd_schedule(int* q, int xcc, int ngroups, int gsize, char* smem, F f) {
  int* s_item = (int*)(smem + SMEM_BYTES - 16);
  int* s_flag = (int*)(smem + SMEM_BYTES - 96);
  int* flags = q + 32;
#pragma unroll 1
  for (int dy = 0; dy < 8; ++dy) {
    const int y = (xcc + dy) & 7;
    if (dy == 1) {
      int t8 = threadIdx.x;
      asm volatile("" : "+v"(t8));
      if (t8 < 8) s_flag[t8] = __hip_atomic_load(&flags[t8], __ATOMIC_RELAXED, __HIP_MEMORY_SCOPE_AGENT);
      __syncthreads();
    }
    if (dy >= 1 && __builtin_amdgcn_readfirstlane(s_flag[y]) != 0) continue;
    for (;;) {
      if (threadIdx.x == 0) *s_item = atomicAdd(&q[y], 1);
      __syncthreads();
      const int i = __builtin_amdgcn_readfirstlane(*s_item);
      __syncthreads();
      const int grp = (i / gsize) * 8 + y;
      if (grp >= ngroups) {
        if (threadIdx.x == 0) __hip_atomic_store(&flags[y], 1, __ATOMIC_RELAXED, __HIP_MEMORY_SCOPE_AGENT);
        break;
      }
      f(grp, i % gsize);
    }
  }
}

__device__ __forceinline__ void phase_inproj(const KP& p, int l, char* smem, int* q, int xcc) {
  const float* bias = p.b_in() + (size_t)l * NIN;
  xcd_schedule(q, xcc, 128, 32, smem, [&](int grp, int within) __attribute__((always_inline)) {
    const int mt = (grp & 15) * 4 + (within & 3), nt = (grp >> 4) * 8 + (within >> 2);
    if (nt >= 58) return;
    const int m0 = mt * 256, n0 = nt * 128;
    const half_t* A = p.xh() + (size_t)m0 * DM;
    const half_t* B = p.winT() + (size_t)n0 * DM;
    int tidx = threadIdx.x;
    asm volatile("" : "+v"(tidx));
    const int lane = tidx & 63, wn = (tidx >> 6) & 1;
    float bv[2];
#pragma unroll
    for (int ni = 0; ni < 2; ++ni) {
      const int oc = orig_col(n0 + wn * 64 + ni * 32 + (lane & 31));
      bv[ni] = oc >= 0 ? bias[oc] : 0.f;
    }
    half_t* vT = (nt == 53) ? p.vsT() : ((nt == 55) ? p.vwT() : nullptr);
    gemm_tile_big(
        DM, [&](int r, int k) { return *(const uint4*)(A + (size_t)r * DM + k); },
        [&](int r, int k) { return *(const uint4*)(B + (size_t)r * DM + k); },
        [&](int mi, int ni, int r, int row, int col, float v) {
          const half_t hv = (half_t)(v + bv[ni]);
          const int tok = m0 + row;
          p.u()[(size_t)tok * NU + n0 + col] = hv;
          if (vT) {
            const int b = tok >> 13, t = tok & 8191;
            vT[((size_t)(b * 2 + (col >> 6)) * 64 + (col & 63)) * SEQ + t] = hv;
          }
        },
        smem);
  });
}

__device__ __forceinline__ void pool_item(const KP& p, int l, int item, char* smem) {
  const int g = item & 3, mt = item >> 2;
  const int m0 = mt * 128;
  const int wnd = 2 << g;
  const half_t* B = p.poolT() + (size_t)g * 128 * 128;
  int tidx = threadIdx.x;
  asm volatile("" : "+v"(tidx));
  const int lane = tidx & 63, wn = (tidx >> 6) & 1;
  float pb[2], ps[2];
#pragma unroll
  for (int ni = 0; ni < 2; ++ni) {
    const int d = wn * 64 + ni * 32 + (lane & 31);
    pb[ni] = p.pool_b()[(size_t)l * 512 + g * 128 + d];
    ps[ni] = p.pool_scale()[(size_t)l * 512 + g * 128 + d];
  }
  gemm_tile<2>(
      128,
      [&](int r, int k) {
        const int tok = m0 + r, t = tok & 8191;
        const int cnt = min(t + 1, wnd);
        const half_t* base = p.u() + (size_t)tok * NU + C_AX + g * 128 + k;
        float s[8];
#pragma unroll
        for (int j = 0; j < 8; ++j) s[j] = 0.f;
        h8 cur = *(const h8*)base;
        for (int q0 = 0; q0 < wnd; q0 += 8) {
          h8 v[8];
#pragma unroll
          for (int i = 0; i < 8; ++i) {
            const int qq = q0 + i;
            if (qq < cnt) v[i] = *(const h8*)(base - (size_t)qq * NU);
            else {
#pragma unroll
              for (int j = 0; j < 8; ++j) v[i][j] = (half_t)0.f;
            }
          }
#pragma unroll
          for (int i = 0; i < 8; ++i)
#pragma unroll
            for (int j = 0; j < 8; ++j) s[j] += (float)v[i][j];
        }
        const float inv = 1.f / (float)cnt;
        h8 o;
#pragma unroll
        for (int j = 0; j < 8; ++j) o[j] = (half_t)(s[j] * inv - (float)cur[j]);
        return *(uint4*)&o;
      },
      [&](int r, int k) { return *(const uint4*)(B + (size_t)r * 128 + k); },
      [&](int mi, int ni, int r, int row, int col, float v) {
        const int tok = m0 + row;
        const float z = (float)p.u()[(size_t)tok * NU + C_AZ + g * 128 + col];
        p.ya()[(size_t)tok * 512 + g * 128 + col] = (half_t)((v + pb[ni]) * ps[ni] * siluf_(z));
      },
      smem);
}

__device__ __forceinline__ void compress_item(const KP& p, int l, int item, char* smem) {
  const int mt = item & 3, kv = (item >> 2) & 1, g = (item >> 3) & 1, b = item >> 4;
  int tid = threadIdx.x;
  asm volatile("" : "+v"(tid));
  const int ccol = (kv ? C_CVC : C_CKC) + g * 64;
  const half_t* ub = p.u() + (size_t)b * SEQ * NU + ccol;
  const half_t* B = p.w1T() + (size_t)kv * 64 * 2048;
  float* hid = (float*)(smem + 28672);
  const float* posb = p.posb() + kv * 64;
  gemm_tile<1>(
      2048,
      [&](int r, int k) {
        const int n = mt * 128 + r;
        if (n >= 511) return make_uint4(0, 0, 0, 0);
        const int tok = 16 * n + (k >> 6);
        return *(const uint4*)(ub + (size_t)tok * NU + (k & 63));
      },
      [&](int r, int k) { return *(const uint4*)(B + (size_t)r * 2048 + k); },
      [&](int mi, int ni, int r, int row, int col, float v) { hid[row * 65 + col] = siluf_(v + posb[col]); }, smem);
  __syncthreads();
  float* w2s = (float*)smem;
  const float* w2 = (kv ? p.w2v() : p.w2k()) + (size_t)l * 4096;
  for (int i = tid; i < 4096; i += 256) w2s[i] = w2[i];
  __syncthreads();
  {
    const int n = tid >> 1, fh = (tid & 1) * 32;
    float acc[32];
#pragma unroll
    for (int f = 0; f < 32; ++f) acc[f] = 0.f;
    for (int e = 0; e < 64; ++e) {
      const float hv = hid[n * 65 + e];
#pragma unroll
      for (int f = 0; f < 32; ++f) acc[f] += hv * w2s[e * 64 + fh + f];
    }
    const int ng = mt * 128 + n;
    const bool valid = ng < 511;
    if (kv == 0) {
      half_t* dst = p.kcmp() + ((size_t)(b * 2 + g) * 512 + ng) * 64 + fh;
#pragma unroll
      for (int f = 0; f < 32; ++f) dst[f] = valid ? (half_t)acc[f] : (half_t)0.f;
    } else {
      half_t* dst = p.vcmpT() + ((size_t)(b * 2 + g) * 64 + fh) * 512 + ng;
#pragma unroll
      for (int f = 0; f < 32; ++f) dst[(size_t)f * 512] = valid ? (half_t)acc[f] : (half_t)0.f;
    }
  }
  __syncthreads();
}

#ifndef DSA_CAP
#define DSA_CAP 128
#endif
__device__ __forceinline__ void dsa_item(const KP& p, int b, int tile, char* smem) {
  const int t0 = tile * 16;
  int tid = threadIdx.x;
  asm volatile("" : "+v"(tid));
  const int lane = tid & 63, wid = tid >> 6;
  uint32_t* hist = (uint32_t*)smem;
  unsigned long long* cand = (unsigned long long*)(smem + 16384);
  unsigned short* sel = (unsigned short*)(smem + 32768);
  unsigned long long* pfx = (unsigned long long*)(smem + 40960);
  unsigned long long* tkey = pfx + 16;
  int* need = (int*)(tkey + 16);
  int* state = need + 16;
  int* cnt = state + 16;
  int* ccnt = cnt + 16;
  int* pf16 = ccnt + 16;
  int* ovf = pf16 + 16;
  int* nrem = ovf + 16;
  int* fastf = nrem + 8;
  uint32_t* h1w = (uint32_t*)(smem + 43008);
  float* pbuf = (float*)smem + wid * 2048;

  const half_t* ub = p.u() + (size_t)b * SEQ * NU;
  const int mytok = lane & 15, hq = lane >> 4;
  const int myt = t0 + mytok;
  if (tid < 16) {
    const int t = t0 + tid;
    pfx[tid] = 0ull; tkey[tid] = 0ull; need[tid] = 256; state[tid] = (t < 256) ? 0 : 1; cnt[tid] = 0; ccnt[tid] = 0;
    pf16[tid] = 0; ovf[tid] = 0;
  }
  if (tid < 8) nrem[tid] = 0;
  if (tid < 16) fastf[tid] = 0;
  for (int i = tid; i < 6144; i += 256) h1w[i] = 0u;
  h8 qf[8], qlh, qll;
  float iw[8];
  {
    const half_t* qrow = ub + (size_t)myt * NU;
#pragma unroll
    for (int h = 0; h < 8; ++h) qf[h] = *(const h8*)(qrow + C_IQ + h * 32 + hq * 8);
    const h8 w8 = *(const h8*)(qrow + C_IW);
#pragma unroll
    for (int h = 0; h < 8; ++h) iw[h] = (float)w8[h] * 0.03125f;
#pragma unroll
    for (int e = 0; e < 8; ++e) {
      float a = 0.f;
#pragma unroll
      for (int h = 0; h < 8; ++h) a += iw[h] * (float)qf[h][e];
      const half_t hi = (half_t)a;
      qlh[e] = hi;
      qll[e] = (half_t)(a - (float)hi);
    }
  }
  __syncthreads();
  const int nkt = (t0 + 16 + 31) >> 5;

  auto loadk = [&](int kt, h8* a) __attribute__((always_inline)) {
#pragma unroll
    for (int i = 0; i < 2; ++i)
      a[i] = *(const h8*)(ub + (size_t)(kt * 32 + i * 16 + (lane & 15)) * NU + C_IK + hq * 8);
  };
  auto scores = [&](const h8* a, float* sc) __attribute__((always_inline)) {
#pragma unroll
    for (int i = 0; i < 2; ++i) {
      f32x4 acc = {0.f, 0.f, 0.f, 0.f};
      acc = __builtin_amdgcn_mfma_f32_16x16x32_f16(a[i], qll, acc, 0, 0, 0);
      acc = __builtin_amdgcn_mfma_f32_16x16x32_f16(a[i], qlh, acc, 0, 0, 0);
#pragma unroll
      for (int h = 0; h < 8; ++h) {
        f32x4 d = {0.f, 0.f, 0.f, 0.f};
        d = __builtin_amdgcn_mfma_f32_16x16x32_f16(a[i], qf[h], d, 0, 0, 0);
#pragma unroll
        for (int r = 0; r < 4; ++r) acc[r] = __builtin_fmaf(__builtin_fabsf(d[r]), iw[h], acc[r]);
      }
#pragma unroll
      for (int r = 0; r < 4; ++r) sc[i * 4 + r] = acc[r];
    }
  };
  auto skey = [&](float s) __attribute__((always_inline)) -> uint32_t {
    s = s + 0.f;
    const uint32_t u_ = __float_as_uint(s);
    return (u_ & 0x80000000u) ? ~u_ : (u_ | 0x80000000u);
  };
  auto mkkey = [&](float s, int key) __attribute__((always_inline)) -> unsigned long long {
    s = s + 0.f;
    uint32_t u_ = __float_as_uint(s);
    u_ = (u_ & 0x80000000u) ? ~u_ : (u_ | 0x80000000u);
    return ((unsigned long long)u_ << 16) | (unsigned long long)(8191 - key);
  };
  auto scan_token = [&](int tk, int level) __attribute__((always_inline)) -> bool {
    const int shift = 40 - 8 * level;
    const uint32_t* hrow = hist + tk * 256;
    const uint4 hv = *(const uint4*)&hrow[252 - 4 * lane];
    const int c = (int)(hv.x + hv.y + hv.z + hv.w);
    int cum = c;
#pragma unroll
    for (int o = 1; o < 64; o <<= 1) {
      int v = __shfl_up(cum, o);
      if (lane >= o) cum += v;
    }
    const int nd = need[tk];
    const unsigned long long mask = __ballot(cum >= nd);
    const int L = mask ? (int)__builtin_ctzll(mask) : 63;
    int running = cum - c, bstar, cb;
    if (running + (int)hv.w >= nd) { bstar = 255 - 4 * lane; cb = hv.w; }
    else {
      running += hv.w;
      if (running + (int)hv.z >= nd) { bstar = 254 - 4 * lane; cb = hv.z; }
      else {
        running += hv.z;
        if (running + (int)hv.y >= nd) { bstar = 253 - 4 * lane; cb = hv.y; }
        else { running += hv.y; bstar = 252 - 4 * lane; cb = hv.x; }
      }
    }
    running = __shfl(running, L); bstar = __shfl(bstar, L); cb = __shfl(cb, L);
    const int nd2 = nd - running;
    const bool fin = (cb == nd2) || (level == 5);
    if (lane == 0) {
      const unsigned long long np = (pfx[tk] << 8) | (unsigned long long)bstar;
      if (fin) { state[tk] = 0; tkey[tk] = np << shift; }
      else { need[tk] = nd2; pfx[tk] = np; }
    }
    return fin;
  };
  auto run_level = [&](int level, bool fillx) __attribute__((always_inline)) {
    const int shift = 40 - 8 * level;
    for (int i = tid; i < 4096; i += 256) hist[i] = 0u;
    __syncthreads();
    {
      const unsigned long long mypfx = pfx[mytok];
      const bool act = state[mytok] == 1 && fastf[mytok] == 0;
      h8 na[2];
      if (wid < nkt) loadk(wid, na);
      for (int kt = wid; kt < nkt; kt += 4) {
        h8 ca[2];
#pragma unroll
        for (int i = 0; i < 2; ++i) ca[i] = na[i];
        loadk(kt + 4 < nkt ? kt + 4 : kt, na);
        float sc[8];
        scores(ca, sc);
        if (act) {
#pragma unroll
          for (int q = 0; q < 8; ++q) {
            const int key = kt * 32 + (q >> 2) * 16 + 4 * hq + (q & 3);
            if (key <= myt) {
              if (level < 2) {
                const uint32_t u32 = skey(sc[q]);
                if (level == 0) {
                  const uint32_t b8 = u32 >> 24;
                  atomicAdd(&hist[mytok * 256 + (int)b8], 1u);
                  if (fillx) {
                    const uint32_t ix = b8 - 0xBEu;
                    if (ix < 3u) {
                      const uint32_t e16 = (ix * 16u + (uint32_t)mytok) * 256u + ((u32 >> 16) & 255u);
                      atomicAdd(&h1w[e16 >> 1], (e16 & 1u) ? 65536u : 1u);
                    }
                  }
                } else if ((u32 >> 24) == (uint32_t)mypfx) atomicAdd(&hist[mytok * 256 + (int)((u32 >> 16) & 255u)], 1u);
              } else {
                const unsigned long long k48 = mkkey(sc[q], key);
                if ((k48 >> (shift + 8)) == mypfx)
                  atomicAdd(&hist[mytok * 256 + (int)((k48 >> shift) & 255ull)], 1u);
              }
            }
          }
        }
      }
    }
    __syncthreads();
    {
      int rem = 0;
      for (int j = 0; j < 4; ++j) {
        const int tk = wid * 4 + j;
        if (state[tk] != 1 || fastf[tk] != 0) continue;
        if (!scan_token(tk, level)) rem++;
      }
      if (lane == 0 && rem) atomicAdd(&nrem[level], rem);
    }
    __syncthreads();
  };

  run_level(0, true);
  if (tid < 16) {
    const int b0 = (int)pfx[tid];
    const int f = (state[tid] == 1 && b0 >= 0xBE && b0 <= 0xC0) ? 1 : 0;
    fastf[tid] = f;
    if (state[tid] == 1 && !f) atomicAdd(&nrem[7], 1);
  }
  __syncthreads();
  if (nrem[7] != 0) run_level(1, false);
  for (int j = 0; j < 4; ++j) {
    const int tk = wid * 4 + j;
    if (state[tk] != 1 || fastf[tk] == 0) continue;
    const uint32_t ix = (uint32_t)pfx[tk] - 0xBEu;
    const unsigned short* hx = (const unsigned short*)h1w + (ix * 16u + (uint32_t)tk) * 256u;
    const ushort4 c4 = *(const ushort4*)&hx[4 * lane];
    uint4 w4;
    w4.x = c4.x; w4.y = c4.y; w4.z = c4.z; w4.w = c4.w;
    *(uint4*)&hist[tk * 256 + 4 * lane] = w4;
    __builtin_amdgcn_wave_barrier();
    scan_token(tk, 1);
  }
  __syncthreads();
  if (tid < 16) fastf[tid] = 0;
  __syncthreads();

  {
    const int st0 = state[mytok];
    const unsigned long long mytk = tkey[mytok];
    const unsigned long long myp16 = pfx[mytok];
    h8 na[2];
    if (wid < nkt) loadk(wid, na);
    for (int kt = wid; kt < nkt; kt += 4) {
      h8 ca[2];
#pragma unroll
      for (int i = 0; i < 2; ++i) ca[i] = na[i];
      loadk(kt + 4 < nkt ? kt + 4 : kt, na);
      float sc[8];
      scores(ca, sc);
#pragma unroll
      for (int q = 0; q < 8; ++q) {
        const int key = kt * 32 + (q >> 2) * 16 + 4 * hq + (q & 3);
        if (key <= myt) {
          const uint32_t u32 = skey(sc[q]);
          bool take, isc = false;
          if (st0 == 0) take = (((unsigned long long)u32 << 16) | (unsigned long long)(8191 - key)) >= mytk;
          else {
            const uint32_t p16 = u32 >> 16;
            take = p16 > (uint32_t)myp16;
            isc = p16 == (uint32_t)myp16;
          }
          if (take) {
            const int pos = atomicAdd(&cnt[mytok], 1);
            if (pos < 256) sel[mytok * 256 + pos] = (unsigned short)key;
          } else if (isc) {
            const int pos = atomicAdd(&ccnt[mytok], 1);
            if (pos < DSA_CAP) cand[mytok * 128 + pos] = ((unsigned long long)u32 << 16) | (unsigned long long)(8191 - key);
          }
        }
      }
    }
  }
  __syncthreads();
  {
    int nov = 0;
    for (int j = 0; j < 4; ++j) {
      const int tk = wid * 4 + j;
      if (state[tk] != 1) continue;
      const int nc = ccnt[tk];
      if (nc > DSA_CAP) {
        nov++;
        if (lane == 0) { ovf[tk] = 1; pf16[tk] = (int)pfx[tk]; }
        continue;
      }
      const int nd = need[tk];
      const unsigned long long k0 = (lane < nc) ? cand[tk * 128 + lane] : 0ull;
      const unsigned long long k1 = (lane + 64 < nc) ? cand[tk * 128 + lane + 64] : 0ull;
      int r0 = 0, r1 = 0;
      for (int q = 0; q < nc; ++q) {
        const unsigned long long kq = cand[tk * 128 + q];
        r0 += (kq > k0) ? 1 : 0;
        r1 += (kq > k1) ? 1 : 0;
      }
      if (lane < nc && r0 < nd) {
        const int pos = atomicAdd(&cnt[tk], 1);
        if (pos < 256) sel[tk * 256 + pos] = (unsigned short)(8191 - (int)(k0 & 0xFFFFull));
      }
      if (lane + 64 < nc && r1 < nd) {
        const int pos = atomicAdd(&cnt[tk], 1);
        if (pos < 256) sel[tk * 256 + pos] = (unsigned short)(8191 - (int)(k1 & 0xFFFFull));
      }
      if (lane == 0) state[tk] = 2;
    }
    if (lane == 0 && nov) atomicAdd(&nrem[6], nov);
  }
  __syncthreads();
  if (nrem[6] != 0) {
    for (int level = 2; level < 6; ++level) {
      run_level(level, false);
      if (nrem[level] == 0) break;
    }
    {
      const bool mine = ovf[mytok] != 0;
      const unsigned long long mytk = tkey[mytok];
      const unsigned long long myp16 = (unsigned long long)(unsigned)pf16[mytok];
      h8 na[2];
      if (wid < nkt) loadk(wid, na);
      for (int kt = wid; kt < nkt; kt += 4) {
        h8 ca[2];
#pragma unroll
        for (int i = 0; i < 2; ++i) ca[i] = na[i];
        loadk(kt + 4 < nkt ? kt + 4 : kt, na);
        float sc[8];
        scores(ca, sc);
        if (mine) {
#pragma unroll
          for (int q = 0; q < 8; ++q) {
            const int key = kt * 32 + (q >> 2) * 16 + 4 * hq + (q & 3);
            if (key <= myt) {
              const unsigned long long k48 = mkkey(sc[q], key);
              if ((k48 >> 32) == myp16 && k48 >= mytk) {
                const int pos = atomicAdd(&cnt[mytok], 1);
                if (pos < 256) sel[mytok * 256 + pos] = (unsigned short)key;
              }
            }
          }
        }
      }
    }
    __syncthreads();
  }
#ifndef DSA_ATT_REP
#define DSA_ATT_REP 1
#endif
  for (int jr = 0; jr < 4 * DSA_ATT_REP; ++jr) {
    const int j = jr & 3;
    const int tk = wid * 4 + j;
    const int t = t0 + tk;
    const int nsel = min(cnt[tk], 256);
    const half_t* urow = ub + (size_t)t * NU;
    const int col = lane & 15;
    h8 q0, q1;
#pragma unroll
    for (int e = 0; e < 8; ++e) { q0[e] = (half_t)0.f; q1[e] = (half_t)0.f; }
    if (col < 8) {
      q0 = *(const h8*)(urow + C_BQ + col * 64 + hq * 8);
      q1 = *(const h8*)(urow + C_BQ + col * 64 + 32 + hq * 8);
    }
    float mx = NEGF;
#pragma unroll 1
    for (int mg = 0; mg < 2; ++mg) {
#pragma unroll
      for (int mm = 0; mm < 8; ++mm) {
        const int m = mg * 8 + mm;
        const int pos = m * 16 + col;
        const int s = (pos < nsel) ? (int)sel[tk * 256 + pos] : 0;
        const half_t* kp = ub + (size_t)s * NU + C_BK + hq * 8;
        const h8 a0 = *(const h8*)kp, a1 = *(const h8*)(kp + 32);
        f32x4 d = {0.f, 0.f, 0.f, 0.f};
        d = __builtin_amdgcn_mfma_f32_16x16x32_f16(a0, q0, d, 0, 0, 0);
        d = __builtin_amdgcn_mfma_f32_16x16x32_f16(a1, q1, d, 0, 0, 0);
#pragma unroll
        for (int r = 0; r < 4; ++r) {
          const int pp = m * 16 + hq * 4 + r;
          const float v = (pp < nsel) ? d[r] * 0.125f : NEGF;
          mx = fmaxf(mx, v);
          if (col < 8) pbuf[pp * 8 + col] = v;
        }
      }
    }
    mx = fmaxf(mx, __shfl_xor(mx, 16));
    mx = fmaxf(mx, __shfl_xor(mx, 32));
    const float mxh = __shfl(mx, lane & 7);
    __builtin_amdgcn_wave_barrier();
    float sum = 0.f;
#pragma unroll 4
    for (int k = 0; k < 32; ++k) {
      const int i = lane + 64 * k;
      const float v = pbuf[i];
      const float e = (v > -1e29f) ? __expf(v - mxh) : 0.f;
      pbuf[i] = e;
      sum += e;
    }
    sum += __shfl_xor(sum, 8);
    sum += __shfl_xor(sum, 16);
    sum += __shfl_xor(sum, 32);
    const float inv = 1.f / sum;
    __builtin_amdgcn_wave_barrier();
    {
      const int rs = lane >> 3, dc = lane & 7;
      float acc[8][8];
#pragma unroll
      for (int h = 0; h < 8; ++h)
#pragma unroll
        for (int e = 0; e < 8; ++e) acc[h][e] = 0.f;
#pragma unroll 1
      for (int g8 = 0; g8 < 4; ++g8) {
        h8 vv[8];
#pragma unroll
        for (int i = 0; i < 8; ++i) {
          const int pos = (g8 * 8 + i) * 8 + rs;
          const int s = (pos < nsel) ? (int)sel[tk * 256 + pos] : 0;
          vv[i] = *(const h8*)(ub + (size_t)s * NU + C_BV + dc * 8);
        }
#pragma unroll
        for (int i = 0; i < 8; ++i) {
          const int pos = (g8 * 8 + i) * 8 + rs;
          const f32x4 pa = *(const f32x4*)&pbuf[pos * 8];
          const f32x4 pb = *(const f32x4*)&pbuf[pos * 8 + 4];
          float vf[8];
#pragma unroll
          for (int e = 0; e < 8; ++e) vf[e] = (float)vv[i][e];
#pragma unroll
          for (int e = 0; e < 8; ++e) {
            acc[0][e] += pa[0] * vf[e]; acc[1][e] += pa[1] * vf[e]; acc[2][e] += pa[2] * vf[e]; acc[3][e] += pa[3] * vf[e];
            acc[4][e] += pb[0] * vf[e]; acc[5][e] += pb[1] * vf[e]; acc[6][e] += pb[2] * vf[e]; acc[7][e] += pb[3] * vf[e];
          }
        }
      }
      half_t* yrow = p.yb() + (size_t)(b * SEQ + t) * 512;
      float v32[4][8], v16[2][8], v8[8];
      const bool b2 = (rs & 4) != 0, b1 = (rs & 2) != 0, b0 = (rs & 1) != 0;
#pragma unroll
      for (int i = 0; i < 4; ++i)
#pragma unroll
        for (int e = 0; e < 8; ++e) {
          const float lo = acc[i][e], hi = acc[4 + i][e];
          v32[i][e] = (b2 ? hi : lo) + __shfl_xor(b2 ? lo : hi, 32);
        }
#pragma unroll
      for (int i = 0; i < 2; ++i)
#pragma unroll
        for (int e = 0; e < 8; ++e) {
          const float lo = v32[i][e], hi = v32[2 + i][e];
          v16[i][e] = (b1 ? hi : lo) + __shfl_xor(b1 ? lo : hi, 16);
        }
#pragma unroll
      for (int e = 0; e < 8; ++e) {
        const float lo = v16[0][e], hi = v16[1][e];
        v8[e] = (b0 ? hi : lo) + __shfl_xor(b0 ? lo : hi, 8);
      }
      {
        const float invh = __shfl(inv, rs);
        const h8 z8 = *(const h8*)(urow + C_BZ + rs * 64 + dc * 8);
        h8 ov;
#pragma unroll
        for (int e = 0; e < 8; ++e) ov[e] = (half_t)(v8[e] * invh * siluf_((float)z8[e]));
        *(h8*)(yrow + rs * 64 + dc * 8) = ov;
      }
    }
    __builtin_amdgcn_wave_barrier();
  }
  __syncthreads();
}

__device__ __forceinline__ void phase2(const KP& p, int l, char* smem, int* q, int xcc) {
  xcd_schedule(q, xcc, 196 * 8, 1, smem, [&](int grp, int) __attribute__((always_inline)) {
    const int y = grp & 7, k = grp >> 3;
    if (k < 4) compress_item(p, l, k * 8 + y, smem);
    else if (k < 132) dsa_item(p, y & 1, 511 - ((k - 4) * 4 + (y >> 1)), smem);
    else pool_item(p, l, (k - 132) * 8 + y, smem);
  });
}

struct DState {
  float m, l;
  f32x16 o[2];
};
#define MLOW (-1e4f)
__device__ __forceinline__ void ds_reset(DState& st) {
  st.m = MLOW; st.l = 0.f;
#pragma unroll
  for (int dt = 0; dt < 2; ++dt)
#pragma unroll
    for (int r = 0; r < 16; ++r) st.o[dt][r] = 0.f;
}
typedef unsigned int u32x4 __attribute__((ext_vector_type(4)));
typedef unsigned int u32x2 __attribute__((ext_vector_type(2)));
struct StageRegs {
  u32x4 k0, k1, v0, v1;
};
template <bool HASV>
__device__ __forceinline__ void load_stage(StageRegs& r, const half_t* __restrict__ Kb, int ldk,
                                           const half_t* __restrict__ VT, int ldv, int key0, int tid) {
  const int row = tid >> 3, c = tid & 7;
  r.k0 = *(const u32x4*)(Kb + (size_t)(key0 + row) * ldk + c * 8);
  r.k1 = *(const u32x4*)(Kb + (size_t)(key0 + row + 32) * ldk + c * 8);
  if (HASV) {
    r.v0 = *(const u32x4*)(VT + (size_t)row * ldv + key0 + c * 8);
    r.v1 = *(const u32x4*)(VT + (size_t)(row + 32) * ldv + key0 + c * 8);
  }
}
template <bool HASV>
__device__ __forceinline__ void write_stage(const StageRegs& r, half_t* Ks, half_t* Vs, int tid) {
  const int row = tid >> 3, c = tid & 7;
  *(u32x4*)&Ks[row * 72 + c * 8] = r.k0;
  *(u32x4*)&Ks[(row + 32) * 72 + c * 8] = r.k1;
  if (HASV) {
    const int ks = c >> 1, a = c & 1;
    u32x2 lo, hi;
    lo[0] = r.v0[0]; lo[1] = r.v0[1]; hi[0] = r.v0[2]; hi[1] = r.v0[3];
    *(u32x2*)&Vs[row * 72 + ks * 16 + a * 4] = lo;
    *(u32x2*)&Vs[row * 72 + ks * 16 + 8 + a * 4] = hi;
    lo[0] = r.v1[0]; lo[1] = r.v1[1]; hi[0] = r.v1[2]; hi[1] = r.v1[3];
    *(u32x2*)&Vs[(row + 32) * 72 + ks * 16 + a * 4] = lo;
    *(u32x2*)&Vs[(row + 32) * 72 + ks * 16 + 8 + a * 4] = hi;
  }
}
template <bool ONLINE, bool HASV, bool FAST, class VF>
__device__ __forceinline__ void dense_block(DState& st, const half_t* Ks, const half_t* Vs, const h8* qf, int key0,
                                            int flag, VF valid, float fixed_m, float fixed_invl, f32x16* pout,
                                            int lane) {
  const int h = lane >> 5, c = lane & 31;
  f32x16 s[2];
#pragma unroll
  for (int kt = 0; kt < 2; ++kt) {
#pragma unroll
    for (int r = 0; r < 16; ++r) s[kt][r] = 0.f;
#pragma unroll
    for (int ks = 0; ks < 4; ++ks) {
      const h8 a = *(const h8*)&Ks[(32 * kt + c) * 72 + 16 * ks + 8 * h];
      s[kt] = __builtin_amdgcn_mfma_f32_32x32x16_f16(a, qf[ks], s[kt], 0, 0, 0);
    }
  }
  float cm = NEGF;
#pragma unroll
  for (int kt = 0; kt < 2; ++kt)
#pragma unroll
    for (int r = 0; r < 16; ++r) {
      const int key = key0 + 32 * kt + (r & 3) + 8 * (r >> 2) + 4 * h;
      const float v = (FAST ? (flag != 0) : valid(key, flag)) ? s[kt][r] : NEGF;
      s[kt][r] = v;
      cm = fmaxf(cm, v);
    }
  float mnew;
  if (ONLINE) {
    cm = fmaxf(cm, __shfl_xor(cm, 32));
    mnew = st.m;
    if (__ballot(cm > st.m + 8.0f) != 0ull) {
      mnew = fmaxf(st.m, cm);
      const float alpha = __builtin_amdgcn_exp2f(st.m - mnew);
      st.m = mnew;
      st.l *= alpha;
      if (HASV) {
#pragma unroll
        for (int dt = 0; dt < 2; ++dt)
#pragma unroll
          for (int r = 0; r < 16; ++r) st.o[dt][r] *= alpha;
      }
    }
  } else {
    mnew = fixed_m;
  }
  float ps = 0.f;
#pragma unroll
  for (int kt = 0; kt < 2; ++kt)
#pragma unroll
    for (int r = 0; r < 16; ++r) {
      float e = __builtin_amdgcn_exp2f(s[kt][r] - mnew);
      if (!ONLINE) e *= fixed_invl;
      s[kt][r] = e;
      ps += e;
    }
  st.l += ps;
  if (pout) { pout[0] = s[0]; pout[1] = s[1]; }
  if (HASV) {
#pragma unroll
    for (int ks = 0; ks < 4; ++ks) {
      h8 pf;
#pragma unroll
      for (int jj = 0; jj < 8; ++jj) pf[jj] = (half_t)s[ks >> 1][8 * (ks & 1) + jj];
#pragma unroll
      for (int dt = 0; dt < 2; ++dt) {
        const h8 vf = *(const h8*)&Vs[(32 * dt + c) * 72 + 16 * ks + 8 * h];
        st.o[dt] = __builtin_amdgcn_mfma_f32_32x32x16_f16(vf, pf, st.o[dt], 0, 0, 0);
      }
    }
  }
}
template <bool ONLINE, bool HASV, bool WANTP, class PRE, class FU, class VF, class PO>
__device__ __forceinline__ void run_dense(DState& st, const half_t* __restrict__ Kb, int ldk,
                                          const half_t* __restrict__ VT, int ldv, int blk_lo, int blk_hi, const h8* qf,
                                          PRE pre, FU full, VF valid, float fixed_m, float fixed_invl, PO post, char* smem,
                                          int tid) {
  half_t* Ks = (half_t*)smem;
  half_t* Vs = Ks + 64 * 72;
  const int lane = tid & 63;
  StageRegs sr;
  load_stage<HASV>(sr, Kb, ldk, VT, ldv, blk_lo * 64, tid);
  for (int blk = blk_lo; blk <= blk_hi; ++blk) {
    __syncthreads();
    write_stage<HASV>(sr, Ks, Vs, tid);
    __syncthreads();
    const int nb = blk < blk_hi ? blk + 1 : blk;
    load_stage<HASV>(sr, Kb, ldk, VT, ldv, nb * 64, tid);
    const int flag = pre(blk);
    if (__ballot(flag != 0) != 0ull) {
      f32x16 pp[2];
      if (full(blk))
        dense_block<ONLINE, HASV, true>(st, Ks, Vs, qf, blk * 64, flag, valid, fixed_m, fixed_invl,
                                        WANTP ? pp : (f32x16*)nullptr, lane);
      else
        dense_block<ONLINE, HASV, false>(st, Ks, Vs, qf, blk * 64, flag, valid, fixed_m, fixed_invl,
                                         WANTP ? pp : (f32x16*)nullptr, lane);
      if (WANTP) post(blk * 64, pp);
    }
  }
}

__device__ __forceinline__ void nsa_item(const KP& p, int b, int g, int tile, char* smem) {
  int tid = threadIdx.x;
  asm volatile("" : "+v"(tid));
  const int lane = tid & 63, wid = tid >> 6;
  const int t0 = tile * 32;
  const int tw0 = t0 + 8 * wid;
  const int col = lane & 31, h = lane >> 5;
  const int j = col >> 2, r4 = col & 3;
  const int tj = tw0 + j;
  const int head = g * 4 + r4;
  float* impA = (float*)(smem + 18432 + wid * 8320);
  float* impB = impA + 1024;
  unsigned long long* msk = (unsigned long long*)(smem + 18432 + 4 * 8320 + wid * 128);
  uint32_t* kbuf = (uint32_t*)(smem + 18432 + 4 * 8320 + 512 + wid * 512);
  const half_t* ub = p.u() + (size_t)b * SEQ * NU;
  const half_t* urow = ub + (size_t)tj * NU;
  h8 qf[4];
#pragma unroll
  for (int ks = 0; ks < 4; ++ks) {
    qf[ks] = *(const h8*)(urow + C_CQ + head * 64 + 16 * ks + 8 * h);
#pragma unroll
    for (int e = 0; e < 8; ++e) qf[ks][e] = (half_t)((float)qf[ks][e] * 0.18033688f);
  }
  float gate[3];
#pragma unroll
  for (int i = 0; i < 3; ++i) gate[i] = sigmoidf_((float)urow[C_CG + head * 3 + i]);
  f32x16 res[2];
#pragma unroll
  for (int dt = 0; dt < 2; ++dt)
#pragma unroll
    for (int r = 0; r < 16; ++r) res[dt][r] = 0.f;
  for (int i = lane; i < 2080; i += 64) impA[i] = 0.f;
  DState st;
  auto nopost = [&](int, f32x16*) __attribute__((always_inline)) {};

  {
    const int nmax_j = (tj >= 31) ? ((tj - 31) >> 4) : -1;
    const int bhi = (t0 >> 4) >> 6;
    const half_t* Kc = p.kcmp() + (size_t)(b * 2 + g) * 512 * 64;
    const half_t* Vc = p.vcmpT() + (size_t)(b * 2 + g) * 64 * 512;
    auto pre = [&](int) __attribute__((always_inline)) { return 1; };
    const int nmax_w = (tw0 >= 31) ? ((tw0 - 31) >> 4) : -1;
    auto fullc = [&](int blk) __attribute__((always_inline)) { return blk * 64 + 63 <= nmax_w; };
    auto vfn = [&](int n, int) __attribute__((always_inline)) { return n <= nmax_j; };
    ds_reset(st);
    run_dense<true, false, false>(st, Kc, 64, (const half_t*)nullptr, 0, 0, bhi, qf, pre, fullc, vfn, 0.f, 0.f, nopost, smem, tid);
    float lt = st.l;
    lt += __shfl_xor(lt, 32);
    const float mfix = st.m;
    const float invl = lt > 0.f ? 1.f / lt : 0.f;
    ds_reset(st);
    auto post = [&](int n0, f32x16* pp) __attribute__((always_inline)) {
#pragma unroll
      for (int kt = 0; kt < 2; ++kt)
#pragma unroll
        for (int qd = 0; qd < 4; ++qd) {
          float a = pp[kt][4 * qd] + pp[kt][4 * qd + 1] + pp[kt][4 * qd + 2] + pp[kt][4 * qd + 3];
          float bb = pp[kt][4 * qd + 3];
          a += __shfl_xor(a, 1); a += __shfl_xor(a, 2);
          bb += __shfl_xor(bb, 1); bb += __shfl_xor(bb, 2);
          if (r4 == 0) {
            const int sblk = (n0 >> 2) + 8 * kt + 2 * qd + h;
            impA[j * 128 + sblk] = a;
            impB[j * 132 + sblk + 1] = bb;
          }
        }
    };
    run_dense<false, true, true>(st, Kc, 64, Vc, 512, 0, bhi, qf, pre, fullc, vfn, mfix, invl, post, smem, tid);
#pragma unroll
    for (int dt = 0; dt < 2; ++dt)
#pragma unroll
      for (int r = 0; r < 16; ++r) res[dt][r] += gate[0] * st.o[dt][r];
  }
  __builtin_amdgcn_wave_barrier();
#pragma unroll 1
  for (int jj = 0; jj < 8; ++jj) {
    const int t = tw0 + jj;
    const int blk = t >> 6;
    uint32_t k0, k1;
    {
      const int s0 = lane, s1 = lane + 64;
      const float i0 = impA[jj * 128 + s0] + impB[jj * 132 + s0];
      const float i1 = impA[jj * 128 + s1] + impB[jj * 132 + s1];
      auto mk = [&](float im, int s) __attribute__((always_inline)) -> uint32_t {
        if (s > blk) return 0u;
        uint32_t kk = ((__float_as_uint(im) >> 1) & ~127u) | (uint32_t)(127 - s) | 0x40000000u;
        if (s == 0 || s == blk || s == blk - 1) kk |= 0x80000000u;
        return kk;
      };
      k0 = mk(i0, s0); k1 = mk(i1, s1);
    }
    kbuf[lane] = k0;
    kbuf[lane + 64] = k1;
    __builtin_amdgcn_wave_barrier();
    int r0 = 0, r1 = 0;
#pragma unroll 4
    for (int qd = 0; qd < 32; ++qd) {
      const uint4 kq = *(const uint4*)&kbuf[4 * qd];
      r0 += (kq.x > k0) + (kq.y > k0) + (kq.z > k0) + (kq.w > k0);
      r1 += (kq.x > k1) + (kq.y > k1) + (kq.z > k1) + (kq.w > k1);
    }
    const unsigned long long lo = __ballot(k0 != 0u && r0 < 16);
    const unsigned long long hi = __ballot(k1 != 0u && r1 < 16);
    __builtin_amdgcn_wave_barrier();
    if (lane == 0) { msk[jj * 2] = lo; msk[jj * 2 + 1] = hi; }
  }
  __builtin_amdgcn_wave_barrier();
  const unsigned long long mylo = msk[j * 2], myhi = msk[j * 2 + 1];
  {
    const half_t* Ksel = ub + C_CKS + g * 64;
    const half_t* Vsel = p.vsT() + (size_t)(b * 2 + g) * 64 * SEQ;
    auto pre = [&](int blk) __attribute__((always_inline)) {
      const unsigned long long mm_ = (blk < 64) ? mylo : myhi;
      return (int)((mm_ >> (blk & 63)) & 1ull);
    };
    auto vfn = [&](int key, int flag) __attribute__((always_inline)) { return flag != 0 && key <= tj; };
    ds_reset(st);
    auto fulls = [&](int blk) __attribute__((always_inline)) { return blk * 64 + 63 <= tw0; };
    run_dense<true, true, false>(st, Ksel, NU, Vsel, SEQ, 0, (t0 + 31) >> 6, qf, pre, fulls, vfn, 0.f, 0.f, nopost, smem, tid);
    float lt = st.l;
    lt += __shfl_xor(lt, 32);
    const float sc = lt > 0.f ? gate[1] / lt : 0.f;
#pragma unroll
    for (int dt = 0; dt < 2; ++dt)
#pragma unroll
      for (int r = 0; r < 16; ++r) res[dt][r] += sc * st.o[dt][r];
  }
  {
    const half_t* Kw = ub + C_CKW + g * 64;
    const half_t* Vw = p.vwT() + (size_t)(b * 2 + g) * 64 * SEQ;
    auto pre = [&](int blk) __attribute__((always_inline)) {
      return (int)((blk * 64 <= tj) && (blk * 64 + 63 > tj - 512));
    };
    auto vfn = [&](int key, int) __attribute__((always_inline)) { return key <= tj && key > tj - 512; };
    ds_reset(st);
    auto fullw = [&](int blk) __attribute__((always_inline)) { return blk * 64 + 63 <= tw0 && blk * 64 > tw0 + 7 - 512; };
    run_dense<true, true, false>(st, Kw, NU, Vw, SEQ, max(0, t0 - 511) >> 6, (t0 + 31) >> 6, qf, pre, fullw, vfn, 0.f, 0.f,
                                 nopost, smem, tid);
    float lt = st.l;
    lt += __shfl_xor(lt, 32);
    const float sc = lt > 0.f ? gate[2] / lt : 0.f;
#pragma unroll
    for (int dt = 0; dt < 2; ++dt)
#pragma unroll
      for (int r = 0; r < 16; ++r) res[dt][r] += sc * st.o[dt][r];
  }
  half_t* yrow = p.yc() + (size_t)(b * SEQ + tj) * 512 + head * 64;
#pragma unroll
  for (int dt = 0; dt < 2; ++dt)
#pragma unroll
    for (int qd = 0; qd < 4; ++qd) {
      const int d = 32 * dt + 8 * qd + 4 * h;
      const h4 z = *(const h4*)(urow + C_CZ + head * 64 + d);
      h4 ov;
#pragma unroll
      for (int e = 0; e < 4; ++e) ov[e] = (half_t)(res[dt][4 * qd + e] * siluf_((float)z[e]));
      *(h4*)(yrow + d) = ov;
    }
  __syncthreads();
}

__device__ __forceinline__ void phase_nsa(const KP& p, char* smem, int* q, int xcc) {
  xcd_schedule(q, xcc, 1024, 1, smem, [&](int grp, int) __attribute__((always_inline)) {
    const int y = grp & 7, k = grp >> 3;
    const int b = y & 1, g = (y >> 1) & 1, tile = 255 - (k * 2 + (y >> 2));
    nsa_item(p, b, g, tile, smem);
  });
}

__device__ __forceinline__ void phase_merge(const KP& p, char* smem, int* q, int xcc) {
  xcd_schedule(q, xcc, 16, 64, smem, [&](int grp, int within) __attribute__((always_inline)) {
    const int mt = (grp & 15) * 8 + (within & 7), nt = (within >> 3);
    const int m0 = mt * 128, n0 = nt * 128;
    f32x16 tot[2][2];
#pragma unroll
    for (int i = 0; i < 2; ++i)
#pragma unroll
      for (int jn = 0; jn < 2; ++jn)
#pragma unroll
        for (int r = 0; r < 16; ++r) tot[i][jn][r] = 0.f;
#pragma unroll 1
    for (int br = 0; br < 3; ++br) {
      const half_t* A = (br == 0 ? p.ya() : (br == 1 ? p.yb() : p.yc())) + (size_t)m0 * 512;
      const half_t* B = p.wpT() + (size_t)br * DM * 512 + (size_t)n0 * 512;
      const half_t* G = p.u() + (size_t)m0 * NU + C_GM + br * 1024 + n0;
      gemm_tile<2>(
          512, [&](int r, int k) { return *(const uint4*)(A + (size_t)r * 512 + k); },
          [&](int r, int k) { return *(const uint4*)(B + (size_t)r * 512 + k); },
          [&](int mi, int ni, int r, int row, int col, float v) {
            const float gz = (float)G[(size_t)row * NU + col];
            tot[mi][ni][r] += sigmoidf_(gz) * v;
          },
          smem);
    }
    int tidx = threadIdx.x;
    asm volatile("" : "+v"(tidx));
    const int lane = tidx & 63, wid = tidx >> 6, wm = wid >> 1, wn = wid & 1;
#pragma unroll
    for (int mi = 0; mi < 2; ++mi)
#pragma unroll
      for (int ni = 0; ni < 2; ++ni)
#pragma unroll
        for (int r = 0; r < 16; ++r) {
          const int row = wm * 64 + mi * 32 + (r & 3) + 8 * (r >> 2) + 4 * (lane >> 5);
          const int col = wn * 64 + ni * 32 + (lane & 31);
          p.mm()[(size_t)(m0 + row) * DM + n0 + col] = (half_t)tot[mi][ni][r];
        }
  });
}

__device__ __forceinline__ void phase_outproj(const KP& p, char* smem, int* q, int xcc) {
  xcd_schedule(q, xcc, 8, 64, smem, [&](int grp, int within) __attribute__((always_inline)) {
    const int mt = grp * 8 + (within & 7), nt = (within >> 3);
    const int m0 = mt * 256, n0 = nt * 128;
    const half_t* A = p.mm() + (size_t)m0 * DM;
    const half_t* B = p.woT() + (size_t)n0 * DM;
    gemm_tile_big(
        DM, [&](int r, int k) { return *(const uint4*)(A + (size_t)r * DM + k); },
        [&](int r, int k) { return *(const uint4*)(B + (size_t)r * DM + k); },
        [&](int mi, int ni, int r, int row, int col, float v) {
          const size_t xi = (size_t)(m0 + row) * DM + n0 + col;
          ((float*)p.u())[xi] = ALPHA_F * p.xr()[xi] + v;
        },
        smem);
  });
}

#define XB_TMO      128
#define XB_XCNT(j)  (256  + 64 * (j))
#define XB_XSUB(j)  (1280 + 64 * (j))
#define XB_XGEN(j)  (2304 + 64 * (j))
#define XB_TOP      3328
#define XB_TOPGEN   3392
#define XCD_BAR_WORDS 3456
#define XB_SPIN_CAP (1u << 20)
#define LAS __attribute__((address_space(3)))
__device__ __forceinline__ unsigned xb_ld(unsigned* p)              { return __hip_atomic_load(p, __ATOMIC_RELAXED, __HIP_MEMORY_SCOPE_AGENT); }
__device__ __forceinline__ unsigned xb_add(unsigned* p, unsigned v) { return __hip_atomic_fetch_add(p, v, __ATOMIC_RELAXED, __HIP_MEMORY_SCOPE_AGENT); }
__device__ __forceinline__ unsigned xb_xcc_id() { return (unsigned)__builtin_amdgcn_s_getreg((3 << 11) | 20) & 0xFu; }
#define XB_SPIN(cond, bar) do { unsigned _sp = 0; while (cond) { __builtin_amdgcn_s_sleep(1); \
    if ((++_sp & 255u) == 0u) { if (xb_ld(&(bar)[XB_TMO])) break; if (_sp > XB_SPIN_CAP) { atomicAdd(&(bar)[XB_TMO], 1u); break; } } } } while (0)
struct XcdBarrier { unsigned* bar; unsigned x; volatile LAS unsigned* st; };
__device__ __forceinline__ XcdBarrier xcd_barrier_post(unsigned* bar, volatile LAS unsigned* st) {
  XcdBarrier b; b.bar = bar; b.x = xb_xcc_id(); b.st = st;
  if (threadIdx.x == 0) (void)xb_add(&bar[XB_XCNT(b.x)], 1u);
  return b;
}
__device__ __forceinline__ void xcd_barrier_complete(unsigned* bar, unsigned x, unsigned& nloc, unsigned& nx) {
  const unsigned G = gridDim.x * gridDim.y * gridDim.z;
  unsigned sum, cnt, mine, sp = 0u;
  for (;;) {
    sum = 0u; cnt = 0u; mine = 0u;
#pragma unroll
    for (unsigned j = 0; j < 16; ++j) { const unsigned c = xb_ld(&bar[XB_XCNT(j)]); sum += c; cnt += (c > 0u) ? 1u : 0u; mine = (j == x) ? c : mine; }
    if (sum == G) break;
    __builtin_amdgcn_s_sleep(1);
    if ((++sp & 255u) == 0u) { if (xb_ld(&bar[XB_TMO])) break; if (sp > XB_SPIN_CAP) { atomicAdd(&bar[XB_TMO], 1u); break; } }
  }
  nloc = mine > 0u ? mine : 1u; nx = cnt > 0u ? cnt : 1u;
}
__device__ __forceinline__ void xcd_barrier(const XcdBarrier& b) {
  asm volatile("s_waitcnt vmcnt(0)" ::: "memory");
  __syncthreads();
  if (threadIdx.x == 0) {
    unsigned* bar = b.bar;
    __builtin_amdgcn_s_waitcnt(0);
    unsigned nloc = b.st[0], nx = b.st[1];
    if (nloc == 0u) { xcd_barrier_complete(bar, b.x, nloc, nx); b.st[0] = nloc; b.st[1] = nx; }
    const unsigned old = xb_add(&bar[XB_XSUB(b.x)], 1u);
    const unsigned gen = old / nloc;
    if (old + 1u == (gen + 1u) * nloc) {
      __builtin_amdgcn_fence(__ATOMIC_RELEASE, "agent");
      asm volatile("s_waitcnt vmcnt(0)" ::: "memory");
      const unsigned og = xb_add(&bar[XB_TOP], 1u);
      const unsigned tg = og / nx;
      if (og + 1u == (tg + 1u) * nx) xb_add(&bar[XB_TOPGEN], 1u);
      else XB_SPIN(xb_ld(&bar[XB_TOPGEN]) == tg, bar);
      __builtin_amdgcn_fence(__ATOMIC_ACQUIRE, "agent");
      xb_add(&bar[XB_XGEN(b.x)], 1u);
      asm volatile("s_waitcnt vmcnt(0)" ::: "memory");
    } else {
      XB_SPIN(xb_ld(&bar[XB_XGEN(b.x)]) == gen, bar);
      __builtin_amdgcn_fence(__ATOMIC_ACQUIRE, "agent");
      asm volatile("s_waitcnt vmcnt(0)" ::: "memory");
    }
  }
  __syncthreads();
}

#define NQ_WORDS 4096
__global__ void __launch_bounds__(256, 2) fwd_megakernel(Params p_unused) {
  cg::grid_group grid = cg::this_grid();
  __shared__ __attribute__((aligned(16))) char smem[SMEM_BYTES];
  volatile LAS unsigned* st = (volatile LAS unsigned*)(smem + SMEM_BYTES - 32);
  if (threadIdx.x == 0) { st[0] = 0u; st[1] = 0u; }
  __syncthreads();
  if (gridDim.y == 4242u) grid.sync();
  XcdBarrier xb;
  {
    const KP p = get_params();
    xb = xcd_barrier_post((unsigned*)p.counters() + NQ_WORDS, st);
    ln_rows(p, -1, false);
    prep_weights(p, 0, smem);
  }
  xcd_barrier(xb);
  const int xcc = (int)(xb.x & 7u);
#ifndef REP1
#define REP1 1
#define REP2 1
#define REP3 1
#define REP4 1
#endif
#ifndef REP5
#define REP5 1
#define REP6 1
#define REP7 0
#endif
#pragma unroll 1
  for (int l = 0; l < DEPTH; ++l) {
#define QPTR(ph, rep) (p.counters() + ((l * 6 + (ph)) * 4 + (rep)) * 32)
    for (int rep = 0; rep < REP1; ++rep) { const KP p = get_params(); phase_inproj(p, l, smem, QPTR(0, rep), xcc); }
    xcd_barrier(xb);
    for (int rep = 0; rep < REP2; ++rep) { const KP p = get_params(); phase2(p, l, smem, QPTR(1, rep), xcc); }
    xcd_barrier(xb);
    for (int rep = 0; rep < REP3; ++rep) { const KP p = get_params(); phase_nsa(p, smem, QPTR(2, rep), xcc); }
    xcd_barrier(xb);
    for (int rep = 0; rep < REP4; ++rep) { const KP p = get_params(); phase_merge(p, smem, QPTR(3, rep), xcc); }
    xcd_barrier(xb);
    for (int rep = 0; rep < REP5; ++rep) { const KP p = get_params(); phase_outproj(p, smem, QPTR(4, rep), xcc); }
    xcd_barrier(xb);
    for (int rep = 0; rep < REP6; ++rep) {
      const KP p = get_params();
      if (l + 1 < DEPTH) {
        ln_rows(p, l, false);
        prep_weights(p, l + 1, smem);
      } else {
        ln_rows(p, l, true);
      }
    }
    if (l + 1 < DEPTH) xcd_barrier(xb);
    for (int rep = 0; rep < REP7; ++rep) xcd_barrier(xb);
  }
}

extern "C" void kernel_launch(void* const* d_in, const int* in_sizes, int n_in, void* d_out, int out_size,
                              void* d_ws, size_t ws_size, hipStream_t stream) {
  static int grid_blocks = 0;
  if (!grid_blocks) {
    int dev = 0, cus = 0, per_cu = 0;
    (void)hipGetDevice(&dev);
    (void)hipDeviceGetAttribute(&cus, hipDeviceAttributeMultiprocessorCount, dev);
    (void)hipOccupancyMaxActiveBlocksPerMultiprocessor(&per_cu, fwd_megakernel, 256, 0);
    if (per_cu > 2) per_cu = 2;
    if (per_cu < 1) per_cu = 1;
    grid_blocks = cus * per_cu;
  }
  Params p{};
  p.x = (const float*)d_in[0]; p.w_in = (const float*)d_in[1]; p.b_in = (const float*)d_in[2];
  p.pool_w = (const float*)d_in[3]; p.pool_b = (const float*)d_in[4]; p.pool_scale = (const float*)d_in[5];
  p.pos_k = (const float*)d_in[6]; p.pos_v = (const float*)d_in[7]; p.w1k = (const float*)d_in[8];
  p.w2k = (const float*)d_in[9]; p.w1v = (const float*)d_in[10]; p.w2v = (const float*)d_in[11];
  p.wpa = (const float*)d_in[12]; p.wpb = (const float*)d_in[13]; p.wpc = (const float*)d_in[14];
  p.wo = (const float*)d_in[15]; p.ln_g = (const float*)d_in[16]; p.ln_b = (const float*)d_in[17];
  p.out = (float*)d_out;
  p.ws = (char*)d_ws;
  if (WS_TOTAL > ws_size) { fprintf(stderr, "workspace too small: need %zu have %zu\n", (size_t)WS_TOTAL, ws_size); return; }
  (void)hipMemsetAsync((char*)d_ws + OFF_counters, 0, (size_t)(NQ_WORDS + XCD_BAR_WORDS) * 4, stream);
  void* args[] = {&p};
  hipError_t e = hipLaunchCooperativeKernel((void*)fwd_megakernel, dim3(grid_blocks), dim3(256), args, 0, stream);
  if (e != hipSuccess) fprintf(stderr, "cooperative launch failed: %s (grid %d)\n", hipGetErrorString(e), grid_blocks);
}
```

```cpp
#include <hip/hip_runtime.h>
#include <hip/hip_cooperative_groups.h>
#include <cstdio>
#include <cstdint>
namespace cg = cooperative_groups;

typedef _Float16 half_t;
typedef _Float16 h8 __attribute__((ext_vector_type(8)));
typedef _Float16 h4 __attribute__((ext_vector_type(4)));
typedef float f32x4 __attribute__((ext_vector_type(4)));
typedef float f32x16 __attribute__((ext_vector_type(16)));

#define SEQ 8192
#define DM 1024
#define NTOK 16384
#define DEPTH 4
#define NIN 7360
#define NU 7424
#define ALPHA_F 1.681792830507429f
#define NEGF (-1e30f)

#define C_AX 0
#define C_AZ 512
#define C_BQ 1024
#define C_BZ 1536
#define C_CQ 2048
#define C_CZ 2560
#define C_GM 3072
#define C_IQ 6144
#define C_CKC 6400
#define C_CVC 6528
#define C_CKS 6656
#define C_CVS 6784
#define C_CKW 6912
#define C_CVW 7040
#define C_BK 7168
#define C_BV 7232
#define C_IK 7296
#define C_IW 7328
#define C_CG 7336

#define SMEM_BYTES 73728

constexpr size_t OFF_xr = 0;
constexpr size_t OFF_xh = OFF_xr + (((size_t)NTOK*DM*4 + 255) & ~(size_t)255);
constexpr size_t OFF_u = OFF_xh + (((size_t)NTOK*DM*2 + 255) & ~(size_t)255);
constexpr size_t OFF_winT = OFF_u + (((size_t)NTOK*NU*2 + 255) & ~(size_t)255);
constexpr size_t OFF_wpT = OFF_winT + (((size_t)NU*DM*2 + 255) & ~(size_t)255);
constexpr size_t OFF_woT = OFF_wpT + (((size_t)3*DM*512*2 + 255) & ~(size_t)255);
constexpr size_t OFF_poolT = OFF_woT + (((size_t)DM*DM*2 + 255) & ~(size_t)255);
constexpr size_t OFF_w1T = OFF_poolT + (((size_t)4*128*128*2 + 255) & ~(size_t)255);
constexpr size_t OFF_posb = OFF_w1T + (((size_t)2*64*2048*2 + 255) & ~(size_t)255);
constexpr size_t OFF_vsT = OFF_posb + (((size_t)512 + 255) & ~(size_t)255);
constexpr size_t OFF_vwT = OFF_vsT + (((size_t)4*64*SEQ*2 + 255) & ~(size_t)255);
constexpr size_t OFF_kcmp = OFF_vwT + (((size_t)4*64*SEQ*2 + 255) & ~(size_t)255);
constexpr size_t OFF_vcmpT = OFF_kcmp + (((size_t)4*512*64*2 + 255) & ~(size_t)255);
constexpr size_t OFF_ya = OFF_vcmpT + (((size_t)4*64*512*2 + 255) & ~(size_t)255);
constexpr size_t OFF_yb = OFF_ya + (((size_t)NTOK*512*2 + 255) & ~(size_t)255);
constexpr size_t OFF_yc = OFF_yb + (((size_t)NTOK*512*2 + 255) & ~(size_t)255);
constexpr size_t OFF_mm = OFF_yc + (((size_t)NTOK*512*2 + 255) & ~(size_t)255);
constexpr size_t OFF_counters = OFF_mm + (((size_t)NTOK*DM*2 + 255) & ~(size_t)255);
constexpr size_t WS_TOTAL = OFF_counters + (((size_t)32768 + 255) & ~(size_t)255);
struct Params {
  const float* x; const float* w_in; const float* b_in; const float* pool_w; const float* pool_b;
  const float* pool_scale; const float* pos_k; const float* pos_v; const float* w1k; const float* w2k;
  const float* w1v; const float* w2v; const float* wpa; const float* wpb; const float* wpc;
  const float* wo; const float* ln_g; const float* ln_b;
  float* out;
  char* ws;
};
typedef const __attribute__((address_space(4))) unsigned long long* kargp_t;
struct KP {
  kargp_t kp;
  __device__ __forceinline__ const float* x() const { return (const float*)(const __attribute__((address_space(1))) float*)kp[0]; }
  __device__ __forceinline__ const float* w_in() const { return (const float*)(const __attribute__((address_space(1))) float*)kp[1]; }
  __device__ __forceinline__ const float* b_in() const { return (const float*)(const __attribute__((address_space(1))) float*)kp[2]; }
  __device__ __forceinline__ const float* pool_w() const { return (const float*)(const __attribute__((address_space(1))) float*)kp[3]; }
  __device__ __forceinline__ const float* pool_b() const { return (const float*)(const __attribute__((address_space(1))) float*)kp[4]; }
  __device__ __forceinline__ const float* pool_scale() const { return (const float*)(const __attribute__((address_space(1))) float*)kp[5]; }
  __device__ __forceinline__ const float* pos_k() const { return (const float*)(const __attribute__((address_space(1))) float*)kp[6]; }
  __device__ __forceinline__ const float* pos_v() const { return (const float*)(const __attribute__((address_space(1))) float*)kp[7]; }
  __device__ __forceinline__ const float* w1k() const { return (const float*)(const __attribute__((address_space(1))) float*)kp[8]; }
  __device__ __forceinline__ const float* w2k() const { return (const float*)(const __attribute__((address_space(1))) float*)kp[9]; }
  __device__ __forceinline__ const float* w1v() const { return (const float*)(const __attribute__((address_space(1))) float*)kp[10]; }
  __device__ __forceinline__ const float* w2v() const { return (const float*)(const __attribute__((address_space(1))) float*)kp[11]; }
  __device__ __forceinline__ const float* wpa() const { return (const float*)(const __attribute__((address_space(1))) float*)kp[12]; }
  __device__ __forceinline__ const float* wpb() const { return (const float*)(const __attribute__((address_space(1))) float*)kp[13]; }
  __device__ __forceinline__ const float* wpc() const { return (const float*)(const __attribute__((address_space(1))) float*)kp[14]; }
  __device__ __forceinline__ const float* wo() const { return (const float*)(const __attribute__((address_space(1))) float*)kp[15]; }
  __device__ __forceinline__ const float* ln_g() const { return (const float*)(const __attribute__((address_space(1))) float*)kp[16]; }
  __device__ __forceinline__ const float* ln_b() const { return (const float*)(const __attribute__((address_space(1))) float*)kp[17]; }
  __device__ __forceinline__ float* out() const { return (float*)(__attribute__((address_space(1))) float*)kp[18]; }
  __device__ __forceinline__ char* ws() const { return (char*)(__attribute__((address_space(1))) char*)kp[19]; }
  __device__ __forceinline__ float* xr() const { return (float*)(ws() + OFF_xr); }
  __device__ __forceinline__ half_t* xh() const { return (half_t*)(ws() + OFF_xh); }
  __device__ __forceinline__ half_t* u() const { return (half_t*)(ws() + OFF_u); }
  __device__ __forceinline__ half_t* winT() const { return (half_t*)(ws() + OFF_winT); }
  __device__ __forceinline__ half_t* wpT() const { return (half_t*)(ws() + OFF_wpT); }
  __device__ __forceinline__ half_t* woT() const { return (half_t*)(ws() + OFF_woT); }
  __device__ __forceinline__ half_t* poolT() const { return (half_t*)(ws() + OFF_poolT); }
  __device__ __forceinline__ half_t* w1T() const { return (half_t*)(ws() + OFF_w1T); }
  __device__ __forceinline__ float* posb() const { return (float*)(ws() + OFF_posb); }
  __device__ __forceinline__ half_t* vsT() const { return (half_t*)(ws() + OFF_vsT); }
  __device__ __forceinline__ half_t* vwT() const { return (half_t*)(ws() + OFF_vwT); }
  __device__ __forceinline__ half_t* kcmp() const { return (half_t*)(ws() + OFF_kcmp); }
  __device__ __forceinline__ half_t* vcmpT() const { return (half_t*)(ws() + OFF_vcmpT); }
  __device__ __forceinline__ half_t* ya() const { return (half_t*)(ws() + OFF_ya); }
  __device__ __forceinline__ half_t* yb() const { return (half_t*)(ws() + OFF_yb); }
  __device__ __forceinline__ half_t* yc() const { return (half_t*)(ws() + OFF_yc); }
  __device__ __forceinline__ half_t* mm() const { return (half_t*)(ws() + OFF_mm); }
  __device__ __forceinline__ int* counters() const { return (int*)(ws() + OFF_counters); }
};
__device__ __forceinline__ KP get_params() {
  KP q;
  q.kp = (kargp_t)__builtin_amdgcn_kernarg_segment_ptr();
  asm volatile("" : "+s"(q.kp));
  return q;
}


__device__ __forceinline__ int orig_col(int n) {
  if (n < 1536) return n;
  if (n < 2048) return 1664 + (n - 1536);
  if (n < 2560) return 2472 + (n - 2048);
  if (n < 3072) return 3776 + (n - 2560);
  if (n < 6144) return 4288 + (n - 3072);
  if (n < 6400) return 2176 + (n - 6144);
  if (n < 7168) return 2984 + (n - 6400);
  if (n < 7296) return 1536 + (n - 7168);
  if (n < 7328) return 2432 + (n - 7296);
  if (n < 7336) return 2464 + (n - 7328);
  if (n < 7360) return 3752 + (n - 7336);
  return -1;
}

__device__ __forceinline__ float wave_sum(float v) {
#pragma unroll
  for (int o = 32; o > 0; o >>= 1) v += __shfl_xor(v, o);
  return v;
}
template <int CTRL>
__device__ __forceinline__ float dpp_quad(float v) {
  return __uint_as_float((unsigned)__builtin_amdgcn_update_dpp(0, (int)__float_as_uint(v), CTRL, 0xF, 0xF, true));
}
__device__ __forceinline__ float sigmoidf_(float x) { return 1.f / (1.f + __expf(-x)); }
__device__ __forceinline__ float siluf_(float x) { return x / (1.f + __expf(-x)); }

template <int NI, class LA, class LB, class EP>
__device__ __forceinline__ void gemm_tile(int K, LA loadA, LB loadB, EP epi, char* smem) {
  constexpr int BN = NI * 64;
  constexpr int NB = BN / 32;
  half_t* sA = (half_t*)smem;
  half_t* sB = sA + 128 * 72;
  int tid = threadIdx.x;
  asm volatile("" : "+v"(tid));
  const int lane = tid & 63, wid = tid >> 6;
  const int wm = wid >> 1, wn = wid & 1;
  f32x16 acc[2][NI];
#pragma unroll
  for (int i = 0; i < 2; ++i)
#pragma unroll
    for (int j = 0; j < NI; ++j)
#pragma unroll
      for (int r = 0; r < 16; ++r) acc[i][j][r] = 0.f;
  const int lr = tid >> 3, lc = (tid & 7) * 8;
  uint4 ra[4], rb[NB];
#pragma unroll
  for (int i = 0; i < 4; ++i) ra[i] = loadA(lr + 32 * i, lc);
#pragma unroll
  for (int i = 0; i < NB; ++i) rb[i] = loadB(lr + 32 * i, lc);
  const int nk = K >> 6;
  for (int kt = 0; kt < nk; ++kt) {
    __syncthreads();
#pragma unroll
    for (int i = 0; i < 4; ++i) *(uint4*)&sA[(lr + 32 * i) * 72 + lc] = ra[i];
#pragma unroll
    for (int i = 0; i < NB; ++i) *(uint4*)&sB[(lr + 32 * i) * 72 + lc] = rb[i];
    __syncthreads();
    if (kt + 1 < nk) {
      const int kk = (kt + 1) * 64 + lc;
#pragma unroll
      for (int i = 0; i < 4; ++i) ra[i] = loadA(lr + 32 * i, kk);
#pragma unroll
      for (int i = 0; i < NB; ++i) rb[i] = loadB(lr + 32 * i, kk);
    }
#pragma unroll
    for (int s = 0; s < 4; ++s) {
      h8 af[2], bf[NI];
#pragma unroll
      for (int mi = 0; mi < 2; ++mi)
        af[mi] = *(const h8*)&sA[(wm * 64 + mi * 32 + (lane & 31)) * 72 + s * 16 + (lane >> 5) * 8];
#pragma unroll
      for (int ni = 0; ni < NI; ++ni)
        bf[ni] = *(const h8*)&sB[(wn * (NI * 32) + ni * 32 + (lane & 31)) * 72 + s * 16 + (lane >> 5) * 8];
#pragma unroll
      for (int mi = 0; mi < 2; ++mi)
#pragma unroll
        for (int ni = 0; ni < NI; ++ni)
          acc[mi][ni] = __builtin_amdgcn_mfma_f32_32x32x16_f16(af[mi], bf[ni], acc[mi][ni], 0, 0, 0);
    }
  }
#pragma unroll
  for (int mi = 0; mi < 2; ++mi)
#pragma unroll
    for (int ni = 0; ni < NI; ++ni)
#pragma unroll
      for (int r = 0; r < 16; ++r) {
        const int row = wm * 64 + mi * 32 + (r & 3) + 8 * (r >> 2) + 4 * (lane >> 5);
        const int col = wn * (NI * 32) + ni * 32 + (lane & 31);
        epi(mi, ni, r, row, col, acc[mi][ni][r]);
      }
}

template <class LA, class LB, class EP>
__device__ __forceinline__ void gemm_tile_big(int K, LA loadA, LB loadB, EP epi, char* smem) {
  half_t* sA = (half_t*)smem;
  half_t* sB = sA + 256 * 72;
  int tid = threadIdx.x;
  asm volatile("" : "+v"(tid));
  const int lane = tid & 63, wid = tid >> 6;
  const int wm = wid >> 1, wn = wid & 1;
  f32x16 acc[4][2];
#pragma unroll
  for (int i = 0; i < 4; ++i)
#pragma unroll
    for (int j = 0; j < 2; ++j)
#pragma unroll
      for (int r = 0; r < 16; ++r) acc[i][j][r] = 0.f;
  const int lr = tid >> 3, lc = (tid & 7) * 8;
  uint4 ra[8], rb[4];
#pragma unroll
  for (int i = 0; i < 8; ++i) ra[i] = loadA(lr + 32 * i, lc);
#pragma unroll
  for (int i = 0; i < 4; ++i) rb[i] = loadB(lr + 32 * i, lc);
  const int nk = K >> 6;
  for (int kt = 0; kt < nk; ++kt) {
    __syncthreads();
#pragma unroll
    for (int i = 0; i < 8; ++i) *(uint4*)&sA[(lr + 32 * i) * 72 + lc] = ra[i];
#pragma unroll
    for (int i = 0; i < 4; ++i) *(uint4*)&sB[(lr + 32 * i) * 72 + lc] = rb[i];
    __syncthreads();
    if (kt + 1 < nk) {
      const int kk = (kt + 1) * 64 + lc;
#pragma unroll
      for (int i = 0; i < 8; ++i) ra[i] = loadA(lr + 32 * i, kk);
#pragma unroll
      for (int i = 0; i < 4; ++i) rb[i] = loadB(lr + 32 * i, kk);
    }
#pragma unroll
    for (int s = 0; s < 4; ++s) {
      h8 af[4], bf[2];
#pragma unroll
      for (int mi = 0; mi < 4; ++mi)
        af[mi] = *(const h8*)&sA[(wm * 128 + mi * 32 + (lane & 31)) * 72 + s * 16 + (lane >> 5) * 8];
#pragma unroll
      for (int ni = 0; ni < 2; ++ni)
        bf[ni] = *(const h8*)&sB[(wn * 64 + ni * 32 + (lane & 31)) * 72 + s * 16 + (lane >> 5) * 8];
#pragma unroll
      for (int mi = 0; mi < 4; ++mi)
#pragma unroll
        for (int ni = 0; ni < 2; ++ni)
          acc[mi][ni] = __builtin_amdgcn_mfma_f32_32x32x16_f16(af[mi], bf[ni], acc[mi][ni], 0, 0, 0);
    }
  }
#pragma unroll
  for (int mi = 0; mi < 4; ++mi)
#pragma unroll
    for (int ni = 0; ni < 2; ++ni)
#pragma unroll
      for (int r = 0; r < 16; ++r) {
        const int row = wm * 128 + mi * 32 + (r & 3) + 8 * (r >> 2) + 4 * (lane >> 5);
        const int col = wn * 64 + ni * 32 + (lane & 31);
        epi(mi, ni, r, row, col, acc[mi][ni][r]);
      }
}

template <class CM>
__device__ __forceinline__ void tconv_tile(const float* __restrict__ src, int lds_, half_t* __restrict__ dst, int ldd,
                                           int n0, int k0, CM cmap, char* smem) {
  float* t = (float*)smem;
  int tid = threadIdx.x;
  asm volatile("" : "+v"(tid));
  {
    const int n = tid & 63;
    const int c = cmap(n0 + n);
    float tv[16];
#pragma unroll
    for (int i = 0; i < 16; ++i) {
      const int k = (tid >> 6) + 4 * i;
      tv[i] = (c >= 0) ? src[(size_t)(k0 + k) * lds_ + c] : 0.f;
    }
#pragma unroll
    for (int i = 0; i < 16; ++i) {
      const int k = (tid >> 6) + 4 * i;
      t[k * 65 + n] = tv[i];
    }
  }
  __syncthreads();
#pragma unroll
  for (int i = 0; i < 2; ++i) {
    const int idx = tid + 256 * i;
    const int n = idx >> 3, kc = (idx & 7) * 8;
    h8 v;
#pragma unroll
    for (int j = 0; j < 8; ++j) v[j] = (half_t)t[(kc + j) * 65 + n];
    *(h8*)&dst[(size_t)(n0 + n) * ldd + k0 + kc] = v;
  }
  __syncthreads();
}

__device__ __forceinline__ void ln_rows(const KP& p, int lprev, bool final_) {
  int tid = threadIdx.x;
  asm volatile("" : "+v"(tid));
  const int lane = tid & 63, wid = tid >> 6;
  const int gw = blockIdx.x * 4 + wid, nw = gridDim.x * 4;
  for (int row = gw; row < NTOK; row += nw) {
    const float4* rp = (const float4*)((lprev < 0 ? p.x() : (const float*)p.u()) + (size_t)row * DM);
    float4 v[4];
    float s = 0.f;
#pragma unroll
    for (int i = 0; i < 4; ++i) {
      v[i] = rp[lane + 64 * i];
      s += v[i].x + v[i].y + v[i].z + v[i].w;
    }
    if (lprev >= 0) {
      float mu = wave_sum(s) * (1.f / DM);
      float q = 0.f;
#pragma unroll
      for (int i = 0; i < 4; ++i) {
        float a = v[i].x - mu, b = v[i].y - mu, c = v[i].z - mu, d = v[i].w - mu;
        q += a * a + b * b + c * c + d * d;
      }
      float rstd = rsqrtf(wave_sum(q) * (1.f / DM) + 1e-5f);
      const float4* g4 = (const float4*)(p.ln_g() + lprev * DM);
      const float4* b4 = (const float4*)(p.ln_b() + lprev * DM);
#pragma unroll
      for (int i = 0; i < 4; ++i) {
        float4 g = g4[lane + 64 * i], bb = b4[lane + 64 * i];
        v[i].x = (v[i].x - mu) * rstd * g.x + bb.x;
        v[i].y = (v[i].y - mu) * rstd * g.y + bb.y;
        v[i].z = (v[i].z - mu) * rstd * g.z + bb.z;
        v[i].w = (v[i].w - mu) * rstd * g.w + bb.w;
      }
    }
    if (final_) {
      float4* op = (float4*)(p.out() + (size_t)row * DM);
#pragma unroll
      for (int i = 0; i < 4; ++i) op[lane + 64 * i] = v[i];
    } else {
      float4* op = (float4*)(p.xr() + (size_t)row * DM);
      h4* hp = (h4*)(p.xh() + (size_t)row * DM);
#pragma unroll
      for (int i = 0; i < 4; ++i) {
        op[lane + 64 * i] = v[i];
        h4 hv;
        hv[0] = (half_t)v[i].x; hv[1] = (half_t)v[i].y; hv[2] = (half_t)v[i].z; hv[3] = (half_t)v[i].w;
        hp[lane + 64 * i] = hv;
      }
    }
  }
}

__device__ __forceinline__ void prep_weights(const KP& p, int l, char* smem) {
  int tid = threadIdx.x;
  asm volatile("" : "+v"(tid));
  const int total = 1856 + 384 + 256 + 16 + 64 + 2;
  for (int it = blockIdx.x; it < total; it += gridDim.x) {
    if (it < 1856) {
      const int nt = it >> 4, kt = it & 15;
      tconv_tile(p.w_in() + (size_t)l * DM * NIN, NIN, p.winT(), DM, nt * 64, kt * 64,
                 [](int n) { return orig_col(n); }, smem);
    } else if (it < 1856 + 384) {
      const int j = it - 1856;
      const int w = j >> 7, r = j & 127, nt = r >> 3, kt = r & 7;
      const float* src = (w == 0 ? p.wpa() : (w == 1 ? p.wpb() : p.wpc())) + (size_t)l * 512 * DM;
      tconv_tile(src, DM, p.wpT() + (size_t)w * DM * 512, 512, nt * 64, kt * 64, [](int n) { return n; }, smem);
    } else if (it < 1856 + 384 + 256) {
      const int j = it - 1856 - 384;
      const int nt = j >> 4, kt = j & 15;
      tconv_tile(p.wo() + (size_t)l * DM * DM, DM, p.woT(), DM, nt * 64, kt * 64, [](int n) { return n; }, smem);
    } else if (it < 1856 + 384 + 256 + 16) {
      const int j = it - 1856 - 384 - 256;
      const int g = j >> 2, nt = (j >> 1) & 1, kt = j & 1;
      tconv_tile(p.pool_w() + ((size_t)l * 4 + g) * 128 * 128, 128, p.poolT() + (size_t)g * 128 * 128, 128, nt * 64,
                 kt * 64, [](int n) { return n; }, smem);
    } else if (it < 1856 + 384 + 256 + 16 + 64) {
      const int j = it - 1856 - 384 - 256 - 16;
      const int kv = j >> 5, kt = j & 31;
      const float* src = (kv ? p.w1v() : p.w1k()) + (size_t)l * 2048 * 64;
      tconv_tile(src, 64, p.w1T() + (size_t)kv * 64 * 2048, 2048, 0, kt * 64, [](int n) { return n; }, smem);
    } else {
      const int kv = it - (1856 + 384 + 256 + 16 + 64);
      const float* w1 = (kv ? p.w1v() : p.w1k()) + (size_t)l * 2048 * 64;
      const float* pos = (kv ? p.pos_v() : p.pos_k()) + (size_t)l * 2048;
      float* red = (float*)smem;
      const int e = tid & 63, part = tid >> 6;
      float sa = 0.f, sb = 0.f, sc_ = 0.f, sd = 0.f;
      const float* wq = w1 + (size_t)part * 512 * 64 + e;
      const float* pq = pos + part * 512;
#pragma unroll 4
      for (int f = 0; f < 512; f += 4) {
        sa += pq[f] * wq[(size_t)f * 64];
        sb += pq[f + 1] * wq[(size_t)(f + 1) * 64];
        sc_ += pq[f + 2] * wq[(size_t)(f + 2) * 64];
        sd += pq[f + 3] * wq[(size_t)(f + 3) * 64];
      }
      const float s = (sa + sb) + (sc_ + sd);
      red[tid] = s;
      __syncthreads();
      if (tid < 64) p.posb()[kv * 64 + tid] = red[tid] + red[tid + 64] + red[tid + 128] + red[tid + 192];
      __syncthreads();
    }
  }
}

template <class F>
__device__ __forceinline__ void xcd_schedule(int* q, int xcc, int ngroups, int gsize, char* smem, F f) {
  int* s_item = (int*)(smem + SMEM_BYTES - 16);
  int* s_flag = (int*)(smem + SMEM_BYTES - 96);
  int* flags = q + 32;
#pragma unroll 1
  for (int dy = 0; dy < 8; ++dy) {
    const int y = (xcc + dy) & 7;
    if (dy == 1) {
      int t8 = threadIdx.x;
      asm volatile("" : "+v"(t8));
      if (t8 < 8) s_flag[t8] = __hip_atomic_load(&flags[t8], __ATOMIC_RELAXED, __HIP_MEMORY_SCOPE_AGENT);
      __syncthreads();
    }
    if (dy >= 1 && __builtin_amdgcn_readfirstlane(s_flag[y]) != 0) continue;
    for (;;) {
      if (threadIdx.x == 0) *s_item = atomicAdd(&q[y], 1);
      __syncthreads();
      const int i = __builtin_amdgcn_readfirstlane(*s_item);
      __syncthreads();
      const int grp = (i / gsize) * 8 + y;
      if (grp >= ngroups) {
        if (threadIdx.x == 0) __hip_atomic_store(&flags[y], 1, __ATOMIC_RELAXED, __HIP_MEMORY_SCOPE_AGENT);
        break;
      }
      f(grp, i % gsize);
    }
  }
}

__device__ __forceinline__ void phase_inproj(const KP& p, int l, char* smem, int* q, int xcc) {
  const float* bias = p.b_in() + (size_t)l * NIN;
  xcd_schedule(q, xcc, 128, 32, smem, [&](int grp, int within) __attribute__((always_inline)) {
    const int mt = (grp & 15) * 4 + (within & 3), nt = (grp >> 4) * 8 + (within >> 2);
    if (nt >= 58) return;
    const int m0 = mt * 256, n0 = nt * 128;
    const half_t* A = p.xh() + (size_t)m0 * DM;
    const half_t* B = p.winT() + (size_t)n0 * DM;
    int tidx = threadIdx.x;
    asm volatile("" : "+v"(tidx));
    const int lane = tidx & 63, wn = (tidx >> 6) & 1;
    float bv[2];
#pragma unroll
    for (int ni = 0; ni < 2; ++ni) {
      const int oc = orig_col(n0 + wn * 64 + ni * 32 + (lane & 31));
      bv[ni] = oc >= 0 ? bias[oc] : 0.f;
    }
    half_t* vT = (nt == 53) ? p.vsT() : ((nt == 55) ? p.vwT() : nullptr);
    gemm_tile_big(
        DM, [&](int r, int k) { return *(const uint4*)(A + (size_t)r * DM + k); },
        [&](int r, int k) { return *(const uint4*)(B + (size_t)r * DM + k); },
        [&](int mi, int ni, int r, int row, int col, float v) {
          const half_t hv = (half_t)(v + bv[ni]);
          const int tok = m0 + row;
          p.u()[(size_t)tok * NU + n0 + col] = hv;
          if (vT) {
            const int b = tok >> 13, t = tok & 8191;
            vT[((size_t)(b * 2 + (col >> 6)) * 64 + (col & 63)) * SEQ + t] = hv;
          }
        },
        smem);
  });
}

__device__ __forceinline__ void pool_item(const KP& p, int l, int item, char* smem) {
  const int g = item & 3, mt = item >> 2;
  const int m0 = mt * 128;
  const int wnd = 2 << g;
  const half_t* B = p.poolT() + (size_t)g * 128 * 128;
  int tidx = threadIdx.x;
  asm volatile("" : "+v"(tidx));
  const int lane = tidx & 63, wn = (tidx >> 6) & 1;
  float pb[2], ps[2];
#pragma unroll
  for (int ni = 0; ni < 2; ++ni) {
    const int d = wn * 64 + ni * 32 + (lane & 31);
    pb[ni] = p.pool_b()[(size_t)l * 512 + g * 128 + d];
    ps[ni] = p.pool_scale()[(size_t)l * 512 + g * 128 + d];
  }
  gemm_tile<2>(
      128,
      [&](int r, int k) {
        const int tok = m0 + r, t = tok & 8191;
        const int cnt = min(t + 1, wnd);
        const half_t* base = p.u() + (size_t)tok * NU + C_AX + g * 128 + k;
        float s[8];
#pragma unroll
        for (int j = 0; j < 8; ++j) s[j] = 0.f;
        h8 cur = *(const h8*)base;
        for (int q0 = 0; q0 < wnd; q0 += 8) {
          h8 v[8];
#pragma unroll
          for (int i = 0; i < 8; ++i) {
            const int qq = q0 + i;
            if (qq < cnt) v[i] = *(const h8*)(base - (size_t)qq * NU);
            else {
#pragma unroll
              for (int j = 0; j < 8; ++j) v[i][j] = (half_t)0.f;
            }
          }
#pragma unroll
          for (int i = 0; i < 8; ++i)
#pragma unroll
            for (int j = 0; j < 8; ++j) s[j] += (float)v[i][j];
        }
        const float inv = 1.f / (float)cnt;
        h8 o;
#pragma unroll
        for (int j = 0; j < 8; ++j) o[j] = (half_t)(s[j] * inv - (float)cur[j]);
        return *(uint4*)&o;
      },
      [&](int r, int k) { return *(const uint4*)(B + (size_t)r * 128 + k); },
      [&](int mi, int ni, int r, int row, int col, float v) {
        const int tok = m0 + row;
        const float z = (float)p.u()[(size_t)tok * NU + C_AZ + g * 128 + col];
        p.ya()[(size_t)tok * 512 + g * 128 + col] = (half_t)((v + pb[ni]) * ps[ni] * siluf_(z));
      },
      smem);
}

__device__ __forceinline__ void compress_item(const KP& p, int l, int item, char* smem) {
  const int mt = item & 3, kv = (item >> 2) & 1, g = (item >> 3) & 1, b = item >> 4;
  int tid = threadIdx.x;
  asm volatile("" : "+v"(tid));
  const int ccol = (kv ? C_CVC : C_CKC) + g * 64;
  const half_t* ub = p.u() + (size_t)b * SEQ * NU + ccol;
  const half_t* B = p.w1T() + (size_t)kv * 64 * 2048;
  float* hid = (float*)(smem + 28672);
  const float* posb = p.posb() + kv * 64;
  gemm_tile<1>(
      2048,
      [&](int r, int k) {
        const int n = mt * 128 + r;
        if (n >= 511) return make_uint4(0, 0, 0, 0);
        const int tok = 16 * n + (k >> 6);
        return *(const uint4*)(ub + (size_t)tok * NU + (k & 63));
      },
      [&](int r, int k) { return *(const uint4*)(B + (size_t)r * 2048 + k); },
      [&](int mi, int ni, int r, int row, int col, float v) { hid[row * 65 + col] = siluf_(v + posb[col]); }, smem);
  __syncthreads();
  float* w2s = (float*)smem;
  const float* w2 = (kv ? p.w2v() : p.w2k()) + (size_t)l * 4096;
  for (int i = tid; i < 4096; i += 256) w2s[i] = w2[i];
  __syncthreads();
  {
    const int n = tid >> 1, fh = (tid & 1) * 32;
    float acc[32];
#pragma unroll
    for (int f = 0; f < 32; ++f) acc[f] = 0.f;
    for (int e = 0; e < 64; ++e) {
      const float hv = hid[n * 65 + e];
#pragma unroll
      for (int f = 0; f < 32; ++f) acc[f] += hv * w2s[e * 64 + fh + f];
    }
    const int ng = mt * 128 + n;
    const bool valid = ng < 511;
    if (kv == 0) {
      half_t* dst = p.kcmp() + ((size_t)(b * 2 + g) * 512 + ng) * 64 + fh;
#pragma unroll
      for (int f = 0; f < 32; ++f) dst[f] = valid ? (half_t)acc[f] : (half_t)0.f;
    } else {
      half_t* dst = p.vcmpT() + ((size_t)(b * 2 + g) * 64 + fh) * 512 + ng;
#pragma unroll
      for (int f = 0; f < 32; ++f) dst[(size_t)f * 512] = valid ? (half_t)acc[f] : (half_t)0.f;
    }
  }
  __syncthreads();
}

#ifndef DSA_CAP
#define DSA_CAP 128
#endif
__device__ __forceinline__ void dsa_item(const KP& p, int b, int tile, char* smem) {
  const int t0 = tile * 16;
  int tid = threadIdx.x;
  asm volatile("" : "+v"(tid));
  const int lane = tid & 63, wid = tid >> 6;
  uint32_t* hist = (uint32_t*)smem;
  unsigned long long* cand = (unsigned long long*)(smem + 16384);
  unsigned short* sel = (unsigned short*)(smem + 32768);
  unsigned long long* pfx = (unsigned long long*)(smem + 40960);
  unsigned long long* tkey = pfx + 16;
  int* need = (int*)(tkey + 16);
  int* state = need + 16;
  int* cnt = state + 16;
  int* ccnt = cnt + 16;
  int* pf16 = ccnt + 16;
  int* ovf = pf16 + 16;
  int* nrem = ovf + 16;
  int* fastf = nrem + 8;
  uint32_t* h1w = (uint32_t*)(smem + 43008);
  float* pbuf = (float*)smem + wid * 2048;

  const half_t* ub = p.u() + (size_t)b * SEQ * NU;
  const int mytok = lane & 15, hq = lane >> 4;
  const int myt = t0 + mytok;
  if (tid < 16) {
    const int t = t0 + tid;
    pfx[tid] = 0ull; tkey[tid] = 0ull; need[tid] = 256; state[tid] = (t < 256) ? 0 : 1; cnt[tid] = 0; ccnt[tid] = 0;
    pf16[tid] = 0; ovf[tid] = 0;
  }
  if (tid < 8) nrem[tid] = 0;
  if (tid < 16) fastf[tid] = 0;
  for (int i = tid; i < 6144; i += 256) h1w[i] = 0u;
  h8 qf[8], qlh, qll;
  float iw[8];
  {
    const half_t* qrow = ub + (size_t)myt * NU;
#pragma unroll
    for (int h = 0; h < 8; ++h) qf[h] = *(const h8*)(qrow + C_IQ + h * 32 + hq * 8);
    const h8 w8 = *(const h8*)(qrow + C_IW);
#pragma unroll
    for (int h = 0; h < 8; ++h) iw[h] = (float)w8[h] * 0.03125f;
#pragma unroll
    for (int e = 0; e < 8; ++e) {
      float a = 0.f;
#pragma unroll
      for (int h = 0; h < 8; ++h) a += iw[h] * (float)qf[h][e];
      const half_t hi = (half_t)a;
      qlh[e] = hi;
      qll[e] = (half_t)(a - (float)hi);
    }
  }
  __syncthreads();
  const int nkt = (t0 + 16 + 31) >> 5;

  auto loadk = [&](int kt, h8* a) __attribute__((always_inline)) {
#pragma unroll
    for (int i = 0; i < 2; ++i)
      a[i] = *(const h8*)(ub + (size_t)(kt * 32 + i * 16 + (lane & 15)) * NU + C_IK + hq * 8);
  };
  auto scores = [&](const h8* a, float* sc) __attribute__((always_inline)) {
#pragma unroll
    for (int i = 0; i < 2; ++i) {
      f32x4 acc = {0.f, 0.f, 0.f, 0.f};
      acc = __builtin_amdgcn_mfma_f32_16x16x32_f16(a[i], qll, acc, 0, 0, 0);
      acc = __builtin_amdgcn_mfma_f32_16x16x32_f16(a[i], qlh, acc, 0, 0, 0);
#pragma unroll
      for (int h = 0; h < 8; ++h) {
        f32x4 d = {0.f, 0.f, 0.f, 0.f};
        d = __builtin_amdgcn_mfma_f32_16x16x32_f16(a[i], qf[h], d, 0, 0, 0);
#pragma unroll
        for (int r = 0; r < 4; ++r) acc[r] = __builtin_fmaf(__builtin_fabsf(d[r]), iw[h], acc[r]);
      }
#pragma unroll
      for (int r = 0; r < 4; ++r) sc[i * 4 + r] = acc[r];
    }
  };
  auto skey = [&](float s) __attribute__((always_inline)) -> uint32_t {
    s = s + 0.f;
    const uint32_t u_ = __float_as_uint(s);
    return (u_ & 0x80000000u) ? ~u_ : (u_ | 0x80000000u);
  };
  auto mkkey = [&](float s, int key) __attribute__((always_inline)) -> unsigned long long {
    s = s + 0.f;
    uint32_t u_ = __float_as_uint(s);
    u_ = (u_ & 0x80000000u) ? ~u_ : (u_ | 0x80000000u);
    return ((unsigned long long)u_ << 16) | (unsigned long long)(8191 - key);
  };
  auto scan_token = [&](int tk, int level) __attribute__((always_inline)) -> bool {
    const int shift = 40 - 8 * level;
    const uint32_t* hrow = hist + tk * 256;
    const uint4 hv = *(const uint4*)&hrow[252 - 4 * lane];
    const int c = (int)(hv.x + hv.y + hv.z + hv.w);
    int cum = c;
#pragma unroll
    for (int o = 1; o < 64; o <<= 1) {
      int v = __shfl_up(cum, o);
      if (lane >= o) cum += v;
    }
    const int nd = need[tk];
    const unsigned long long mask = __ballot(cum >= nd);
    const int L = mask ? (int)__builtin_ctzll(mask) : 63;
    int running = cum - c, bstar, cb;
    if (running + (int)hv.w >= nd) { bstar = 255 - 4 * lane; cb = hv.w; }
    else {
      running += hv.w;
      if (running + (int)hv.z >= nd) { bstar = 254 - 4 * lane; cb = hv.z; }
      else {
        running += hv.z;
        if (running + (int)hv.y >= nd) { bstar = 253 - 4 * lane; cb = hv.y; }
        else { running += hv.y; bstar = 252 - 4 * lane; cb = hv.x; }
      }
    }
    running = __shfl(running, L); bstar = __shfl(bstar, L); cb = __shfl(cb, L);
    const int nd2 = nd - running;
    const bool fin = (cb == nd2) || (level == 5);
    if (lane == 0) {
      const unsigned long long np = (pfx[tk] << 8) | (unsigned long long)bstar;
      if (fin) { state[tk] = 0; tkey[tk] = np << shift; }
      else { need[tk] = nd2; pfx[tk] = np; }
    }
    return fin;
  };
  auto run_level = [&](int level, bool fillx) __attribute__((always_inline)) {
    const int shift = 40 - 8 * level;
    for (int i = tid; i < 4096; i += 256) hist[i] = 0u;
    __syncthreads();
    {
      const unsigned long long mypfx = pfx[mytok];
      const bool act = state[mytok] == 1 && fastf[mytok] == 0;
      h8 na[2];
      if (wid < nkt) loadk(wid, na);
      for (int kt = wid; kt < nkt; kt += 4) {
        h8 ca[2];
#pragma unroll
        for (int i = 0; i < 2; ++i) ca[i] = na[i];
        loadk(kt + 4 < nkt ? kt + 4 : kt, na);
        float sc[8];
        scores(ca, sc);
        if (act) {
#pragma unroll
          for (int q = 0; q < 8; ++q) {
            const int key = kt * 32 + (q >> 2) * 16 + 4 * hq + (q & 3);
            if (key <= myt) {
              if (level < 2) {
                const uint32_t u32 = skey(sc[q]);
                if (level == 0) {
                  const uint32_t b8 = u32 >> 24;
                  atomicAdd(&hist[mytok * 256 + (int)b8], 1u);
                  if (fillx) {
                    const uint32_t ix = b8 - 0xBEu;
                    if (ix < 3u) {
                      const uint32_t e16 = (ix * 16u + (uint32_t)mytok) * 256u + ((u32 >> 16) & 255u);
                      atomicAdd(&h1w[e16 >> 1], (e16 & 1u) ? 65536u : 1u);
                    }
                  }
                } else if ((u32 >> 24) == (uint32_t)mypfx) atomicAdd(&hist[mytok * 256 + (int)((u32 >> 16) & 255u)], 1u);
              } else {
                const unsigned long long k48 = mkkey(sc[q], key);
                if ((k48 >> (shift + 8)) == mypfx)
                  atomicAdd(&hist[mytok * 256 + (int)((k48 >> shift) & 255ull)], 1u);
              }
            }
          }
        }
      }
    }
    __syncthreads();
    {
      int rem = 0;
      for (int j = 0; j < 4; ++j) {
        const int tk = wid * 4 + j;
        if (state[tk] != 1 || fastf[tk] != 0) continue;
        if (!scan_token(tk, level)) rem++;
      }
      if (lane == 0 && rem) atomicAdd(&nrem[level], rem);
    }
    __syncthreads();
  };

  run_level(0, true);
  if (tid < 16) {
    const int b0 = (int)pfx[tid];
    const int f = (state[tid] == 1 && b0 >= 0xBE && b0 <= 0xC0) ? 1 : 0;
    fastf[tid] = f;
    if (state[tid] == 1 && !f) atomicAdd(&nrem[7], 1);
  }
  __syncthreads();
  if (nrem[7] != 0) run_level(1, false);
  for (int j = 0; j < 4; ++j) {
    const int tk = wid * 4 + j;
    if (state[tk] != 1 || fastf[tk] == 0) continue;
    const uint32_t ix = (uint32_t)pfx[tk] - 0xBEu;
    const unsigned short* hx = (const unsigned short*)h1w + (ix * 16u + (uint32_t)tk) * 256u;
    const ushort4 c4 = *(const ushort4*)&hx[4 * lane];
    uint4 w4;
    w4.x = c4.x; w4.y = c4.y; w4.z = c4.z; w4.w = c4.w;
    *(uint4*)&hist[tk * 256 + 4 * lane] = w4;
    __builtin_amdgcn_wave_barrier();
    scan_token(tk, 1);
  }
  __syncthreads();
  if (tid < 16) fastf[tid] = 0;
  __syncthreads();

  {
    const int st0 = state[mytok];
    const unsigned long long mytk = tkey[mytok];
    const unsigned long long myp16 = pfx[mytok];
    h8 na[2];
    if (wid < nkt) loadk(wid, na);
    for (int kt = wid; kt < nkt; kt += 4) {
      h8 ca[2];
#pragma unroll
      for (int i = 0; i < 2; ++i) ca[i] = na[i];
      loadk(kt + 4 < nkt ? kt + 4 : kt, na);
      float sc[8];
      scores(ca, sc);
#pragma unroll
      for (int q = 0; q < 8; ++q) {
        const int key = kt * 32 + (q >> 2) * 16 + 4 * hq + (q & 3);
        if (key <= myt) {
          const uint32_t u32 = skey(sc[q]);
          bool take, isc = false;
          if (st0 == 0) take = (((unsigned long long)u32 << 16) | (unsigned long long)(8191 - key)) >= mytk;
          else {
            const uint32_t p16 = u32 >> 16;
            take = p16 > (uint32_t)myp16;
            isc = p16 == (uint32_t)myp16;
          }
          if (take) {
            const int pos = atomicAdd(&cnt[mytok], 1);
            if (pos < 256) sel[mytok * 256 + pos] = (unsigned short)key;
          } else if (isc) {
            const int pos = atomicAdd(&ccnt[mytok], 1);
            if (pos < DSA_CAP) cand[mytok * 128 + pos] = ((unsigned long long)u32 << 16) | (unsigned long long)(8191 - key);
          }
        }
      }
    }
  }
  __syncthreads();
  {
    int nov = 0;
    for (int j = 0; j < 4; ++j) {
      const int tk = wid * 4 + j;
      if (state[tk] != 1) continue;
      const int nc = ccnt[tk];
      if (nc > DSA_CAP) {
        nov++;
        if (lane == 0) { ovf[tk] = 1; pf16[tk] = (int)pfx[tk]; }
        continue;
      }
      const int nd = need[tk];
      const unsigned long long k0 = (lane < nc) ? cand[tk * 128 + lane] : 0ull;
      const unsigned long long k1 = (lane + 64 < nc) ? cand[tk * 128 + lane + 64] : 0ull;
      int r0 = 0, r1 = 0;
      for (int q = 0; q < nc; ++q) {
        const unsigned long long kq = cand[tk * 128 + q];
        r0 += (kq > k0) ? 1 : 0;
        r1 += (kq > k1) ? 1 : 0;
      }
      if (lane < nc && r0 < nd) {
        const int pos = atomicAdd(&cnt[tk], 1);
        if (pos < 256) sel[tk * 256 + pos] = (unsigned short)(8191 - (int)(k0 & 0xFFFFull));
      }
      if (lane + 64 < nc && r1 < nd) {
        const int pos = atomicAdd(&cnt[tk], 1);
        if (pos < 256) sel[tk * 256 + pos] = (unsigned short)(8191 - (int)(k1 & 0xFFFFull));
      }
      if (lane == 0) state[tk] = 2;
    }
    if (lane == 0 && nov) atomicAdd(&nrem[6], nov);
  }
  __syncthreads();
  if (nrem[6] != 0) {
    for (int level = 2; level < 6; ++level) {
      run_level(level, false);
      if (nrem[level] == 0) break;
    }
    {
      const bool mine = ovf[mytok] != 0;
      const unsigned long long mytk = tkey[mytok];
      const unsigned long long myp16 = (unsigned long long)(unsigned)pf16[mytok];
      h8 na[2];
      if (wid < nkt) loadk(wid, na);
      for (int kt = wid; kt < nkt; kt += 4) {
        h8 ca[2];
#pragma unroll
        for (int i = 0; i < 2; ++i) ca[i] = na[i];
        loadk(kt + 4 < nkt ? kt + 4 : kt, na);
        float sc[8];
        scores(ca, sc);
        if (mine) {
#pragma unroll
          for (int q = 0; q < 8; ++q) {
            const int key = kt * 32 + (q >> 2) * 16 + 4 * hq + (q & 3);
            if (key <= myt) {
              const unsigned long long k48 = mkkey(sc[q], key);
              if ((k48 >> 32) == myp16 && k48 >= mytk) {
                const int pos = atomicAdd(&cnt[mytok], 1);
                if (pos < 256) sel[mytok * 256 + pos] = (unsigned short)key;
              }
            }
          }
        }
      }
    }
    __syncthreads();
  }
#ifndef DSA_ATT_REP
#define DSA_ATT_REP 1
#endif
  for (int jr = 0; jr < 4 * DSA_ATT_REP; ++jr) {
    const int j = jr & 3;
    const int tk = wid * 4 + j;
    const int t = t0 + tk;
    const int nsel = min(cnt[tk], 256);
    const half_t* urow = ub + (size_t)t * NU;
    const int col = lane & 15;
    h8 q0, q1;
#pragma unroll
    for (int e = 0; e < 8; ++e) { q0[e] = (half_t)0.f; q1[e] = (half_t)0.f; }
    if (col < 8) {
      q0 = *(const h8*)(urow + C_BQ + col * 64 + hq * 8);
      q1 = *(const h8*)(urow + C_BQ + col * 64 + 32 + hq * 8);
    }
    float mx = NEGF;
#pragma unroll 1
    for (int mg = 0; mg < 2; ++mg) {
#pragma unroll
      for (int mm = 0; mm < 8; ++mm) {
        const int m = mg * 8 + mm;
        const int pos = m * 16 + col;
        const int s = (pos < nsel) ? (int)sel[tk * 256 + pos] : 0;
        const half_t* kp = ub + (size_t)s * NU + C_BK + hq * 8;
        const h8 a0 = *(const h8*)kp, a1 = *(const h8*)(kp + 32);
        f32x4 d = {0.f, 0.f, 0.f, 0.f};
        d = __builtin_amdgcn_mfma_f32_16x16x32_f16(a0, q0, d, 0, 0, 0);
        d = __builtin_amdgcn_mfma_f32_16x16x32_f16(a1, q1, d, 0, 0, 0);
#pragma unroll
        for (int r = 0; r < 4; ++r) {
          const int pp = m * 16 + hq * 4 + r;
          const float v = (pp < nsel) ? d[r] * 0.125f : NEGF;
          mx = fmaxf(mx, v);
          if (col < 8) pbuf[pp * 8 + col] = v;
        }
      }
    }
    mx = fmaxf(mx, __shfl_xor(mx, 16));
    mx = fmaxf(mx, __shfl_xor(mx, 32));
    const float mxh = __shfl(mx, lane & 7);
    __builtin_amdgcn_wave_barrier();
    float sum = 0.f;
#pragma unroll 4
    for (int k = 0; k < 32; ++k) {
      const int i = lane + 64 * k;
      const float v = pbuf[i];
      const float e = (v > -1e29f) ? __expf(v - mxh) : 0.f;
      pbuf[i] = e;
      sum += e;
    }
    sum += __shfl_xor(sum, 8);
    sum += __shfl_xor(sum, 16);
    sum += __shfl_xor(sum, 32);
    const float inv = 1.f / sum;
    __builtin_amdgcn_wave_barrier();
    {
      const int rs = lane >> 3, dc = lane & 7;
      float acc[8][8];
#pragma unroll
      for (int h = 0; h < 8; ++h)
#pragma unroll
        for (int e = 0; e < 8; ++e) acc[h][e] = 0.f;
#pragma unroll 1
      for (int g8 = 0; g8 < 4; ++g8) {
        h8 vv[8];
#pragma unroll
        for (int i = 0; i < 8; ++i) {
          const int pos = (g8 * 8 + i) * 8 + rs;
          const int s = (pos < nsel) ? (int)sel[tk * 256 + pos] : 0;
          vv[i] = *(const h8*)(ub + (size_t)s * NU + C_BV + dc * 8);
        }
#pragma unroll
        for (int i = 0; i < 8; ++i) {
          const int pos = (g8 * 8 + i) * 8 + rs;
          const f32x4 pa = *(const f32x4*)&pbuf[pos * 8];
          const f32x4 pb = *(const f32x4*)&pbuf[pos * 8 + 4];
          float vf[8];
#pragma unroll
          for (int e = 0; e < 8; ++e) vf[e] = (float)vv[i][e];
#pragma unroll
          for (int e = 0; e < 8; ++e) {
            acc[0][e] += pa[0] * vf[e]; acc[1][e] += pa[1] * vf[e]; acc[2][e] += pa[2] * vf[e]; acc[3][e] += pa[3] * vf[e];
            acc[4][e] += pb[0] * vf[e]; acc[5][e] += pb[1] * vf[e]; acc[6][e] += pb[2] * vf[e]; acc[7][e] += pb[3] * vf[e];
          }
        }
      }
      half_t* yrow = p.yb() + (size_t)(b * SEQ + t) * 512;
      float v32[4][8], v16[2][8], v8[8];
      const bool b2 = (rs & 4) != 0, b1 = (rs & 2) != 0, b0 = (rs & 1) != 0;
#pragma unroll
      for (int i = 0; i < 4; ++i)
#pragma unroll
        for (int e = 0; e < 8; ++e) {
          const float lo = acc[i][e], hi = acc[4 + i][e];
          v32[i][e] = (b2 ? hi : lo) + __shfl_xor(b2 ? lo : hi, 32);
        }
#pragma unroll
      for (int i = 0; i < 2; ++i)
#pragma unroll
        for (int e = 0; e < 8; ++e) {
          const float lo = v32[i][e], hi = v32[2 + i][e];
          v16[i][e] = (b1 ? hi : lo) + __shfl_xor(b1 ? lo : hi, 16);
        }
#pragma unroll
      for (int e = 0; e < 8; ++e) {
        const float lo = v16[0][e], hi = v16[1][e];
        v8[e] = (b0 ? hi : lo) + __shfl_xor(b0 ? lo : hi, 8);
      }
      {
        const float invh = __shfl(inv, rs);
        const h8 z8 = *(const h8*)(urow + C_BZ + rs * 64 + dc * 8);
        h8 ov;
#pragma unroll
        for (int e = 0; e < 8; ++e) ov[e] = (half_t)(v8[e] * invh * siluf_((float)z8[e]));
        *(h8*)(yrow + rs * 64 + dc * 8) = ov;
      }
    }
    __builtin_amdgcn_wave_barrier();
  }
  __syncthreads();
}

__device__ __forceinline__ void phase2(const KP& p, int l, char* smem, int* q, int xcc) {
  xcd_schedule(q, xcc, 196 * 8, 1, smem, [&](int grp, int) __attribute__((always_inline)) {
    const int y = grp & 7, k = grp >> 3;
    if (k < 4) compress_item(p, l, k * 8 + y, smem);
    else if (k < 132) dsa_item(p, y & 1, 511 - ((k - 4) * 4 + (y >> 1)), smem);
    else pool_item(p, l, (k - 132) * 8 + y, smem);
  });
}

struct DState {
  float m, l;
  f32x16 o[2];
};
#define MLOW (-1e4f)
__device__ __forceinline__ void ds_reset(DState& st) {
  st.m = MLOW; st.l = 0.f;
#pragma unroll
  for (int dt = 0; dt < 2; ++dt)
#pragma unroll
    for (int r = 0; r < 16; ++r) st.o[dt][r] = 0.f;
}
typedef unsigned int u32x4 __attribute__((ext_vector_type(4)));
typedef unsigned int u32x2 __attribute__((ext_vector_type(2)));
struct StageRegs {
  u32x4 k0, k1, v0, v1;
};
template <bool HASV>
__device__ __forceinline__ void load_stage(StageRegs& r, const half_t* __restrict__ Kb, int ldk,
                                           const half_t* __restrict__ VT, int ldv, int key0, int tid) {
  const int row = tid >> 3, c = tid & 7;
  r.k0 = *(const u32x4*)(Kb + (size_t)(key0 + row) * ldk + c * 8);
  r.k1 = *(const u32x4*)(Kb + (size_t)(key0 + row + 32) * ldk + c * 8);
  if (HASV) {
    r.v0 = *(const u32x4*)(VT + (size_t)row * ldv + key0 + c * 8);
    r.v1 = *(const u32x4*)(VT + (size_t)(row + 32) * ldv + key0 + c * 8);
  }
}
template <bool HASV>
__device__ __forceinline__ void write_stage(const StageRegs& r, half_t* Ks, half_t* Vs, int tid) {
  const int row = tid >> 3, c = tid & 7;
  *(u32x4*)&Ks[row * 72 + c * 8] = r.k0;
  *(u32x4*)&Ks[(row + 32) * 72 + c * 8] = r.k1;
  if (HASV) {
    const int ks = c >> 1, a = c & 1;
    u32x2 lo, hi;
    lo[0] = r.v0[0]; lo[1] = r.v0[1]; hi[0] = r.v0[2]; hi[1] = r.v0[3];
    *(u32x2*)&Vs[row * 72 + ks * 16 + a * 4] = lo;
    *(u32x2*)&Vs[row * 72 + ks * 16 + 8 + a * 4] = hi;
    lo[0] = r.v1[0]; lo[1] = r.v1[1]; hi[0] = r.v1[2]; hi[1] = r.v1[3];
    *(u32x2*)&Vs[(row + 32) * 72 + ks * 16 + a * 4] = lo;
    *(u32x2*)&Vs[(row + 32) * 72 + ks * 16 + 8 + a * 4] = hi;
  }
}
template <bool ONLINE, bool HASV, bool FAST, class VF>
__device__ __forceinline__ void dense_block(DState& st, const half_t* Ks, const half_t* Vs, const h8* qf, int key0,
                                            int flag, VF valid, float fixed_m, float fixed_invl, f32x16* pout,
                                            int lane) {
  const int h = lane >> 5, c = lane & 31;
  f32x16 s[2];
#pragma unroll
  for (int kt = 0; kt < 2; ++kt) {
#pragma unroll
    for (int r = 0; r < 16; ++r) s[kt][r] = 0.f;
#pragma unroll
    for (int ks = 0; ks < 4; ++ks) {
      const h8 a = *(const h8*)&Ks[(32 * kt + c) * 72 + 16 * ks + 8 * h];
      s[kt] = __builtin_amdgcn_mfma_f32_32x32x16_f16(a, qf[ks], s[kt], 0, 0, 0);
    }
  }
  float cm = NEGF;
#pragma unroll
  for (int kt = 0; kt < 2; ++kt)
#pragma unroll
    for (int r = 0; r < 16; ++r) {
      const int key = key0 + 32 * kt + (r & 3) + 8 * (r >> 2) + 4 * h;
      const float v = (FAST ? (flag != 0) : valid(key, flag)) ? s[kt][r] : NEGF;
      s[kt][r] = v;
      cm = fmaxf(cm, v);
    }
  float mnew;
  if (ONLINE) {
    cm = fmaxf(cm, __shfl_xor(cm, 32));
    mnew = st.m;
    if (__ballot(cm > st.m + 8.0f) != 0ull) {
      mnew = fmaxf(st.m, cm);
      const float alpha = __builtin_amdgcn_exp2f(st.m - mnew);
      st.m = mnew;
      st.l *= alpha;
      if (HASV) {
#pragma unroll
        for (int dt = 0; dt < 2; ++dt)
#pragma unroll
          for (int r = 0; r < 16; ++r) st.o[dt][r] *= alpha;
      }
    }
  } else {
    mnew = fixed_m;
  }
  float ps = 0.f;
#pragma unroll
  for (int kt = 0; kt < 2; ++kt)
#pragma unroll
    for (int r = 0; r < 16; ++r) {
      float e = __builtin_amdgcn_exp2f(s[kt][r] - mnew);
      if (!ONLINE) e *= fixed_invl;
      s[kt][r] = e;
      ps += e;
    }
  st.l += ps;
  if (pout) { pout[0] = s[0]; pout[1] = s[1]; }
  if (HASV) {
#pragma unroll
    for (int ks = 0; ks < 4; ++ks) {
      h8 pf;
#pragma unroll
      for (int jj = 0; jj < 8; ++jj) pf[jj] = (half_t)s[ks >> 1][8 * (ks & 1) + jj];
#pragma unroll
      for (int dt = 0; dt < 2; ++dt) {
        const h8 vf = *(const h8*)&Vs[(32 * dt + c) * 72 + 16 * ks + 8 * h];
        st.o[dt] = __builtin_amdgcn_mfma_f32_32x32x16_f16(vf, pf, st.o[dt], 0, 0, 0);
      }
    }
  }
}
template <bool ONLINE, bool HASV, bool WANTP, class PRE, class FU, class VF, class PO>
__device__ __forceinline__ void run_dense(DState& st, const half_t* __restrict__ Kb, int ldk,
                                          const half_t* __restrict__ VT, int ldv, int blk_lo, int blk_hi, const h8* qf,
                                          PRE pre, FU full, VF valid, float fixed_m, float fixed_invl, PO post, char* smem,
                                          int tid) {
  half_t* Ks = (half_t*)smem;
  half_t* Vs = Ks + 64 * 72;
  const int lane = tid & 63;
  StageRegs sr;
  load_stage<HASV>(sr, Kb, ldk, VT, ldv, blk_lo * 64, tid);
  for (int blk = blk_lo; blk <= blk_hi; ++blk) {
    __syncthreads();
    write_stage<HASV>(sr, Ks, Vs, tid);
    __syncthreads();
    const int nb = blk < blk_hi ? blk + 1 : blk;
    load_stage<HASV>(sr, Kb, ldk, VT, ldv, nb * 64, tid);
    const int flag = pre(blk);
    if (__ballot(flag != 0) != 0ull) {
      f32x16 pp[2];
      if (full(blk))
        dense_block<ONLINE, HASV, true>(st, Ks, Vs, qf, blk * 64, flag, valid, fixed_m, fixed_invl,
                                        WANTP ? pp : (f32x16*)nullptr, lane);
      else
        dense_block<ONLINE, HASV, false>(st, Ks, Vs, qf, blk * 64, flag, valid, fixed_m, fixed_invl,
                                         WANTP ? pp : (f32x16*)nullptr, lane);
      if (WANTP) post(blk * 64, pp);
    }
  }
}

__device__ __forceinline__ void nsa_item(const KP& p, int b, int g, int tile, char* smem) {
  int tid = threadIdx.x;
  asm volatile("" : "+v"(tid));
  const int lane = tid & 63, wid = tid >> 6;
  const int t0 = tile * 32;
  const int tw0 = t0 + 8 * wid;
  const int col = lane & 31, h = lane >> 5;
  const int j = col >> 2, r4 = col & 3;
  const int tj = tw0 + j;
  const int head = g * 4 + r4;
  float* impA = (float*)(smem + 18432 + wid * 8320);
  float* impB = impA + 1024;
  unsigned long long* msk = (unsigned long long*)(smem + 18432 + 4 * 8320 + wid * 128);
  uint32_t* kbuf = (uint32_t*)(smem + 18432 + 4 * 8320 + 512 + wid * 512);
  const half_t* ub = p.u() + (size_t)b * SEQ * NU;
  const half_t* urow = ub + (size_t)tj * NU;
  h8 qf[4];
#pragma unroll
  for (int ks = 0; ks < 4; ++ks) {
    qf[ks] = *(const h8*)(urow + C_CQ + head * 64 + 16 * ks + 8 * h);
#pragma unroll
    for (int e = 0; e < 8; ++e) qf[ks][e] = (half_t)((float)qf[ks][e] * 0.18033688f);
  }
  float gate[3];
#pragma unroll
  for (int i = 0; i < 3; ++i) gate[i] = sigmoidf_((float)urow[C_CG + head * 3 + i]);
  f32x16 res[2];
#pragma unroll
  for (int dt = 0; dt < 2; ++dt)
#pragma unroll
    for (int r = 0; r < 16; ++r) res[dt][r] = 0.f;
  for (int i = lane; i < 2080; i += 64) impA[i] = 0.f;
  DState st;
  auto nopost = [&](int, f32x16*) __attribute__((always_inline)) {};

  {
    const int nmax_j = (tj >= 31) ? ((tj - 31) >> 4) : -1;
    const int bhi = (t0 >> 4) >> 6;
    const half_t* Kc = p.kcmp() + (size_t)(b * 2 + g) * 512 * 64;
    const half_t* Vc = p.vcmpT() + (size_t)(b * 2 + g) * 64 * 512;
    auto pre = [&](int) __attribute__((always_inline)) { return 1; };
    const int nmax_w = (tw0 >= 31) ? ((tw0 - 31) >> 4) : -1;
    auto fullc = [&](int blk) __attribute__((always_inline)) { return blk * 64 + 63 <= nmax_w; };
    auto vfn = [&](int n, int) __attribute__((always_inline)) { return n <= nmax_j; };
    ds_reset(st);
    run_dense<true, false, false>(st, Kc, 64, (const half_t*)nullptr, 0, 0, bhi, qf, pre, fullc, vfn, 0.f, 0.f, nopost, smem, tid);
    float lt = st.l;
    lt += __shfl_xor(lt, 32);
    const float mfix = st.m;
    const float invl = lt > 0.f ? 1.f / lt : 0.f;
    ds_reset(st);
    auto post = [&](int n0, f32x16* pp) __attribute__((always_inline)) {
#pragma unroll
      for (int kt = 0; kt < 2; ++kt)
#pragma unroll
        for (int qd = 0; qd < 4; ++qd) {
          float a = pp[kt][4 * qd] + pp[kt][4 * qd + 1] + pp[kt][4 * qd + 2] + pp[kt][4 * qd + 3];
          float bb = pp[kt][4 * qd + 3];
          a += dpp_quad<0xB1>(a); a += dpp_quad<0x4E>(a);
          bb += dpp_quad<0xB1>(bb); bb += dpp_quad<0x4E>(bb);
          if (r4 == 0) {
            const int sblk = (n0 >> 2) + 8 * kt + 2 * qd + h;
            impA[j * 128 + sblk] = a;
            impB[j * 132 + sblk + 1] = bb;
          }
        }
    };
    run_dense<false, true, true>(st, Kc, 64, Vc, 512, 0, bhi, qf, pre, fullc, vfn, mfix, invl, post, smem, tid);
#pragma unroll
    for (int dt = 0; dt < 2; ++dt)
#pragma unroll
      for (int r = 0; r < 16; ++r) res[dt][r] += gate[0] * st.o[dt][r];
  }
  __builtin_amdgcn_wave_barrier();
#pragma unroll 1
  for (int jj = 0; jj < 8; ++jj) {
    const int t = tw0 + jj;
    const int blk = t >> 6;
    uint32_t k0, k1;
    {
      const int s0 = lane, s1 = lane + 64;
      const float i0 = impA[jj * 128 + s0] + impB[jj * 132 + s0];
      const float i1 = impA[jj * 128 + s1] + impB[jj * 132 + s1];
      auto mk = [&](float im, int s) __attribute__((always_inline)) -> uint32_t {
        if (s > blk) return 0u;
        uint32_t kk = ((__float_as_uint(im) >> 1) & ~127u) | (uint32_t)(127 - s) | 0x40000000u;
        if (s == 0 || s == blk || s == blk - 1) kk |= 0x80000000u;
        return kk;
      };
      k0 = mk(i0, s0); k1 = mk(i1, s1);
    }
    kbuf[lane] = k0;
    kbuf[lane + 64] = k1;
    __builtin_amdgcn_wave_barrier();
    int r0 = 0, r1 = 0;
#pragma unroll 4
    for (int qd = 0; qd < 32; ++qd) {
      const uint4 kq = *(const uint4*)&kbuf[4 * qd];
      r0 += (kq.x > k0) + (kq.y > k0) + (kq.z > k0) + (kq.w > k0);
      r1 += (kq.x > k1) + (kq.y > k1) + (kq.z > k1) + (kq.w > k1);
    }
    const unsigned long long lo = __ballot(k0 != 0u && r0 < 16);
    const unsigned long long hi = __ballot(k1 != 0u && r1 < 16);
    __builtin_amdgcn_wave_barrier();
    if (lane == 0) { msk[jj * 2] = lo; msk[jj * 2 + 1] = hi; }
  }
  __builtin_amdgcn_wave_barrier();
  const unsigned long long mylo = msk[j * 2], myhi = msk[j * 2 + 1];
  {
    const half_t* Ksel = ub + C_CKS + g * 64;
    const half_t* Vsel = p.vsT() + (size_t)(b * 2 + g) * 64 * SEQ;
    auto pre = [&](int blk) __attribute__((always_inline)) {
      const unsigned long long mm_ = (blk < 64) ? mylo : myhi;
      return (int)((mm_ >> (blk & 63)) & 1ull);
    };
    auto vfn = [&](int key, int flag) __attribute__((always_inline)) { return flag != 0 && key <= tj; };
    ds_reset(st);
    auto fulls = [&](int blk) __attribute__((always_inline)) { return blk * 64 + 63 <= tw0; };
    run_dense<true, true, false>(st, Ksel, NU, Vsel, SEQ, 0, (t0 + 31) >> 6, qf, pre, fulls, vfn, 0.f, 0.f, nopost, smem, tid);
    float lt = st.l;
    lt += __shfl_xor(lt, 32);
    const float sc = lt > 0.f ? gate[1] / lt : 0.f;
#pragma unroll
    for (int dt = 0; dt < 2; ++dt)
#pragma unroll
      for (int r = 0; r < 16; ++r) res[dt][r] += sc * st.o[dt][r];
  }
  {
    const half_t* Kw = ub + C_CKW + g * 64;
    const half_t* Vw = p.vwT() + (size_t)(b * 2 + g) * 64 * SEQ;
    auto pre = [&](int blk) __attribute__((always_inline)) {
      return (int)((blk * 64 <= tj) && (blk * 64 + 63 > tj - 512));
    };
    auto vfn = [&](int key, int) __attribute__((always_inline)) { return key <= tj && key > tj - 512; };
    ds_reset(st);
    auto fullw = [&](int blk) __attribute__((always_inline)) { return blk * 64 + 63 <= tw0 && blk * 64 > tw0 + 7 - 512; };
    run_dense<true, true, false>(st, Kw, NU, Vw, SEQ, max(0, t0 - 511) >> 6, (t0 + 31) >> 6, qf, pre, fullw, vfn, 0.f, 0.f,
                                 nopost, smem, tid);
    float lt = st.l;
    lt += __shfl_xor(lt, 32);
    const float sc = lt > 0.f ? gate[2] / lt : 0.f;
#pragma unroll
    for (int dt = 0; dt < 2; ++dt)
#pragma unroll
      for (int r = 0; r < 16; ++r) res[dt][r] += sc * st.o[dt][r];
  }
  half_t* yrow = p.yc() + (size_t)(b * SEQ + tj) * 512 + head * 64;
#pragma unroll
  for (int dt = 0; dt < 2; ++dt)
#pragma unroll
    for (int qd = 0; qd < 4; ++qd) {
      const int d = 32 * dt + 8 * qd + 4 * h;
      const h4 z = *(const h4*)(urow + C_CZ + head * 64 + d);
      h4 ov;
#pragma unroll
      for (int e = 0; e < 4; ++e) ov[e] = (half_t)(res[dt][4 * qd + e] * siluf_((float)z[e]));
      *(h4*)(yrow + d) = ov;
    }
  __syncthreads();
}

__device__ __forceinline__ void phase_nsa(const KP& p, char* smem, int* q, int xcc) {
  xcd_schedule(q, xcc, 1024, 1, smem, [&](int grp, int) __attribute__((always_inline)) {
    const int y = grp & 7, k = grp >> 3;
    const int b = y & 1, g = (y >> 1) & 1, tile = 255 - (k * 2 + (y >> 2));
    nsa_item(p, b, g, tile, smem);
  });
}

__device__ __forceinline__ void phase_merge(const KP& p, char* smem, int* q, int xcc) {
  xcd_schedule(q, xcc, 16, 64, smem, [&](int grp, int within) __attribute__((always_inline)) {
    const int mt = (grp & 15) * 8 + (within & 7), nt = (within >> 3);
    const int m0 = mt * 128, n0 = nt * 128;
    f32x16 tot[2][2];
#pragma unroll
    for (int i = 0; i < 2; ++i)
#pragma unroll
      for (int jn = 0; jn < 2; ++jn)
#pragma unroll
        for (int r = 0; r < 16; ++r) tot[i][jn][r] = 0.f;
#pragma unroll 1
    for (int br = 0; br < 3; ++br) {
      const half_t* A = (br == 0 ? p.ya() : (br == 1 ? p.yb() : p.yc())) + (size_t)m0 * 512;
      const half_t* B = p.wpT() + (size_t)br * DM * 512 + (size_t)n0 * 512;
      const half_t* G = p.u() + (size_t)m0 * NU + C_GM + br * 1024 + n0;
      gemm_tile<2>(
          512, [&](int r, int k) { return *(const uint4*)(A + (size_t)r * 512 + k); },
          [&](int r, int k) { return *(const uint4*)(B + (size_t)r * 512 + k); },
          [&](int mi, int ni, int r, int row, int col, float v) {
            const float gz = (float)G[(size_t)row * NU + col];
            tot[mi][ni][r] += sigmoidf_(gz) * v;
          },
          smem);
    }
    int tidx = threadIdx.x;
    asm volatile("" : "+v"(tidx));
    const int lane = tidx & 63, wid = tidx >> 6, wm = wid >> 1, wn = wid & 1;
#pragma unroll
    for (int mi = 0; mi < 2; ++mi)
#pragma unroll
      for (int ni = 0; ni < 2; ++ni)
#pragma unroll
        for (int r = 0; r < 16; ++r) {
          const int row = wm * 64 + mi * 32 + (r & 3) + 8 * (r >> 2) + 4 * (lane >> 5);
          const int col = wn * 64 + ni * 32 + (lane & 31);
          p.mm()[(size_t)(m0 + row) * DM + n0 + col] = (half_t)tot[mi][ni][r];
        }
  });
}

__device__ __forceinline__ void phase_outproj(const KP& p, char* smem, int* q, int xcc) {
  xcd_schedule(q, xcc, 8, 64, smem, [&](int grp, int within) __attribute__((always_inline)) {
    const int mt = grp * 8 + (within & 7), nt = (within >> 3);
    const int m0 = mt * 256, n0 = nt * 128;
    const half_t* A = p.mm() + (size_t)m0 * DM;
    const half_t* B = p.woT() + (size_t)n0 * DM;
    gemm_tile_big(
        DM, [&](int r, int k) { return *(const uint4*)(A + (size_t)r * DM + k); },
        [&](int r, int k) { return *(const uint4*)(B + (size_t)r * DM + k); },
        [&](int mi, int ni, int r, int row, int col, float v) {
          const size_t xi = (size_t)(m0 + row) * DM + n0 + col;
          ((float*)p.u())[xi] = ALPHA_F * p.xr()[xi] + v;
        },
        smem);
  });
}

#define XB_TMO      128
#define XB_XCNT(j)  (256  + 64 * (j))
#define XB_XSUB(j)  (1280 + 64 * (j))
#define XB_XGEN(j)  (2304 + 64 * (j))
#define XB_TOP      3328
#define XB_TOPGEN   3392
#define XCD_BAR_WORDS 3456
#define XB_SPIN_CAP (1u << 20)
#define LAS __attribute__((address_space(3)))
__device__ __forceinline__ unsigned xb_ld(unsigned* p)              { return __hip_atomic_load(p, __ATOMIC_RELAXED, __HIP_MEMORY_SCOPE_AGENT); }
__device__ __forceinline__ unsigned xb_add(unsigned* p, unsigned v) { return __hip_atomic_fetch_add(p, v, __ATOMIC_RELAXED, __HIP_MEMORY_SCOPE_AGENT); }
__device__ __forceinline__ unsigned xb_xcc_id() { return (unsigned)__builtin_amdgcn_s_getreg((3 << 11) | 20) & 0xFu; }
#define XB_SPIN(cond, bar) do { unsigned _sp = 0; while (cond) { __builtin_amdgcn_s_sleep(1); \
    if ((++_sp & 255u) == 0u) { if (xb_ld(&(bar)[XB_TMO])) break; if (_sp > XB_SPIN_CAP) { atomicAdd(&(bar)[XB_TMO], 1u); break; } } } } while (0)
struct XcdBarrier { unsigned* bar; unsigned x; volatile LAS unsigned* st; };
__device__ __forceinline__ XcdBarrier xcd_barrier_post(unsigned* bar, volatile LAS unsigned* st) {
  XcdBarrier b; b.bar = bar; b.x = xb_xcc_id(); b.st = st;
  if (threadIdx.x == 0) (void)xb_add(&bar[XB_XCNT(b.x)], 1u);
  return b;
}
__device__ __forceinline__ void xcd_barrier_complete(unsigned* bar, unsigned x, unsigned& nloc, unsigned& nx) {
  const unsigned G = gridDim.x * gridDim.y * gridDim.z;
  unsigned sum, cnt, mine, sp = 0u;
  for (;;) {
    sum = 0u; cnt = 0u; mine = 0u;
#pragma unroll
    for (unsigned j = 0; j < 16; ++j) { const unsigned c = xb_ld(&bar[XB_XCNT(j)]); sum += c; cnt += (c > 0u) ? 1u : 0u; mine = (j == x) ? c : mine; }
    if (sum == G) break;
    __builtin_amdgcn_s_sleep(1);
    if ((++sp & 255u) == 0u) { if (xb_ld(&bar[XB_TMO])) break; if (sp > XB_SPIN_CAP) { atomicAdd(&bar[XB_TMO], 1u); break; } }
  }
  nloc = mine > 0u ? mine : 1u; nx = cnt > 0u ? cnt : 1u;
}
__device__ __forceinline__ void xcd_barrier(const XcdBarrier& b) {
  asm volatile("s_waitcnt vmcnt(0)" ::: "memory");
  __syncthreads();
  if (threadIdx.x == 0) {
    unsigned* bar = b.bar;
    __builtin_amdgcn_s_waitcnt(0);
    unsigned nloc = b.st[0], nx = b.st[1];
    if (nloc == 0u) { xcd_barrier_complete(bar, b.x, nloc, nx); b.st[0] = nloc; b.st[1] = nx; }
    const unsigned old = xb_add(&bar[XB_XSUB(b.x)], 1u);
    const unsigned gen = old / nloc;
    if (old + 1u == (gen + 1u) * nloc) {
      __builtin_amdgcn_fence(__ATOMIC_RELEASE, "agent");
      asm volatile("s_waitcnt vmcnt(0)" ::: "memory");
      const unsigned og = xb_add(&bar[XB_TOP], 1u);
      const unsigned tg = og / nx;
      if (og + 1u == (tg + 1u) * nx) xb_add(&bar[XB_TOPGEN], 1u);
      else XB_SPIN(xb_ld(&bar[XB_TOPGEN]) == tg, bar);
      __builtin_amdgcn_fence(__ATOMIC_ACQUIRE, "agent");
      xb_add(&bar[XB_XGEN(b.x)], 1u);
      asm volatile("s_waitcnt vmcnt(0)" ::: "memory");
    } else {
      XB_SPIN(xb_ld(&bar[XB_XGEN(b.x)]) == gen, bar);
      __builtin_amdgcn_fence(__ATOMIC_ACQUIRE, "agent");
      asm volatile("s_waitcnt vmcnt(0)" ::: "memory");
    }
  }
  __syncthreads();
}

#define NQ_WORDS 4096
__global__ void __launch_bounds__(256, 2) fwd_megakernel(Params p_unused) {
  cg::grid_group grid = cg::this_grid();
  __shared__ __attribute__((aligned(16))) char smem[SMEM_BYTES];
  volatile LAS unsigned* st = (volatile LAS unsigned*)(smem + SMEM_BYTES - 32);
  if (threadIdx.x == 0) { st[0] = 0u; st[1] = 0u; }
  __syncthreads();
  if (gridDim.y == 4242u) grid.sync();
  XcdBarrier xb;
  {
    const KP p = get_params();
    xb = xcd_barrier_post((unsigned*)p.counters() + NQ_WORDS, st);
    ln_rows(p, -1, false);
    prep_weights(p, 0, smem);
  }
  xcd_barrier(xb);
  const int xcc = (int)(xb.x & 7u);
#ifndef REP1
#define REP1 1
#define REP2 1
#define REP3 1
#define REP4 1
#endif
#ifndef REP5
#define REP5 1
#define REP6 1
#define REP7 0
#endif
#pragma unroll 1
  for (int l = 0; l < DEPTH; ++l) {
#define QPTR(ph, rep) (p.counters() + ((l * 6 + (ph)) * 4 + (rep)) * 32)
    for (int rep = 0; rep < REP1; ++rep) { const KP p = get_params(); phase_inproj(p, l, smem, QPTR(0, rep), xcc); }
    xcd_barrier(xb);
    for (int rep = 0; rep < REP2; ++rep) { const KP p = get_params(); phase2(p, l, smem, QPTR(1, rep), xcc); }
    xcd_barrier(xb);
    for (int rep = 0; rep < REP3; ++rep) { const KP p = get_params(); phase_nsa(p, smem, QPTR(2, rep), xcc); }
    xcd_barrier(xb);
    for (int rep = 0; rep < REP4; ++rep) { const KP p = get_params(); phase_merge(p, smem, QPTR(3, rep), xcc); }
    xcd_barrier(xb);
    for (int rep = 0; rep < REP5; ++rep) { const KP p = get_params(); phase_outproj(p, smem, QPTR(4, rep), xcc); }
    xcd_barrier(xb);
    for (int rep = 0; rep < REP6; ++rep) {
      const KP p = get_params();
      if (l + 1 < DEPTH) {
        ln_rows(p, l, false);
        prep_weights(p, l + 1, smem);
      } else {
        ln_rows(p, l, true);
      }
    }
    if (l + 1 < DEPTH) xcd_barrier(xb);
    for (int rep = 0; rep < REP7; ++rep) xcd_barrier(xb);
  }
}

extern "C" void kernel_launch(void* const* d_in, const int* in_sizes, int n_in, void* d_out, int out_size,
                              void* d_ws, size_t ws_size, hipStream_t stream) {
  static int grid_blocks = 0;
  if (!grid_blocks) {
    int dev = 0, cus = 0, per_cu = 0;
    (void)hipGetDevice(&dev);
    (void)hipDeviceGetAttribute(&cus, hipDeviceAttributeMultiprocessorCount, dev);
    (void)hipOccupancyMaxActiveBlocksPerMultiprocessor(&per_cu, fwd_megakernel, 256, 0);
    if (per_cu > 2) per_cu = 2;
    if (per_cu < 1) per_cu = 1;
    grid_blocks = cus * per_cu;
  }
  Params p{};
  p.x = (const float*)d_in[0]; p.w_in = (const float*)d_in[1]; p.b_in = (const float*)d_in[2];
  p.pool_w = (const float*)d_in[3]; p.pool_b = (const float*)d_in[4]; p.pool_scale = (const float*)d_in[5];
  p.pos_k = (const float*)d_in[6]; p.pos_v = (const float*)d_in[7]; p.w1k = (const float*)d_in[8];
  p.w2k = (const float*)d_in[9]; p.w1v = (const float*)d_in[10]; p.w2v = (const float*)d_in[11];
  p.wpa = (const float*)d_in[12]; p.wpb = (const float*)d_in[13]; p.wpc = (const float*)d_in[14];
  p.wo = (const float*)d_in[15]; p.ln_g = (const float*)d_in[16]; p.ln_b = (const float*)d_in[17];
  p.out = (float*)d_out;
  p.ws = (char*)d_ws;
  if (WS_TOTAL > ws_size) { fprintf(stderr, "workspace too small: need %zu have %zu\n", (size_t)WS_TOTAL, ws_size); return; }
  (void)hipMemsetAsync((char*)d_ws + OFF_counters, 0, (size_t)(NQ_WORDS + XCD_BAR_WORDS) * 4, stream);
  void* args[] = {&p};
  hipError_t e = hipLaunchCooperativeKernel((void*)fwd_megakernel, dim3(grid_blocks), dim3(256), args, 0, stream);
  if (e != hipSuccess) fprintf(stderr, "cooperative launch failed: %s (grid %d)\n", hipGetErrorString(e), grid_blocks);
}
```

```cpp
#include <hip/hip_runtime.h>
#include <hip/hip_cooperative_groups.h>
#include <cstdio>
#include <cstdint>
namespace cg = cooperative_groups;

typedef _Float16 half_t;
typedef _Float16 h8 __attribute__((ext_vector_type(8)));
typedef _Float16 h4 __attribute__((ext_vector_type(4)));
typedef float f32x4 __attribute__((ext_vector_type(4)));
typedef float f32x16 __attribute__((ext_vector_type(16)));

#define SEQ 8192
#define DM 1024
#define NTOK 16384
#define DEPTH 4
#define NIN 7360
#define NU 7424
#define ALPHA_F 1.681792830507429f
#define NEGF (-1e30f)

#define C_AX 0
#define C_AZ 512
#define C_BQ 1024
#define C_BZ 1536
#define C_CQ 2048
#define C_CZ 2560
#define C_GM 3072
#define C_IQ 6144
#define C_CKC 6400
#define C_CVC 6528
#define C_CKS 6656
#define C_CVS 6784
#define C_CKW 6912
#define C_CVW 7040
#define C_BK 7168
#define C_BV 7232
#define C_IK 7296
#define C_IW 7328
#define C_CG 7336

#define SMEM_BYTES 73728

constexpr size_t OFF_xr = 0;
constexpr size_t OFF_xh = OFF_xr + (((size_t)NTOK*DM*4 + 255) & ~(size_t)255);
constexpr size_t OFF_u = OFF_xh + (((size_t)NTOK*DM*2 + 255) & ~(size_t)255);
constexpr size_t OFF_winT = OFF_u + (((size_t)NTOK*NU*2 + 255) & ~(size_t)255);
constexpr size_t OFF_wpT = OFF_winT + (((size_t)NU*DM*2 + 255) & ~(size_t)255);
constexpr size_t OFF_woT = OFF_wpT + (((size_t)3*DM*512*2 + 255) & ~(size_t)255);
constexpr size_t OFF_poolT = OFF_woT + (((size_t)DM*DM*2 + 255) & ~(size_t)255);
constexpr size_t OFF_w1T = OFF_poolT + (((size_t)4*128*128*2 + 255) & ~(size_t)255);
constexpr size_t OFF_posb = OFF_w1T + (((size_t)2*64*2048*2 + 255) & ~(size_t)255);
constexpr size_t OFF_vsT = OFF_posb + (((size_t)512 + 255) & ~(size_t)255);
constexpr size_t OFF_vwT = OFF_vsT + (((size_t)4*64*SEQ*2 + 255) & ~(size_t)255);
constexpr size_t OFF_kcmp = OFF_vwT + (((size_t)4*64*SEQ*2 + 255) & ~(size_t)255);
constexpr size_t OFF_vcmpT = OFF_kcmp + (((size_t)4*512*64*2 + 255) & ~(size_t)255);
constexpr size_t OFF_ya = OFF_vcmpT + (((size_t)4*64*512*2 + 255) & ~(size_t)255);
constexpr size_t OFF_yb = OFF_ya + (((size_t)NTOK*512*2 + 255) & ~(size_t)255);
constexpr size_t OFF_yc = OFF_yb + (((size_t)NTOK*512*2 + 255) & ~(size_t)255);
constexpr size_t OFF_mm = OFF_yc + (((size_t)NTOK*512*2 + 255) & ~(size_t)255);
constexpr size_t OFF_counters = OFF_mm + (((size_t)NTOK*DM*2 + 255) & ~(size_t)255);
constexpr size_t WS_TOTAL = OFF_counters + (((size_t)32768 + 255) & ~(size_t)255);
struct Params {
  const float* x; const float* w_in; const float* b_in; const float* pool_w; const float* pool_b;
  const float* pool_scale; const float* pos_k; const float* pos_v; const float* w1k; const float* w2k;
  const float* w1v; const float* w2v; const float* wpa; const float* wpb; const float* wpc;
  const float* wo; const float* ln_g; const float* ln_b;
  float* out;
  char* ws;
};
typedef const __attribute__((address_space(4))) unsigned long long* kargp_t;
struct KP {
  kargp_t kp;
  __device__ __forceinline__ const float* x() const { return (const float*)(const __attribute__((address_space(1))) float*)kp[0]; }
  __device__ __forceinline__ const float* w_in() const { return (const float*)(const __attribute__((address_space(1))) float*)kp[1]; }
  __device__ __forceinline__ const float* b_in() const { return (const float*)(const __attribute__((address_space(1))) float*)kp[2]; }
  __device__ __forceinline__ const float* pool_w() const { return (const float*)(const __attribute__((address_space(1))) float*)kp[3]; }
  __device__ __forceinline__ const float* pool_b() const { return (const float*)(const __attribute__((address_space(1))) float*)kp[4]; }
  __device__ __forceinline__ const float* pool_scale() const { return (const float*)(const __attribute__((address_space(1))) float*)kp[5]; }
  __device__ __forceinline__ const float* pos_k() const { return (const float*)(const __attribute__((address_space(1))) float*)kp[6]; }
  __device__ __forceinline__ const float* pos_v() const { return (const float*)(const __attribute__((address_space(1))) float*)kp[7]; }
  __device__ __forceinline__ const float* w1k() const { return (const float*)(const __attribute__((address_space(1))) float*)kp[8]; }
  __device__ __forceinline__ const float* w2k() const { return (const float*)(const __attribute__((address_space(1))) float*)kp[9]; }
  __device__ __forceinline__ const float* w1v() const { return (const float*)(const __attribute__((address_space(1))) float*)kp[10]; }
  __device__ __forceinline__ const float* w2v() const { return (const float*)(const __attribute__((address_space(1))) float*)kp[11]; }
  __device__ __forceinline__ const float* wpa() const { return (const float*)(const __attribute__((address_space(1))) float*)kp[12]; }
  __device__ __forceinline__ const float* wpb() const { return (const float*)(const __attribute__((address_space(1))) float*)kp[13]; }
  __device__ __forceinline__ const float* wpc() const { return (const float*)(const __attribute__((address_space(1))) float*)kp[14]; }
  __device__ __forceinline__ const float* wo() const { return (const float*)(const __attribute__((address_space(1))) float*)kp[15]; }
  __device__ __forceinline__ const float* ln_g() const { return (const float*)(const __attribute__((address_space(1))) float*)kp[16]; }
  __device__ __forceinline__ const float* ln_b() const { return (const float*)(const __attribute__((address_space(1))) float*)kp[17]; }
  __device__ __forceinline__ float* out() const { return (float*)(__attribute__((address_space(1))) float*)kp[18]; }
  __device__ __forceinline__ char* ws() const { return (char*)(__attribute__((address_space(1))) char*)kp[19]; }
  __device__ __forceinline__ float* xr() const { return (float*)(ws() + OFF_xr); }
  __device__ __forceinline__ half_t* xh() const { return (half_t*)(ws() + OFF_xh); }
  __device__ __forceinline__ half_t* u() const { return (half_t*)(ws() + OFF_u); }
  __device__ __forceinline__ half_t* winT() const { return (half_t*)(ws() + OFF_winT); }
  __device__ __forceinline__ half_t* wpT() const { return (half_t*)(ws() + OFF_wpT); }
  __device__ __forceinline__ half_t* woT() const { return (half_t*)(ws() + OFF_woT); }
  __device__ __forceinline__ half_t* poolT() const { return (half_t*)(ws() + OFF_poolT); }
  __device__ __forceinline__ half_t* w1T() const { return (half_t*)(ws() + OFF_w1T); }
  __device__ __forceinline__ float* posb() const { return (float*)(ws() + OFF_posb); }
  __device__ __forceinline__ half_t* vsT() const { return (half_t*)(ws() + OFF_vsT); }
  __device__ __forceinline__ half_t* vwT() const { return (half_t*)(ws() + OFF_vwT); }
  __device__ __forceinline__ half_t* kcmp() const { return (half_t*)(ws() + OFF_kcmp); }
  __device__ __forceinline__ half_t* vcmpT() const { return (half_t*)(ws() + OFF_vcmpT); }
  __device__ __forceinline__ half_t* ya() const { return (half_t*)(ws() + OFF_ya); }
  __device__ __forceinline__ half_t* yb() const { return (half_t*)(ws() + OFF_yb); }
  __device__ __forceinline__ half_t* yc() const { return (half_t*)(ws() + OFF_yc); }
  __device__ __forceinline__ half_t* mm() const { return (half_t*)(ws() + OFF_mm); }
  __device__ __forceinline__ int* counters() const { return (int*)(ws() + OFF_counters); }
};
__device__ __forceinline__ KP get_params() {
  KP q;
  q.kp = (kargp_t)__builtin_amdgcn_kernarg_segment_ptr();
  asm volatile("" : "+s"(q.kp));
  return q;
}


__device__ __forceinline__ int orig_col(int n) {
  if (n < 1536) return n;
  if (n < 2048) return 1664 + (n - 1536);
  if (n < 2560) return 2472 + (n - 2048);
  if (n < 3072) return 3776 + (n - 2560);
  if (n < 6144) return 4288 + (n - 3072);
  if (n < 6400) return 2176 + (n - 6144);
  if (n < 7168) return 2984 + (n - 6400);
  if (n < 7296) return 1536 + (n - 7168);
  if (n < 7328) return 2432 + (n - 7296);
  if (n < 7336) return 2464 + (n - 7328);
  if (n < 7360) return 3752 + (n - 7336);
  return -1;
}

__device__ __forceinline__ float wave_sum(float v) {
#pragma unroll
  for (int o = 32; o > 0; o >>= 1) v += __shfl_xor(v, o);
  return v;
}
template <int CTRL>
__device__ __forceinline__ float dpp_quad(float v) {
  return __uint_as_float((unsigned)__builtin_amdgcn_update_dpp(0, (int)__float_as_uint(v), CTRL, 0xF, 0xF, true));
}
__device__ __forceinline__ float sigmoidf_(float x) { return 1.f / (1.f + __expf(-x)); }
__device__ __forceinline__ float siluf_(float x) { return x / (1.f + __expf(-x)); }

template <int NI, class LA, class LB, class EP>
__device__ __forceinline__ void gemm_tile(int K, LA loadA, LB loadB, EP epi, char* smem) {
  constexpr int BN = NI * 64;
  constexpr int NB = BN / 32;
  half_t* sA = (half_t*)smem;
  half_t* sB = sA + 128 * 72;
  int tid = threadIdx.x;
  asm volatile("" : "+v"(tid));
  const int lane = tid & 63, wid = tid >> 6;
  const int wm = wid >> 1, wn = wid & 1;
  f32x16 acc[2][NI];
#pragma unroll
  for (int i = 0; i < 2; ++i)
#pragma unroll
    for (int j = 0; j < NI; ++j)
#pragma unroll
      for (int r = 0; r < 16; ++r) acc[i][j][r] = 0.f;
  const int lr = tid >> 3, lc = (tid & 7) * 8;
  uint4 ra[4], rb[NB];
#pragma unroll
  for (int i = 0; i < 4; ++i) ra[i] = loadA(lr + 32 * i, lc);
#pragma unroll
  for (int i = 0; i < NB; ++i) rb[i] = loadB(lr + 32 * i, lc);
  const int nk = K >> 6;
  for (int kt = 0; kt < nk; ++kt) {
    __syncthreads();
#pragma unroll
    for (int i = 0; i < 4; ++i) *(uint4*)&sA[(lr + 32 * i) * 72 + lc] = ra[i];
#pragma unroll
    for (int i = 0; i < NB; ++i) *(uint4*)&sB[(lr + 32 * i) * 72 + lc] = rb[i];
    __syncthreads();
    if (kt + 1 < nk) {
      const int kk = (kt + 1) * 64 + lc;
#pragma unroll
      for (int i = 0; i < 4; ++i) ra[i] = loadA(lr + 32 * i, kk);
#pragma unroll
      for (int i = 0; i < NB; ++i) rb[i] = loadB(lr + 32 * i, kk);
    }
#pragma unroll
    for (int s = 0; s < 4; ++s) {
      h8 af[2], bf[NI];
#pragma unroll
      for (int mi = 0; mi < 2; ++mi)
        af[mi] = *(const h8*)&sA[(wm * 64 + mi * 32 + (lane & 31)) * 72 + s * 16 + (lane >> 5) * 8];
#pragma unroll
      for (int ni = 0; ni < NI; ++ni)
        bf[ni] = *(const h8*)&sB[(wn * (NI * 32) + ni * 32 + (lane & 31)) * 72 + s * 16 + (lane >> 5) * 8];
#pragma unroll
      for (int mi = 0; mi < 2; ++mi)
#pragma unroll
        for (int ni = 0; ni < NI; ++ni)
          acc[mi][ni] = __builtin_amdgcn_mfma_f32_32x32x16_f16(af[mi], bf[ni], acc[mi][ni], 0, 0, 0);
    }
  }
#pragma unroll
  for (int mi = 0; mi < 2; ++mi)
#pragma unroll
    for (int ni = 0; ni < NI; ++ni)
#pragma unroll
      for (int r = 0; r < 16; ++r) {
        const int row = wm * 64 + mi * 32 + (r & 3) + 8 * (r >> 2) + 4 * (lane >> 5);
        const int col = wn * (NI * 32) + ni * 32 + (lane & 31);
        epi(mi, ni, r, row, col, acc[mi][ni][r]);
      }
}

template <class LA, class LB, class EP>
__device__ __forceinline__ void gemm_tile_big(int K, LA loadA, LB loadB, EP epi, char* smem) {
  half_t* sA = (half_t*)smem;
  half_t* sB = sA + 256 * 72;
  int tid = threadIdx.x;
  asm volatile("" : "+v"(tid));
  const int lane = tid & 63, wid = tid >> 6;
  const int wm = wid >> 1, wn = wid & 1;
  f32x16 acc[4][2];
#pragma unroll
  for (int i = 0; i < 4; ++i)
#pragma unroll
    for (int j = 0; j < 2; ++j)
#pragma unroll
      for (int r = 0; r < 16; ++r) acc[i][j][r] = 0.f;
  const int lr = tid >> 3, lc = (tid & 7) * 8;
  uint4 ra[8], rb[4];
#pragma unroll
  for (int i = 0; i < 8; ++i) ra[i] = loadA(lr + 32 * i, lc);
#pragma unroll
  for (int i = 0; i < 4; ++i) rb[i] = loadB(lr + 32 * i, lc);
  const int nk = K >> 6;
  for (int kt = 0; kt < nk; ++kt) {
    __syncthreads();
#pragma unroll
    for (int i = 0; i < 8; ++i) *(uint4*)&sA[(lr + 32 * i) * 72 + lc] = ra[i];
#pragma unroll
    for (int i = 0; i < 4; ++i) *(uint4*)&sB[(lr + 32 * i) * 72 + lc] = rb[i];
    __syncthreads();
    if (kt + 1 < nk) {
      const int kk = (kt + 1) * 64 + lc;
#pragma unroll
      for (int i = 0; i < 8; ++i) ra[i] = loadA(lr + 32 * i, kk);
#pragma unroll
      for (int i = 0; i < 4; ++i) rb[i] = loadB(lr + 32 * i, kk);
    }
#pragma unroll
    for (int s = 0; s < 4; ++s) {
      h8 af[4], bf[2];
#pragma unroll
      for (int mi = 0; mi < 4; ++mi)
        af[mi] = *(const h8*)&sA[(wm * 128 + mi * 32 + (lane & 31)) * 72 + s * 16 + (lane >> 5) * 8];
#pragma unroll
      for (int ni = 0; ni < 2; ++ni)
        bf[ni] = *(const h8*)&sB[(wn * 64 + ni * 32 + (lane & 31)) * 72 + s * 16 + (lane >> 5) * 8];
#pragma unroll
      for (int mi = 0; mi < 4; ++mi)
#pragma unroll
        for (int ni = 0; ni < 2; ++ni)
          acc[mi][ni] = __builtin_amdgcn_mfma_f32_32x32x16_f16(af[mi], bf[ni], acc[mi][ni], 0, 0, 0);
    }
  }
#pragma unroll
  for (int mi = 0; mi < 4; ++mi)
#pragma unroll
    for (int ni = 0; ni < 2; ++ni)
#pragma unroll
      for (int r = 0; r < 16; ++r) {
        const int row = wm * 128 + mi * 32 + (r & 3) + 8 * (r >> 2) + 4 * (lane >> 5);
        const int col = wn * 64 + ni * 32 + (lane & 31);
        epi(mi, ni, r, row, col, acc[mi][ni][r]);
      }
}

template <class CM>
__device__ __forceinline__ void tconv_tile(const float* __restrict__ src, int lds_, half_t* __restrict__ dst, int ldd,
                                           int n0, int k0, CM cmap, char* smem) {
  float* t = (float*)smem;
  int tid = threadIdx.x;
  asm volatile("" : "+v"(tid));
  {
    const int n = tid & 63;
    const int c = cmap(n0 + n);
    float tv[16];
#pragma unroll
    for (int i = 0; i < 16; ++i) {
      const int k = (tid >> 6) + 4 * i;
      tv[i] = (c >= 0) ? src[(size_t)(k0 + k) * lds_ + c] : 0.f;
    }
#pragma unroll
    for (int i = 0; i < 16; ++i) {
      const int k = (tid >> 6) + 4 * i;
      t[k * 65 + n] = tv[i];
    }
  }
  __syncthreads();
#pragma unroll
  for (int i = 0; i < 2; ++i) {
    const int idx = tid + 256 * i;
    const int n = idx >> 3, kc = (idx & 7) * 8;
    h8 v;
#pragma unroll
    for (int j = 0; j < 8; ++j) v[j] = (half_t)t[(kc + j) * 65 + n];
    *(h8*)&dst[(size_t)(n0 + n) * ldd + k0 + kc] = v;
  }
  __syncthreads();
}

__device__ __forceinline__ void ln_rows(const KP& p, int lprev, bool final_) {
  int tid = threadIdx.x;
  asm volatile("" : "+v"(tid));
  const int lane = tid & 63, wid = tid >> 6;
  const int gw = blockIdx.x * 4 + wid, nw = gridDim.x * 4;
  for (int row = gw; row < NTOK; row += nw) {
    const float4* rp = (const float4*)((lprev < 0 ? p.x() : (const float*)p.u()) + (size_t)row * DM);
    float4 v[4];
    float s = 0.f;
#pragma unroll
    for (int i = 0; i < 4; ++i) {
      v[i] = rp[lane + 64 * i];
      s += v[i].x + v[i].y + v[i].z + v[i].w;
    }
    if (lprev >= 0) {
      float mu = wave_sum(s) * (1.f / DM);
      float q = 0.f;
#pragma unroll
      for (int i = 0; i < 4; ++i) {
        float a = v[i].x - mu, b = v[i].y - mu, c = v[i].z - mu, d = v[i].w - mu;
        q += a * a + b * b + c * c + d * d;
      }
      float rstd = rsqrtf(wave_sum(q) * (1.f / DM) + 1e-5f);
      const float4* g4 = (const float4*)(p.ln_g() + lprev * DM);
      const float4* b4 = (const float4*)(p.ln_b() + lprev * DM);
#pragma unroll
      for (int i = 0; i < 4; ++i) {
        float4 g = g4[lane + 64 * i], bb = b4[lane + 64 * i];
        v[i].x = (v[i].x - mu) * rstd * g.x + bb.x;
        v[i].y = (v[i].y - mu) * rstd * g.y + bb.y;
        v[i].z = (v[i].z - mu) * rstd * g.z + bb.z;
        v[i].w = (v[i].w - mu) * rstd * g.w + bb.w;
      }
    }
    if (final_) {
      float4* op = (float4*)(p.out() + (size_t)row * DM);
#pragma unroll
      for (int i = 0; i < 4; ++i) op[lane + 64 * i] = v[i];
    } else {
      float4* op = (float4*)(p.xr() + (size_t)row * DM);
      h4* hp = (h4*)(p.xh() + (size_t)row * DM);
#pragma unroll
      for (int i = 0; i < 4; ++i) {
        op[lane + 64 * i] = v[i];
        h4 hv;
        hv[0] = (half_t)v[i].x; hv[1] = (half_t)v[i].y; hv[2] = (half_t)v[i].z; hv[3] = (half_t)v[i].w;
        hp[lane + 64 * i] = hv;
      }
    }
  }
}

__device__ __forceinline__ void prep_weights(const KP& p, int l, char* smem) {
  int tid = threadIdx.x;
  asm volatile("" : "+v"(tid));
  const int total = 1856 + 384 + 256 + 16 + 64 + 2;
  for (int it = blockIdx.x; it < total; it += gridDim.x) {
    if (it < 1856) {
      const int nt = it >> 4, kt = it & 15;
      tconv_tile(p.w_in() + (size_t)l * DM * NIN, NIN, p.winT(), DM, nt * 64, kt * 64,
                 [](int n) { return orig_col(n); }, smem);
    } else if (it < 1856 + 384) {
      const int j = it - 1856;
      const int w = j >> 7, r = j & 127, nt = r >> 3, kt = r & 7;
      const float* src = (w == 0 ? p.wpa() : (w == 1 ? p.wpb() : p.wpc())) + (size_t)l * 512 * DM;
      tconv_tile(src, DM, p.wpT() + (size_t)w * DM * 512, 512, nt * 64, kt * 64, [](int n) { return n; }, smem);
    } else if (it < 1856 + 384 + 256) {
      const int j = it - 1856 - 384;
      const int nt = j >> 4, kt = j & 15;
      tconv_tile(p.wo() + (size_t)l * DM * DM, DM, p.woT(), DM, nt * 64, kt * 64, [](int n) { return n; }, smem);
    } else if (it < 1856 + 384 + 256 + 16) {
      const int j = it - 1856 - 384 - 256;
      const int g = j >> 2, nt = (j >> 1) & 1, kt = j & 1;
      tconv_tile(p.pool_w() + ((size_t)l * 4 + g) * 128 * 128, 128, p.poolT() + (size_t)g * 128 * 128, 128, nt * 64,
                 kt * 64, [](int n) { return n; }, smem);
    } else if (it < 1856 + 384 + 256 + 16 + 64) {
      const int j = it - 1856 - 384 - 256 - 16;
      const int kv = j >> 5, kt = j & 31;
      const float* src = (kv ? p.w1v() : p.w1k()) + (size_t)l * 2048 * 64;
      tconv_tile(src, 64, p.w1T() + (size_t)kv * 64 * 2048, 2048, 0, kt * 64, [](int n) { return n; }, smem);
    } else {
      const int kv = it - (1856 + 384 + 256 + 16 + 64);
      const float* w1 = (kv ? p.w1v() : p.w1k()) + (size_t)l * 2048 * 64;
      const float* pos = (kv ? p.pos_v() : p.pos_k()) + (size_t)l * 2048;
      float* red = (float*)smem;
      const int e = tid & 63, part = tid >> 6;
      float sa = 0.f, sb = 0.f, sc_ = 0.f, sd = 0.f;
      const float* wq = w1 + (size_t)part * 512 * 64 + e;
      const float* pq = pos + part * 512;
#pragma unroll 4
      for (int f = 0; f < 512; f += 4) {
        sa += pq[f] * wq[(size_t)f * 64];
        sb += pq[f + 1] * wq[(size_t)(f + 1) * 64];
        sc_ += pq[f + 2] * wq[(size_t)(f + 2) * 64];
        sd += pq[f + 3] * wq[(size_t)(f + 3) * 64];
      }
      const float s = (sa + sb) + (sc_ + sd);
      red[tid] = s;
      __syncthreads();
      if (tid < 64) p.posb()[kv * 64 + tid] = red[tid] + red[tid + 64] + red[tid + 128] + red[tid + 192];
      __syncthreads();
    }
  }
}

template <class F>
__device__ __forceinline__ void xcd_schedule(int* q, int xcc, int ngroups, int gsize, char* smem, F f) {
  int* s_item = (int*)(smem + SMEM_BYTES - 16);
  int* s_flag = (int*)(smem + SMEM_BYTES - 96);
  int* flags = q + 32;
#pragma unroll 1
  for (int dy = 0; dy < 8; ++dy) {
    const int y = (xcc + dy) & 7;
    if (dy == 1) {
      int t8 = threadIdx.x;
      asm volatile("" : "+v"(t8));
      if (t8 < 8) s_flag[t8] = __hip_atomic_load(&flags[t8], __ATOMIC_RELAXED, __HIP_MEMORY_SCOPE_AGENT);
      __syncthreads();
    }
    if (dy >= 1 && __builtin_amdgcn_readfirstlane(s_flag[y]) != 0) continue;
    for (;;) {
      if (threadIdx.x == 0) *s_item = atomicAdd(&q[y], 1);
      __syncthreads();
      const int i = __builtin_amdgcn_readfirstlane(*s_item);
      __syncthreads();
      const int grp = (i / gsize) * 8 + y;
      if (grp >= ngroups) {
        if (threadIdx.x == 0) __hip_atomic_store(&flags[y], 1, __ATOMIC_RELAXED, __HIP_MEMORY_SCOPE_AGENT);
        break;
      }
      f(grp, i % gsize);
    }
  }
}

__device__ __forceinline__ void phase_inproj(const KP& p, int l, char* smem, int* q, int xcc) {
  const float* bias = p.b_in() + (size_t)l * NIN;
  xcd_schedule(q, xcc, 128, 32, smem, [&](int grp, int within) __attribute__((always_inline)) {
    const int mt = (grp & 15) * 4 + (within & 3), nt = (grp >> 4) * 8 + (within >> 2);
    if (nt >= 58) return;
    const int m0 = mt * 256, n0 = nt * 128;
    const half_t* A = p.xh() + (size_t)m0 * DM;
    const half_t* B = p.winT() + (size_t)n0 * DM;
    int tidx = threadIdx.x;
    asm volatile("" : "+v"(tidx));
    const int lane = tidx & 63, wn = (tidx >> 6) & 1;
    float bv[2];
#pragma unroll
    for (int ni = 0; ni < 2; ++ni) {
      const int oc = orig_col(n0 + wn * 64 + ni * 32 + (lane & 31));
      bv[ni] = oc >= 0 ? bias[oc] : 0.f;
    }
    half_t* vT = (nt == 53) ? p.vsT() : ((nt == 55) ? p.vwT() : nullptr);
    gemm_tile_big(
        DM, [&](int r, int k) { return *(const uint4*)(A + (size_t)r * DM + k); },
        [&](int r, int k) { return *(const uint4*)(B + (size_t)r * DM + k); },
        [&](int mi, int ni, int r, int row, int col, float v) {
          const half_t hv = (half_t)(v + bv[ni]);
          const int tok = m0 + row;
          p.u()[(size_t)tok * NU + n0 + col] = hv;
          if (vT) {
            const int b = tok >> 13, t = tok & 8191;
            vT[((size_t)(b * 2 + (col >> 6)) * 64 + (col & 63)) * SEQ + t] = hv;
          }
        },
        smem);
  });
}

__device__ __forceinline__ void pool_item(const KP& p, int l, int item, char* smem) {
  const int g = item & 3, mt = item >> 2;
  const int m0 = mt * 128;
  const int wnd = 2 << g;
  const half_t* B = p.poolT() + (size_t)g * 128 * 128;
  int tidx = threadIdx.x;
  asm volatile("" : "+v"(tidx));
  const int lane = tidx & 63, wn = (tidx >> 6) & 1;
  float pb[2], ps[2];
#pragma unroll
  for (int ni = 0; ni < 2; ++ni) {
    const int d = wn * 64 + ni * 32 + (lane & 31);
    pb[ni] = p.pool_b()[(size_t)l * 512 + g * 128 + d];
    ps[ni] = p.pool_scale()[(size_t)l * 512 + g * 128 + d];
  }
  gemm_tile<2>(
      128,
      [&](int r, int k) {
        const int tok = m0 + r, t = tok & 8191;
        const int cnt = min(t + 1, wnd);
        const half_t* base = p.u() + (size_t)tok * NU + C_AX + g * 128 + k;
        float s[8];
#pragma unroll
        for (int j = 0; j < 8; ++j) s[j] = 0.f;
        h8 cur = *(const h8*)base;
        for (int q0 = 0; q0 < wnd; q0 += 8) {
          h8 v[8];
#pragma unroll
          for (int i = 0; i < 8; ++i) {
            const int qq = q0 + i;
            if (qq < cnt) v[i] = *(const h8*)(base - (size_t)qq * NU);
            else {
#pragma unroll
              for (int j = 0; j < 8; ++j) v[i][j] = (half_t)0.f;
            }
          }
#pragma unroll
          for (int i = 0; i < 8; ++i)
#pragma unroll
            for (int j = 0; j < 8; ++j) s[j] += (float)v[i][j];
        }
        const float inv = 1.f / (float)cnt;
        h8 o;
#pragma unroll
        for (int j = 0; j < 8; ++j) o[j] = (half_t)(s[j] * inv - (float)cur[j]);
        return *(uint4*)&o;
      },
      [&](int r, int k) { return *(const uint4*)(B + (size_t)r * 128 + k); },
      [&](int mi, int ni, int r, int row, int col, float v) {
        const int tok = m0 + row;
        const float z = (float)p.u()[(size_t)tok * NU + C_AZ + g * 128 + col];
        p.ya()[(size_t)tok * 512 + g * 128 + col] = (half_t)((v + pb[ni]) * ps[ni] * siluf_(z));
      },
      smem);
}

__device__ __forceinline__ void compress_item(const KP& p, int l, int item, char* smem) {
  const int mt = item & 3, kv = (item >> 2) & 1, g = (item >> 3) & 1, b = item >> 4;
  int tid = threadIdx.x;
  asm volatile("" : "+v"(tid));
  const int ccol = (kv ? C_CVC : C_CKC) + g * 64;
  const half_t* ub = p.u() + (size_t)b * SEQ * NU + ccol;
  const half_t* B = p.w1T() + (size_t)kv * 64 * 2048;
  float* hid = (float*)(smem + 28672);
  const float* posb = p.posb() + kv * 64;
  gemm_tile<1>(
      2048,
      [&](int r, int k) {
        const int n = mt * 128 + r;
        if (n >= 511) return make_uint4(0, 0, 0, 0);
        const int tok = 16 * n + (k >> 6);
        return *(const uint4*)(ub + (size_t)tok * NU + (k & 63));
      },
      [&](int r, int k) { return *(const uint4*)(B + (size_t)r * 2048 + k); },
      [&](int mi, int ni, int r, int row, int col, float v) { hid[row * 65 + col] = siluf_(v + posb[col]); }, smem);
  __syncthreads();
  float* w2s = (float*)smem;
  const float* w2 = (kv ? p.w2v() : p.w2k()) + (size_t)l * 4096;
  for (int i = tid; i < 4096; i += 256) w2s[i] = w2[i];
  __syncthreads();
  {
    const int n = tid >> 1, fh = (tid & 1) * 32;
    float acc[32];
#pragma unroll
    for (int f = 0; f < 32; ++f) acc[f] = 0.f;
    for (int e = 0; e < 64; ++e) {
      const float hv = hid[n * 65 + e];
#pragma unroll
      for (int f = 0; f < 32; ++f) acc[f] += hv * w2s[e * 64 + fh + f];
    }
    const int ng = mt * 128 + n;
    const bool valid = ng < 511;
    if (kv == 0) {
      half_t* dst = p.kcmp() + ((size_t)(b * 2 + g) * 512 + ng) * 64 + fh;
#pragma unroll
      for (int f = 0; f < 32; ++f) dst[f] = valid ? (half_t)acc[f] : (half_t)0.f;
    } else {
      half_t* dst = p.vcmpT() + ((size_t)(b * 2 + g) * 64 + fh) * 512 + ng;
#pragma unroll
      for (int f = 0; f < 32; ++f) dst[(size_t)f * 512] = valid ? (half_t)acc[f] : (half_t)0.f;
    }
  }
  __syncthreads();
}

#ifndef DSA_CAP
#define DSA_CAP 128
#endif
__device__ __forceinline__ void dsa_item(const KP& p, int b, int tile, char* smem) {
  const int t0 = tile * 16;
  int tid = threadIdx.x;
  asm volatile("" : "+v"(tid));
  const int lane = tid & 63, wid = tid >> 6;
  uint32_t* hist = (uint32_t*)smem;
  unsigned long long* cand = (unsigned long long*)(smem + 16384);
  unsigned short* sel = (unsigned short*)(smem + 32768);
  unsigned long long* pfx = (unsigned long long*)(smem + 40960);
  unsigned long long* tkey = pfx + 16;
  int* need = (int*)(tkey + 16);
  int* state = need + 16;
  int* cnt = state + 16;
  int* ccnt = cnt + 16;
  int* pf16 = ccnt + 16;
  int* ovf = pf16 + 16;
  int* nrem = ovf + 16;
  int* fastf = nrem + 8;
  uint32_t* h1w = (uint32_t*)(smem + 43008);
  float* pbuf = (float*)smem + wid * 2048;

  const half_t* ub = p.u() + (size_t)b * SEQ * NU;
  const int mytok = lane & 15, hq = lane >> 4;
  const int myt = t0 + mytok;
  if (tid < 16) {
    const int t = t0 + tid;
    pfx[tid] = 0ull; tkey[tid] = 0ull; need[tid] = 256; state[tid] = (t < 256) ? 0 : 1; cnt[tid] = 0; ccnt[tid] = 0;
    pf16[tid] = 0; ovf[tid] = 0;
  }
  if (tid < 8) nrem[tid] = 0;
  if (tid < 16) fastf[tid] = 0;
  for (int i = tid; i < 6144; i += 256) h1w[i] = 0u;
  h8 qf[8], qlh, qll;
  float iw[8];
  {
    const half_t* qrow = ub + (size_t)myt * NU;
#pragma unroll
    for (int h = 0; h < 8; ++h) qf[h] = *(const h8*)(qrow + C_IQ + h * 32 + hq * 8);
    const h8 w8 = *(const h8*)(qrow + C_IW);
#pragma unroll
    for (int h = 0; h < 8; ++h) iw[h] = (float)w8[h] * 0.03125f;
#pragma unroll
    for (int e = 0; e < 8; ++e) {
      float a = 0.f;
#pragma unroll
      for (int h = 0; h < 8; ++h) a += iw[h] * (float)qf[h][e];
      const half_t hi = (half_t)a;
      qlh[e] = hi;
      qll[e] = (half_t)(a - (float)hi);
    }
  }
  __syncthreads();
  const int nkt = (t0 + 16 + 31) >> 5;

  auto loadk = [&](int kt, h8* a) __attribute__((always_inline)) {
#pragma unroll
    for (int i = 0; i < 2; ++i)
      a[i] = *(const h8*)(ub + (size_t)(kt * 32 + i * 16 + (lane & 15)) * NU + C_IK + hq * 8);
  };
  auto scores = [&](const h8* a, float* sc) __attribute__((always_inline)) {
#pragma unroll
    for (int i = 0; i < 2; ++i) {
      f32x4 acc = {0.f, 0.f, 0.f, 0.f};
      acc = __builtin_amdgcn_mfma_f32_16x16x32_f16(a[i], qll, acc, 0, 0, 0);
      acc = __builtin_amdgcn_mfma_f32_16x16x32_f16(a[i], qlh, acc, 0, 0, 0);
#pragma unroll
      for (int h = 0; h < 8; ++h) {
        f32x4 d = {0.f, 0.f, 0.f, 0.f};
        d = __builtin_amdgcn_mfma_f32_16x16x32_f16(a[i], qf[h], d, 0, 0, 0);
#pragma unroll
        for (int r = 0; r < 4; ++r) acc[r] = __builtin_fmaf(__builtin_fabsf(d[r]), iw[h], acc[r]);
      }
#pragma unroll
      for (int r = 0; r < 4; ++r) sc[i * 4 + r] = acc[r];
    }
  };
  auto skey = [&](float s) __attribute__((always_inline)) -> uint32_t {
    s = s + 0.f;
    const uint32_t u_ = __float_as_uint(s);
    return (u_ & 0x80000000u) ? ~u_ : (u_ | 0x80000000u);
  };
  auto mkkey = [&](float s, int key) __attribute__((always_inline)) -> unsigned long long {
    s = s + 0.f;
    uint32_t u_ = __float_as_uint(s);
    u_ = (u_ & 0x80000000u) ? ~u_ : (u_ | 0x80000000u);
    return ((unsigned long long)u_ << 16) | (unsigned long long)(8191 - key);
  };
  auto scan_token = [&](int tk, int level) __attribute__((always_inline)) -> bool {
    const int shift = 40 - 8 * level;
    const uint32_t* hrow = hist + tk * 256;
    const uint4 hv = *(const uint4*)&hrow[252 - 4 * lane];
    const int c = (int)(hv.x + hv.y + hv.z + hv.w);
    int cum = c;
#pragma unroll
    for (int o = 1; o < 64; o <<= 1) {
      int v = __shfl_up(cum, o);
      if (lane >= o) cum += v;
    }
    const int nd = need[tk];
    const unsigned long long mask = __ballot(cum >= nd);
    const int L = mask ? (int)__builtin_ctzll(mask) : 63;
    int running = cum - c, bstar, cb;
    if (running + (int)hv.w >= nd) { bstar = 255 - 4 * lane; cb = hv.w; }
    else {
      running += hv.w;
      if (running + (int)hv.z >= nd) { bstar = 254 - 4 * lane; cb = hv.z; }
      else {
        running += hv.z;
        if (running + (int)hv.y >= nd) { bstar = 253 - 4 * lane; cb = hv.y; }
        else { running += hv.y; bstar = 252 - 4 * lane; cb = hv.x; }
      }
    }
    running = __shfl(running, L); bstar = __shfl(bstar, L); cb = __shfl(cb, L);
    const int nd2 = nd - running;
    const bool fin = (cb == nd2) || (level == 5);
    if (lane == 0) {
      const unsigned long long np = (pfx[tk] << 8) | (unsigned long long)bstar;
      if (fin) { state[tk] = 0; tkey[tk] = np << shift; }
      else { need[tk] = nd2; pfx[tk] = np; }
    }
    return fin;
  };
  auto run_level = [&](int level, bool fillx) __attribute__((always_inline)) {
    const int shift = 40 - 8 * level;
    for (int i = tid; i < 4096; i += 256) hist[i] = 0u;
    __syncthreads();
    {
      const unsigned long long mypfx = pfx[mytok];
      const bool act = state[mytok] == 1 && fastf[mytok] == 0;
      h8 na[2];
      if (wid < nkt) loadk(wid, na);
      for (int kt = wid; kt < nkt; kt += 4) {
        h8 ca[2];
#pragma unroll
        for (int i = 0; i < 2; ++i) ca[i] = na[i];
        loadk(kt + 4 < nkt ? kt + 4 : kt, na);
        float sc[8];
        scores(ca, sc);
        if (act) {
#pragma unroll
          for (int q = 0; q < 8; ++q) {
            const int key = kt * 32 + (q >> 2) * 16 + 4 * hq + (q & 3);
            if (key <= myt) {
              if (level < 2) {
                const uint32_t u32 = skey(sc[q]);
                if (level == 0) {
                  const uint32_t b8 = u32 >> 24;
                  atomicAdd(&hist[mytok * 256 + (int)b8], 1u);
                  if (fillx) {
                    const uint32_t ix = b8 - 0xBEu;
                    if (ix < 3u) {
                      const uint32_t e16 = (ix * 16u + (uint32_t)mytok) * 256u + ((u32 >> 16) & 255u);
                      atomicAdd(&h1w[e16 >> 1], (e16 & 1u) ? 65536u : 1u);
                    }
                  }
                } else if ((u32 >> 24) == (uint32_t)mypfx) atomicAdd(&hist[mytok * 256 + (int)((u32 >> 16) & 255u)], 1u);
              } else {
                const unsigned long long k48 = mkkey(sc[q], key);
                if ((k48 >> (shift + 8)) == mypfx)
                  atomicAdd(&hist[mytok * 256 + (int)((k48 >> shift) & 255ull)], 1u);
              }
            }
          }
        }
      }
    }
    __syncthreads();
    {
      int rem = 0;
      for (int j = 0; j < 4; ++j) {
        const int tk = wid * 4 + j;
        if (state[tk] != 1 || fastf[tk] != 0) continue;
        if (!scan_token(tk, level)) rem++;
      }
      if (lane == 0 && rem) atomicAdd(&nrem[level], rem);
    }
    __syncthreads();
  };

  run_level(0, true);
  if (tid < 16) {
    const int b0 = (int)pfx[tid];
    const int f = (state[tid] == 1 && b0 >= 0xBE && b0 <= 0xC0) ? 1 : 0;
    fastf[tid] = f;
    if (state[tid] == 1 && !f) atomicAdd(&nrem[7], 1);
  }
  __syncthreads();
  if (nrem[7] != 0) run_level(1, false);
  for (int j = 0; j < 4; ++j) {
    const int tk = wid * 4 + j;
    if (state[tk] != 1 || fastf[tk] == 0) continue;
    const uint32_t ix = (uint32_t)pfx[tk] - 0xBEu;
    const unsigned short* hx = (const unsigned short*)h1w + (ix * 16u + (uint32_t)tk) * 256u;
    const ushort4 c4 = *(const ushort4*)&hx[4 * lane];
    uint4 w4;
    w4.x = c4.x; w4.y = c4.y; w4.z = c4.z; w4.w = c4.w;
    *(uint4*)&hist[tk * 256 + 4 * lane] = w4;
    __builtin_amdgcn_wave_barrier();
    scan_token(tk, 1);
  }
  __syncthreads();
  if (tid < 16) fastf[tid] = 0;
  __syncthreads();

  {
    const int st0 = state[mytok];
    const unsigned long long mytk = tkey[mytok];
    const unsigned long long myp16 = pfx[mytok];
    h8 na[2];
    if (wid < nkt) loadk(wid, na);
    for (int kt = wid; kt < nkt; kt += 4) {
      h8 ca[2];
#pragma unroll
      for (int i = 0; i < 2; ++i) ca[i] = na[i];
      loadk(kt + 4 < nkt ? kt + 4 : kt, na);
      float sc[8];
      scores(ca, sc);
#pragma unroll
      for (int q = 0; q < 8; ++q) {
        const int key = kt * 32 + (q >> 2) * 16 + 4 * hq + (q & 3);
        if (key <= myt) {
          const uint32_t u32 = skey(sc[q]);
          bool take, isc = false;
          if (st0 == 0) take = (((unsigned long long)u32 << 16) | (unsigned long long)(8191 - key)) >= mytk;
          else {
            const uint32_t p16 = u32 >> 16;
            take = p16 > (uint32_t)myp16;
            isc = p16 == (uint32_t)myp16;
          }
          if (take) {
            const int pos = atomicAdd(&cnt[mytok], 1);
            if (pos < 256) sel[mytok * 256 + pos] = (unsigned short)key;
          } else if (isc) {
            const int pos = atomicAdd(&ccnt[mytok], 1);
            if (pos < DSA_CAP) cand[mytok * 128 + pos] = ((unsigned long long)u32 << 16) | (unsigned long long)(8191 - key);
          }
        }
      }
    }
  }
  __syncthreads();
  {
    int nov = 0;
    for (int j = 0; j < 4; ++j) {
      const int tk = wid * 4 + j;
      if (state[tk] != 1) continue;
      const int nc = ccnt[tk];
      if (nc > DSA_CAP) {
        nov++;
        if (lane == 0) { ovf[tk] = 1; pf16[tk] = (int)pfx[tk]; }
        continue;
      }
      const int nd = need[tk];
      const unsigned long long k0 = (lane < nc) ? cand[tk * 128 + lane] : 0ull;
      const unsigned long long k1 = (lane + 64 < nc) ? cand[tk * 128 + lane + 64] : 0ull;
      int r0 = 0, r1 = 0;
      for (int q = 0; q < nc; ++q) {
        const unsigned long long kq = cand[tk * 128 + q];
        r0 += (kq > k0) ? 1 : 0;
        r1 += (kq > k1) ? 1 : 0;
      }
      if (lane < nc && r0 < nd) {
        const int pos = atomicAdd(&cnt[tk], 1);
        if (pos < 256) sel[tk * 256 + pos] = (unsigned short)(8191 - (int)(k0 & 0xFFFFull));
      }
      if (lane + 64 < nc && r1 < nd) {
        const int pos = atomicAdd(&cnt[tk], 1);
        if (pos < 256) sel[tk * 256 + pos] = (unsigned short)(8191 - (int)(k1 & 0xFFFFull));
      }
      if (lane == 0) state[tk] = 2;
    }
    if (lane == 0 && nov) atomicAdd(&nrem[6], nov);
  }
  __syncthreads();
  if (nrem[6] != 0) {
    for (int level = 2; level < 6; ++level) {
      run_level(level, false);
      if (nrem[level] == 0) break;
    }
    {
      const bool mine = ovf[mytok] != 0;
      const unsigned long long mytk = tkey[mytok];
      const unsigned long long myp16 = (unsigned long long)(unsigned)pf16[mytok];
      h8 na[2];
      if (wid < nkt) loadk(wid, na);
      for (int kt = wid; kt < nkt; kt += 4) {
        h8 ca[2];
#pragma unroll
        for (int i = 0; i < 2; ++i) ca[i] = na[i];
        loadk(kt + 4 < nkt ? kt + 4 : kt, na);
        float sc[8];
        scores(ca, sc);
        if (mine) {
#pragma unroll
          for (int q = 0; q < 8; ++q) {
            const int key = kt * 32 + (q >> 2) * 16 + 4 * hq + (q & 3);
            if (key <= myt) {
              const unsigned long long k48 = mkkey(sc[q], key);
              if ((k48 >> 32) == myp16 && k48 >= mytk) {
                const int pos = atomicAdd(&cnt[mytok], 1);
                if (pos < 256) sel[mytok * 256 + pos] = (unsigned short)key;
              }
            }
          }
        }
      }
    }
    __syncthreads();
  }
#ifndef DSA_ATT_REP
#define DSA_ATT_REP 1
#endif
  for (int jr = 0; jr < 4 * DSA_ATT_REP; ++jr) {
    const int j = jr & 3;
    const int tk = wid * 4 + j;
    const int t = t0 + tk;
    const int nsel = min(cnt[tk], 256);
    const half_t* urow = ub + (size_t)t * NU;
    const int col = lane & 15;
    h8 q0, q1;
#pragma unroll
    for (int e = 0; e < 8; ++e) { q0[e] = (half_t)0.f; q1[e] = (half_t)0.f; }
    if (col < 8) {
      q0 = *(const h8*)(urow + C_BQ + col * 64 + hq * 8);
      q1 = *(const h8*)(urow + C_BQ + col * 64 + 32 + hq * 8);
    }
    float mx = NEGF;
#pragma unroll 1
    for (int mg = 0; mg < 2; ++mg) {
#pragma unroll
      for (int mm = 0; mm < 8; ++mm) {
        const int m = mg * 8 + mm;
        const int pos = m * 16 + col;
        const int s = (pos < nsel) ? (int)sel[tk * 256 + pos] : 0;
        const half_t* kp = ub + (size_t)s * NU + C_BK + hq * 8;
        const h8 a0 = *(const h8*)kp, a1 = *(const h8*)(kp + 32);
        f32x4 d = {0.f, 0.f, 0.f, 0.f};
        d = __builtin_amdgcn_mfma_f32_16x16x32_f16(a0, q0, d, 0, 0, 0);
        d = __builtin_amdgcn_mfma_f32_16x16x32_f16(a1, q1, d, 0, 0, 0);
#pragma unroll
        for (int r = 0; r < 4; ++r) {
          const int pp = m * 16 + hq * 4 + r;
          const float v = (pp < nsel) ? d[r] * 0.125f : NEGF;
          mx = fmaxf(mx, v);
          if (col < 8) pbuf[pp * 8 + col] = v;
        }
      }
    }
    mx = fmaxf(mx, __shfl_xor(mx, 16));
    mx = fmaxf(mx, __shfl_xor(mx, 32));
    const float mxh = __shfl(mx, lane & 7);
    __builtin_amdgcn_wave_barrier();
    float sum = 0.f;
#pragma unroll 4
    for (int k = 0; k < 32; ++k) {
      const int i = lane + 64 * k;
      const float v = pbuf[i];
      const float e = (v > -1e29f) ? __expf(v - mxh) : 0.f;
      pbuf[i] = e;
      sum += e;
    }
    sum += __shfl_xor(sum, 8);
    sum += __shfl_xor(sum, 16);
    sum += __shfl_xor(sum, 32);
    const float inv = 1.f / sum;
    __builtin_amdgcn_wave_barrier();
    {
      const int rs = lane >> 3, dc = lane & 7;
      float acc[8][8];
#pragma unroll
      for (int h = 0; h < 8; ++h)
#pragma unroll
        for (int e = 0; e < 8; ++e) acc[h][e] = 0.f;
#pragma unroll 1
      for (int g8 = 0; g8 < 4; ++g8) {
        h8 vv[8];
#pragma unroll
        for (int i = 0; i < 8; ++i) {
          const int pos = (g8 * 8 + i) * 8 + rs;
          const int s = (pos < nsel) ? (int)sel[tk * 256 + pos] : 0;
          vv[i] = *(const h8*)(ub + (size_t)s * NU + C_BV + dc * 8);
        }
#pragma unroll
        for (int i = 0; i < 8; ++i) {
          const int pos = (g8 * 8 + i) * 8 + rs;
          const f32x4 pa = *(const f32x4*)&pbuf[pos * 8];
          const f32x4 pb = *(const f32x4*)&pbuf[pos * 8 + 4];
          float vf[8];
#pragma unroll
          for (int e = 0; e < 8; ++e) vf[e] = (float)vv[i][e];
#pragma unroll
          for (int e = 0; e < 8; ++e) {
            acc[0][e] += pa[0] * vf[e]; acc[1][e] += pa[1] * vf[e]; acc[2][e] += pa[2] * vf[e]; acc[3][e] += pa[3] * vf[e];
            acc[4][e] += pb[0] * vf[e]; acc[5][e] += pb[1] * vf[e]; acc[6][e] += pb[2] * vf[e]; acc[7][e] += pb[3] * vf[e];
          }
        }
      }
      half_t* yrow = p.yb() + (size_t)(b * SEQ + t) * 512;
      float v32[4][8], v16[2][8], v8[8];
      const bool b2 = (rs & 4) != 0, b1 = (rs & 2) != 0, b0 = (rs & 1) != 0;
#pragma unroll
      for (int i = 0; i < 4; ++i)
#pragma unroll
        for (int e = 0; e < 8; ++e) {
          const float lo = acc[i][e], hi = acc[4 + i][e];
          const float snd = b2 ? lo : hi;
          auto rr = __builtin_amdgcn_permlane32_swap(__float_as_uint(snd), __float_as_uint(snd), false, false);
          v32[i][e] = (b2 ? hi : lo) + __uint_as_float(b2 ? rr[0] : rr[1]);
        }
#pragma unroll
      for (int i = 0; i < 2; ++i)
#pragma unroll
        for (int e = 0; e < 8; ++e) {
          const float lo = v32[i][e], hi = v32[2 + i][e];
          v16[i][e] = (b1 ? hi : lo) + __shfl_xor(b1 ? lo : hi, 16);
        }
#pragma unroll
      for (int e = 0; e < 8; ++e) {
        const float lo = v16[0][e], hi = v16[1][e];
        v8[e] = (b0 ? hi : lo) + dpp_quad<0x128>(b0 ? lo : hi);
      }
      {
        const float invh = __shfl(inv, rs);
        const h8 z8 = *(const h8*)(urow + C_BZ + rs * 64 + dc * 8);
        h8 ov;
#pragma unroll
        for (int e = 0; e < 8; ++e) ov[e] = (half_t)(v8[e] * invh * siluf_((float)z8[e]));
        *(h8*)(yrow + rs * 64 + dc * 8) = ov;
      }
    }
    __builtin_amdgcn_wave_barrier();
  }
  __syncthreads();
}

__device__ __forceinline__ void phase2(const KP& p, int l, char* smem, int* q, int xcc) {
  xcd_schedule(q, xcc, 196 * 8, 1, smem, [&](int grp, int) __attribute__((always_inline)) {
    const int y = grp & 7, k = grp >> 3;
    if (k < 4) compress_item(p, l, k * 8 + y, smem);
    else if (k < 132) dsa_item(p, y & 1, 511 - ((k - 4) * 4 + (y >> 1)), smem);
    else pool_item(p, l, (k - 132) * 8 + y, smem);
  });
}

struct DState {
  float m, l;
  f32x16 o[2];
};
#define MLOW (-1e4f)
__device__ __forceinline__ void ds_reset(DState& st) {
  st.m = MLOW; st.l = 0.f;
#pragma unroll
  for (int dt = 0; dt < 2; ++dt)
#pragma unroll
    for (int r = 0; r < 16; ++r) st.o[dt][r] = 0.f;
}
typedef unsigned int u32x4 __attribute__((ext_vector_type(4)));
typedef unsigned int u32x2 __attribute__((ext_vector_type(2)));
struct StageRegs {
  u32x4 k0, k1, v0, v1;
};
template <bool HASV>
__device__ __forceinline__ void load_stage(StageRegs& r, const half_t* __restrict__ Kb, int ldk,
                                           const half_t* __restrict__ VT, int ldv, int key0, int tid) {
  const int row = tid >> 3, c = tid & 7;
  r.k0 = *(const u32x4*)(Kb + (size_t)(key0 + row) * ldk + c * 8);
  r.k1 = *(const u32x4*)(Kb + (size_t)(key0 + row + 32) * ldk + c * 8);
  if (HASV) {
    r.v0 = *(const u32x4*)(VT + (size_t)row * ldv + key0 + c * 8);
    r.v1 = *(const u32x4*)(VT + (size_t)(row + 32) * ldv + key0 + c * 8);
  }
}
template <bool HASV>
__device__ __forceinline__ void write_stage(const StageRegs& r, half_t* Ks, half_t* Vs, int tid) {
  const int row = tid >> 3, c = tid & 7;
  *(u32x4*)&Ks[row * 72 + c * 8] = r.k0;
  *(u32x4*)&Ks[(row + 32) * 72 + c * 8] = r.k1;
  if (HASV) {
    const int ks = c >> 1, a = c & 1;
    u32x2 lo, hi;
    lo[0] = r.v0[0]; lo[1] = r.v0[1]; hi[0] = r.v0[2]; hi[1] = r.v0[3];
    *(u32x2*)&Vs[row * 72 + ks * 16 + a * 4] = lo;
    *(u32x2*)&Vs[row * 72 + ks * 16 + 8 + a * 4] = hi;
    lo[0] = r.v1[0]; lo[1] = r.v1[1]; hi[0] = r.v1[2]; hi[1] = r.v1[3];
    *(u32x2*)&Vs[(row + 32) * 72 + ks * 16 + a * 4] = lo;
    *(u32x2*)&Vs[(row + 32) * 72 + ks * 16 + 8 + a * 4] = hi;
  }
}
template <bool ONLINE, bool HASV, bool FAST, class VF>
__device__ __forceinline__ void dense_block(DState& st, const half_t* Ks, const half_t* Vs, const h8* qf, int key0,
                                            int flag, VF valid, float fixed_m, float fixed_invl, f32x16* pout,
                                            int lane) {
  const int h = lane >> 5, c = lane & 31;
  f32x16 s[2];
#pragma unroll
  for (int kt = 0; kt < 2; ++kt) {
#pragma unroll
    for (int r = 0; r < 16; ++r) s[kt][r] = 0.f;
#pragma unroll
    for (int ks = 0; ks < 4; ++ks) {
      const h8 a = *(const h8*)&Ks[(32 * kt + c) * 72 + 16 * ks + 8 * h];
      s[kt] = __builtin_amdgcn_mfma_f32_32x32x16_f16(a, qf[ks], s[kt], 0, 0, 0);
    }
  }
  float cm = NEGF;
#pragma unroll
  for (int kt = 0; kt < 2; ++kt)
#pragma unroll
    for (int r = 0; r < 16; ++r) {
      const int key = key0 + 32 * kt + (r & 3) + 8 * (r >> 2) + 4 * h;
      const float v = (FAST ? (flag != 0) : valid(key, flag)) ? s[kt][r] : NEGF;
      s[kt][r] = v;
      cm = fmaxf(cm, v);
    }
  float mnew;
  if (ONLINE) {
    cm = fmaxf(cm, __shfl_xor(cm, 32));
    mnew = st.m;
    if (__ballot(cm > st.m + 8.0f) != 0ull) {
      mnew = fmaxf(st.m, cm);
      const float alpha = __builtin_amdgcn_exp2f(st.m - mnew);
      st.m = mnew;
      st.l *= alpha;
      if (HASV) {
#pragma unroll
        for (int dt = 0; dt < 2; ++dt)
#pragma unroll
          for (int r = 0; r < 16; ++r) st.o[dt][r] *= alpha;
      }
    }
  } else {
    mnew = fixed_m;
  }
  float ps = 0.f;
#pragma unroll
  for (int kt = 0; kt < 2; ++kt)
#pragma unroll
    for (int r = 0; r < 16; ++r) {
      float e = __builtin_amdgcn_exp2f(s[kt][r] - mnew);
      if (!ONLINE) e *= fixed_invl;
      s[kt][r] = e;
      ps += e;
    }
  st.l += ps;
  if (pout) { pout[0] = s[0]; pout[1] = s[1]; }
  if (HASV) {
#pragma unroll
    for (int ks = 0; ks < 4; ++ks) {
      h8 pf;
#pragma unroll
      for (int jj = 0; jj < 8; ++jj) pf[jj] = (half_t)s[ks >> 1][8 * (ks & 1) + jj];
#pragma unroll
      for (int dt = 0; dt < 2; ++dt) {
        const h8 vf = *(const h8*)&Vs[(32 * dt + c) * 72 + 16 * ks + 8 * h];
        st.o[dt] = __builtin_amdgcn_mfma_f32_32x32x16_f16(vf, pf, st.o[dt], 0, 0, 0);
      }
    }
  }
}
template <bool ONLINE, bool HASV, bool WANTP, class PRE, class FU, class VF, class PO>
__device__ __forceinline__ void run_dense(DState& st, const half_t* __restrict__ Kb, int ldk,
                                          const half_t* __restrict__ VT, int ldv, int blk_lo, int blk_hi, const h8* qf,
                                          PRE pre, FU full, VF valid, float fixed_m, float fixed_invl, PO post, char* smem,
                                          int tid) {
  half_t* Ks = (half_t*)smem;
  half_t* Vs = Ks + 64 * 72;
  const int lane = tid & 63;
  StageRegs sr;
  load_stage<HASV>(sr, Kb, ldk, VT, ldv, blk_lo * 64, tid);
  for (int blk = blk_lo; blk <= blk_hi; ++blk) {
    __syncthreads();
    write_stage<HASV>(sr, Ks, Vs, tid);
    __syncthreads();
    const int nb = blk < blk_hi ? blk + 1 : blk;
    load_stage<HASV>(sr, Kb, ldk, VT, ldv, nb * 64, tid);
    const int flag = pre(blk);
    if (__ballot(flag != 0) != 0ull) {
      f32x16 pp[2];
      if (full(blk))
        dense_block<ONLINE, HASV, true>(st, Ks, Vs, qf, blk * 64, flag, valid, fixed_m, fixed_invl,
                                        WANTP ? pp : (f32x16*)nullptr, lane);
      else
        dense_block<ONLINE, HASV, false>(st, Ks, Vs, qf, blk * 64, flag, valid, fixed_m, fixed_invl,
                                         WANTP ? pp : (f32x16*)nullptr, lane);
      if (WANTP) post(blk * 64, pp);
    }
  }
}

__device__ __forceinline__ void nsa_item(const KP& p, int b, int g, int tile, char* smem) {
  int tid = threadIdx.x;
  asm volatile("" : "+v"(tid));
  const int lane = tid & 63, wid = tid >> 6;
  const int t0 = tile * 32;
  const int tw0 = t0 + 8 * wid;
  const int col = lane & 31, h = lane >> 5;
  const int j = col >> 2, r4 = col & 3;
  const int tj = tw0 + j;
  const int head = g * 4 + r4;
  float* impA = (float*)(smem + 18432 + wid * 8320);
  float* impB = impA + 1024;
  unsigned long long* msk = (unsigned long long*)(smem + 18432 + 4 * 8320 + wid * 128);
  uint32_t* kbuf = (uint32_t*)(smem + 18432 + 4 * 8320 + 512 + wid * 512);
  const half_t* ub = p.u() + (size_t)b * SEQ * NU;
  const half_t* urow = ub + (size_t)tj * NU;
  h8 qf[4];
#pragma unroll
  for (int ks = 0; ks < 4; ++ks) {
    qf[ks] = *(const h8*)(urow + C_CQ + head * 64 + 16 * ks + 8 * h);
#pragma unroll
    for (int e = 0; e < 8; ++e) qf[ks][e] = (half_t)((float)qf[ks][e] * 0.18033688f);
  }
  float gate[3];
#pragma unroll
  for (int i = 0; i < 3; ++i) gate[i] = sigmoidf_((float)urow[C_CG + head * 3 + i]);
  f32x16 res[2];
#pragma unroll
  for (int dt = 0; dt < 2; ++dt)
#pragma unroll
    for (int r = 0; r < 16; ++r) res[dt][r] = 0.f;
  for (int i = lane; i < 2080; i += 64) impA[i] = 0.f;
  DState st;
  auto nopost = [&](int, f32x16*) __attribute__((always_inline)) {};

  {
    const int nmax_j = (tj >= 31) ? ((tj - 31) >> 4) : -1;
    const int bhi = (t0 >> 4) >> 6;
    const half_t* Kc = p.kcmp() + (size_t)(b * 2 + g) * 512 * 64;
    const half_t* Vc = p.vcmpT() + (size_t)(b * 2 + g) * 64 * 512;
    auto pre = [&](int) __attribute__((always_inline)) { return 1; };
    const int nmax_w = (tw0 >= 31) ? ((tw0 - 31) >> 4) : -1;
    auto fullc = [&](int blk) __attribute__((always_inline)) { return blk * 64 + 63 <= nmax_w; };
    auto vfn = [&](int n, int) __attribute__((always_inline)) { return n <= nmax_j; };
    ds_reset(st);
    run_dense<true, false, false>(st, Kc, 64, (const half_t*)nullptr, 0, 0, bhi, qf, pre, fullc, vfn, 0.f, 0.f, nopost, smem, tid);
    float lt = st.l;
    lt += __shfl_xor(lt, 32);
    const float mfix = st.m;
    const float invl = lt > 0.f ? 1.f / lt : 0.f;
    ds_reset(st);
    auto post = [&](int n0, f32x16* pp) __attribute__((always_inline)) {
#pragma unroll
      for (int kt = 0; kt < 2; ++kt)
#pragma unroll
        for (int qd = 0; qd < 4; ++qd) {
          float a = pp[kt][4 * qd] + pp[kt][4 * qd + 1] + pp[kt][4 * qd + 2] + pp[kt][4 * qd + 3];
          float bb = pp[kt][4 * qd + 3];
          a += dpp_quad<0xB1>(a); a += dpp_quad<0x4E>(a);
          bb += dpp_quad<0xB1>(bb); bb += dpp_quad<0x4E>(bb);
          if (r4 == 0) {
            const int sblk = (n0 >> 2) + 8 * kt + 2 * qd + h;
            impA[j * 128 + sblk] = a;
            impB[j * 132 + sblk + 1] = bb;
          }
        }
    };
    run_dense<false, true, true>(st, Kc, 64, Vc, 512, 0, bhi, qf, pre, fullc, vfn, mfix, invl, post, smem, tid);
#pragma unroll
    for (int dt = 0; dt < 2; ++dt)
#pragma unroll
      for (int r = 0; r < 16; ++r) res[dt][r] += gate[0] * st.o[dt][r];
  }
  __builtin_amdgcn_wave_barrier();
#pragma unroll 1
  for (int jj = 0; jj < 8; ++jj) {
    const int t = tw0 + jj;
    const int blk = t >> 6;
    uint32_t k0, k1;
    {
      const int s0 = lane, s1 = lane + 64;
      const float i0 = impA[jj * 128 + s0] + impB[jj * 132 + s0];
      const float i1 = impA[jj * 128 + s1] + impB[jj * 132 + s1];
      auto mk = [&](float im, int s) __attribute__((always_inline)) -> uint32_t {
        if (s > blk) return 0u;
        uint32_t kk = ((__float_as_uint(im) >> 1) & ~127u) | (uint32_t)(127 - s) | 0x40000000u;
        if (s == 0 || s == blk || s == blk - 1) kk |= 0x80000000u;
        return kk;
      };
      k0 = mk(i0, s0); k1 = mk(i1, s1);
    }
    kbuf[lane] = k0;
    kbuf[lane + 64] = k1;
    __builtin_amdgcn_wave_barrier();
    int r0 = 0, r1 = 0;
#pragma unroll 4
    for (int qd = 0; qd < 32; ++qd) {
      const uint4 kq = *(const uint4*)&kbuf[4 * qd];
      r0 += (kq.x > k0) + (kq.y > k0) + (kq.z > k0) + (kq.w > k0);
      r1 += (kq.x > k1) + (kq.y > k1) + (kq.z > k1) + (kq.w > k1);
    }
    const unsigned long long lo = __ballot(k0 != 0u && r0 < 16);
    const unsigned long long hi = __ballot(k1 != 0u && r1 < 16);
    __builtin_amdgcn_wave_barrier();
    if (lane == 0) { msk[jj * 2] = lo; msk[jj * 2 + 1] = hi; }
  }
  __builtin_amdgcn_wave_barrier();
  const unsigned long long mylo = msk[j * 2], myhi = msk[j * 2 + 1];
  {
    const half_t* Ksel = ub + C_CKS + g * 64;
    const half_t* Vsel = p.vsT() + (size_t)(b * 2 + g) * 64 * SEQ;
    auto pre = [&](int blk) __attribute__((always_inline)) {
      const unsigned long long mm_ = (blk < 64) ? mylo : myhi;
      return (int)((mm_ >> (blk & 63)) & 1ull);
    };
    auto vfn = [&](int key, int flag) __attribute__((always_inline)) { return flag != 0 && key <= tj; };
    ds_reset(st);
    auto fulls = [&](int blk) __attribute__((always_inline)) { return blk * 64 + 63 <= tw0; };
    run_dense<true, true, false>(st, Ksel, NU, Vsel, SEQ, 0, (t0 + 31) >> 6, qf, pre, fulls, vfn, 0.f, 0.f, nopost, smem, tid);
    float lt = st.l;
    lt += __shfl_xor(lt, 32);
    const float sc = lt > 0.f ? gate[1] / lt : 0.f;
#pragma unroll
    for (int dt = 0; dt < 2; ++dt)
#pragma unroll
      for (int r = 0; r < 16; ++r) res[dt][r] += sc * st.o[dt][r];
  }
  {
    const half_t* Kw = ub + C_CKW + g * 64;
    const half_t* Vw = p.vwT() + (size_t)(b * 2 + g) * 64 * SEQ;
    auto pre = [&](int blk) __attribute__((always_inline)) {
      return (int)((blk * 64 <= tj) && (blk * 64 + 63 > tj - 512));
    };
    auto vfn = [&](int key, int) __attribute__((always_inline)) { return key <= tj && key > tj - 512; };
    ds_reset(st);
    auto fullw = [&](int blk) __attribute__((always_inline)) { return blk * 64 + 63 <= tw0 && blk * 64 > tw0 + 7 - 512; };
    run_dense<true, true, false>(st, Kw, NU, Vw, SEQ, max(0, t0 - 511) >> 6, (t0 + 31) >> 6, qf, pre, fullw, vfn, 0.f, 0.f,
                                 nopost, smem, tid);
    float lt = st.l;
    lt += __shfl_xor(lt, 32);
    const float sc = lt > 0.f ? gate[2] / lt : 0.f;
#pragma unroll
    for (int dt = 0; dt < 2; ++dt)
#pragma unroll
      for (int r = 0; r < 16; ++r) res[dt][r] += sc * st.o[dt][r];
  }
  half_t* yrow = p.yc() + (size_t)(b * SEQ + tj) * 512 + head * 64;
#pragma unroll
  for (int dt = 0; dt < 2; ++dt)
#pragma unroll
    for (int qd = 0; qd < 4; ++qd) {
      const int d = 32 * dt + 8 * qd + 4 * h;
      const h4 z = *(const h4*)(urow + C_CZ + head * 64 + d);
      h4 ov;
#pragma unroll
      for (int e = 0; e < 4; ++e) ov[e] = (half_t)(res[dt][4 * qd + e] * siluf_((float)z[e]));
      *(h4*)(yrow + d) = ov;
    }
  __syncthreads();
}

__device__ __forceinline__ void phase_nsa(const KP& p, char* smem, int* q, int xcc) {
  xcd_schedule(q, xcc, 1024, 1, smem, [&](int grp, int) __attribute__((always_inline)) {
    const int y = grp & 7, k = grp >> 3;
    const int b = y & 1, g = (y >> 1) & 1, tile = 255 - (k * 2 + (y >> 2));
    nsa_item(p, b, g, tile, smem);
  });
}

__device__ __forceinline__ void phase_merge(const KP& p, char* smem, int* q, int xcc) {
  xcd_schedule(q, xcc, 16, 64, smem, [&](int grp, int within) __attribute__((always_inline)) {
    const int mt = (grp & 15) * 8 + (within & 7), nt = (within >> 3);
    const int m0 = mt * 128, n0 = nt * 128;
    f32x16 tot[2][2];
#pragma unroll
    for (int i = 0; i < 2; ++i)
#pragma unroll
      for (int jn = 0; jn < 2; ++jn)
#pragma unroll
        for (int r = 0; r < 16; ++r) tot[i][jn][r] = 0.f;
#pragma unroll 1
    for (int br = 0; br < 3; ++br) {
      const half_t* A = (br == 0 ? p.ya() : (br == 1 ? p.yb() : p.yc())) + (size_t)m0 * 512;
      const half_t* B = p.wpT() + (size_t)br * DM * 512 + (size_t)n0 * 512;
      const half_t* G = p.u() + (size_t)m0 * NU + C_GM + br * 1024 + n0;
      gemm_tile<2>(
          512, [&](int r, int k) { return *(const uint4*)(A + (size_t)r * 512 + k); },
          [&](int r, int k) { return *(const uint4*)(B + (size_t)r * 512 + k); },
          [&](int mi, int ni, int r, int row, int col, float v) {
            const float gz = (float)G[(size_t)row * NU + col];
            tot[mi][ni][r] += sigmoidf_(gz) * v;
          },
          smem);
    }
    int tidx = threadIdx.x;
    asm volatile("" : "+v"(tidx));
    const int lane = tidx & 63, wid = tidx >> 6, wm = wid >> 1, wn = wid & 1;
#pragma unroll
    for (int mi = 0; mi < 2; ++mi)
#pragma unroll
      for (int ni = 0; ni < 2; ++ni)
#pragma unroll
        for (int r = 0; r < 16; ++r) {
          const int row = wm * 64 + mi * 32 + (r & 3) + 8 * (r >> 2) + 4 * (lane >> 5);
          const int col = wn * 64 + ni * 32 + (lane & 31);
          p.mm()[(size_t)(m0 + row) * DM + n0 + col] = (half_t)tot[mi][ni][r];
        }
  });
}

__device__ __forceinline__ void phase_outproj(const KP& p, char* smem, int* q, int xcc) {
  xcd_schedule(q, xcc, 8, 64, smem, [&](int grp, int within) __attribute__((always_inline)) {
    const int mt = grp * 8 + (within & 7), nt = (within >> 3);
    const int m0 = mt * 256, n0 = nt * 128;
    const half_t* A = p.mm() + (size_t)m0 * DM;
    const half_t* B = p.woT() + (size_t)n0 * DM;
    gemm_tile_big(
        DM, [&](int r, int k) { return *(const uint4*)(A + (size_t)r * DM + k); },
        [&](int r, int k) { return *(const uint4*)(B + (size_t)r * DM + k); },
        [&](int mi, int ni, int r, int row, int col, float v) {
          const size_t xi = (size_t)(m0 + row) * DM + n0 + col;
          ((float*)p.u())[xi] = ALPHA_F * p.xr()[xi] + v;
        },
        smem);
  });
}

#define XB_TMO      128
#define XB_XCNT(j)  (256  + 64 * (j))
#define XB_XSUB(j)  (1280 + 64 * (j))
#define XB_XGEN(j)  (2304 + 64 * (j))
#define XB_TOP      3328
#define XB_TOPGEN   3392
#define XCD_BAR_WORDS 3456
#define XB_SPIN_CAP (1u << 20)
#define LAS __attribute__((address_space(3)))
__device__ __forceinline__ unsigned xb_ld(unsigned* p)              { return __hip_atomic_load(p, __ATOMIC_RELAXED, __HIP_MEMORY_SCOPE_AGENT); }
__device__ __forceinline__ unsigned xb_add(unsigned* p, unsigned v) { return __hip_atomic_fetch_add(p, v, __ATOMIC_RELAXED, __HIP_MEMORY_SCOPE_AGENT); }
__device__ __forceinline__ unsigned xb_xcc_id() { return (unsigned)__builtin_amdgcn_s_getreg((3 << 11) | 20) & 0xFu; }
#define XB_SPIN(cond, bar) do { unsigned _sp = 0; while (cond) { __builtin_amdgcn_s_sleep(1); \
    if ((++_sp & 255u) == 0u) { if (xb_ld(&(bar)[XB_TMO])) break; if (_sp > XB_SPIN_CAP) { atomicAdd(&(bar)[XB_TMO], 1u); break; } } } } while (0)
struct XcdBarrier { unsigned* bar; unsigned x; volatile LAS unsigned* st; };
__device__ __forceinline__ XcdBarrier xcd_barrier_post(unsigned* bar, volatile LAS unsigned* st) {
  XcdBarrier b; b.bar = bar; b.x = xb_xcc_id(); b.st = st;
  if (threadIdx.x == 0) (void)xb_add(&bar[XB_XCNT(b.x)], 1u);
  return b;
}
__device__ __forceinline__ void xcd_barrier_complete(unsigned* bar, unsigned x, unsigned& nloc, unsigned& nx) {
  const unsigned G = gridDim.x * gridDim.y * gridDim.z;
  unsigned sum, cnt, mine, sp = 0u;
  for (;;) {
    sum = 0u; cnt = 0u; mine = 0u;
#pragma unroll
    for (unsigned j = 0; j < 16; ++j) { const unsigned c = xb_ld(&bar[XB_XCNT(j)]); sum += c; cnt += (c > 0u) ? 1u : 0u; mine = (j == x) ? c : mine; }
    if (sum == G) break;
    __builtin_amdgcn_s_sleep(1);
    if ((++sp & 255u) == 0u) { if (xb_ld(&bar[XB_TMO])) break; if (sp > XB_SPIN_CAP) { atomicAdd(&bar[XB_TMO], 1u); break; } }
  }
  nloc = mine > 0u ? mine : 1u; nx = cnt > 0u ? cnt : 1u;
}
__device__ __forceinline__ void xcd_barrier(const XcdBarrier& b) {
  asm volatile("s_waitcnt vmcnt(0)" ::: "memory");
  __syncthreads();
  if (threadIdx.x == 0) {
    unsigned* bar = b.bar;
    __builtin_amdgcn_s_waitcnt(0);
    unsigned nloc = b.st[0], nx = b.st[1];
    if (nloc == 0u) { xcd_barrier_complete(bar, b.x, nloc, nx); b.st[0] = nloc; b.st[1] = nx; }
    const unsigned old = xb_add(&bar[XB_XSUB(b.x)], 1u);
    const unsigned gen = old / nloc;
    if (old + 1u == (gen + 1u) * nloc) {
      __builtin_amdgcn_fence(__ATOMIC_RELEASE, "agent");
      asm volatile("s_waitcnt vmcnt(0)" ::: "memory");
      const unsigned og = xb_add(&bar[XB_TOP], 1u);
      const unsigned tg = og / nx;
      if (og + 1u == (tg + 1u) * nx) xb_add(&bar[XB_TOPGEN], 1u);
      else XB_SPIN(xb_ld(&bar[XB_TOPGEN]) == tg, bar);
      __builtin_amdgcn_fence(__ATOMIC_ACQUIRE, "agent");
      xb_add(&bar[XB_XGEN(b.x)], 1u);
      asm volatile("s_waitcnt vmcnt(0)" ::: "memory");
    } else {
      XB_SPIN(xb_ld(&bar[XB_XGEN(b.x)]) == gen, bar);
      __builtin_amdgcn_fence(__ATOMIC_ACQUIRE, "agent");
      asm volatile("s_waitcnt vmcnt(0)" ::: "memory");
    }
  }
  __syncthreads();
}

#define NQ_WORDS 4096
__global__ void __launch_bounds__(256, 2) fwd_megakernel(Params p_unused) {
  cg::grid_group grid = cg::this_grid();
  __shared__ __attribute__((aligned(16))) char smem[SMEM_BYTES];
  volatile LAS unsigned* st = (volatile LAS unsigned*)(smem + SMEM_BYTES - 32);
  if (threadIdx.x == 0) { st[0] = 0u; st[1] = 0u; }
  __syncthreads();
  if (gridDim.y == 4242u) grid.sync();
  XcdBarrier xb;
  {
    const KP p = get_params();
    xb = xcd_barrier_post((unsigned*)p.counters() + NQ_WORDS, st);
    ln_rows(p, -1, false);
    prep_weights(p, 0, smem);
  }
  xcd_barrier(xb);
  const int xcc = (int)(xb.x & 7u);
#ifndef REP1
#define REP1 1
#define REP2 1
#define REP3 1
#define REP4 1
#endif
#ifndef REP5
#define REP5 1
#define REP6 1
#define REP7 0
#endif
#pragma unroll 1
  for (int l = 0; l < DEPTH; ++l) {
#define QPTR(ph, rep) (p.counters() + ((l * 6 + (ph)) * 4 + (rep)) * 32)
    for (int rep = 0; rep < REP1; ++rep) { const KP p = get_params(); phase_inproj(p, l, smem, QPTR(0, rep), xcc); }
    xcd_barrier(xb);
    for (int rep = 0; rep < REP2; ++rep) { const KP p = get_params(); phase2(p, l, smem, QPTR(1, rep), xcc); }
    xcd_barrier(xb);
    for (int rep = 0; rep < REP3; ++rep) { const KP p = get_params(); phase_nsa(p, smem, QPTR(2, rep), xcc); }
    xcd_barrier(xb);
    for (int rep = 0; rep < REP4; ++rep) { const KP p = get_params(); phase_merge(p, smem, QPTR(3, rep), xcc); }
    xcd_barrier(xb);
    for (int rep = 0; rep < REP5; ++rep) { const KP p = get_params(); phase_outproj(p, smem, QPTR(4, rep), xcc); }
    xcd_barrier(xb);
    for (int rep = 0; rep < REP6; ++rep) {
      const KP p = get_params();
      if (l + 1 < DEPTH) {
        ln_rows(p, l, false);
        prep_weights(p, l + 1, smem);
      } else {
        ln_rows(p, l, true);
      }
    }
    if (l + 1 < DEPTH) xcd_barrier(xb);
    for (int rep = 0; rep < REP7; ++rep) xcd_barrier(xb);
  }
}

extern "C" void kernel_launch(void* const* d_in, const int* in_sizes, int n_in, void* d_out, int out_size,
                              void* d_ws, size_t ws_size, hipStream_t stream) {
  static int grid_blocks = 0;
  if (!grid_blocks) {
    int dev = 0, cus = 0, per_cu = 0;
    (void)hipGetDevice(&dev);
    (void)hipDeviceGetAttribute(&cus, hipDeviceAttributeMultiprocessorCount, dev);
    (void)hipOccupancyMaxActiveBlocksPerMultiprocessor(&per_cu, fwd_megakernel, 256, 0);
    if (per_cu > 2) per_cu = 2;
    if (per_cu < 1) per_cu = 1;
    grid_blocks = cus * per_cu;
  }
  Params p{};
  p.x = (const float*)d_in[0]; p.w_in = (const float*)d_in[1]; p.b_in = (const float*)d_in[2];
  p.pool_w = (const float*)d_in[3]; p.pool_b = (const float*)d_in[4]; p.pool_scale = (const float*)d_in[5];
  p.pos_k = (const float*)d_in[6]; p.pos_v = (const float*)d_in[7]; p.w1k = (const float*)d_in[8];
  p.w2k = (const float*)d_in[9]; p.w1v = (const float*)d_in[10]; p.w2v = (const float*)d_in[11];
  p.wpa = (const float*)d_in[12]; p.wpb = (const float*)d_in[13]; p.wpc = (const float*)d_in[14];
  p.wo = (const float*)d_in[15]; p.ln_g = (const float*)d_in[16]; p.ln_b = (const float*)d_in[17];
  p.out = (float*)d_out;
  p.ws = (char*)d_ws;
  if (WS_TOTAL > ws_size) { fprintf(stderr, "workspace too small: need %zu have %zu\n", (size_t)WS_TOTAL, ws_size); return; }
  (void)hipMemsetAsync((char*)d_ws + OFF_counters, 0, (size_t)(NQ_WORDS + XCD_BAR_WORDS) * 4, stream);
  void* args[] = {&p};
  hipError_t e = hipLaunchCooperativeKernel((void*)fwd_megakernel, dim3(grid_blocks), dim3(256), args, 0, stream);
  if (e != hipSuccess) fprintf(stderr, "cooperative launch failed: %s (grid %d)\n", hipGetErrorString(e), grid_blocks);
}
```
